# Optimizing an MI355X kernel written in HIP

```python
import jax, jax.numpy as jnp
from jax import lax
import numpy as np

D_MODEL = 1024
BATCH = 2
SEQ = 8192
DEPTH = 2

MLA_HEADS = 4
MLA_NOPE_DIM = 128
MLA_ROPE_DIM = 64
MLA_QK_DIM = MLA_NOPE_DIM + MLA_ROPE_DIM
MLA_V_DIM = 128
MLA_Q_RANK = 256
MLA_KV_RANK = 128
MLA_WIDTH = MLA_HEADS * MLA_V_DIM
ROPE_THETA = 10000.0
ATTN_BLOCK = 128
S5_GROUP_CH = 16
S5_GROUPS = 16
S5_WIDTH = S5_GROUPS * S5_GROUP_CH
S5_STATE = 64
LRU_HEADS = 4
LRU_HEAD_DIM = 64
LRU_WIDTH = LRU_HEADS * LRU_HEAD_DIM
LRU_CONV = 4
LRU_C = 8.0
MIX_WIDTH = MLA_WIDTH + S5_WIDTH + LRU_WIDTH
OFF_CQ = 0
OFF_CKV = OFF_CQ + MLA_Q_RANK
OFF_KR = OFF_CKV + MLA_KV_RANK
OFF_S5 = OFF_KR + MLA_ROPE_DIM
OFF_LRU_X = OFF_S5 + S5_WIDTH
OFF_LRU_G = OFF_LRU_X + LRU_WIDTH
IN_WIDTH = OFF_LRU_G + LRU_WIDTH
PEER_HEADS = 8
PEER_KEYS = 128
PEER_EXPERTS = PEER_KEYS * PEER_KEYS
PEER_KEY_DIM = 256
PEER_HALF = PEER_KEY_DIM // 2
PEER_TOPK = 16
PEER_CHUNK = 128
EPS = 1e-6

kernel_name = 'hymba_mla_s5_rglru_peer'


def rms_norm(x, g):
    xf = x.astype(jnp.float32)
    y = xf * lax.rsqrt(jnp.mean(xf * xf, axis=-1, keepdims=True) + EPS)
    return (y * g.astype(jnp.float32)).astype(x.dtype)


def apply_rope(x, cos, sin):
    x1, x2 = jnp.split(x.astype(jnp.float32), 2, axis=-1)
    return jnp.concatenate([x1 * cos - x2 * sin, x1 * sin + x2 * cos], axis=-1).astype(x.dtype)


def linear_combine(e1, e2):
    a1, b1 = e1
    a2, b2 = e2
    return a2 * a1, a2 * b1 + b2


def causal_block_attention(q, k, v):
    B, S, H, Dq = q.shape
    Dv = v.shape[-1]
    nb = S // ATTN_BLOCK
    scale = Dq ** -0.5
    qb = q.reshape(B, nb, ATTN_BLOCK, H, Dq).transpose(1, 0, 2, 3, 4)
    kpos = jnp.arange(S)

    def one_block(args):
        q_blk, i = args
        s = jnp.einsum('bqhd,bkhd->bhqk', q_blk, k, preferred_element_type=jnp.float32) * scale
        qpos = i * ATTN_BLOCK + jnp.arange(ATTN_BLOCK)
        s = jnp.where(kpos[None, :] <= qpos[:, None], s, -jnp.inf)
        p = jax.nn.softmax(s, axis=-1).astype(v.dtype)
        return jnp.einsum('bhqk,bkhd->bqhd', p, v)

    out = lax.map(one_block, (qb, jnp.arange(nb)))
    return out.transpose(1, 0, 2, 3, 4).reshape(B, S, H * Dv)


def mla_mixer(cq, ckv, kr, cos, sin, q_a_norm, w_uq, kv_a_norm, w_ukv, q_norm, k_norm):
    B, S, _ = cq.shape
    q = (rms_norm(cq, q_a_norm) @ w_uq).reshape(B, S, MLA_HEADS, MLA_QK_DIM)
    kv = (rms_norm(ckv, kv_a_norm) @ w_ukv).reshape(B, S, MLA_HEADS, MLA_NOPE_DIM + MLA_V_DIM)
    k_nope, v = kv[..., :MLA_NOPE_DIM], kv[..., MLA_NOPE_DIM:]
    k_rope = jnp.broadcast_to(kr[:, :, None, :], (B, S, MLA_HEADS, MLA_ROPE_DIM))
    k = jnp.concatenate([k_nope, k_rope], axis=-1)
    q = rms_norm(q, q_norm)
    k = rms_norm(k, k_norm)
    q = jnp.concatenate([q[..., :MLA_NOPE_DIM], apply_rope(q[..., MLA_NOPE_DIM:], cos, sin)], axis=-1)
    k = jnp.concatenate([k[..., :MLA_NOPE_DIM], apply_rope(k[..., MLA_NOPE_DIM:], cos, sin)], axis=-1)
    return causal_block_attention(q, k, v)


def s5_mixer(u, a_re, a_im, log_dt, b_re, b_im, c_re, c_im, d_skip, glu_w, glu_b):
    B, S, _ = u.shape
    f32 = jnp.float32
    uf = u.astype(f32).reshape(B, S, S5_GROUPS, S5_GROUP_CH)
    lam = lax.complex(a_re.astype(f32), a_im.astype(f32))
    dt = jnp.exp(log_dt.astype(f32))[:, None]
    lam_bar = jnp.exp(lam * dt)
    b_bar = ((lam_bar - 1.0) / lam)[..., None] * lax.complex(b_re.astype(f32), b_im.astype(f32))
    bu = jnp.einsum('gpc,bsgc->bsgp', b_bar, uf)
    a = jnp.broadcast_to(lam_bar, bu.shape)
    _, h = lax.associative_scan(linear_combine, (a, bu), axis=1)
    cmat = lax.complex(c_re.astype(f32), c_im.astype(f32))
    y = jnp.einsum('gcp,bsgp->bsgc', cmat, h).real + d_skip.astype(f32).reshape(S5_GROUPS, S5_GROUP_CH) * uf
    y = jax.nn.gelu(y.reshape(B, S, S5_WIDTH), approximate=False)
    y = y * jax.nn.sigmoid(y @ glu_w.astype(f32) + glu_b.astype(f32))
    return y.astype(u.dtype)


def rglru_mixer(xb, gate, conv_w, conv_b, w_a, b_a, w_x, b_x, lam):
    B, S, W = xb.shape
    f32 = jnp.float32
    xc = lax.conv_general_dilated(xb, conv_w[:, None, :], window_strides=(1,), padding=[(LRU_CONV - 1, 0)],
                                  dimension_numbers=('NWC', 'WIO', 'NWC'), feature_group_count=W) + conv_b
    xh = xc.reshape(B, S, LRU_HEADS, LRU_HEAD_DIM)
    r = jax.nn.sigmoid(jnp.einsum('bshi,hij->bshj', xh, w_a).reshape(B, S, W) + b_a)
    i = jax.nn.sigmoid(jnp.einsum('bshi,hij->bshj', xh, w_x).reshape(B, S, W) + b_x)
    log_a = LRU_C * r.astype(f32) * jax.nn.log_sigmoid(lam.astype(f32))
    a = jnp.exp(log_a)
    bterm = jnp.sqrt(-jnp.expm1(2.0 * log_a)) * (i * xc).astype(f32)
    _, h = lax.associative_scan(linear_combine, (a, bterm), axis=1)
    return (h * jax.nn.gelu(gate.astype(f32), approximate=False)).astype(xb.dtype)


def peer_ffn(x, w_query, sub_keys, expert_u, expert_v):
    B, S, D = x.shape
    T = B * S
    H, K = PEER_HEADS, PEER_TOPK
    xt = x.reshape(T, D)
    q = (xt @ w_query).reshape(T, H, 2, PEER_HALF)
    scores = jnp.einsum('thpd,pnd->thpn', q, sub_keys, preferred_element_type=jnp.float32)
    s_top, i_top = lax.top_k(scores, K)
    cand_s = (s_top[:, :, 0, :, None] + s_top[:, :, 1, None, :]).reshape(T, H, K * K)
    cand_i = (i_top[:, :, 0, :, None] * PEER_KEYS + i_top[:, :, 1, None, :]).reshape(T, H, K * K)
    best, pos = lax.top_k(cand_s, K)
    idx = jnp.take_along_axis(cand_i, pos, axis=-1)
    gates = jax.nn.softmax(best, axis=-1)
    nc = T // PEER_CHUNK

    def chunk(args):
        xc, ic, gc = args
        u = expert_u[ic]
        hid = jax.nn.gelu(jnp.einsum('chkd,cd->chk', u, xc, preferred_element_type=jnp.float32), approximate=False)
        w = (gc * hid).astype(x.dtype)
        return jnp.einsum('chk,chkd->cd', w, expert_v[ic])

    y = lax.map(chunk, (xt.reshape(nc, PEER_CHUNK, D), idx.reshape(nc, PEER_CHUNK, H, K),
                        gates.reshape(nc, PEER_CHUNK, H, K)))
    return y.reshape(B, S, D)


def setup_inputs(seed: int = 0) -> dict:
    key = jax.random.key(seed)
    ks = iter(jax.random.split(key, 40))
    f32 = jnp.float32
    L = DEPTH

    def nrm(shape, scale):
        return jax.random.normal(next(ks), shape, f32) * scale

    def gain(n):
        return 1.0 + 0.02 * jax.random.normal(next(ks), (L, n), f32)

    x = jax.random.normal(next(ks), (BATCH, SEQ, D_MODEL), f32)
    positions = jnp.broadcast_to(jnp.arange(SEQ, dtype=jnp.int32), (BATCH, SEQ))
    mix_norm = gain(D_MODEL)
    w_in = nrm((L, D_MODEL, IN_WIDTH), D_MODEL ** -0.5)
    q_a_norm = gain(MLA_Q_RANK)
    w_uq = nrm((L, MLA_Q_RANK, MLA_HEADS * MLA_QK_DIM), MLA_Q_RANK ** -0.5)
    kv_a_norm = gain(MLA_KV_RANK)
    w_ukv = nrm((L, MLA_KV_RANK, MLA_HEADS * (MLA_NOPE_DIM + MLA_V_DIM)), MLA_KV_RANK ** -0.5)
    q_norm = gain(MLA_QK_DIM)
    k_norm = gain(MLA_QK_DIM)
    s5_a_re = -0.5 * jnp.exp(0.02 * jax.random.normal(next(ks), (L, S5_GROUPS, S5_STATE), f32))
    s5_a_im = jnp.broadcast_to(jnp.pi * jnp.arange(S5_STATE, dtype=f32), (L, S5_GROUPS, S5_STATE)) \
        + 0.01 * jax.random.normal(next(ks), (L, S5_GROUPS, S5_STATE), f32)
    s5_log_dt = jax.random.uniform(next(ks), (L, S5_GROUPS), f32, minval=float(np.log(1e-3)), maxval=float(np.log(1e-1)))
    bscale = (2.0 * S5_GROUP_CH) ** -0.5
    s5_b_re = nrm((L, S5_GROUPS, S5_STATE, S5_GROUP_CH), bscale)
    s5_b_im = nrm((L, S5_GROUPS, S5_STATE, S5_GROUP_CH), bscale)
    cscale = (2.0 * S5_STATE) ** -0.5
    s5_c_re = nrm((L, S5_GROUPS, S5_GROUP_CH, S5_STATE), cscale)
    s5_c_im = nrm((L, S5_GROUPS, S5_GROUP_CH, S5_STATE), cscale)
    s5_d = nrm((L, S5_WIDTH), 1.0)
    s5_glu_w = nrm((L, S5_WIDTH, S5_WIDTH), S5_WIDTH ** -0.5)
    s5_glu_b = nrm((L, S5_WIDTH), 0.01)
    lru_conv_w = nrm((L, LRU_CONV, LRU_WIDTH), LRU_CONV ** -0.5)
    lru_conv_b = nrm((L, LRU_WIDTH), 0.01)
    lru_w_a = nrm((L, LRU_HEADS, LRU_HEAD_DIM, LRU_HEAD_DIM), LRU_HEAD_DIM ** -0.5)
    lru_b_a = nrm((L, LRU_WIDTH), 0.01)
    lru_w_x = nrm((L, LRU_HEADS, LRU_HEAD_DIM, LRU_HEAD_DIM), LRU_HEAD_DIM ** -0.5)
    lru_b_x = nrm((L, LRU_WIDTH), 0.01)
    a_c = jax.random.uniform(next(ks), (L, LRU_WIDTH), f32, minval=0.9, maxval=0.999)
    s = a_c ** (1.0 / LRU_C)
    lru_lambda = jnp.log(s) - jnp.log1p(-s)
    mix_out_norm = gain(MIX_WIDTH)
    w_out = nrm((L, MIX_WIDTH, D_MODEL), MIX_WIDTH ** -0.5)
    ffn_norm = gain(D_MODEL)
    peer_w_query = nrm((L, D_MODEL, PEER_HEADS * PEER_KEY_DIM), D_MODEL ** -0.5)
    peer_sub_keys = nrm((L, 2, PEER_KEYS, PEER_HALF), PEER_HALF ** -0.5)
    peer_u = nrm((L, PEER_EXPERTS, D_MODEL), D_MODEL ** -0.5)
    peer_v = nrm((L, PEER_EXPERTS, D_MODEL), PEER_HEADS ** -0.5)
    return {'x': x, 'positions': positions, 'mix_norm': mix_norm, 'w_in': w_in,
            'q_a_norm': q_a_norm, 'w_uq': w_uq, 'kv_a_norm': kv_a_norm, 'w_ukv': w_ukv,
            'q_norm': q_norm, 'k_norm': k_norm,
            's5_a_re': s5_a_re, 's5_a_im': s5_a_im, 's5_log_dt': s5_log_dt,
            's5_b_re': s5_b_re, 's5_b_im': s5_b_im, 's5_c_re': s5_c_re, 's5_c_im': s5_c_im,
            's5_d': s5_d, 's5_glu_w': s5_glu_w, 's5_glu_b': s5_glu_b,
            'lru_conv_w': lru_conv_w, 'lru_conv_b': lru_conv_b, 'lru_w_a': lru_w_a, 'lru_b_a': lru_b_a,
            'lru_w_x': lru_w_x, 'lru_b_x': lru_b_x, 'lru_lambda': lru_lambda,
            'mix_out_norm': mix_out_norm, 'w_out': w_out, 'ffn_norm': ffn_norm,
            'peer_w_query': peer_w_query, 'peer_sub_keys': peer_sub_keys, 'peer_u': peer_u, 'peer_v': peer_v}


def reference(x, positions, mix_norm, w_in, q_a_norm, w_uq, kv_a_norm, w_ukv, q_norm, k_norm,
              s5_a_re, s5_a_im, s5_log_dt, s5_b_re, s5_b_im, s5_c_re, s5_c_im, s5_d, s5_glu_w, s5_glu_b,
              lru_conv_w, lru_conv_b, lru_w_a, lru_b_a, lru_w_x, lru_b_x, lru_lambda,
              mix_out_norm, w_out, ffn_norm, peer_w_query, peer_sub_keys, peer_u, peer_v):
    freqs = ROPE_THETA ** (-jnp.arange(0, MLA_ROPE_DIM, 2, dtype=jnp.float32) / MLA_ROPE_DIM)
    ang = positions.astype(jnp.float32)[..., None] * freqs
    cos = jnp.cos(ang)[:, :, None, :]
    sin = jnp.sin(ang)[:, :, None, :]
    for l in range(DEPTH):
        z = rms_norm(x, mix_norm[l]) @ w_in[l]
        a_out = mla_mixer(z[..., OFF_CQ:OFF_CKV], z[..., OFF_CKV:OFF_KR], z[..., OFF_KR:OFF_S5], cos, sin,
                          q_a_norm[l], w_uq[l], kv_a_norm[l], w_ukv[l], q_norm[l], k_norm[l])
        s_out = s5_mixer(z[..., OFF_S5:OFF_LRU_X], s5_a_re[l], s5_a_im[l], s5_log_dt[l], s5_b_re[l], s5_b_im[l],
                         s5_c_re[l], s5_c_im[l], s5_d[l], s5_glu_w[l], s5_glu_b[l])
        r_out = rglru_mixer(z[..., OFF_LRU_X:OFF_LRU_G], z[..., OFF_LRU_G:IN_WIDTH], lru_conv_w[l], lru_conv_b[l],
                            lru_w_a[l], lru_b_a[l], lru_w_x[l], lru_b_x[l], lru_lambda[l])
        g = mix_out_norm[l]
        y = jnp.concatenate([rms_norm(a_out, g[:MLA_WIDTH]),
                             rms_norm(s_out, g[MLA_WIDTH:MLA_WIDTH + S5_WIDTH]),
                             rms_norm(r_out, g[MLA_WIDTH + S5_WIDTH:])], axis=-1)
        x = x + y @ w_out[l]
        x = x + peer_ffn(rms_norm(x, ffn_norm[l]), peer_w_query[l], peer_sub_keys[l], peer_u[l], peer_v[l])
    return x
```

```cpp
#include <hip/hip_runtime.h>
#include <cstdint>
#include <cstdio>

typedef unsigned short bf16;
typedef unsigned int u32;

constexpr int NB = 2, SEQ = 8192, T = NB * SEQ, DM = 1024, NL = 2;
constexpr int ZW = 1280;
constexpr int ZC_CQ = 0, ZC_CKV = 256, ZC_KR = 384, ZC_U = 512, ZC_X = 768, ZC_G = 1024;
constexpr int NH = 4, DQK = 192, DV = 128;
constexpr float EPS = 1e-6f;
constexpr float QSCALE = 0.07216878364870322f * 1.4426950408889634f;

constexpr size_t MiB = 1u << 20;
constexpr size_t WS_CTL = 0, WS_WINT = 1 * MiB, WS_WUQT = 7 * MiB, WS_WUKVT = 8 * MiB, WS_GLUT = 9 * MiB, WS_WOUTT = 10 * MiB,
                 WS_WQT = 14 * MiB, WS_SUBKT = 22 * MiB, WS_COS = 23 * MiB, WS_SIN = 25 * MiB, WS_PU = 28 * MiB, WS_PV = 92 * MiB,
                 WS_XB = 156 * MiB, WS_Z = 188 * MiB, WS_RA = 228 * MiB, WS_RB = 356 * MiB, WS_CKVN = 420 * MiB, WS_AO = 424 * MiB,
                 WS_ROUT = 440 * MiB, WS_Y = 448 * MiB, WS_IDX = 480 * MiB, WS_GATE = 488 * MiB, WS_END = 496 * MiB;
constexpr size_t WS_QRAW = WS_RA, WS_KVRAW = WS_RA + 24 * MiB, WS_QB = WS_RA + 56 * MiB, WS_KB = WS_RA + 80 * MiB, WS_VB = WS_RA + 104 * MiB,
                 WS_CQN = WS_RA + 120 * MiB, WS_SC = WS_RA;
constexpr size_t WS_XC = WS_RB, WS_AA = WS_RB + 16 * MiB, WS_BT = WS_RB + 32 * MiB, WS_YG = WS_RB + 48 * MiB, WS_SOUT = WS_RB + 56 * MiB, WS_QP = WS_RB;
constexpr size_t WS_STOP = WS_Z, WS_ITOP = WS_Z + 16 * MiB;

__device__ __forceinline__ float bf2f(bf16 h) { return __uint_as_float((u32)h << 16); }
__device__ __forceinline__ bf16 f2bf(float f) { u32 u = __float_as_uint(f); return (bf16)((u + 0x7fffu + ((u >> 16) & 1u)) >> 16); }
__device__ __forceinline__ u32 pk2(float lo, float hi) { return (u32)f2bf(lo) | ((u32)f2bf(hi) << 16); }
__device__ __forceinline__ float wave_sum(float v) {
#pragma unroll
    for (int o = 32; o > 0; o >>= 1) v += __shfl_xor(v, o);
    return v;
}
__device__ __forceinline__ float wave_max(float v) {
#pragma unroll
    for (int o = 32; o > 0; o >>= 1) v = fmaxf(v, __shfl_xor(v, o));
    return v;
}
__device__ __forceinline__ float gelu_f(float x) { return 0.5f * x * (1.f + erff(x * 0.70710678118654752f)); }
__device__ __forceinline__ float sigmoid_f(float x) { return 1.f / (1.f + __expf(-x)); }
__device__ __forceinline__ void unpack8(uint4 w, float* o) {
    o[0] = __uint_as_float(w.x << 16); o[1] = __uint_as_float(w.x & 0xffff0000u);
    o[2] = __uint_as_float(w.y << 16); o[3] = __uint_as_float(w.y & 0xffff0000u);
    o[4] = __uint_as_float(w.z << 16); o[5] = __uint_as_float(w.z & 0xffff0000u);
    o[6] = __uint_as_float(w.w << 16); o[7] = __uint_as_float(w.w & 0xffff0000u);
}
__device__ __forceinline__ void sincos_acc(float x, float& s, float& c) {
    double fr = (double)x * 0.15915494309189535; fr -= rint(fr);
    float r = (float)(fr * 6.283185307179586);
    s = sinf(r); c = cosf(r);
}

__global__ void k_prep_transpose(const float* __restrict__ W, int K, int N, bf16* __restrict__ WT, int Nout, int mapmode) {
    __shared__ float tile[32][33];
    const int n0 = blockIdx.x * 32, k0 = blockIdx.y * 32, tx = threadIdx.x & 31, ty = threadIdx.x >> 5;
    for (int i = ty; i < 32; i += 8) {
        int n = n0 + tx, src = n;
        if (mapmode == 1) { if (n < 448) src = n; else if (n < 512) src = -1; else src = n - 64; }
        tile[i][tx] = (src >= 0 && src < N) ? W[(size_t)(k0 + i) * N + src] : 0.f;
    }
    __syncthreads();
    for (int i = ty; i < 32; i += 8) { int n = n0 + i; if (n < Nout) WT[(size_t)n * K + k0 + tx] = f2bf(tile[tx][i]); }
}
__global__ void k_prep_subk(const float* __restrict__ sk, bf16* __restrict__ out) {
    int i = blockIdx.x * blockDim.x + threadIdx.x; if (i >= 256 * 256) return;
    int r = i >> 8, c = i & 255, pp = r >> 7, n = r & 127, p = c >> 7, d = c & 127;
    out[i] = (p == pp) ? f2bf(sk[(pp * 128 + n) * 128 + d]) : (bf16)0;
}
__global__ void k_cvt_bf16(const float4* __restrict__ in, uint2* __restrict__ out, size_t n4) {
    size_t i = (size_t)blockIdx.x * blockDim.x + threadIdx.x, st = (size_t)gridDim.x * blockDim.x;
    for (; i < n4; i += st) { float4 v = in[i]; out[i] = make_uint2(pk2(v.x, v.y), pk2(v.z, v.w)); }
}
__global__ void k_rope_table(const int* __restrict__ pos, float* __restrict__ COS, float* __restrict__ SIN) {
    int i = blockIdx.x * blockDim.x + threadIdx.x; if (i >= T * 32) return;
    int t = i >> 5, j = i & 31;
    float freq = (float)exp(-(double)(2 * j) / 64.0 * 9.210340371976184);
    float ang = (float)pos[t] * freq;
    float s, c; sincos_acc(ang, s, c);
    COS[i] = c; SIN[i] = s;
}

__global__ __launch_bounds__(256) void k_rowprep(const float* __restrict__ x, const float* __restrict__ gain, bf16* __restrict__ XB) {
    const int row = blockIdx.x * 4 + (threadIdx.x >> 6), lane = threadIdx.x & 63;
    const float4* xr = (const float4*)(x + (size_t)row * DM) + lane;
    float4 v[4]; float ss = 0.f;
#pragma unroll
    for (int j = 0; j < 4; ++j) { v[j] = xr[64 * j]; ss += v[j].x * v[j].x + v[j].y * v[j].y + v[j].z * v[j].z + v[j].w * v[j].w; }
    const float rstd = rsqrtf(wave_sum(ss) * (1.f / DM) + EPS);
    uint2* o = (uint2*)(XB + (size_t)row * DM) + lane;
#pragma unroll
    for (int j = 0; j < 4; ++j) { float4 g = ((const float4*)gain)[lane + 64 * j];
        o[64 * j] = make_uint2(pk2(v[j].x * rstd * g.x, v[j].y * rstd * g.y), pk2(v[j].z * rstd * g.z, v[j].w * rstd * g.w)); }
}

enum { EPI_BF16 = 0, EPI_F32 = 1, EPI_GLU = 2, EPI_RESID = 3 };
struct GemmArgs { const bf16* A; const bf16* Bt; void* C; const float* aux0; const bf16* aux1; int lda, M, N, K, ldc, aux_ld; };
template <int EPI> __global__ __launch_bounds__(256) void k_gemm_simple(GemmArgs g) {
    __shared__ float As[16][68], Bs[16][68];
    const int tid = threadIdx.x, tx = tid & 15, ty = tid >> 4, m0 = blockIdx.y * 64, n0 = blockIdx.x * 64;
    float acc[4][4];
#pragma unroll
    for (int i = 0; i < 4; ++i)
#pragma unroll
        for (int j = 0; j < 4; ++j) acc[i][j] = 0.f;
    const int lr = tid >> 2, lk = (tid & 3) * 4;
    for (int k0 = 0; k0 < g.K; k0 += 16) {
        { const uint2 w = *(const uint2*)(g.A + (size_t)(m0 + lr) * g.lda + k0 + lk);
          As[lk][lr] = __uint_as_float(w.x << 16); As[lk + 1][lr] = __uint_as_float(w.x & 0xffff0000u); As[lk + 2][lr] = __uint_as_float(w.y << 16); As[lk + 3][lr] = __uint_as_float(w.y & 0xffff0000u); }
        { const uint2 w = *(const uint2*)(g.Bt + (size_t)(n0 + lr) * g.K + k0 + lk);
          Bs[lk][lr] = __uint_as_float(w.x << 16); Bs[lk + 1][lr] = __uint_as_float(w.x & 0xffff0000u); Bs[lk + 2][lr] = __uint_as_float(w.y << 16); Bs[lk + 3][lr] = __uint_as_float(w.y & 0xffff0000u); }
        __syncthreads();
#pragma unroll
        for (int kk = 0; kk < 16; ++kk) {
            float a[4], b[4];
#pragma unroll
            for (int i = 0; i < 4; ++i) { a[i] = As[kk][ty * 4 + i]; b[i] = Bs[kk][tx * 4 + i]; }
#pragma unroll
            for (int i = 0; i < 4; ++i)
#pragma unroll
                for (int j = 0; j < 4; ++j) acc[i][j] += a[i] * b[j];
        }
        __syncthreads();
    }
#pragma unroll
    for (int i = 0; i < 4; ++i)
#pragma unroll
        for (int j = 0; j < 4; ++j) {
            const int row = m0 + ty * 4 + i, col = n0 + tx * 4 + j; const size_t ix = (size_t)row * g.ldc + col; const float v = acc[i][j];
            if (EPI == EPI_BF16) ((bf16*)g.C)[ix] = f2bf(v);
            else if (EPI == EPI_F32) ((float*)g.C)[ix] = v;
            else if (EPI == EPI_GLU) { const float yg = bf2f(g.aux1[(size_t)row * g.aux_ld + col]); ((bf16*)g.C)[ix] = f2bf(yg * sigmoid_f(v + g.aux0[col])); }
            else { ((float*)g.C)[ix] = g.aux0[ix] + v; }
        }
}

__global__ __launch_bounds__(256) void k_zstats(const bf16* __restrict__ Z, const float* __restrict__ qan, const float* __restrict__ kvan, bf16* __restrict__ CQN, bf16* __restrict__ CKVN) {
    const int row = blockIdx.x * 4 + (threadIdx.x >> 6), lane = threadIdx.x & 63;
    const bf16* zr = Z + (size_t)row * ZW;
    { const uint2 w = *(const uint2*)(zr + ZC_CQ + 4 * lane);
      float a = __uint_as_float(w.x << 16), b = __uint_as_float(w.x & 0xffff0000u), c = __uint_as_float(w.y << 16), d = __uint_as_float(w.y & 0xffff0000u);
      const float rstd = rsqrtf(wave_sum(a * a + b * b + c * c + d * d) * (1.f / 256) + EPS);
      const float4 g = ((const float4*)qan)[lane];
      *(uint2*)(CQN + (size_t)row * 256 + 4 * lane) = make_uint2(pk2(a * rstd * g.x, b * rstd * g.y), pk2(c * rstd * g.z, d * rstd * g.w)); }
    { const u32 w = *(const u32*)(zr + ZC_CKV + 2 * lane);
      float a = __uint_as_float(w << 16), b = __uint_as_float(w & 0xffff0000u);
      const float rstd = rsqrtf(wave_sum(a * a + b * b) * (1.f / 128) + EPS);
      const float2 g = ((const float2*)kvan)[lane];
      *(u32*)(CKVN + (size_t)row * 128 + 2 * lane) = pk2(a * rstd * g.x, b * rstd * g.y); }
}

__global__ __launch_bounds__(256) void k_qkfin(const bf16* __restrict__ QRAW, const bf16* __restrict__ KVRAW, const bf16* __restrict__ Z,
                                               const float* __restrict__ qn, const float* __restrict__ kn, const float* __restrict__ COS, const float* __restrict__ SIN,
                                               bf16* __restrict__ QB, bf16* __restrict__ KB, bf16* __restrict__ VB) {
    const int w = blockIdx.x * 4 + (threadIdx.x >> 6), lane = threadIdx.x & 63;
    const int t = w >> 2, h = w & 3, b = t / SEQ, s = t % SEQ; const size_t bh = (size_t)b * NH + h;
    const float cs = COS[t * 32 + (lane & 31)], sn = SIN[t * 32 + (lane & 31)];
    {
        const bf16* p = QRAW + (size_t)t * 768 + h * DQK;
        float v0 = bf2f(p[lane]), v1 = bf2f(p[lane + 64]), v2 = bf2f(p[lane + 128]);
        const float rstd = rsqrtf(wave_sum(v0 * v0 + v1 * v1 + v2 * v2) * (1.f / DQK) + EPS);
        v0 *= rstd * qn[lane]; v1 *= rstd * qn[lane + 64]; v2 *= rstd * qn[lane + 128];
        const float pr = __shfl_xor(v2, 32);
        const float r2 = (lane < 32) ? (v2 * cs - pr * sn) : (pr * sn + v2 * cs);
        bf16* o = QB + (bh * SEQ + s) * DQK;
        o[lane] = f2bf(v0 * QSCALE); o[lane + 64] = f2bf(v1 * QSCALE); o[lane + 128] = f2bf(r2 * QSCALE);
    }
    {
        const bf16* p = KVRAW + (size_t)t * 1024 + h * 256;
        float v0 = bf2f(p[lane]), v1 = bf2f(p[lane + 64]), v2 = bf2f(Z[(size_t)t * ZW + ZC_KR + lane]);
        const float rstd = rsqrtf(wave_sum(v0 * v0 + v1 * v1 + v2 * v2) * (1.f / DQK) + EPS);
        v0 *= rstd * kn[lane]; v1 *= rstd * kn[lane + 64]; v2 *= rstd * kn[lane + 128];
        const float pr = __shfl_xor(v2, 32);
        const float r2 = (lane < 32) ? (v2 * cs - pr * sn) : (pr * sn + v2 * cs);
        bf16* o = KB + (bh * SEQ + s) * DQK;
        o[lane] = f2bf(v0); o[lane + 64] = f2bf(v1); o[lane + 128] = f2bf(r2);
        bf16* ov = VB + (bh * SEQ + s) * DV;
        ov[lane] = p[128 + lane]; ov[lane + 64] = p[192 + lane];
    }
}

__global__ __launch_bounds__(256) void k_attn_simple(const bf16* __restrict__ QB, const bf16* __restrict__ KB, const bf16* __restrict__ VB, bf16* __restrict__ AO) {
    __shared__ float qs[4][DQK];
    const int wv = threadIdx.x >> 6, lane = threadIdx.x & 63;
    const int gq = blockIdx.x * 4 + wv, bh = gq / SEQ, q = gq % SEQ;
    const bf16* qp = QB + ((size_t)bh * SEQ + q) * DQK;
    qs[wv][lane] = bf2f(qp[lane]); qs[wv][lane + 64] = bf2f(qp[lane + 64]); qs[wv][lane + 128] = bf2f(qp[lane + 128]);
    __syncthreads();
    float m = -1e30f, l = 0.f, o0 = 0.f, o1 = 0.f;
    const int ntile = q / 64 + 1;
    for (int kt = 0; kt < ntile; ++kt) {
        const int key = kt * 64 + lane;
        const uint4* kp = (const uint4*)(KB + ((size_t)bh * SEQ + key) * DQK);
        float sc = 0.f;
#pragma unroll 4
        for (int c = 0; c < 24; ++c) { float kv[8]; unpack8(kp[c], kv);
#pragma unroll
            for (int e = 0; e < 8; ++e) sc += kv[e] * qs[wv][c * 8 + e]; }
        if (key > q) sc = -INFINITY;
        const float mn = fmaxf(m, wave_max(sc));
        const float p = exp2f(sc - mn), al = exp2f(m - mn);
        l = l * al + wave_sum(p); o0 *= al; o1 *= al; m = mn;
        const u32* vp = (const u32*)(VB + ((size_t)bh * SEQ + kt * 64) * DV) + lane;
#pragma unroll 8
        for (int k = 0; k < 64; ++k) { const float pk = __shfl(p, k); const u32 w = vp[(size_t)k * (DV / 2)];
            o0 += pk * __uint_as_float(w << 16); o1 += pk * __uint_as_float(w & 0xffff0000u); }
    }
    const int b = bh / NH, h = bh % NH; const float il = 1.f / l;
    *(u32*)(AO + ((size_t)b * SEQ + q) * 512 + h * DV + 2 * lane) = pk2(o0 * il, o1 * il);
}

__global__ __launch_bounds__(64) void k_s5_simple(const bf16* __restrict__ Z, const float* __restrict__ a_re, const float* __restrict__ a_im, const float* __restrict__ log_dt,
                                                  const float* __restrict__ b_re, const float* __restrict__ b_im, const float* __restrict__ c_re, const float* __restrict__ c_im,
                                                  const float* __restrict__ dsk, bf16* __restrict__ YG) {
    const int b = blockIdx.x >> 4, g = blockIdx.x & 15, p = threadIdx.x;
    const float are = a_re[g * 64 + p], aim = a_im[g * 64 + p], dt = expf(log_dt[g]);
    const float mag = expf(are * dt); float sn, cs; sincos_acc(aim * dt, sn, cs);
    const float lre = mag * cs, lim = mag * sn;
    const float xr = lre - 1.f, xi = lim, den = are * are + aim * aim;
    const float cr = (xr * are + xi * aim) / den, ci = (xi * are - xr * aim) / den;
    float Bre[16], Bim[16], Cre[16], Cim[16];
#pragma unroll
    for (int c = 0; c < 16; ++c) { const float br = b_re[(g * 64 + p) * 16 + c], bi = b_im[(g * 64 + p) * 16 + c];
        Bre[c] = cr * br - ci * bi; Bim[c] = cr * bi + ci * br; Cre[c] = c_re[(g * 16 + c) * 64 + p]; Cim[c] = c_im[(g * 16 + c) * 64 + p]; }
    const float D = (p < 16) ? dsk[g * 16 + p] : 0.f;
    float hre = 0.f, him = 0.f;
    for (int s = 0; s < SEQ; ++s) {
        const bf16* up = Z + (size_t)(b * SEQ + s) * ZW + ZC_U + g * 16;
        float u[16]; unpack8(*(const uint4*)up, u); unpack8(*(const uint4*)(up + 8), u + 8);
        float bre = 0.f, bim = 0.f;
#pragma unroll
        for (int c = 0; c < 16; ++c) { bre += Bre[c] * u[c]; bim += Bim[c] * u[c]; }
        const float nre = lre * hre - lim * him + bre, nim = lre * him + lim * hre + bim; hre = nre; him = nim;
        float my = 0.f;
#pragma unroll
        for (int c = 0; c < 16; ++c) { const float v = wave_sum(Cre[c] * hre - Cim[c] * him); if (p == c) my = v + D * u[c]; }
        if (p < 16) YG[(size_t)(b * SEQ + s) * 256 + g * 16 + p] = f2bf(gelu_f(my));
    }
}

__global__ void k_lru_xc(const bf16* __restrict__ Z, const float* __restrict__ cw, const float* __restrict__ cb, float* __restrict__ XC) {
    const int i = blockIdx.x * blockDim.x + threadIdx.x; const int t = i >> 8, c = i & 255, s = t % SEQ;
    float a = cb[c];
#pragma unroll
    for (int j = 0; j < 4; ++j) { const int ss = s - 3 + j; if (ss >= 0) a += cw[j * 256 + c] * bf2f(Z[(size_t)(t - 3 + j) * ZW + ZC_X + c]); }
    XC[i] = a;
}
__global__ void k_lru_gates(const float* __restrict__ XC, const float* __restrict__ wa, const float* __restrict__ ba, const float* __restrict__ wx, const float* __restrict__ bx,
                            const float* __restrict__ lam, float* __restrict__ AA, float* __restrict__ BT) {
    const int i = blockIdx.x * blockDim.x + threadIdx.x; const int t = i >> 8, c = i & 255, h = c >> 6, j = c & 63;
    const float* xr = XC + (size_t)t * 256 + h * 64;
    float ra = ba[c], rx = bx[c];
    for (int k = 0; k < 64; ++k) { const float xv = xr[k]; ra += xv * wa[(h * 64 + k) * 64 + j]; rx += xv * wx[(h * 64 + k) * 64 + j]; }
    const float r = sigmoid_f(ra), ig = sigmoid_f(rx);
    const float lsg = -log1pf(expf(-lam[c]));
    const float la = 8.f * r * lsg, a = expf(la);
    AA[i] = a; BT[i] = sqrtf(-expm1f(2.f * la)) * (ig * XC[i]);
}
__global__ __launch_bounds__(64) void k_lru_scan(const float* __restrict__ AA, const float* __restrict__ BT, const bf16* __restrict__ Z, bf16* __restrict__ ROUT) {
    const int i = blockIdx.x * 64 + threadIdx.x, b = i >> 8, c = i & 255;
    float h = 0.f;
#pragma unroll 8
    for (int s = 0; s < SEQ; ++s) { const size_t t = (size_t)b * SEQ + s;
        h = AA[t * 256 + c] * h + BT[t * 256 + c];
        ROUT[t * 256 + c] = f2bf(h * gelu_f(bf2f(Z[t * ZW + ZC_G + c]))); }
}

__global__ __launch_bounds__(256) void k_mixnorm(const bf16* __restrict__ AO, const bf16* __restrict__ SOUT, const bf16* __restrict__ ROUT, const float* __restrict__ g, bf16* __restrict__ Y) {
    const int row = blockIdx.x * 4 + (threadIdx.x >> 6), lane = threadIdx.x & 63;
    {   float v[8]; unpack8(*(const uint4*)(AO + (size_t)row * 512 + 8 * lane), v);
        float ss = 0.f;
#pragma unroll
        for (int e = 0; e < 8; ++e) ss += v[e] * v[e];
        const float rstd = rsqrtf(wave_sum(ss) * (1.f / 512) + EPS); const float* gg = g + 8 * lane;
        *(uint4*)(Y + (size_t)row * DM + 8 * lane) = make_uint4(pk2(v[0] * rstd * gg[0], v[1] * rstd * gg[1]), pk2(v[2] * rstd * gg[2], v[3] * rstd * gg[3]),
                                                                pk2(v[4] * rstd * gg[4], v[5] * rstd * gg[5]), pk2(v[6] * rstd * gg[6], v[7] * rstd * gg[7])); }
#pragma unroll
    for (int part = 0; part < 2; ++part) {
        const bf16* src = part == 0 ? SOUT : ROUT; const int off = 512 + 256 * part;
        const uint2 w = *(const uint2*)(src + (size_t)row * 256 + 4 * lane);
        float a = __uint_as_float(w.x << 16), b = __uint_as_float(w.x & 0xffff0000u), c = __uint_as_float(w.y << 16), d = __uint_as_float(w.y & 0xffff0000u);
        const float rstd = rsqrtf(wave_sum(a * a + b * b + c * c + d * d) * (1.f / 256) + EPS); const float* gg = g + off + 4 * lane;
        *(uint2*)(Y + (size_t)row * DM + off + 4 * lane) = make_uint2(pk2(a * rstd * gg[0], b * rstd * gg[1]), pk2(c * rstd * gg[2], d * rstd * gg[3]));
    }
}

__global__ void k_topk_a(const float* __restrict__ SC, float* __restrict__ STOP, int* __restrict__ ITOP) {
    const int i = blockIdx.x * blockDim.x + threadIdx.x;
    const float* sc = SC + (size_t)i * 128;
    float pv = INFINITY; int pn = -1;
    for (int it = 0; it < 16; ++it) {
        float bv = -INFINITY; int bn = 1 << 30;
        for (int n = 0; n < 128; ++n) { const float v = sc[n];
            const bool elig = (v < pv) || (v == pv && n > pn);
            if (elig && (v > bv || (v == bv && n < bn))) { bv = v; bn = n; } }
        STOP[(size_t)i * 16 + it] = bv; ITOP[(size_t)i * 16 + it] = bn; pv = bv; pn = bn;
    }
}
__global__ __launch_bounds__(64) void k_topk_b(const float* __restrict__ STOP, const int* __restrict__ ITOP, int* __restrict__ IDX, float* __restrict__ GATE) {
    __shared__ float sm[64][33];
    const int i = blockIdx.x * 64 + threadIdx.x;
    float* my = sm[threadIdx.x];
    for (int k = 0; k < 32; ++k) my[k] = STOP[(size_t)i * 32 + k];
    float pv = INFINITY; int pn = -1; float best0 = 0.f, den = 0.f;
    float ev[16];
#pragma unroll
    for (int it = 0; it < 16; ++it) {
        float bv = -INFINITY; int bn = 1 << 30;
        for (int f = 0; f < 256; ++f) { const float v = my[f >> 4] + my[16 + (f & 15)];
            const bool elig = (v < pv) || (v == pv && f > pn);
            if (elig && (v > bv || (v == bv && f < bn))) { bv = v; bn = f; } }
        pv = bv; pn = bn;
        if (it == 0) best0 = bv;
        ev[it] = expf(bv - best0); den += ev[it];
        IDX[(size_t)i * 16 + it] = ITOP[(size_t)i * 32 + (bn >> 4)] * 128 + ITOP[(size_t)i * 32 + 16 + (bn & 15)];
    }
#pragma unroll
    for (int it = 0; it < 16; ++it) GATE[(size_t)i * 16 + it] = ev[it] / den;
}

__global__ __launch_bounds__(256) void k_gather(const bf16* __restrict__ HN, const int* __restrict__ IDX, const float* __restrict__ GATE, const bf16* __restrict__ PU, const bf16* __restrict__ PV, float* __restrict__ X) {
    const int t = blockIdx.x * 4 + (threadIdx.x >> 6), lane = threadIdx.x & 63;
    float hn[16]; unpack8(*(const uint4*)(HN + (size_t)t * DM + 8 * lane), hn); unpack8(*(const uint4*)(HN + (size_t)t * DM + 512 + 8 * lane), hn + 8);
    float y[16];
#pragma unroll
    for (int e = 0; e < 16; ++e) y[e] = 0.f;
    for (int k = 0; k < 128; ++k) {
        const int e = IDX[(size_t)t * 128 + k]; const float gt = GATE[(size_t)t * 128 + k];
        const bf16* ur = PU + (size_t)e * DM; const bf16* vr = PV + (size_t)e * DM;
        float u[16]; unpack8(*(const uint4*)(ur + 8 * lane), u); unpack8(*(const uint4*)(ur + 512 + 8 * lane), u + 8);
        float d = 0.f;
#pragma unroll
        for (int q = 0; q < 16; ++q) d += u[q] * hn[q];
        d = wave_sum(d);
        const float w = gt * gelu_f(d);
        float v[16]; unpack8(*(const uint4*)(vr + 8 * lane), v); unpack8(*(const uint4*)(vr + 512 + 8 * lane), v + 8);
#pragma unroll
        for (int q = 0; q < 16; ++q) y[q] += w * v[q];
    }
    float4* xo = (float4*)(X + (size_t)t * DM + 8 * lane);
    float4 a = xo[0], b = xo[1]; a.x += y[0]; a.y += y[1]; a.z += y[2]; a.w += y[3]; b.x += y[4]; b.y += y[5]; b.z += y[6]; b.w += y[7]; xo[0] = a; xo[1] = b;
    xo = (float4*)(X + (size_t)t * DM + 512 + 8 * lane);
    a = xo[0]; b = xo[1]; a.x += y[8]; a.y += y[9]; a.z += y[10]; a.w += y[11]; b.x += y[12]; b.y += y[13]; b.z += y[14]; b.w += y[15]; xo[0] = a; xo[1] = b;
}

template <int EPI> static void gemm_simple(hipStream_t st, const bf16* A, int lda, const bf16* Bt, int M, int N, int K, void* C, int ldc, const float* aux0 = nullptr, const bf16* aux1 = nullptr, int aux_ld = 0) {
    GemmArgs g{}; g.A = A; g.lda = lda; g.Bt = Bt; g.M = M; g.N = N; g.K = K; g.C = C; g.ldc = ldc; g.aux0 = aux0; g.aux1 = aux1; g.aux_ld = aux_ld;
    hipLaunchKernelGGL(k_gemm_simple<EPI>, dim3(N / 64, M / 64), dim3(256), 0, st, g);
}

extern "C" void kernel_launch(void* const* d_in, const int* in_sizes, int n_in, void* d_out, int out_size, void* d_ws, size_t ws_size, hipStream_t stream) {
    if (n_in != 34 || out_size != T * DM || ws_size < WS_END) { fprintf(stderr, "kernel_launch: unexpected shapes (n_in %d out %d ws %zu)\n", n_in, out_size, ws_size); return; }
    char* ws = (char*)d_ws; float* out = (float*)d_out;
#define IN(i) ((const float*)d_in[i])
    bf16 *WINT = (bf16*)(ws + WS_WINT), *WUQT = (bf16*)(ws + WS_WUQT), *WUKVT = (bf16*)(ws + WS_WUKVT), *GLUT = (bf16*)(ws + WS_GLUT), *WOUTT = (bf16*)(ws + WS_WOUTT),
         *WQT = (bf16*)(ws + WS_WQT), *SUBKT = (bf16*)(ws + WS_SUBKT), *PU = (bf16*)(ws + WS_PU), *PV = (bf16*)(ws + WS_PV);
    float *COS = (float*)(ws + WS_COS), *SIN = (float*)(ws + WS_SIN);
    bf16 *XB = (bf16*)(ws + WS_XB), *Z = (bf16*)(ws + WS_Z), *QRAW = (bf16*)(ws + WS_QRAW), *KVRAW = (bf16*)(ws + WS_KVRAW), *QB = (bf16*)(ws + WS_QB), *KB = (bf16*)(ws + WS_KB),
         *VB = (bf16*)(ws + WS_VB), *CQN = (bf16*)(ws + WS_CQN), *CKVN = (bf16*)(ws + WS_CKVN), *AO = (bf16*)(ws + WS_AO), *ROUT = (bf16*)(ws + WS_ROUT), *Y = (bf16*)(ws + WS_Y),
         *YG = (bf16*)(ws + WS_YG), *SOUT = (bf16*)(ws + WS_SOUT), *QP = (bf16*)(ws + WS_QP);
    float *XC = (float*)(ws + WS_XC), *AA = (float*)(ws + WS_AA), *BT = (float*)(ws + WS_BT), *SC = (float*)(ws + WS_SC), *STOP = (float*)(ws + WS_STOP), *GATE = (float*)(ws + WS_GATE);
    int *ITOP = (int*)(ws + WS_ITOP), *IDX = (int*)(ws + WS_IDX);
    for (int l = 0; l < NL; ++l) {
        hipLaunchKernelGGL(k_prep_transpose, dim3(ZW / 32, DM / 32), dim3(256), 0, stream, IN(3) + (size_t)l * DM * 1216, DM, 1216, WINT + (size_t)l * ZW * DM, ZW, 1);
        hipLaunchKernelGGL(k_prep_transpose, dim3(768 / 32, 256 / 32), dim3(256), 0, stream, IN(5) + (size_t)l * 256 * 768, 256, 768, WUQT + (size_t)l * 768 * 256, 768, 0);
        hipLaunchKernelGGL(k_prep_transpose, dim3(1024 / 32, 128 / 32), dim3(256), 0, stream, IN(7) + (size_t)l * 128 * 1024, 128, 1024, WUKVT + (size_t)l * 1024 * 128, 1024, 0);
        hipLaunchKernelGGL(k_prep_transpose, dim3(256 / 32, 256 / 32), dim3(256), 0, stream, IN(18) + (size_t)l * 256 * 256, 256, 256, GLUT + (size_t)l * 256 * 256, 256, 0);
        hipLaunchKernelGGL(k_prep_transpose, dim3(1024 / 32, 1024 / 32), dim3(256), 0, stream, IN(28) + (size_t)l * DM * DM, DM, DM, WOUTT + (size_t)l * DM * DM, DM, 0);
        hipLaunchKernelGGL(k_prep_transpose, dim3(2048 / 32, 1024 / 32), dim3(256), 0, stream, IN(30) + (size_t)l * DM * 2048, DM, 2048, WQT + (size_t)l * 2048 * DM, 2048, 0);
        hipLaunchKernelGGL(k_prep_subk, dim3(256), dim3(256), 0, stream, IN(31) + (size_t)l * 2 * 128 * 128, SUBKT + (size_t)l * 65536);
    }
    hipLaunchKernelGGL(k_cvt_bf16, dim3(4096), dim3(256), 0, stream, (const float4*)IN(32), (uint2*)PU, (size_t)NL * 16384 * DM / 4);
    hipLaunchKernelGGL(k_cvt_bf16, dim3(4096), dim3(256), 0, stream, (const float4*)IN(33), (uint2*)PV, (size_t)NL * 16384 * DM / 4);
    hipLaunchKernelGGL(k_rope_table, dim3(T * 32 / 256), dim3(256), 0, stream, (const int*)d_in[1], COS, SIN);
    for (int l = 0; l < NL; ++l) {
        const float* xin = (l == 0) ? IN(0) : out;
        hipLaunchKernelGGL(k_rowprep, dim3(T / 4), dim3(256), 0, stream, xin, IN(2) + l * DM, XB);
        gemm_simple<EPI_BF16>(stream, XB, DM, WINT + (size_t)l * ZW * DM, T, ZW, DM, Z, ZW);
        hipLaunchKernelGGL(k_zstats, dim3(T / 4), dim3(256), 0, stream, Z, IN(4) + l * 256, IN(6) + l * 128, CQN, CKVN);
        gemm_simple<EPI_BF16>(stream, CQN, 256, WUQT + (size_t)l * 768 * 256, T, 768, 256, QRAW, 768);
        gemm_simple<EPI_BF16>(stream, CKVN, 128, WUKVT + (size_t)l * 1024 * 128, T, 1024, 128, KVRAW, 1024);
        hipLaunchKernelGGL(k_qkfin, dim3(T), dim3(256), 0, stream, QRAW, KVRAW, Z, IN(8) + l * DQK, IN(9) + l * DQK, COS, SIN, QB, KB, VB);
        hipLaunchKernelGGL(k_attn_simple, dim3(NB * NH * SEQ / 4), dim3(256), 0, stream, QB, KB, VB, AO);
        hipLaunchKernelGGL(k_s5_simple, dim3(NB * 16), dim3(64), 0, stream, Z, IN(10) + l * 1024, IN(11) + l * 1024, IN(12) + l * 16, IN(13) + l * 16384, IN(14) + l * 16384,
                           IN(15) + l * 16384, IN(16) + l * 16384, IN(17) + l * 256, YG);
        gemm_simple<EPI_GLU>(stream, YG, 256, GLUT + (size_t)l * 65536, T, 256, 256, SOUT, 256, IN(19) + l * 256, YG, 256);
        hipLaunchKernelGGL(k_lru_xc, dim3(T * 256 / 256), dim3(256), 0, stream, Z, IN(20) + l * 1024, IN(21) + l * 256, XC);
        hipLaunchKernelGGL(k_lru_gates, dim3(T * 256 / 256), dim3(256), 0, stream, XC, IN(22) + l * 16384, IN(23) + l * 256, IN(24) + l * 16384, IN(25) + l * 256, IN(26) + l * 256, AA, BT);
        hipLaunchKernelGGL(k_lru_scan, dim3(NB * 256 / 64), dim3(64), 0, stream, AA, BT, Z, ROUT);
        hipLaunchKernelGGL(k_mixnorm, dim3(T / 4), dim3(256), 0, stream, AO, SOUT, ROUT, IN(27) + l * DM, Y);
        gemm_simple<EPI_RESID>(stream, Y, DM, WOUTT + (size_t)l * DM * DM, T, DM, DM, out, DM, xin);
        hipLaunchKernelGGL(k_rowprep, dim3(T / 4), dim3(256), 0, stream, out, IN(29) + l * DM, XB);
        gemm_simple<EPI_BF16>(stream, XB, DM, WQT + (size_t)l * 2048 * DM, T, 2048, DM, QP, 2048);
        gemm_simple<EPI_F32>(stream, QP, 256, SUBKT + (size_t)l * 65536, T * 8, 256, 256, SC, 256);
        hipLaunchKernelGGL(k_topk_a, dim3(T * 16 / 256), dim3(256), 0, stream, SC, STOP, ITOP);
        hipLaunchKernelGGL(k_topk_b, dim3(T * 8 / 64), dim3(64), 0, stream, STOP, ITOP, IDX, GATE);
        hipLaunchKernelGGL(k_gather, dim3(T / 4), dim3(256), 0, stream, XB, IDX, GATE, PU + (size_t)l * 16384 * DM, PV + (size_t)l * 16384 * DM, out);
    }
#undef IN
}
```

```cpp
#include <hip/hip_runtime.h>
#include <cstdint>
#include <cstdio>

#ifndef MK_PER_PHASE
#define MK_PER_PHASE 0
#endif

typedef unsigned short bf16;
typedef unsigned int u32;

constexpr int NB = 2, SEQ = 8192, T = NB * SEQ, DM = 1024, NL = 2;
constexpr int ZW = 1280;
constexpr int ZC_CQ = 0, ZC_CKV = 256, ZC_KR = 384, ZC_U = 512, ZC_X = 768, ZC_G = 1024;
constexpr int NH = 4, DQK = 192, DV = 128;
constexpr float EPS = 1e-6f;
constexpr float QSCALE = 0.07216878364870322f * 1.4426950408889634f;

constexpr size_t MiB = 1u << 20;
constexpr size_t WS_CTL = 0, CTL_ZERO_BYTES = 1 * MiB, WS_WINT = 1 * MiB, WS_WUQT = 7 * MiB, WS_WUKVT = 8 * MiB, WS_GLUT = 9 * MiB, WS_WOUTT = 10 * MiB,
                 WS_WQT = 14 * MiB, WS_SUBKT = 22 * MiB, WS_COS = 23 * MiB, WS_SIN = 25 * MiB, WS_PU = 28 * MiB, WS_PV = 92 * MiB,
                 WS_XB = 156 * MiB, WS_Z = 188 * MiB, WS_RA = 228 * MiB, WS_RB = 356 * MiB, WS_CKVN = 420 * MiB, WS_AO = 424 * MiB,
                 WS_ROUT = 440 * MiB, WS_Y = 448 * MiB, WS_IDX = 480 * MiB, WS_GATE = 488 * MiB, WS_END = 496 * MiB;
constexpr size_t WS_QRAW = WS_RA, WS_KVRAW = WS_RA + 24 * MiB, WS_QB = WS_RA + 56 * MiB, WS_KB = WS_RA + 80 * MiB, WS_VB = WS_RA + 104 * MiB,
                 WS_CQN = WS_RA + 120 * MiB, WS_SC = WS_RA;
constexpr size_t WS_XC = WS_RB, WS_AA = WS_RB + 16 * MiB, WS_BT = WS_RB + 32 * MiB, WS_YG = WS_RB + 48 * MiB, WS_SOUT = WS_RB + 56 * MiB, WS_QP = WS_RB;
constexpr size_t WS_STOP = WS_Z, WS_ITOP = WS_Z + 16 * MiB;
constexpr int CW_BAR = 4096;

__device__ __forceinline__ float bf2f(bf16 h) { return __uint_as_float((u32)h << 16); }
__device__ __forceinline__ bf16 f2bf(float f) { u32 u = __float_as_uint(f); return (bf16)((u + 0x7fffu + ((u >> 16) & 1u)) >> 16); }
__device__ __forceinline__ u32 pk2(float lo, float hi) { return (u32)f2bf(lo) | ((u32)f2bf(hi) << 16); }
__device__ __forceinline__ float wave_sum(float v) {
#pragma unroll
    for (int o = 32; o > 0; o >>= 1) v += __shfl_xor(v, o);
    return v;
}
__device__ __forceinline__ float wave_max(float v) {
#pragma unroll
    for (int o = 32; o > 0; o >>= 1) v = fmaxf(v, __shfl_xor(v, o));
    return v;
}
__device__ __forceinline__ float gelu_f(float x) { return 0.5f * x * (1.f + erff(x * 0.70710678118654752f)); }
__device__ __forceinline__ float sigmoid_f(float x) { return 1.f / (1.f + __expf(-x)); }
__device__ __forceinline__ void unpack8(uint4 w, float* o) {
    o[0] = __uint_as_float(w.x << 16); o[1] = __uint_as_float(w.x & 0xffff0000u);
    o[2] = __uint_as_float(w.y << 16); o[3] = __uint_as_float(w.y & 0xffff0000u);
    o[4] = __uint_as_float(w.z << 16); o[5] = __uint_as_float(w.z & 0xffff0000u);
    o[6] = __uint_as_float(w.w << 16); o[7] = __uint_as_float(w.w & 0xffff0000u);
}
__device__ __forceinline__ void sincos_acc(float x, float& s, float& c) {
    const float k = rintf(x * 0.15915494309189535f);
    float r = fmaf(-k, 6.28125f, x);
    r = fmaf(-k, 1.9350051879882812e-3f, r);
    r = fmaf(-k, 3.0199160335e-7f, r);
    const float f = r * 0.15915494309189535f;
    s = __builtin_amdgcn_sinf(f); c = __builtin_amdgcn_cosf(f);
}
namespace pg8 {
#define PG8_LAS __attribute__((address_space(3)))
typedef unsigned short bf16_t;
typedef short bf16x8 __attribute__((ext_vector_type(8)));
typedef float f32x4 __attribute__((ext_vector_type(4)));
typedef unsigned u32x4 __attribute__((ext_vector_type(4)));
constexpr int BM = 256, BK = 64, HALF = 128, HTB = HALF * BK * 2  , STAGE_BYTES = 8 * HTB, NXCD = 8, WGM = 8;

__host__ __device__ __forceinline__ int lds_byte(int r, int c) { const int st = (r >> 4) * 2 + (c >> 5), rr = r & 15, cc = c & 31, ob = rr * 64 + cc * 2; return st * 1024 + (ob ^ (((ob >> 9) & 1) << 5)); }
__host__ __device__ __forceinline__ void stage_rc(int b, int& R, int& C) { const int st = b / 1024, sb = b % 1024, swz = sb ^ (((sb >> 9) & 1) << 5); R = (st >> 1) * 16 + swz / 64; C = (st & 1) * 32 + (swz % 64) / 2; }
__host__ __device__ __forceinline__ int perm32(int rho) { const int n = rho >> 4, i = rho & 15; return 8 * (i >> 2) + 4 * n + (i & 3); }

struct Unit { int pm, pn; };
struct Gemm { const bf16_t* A; const bf16_t* Bt; int M, N, K, lda; };

struct StaticOrder {
    int nM, nN, nwg, G, c;
    __host__ __device__ void init(int M, int N, int G_, int c_) { nM = M / BM; nN = N / BM; nwg = nM * nN; G = G_; c = c_; }
    __host__ __device__ bool next(int i, Unit& u) const {
        const long L = (long)i * G + c; if (L >= nwg) return false;
        int wgid = (int)L; { const int q = nwg / NXCD, r = nwg % NXCD, xcd = wgid % NXCD, off = wgid / NXCD; wgid = (xcd < r ? xcd * (q + 1) : r * (q + 1) + (xcd - r) * q) + off; }
        const int nig = WGM * nN, gid = wgid / nig, fm = gid * WGM, gsz = (nM - fm) < WGM ? (nM - fm) : WGM;
        u.pm = fm + ((wgid % nig) % gsz); u.pn = (wgid % nig) / gsz; return true;
    }
    __device__ __forceinline__ void a_ready(const Unit&) const {}
    __device__ __forceinline__ void done(const Unit&) const {}
};

__device__ __forceinline__ unsigned cvt_pk_bf16(float lo, float hi) { unsigned r; asm volatile("v_cvt_pk_bf16_f32 %0, %1, %2" : "=v"(r) : "v"(lo), "v"(hi)); return r; }
typedef float f32x2 __attribute__((ext_vector_type(2)));
__device__ __forceinline__ f32x2 gelu_pk(f32x2 v) {
    const f32x2 av = __builtin_elementwise_abs(v), d = av * 0.2316418882f + 1.0f;
    f32x2 t; t.x = __builtin_amdgcn_rcpf(d.x); t.y = __builtin_amdgcn_rcpf(d.y);
    f32x2 q = t * 0.5307027145f + (-0.7265760135f); q = q * t + 0.7107068705f; q = q * t + (-0.142248368f); q = q * t + 0.127414796f; q = q * t;
    const f32x2 s = (v * v) * (-0.72134752044f);
    f32x2 e; e.x = __builtin_amdgcn_exp2f(s.x); e.y = __builtin_amdgcn_exp2f(s.y);
    const f32x2 m = v * (q * e), r = v - m;
    f32x2 o; o.x = v.x < 0.f ? m.x : r.x; o.y = v.y < 0.f ? m.y : r.y; return o;
}

template <int ACT  > struct EpiBf16 {
    static constexpr bool PERM = true, AFTER_DRAIN = false; static_assert(ACT == 0 || ACT == 1, "EpiBf16: ACT is 0 (none) or 1 (gelu_pk)");
    bf16_t* O; int ldc; const float* bias; int split_cols; size_t split_stride; float scale0;
    __device__ __forceinline__ void operator()(const f32x4 (&acc)[2][2][4][2], const Unit& u, int wr, int wc, int fr, int fq) const {
        const int row0 = u.pm * BM + wr * 64 + fr; int colt = u.pn * BM; bf16_t* base = O;
        float sc = 1.f; if (split_cols) { const int t = colt / split_cols; base += (size_t)t * split_stride; colt -= t * split_cols; if (t == 0) sc = scale0; }
        const int col0 = colt + wc * 32 + 8 * fq, bcol0 = u.pn * BM + wc * 32 + 8 * fq;
        f32x4 bv[2][2];
#pragma unroll
        for (int bj = 0; bj < 2; ++bj)
#pragma unroll
            for (int n = 0; n < 2; ++n) bv[bj][n] = bias ? *(const f32x4*)(bias + bcol0 + bj * HALF + 4 * n) : (f32x4){0.f, 0.f, 0.f, 0.f};
#pragma unroll
        for (int ai = 0; ai < 2; ++ai)
#pragma unroll
            for (int m = 0; m < 4; ++m) { bf16_t* rowp = base + (size_t)(row0 + ai * HALF + m * 16) * ldc + col0;
#pragma unroll
                for (int bj = 0; bj < 2; ++bj) { f32x4 v0 = acc[ai][bj][m][0] + bv[bj][0], v1 = acc[ai][bj][m][1] + bv[bj][1];
                    if (ACT == 1) { f32x2 a = gelu_pk((f32x2){v0[0], v0[1]}), b = gelu_pk((f32x2){v0[2], v0[3]}), c = gelu_pk((f32x2){v1[0], v1[1]}), d = gelu_pk((f32x2){v1[2], v1[3]});
                        v0 = (f32x4){a.x, a.y, b.x, b.y}; v1 = (f32x4){c.x, c.y, d.x, d.y}; }
                    v0 = v0 * sc; v1 = v1 * sc; u32x4 w; w.x = cvt_pk_bf16(v0[0], v0[1]); w.y = cvt_pk_bf16(v0[2], v0[3]); w.z = cvt_pk_bf16(v1[0], v1[1]); w.w = cvt_pk_bf16(v1[2], v1[3]);
                    *(u32x4*)(rowp + bj * HALF) = w; } }
    }
};


struct EpiF32 {
    static constexpr bool PERM = false, AFTER_DRAIN = false;
    float* C; int ldc; const float* resid;
    __device__ __forceinline__ void operator()(const f32x4 (&acc)[2][2][4][2], const Unit& u, int wr, int wc, int fr, int fq) const {
        const int row0 = u.pm * BM + wr * 64 + fr, col0 = u.pn * BM + wc * 32 + 4 * fq;
#pragma unroll
        for (int ai = 0; ai < 2; ++ai)
#pragma unroll
            for (int m = 0; m < 4; ++m) { const size_t rb = (size_t)(row0 + ai * HALF + m * 16) * ldc + col0;
#pragma unroll
                for (int bj = 0; bj < 2; ++bj)
#pragma unroll
                    for (int n = 0; n < 2; ++n) { const size_t ix = rb + bj * HALF + n * 16; f32x4 v = acc[ai][bj][m][n];
                        if (resid) v += *(const f32x4*)(resid + ix);
                        *(f32x4*)(C + ix) = v; } }
    }
};
struct EpiGlu {
    static constexpr bool PERM = true, AFTER_DRAIN = false;
    bf16_t* O; int ldc; const float* bias; const bf16_t* YG;
    __device__ __forceinline__ void operator()(const f32x4 (&acc)[2][2][4][2], const Unit& u, int wr, int wc, int fr, int fq) const {
        const int row0 = u.pm * BM + wr * 64 + fr, col0 = u.pn * BM + wc * 32 + 8 * fq;
#pragma unroll
        for (int ai = 0; ai < 2; ++ai)
#pragma unroll
            for (int m = 0; m < 4; ++m) { const size_t rb = (size_t)(row0 + ai * HALF + m * 16) * ldc + col0;
#pragma unroll
                for (int bj = 0; bj < 2; ++bj) { const size_t ix = rb + bj * HALF;
                    const f32x4 b0 = *(const f32x4*)(bias + col0 + bj * HALF), b1 = *(const f32x4*)(bias + col0 + bj * HALF + 4);
                    const u32x4 yw = *(const u32x4*)(YG + ix);
                    f32x4 v0 = acc[ai][bj][m][0] + b0, v1 = acc[ai][bj][m][1] + b1; float o[8];
#pragma unroll
                    for (int e = 0; e < 4; ++e) { const unsigned w = e == 0 ? yw.x : e == 1 ? yw.y : e == 2 ? yw.z : yw.w;
                        const float y0 = __uint_as_float(w << 16), y1 = __uint_as_float(w & 0xffff0000u);
                        const float a0 = e < 2 ? v0[2 * e] : v1[2 * e - 4], a1 = e < 2 ? v0[2 * e + 1] : v1[2 * e - 3];
                        o[2 * e] = y0 / (1.f + __expf(-a0)); o[2 * e + 1] = y1 / (1.f + __expf(-a1)); }
                    u32x4 w; w.x = cvt_pk_bf16(o[0], o[1]); w.y = cvt_pk_bf16(o[2], o[3]); w.z = cvt_pk_bf16(o[4], o[5]); w.w = cvt_pk_bf16(o[6], o[7]);
                    *(u32x4*)(O + ix) = w; } }
    }
};
template <class Epi, class Sched, bool ALIGN_EPI = false, bool SP2 = false>
__device__ __forceinline__ void gemm_phase(PG8_LAS unsigned char* lds, const Gemm g, const Sched& S, const Epi& E) {
    int tid_l = threadIdx.x; asm volatile("" : "+v"(tid_l));
    const int tid = tid_l, wid = __builtin_amdgcn_readfirstlane(tid >> 6), lane = tid & 63, wr = wid >> 2, wc = wid & 3, fr = lane & 15, fq = lane >> 4;
    const int K = g.K, nt = K / BK;
    unsigned voffA[2], voffB[2];
#pragma unroll
    for (int i = 0; i < 2; ++i) { int R, C; stage_rc(tid * 16 + i * 8192, R, C); const int Rb = Epi::PERM ? ((R & ~31) + perm32(R & 31)) : R;
        voffA[i] = (unsigned)(R * g.lda + C) * 2u; voffB[i] = (unsigned)(Rb * K + C) * 2u; }
    const size_t kstep = (size_t)(BK * 2);
    const size_t hsA = (size_t)HALF * g.lda * 2, hsB = (size_t)HALF * K * 2;
    const size_t tsA = 2 * hsA, tsB = 2 * hsB;
    const unsigned ldsw = (unsigned)wid * 1024u;
    const int aoff = lds_byte(wr * 64 + fr, fq * 8), boff = lds_byte(wc * 32 + fr, fq * 8);
#define PG8_SA(b, h) (((b) * 2 + (h)) * HTB)
#define PG8_SB(b, h) ((4 + (b) * 2 + (h)) * HTB)
#define PG8_STAGE(bufoff, gbase, voff) do { _Pragma("unroll") for (int _i = 0; _i < 2; ++_i) \
        __builtin_amdgcn_global_load_lds((const unsigned*)((const char*)(gbase) + (voff)[_i]), (PG8_LAS unsigned*)(lds + (bufoff) + ldsw + _i * 8192), 16, 0, 0); } while (0)
#define PG8_LDA(dst, b, h) do { _Pragma("unroll") for (int m = 0; m < 4; ++m) _Pragma("unroll") for (int k = 0; k < 2; ++k) dst[m][k] = *(const PG8_LAS bf16x8*)(lds + PG8_SA(b, h) + aoff + m * 2048 + k * 1024); } while (0)
#define PG8_LDB(dst, b, h) do { _Pragma("unroll") for (int n = 0; n < 2; ++n) _Pragma("unroll") for (int k = 0; k < 2; ++k) dst[n][k] = *(const PG8_LAS bf16x8*)(lds + PG8_SB(b, h) + boff + n * 2048 + k * 1024); } while (0)
#define PG8_MMA(ai, bj, At, Bt) do { __builtin_amdgcn_s_setprio(1); _Pragma("unroll") for (int m = 0; m < 4; ++m) _Pragma("unroll") for (int n = 0; n < 2; ++n) _Pragma("unroll") for (int k = 0; k < 2; ++k) \
        acc[ai][bj][m][n] = __builtin_amdgcn_mfma_f32_16x16x32_bf16(Bt[n][k], At[m][k], acc[ai][bj][m][n], 0, 0, 0); __builtin_amdgcn_s_setprio(0); } while (0)
#define PG8_WAIT_V(n) asm volatile("s_waitcnt vmcnt(" #n ")" ::: "memory")
#define PG8_WAIT_L(n) asm volatile("s_waitcnt lgkmcnt(" #n ")" ::: "memory")
#define PG8_BAR __builtin_amdgcn_s_barrier()
#define PG8_SCHED __builtin_amdgcn_sched_barrier(0)
    Unit cur, nxt; int ui = 0;
    if (!S.next(0, cur)) return;
    f32x4 acc[2][2][4][2];
#pragma unroll
    for (int a = 0; a < 2; ++a)
#pragma unroll
        for (int b = 0; b < 2; ++b)
#pragma unroll
            for (int m = 0; m < 4; ++m)
#pragma unroll
                for (int n = 0; n < 2; ++n) acc[a][b][m][n] = (f32x4){0.f, 0.f, 0.f, 0.f};
    bf16x8 At[4][2], B0[2][2], B1[2][2];
    const char* cA = (const char*)g.A + (size_t)cur.pm * tsA; const char* cB = (const char*)g.Bt + (size_t)cur.pn * tsB;
    S.a_ready(cur);
    if constexpr (SP2) {
        PG8_STAGE(PG8_SB(0, 0), cB, voffB); PG8_STAGE(PG8_SB(0, 1), cB + hsB, voffB); PG8_STAGE(PG8_SA(0, 0), cA, voffA); PG8_STAGE(PG8_SA(0, 1), cA + hsA, voffA);
        if (wr == 1) PG8_BAR;
        PG8_WAIT_V(2); PG8_BAR;
        PG8_STAGE(PG8_SB(1, 0), cB + kstep, voffB); PG8_STAGE(PG8_SA(1, 0), cA + kstep, voffA); PG8_STAGE(PG8_SB(1, 1), cB + hsB + kstep, voffB);
        PG8_WAIT_V(6); PG8_BAR;
    } else {
        PG8_STAGE(PG8_SB(0, 0), cB, voffB); PG8_STAGE(PG8_SA(0, 0), cA, voffA); PG8_STAGE(PG8_SB(0, 1), cB + hsB, voffB); PG8_STAGE(PG8_SA(0, 1), cA + hsA, voffA);
        if (wr == 1) PG8_BAR;
        PG8_WAIT_V(4); PG8_BAR;
        PG8_STAGE(PG8_SB(1, 0), cB + kstep, voffB); PG8_STAGE(PG8_SA(1, 0), cA + kstep, voffA); PG8_STAGE(PG8_SB(1, 1), cB + hsB + kstep, voffB);
        PG8_WAIT_V(6); PG8_BAR;
    }
    for (;;) {
        const bool has_next = S.next(ui + 1, nxt);
        const char* nA = has_next ? (const char*)g.A + (size_t)nxt.pm * tsA : cA; const char* nB = has_next ? (const char*)g.Bt + (size_t)nxt.pn * tsB : cB;
        for (int t = 0; t < nt; t += 2) {
            const bool last = (t == nt - 2);
            const char* a1 = cA + (size_t)(t + 1) * kstep;
            const char* a2 = last ? nA : cA + (size_t)(t + 2) * kstep; const char* b2 = last ? nB : cB + (size_t)(t + 2) * kstep;
            const char* a3 = a2 + kstep; const char* b3 = b2 + kstep;
            if (last && has_next) S.a_ready(nxt);
            if constexpr (SP2) {
            PG8_LDB(B0, 0, 0); PG8_LDB(B1, 0, 1); PG8_SCHED; PG8_LDA(At, 0, 0); PG8_STAGE(PG8_SA(1, 1), a1 + hsA, voffA);
            PG8_WAIT_V(8); PG8_WAIT_L(0); PG8_BAR; PG8_MMA(0, 0, At, B0); PG8_MMA(0, 1, At, B1); PG8_BAR; PG8_SCHED;
            PG8_LDA(At, 0, 1); PG8_STAGE(PG8_SB(0, 0), b2, voffB); PG8_STAGE(PG8_SB(0, 1), b2 + hsB, voffB); PG8_STAGE(PG8_SA(0, 0), a2, voffA);
            PG8_WAIT_V(8); PG8_WAIT_L(0); PG8_BAR; PG8_MMA(1, 0, At, B0); PG8_MMA(1, 1, At, B1); PG8_BAR; PG8_SCHED;
            PG8_LDB(B0, 1, 0); PG8_LDB(B1, 1, 1); PG8_SCHED; PG8_LDA(At, 1, 0); PG8_STAGE(PG8_SA(0, 1), a2 + hsA, voffA);
            PG8_WAIT_V(8); PG8_WAIT_L(0); PG8_BAR; PG8_MMA(0, 0, At, B0); PG8_MMA(0, 1, At, B1); PG8_BAR; PG8_SCHED;
            PG8_LDA(At, 1, 1); PG8_STAGE(PG8_SB(1, 0), b3, voffB); PG8_STAGE(PG8_SB(1, 1), b3 + hsB, voffB); PG8_STAGE(PG8_SA(1, 0), a3, voffA);
            PG8_WAIT_V(8); PG8_WAIT_L(0); PG8_BAR; PG8_MMA(1, 0, At, B0); PG8_MMA(1, 1, At, B1); PG8_BAR; PG8_SCHED;
            } else {
            PG8_LDB(B0, 0, 0); PG8_SCHED; PG8_LDA(At, 0, 0); PG8_STAGE(PG8_SA(1, 1), a1 + hsA, voffA);
            PG8_WAIT_L(8); PG8_BAR; PG8_WAIT_L(0); PG8_MMA(0, 0, At, B0); PG8_BAR; PG8_SCHED;
            PG8_LDB(B1, 0, 1); PG8_STAGE(PG8_SB(0, 0), b2, voffB);
            PG8_BAR; PG8_WAIT_L(0); PG8_MMA(0, 1, At, B1); PG8_BAR;
            PG8_LDA(At, 0, 1); PG8_STAGE(PG8_SA(0, 0), a2, voffA);
            PG8_BAR; PG8_WAIT_L(0); PG8_MMA(1, 0, At, B0); PG8_BAR; PG8_SCHED;
            PG8_STAGE(PG8_SB(0, 1), b2 + hsB, voffB);
            PG8_WAIT_V(6); PG8_BAR; PG8_MMA(1, 1, At, B1); PG8_BAR;
            PG8_LDB(B0, 1, 0); PG8_SCHED; PG8_LDA(At, 1, 0); PG8_STAGE(PG8_SA(0, 1), a2 + hsA, voffA);
            PG8_WAIT_L(8); PG8_BAR; PG8_WAIT_L(0); PG8_MMA(0, 0, At, B0); PG8_BAR; PG8_SCHED;
            PG8_LDB(B1, 1, 1); PG8_STAGE(PG8_SB(1, 0), b3, voffB);
            PG8_BAR; PG8_WAIT_L(0); PG8_MMA(0, 1, At, B1); PG8_BAR;
            PG8_LDA(At, 1, 1); PG8_STAGE(PG8_SA(1, 0), a3, voffA);
            PG8_BAR; PG8_WAIT_L(0); PG8_MMA(1, 0, At, B0); PG8_BAR; PG8_SCHED;
            PG8_STAGE(PG8_SB(1, 1), b3 + hsB, voffB);
            PG8_WAIT_V(6); PG8_BAR; PG8_MMA(1, 1, At, B1); PG8_BAR;
            }
        }
        if constexpr (ALIGN_EPI) { if (wr == 0) PG8_BAR; }
        if constexpr (!Epi::AFTER_DRAIN) { E(acc, cur, wr, wc, fr, fq); S.done(cur); }
        if (!has_next) break;
#pragma unroll
        for (int a = 0; a < 2; ++a)
#pragma unroll
            for (int b = 0; b < 2; ++b)
#pragma unroll
                for (int m = 0; m < 4; ++m)
#pragma unroll
                    for (int n = 0; n < 2; ++n) acc[a][b][m][n] = (f32x4){0.f, 0.f, 0.f, 0.f};
        cur = nxt; cA = nA; cB = nB; ++ui;
        if constexpr (ALIGN_EPI) { if (wr == 1) PG8_BAR; }
    }
    PG8_WAIT_V(0);
    if constexpr (!ALIGN_EPI) { if (wr == 0) PG8_BAR; }
    PG8_BAR;
    if constexpr (Epi::AFTER_DRAIN) { E.fused(acc, cur, wr, wc, fr, fq, lds, wid, lane); S.done(cur); }
#undef PG8_SA
#undef PG8_SB
#undef PG8_STAGE
#undef PG8_LDA
#undef PG8_LDB
#undef PG8_MMA
#undef PG8_WAIT_V
#undef PG8_WAIT_L
#undef PG8_BAR
#undef PG8_SCHED
}
}
#define GAS __attribute__((address_space(1)))
#define LAS __attribute__((address_space(3)))
#define XB_TMO      128
#define XB_XCNT(j)  (256  + 64 * (j))
#define XB_XSUB(j)  (1280 + 64 * (j))
#define XB_XGEN(j)  (2304 + 64 * (j))
#define XB_TOP      3328
#define XB_TOPGEN   3392
#define XCD_BAR_WORDS 3456
#define XB_SPIN_CAP (1u << 25)
__device__ __forceinline__ unsigned xb_ld(unsigned* p)              { return __hip_atomic_load(p, __ATOMIC_RELAXED, __HIP_MEMORY_SCOPE_AGENT); }
__device__ __forceinline__ unsigned xb_add(unsigned* p, unsigned v) { return __hip_atomic_fetch_add(p, v, __ATOMIC_RELAXED, __HIP_MEMORY_SCOPE_AGENT); }
__device__ __forceinline__ unsigned xb_xcc_id() { return (unsigned)__builtin_amdgcn_s_getreg((3 << 11) | 20) & 0xFu; }
#define XB_SPIN(cond, bar) do { unsigned _sp = 0; while (cond) { __builtin_amdgcn_s_sleep(1); \
    if ((++_sp & 255u) == 0u) { if (xb_ld(&(bar)[XB_TMO])) break; if (_sp > XB_SPIN_CAP) { atomicAdd(&(bar)[XB_TMO], 1u); break; } } } } while (0)
struct XcdBarrier { unsigned* bar; unsigned x; volatile LAS unsigned* st; };
__device__ __forceinline__ XcdBarrier xcd_barrier_post(unsigned* bar, volatile LAS unsigned* st) {
    XcdBarrier b; b.bar = bar; b.x = xb_xcc_id(); b.st = st;
    if (threadIdx.x == 0) (void)xb_add(&bar[XB_XCNT(b.x)], 1u);
    return b;
}
__device__ __forceinline__ void xcd_barrier_complete(unsigned* bar, unsigned x, unsigned& nloc, unsigned& nx) {
    const unsigned G = gridDim.x * gridDim.y * gridDim.z;
    unsigned sum, cnt, mine, sp = 0u;
    for (;;) {
        sum = 0u; cnt = 0u; mine = 0u;
#pragma unroll
        for (unsigned j = 0; j < 16; ++j) { const unsigned c = xb_ld(&bar[XB_XCNT(j)]); sum += c; cnt += (c > 0u) ? 1u : 0u; mine = (j == x) ? c : mine; }
        if (sum == G) break;
        __builtin_amdgcn_s_sleep(1);
        if ((++sp & 255u) == 0u) { if (xb_ld(&bar[XB_TMO])) break; if (sp > XB_SPIN_CAP) { atomicAdd(&bar[XB_TMO], 1u); break; } }
    }
    nloc = mine > 0u ? mine : 1u; nx = cnt > 0u ? cnt : 1u;
}
__device__ __forceinline__ void xcd_barrier(const XcdBarrier& b) {
    asm volatile("s_waitcnt vmcnt(0)" ::: "memory");
    __syncthreads();
    if (threadIdx.x == 0) {
        unsigned* bar = b.bar;
        __builtin_amdgcn_s_waitcnt(0);
        unsigned nloc = b.st[0], nx = b.st[1];
        if (nloc == 0u) { xcd_barrier_complete(bar, b.x, nloc, nx); b.st[0] = nloc; b.st[1] = nx; }
        const unsigned old = xb_add(&bar[XB_XSUB(b.x)], 1u);
        const unsigned gen = old / nloc;
        if (old + 1u == (gen + 1u) * nloc) {
            __builtin_amdgcn_fence(__ATOMIC_RELEASE, "agent");
            asm volatile("s_waitcnt vmcnt(0)" ::: "memory");
            const unsigned og = xb_add(&bar[XB_TOP], 1u);
            const unsigned tg = og / nx;
            if (og + 1u == (tg + 1u) * nx) xb_add(&bar[XB_TOPGEN], 1u);
            else XB_SPIN(xb_ld(&bar[XB_TOPGEN]) == tg, bar);
            __builtin_amdgcn_fence(__ATOMIC_ACQUIRE, "agent");
            xb_add(&bar[XB_XGEN(b.x)], 1u);
            asm volatile("s_waitcnt vmcnt(0)" ::: "memory");
        } else {
            XB_SPIN(xb_ld(&bar[XB_XGEN(b.x)]) == gen, bar);
            __builtin_amdgcn_fence(__ATOMIC_ACQUIRE, "agent");
            asm volatile("s_waitcnt vmcnt(0)" ::: "memory");
        }
    }
    __syncthreads();
}
constexpr int NWAVES = 8, NTHR = 512;
constexpr int RING_BYTES = 131072, MISC_OFF = RING_BYTES + 320, LDS_BYTES = 147456;
struct Args { const void* in[34]; float* out; unsigned char* ws; int ph_lo, ph_hi; };
struct Ctx { LAS unsigned char* lds; int tid, lane, wave, G, bid, gw, ngw, gt, ngt; };
#define INF(i) ((const float*)a.in[i])
#define WSP(T_, off) ((T_*)(a.ws + (off)))

__device__ __forceinline__ void prep_tile(const float* W, int K, int N, bf16* WT, int Nout, int mapmode, int item, LAS float* tile, int t256) {
    const int nbn = Nout / 32, kb = item / nbn, nb = item % nbn, n0 = nb * 32, k0 = kb * 32, tx = t256 & 31, ty = t256 >> 5;
    for (int i = ty; i < 32; i += 8) {
        const int n = n0 + tx; int src = n;
        if (mapmode == 1) { if (n < 448) src = n; else if (n < 512) src = -1; else src = n - 64; }
        tile[i * 33 + tx] = (src >= 0 && src < N) ? W[(size_t)(k0 + i) * N + src] : 0.f;
    }
    __syncthreads();
    for (int i = ty; i < 32; i += 8) WT[(size_t)(n0 + i) * K + k0 + tx] = f2bf(tile[tx * 33 + i]);
    __syncthreads();
}
template <class ArgsRef> __device__ __forceinline__ void ph_prep(const ArgsRef& a, const Ctx& c) {
    const int sub = c.tid >> 8, t256 = c.tid & 255; LAS float* tile = (LAS float*)c.lds + sub * (32 * 33);
    constexpr int NT0 = 1280, NT1 = 192, NT2 = 128, NT3 = 64, NT4 = 1024, NT5 = 2048, NTL = NT0 + NT1 + NT2 + NT3 + NT4 + NT5, NTOT = NL * NTL;
    const int nsb = c.G * 2;
    for (int it0 = c.bid * 2; it0 < NTOT; it0 += nsb) {
        int it = it0 + sub; if (it >= NTOT) it = NTOT - 1;
        const int l = it / NTL; int r = it % NTL;
        if (r < NT0) prep_tile(INF(3) + (size_t)l * DM * 1216, DM, 1216, WSP(bf16, WS_WINT) + (size_t)l * ZW * DM, ZW, 1, r, tile, t256);
        else if ((r -= NT0) < NT1) prep_tile(INF(5) + (size_t)l * 256 * 768, 256, 768, WSP(bf16, WS_WUQT) + (size_t)l * 768 * 256, 768, 0, r, tile, t256);
        else if ((r -= NT1) < NT2) prep_tile(INF(7) + (size_t)l * 128 * 1024, 128, 1024, WSP(bf16, WS_WUKVT) + (size_t)l * 1024 * 128, 1024, 0, r, tile, t256);
        else if ((r -= NT2) < NT3) prep_tile(INF(18) + (size_t)l * 65536, 256, 256, WSP(bf16, WS_GLUT) + (size_t)l * 65536, 256, 0, r, tile, t256);
        else if ((r -= NT3) < NT4) prep_tile(INF(28) + (size_t)l * DM * DM, DM, DM, WSP(bf16, WS_WOUTT) + (size_t)l * DM * DM, DM, 0, r, tile, t256);
        else { r -= NT4; prep_tile(INF(30) + (size_t)l * DM * 2048, DM, 2048, WSP(bf16, WS_WQT) + (size_t)l * 2048 * DM, 2048, 0, r, tile, t256); }
    }
    for (int i = c.gt; i < NL * 65536; i += c.ngt) { const int l = i >> 16, e = i & 65535, r = e >> 8, cc = e & 255, pp = r >> 7, n = r & 127, p = cc >> 7, d = cc & 127;
        WSP(bf16, WS_SUBKT)[i] = (p == pp) ? f2bf(INF(31)[(size_t)l * 32768 + (pp * 128 + n) * 128 + d]) : (bf16)0; }
    { const size_t n4 = (size_t)NL * 16384 * DM / 4; const float4* u = (const float4*)a.in[32]; const float4* v = (const float4*)a.in[33]; uint2* pu = WSP(uint2, WS_PU); uint2* pv = WSP(uint2, WS_PV);
      for (size_t i = c.gt; i < n4; i += c.ngt) { const float4 x = u[i]; pu[i] = make_uint2(pk2(x.x, x.y), pk2(x.z, x.w)); const float4 y = v[i]; pv[i] = make_uint2(pk2(y.x, y.y), pk2(y.z, y.w)); } }
    for (int i = c.gt; i < T * 32; i += c.ngt) { const int t = i >> 5, j = i & 31;
        const float freq = exp2f(-(float)j * 0.41524101186092033f);
        const float ang = (float)((const int*)a.in[1])[t] * freq; float s, cs; sincos_acc(ang, s, cs);
        WSP(float, WS_COS)[i] = cs; WSP(float, WS_SIN)[i] = s; }
}

__device__ __forceinline__ void ph_rowprep(const Ctx& c, const float* x, const float* gain, bf16* XB) {
    for (int row = c.gw; row < T; row += c.ngw) {
        const float4* xr = (const float4*)(x + (size_t)row * DM) + c.lane;
        float4 v[4]; float ss = 0.f;
#pragma unroll
        for (int j = 0; j < 4; ++j) { v[j] = xr[64 * j]; ss += v[j].x * v[j].x + v[j].y * v[j].y + v[j].z * v[j].z + v[j].w * v[j].w; }
        const float rstd = rsqrtf(wave_sum(ss) * (1.f / DM) + EPS);
        uint2* o = (uint2*)(XB + (size_t)row * DM) + c.lane;
#pragma unroll
        for (int j = 0; j < 4; ++j) { const float4 g = ((const float4*)gain)[c.lane + 64 * j];
            o[64 * j] = make_uint2(pk2(v[j].x * rstd * g.x, v[j].y * rstd * g.y), pk2(v[j].z * rstd * g.z, v[j].w * rstd * g.w)); }
    }
}

enum { EPI_BF16 = 0, EPI_F32 = 1, EPI_GLU = 2, EPI_RESID = 3 };
template <int EPI> __device__ __forceinline__ void gemm_simple(const Ctx& c, const bf16* A, int lda, const bf16* Bt, int M, int N, int K, void* C, int ldc, const float* aux0, const bf16* aux1) {
    LAS float* As = (LAS float*)c.lds; LAS float* Bs = As + 16 * 132;
    const int tid = c.tid, tx = tid & 15, ty = tid >> 4, nN = N / 64, ntile = (M / 128) * nN;
    for (int tile = c.bid; tile < ntile; tile += c.G) {
        const int m0 = (tile / nN) * 128, n0 = (tile % nN) * 64;
        float acc[4][4];
#pragma unroll
        for (int i = 0; i < 4; ++i)
#pragma unroll
            for (int j = 0; j < 4; ++j) acc[i][j] = 0.f;
        const int lr = tid >> 2, lk = (tid & 3) * 4;
        for (int k0 = 0; k0 < K; k0 += 16) {
            { const uint2 w = *(const uint2*)(A + (size_t)(m0 + lr) * lda + k0 + lk);
              As[lk * 132 + lr] = __uint_as_float(w.x << 16); As[(lk + 1) * 132 + lr] = __uint_as_float(w.x & 0xffff0000u); As[(lk + 2) * 132 + lr] = __uint_as_float(w.y << 16); As[(lk + 3) * 132 + lr] = __uint_as_float(w.y & 0xffff0000u); }
            if (tid < 256) { const uint2 w = *(const uint2*)(Bt + (size_t)(n0 + lr) * K + k0 + lk);
              Bs[lk * 68 + lr] = __uint_as_float(w.x << 16); Bs[(lk + 1) * 68 + lr] = __uint_as_float(w.x & 0xffff0000u); Bs[(lk + 2) * 68 + lr] = __uint_as_float(w.y << 16); Bs[(lk + 3) * 68 + lr] = __uint_as_float(w.y & 0xffff0000u); }
            __syncthreads();
#pragma unroll
            for (int kk = 0; kk < 16; ++kk) {
                float av[4], bv[4];
#pragma unroll
                for (int i = 0; i < 4; ++i) { av[i] = As[kk * 132 + ty * 4 + i]; bv[i] = Bs[kk * 68 + tx * 4 + i]; }
#pragma unroll
                for (int i = 0; i < 4; ++i)
#pragma unroll
                    for (int j = 0; j < 4; ++j) acc[i][j] += av[i] * bv[j];
            }
            __syncthreads();
        }
#pragma unroll
        for (int i = 0; i < 4; ++i)
#pragma unroll
            for (int j = 0; j < 4; ++j) {
                const int row = m0 + ty * 4 + i, col = n0 + tx * 4 + j; const size_t ix = (size_t)row * ldc + col; const float v = acc[i][j];
                if (EPI == EPI_BF16) ((bf16*)C)[ix] = f2bf(v);
                else if (EPI == EPI_F32) ((float*)C)[ix] = v;
                else if (EPI == EPI_GLU) { const float yg = bf2f(aux1[ix]); ((bf16*)C)[ix] = f2bf(yg * sigmoid_f(v + aux0[col])); }
                else { ((float*)C)[ix] = aux0[ix] + v; }
            }
    }
}

__device__ __forceinline__ void ph_zstats(const Ctx& c, const bf16* Z, const float* qan, const float* kvan, bf16* CQN, bf16* CKVN) {
    for (int row = c.gw; row < T; row += c.ngw) {
        const bf16* zr = Z + (size_t)row * ZW; const int lane = c.lane;
        { const uint2 w = *(const uint2*)(zr + ZC_CQ + 4 * lane);
          float a0 = __uint_as_float(w.x << 16), a1 = __uint_as_float(w.x & 0xffff0000u), a2 = __uint_as_float(w.y << 16), a3 = __uint_as_float(w.y & 0xffff0000u);
          const float rstd = rsqrtf(wave_sum(a0 * a0 + a1 * a1 + a2 * a2 + a3 * a3) * (1.f / 256) + EPS);
          const float4 g = ((const float4*)qan)[lane];
          *(uint2*)(CQN + (size_t)row * 256 + 4 * lane) = make_uint2(pk2(a0 * rstd * g.x, a1 * rstd * g.y), pk2(a2 * rstd * g.z, a3 * rstd * g.w)); }
        { const u32 w = *(const u32*)(zr + ZC_CKV + 2 * lane);
          float a0 = __uint_as_float(w << 16), a1 = __uint_as_float(w & 0xffff0000u);
          const float rstd = rsqrtf(wave_sum(a0 * a0 + a1 * a1) * (1.f / 128) + EPS);
          const float2 g = ((const float2*)kvan)[lane];
          *(u32*)(CKVN + (size_t)row * 128 + 2 * lane) = pk2(a0 * rstd * g.x, a1 * rstd * g.y); }
    }
}

__device__ __forceinline__ void ph_qkfin(const Ctx& c, const bf16* QRAW, const bf16* KVRAW, const bf16* Z, const float* qn, const float* kn, const float* COS, const float* SIN, bf16* QB, bf16* KB, bf16* VB) {
    const int lane = c.lane;
    for (int w = c.gw; w < T * NH; w += c.ngw) {
        const int t = w >> 2, h = w & 3, b = t / SEQ, s = t % SEQ; const size_t bh = (size_t)b * NH + h;
        const float cs = COS[t * 32 + (lane & 31)], sn = SIN[t * 32 + (lane & 31)];
        {   const bf16* p = QRAW + (size_t)t * 768 + h * DQK;
            float v0 = bf2f(p[lane]), v1 = bf2f(p[lane + 64]), v2 = bf2f(p[lane + 128]);
            const float rstd = rsqrtf(wave_sum(v0 * v0 + v1 * v1 + v2 * v2) * (1.f / DQK) + EPS);
            v0 *= rstd * qn[lane]; v1 *= rstd * qn[lane + 64]; v2 *= rstd * qn[lane + 128];
            const float pr = __shfl_xor(v2, 32);
            const float r2 = (lane < 32) ? (v2 * cs - pr * sn) : (pr * sn + v2 * cs);
            bf16* o = QB + (bh * SEQ + s) * DQK;
            o[lane] = f2bf(v0 * QSCALE); o[lane + 64] = f2bf(v1 * QSCALE); o[lane + 128] = f2bf(r2 * QSCALE); }
        {   const bf16* p = KVRAW + (size_t)t * 1024 + h * 256;
            float v0 = bf2f(p[lane]), v1 = bf2f(p[lane + 64]), v2 = bf2f(Z[(size_t)t * ZW + ZC_KR + lane]);
            const float rstd = rsqrtf(wave_sum(v0 * v0 + v1 * v1 + v2 * v2) * (1.f / DQK) + EPS);
            v0 *= rstd * kn[lane]; v1 *= rstd * kn[lane + 64]; v2 *= rstd * kn[lane + 128];
            const float pr = __shfl_xor(v2, 32);
            const float r2 = (lane < 32) ? (v2 * cs - pr * sn) : (pr * sn + v2 * cs);
            bf16* o = KB + (bh * SEQ + s) * DQK;
            o[lane] = f2bf(v0); o[lane + 64] = f2bf(v1); o[lane + 128] = f2bf(r2);
            bf16* ov = VB + (bh * SEQ + s) * DV;
            ov[lane] = p[128 + lane]; ov[lane + 64] = p[192 + lane]; }
    }
}

__device__ __forceinline__ void ph_attn_simple(const Ctx& c, const bf16* QB, const bf16* KB, const bf16* VB, bf16* AO) {
    LAS float* qs = (LAS float*)c.lds + c.wave * DQK; const int lane = c.lane;
    for (int gq = c.gw; gq < NB * NH * SEQ; gq += c.ngw) {
        const int bh = gq / SEQ, q = gq % SEQ;
        const bf16* qp = QB + ((size_t)bh * SEQ + q) * DQK;
        qs[lane] = bf2f(qp[lane]); qs[lane + 64] = bf2f(qp[lane + 64]); qs[lane + 128] = bf2f(qp[lane + 128]);
        asm volatile("s_waitcnt lgkmcnt(0)" ::: "memory");
        float m = -1e30f, l = 0.f, o0 = 0.f, o1 = 0.f;
        const int ntile = q / 64 + 1;
        for (int kt = 0; kt < ntile; ++kt) {
            const int key = kt * 64 + lane;
            const uint4* kp = (const uint4*)(KB + ((size_t)bh * SEQ + key) * DQK);
            float sc = 0.f;
#pragma unroll 4
            for (int cc = 0; cc < 24; ++cc) { float kv[8]; unpack8(kp[cc], kv);
#pragma unroll
                for (int e = 0; e < 8; ++e) sc += kv[e] * qs[cc * 8 + e]; }
            if (key > q) sc = -INFINITY;
            const float mn = fmaxf(m, wave_max(sc));
            const float p = exp2f(sc - mn), al = exp2f(m - mn);
            l = l * al + wave_sum(p); o0 *= al; o1 *= al; m = mn;
            const u32* vp = (const u32*)(VB + ((size_t)bh * SEQ + kt * 64) * DV) + lane;
#pragma unroll 8
            for (int k = 0; k < 64; ++k) { const float pk = __shfl(p, k); const u32 w = vp[(size_t)k * (DV / 2)];
                o0 += pk * __uint_as_float(w << 16); o1 += pk * __uint_as_float(w & 0xffff0000u); }
        }
        const int b = bh / NH, h = bh % NH; const float il = 1.f / l;
        *(u32*)(AO + ((size_t)b * SEQ + q) * 512 + h * DV + 2 * lane) = pk2(o0 * il, o1 * il);
    }
}

__device__ __forceinline__ void ph_s5_simple(const Ctx& c, const bf16* Z, const float* a_re, const float* a_im, const float* log_dt, const float* b_re, const float* b_im,
                                             const float* c_re, const float* c_im, const float* dsk, bf16* YG) {
    for (int item = c.gw; item < NB * 16; item += c.ngw) {
        const int b = item >> 4, g = item & 15, p = c.lane;
        const float are = a_re[g * 64 + p], aim = a_im[g * 64 + p], dt = expf(log_dt[g]);
        const float mag = expf(are * dt); float sn, cs; sincos_acc(aim * dt, sn, cs);
        const float lre = mag * cs, lim = mag * sn;
        const float xr = lre - 1.f, xi = lim, den = are * are + aim * aim;
        const float cr = (xr * are + xi * aim) / den, ci = (xi * are - xr * aim) / den;
        float Bre[16], Bim[16], Cre[16], Cim[16];
#pragma unroll
        for (int k = 0; k < 16; ++k) { const float br = b_re[(g * 64 + p) * 16 + k], bi = b_im[(g * 64 + p) * 16 + k];
            Bre[k] = cr * br - ci * bi; Bim[k] = cr * bi + ci * br; Cre[k] = c_re[(g * 16 + k) * 64 + p]; Cim[k] = c_im[(g * 16 + k) * 64 + p]; }
        const float D = (p < 16) ? dsk[g * 16 + p] : 0.f;
        float hre = 0.f, him = 0.f;
        for (int s = 0; s < SEQ; ++s) {
            const bf16* up = Z + (size_t)(b * SEQ + s) * ZW + ZC_U + g * 16;
            float u[16]; unpack8(*(const uint4*)up, u); unpack8(*(const uint4*)(up + 8), u + 8);
            float bre = 0.f, bim = 0.f;
#pragma unroll
            for (int k = 0; k < 16; ++k) { bre += Bre[k] * u[k]; bim += Bim[k] * u[k]; }
            const float nre = lre * hre - lim * him + bre, nim = lre * him + lim * hre + bim; hre = nre; him = nim;
            float my = 0.f;
#pragma unroll
            for (int k = 0; k < 16; ++k) { const float v = wave_sum(Cre[k] * hre - Cim[k] * him); if (p == k) my = v + D * u[k]; }
            if (p < 16) YG[(size_t)(b * SEQ + s) * 256 + g * 16 + p] = f2bf(gelu_f(my));
        }
    }
}

__device__ __forceinline__ void ph_lru_xc(const Ctx& c, const bf16* Z, const float* cw, const float* cb, float* XC) {
    for (int i = c.gt; i < T * 256; i += c.ngt) { const int t = i >> 8, ch = i & 255, s = t % SEQ;
        float acc = cb[ch];
#pragma unroll
        for (int j = 0; j < 4; ++j) { const int ss = s - 3 + j; if (ss >= 0) acc += cw[j * 256 + ch] * bf2f(Z[(size_t)(t - 3 + j) * ZW + ZC_X + ch]); }
        XC[i] = acc; }
}
__device__ __forceinline__ void ph_lru_gates(const Ctx& c, const float* XC, const float* wa, const float* ba, const float* wx, const float* bx, const float* lam, float* AA, float* BT) {
    for (int i = c.gt; i < T * 256; i += c.ngt) { const int t = i >> 8, ch = i & 255, h = ch >> 6, j = ch & 63;
        const float* xr = XC + (size_t)t * 256 + h * 64;
        float ra = ba[ch], rx = bx[ch];
        for (int k = 0; k < 64; ++k) { const float xv = xr[k]; ra += xv * wa[(h * 64 + k) * 64 + j]; rx += xv * wx[(h * 64 + k) * 64 + j]; }
        const float r = sigmoid_f(ra), ig = sigmoid_f(rx);
        const float lsg = -log1pf(expf(-lam[ch]));
        const float la = 8.f * r * lsg, av = expf(la);
        AA[i] = av; BT[i] = sqrtf(-expm1f(2.f * la)) * (ig * XC[i]); }
}
__device__ __forceinline__ void ph_lru_scan(const Ctx& c, const float* AA, const float* BT, const bf16* Z, bf16* ROUT) {
    for (int item = c.gw; item < NB * 4; item += c.ngw) {
        const int i = item * 64 + c.lane, b = i >> 8, ch = i & 255;
        float h = 0.f;
#pragma unroll 8
        for (int s = 0; s < SEQ; ++s) { const size_t t = (size_t)b * SEQ + s;
            h = AA[t * 256 + ch] * h + BT[t * 256 + ch];
            ROUT[t * 256 + ch] = f2bf(h * gelu_f(bf2f(Z[t * ZW + ZC_G + ch]))); }
    }
}

__device__ __forceinline__ void ph_mixnorm(const Ctx& c, const bf16* AO, const bf16* SOUT, const bf16* ROUT, const float* g, bf16* Y) {
    const int lane = c.lane;
    for (int row = c.gw; row < T; row += c.ngw) {
        {   float v[8]; unpack8(*(const uint4*)(AO + (size_t)row * 512 + 8 * lane), v);
            float ss = 0.f;
#pragma unroll
            for (int e = 0; e < 8; ++e) ss += v[e] * v[e];
            const float rstd = rsqrtf(wave_sum(ss) * (1.f / 512) + EPS); const float* gg = g + 8 * lane;
            *(uint4*)(Y + (size_t)row * DM + 8 * lane) = make_uint4(pk2(v[0] * rstd * gg[0], v[1] * rstd * gg[1]), pk2(v[2] * rstd * gg[2], v[3] * rstd * gg[3]),
                                                                    pk2(v[4] * rstd * gg[4], v[5] * rstd * gg[5]), pk2(v[6] * rstd * gg[6], v[7] * rstd * gg[7])); }
#pragma unroll
        for (int part = 0; part < 2; ++part) {
            const bf16* src = part == 0 ? SOUT : ROUT; const int off = 512 + 256 * part;
            const uint2 w = *(const uint2*)(src + (size_t)row * 256 + 4 * lane);
            float a0 = __uint_as_float(w.x << 16), a1 = __uint_as_float(w.x & 0xffff0000u), a2 = __uint_as_float(w.y << 16), a3 = __uint_as_float(w.y & 0xffff0000u);
            const float rstd = rsqrtf(wave_sum(a0 * a0 + a1 * a1 + a2 * a2 + a3 * a3) * (1.f / 256) + EPS); const float* gg = g + off + 4 * lane;
            *(uint2*)(Y + (size_t)row * DM + off + 4 * lane) = make_uint2(pk2(a0 * rstd * gg[0], a1 * rstd * gg[1]), pk2(a2 * rstd * gg[2], a3 * rstd * gg[3]));
        }
    }
}

__device__ __forceinline__ void ph_topk_a(const Ctx& c, const float* SC, float* STOP, int* ITOP) {
    for (int i = c.gt; i < T * 16; i += c.ngt) {
        const float* sc = SC + (size_t)i * 128;
        float pv = INFINITY; int pn = -1;
        for (int it = 0; it < 16; ++it) {
            float bv = -INFINITY; int bn = 1 << 30;
            for (int n = 0; n < 128; ++n) { const float v = sc[n];
                const bool elig = (v < pv) || (v == pv && n > pn);
                if (elig && (v > bv || (v == bv && n < bn))) { bv = v; bn = n; } }
            STOP[(size_t)i * 16 + it] = bv; ITOP[(size_t)i * 16 + it] = bn; pv = bv; pn = bn;
        }
    }
}
__device__ __forceinline__ void ph_topk_b(const Ctx& c, const float* STOP, const int* ITOP, int* IDX, float* GATE) {
    LAS float* my = (LAS float*)c.lds + c.tid * 33;
    for (int i = c.gt; i < T * 8; i += c.ngt) {
        for (int k = 0; k < 32; ++k) my[k] = STOP[(size_t)i * 32 + k];
        float pv = INFINITY; int pn = -1; float best0 = 0.f, den = 0.f;
        float ev[16];
#pragma unroll
        for (int it = 0; it < 16; ++it) {
            float bv = -INFINITY; int bn = 1 << 30;
            for (int f = 0; f < 256; ++f) { const float v = my[f >> 4] + my[16 + (f & 15)];
                const bool elig = (v < pv) || (v == pv && f > pn);
                if (elig && (v > bv || (v == bv && f < bn))) { bv = v; bn = f; } }
            pv = bv; pn = bn;
            if (it == 0) best0 = bv;
            ev[it] = expf(bv - best0); den += ev[it];
            IDX[(size_t)i * 16 + it] = ITOP[(size_t)i * 32 + (bn >> 4)] * 128 + ITOP[(size_t)i * 32 + 16 + (bn & 15)];
        }
#pragma unroll
        for (int it = 0; it < 16; ++it) GATE[(size_t)i * 16 + it] = ev[it] / den;
    }
}

__device__ __forceinline__ void ph_gather(const Ctx& c, const bf16* HN, const int* IDX, const float* GATE, const bf16* PU, const bf16* PV, float* X) {
    const int lane = c.lane;
    for (int t = c.gw; t < T; t += c.ngw) {
        float hn[16]; unpack8(*(const uint4*)(HN + (size_t)t * DM + 8 * lane), hn); unpack8(*(const uint4*)(HN + (size_t)t * DM + 512 + 8 * lane), hn + 8);
        float y[16];
#pragma unroll
        for (int e = 0; e < 16; ++e) y[e] = 0.f;
        for (int k = 0; k < 128; ++k) {
            const int e = IDX[(size_t)t * 128 + k]; const float gt = GATE[(size_t)t * 128 + k];
            const bf16* ur = PU + (size_t)e * DM; const bf16* vr = PV + (size_t)e * DM;
            float u[16]; unpack8(*(const uint4*)(ur + 8 * lane), u); unpack8(*(const uint4*)(ur + 512 + 8 * lane), u + 8);
            float d = 0.f;
#pragma unroll
            for (int q = 0; q < 16; ++q) d += u[q] * hn[q];
            d = wave_sum(d);
            const float w = gt * gelu_f(d);
            float v[16]; unpack8(*(const uint4*)(vr + 8 * lane), v); unpack8(*(const uint4*)(vr + 512 + 8 * lane), v + 8);
#pragma unroll
            for (int q = 0; q < 16; ++q) y[q] += w * v[q];
        }
        float4* xo = (float4*)(X + (size_t)t * DM + 8 * lane);
        float4 p0 = xo[0], p1 = xo[1]; p0.x += y[0]; p0.y += y[1]; p0.z += y[2]; p0.w += y[3]; p1.x += y[4]; p1.y += y[5]; p1.z += y[6]; p1.w += y[7]; xo[0] = p0; xo[1] = p1;
        xo = (float4*)(X + (size_t)t * DM + 512 + 8 * lane);
        p0 = xo[0]; p1 = xo[1]; p0.x += y[8]; p0.y += y[9]; p0.z += y[10]; p0.w += y[11]; p1.x += y[12]; p1.y += y[13]; p1.z += y[14]; p1.w += y[15]; xo[0] = p0; xo[1] = p1;
    }
}
#ifndef MK_SIMPLE_GEMM
#define MK_SIMPLE_GEMM 0
#endif
constexpr int NPH_LAYER = 16, NPH = 1 + NL * NPH_LAYER;
struct GD { const bf16* A; const bf16* Bt; void* C; const float* aux0; const bf16* aux1; int lda, M, N, K, ldc, kind; };
template <class Epi> __device__ __forceinline__ void run_gemm(const Ctx& c, const bf16* A, int lda, const bf16* Bt, int M, int N, int K, const Epi& E) {
    pg8::Gemm g{A, Bt, M, N, K, lda}; pg8::StaticOrder S; S.init(M, N, c.G, c.bid);
    pg8::gemm_phase<Epi, pg8::StaticOrder, true, true>(c.lds, g, S, E);
}
#define AS4 __attribute__((address_space(4)))
__global__ void __launch_bounds__(NTHR, 2) mega(Args a_) {
    extern __shared__ __attribute__((aligned(16))) unsigned char lds_raw[];
    {   const int t0 = threadIdx.x;
        for (int u = t0; u < (LDS_BYTES - RING_BYTES) / 4; u += NTHR) ((LAS unsigned*)((LAS unsigned char*)lds_raw + RING_BYTES))[u] = 0u; }
    __syncthreads();
    volatile LAS unsigned* MISC = (volatile LAS unsigned*)((LAS unsigned char*)lds_raw + MISC_OFF);
    XcdBarrier bar; bar.bar = (unsigned*)(a_.ws + WS_CTL) + CW_BAR; bar.x = 0; bar.st = MISC + 8;
    const int ph_lo = a_.ph_lo, ph_hi = a_.ph_hi;
    if (ph_hi - ph_lo > 1) bar = xcd_barrier_post((unsigned*)(a_.ws + WS_CTL) + CW_BAR, MISC + 8);

    int p = ph_lo;
    if (p == 0) {
        const Args AS4* ap0 = (const Args AS4*)__builtin_amdgcn_kernarg_segment_ptr(); Ctx c0; c0.lds = (LAS unsigned char*)lds_raw; c0.tid = threadIdx.x; c0.lane = c0.tid & 63; c0.wave = __builtin_amdgcn_readfirstlane(c0.tid >> 6);
        c0.G = gridDim.x; c0.bid = blockIdx.x; c0.gw = c0.wave * c0.G + c0.bid; c0.ngw = NWAVES * c0.G; c0.gt = c0.bid * NTHR + c0.tid; c0.ngt = c0.G * NTHR;
        ph_prep(*ap0, c0);
        if (p + 1 < ph_hi) xcd_barrier(bar);
        p = 1;
    }
    for (; p < ph_hi; ++p) {
        const Args AS4* ap = (const Args AS4*)__builtin_amdgcn_kernarg_segment_ptr(); asm volatile("" : "+s"(ap));
        int tid_ = threadIdx.x; asm volatile("" : "+v"(tid_));
#define a (*ap)
        Ctx c; c.lds = (LAS unsigned char*)lds_raw; c.tid = tid_; c.lane = c.tid & 63; c.wave = __builtin_amdgcn_readfirstlane(c.tid >> 6);
        { int G_ = gridDim.x, bid_ = blockIdx.x; asm volatile("" : "+s"(G_), "+s"(bid_)); c.G = G_; c.bid = bid_; }
        c.gw = c.wave * c.G + c.bid; c.ngw = NWAVES * c.G; c.gt = c.bid * NTHR + c.tid; c.ngt = c.G * NTHR;
        bf16 *WINT = WSP(bf16, WS_WINT), *WUQT = WSP(bf16, WS_WUQT), *WUKVT = WSP(bf16, WS_WUKVT), *GLUT = WSP(bf16, WS_GLUT), *WOUTT = WSP(bf16, WS_WOUTT),
             *WQT = WSP(bf16, WS_WQT), *SUBKT = WSP(bf16, WS_SUBKT), *PU = WSP(bf16, WS_PU), *PV = WSP(bf16, WS_PV);
        float *COS = WSP(float, WS_COS), *SIN = WSP(float, WS_SIN);
        bf16 *XB = WSP(bf16, WS_XB), *Z = WSP(bf16, WS_Z), *QRAW = WSP(bf16, WS_QRAW), *KVRAW = WSP(bf16, WS_KVRAW), *QB = WSP(bf16, WS_QB), *KB = WSP(bf16, WS_KB),
             *VB = WSP(bf16, WS_VB), *CQN = WSP(bf16, WS_CQN), *CKVN = WSP(bf16, WS_CKVN), *AO = WSP(bf16, WS_AO), *ROUT = WSP(bf16, WS_ROUT), *Y = WSP(bf16, WS_Y),
             *YG = WSP(bf16, WS_YG), *SOUT = WSP(bf16, WS_SOUT), *QP = WSP(bf16, WS_QP);
        float *XC = WSP(float, WS_XC), *AA = WSP(float, WS_AA), *BT = WSP(float, WS_BT), *SC = WSP(float, WS_SC), *STOP = WSP(float, WS_STOP), *GATE = WSP(float, WS_GATE);
        int *ITOP = WSP(int, WS_ITOP), *IDX = WSP(int, WS_IDX);
        float* out = a.out;
        {
            const int l = (p - 1) / NPH_LAYER, k = (p - 1) % NPH_LAYER;
            const float* xin = (l == 0) ? INF(0) : out;
            GD gd; gd.kind = 0; gd.A = nullptr; gd.Bt = nullptr; gd.C = nullptr; gd.aux0 = nullptr; gd.aux1 = nullptr; gd.lda = 0; gd.M = T; gd.N = 0; gd.K = 0; gd.ldc = 0;
#define SETG(kind_, A_, lda_, Bt_, M_, N_, K_, C_, ldc_, aux0_, aux1_) do { gd.kind = kind_; gd.A = A_; gd.lda = lda_; gd.Bt = Bt_; gd.M = M_; gd.N = N_; gd.K = K_; gd.C = (void*)(C_); gd.ldc = ldc_; gd.aux0 = aux0_; gd.aux1 = aux1_; } while (0)
            switch (k) {
            case 0: ph_rowprep(c, xin, INF(2) + l * DM, XB); break;
            case 1: SETG(1, XB, DM, WINT + (size_t)l * ZW * DM, T, ZW, DM, Z, ZW, nullptr, nullptr); break;
            case 2: ph_zstats(c, Z, INF(4) + l * 256, INF(6) + l * 128, CQN, CKVN); ph_lru_xc(c, Z, INF(20) + l * 1024, INF(21) + l * 256, XC); break;
            case 3: SETG(1, CQN, 256, WUQT + (size_t)l * 768 * 256, T, 768, 256, QRAW, 768, nullptr, nullptr); break;
            case 4: SETG(1, CKVN, 128, WUKVT + (size_t)l * 1024 * 128, T, 1024, 128, KVRAW, 1024, nullptr, nullptr);
                    ph_lru_gates(c, XC, INF(22) + l * 16384, INF(23) + l * 256, INF(24) + l * 16384, INF(25) + l * 256, INF(26) + l * 256, AA, BT); break;
            case 5: ph_qkfin(c, QRAW, KVRAW, Z, INF(8) + l * DQK, INF(9) + l * DQK, COS, SIN, QB, KB, VB); break;
            case 6:
                ph_s5_simple(c, Z, INF(10) + l * 1024, INF(11) + l * 1024, INF(12) + l * 16, INF(13) + l * 16384, INF(14) + l * 16384, INF(15) + l * 16384, INF(16) + l * 16384, INF(17) + l * 256, YG);
                ph_lru_scan(c, AA, BT, Z, ROUT);
                ph_attn_simple(c, QB, KB, VB, AO);
                break;
            case 7: SETG(3, YG, 256, GLUT + (size_t)l * 65536, T, 256, 256, SOUT, 256, INF(19) + l * 256, YG); break;
            case 8: ph_mixnorm(c, AO, SOUT, ROUT, INF(27) + l * DM, Y); break;
            case 9: SETG(2, Y, DM, WOUTT + (size_t)l * DM * DM, T, DM, DM, out, DM, xin, nullptr); break;
            case 10: ph_rowprep(c, out, INF(29) + l * DM, XB); break;
            case 11: SETG(1, XB, DM, WQT + (size_t)l * 2048 * DM, T, 2048, DM, QP, 2048, nullptr, nullptr); break;
            case 12: SETG(2, QP, 256, SUBKT + (size_t)l * 65536, T * 8, 256, 256, SC, 256, nullptr, nullptr); break;
            case 13: ph_topk_a(c, SC, STOP, ITOP); break;
            case 14: ph_topk_b(c, STOP, ITOP, IDX, GATE); break;
            default: ph_gather(c, XB, IDX, GATE, PU + (size_t)l * 16384 * DM, PV + (size_t)l * 16384 * DM, out); break;
            }
#undef SETG
#if MK_SIMPLE_GEMM
            if (gd.kind == 1) gemm_simple<EPI_BF16>(c, gd.A, gd.lda, gd.Bt, gd.M, gd.N, gd.K, gd.C, gd.ldc, nullptr, nullptr);
            else if (gd.kind == 2) { if (gd.aux0) gemm_simple<EPI_RESID>(c, gd.A, gd.lda, gd.Bt, gd.M, gd.N, gd.K, gd.C, gd.ldc, gd.aux0, nullptr); else gemm_simple<EPI_F32>(c, gd.A, gd.lda, gd.Bt, gd.M, gd.N, gd.K, gd.C, gd.ldc, nullptr, nullptr); }
            else if (gd.kind == 3) gemm_simple<EPI_GLU>(c, gd.A, gd.lda, gd.Bt, gd.M, gd.N, gd.K, gd.C, gd.ldc, gd.aux0, gd.aux1);
#else
            if (gd.kind == 1) run_gemm(c, gd.A, gd.lda, gd.Bt, gd.M, gd.N, gd.K, pg8::EpiBf16<0>{(bf16*)gd.C, gd.ldc, nullptr, 0, 0, 1.f});
            else if (gd.kind == 2) run_gemm(c, gd.A, gd.lda, gd.Bt, gd.M, gd.N, gd.K, pg8::EpiF32{(float*)gd.C, gd.ldc, gd.aux0});
            else if (gd.kind == 3) run_gemm(c, gd.A, gd.lda, gd.Bt, gd.M, gd.N, gd.K, pg8::EpiGlu{(bf16*)gd.C, gd.ldc, gd.aux0, gd.aux1});
#endif
        }
        if (p + 1 < ph_hi) { XcdBarrier b2 = bar; unsigned* bb = (unsigned*)(a.ws + WS_CTL) + CW_BAR; unsigned bx = bar.x; asm volatile("" : "+s"(bb), "+s"(bx)); b2.bar = bb; b2.x = bx; xcd_barrier(b2); }
#undef a
    }
}

extern "C" void kernel_launch(void* const* d_in, const int* in_sizes, int n_in, void* d_out, int out_size, void* d_ws, size_t ws_size, hipStream_t stream) {
    static int grid = 0;
    if (grid == 0) {
        if (n_in != 34 || out_size != T * DM || ws_size < WS_END) { fprintf(stderr, "kernel_launch: unexpected shapes (n_in %d out %d ws %zu)\n", n_in, out_size, ws_size); grid = -1; return; }
        int dev = 0, cus = 0, per_cu = 0;
        if (hipGetDevice(&dev) != hipSuccess || hipDeviceGetAttribute(&cus, hipDeviceAttributeMultiprocessorCount, dev) != hipSuccess) { grid = -1; return; }
        if (hipFuncSetAttribute((const void*)mega, hipFuncAttributeMaxDynamicSharedMemorySize, LDS_BYTES) != hipSuccess) { fprintf(stderr, "kernel_launch: hipFuncSetAttribute failed\n"); grid = -1; return; }
        if (hipOccupancyMaxActiveBlocksPerMultiprocessor(&per_cu, (const void*)mega, NTHR, LDS_BYTES) != hipSuccess || per_cu < 1) { fprintf(stderr, "kernel_launch: occupancy query says %d blocks per CU\n", per_cu); }
        (void)hipGetLastError();
        grid = cus;
    }
    if (grid < 0) return;
    (void)hipMemsetAsync((char*)d_ws + WS_CTL, 0, CTL_ZERO_BYTES, stream);
    Args a{};
    for (int i = 0; i < 34; ++i) a.in[i] = d_in[i];
    a.out = (float*)d_out; a.ws = (unsigned char*)d_ws;
#if MK_PER_PHASE
    for (int p = 0; p < NPH; ++p) { a.ph_lo = p; a.ph_hi = p + 1; hipLaunchKernelGGL(mega, dim3(grid), dim3(NTHR), LDS_BYTES, stream, a); }
#else
    a.ph_lo = 0; a.ph_hi = NPH;
    hipLaunchKernelGGL(mega, dim3(grid), dim3(NTHR), LDS_BYTES, stream, a);
#endif
}
```

```cpp
#include <hip/hip_runtime.h>
#include <cstdint>
#include <cstdio>

#ifndef MK_PER_PHASE
#define MK_PER_PHASE 0
#endif

typedef unsigned short bf16;
typedef unsigned int u32;

constexpr int NB = 2, SEQ = 8192, T = NB * SEQ, DM = 1024, NL = 2;
constexpr int ZW = 1280;
constexpr int ZC_CQ = 0, ZC_CKV = 256, ZC_KR = 384, ZC_U = 512, ZC_X = 768, ZC_G = 1024;
constexpr int NH = 4, DQK = 192, DV = 128;
constexpr float EPS = 1e-6f;
constexpr float QSCALE = 0.07216878364870322f * 1.4426950408889634f;

constexpr size_t MiB = 1u << 20;
constexpr size_t WS_CTL = 0, CTL_ZERO_BYTES = 1 * MiB, WS_WINT = 1 * MiB, WS_WUQT = 7 * MiB, WS_WUKVT = 8 * MiB, WS_GLUT = 9 * MiB, WS_WOUTT = 10 * MiB,
                 WS_WQT = 14 * MiB, WS_SUBKT = 22 * MiB, WS_COS = 23 * MiB, WS_SIN = 25 * MiB, WS_PU = 28 * MiB, WS_PV = 92 * MiB,
                 WS_XB = 156 * MiB, WS_Z = 188 * MiB, WS_RA = 228 * MiB, WS_RB = 356 * MiB, WS_CKVN = 420 * MiB, WS_AO = 424 * MiB,
                 WS_ROUT = 440 * MiB, WS_Y = 448 * MiB, WS_IDX = 480 * MiB, WS_GATE = 488 * MiB, WS_END = 496 * MiB;
constexpr size_t WS_QRAW = WS_RA, WS_KVRAW = WS_RA + 24 * MiB, WS_QB = WS_RA + 56 * MiB, WS_KB = WS_RA + 80 * MiB, WS_VB = WS_RA + 104 * MiB,
                 WS_CQN = WS_RA + 120 * MiB, WS_SC = WS_RA;
constexpr size_t WS_XC = WS_RB, WS_AA = WS_RB + 16 * MiB, WS_BT = WS_RB + 32 * MiB, WS_YG = WS_RB + 48 * MiB, WS_SOUT = WS_RB + 56 * MiB, WS_QP = WS_RB;
constexpr size_t WS_STOP = WS_Z, WS_ITOP = WS_Z + 16 * MiB;
constexpr int CW_BAR = 4096;

__device__ __forceinline__ float bf2f(bf16 h) { return __uint_as_float((u32)h << 16); }
__device__ __forceinline__ bf16 f2bf(float f) { u32 u = __float_as_uint(f); return (bf16)((u + 0x7fffu + ((u >> 16) & 1u)) >> 16); }
__device__ __forceinline__ u32 pk2(float lo, float hi) { return (u32)f2bf(lo) | ((u32)f2bf(hi) << 16); }
__device__ __forceinline__ float wave_sum(float v) {
#pragma unroll
    for (int o = 32; o > 0; o >>= 1) v += __shfl_xor(v, o);
    return v;
}
__device__ __forceinline__ float wave_max(float v) {
#pragma unroll
    for (int o = 32; o > 0; o >>= 1) v = fmaxf(v, __shfl_xor(v, o));
    return v;
}
__device__ __forceinline__ float gelu_f(float x) { return 0.5f * x * (1.f + erff(x * 0.70710678118654752f)); }
__device__ __forceinline__ float sigmoid_f(float x) { return 1.f / (1.f + __expf(-x)); }
__device__ __forceinline__ void unpack8(uint4 w, float* o) {
    o[0] = __uint_as_float(w.x << 16); o[1] = __uint_as_float(w.x & 0xffff0000u);
    o[2] = __uint_as_float(w.y << 16); o[3] = __uint_as_float(w.y & 0xffff0000u);
    o[4] = __uint_as_float(w.z << 16); o[5] = __uint_as_float(w.z & 0xffff0000u);
    o[6] = __uint_as_float(w.w << 16); o[7] = __uint_as_float(w.w & 0xffff0000u);
}
__device__ __forceinline__ void sincos_acc(float x, float& s, float& c) {
    const float k = rintf(x * 0.15915494309189535f);
    float r = fmaf(-k, 6.28125f, x);
    r = fmaf(-k, 1.9350051879882812e-3f, r);
    r = fmaf(-k, 3.0199160335e-7f, r);
    const float f = r * 0.15915494309189535f;
    s = __builtin_amdgcn_sinf(f); c = __builtin_amdgcn_cosf(f);
}
namespace pg8 {
#define PG8_LAS __attribute__((address_space(3)))
typedef unsigned short bf16_t;
typedef short bf16x8 __attribute__((ext_vector_type(8)));
typedef float f32x4 __attribute__((ext_vector_type(4)));
typedef unsigned u32x4 __attribute__((ext_vector_type(4)));
constexpr int BM = 256, BK = 64, HALF = 128, HTB = HALF * BK * 2  , STAGE_BYTES = 8 * HTB, NXCD = 8, WGM = 8;

__host__ __device__ __forceinline__ int lds_byte(int r, int c) { const int st = (r >> 4) * 2 + (c >> 5), rr = r & 15, cc = c & 31, ob = rr * 64 + cc * 2; return st * 1024 + (ob ^ (((ob >> 9) & 1) << 5)); }
__host__ __device__ __forceinline__ void stage_rc(int b, int& R, int& C) { const int st = b / 1024, sb = b % 1024, swz = sb ^ (((sb >> 9) & 1) << 5); R = (st >> 1) * 16 + swz / 64; C = (st & 1) * 32 + (swz % 64) / 2; }
__host__ __device__ __forceinline__ int perm32(int rho) { const int n = rho >> 4, i = rho & 15; return 8 * (i >> 2) + 4 * n + (i & 3); }

struct Unit { int pm, pn; };
struct Gemm { const bf16_t* A; const bf16_t* Bt; int M, N, K, lda; };

struct StaticOrder {
    int nM, nN, nwg, G, c;
    __host__ __device__ void init(int M, int N, int G_, int c_) { nM = M / BM; nN = N / BM; nwg = nM * nN; G = G_; c = c_; }
    __host__ __device__ bool next(int i, Unit& u) const {
        const long L = (long)i * G + c; if (L >= nwg) return false;
        int wgid = (int)L; { const int q = nwg / NXCD, r = nwg % NXCD, xcd = wgid % NXCD, off = wgid / NXCD; wgid = (xcd < r ? xcd * (q + 1) : r * (q + 1) + (xcd - r) * q) + off; }
        const int nig = WGM * nN, gid = wgid / nig, fm = gid * WGM, gsz = (nM - fm) < WGM ? (nM - fm) : WGM;
        u.pm = fm + ((wgid % nig) % gsz); u.pn = (wgid % nig) / gsz; return true;
    }
    __device__ __forceinline__ void a_ready(const Unit&) const {}
    __device__ __forceinline__ void done(const Unit&) const {}
};

__device__ __forceinline__ unsigned cvt_pk_bf16(float lo, float hi) { unsigned r; asm volatile("v_cvt_pk_bf16_f32 %0, %1, %2" : "=v"(r) : "v"(lo), "v"(hi)); return r; }
typedef float f32x2 __attribute__((ext_vector_type(2)));
__device__ __forceinline__ f32x2 gelu_pk(f32x2 v) {
    const f32x2 av = __builtin_elementwise_abs(v), d = av * 0.2316418882f + 1.0f;
    f32x2 t; t.x = __builtin_amdgcn_rcpf(d.x); t.y = __builtin_amdgcn_rcpf(d.y);
    f32x2 q = t * 0.5307027145f + (-0.7265760135f); q = q * t + 0.7107068705f; q = q * t + (-0.142248368f); q = q * t + 0.127414796f; q = q * t;
    const f32x2 s = (v * v) * (-0.72134752044f);
    f32x2 e; e.x = __builtin_amdgcn_exp2f(s.x); e.y = __builtin_amdgcn_exp2f(s.y);
    const f32x2 m = v * (q * e), r = v - m;
    f32x2 o; o.x = v.x < 0.f ? m.x : r.x; o.y = v.y < 0.f ? m.y : r.y; return o;
}

template <int ACT  > struct EpiBf16 {
    static constexpr bool PERM = true, AFTER_DRAIN = false; static_assert(ACT == 0 || ACT == 1, "EpiBf16: ACT is 0 (none) or 1 (gelu_pk)");
    bf16_t* O; int ldc; const float* bias; int split_cols; size_t split_stride; float scale0;
    __device__ __forceinline__ void operator()(const f32x4 (&acc)[2][2][4][2], const Unit& u, int wr, int wc, int fr, int fq) const {
        const int row0 = u.pm * BM + wr * 64 + fr; int colt = u.pn * BM; bf16_t* base = O;
        float sc = 1.f; if (split_cols) { const int t = colt / split_cols; base += (size_t)t * split_stride; colt -= t * split_cols; if (t == 0) sc = scale0; }
        const int col0 = colt + wc * 32 + 8 * fq, bcol0 = u.pn * BM + wc * 32 + 8 * fq;
        f32x4 bv[2][2];
#pragma unroll
        for (int bj = 0; bj < 2; ++bj)
#pragma unroll
            for (int n = 0; n < 2; ++n) bv[bj][n] = bias ? *(const f32x4*)(bias + bcol0 + bj * HALF + 4 * n) : (f32x4){0.f, 0.f, 0.f, 0.f};
#pragma unroll
        for (int ai = 0; ai < 2; ++ai)
#pragma unroll
            for (int m = 0; m < 4; ++m) { bf16_t* rowp = base + (size_t)(row0 + ai * HALF + m * 16) * ldc + col0;
#pragma unroll
                for (int bj = 0; bj < 2; ++bj) { f32x4 v0 = acc[ai][bj][m][0] + bv[bj][0], v1 = acc[ai][bj][m][1] + bv[bj][1];
                    if (ACT == 1) { f32x2 a = gelu_pk((f32x2){v0[0], v0[1]}), b = gelu_pk((f32x2){v0[2], v0[3]}), c = gelu_pk((f32x2){v1[0], v1[1]}), d = gelu_pk((f32x2){v1[2], v1[3]});
                        v0 = (f32x4){a.x, a.y, b.x, b.y}; v1 = (f32x4){c.x, c.y, d.x, d.y}; }
                    v0 = v0 * sc; v1 = v1 * sc; u32x4 w; w.x = cvt_pk_bf16(v0[0], v0[1]); w.y = cvt_pk_bf16(v0[2], v0[3]); w.z = cvt_pk_bf16(v1[0], v1[1]); w.w = cvt_pk_bf16(v1[2], v1[3]);
                    *(u32x4*)(rowp + bj * HALF) = w; } }
    }
};


struct EpiF32 {
    static constexpr bool PERM = false, AFTER_DRAIN = false;
    float* C; int ldc; const float* resid;
    __device__ __forceinline__ void operator()(const f32x4 (&acc)[2][2][4][2], const Unit& u, int wr, int wc, int fr, int fq) const {
        const int row0 = u.pm * BM + wr * 64 + fr, col0 = u.pn * BM + wc * 32 + 4 * fq;
#pragma unroll
        for (int ai = 0; ai < 2; ++ai)
#pragma unroll
            for (int m = 0; m < 4; ++m) { const size_t rb = (size_t)(row0 + ai * HALF + m * 16) * ldc + col0;
#pragma unroll
                for (int bj = 0; bj < 2; ++bj)
#pragma unroll
                    for (int n = 0; n < 2; ++n) { const size_t ix = rb + bj * HALF + n * 16; f32x4 v = acc[ai][bj][m][n];
                        if (resid) v += *(const f32x4*)(resid + ix);
                        *(f32x4*)(C + ix) = v; } }
    }
};
struct EpiGlu {
    static constexpr bool PERM = true, AFTER_DRAIN = false;
    bf16_t* O; int ldc; const float* bias; const bf16_t* YG;
    __device__ __forceinline__ void operator()(const f32x4 (&acc)[2][2][4][2], const Unit& u, int wr, int wc, int fr, int fq) const {
        const int row0 = u.pm * BM + wr * 64 + fr, col0 = u.pn * BM + wc * 32 + 8 * fq;
#pragma unroll
        for (int ai = 0; ai < 2; ++ai)
#pragma unroll
            for (int m = 0; m < 4; ++m) { const size_t rb = (size_t)(row0 + ai * HALF + m * 16) * ldc + col0;
#pragma unroll
                for (int bj = 0; bj < 2; ++bj) { const size_t ix = rb + bj * HALF;
                    const f32x4 b0 = *(const f32x4*)(bias + col0 + bj * HALF), b1 = *(const f32x4*)(bias + col0 + bj * HALF + 4);
                    const u32x4 yw = *(const u32x4*)(YG + ix);
                    f32x4 v0 = acc[ai][bj][m][0] + b0, v1 = acc[ai][bj][m][1] + b1; float o[8];
#pragma unroll
                    for (int e = 0; e < 4; ++e) { const unsigned w = e == 0 ? yw.x : e == 1 ? yw.y : e == 2 ? yw.z : yw.w;
                        const float y0 = __uint_as_float(w << 16), y1 = __uint_as_float(w & 0xffff0000u);
                        const float a0 = e < 2 ? v0[2 * e] : v1[2 * e - 4], a1 = e < 2 ? v0[2 * e + 1] : v1[2 * e - 3];
                        o[2 * e] = y0 / (1.f + __expf(-a0)); o[2 * e + 1] = y1 / (1.f + __expf(-a1)); }
                    u32x4 w; w.x = cvt_pk_bf16(o[0], o[1]); w.y = cvt_pk_bf16(o[2], o[3]); w.z = cvt_pk_bf16(o[4], o[5]); w.w = cvt_pk_bf16(o[6], o[7]);
                    *(u32x4*)(O + ix) = w; } }
    }
};
template <class Epi, class Sched, bool ALIGN_EPI = false, bool SP2 = false>
__device__ __forceinline__ void gemm_phase(PG8_LAS unsigned char* lds, const Gemm g, const Sched& S, const Epi& E) {
    int tid_l = threadIdx.x; asm volatile("" : "+v"(tid_l));
    const int tid = tid_l, wid = __builtin_amdgcn_readfirstlane(tid >> 6), lane = tid & 63, wr = wid >> 2, wc = wid & 3, fr = lane & 15, fq = lane >> 4;
    const int K = g.K, nt = K / BK;
    unsigned voffA[2], voffB[2];
#pragma unroll
    for (int i = 0; i < 2; ++i) { int R, C; stage_rc(tid * 16 + i * 8192, R, C); const int Rb = Epi::PERM ? ((R & ~31) + perm32(R & 31)) : R;
        voffA[i] = (unsigned)(R * g.lda + C) * 2u; voffB[i] = (unsigned)(Rb * K + C) * 2u; }
    const size_t kstep = (size_t)(BK * 2);
    const size_t hsA = (size_t)HALF * g.lda * 2, hsB = (size_t)HALF * K * 2;
    const size_t tsA = 2 * hsA, tsB = 2 * hsB;
    const unsigned ldsw = (unsigned)wid * 1024u;
    const int aoff = lds_byte(wr * 64 + fr, fq * 8), boff = lds_byte(wc * 32 + fr, fq * 8);
#define PG8_SA(b, h) (((b) * 2 + (h)) * HTB)
#define PG8_SB(b, h) ((4 + (b) * 2 + (h)) * HTB)
#define PG8_STAGE(bufoff, gbase, voff) do { _Pragma("unroll") for (int _i = 0; _i < 2; ++_i) \
        __builtin_amdgcn_global_load_lds((const unsigned*)((const char*)(gbase) + (voff)[_i]), (PG8_LAS unsigned*)(lds + (bufoff) + ldsw + _i * 8192), 16, 0, 0); } while (0)
#define PG8_LDA(dst, b, h) do { _Pragma("unroll") for (int m = 0; m < 4; ++m) _Pragma("unroll") for (int k = 0; k < 2; ++k) dst[m][k] = *(const PG8_LAS bf16x8*)(lds + PG8_SA(b, h) + aoff + m * 2048 + k * 1024); } while (0)
#define PG8_LDB(dst, b, h) do { _Pragma("unroll") for (int n = 0; n < 2; ++n) _Pragma("unroll") for (int k = 0; k < 2; ++k) dst[n][k] = *(const PG8_LAS bf16x8*)(lds + PG8_SB(b, h) + boff + n * 2048 + k * 1024); } while (0)
#define PG8_MMA(ai, bj, At, Bt) do { __builtin_amdgcn_s_setprio(1); _Pragma("unroll") for (int m = 0; m < 4; ++m) _Pragma("unroll") for (int n = 0; n < 2; ++n) _Pragma("unroll") for (int k = 0; k < 2; ++k) \
        acc[ai][bj][m][n] = __builtin_amdgcn_mfma_f32_16x16x32_bf16(Bt[n][k], At[m][k], acc[ai][bj][m][n], 0, 0, 0); __builtin_amdgcn_s_setprio(0); } while (0)
#define PG8_WAIT_V(n) asm volatile("s_waitcnt vmcnt(" #n ")" ::: "memory")
#define PG8_WAIT_L(n) asm volatile("s_waitcnt lgkmcnt(" #n ")" ::: "memory")
#define PG8_BAR __builtin_amdgcn_s_barrier()
#define PG8_SCHED __builtin_amdgcn_sched_barrier(0)
    Unit cur, nxt; int ui = 0;
    if (!S.next(0, cur)) return;
    f32x4 acc[2][2][4][2];
#pragma unroll
    for (int a = 0; a < 2; ++a)
#pragma unroll
        for (int b = 0; b < 2; ++b)
#pragma unroll
            for (int m = 0; m < 4; ++m)
#pragma unroll
                for (int n = 0; n < 2; ++n) acc[a][b][m][n] = (f32x4){0.f, 0.f, 0.f, 0.f};
    bf16x8 At[4][2], B0[2][2], B1[2][2];
    const char* cA = (const char*)g.A + (size_t)cur.pm * tsA; const char* cB = (const char*)g.Bt + (size_t)cur.pn * tsB;
    S.a_ready(cur);
    if constexpr (SP2) {
        PG8_STAGE(PG8_SB(0, 0), cB, voffB); PG8_STAGE(PG8_SB(0, 1), cB + hsB, voffB); PG8_STAGE(PG8_SA(0, 0), cA, voffA); PG8_STAGE(PG8_SA(0, 1), cA + hsA, voffA);
        if (wr == 1) PG8_BAR;
        PG8_WAIT_V(2); PG8_BAR;
        PG8_STAGE(PG8_SB(1, 0), cB + kstep, voffB); PG8_STAGE(PG8_SA(1, 0), cA + kstep, voffA); PG8_STAGE(PG8_SB(1, 1), cB + hsB + kstep, voffB);
        PG8_WAIT_V(6); PG8_BAR;
    } else {
        PG8_STAGE(PG8_SB(0, 0), cB, voffB); PG8_STAGE(PG8_SA(0, 0), cA, voffA); PG8_STAGE(PG8_SB(0, 1), cB + hsB, voffB); PG8_STAGE(PG8_SA(0, 1), cA + hsA, voffA);
        if (wr == 1) PG8_BAR;
        PG8_WAIT_V(4); PG8_BAR;
        PG8_STAGE(PG8_SB(1, 0), cB + kstep, voffB); PG8_STAGE(PG8_SA(1, 0), cA + kstep, voffA); PG8_STAGE(PG8_SB(1, 1), cB + hsB + kstep, voffB);
        PG8_WAIT_V(6); PG8_BAR;
    }
    for (;;) {
        const bool has_next = S.next(ui + 1, nxt);
        const char* nA = has_next ? (const char*)g.A + (size_t)nxt.pm * tsA : cA; const char* nB = has_next ? (const char*)g.Bt + (size_t)nxt.pn * tsB : cB;
        for (int t = 0; t < nt; t += 2) {
            const bool last = (t == nt - 2);
            const char* a1 = cA + (size_t)(t + 1) * kstep;
            const char* a2 = last ? nA : cA + (size_t)(t + 2) * kstep; const char* b2 = last ? nB : cB + (size_t)(t + 2) * kstep;
            const char* a3 = a2 + kstep; const char* b3 = b2 + kstep;
            if (last && has_next) S.a_ready(nxt);
            if constexpr (SP2) {
            PG8_LDB(B0, 0, 0); PG8_LDB(B1, 0, 1); PG8_SCHED; PG8_LDA(At, 0, 0); PG8_STAGE(PG8_SA(1, 1), a1 + hsA, voffA);
            PG8_WAIT_V(8); PG8_WAIT_L(0); PG8_BAR; PG8_MMA(0, 0, At, B0); PG8_MMA(0, 1, At, B1); PG8_BAR; PG8_SCHED;
            PG8_LDA(At, 0, 1); PG8_STAGE(PG8_SB(0, 0), b2, voffB); PG8_STAGE(PG8_SB(0, 1), b2 + hsB, voffB); PG8_STAGE(PG8_SA(0, 0), a2, voffA);
            PG8_WAIT_V(8); PG8_WAIT_L(0); PG8_BAR; PG8_MMA(1, 0, At, B0); PG8_MMA(1, 1, At, B1); PG8_BAR; PG8_SCHED;
            PG8_LDB(B0, 1, 0); PG8_LDB(B1, 1, 1); PG8_SCHED; PG8_LDA(At, 1, 0); PG8_STAGE(PG8_SA(0, 1), a2 + hsA, voffA);
            PG8_WAIT_V(8); PG8_WAIT_L(0); PG8_BAR; PG8_MMA(0, 0, At, B0); PG8_MMA(0, 1, At, B1); PG8_BAR; PG8_SCHED;
            PG8_LDA(At, 1, 1); PG8_STAGE(PG8_SB(1, 0), b3, voffB); PG8_STAGE(PG8_SB(1, 1), b3 + hsB, voffB); PG8_STAGE(PG8_SA(1, 0), a3, voffA);
            PG8_WAIT_V(8); PG8_WAIT_L(0); PG8_BAR; PG8_MMA(1, 0, At, B0); PG8_MMA(1, 1, At, B1); PG8_BAR; PG8_SCHED;
            } else {
            PG8_LDB(B0, 0, 0); PG8_SCHED; PG8_LDA(At, 0, 0); PG8_STAGE(PG8_SA(1, 1), a1 + hsA, voffA);
            PG8_WAIT_L(8); PG8_BAR; PG8_WAIT_L(0); PG8_MMA(0, 0, At, B0); PG8_BAR; PG8_SCHED;
            PG8_LDB(B1, 0, 1); PG8_STAGE(PG8_SB(0, 0), b2, voffB);
            PG8_BAR; PG8_WAIT_L(0); PG8_MMA(0, 1, At, B1); PG8_BAR;
            PG8_LDA(At, 0, 1); PG8_STAGE(PG8_SA(0, 0), a2, voffA);
            PG8_BAR; PG8_WAIT_L(0); PG8_MMA(1, 0, At, B0); PG8_BAR; PG8_SCHED;
            PG8_STAGE(PG8_SB(0, 1), b2 + hsB, voffB);
            PG8_WAIT_V(6); PG8_BAR; PG8_MMA(1, 1, At, B1); PG8_BAR;
            PG8_LDB(B0, 1, 0); PG8_SCHED; PG8_LDA(At, 1, 0); PG8_STAGE(PG8_SA(0, 1), a2 + hsA, voffA);
            PG8_WAIT_L(8); PG8_BAR; PG8_WAIT_L(0); PG8_MMA(0, 0, At, B0); PG8_BAR; PG8_SCHED;
            PG8_LDB(B1, 1, 1); PG8_STAGE(PG8_SB(1, 0), b3, voffB);
            PG8_BAR; PG8_WAIT_L(0); PG8_MMA(0, 1, At, B1); PG8_BAR;
            PG8_LDA(At, 1, 1); PG8_STAGE(PG8_SA(1, 0), a3, voffA);
            PG8_BAR; PG8_WAIT_L(0); PG8_MMA(1, 0, At, B0); PG8_BAR; PG8_SCHED;
            PG8_STAGE(PG8_SB(1, 1), b3 + hsB, voffB);
            PG8_WAIT_V(6); PG8_BAR; PG8_MMA(1, 1, At, B1); PG8_BAR;
            }
        }
        if constexpr (ALIGN_EPI) { if (wr == 0) PG8_BAR; }
        if constexpr (!Epi::AFTER_DRAIN) { E(acc, cur, wr, wc, fr, fq); S.done(cur); }
        if (!has_next) break;
#pragma unroll
        for (int a = 0; a < 2; ++a)
#pragma unroll
            for (int b = 0; b < 2; ++b)
#pragma unroll
                for (int m = 0; m < 4; ++m)
#pragma unroll
                    for (int n = 0; n < 2; ++n) acc[a][b][m][n] = (f32x4){0.f, 0.f, 0.f, 0.f};
        cur = nxt; cA = nA; cB = nB; ++ui;
        if constexpr (ALIGN_EPI) { if (wr == 1) PG8_BAR; }
    }
    PG8_WAIT_V(0);
    if constexpr (!ALIGN_EPI) { if (wr == 0) PG8_BAR; }
    PG8_BAR;
    if constexpr (Epi::AFTER_DRAIN) { E.fused(acc, cur, wr, wc, fr, fq, lds, wid, lane); S.done(cur); }
#undef PG8_SA
#undef PG8_SB
#undef PG8_STAGE
#undef PG8_LDA
#undef PG8_LDB
#undef PG8_MMA
#undef PG8_WAIT_V
#undef PG8_WAIT_L
#undef PG8_BAR
#undef PG8_SCHED
}
}
#define GAS __attribute__((address_space(1)))
#define LAS __attribute__((address_space(3)))
#define XB_TMO      128
#define XB_XCNT(j)  (256  + 64 * (j))
#define XB_XSUB(j)  (1280 + 64 * (j))
#define XB_XGEN(j)  (2304 + 64 * (j))
#define XB_TOP      3328
#define XB_TOPGEN   3392
#define XCD_BAR_WORDS 3456
#define XB_SPIN_CAP (1u << 25)
__device__ __forceinline__ unsigned xb_ld(unsigned* p)              { return __hip_atomic_load(p, __ATOMIC_RELAXED, __HIP_MEMORY_SCOPE_AGENT); }
__device__ __forceinline__ unsigned xb_add(unsigned* p, unsigned v) { return __hip_atomic_fetch_add(p, v, __ATOMIC_RELAXED, __HIP_MEMORY_SCOPE_AGENT); }
__device__ __forceinline__ unsigned xb_xcc_id() { return (unsigned)__builtin_amdgcn_s_getreg((3 << 11) | 20) & 0xFu; }
#define XB_SPIN(cond, bar) do { unsigned _sp = 0; while (cond) { __builtin_amdgcn_s_sleep(1); \
    if ((++_sp & 255u) == 0u) { if (xb_ld(&(bar)[XB_TMO])) break; if (_sp > XB_SPIN_CAP) { atomicAdd(&(bar)[XB_TMO], 1u); break; } } } } while (0)
struct XcdBarrier { unsigned* bar; unsigned x; volatile LAS unsigned* st; };
__device__ __forceinline__ XcdBarrier xcd_barrier_post(unsigned* bar, volatile LAS unsigned* st) {
    XcdBarrier b; b.bar = bar; b.x = xb_xcc_id(); b.st = st;
    if (threadIdx.x == 0) (void)xb_add(&bar[XB_XCNT(b.x)], 1u);
    return b;
}
__device__ __forceinline__ void xcd_barrier_complete(unsigned* bar, unsigned x, unsigned& nloc, unsigned& nx) {
    const unsigned G = gridDim.x * gridDim.y * gridDim.z;
    unsigned sum, cnt, mine, sp = 0u;
    for (;;) {
        sum = 0u; cnt = 0u; mine = 0u;
#pragma unroll
        for (unsigned j = 0; j < 16; ++j) { const unsigned c = xb_ld(&bar[XB_XCNT(j)]); sum += c; cnt += (c > 0u) ? 1u : 0u; mine = (j == x) ? c : mine; }
        if (sum == G) break;
        __builtin_amdgcn_s_sleep(1);
        if ((++sp & 255u) == 0u) { if (xb_ld(&bar[XB_TMO])) break; if (sp > XB_SPIN_CAP) { atomicAdd(&bar[XB_TMO], 1u); break; } }
    }
    nloc = mine > 0u ? mine : 1u; nx = cnt > 0u ? cnt : 1u;
}
__device__ __forceinline__ void xcd_barrier(const XcdBarrier& b) {
    asm volatile("s_waitcnt vmcnt(0)" ::: "memory");
    __syncthreads();
    if (threadIdx.x == 0) {
        unsigned* bar = b.bar;
        __builtin_amdgcn_s_waitcnt(0);
        unsigned nloc = b.st[0], nx = b.st[1];
        if (nloc == 0u) { xcd_barrier_complete(bar, b.x, nloc, nx); b.st[0] = nloc; b.st[1] = nx; }
        const unsigned old = xb_add(&bar[XB_XSUB(b.x)], 1u);
        const unsigned gen = old / nloc;
        if (old + 1u == (gen + 1u) * nloc) {
            __builtin_amdgcn_fence(__ATOMIC_RELEASE, "agent");
            asm volatile("s_waitcnt vmcnt(0)" ::: "memory");
            const unsigned og = xb_add(&bar[XB_TOP], 1u);
            const unsigned tg = og / nx;
            if (og + 1u == (tg + 1u) * nx) xb_add(&bar[XB_TOPGEN], 1u);
            else XB_SPIN(xb_ld(&bar[XB_TOPGEN]) == tg, bar);
            __builtin_amdgcn_fence(__ATOMIC_ACQUIRE, "agent");
            xb_add(&bar[XB_XGEN(b.x)], 1u);
            asm volatile("s_waitcnt vmcnt(0)" ::: "memory");
        } else {
            XB_SPIN(xb_ld(&bar[XB_XGEN(b.x)]) == gen, bar);
            __builtin_amdgcn_fence(__ATOMIC_ACQUIRE, "agent");
            asm volatile("s_waitcnt vmcnt(0)" ::: "memory");
        }
    }
    __syncthreads();
}
constexpr int NWAVES = 8, NTHR = 512;
constexpr int RING_BYTES = 131072, MISC_OFF = RING_BYTES + 320, LDS_BYTES = 147456;
struct Args { const void* in[34]; float* out; unsigned char* ws; int ph_lo, ph_hi; };
struct Ctx { LAS unsigned char* lds; int tid, lane, wave, G, bid, gw, ngw, gt, ngt; };
#define INF(i) ((const float*)a.in[i])
#define WSP(T_, off) ((T_*)(a.ws + (off)))

__device__ __forceinline__ void prep_tile(const float* W, int K, int N, bf16* WT, int Nout, int mapmode, int item, LAS float* tile, int t256) {
    const int nbn = Nout / 32, kb = item / nbn, nb = item % nbn, n0 = nb * 32, k0 = kb * 32, tx = t256 & 31, ty = t256 >> 5;
    for (int i = ty; i < 32; i += 8) {
        const int n = n0 + tx; int src = n;
        if (mapmode == 1) { if (n < 448) src = n; else if (n < 512) src = -1; else src = n - 64; }
        tile[i * 33 + tx] = (src >= 0 && src < N) ? W[(size_t)(k0 + i) * N + src] : 0.f;
    }
    __syncthreads();
    for (int i = ty; i < 32; i += 8) WT[(size_t)(n0 + i) * K + k0 + tx] = f2bf(tile[tx * 33 + i]);
    __syncthreads();
}
template <class ArgsRef> __device__ __forceinline__ void ph_prep(const ArgsRef& a, const Ctx& c) {
    const int sub = c.tid >> 8, t256 = c.tid & 255; LAS float* tile = (LAS float*)c.lds + sub * (32 * 33);
    constexpr int NT0 = 1280, NT1 = 192, NT2 = 128, NT3 = 64, NT4 = 1024, NT5 = 2048, NTL = NT0 + NT1 + NT2 + NT3 + NT4 + NT5, NTOT = NL * NTL;
    const int nsb = c.G * 2;
    for (int it0 = c.bid * 2; it0 < NTOT; it0 += nsb) {
        int it = it0 + sub; if (it >= NTOT) it = NTOT - 1;
        const int l = it / NTL; int r = it % NTL;
        if (r < NT0) prep_tile(INF(3) + (size_t)l * DM * 1216, DM, 1216, WSP(bf16, WS_WINT) + (size_t)l * ZW * DM, ZW, 1, r, tile, t256);
        else if ((r -= NT0) < NT1) prep_tile(INF(5) + (size_t)l * 256 * 768, 256, 768, WSP(bf16, WS_WUQT) + (size_t)l * 768 * 256, 768, 0, r, tile, t256);
        else if ((r -= NT1) < NT2) prep_tile(INF(7) + (size_t)l * 128 * 1024, 128, 1024, WSP(bf16, WS_WUKVT) + (size_t)l * 1024 * 128, 1024, 0, r, tile, t256);
        else if ((r -= NT2) < NT3) prep_tile(INF(18) + (size_t)l * 65536, 256, 256, WSP(bf16, WS_GLUT) + (size_t)l * 65536, 256, 0, r, tile, t256);
        else if ((r -= NT3) < NT4) prep_tile(INF(28) + (size_t)l * DM * DM, DM, DM, WSP(bf16, WS_WOUTT) + (size_t)l * DM * DM, DM, 0, r, tile, t256);
        else { r -= NT4; prep_tile(INF(30) + (size_t)l * DM * 2048, DM, 2048, WSP(bf16, WS_WQT) + (size_t)l * 2048 * DM, 2048, 0, r, tile, t256); }
    }
    for (int i = c.gt; i < NL * 65536; i += c.ngt) { const int l = i >> 16, e = i & 65535, r = e >> 8, cc = e & 255, pp = r >> 7, n = r & 127, p = cc >> 7, d = cc & 127;
        WSP(bf16, WS_SUBKT)[i] = (p == pp) ? f2bf(INF(31)[(size_t)l * 32768 + (pp * 128 + n) * 128 + d]) : (bf16)0; }
    { const size_t n4 = (size_t)NL * 16384 * DM / 4; const float4* u = (const float4*)a.in[32]; const float4* v = (const float4*)a.in[33]; uint2* pu = WSP(uint2, WS_PU); uint2* pv = WSP(uint2, WS_PV);
      for (size_t i = c.gt; i < n4; i += c.ngt) { const float4 x = u[i]; pu[i] = make_uint2(pk2(x.x, x.y), pk2(x.z, x.w)); const float4 y = v[i]; pv[i] = make_uint2(pk2(y.x, y.y), pk2(y.z, y.w)); } }
    for (int i = c.gt; i < T * 32; i += c.ngt) { const int t = i >> 5, j = i & 31;
        const float freq = exp2f(-(float)j * 0.41524101186092033f);
        const float ang = (float)((const int*)a.in[1])[t] * freq; float s, cs; sincos_acc(ang, s, cs);
        WSP(float, WS_COS)[i] = cs; WSP(float, WS_SIN)[i] = s; }
}

__device__ __forceinline__ void ph_rowprep(const Ctx& c, const float* x, const float* gain, bf16* XB) {
    for (int row = c.gw; row < T; row += c.ngw) {
        const float4* xr = (const float4*)(x + (size_t)row * DM) + c.lane;
        float4 v[4]; float ss = 0.f;
#pragma unroll
        for (int j = 0; j < 4; ++j) { v[j] = xr[64 * j]; ss += v[j].x * v[j].x + v[j].y * v[j].y + v[j].z * v[j].z + v[j].w * v[j].w; }
        const float rstd = rsqrtf(wave_sum(ss) * (1.f / DM) + EPS);
        uint2* o = (uint2*)(XB + (size_t)row * DM) + c.lane;
#pragma unroll
        for (int j = 0; j < 4; ++j) { const float4 g = ((const float4*)gain)[c.lane + 64 * j];
            o[64 * j] = make_uint2(pk2(v[j].x * rstd * g.x, v[j].y * rstd * g.y), pk2(v[j].z * rstd * g.z, v[j].w * rstd * g.w)); }
    }
}

enum { EPI_BF16 = 0, EPI_F32 = 1, EPI_GLU = 2, EPI_RESID = 3 };
template <int EPI> __device__ __forceinline__ void gemm_simple(const Ctx& c, const bf16* A, int lda, const bf16* Bt, int M, int N, int K, void* C, int ldc, const float* aux0, const bf16* aux1) {
    LAS float* As = (LAS float*)c.lds; LAS float* Bs = As + 16 * 132;
    const int tid = c.tid, tx = tid & 15, ty = tid >> 4, nN = N / 64, ntile = (M / 128) * nN;
    for (int tile = c.bid; tile < ntile; tile += c.G) {
        const int m0 = (tile / nN) * 128, n0 = (tile % nN) * 64;
        float acc[4][4];
#pragma unroll
        for (int i = 0; i < 4; ++i)
#pragma unroll
            for (int j = 0; j < 4; ++j) acc[i][j] = 0.f;
        const int lr = tid >> 2, lk = (tid & 3) * 4;
        for (int k0 = 0; k0 < K; k0 += 16) {
            { const uint2 w = *(const uint2*)(A + (size_t)(m0 + lr) * lda + k0 + lk);
              As[lk * 132 + lr] = __uint_as_float(w.x << 16); As[(lk + 1) * 132 + lr] = __uint_as_float(w.x & 0xffff0000u); As[(lk + 2) * 132 + lr] = __uint_as_float(w.y << 16); As[(lk + 3) * 132 + lr] = __uint_as_float(w.y & 0xffff0000u); }
            if (tid < 256) { const uint2 w = *(const uint2*)(Bt + (size_t)(n0 + lr) * K + k0 + lk);
              Bs[lk * 68 + lr] = __uint_as_float(w.x << 16); Bs[(lk + 1) * 68 + lr] = __uint_as_float(w.x & 0xffff0000u); Bs[(lk + 2) * 68 + lr] = __uint_as_float(w.y << 16); Bs[(lk + 3) * 68 + lr] = __uint_as_float(w.y & 0xffff0000u); }
            __syncthreads();
#pragma unroll
            for (int kk = 0; kk < 16; ++kk) {
                float av[4], bv[4];
#pragma unroll
                for (int i = 0; i < 4; ++i) { av[i] = As[kk * 132 + ty * 4 + i]; bv[i] = Bs[kk * 68 + tx * 4 + i]; }
#pragma unroll
                for (int i = 0; i < 4; ++i)
#pragma unroll
                    for (int j = 0; j < 4; ++j) acc[i][j] += av[i] * bv[j];
            }
            __syncthreads();
        }
#pragma unroll
        for (int i = 0; i < 4; ++i)
#pragma unroll
            for (int j = 0; j < 4; ++j) {
                const int row = m0 + ty * 4 + i, col = n0 + tx * 4 + j; const size_t ix = (size_t)row * ldc + col; const float v = acc[i][j];
                if (EPI == EPI_BF16) ((bf16*)C)[ix] = f2bf(v);
                else if (EPI == EPI_F32) ((float*)C)[ix] = v;
                else if (EPI == EPI_GLU) { const float yg = bf2f(aux1[ix]); ((bf16*)C)[ix] = f2bf(yg * sigmoid_f(v + aux0[col])); }
                else { ((float*)C)[ix] = aux0[ix] + v; }
            }
    }
}

__device__ __forceinline__ void ph_zstats(const Ctx& c, const bf16* Z, const float* qan, const float* kvan, bf16* CQN, bf16* CKVN) {
    for (int row = c.gw; row < T; row += c.ngw) {
        const bf16* zr = Z + (size_t)row * ZW; const int lane = c.lane;
        { const uint2 w = *(const uint2*)(zr + ZC_CQ + 4 * lane);
          float a0 = __uint_as_float(w.x << 16), a1 = __uint_as_float(w.x & 0xffff0000u), a2 = __uint_as_float(w.y << 16), a3 = __uint_as_float(w.y & 0xffff0000u);
          const float rstd = rsqrtf(wave_sum(a0 * a0 + a1 * a1 + a2 * a2 + a3 * a3) * (1.f / 256) + EPS);
          const float4 g = ((const float4*)qan)[lane];
          *(uint2*)(CQN + (size_t)row * 256 + 4 * lane) = make_uint2(pk2(a0 * rstd * g.x, a1 * rstd * g.y), pk2(a2 * rstd * g.z, a3 * rstd * g.w)); }
        { const u32 w = *(const u32*)(zr + ZC_CKV + 2 * lane);
          float a0 = __uint_as_float(w << 16), a1 = __uint_as_float(w & 0xffff0000u);
          const float rstd = rsqrtf(wave_sum(a0 * a0 + a1 * a1) * (1.f / 128) + EPS);
          const float2 g = ((const float2*)kvan)[lane];
          *(u32*)(CKVN + (size_t)row * 128 + 2 * lane) = pk2(a0 * rstd * g.x, a1 * rstd * g.y); }
    }
}

__device__ __forceinline__ void ph_qkfin(const Ctx& c, const bf16* QRAW, const bf16* KVRAW, const bf16* Z, const float* qn, const float* kn, const float* COS, const float* SIN, bf16* QB, bf16* KB, bf16* VB) {
    const int lane = c.lane;
    for (int w = c.gw; w < T * NH; w += c.ngw) {
        const int t = w >> 2, h = w & 3, b = t / SEQ, s = t % SEQ; const size_t bh = (size_t)b * NH + h;
        const float cs = COS[t * 32 + (lane & 31)], sn = SIN[t * 32 + (lane & 31)];
        {   const bf16* p = QRAW + (size_t)t * 768 + h * DQK;
            float v0 = bf2f(p[lane]), v1 = bf2f(p[lane + 64]), v2 = bf2f(p[lane + 128]);
            const float rstd = rsqrtf(wave_sum(v0 * v0 + v1 * v1 + v2 * v2) * (1.f / DQK) + EPS);
            v0 *= rstd * qn[lane]; v1 *= rstd * qn[lane + 64]; v2 *= rstd * qn[lane + 128];
            const float pr = __shfl_xor(v2, 32);
            const float r2 = (lane < 32) ? (v2 * cs - pr * sn) : (pr * sn + v2 * cs);
            bf16* o = QB + (bh * SEQ + s) * DQK;
            o[lane] = f2bf(v0 * QSCALE); o[lane + 64] = f2bf(v1 * QSCALE); o[lane + 128] = f2bf(r2 * QSCALE); }
        {   const bf16* p = KVRAW + (size_t)t * 1024 + h * 256;
            float v0 = bf2f(p[lane]), v1 = bf2f(p[lane + 64]), v2 = bf2f(Z[(size_t)t * ZW + ZC_KR + lane]);
            const float rstd = rsqrtf(wave_sum(v0 * v0 + v1 * v1 + v2 * v2) * (1.f / DQK) + EPS);
            v0 *= rstd * kn[lane]; v1 *= rstd * kn[lane + 64]; v2 *= rstd * kn[lane + 128];
            const float pr = __shfl_xor(v2, 32);
            const float r2 = (lane < 32) ? (v2 * cs - pr * sn) : (pr * sn + v2 * cs);
            bf16* o = KB + (bh * SEQ + s) * DQK;
            o[lane] = f2bf(v0); o[lane + 64] = f2bf(v1); o[lane + 128] = f2bf(r2);
            bf16* ov = VB + (bh * SEQ + s) * DV;
            ov[lane] = p[128 + lane]; ov[lane + 64] = p[192 + lane]; }
    }
}

__device__ __forceinline__ void ph_attn_simple(const Ctx& c, const bf16* QB, const bf16* KB, const bf16* VB, bf16* AO) {
    LAS float* qs = (LAS float*)c.lds + c.wave * DQK; const int lane = c.lane;
    for (int gq = c.gw; gq < NB * NH * SEQ; gq += c.ngw) {
        const int bh = gq / SEQ, q = gq % SEQ;
        const bf16* qp = QB + ((size_t)bh * SEQ + q) * DQK;
        qs[lane] = bf2f(qp[lane]); qs[lane + 64] = bf2f(qp[lane + 64]); qs[lane + 128] = bf2f(qp[lane + 128]);
        asm volatile("s_waitcnt lgkmcnt(0)" ::: "memory");
        float m = -1e30f, l = 0.f, o0 = 0.f, o1 = 0.f;
        const int ntile = q / 64 + 1;
        for (int kt = 0; kt < ntile; ++kt) {
            const int key = kt * 64 + lane;
            const uint4* kp = (const uint4*)(KB + ((size_t)bh * SEQ + key) * DQK);
            float sc = 0.f;
#pragma unroll 4
            for (int cc = 0; cc < 24; ++cc) { float kv[8]; unpack8(kp[cc], kv);
#pragma unroll
                for (int e = 0; e < 8; ++e) sc += kv[e] * qs[cc * 8 + e]; }
            if (key > q) sc = -INFINITY;
            const float mn = fmaxf(m, wave_max(sc));
            const float p = exp2f(sc - mn), al = exp2f(m - mn);
            l = l * al + wave_sum(p); o0 *= al; o1 *= al; m = mn;
            const u32* vp = (const u32*)(VB + ((size_t)bh * SEQ + kt * 64) * DV) + lane;
#pragma unroll 8
            for (int k = 0; k < 64; ++k) { const float pk = __shfl(p, k); const u32 w = vp[(size_t)k * (DV / 2)];
                o0 += pk * __uint_as_float(w << 16); o1 += pk * __uint_as_float(w & 0xffff0000u); }
        }
        const int b = bh / NH, h = bh % NH; const float il = 1.f / l;
        *(u32*)(AO + ((size_t)b * SEQ + q) * 512 + h * DV + 2 * lane) = pk2(o0 * il, o1 * il);
    }
}

__device__ __forceinline__ void ph_s5_simple(const Ctx& c, const bf16* Z, const float* a_re, const float* a_im, const float* log_dt, const float* b_re, const float* b_im,
                                             const float* c_re, const float* c_im, const float* dsk, bf16* YG) {
    for (int item = c.gw; item < NB * 16; item += c.ngw) {
        const int b = item >> 4, g = item & 15, p = c.lane;
        const float are = a_re[g * 64 + p], aim = a_im[g * 64 + p], dt = expf(log_dt[g]);
        const float mag = expf(are * dt); float sn, cs; sincos_acc(aim * dt, sn, cs);
        const float lre = mag * cs, lim = mag * sn;
        const float xr = lre - 1.f, xi = lim, den = are * are + aim * aim;
        const float cr = (xr * are + xi * aim) / den, ci = (xi * are - xr * aim) / den;
        float Bre[16], Bim[16], Cre[16], Cim[16];
#pragma unroll
        for (int k = 0; k < 16; ++k) { const float br = b_re[(g * 64 + p) * 16 + k], bi = b_im[(g * 64 + p) * 16 + k];
            Bre[k] = cr * br - ci * bi; Bim[k] = cr * bi + ci * br; Cre[k] = c_re[(g * 16 + k) * 64 + p]; Cim[k] = c_im[(g * 16 + k) * 64 + p]; }
        const float D = (p < 16) ? dsk[g * 16 + p] : 0.f;
        float hre = 0.f, him = 0.f;
        for (int s = 0; s < SEQ; ++s) {
            const bf16* up = Z + (size_t)(b * SEQ + s) * ZW + ZC_U + g * 16;
            float u[16]; unpack8(*(const uint4*)up, u); unpack8(*(const uint4*)(up + 8), u + 8);
            float bre = 0.f, bim = 0.f;
#pragma unroll
            for (int k = 0; k < 16; ++k) { bre += Bre[k] * u[k]; bim += Bim[k] * u[k]; }
            const float nre = lre * hre - lim * him + bre, nim = lre * him + lim * hre + bim; hre = nre; him = nim;
            float my = 0.f;
#pragma unroll
            for (int k = 0; k < 16; ++k) { const float v = wave_sum(Cre[k] * hre - Cim[k] * him); if (p == k) my = v + D * u[k]; }
            if (p < 16) YG[(size_t)(b * SEQ + s) * 256 + g * 16 + p] = f2bf(gelu_f(my));
        }
    }
}

__device__ __forceinline__ void ph_lru_xc(const Ctx& c, const bf16* Z, const float* cw, const float* cb, float* XC) {
    for (int i = c.gt; i < T * 256; i += c.ngt) { const int t = i >> 8, ch = i & 255, s = t % SEQ;
        float acc = cb[ch];
#pragma unroll
        for (int j = 0; j < 4; ++j) { const int ss = s - 3 + j; if (ss >= 0) acc += cw[j * 256 + ch] * bf2f(Z[(size_t)(t - 3 + j) * ZW + ZC_X + ch]); }
        XC[i] = acc; }
}
__device__ __forceinline__ void ph_lru_gates(const Ctx& c, const float* XC, const float* wa, const float* ba, const float* wx, const float* bx, const float* lam, float* AA, float* BT) {
    for (int i = c.gt; i < T * 256; i += c.ngt) { const int t = i >> 8, ch = i & 255, h = ch >> 6, j = ch & 63;
        const float* xr = XC + (size_t)t * 256 + h * 64;
        float ra = ba[ch], rx = bx[ch];
        for (int k = 0; k < 64; ++k) { const float xv = xr[k]; ra += xv * wa[(h * 64 + k) * 64 + j]; rx += xv * wx[(h * 64 + k) * 64 + j]; }
        const float r = sigmoid_f(ra), ig = sigmoid_f(rx);
        const float lsg = -log1pf(expf(-lam[ch]));
        const float la = 8.f * r * lsg, av = expf(la);
        AA[i] = av; BT[i] = sqrtf(-expm1f(2.f * la)) * (ig * XC[i]); }
}
__device__ __forceinline__ void ph_lru_scan(const Ctx& c, const float* AA, const float* BT, const bf16* Z, bf16* ROUT) {
    for (int item = c.gw; item < NB * 4; item += c.ngw) {
        const int i = item * 64 + c.lane, b = i >> 8, ch = i & 255;
        float h = 0.f;
#pragma unroll 8
        for (int s = 0; s < SEQ; ++s) { const size_t t = (size_t)b * SEQ + s;
            h = AA[t * 256 + ch] * h + BT[t * 256 + ch];
            ROUT[t * 256 + ch] = f2bf(h * gelu_f(bf2f(Z[t * ZW + ZC_G + ch]))); }
    }
}

__device__ __forceinline__ void ph_mixnorm(const Ctx& c, const bf16* AO, const bf16* SOUT, const bf16* ROUT, const float* g, bf16* Y) {
    const int lane = c.lane;
    for (int row = c.gw; row < T; row += c.ngw) {
        {   float v[8]; unpack8(*(const uint4*)(AO + (size_t)row * 512 + 8 * lane), v);
            float ss = 0.f;
#pragma unroll
            for (int e = 0; e < 8; ++e) ss += v[e] * v[e];
            const float rstd = rsqrtf(wave_sum(ss) * (1.f / 512) + EPS); const float* gg = g + 8 * lane;
            *(uint4*)(Y + (size_t)row * DM + 8 * lane) = make_uint4(pk2(v[0] * rstd * gg[0], v[1] * rstd * gg[1]), pk2(v[2] * rstd * gg[2], v[3] * rstd * gg[3]),
                                                                    pk2(v[4] * rstd * gg[4], v[5] * rstd * gg[5]), pk2(v[6] * rstd * gg[6], v[7] * rstd * gg[7])); }
#pragma unroll
        for (int part = 0; part < 2; ++part) {
            const bf16* src = part == 0 ? SOUT : ROUT; const int off = 512 + 256 * part;
            const uint2 w = *(const uint2*)(src + (size_t)row * 256 + 4 * lane);
            float a0 = __uint_as_float(w.x << 16), a1 = __uint_as_float(w.x & 0xffff0000u), a2 = __uint_as_float(w.y << 16), a3 = __uint_as_float(w.y & 0xffff0000u);
            const float rstd = rsqrtf(wave_sum(a0 * a0 + a1 * a1 + a2 * a2 + a3 * a3) * (1.f / 256) + EPS); const float* gg = g + off + 4 * lane;
            *(uint2*)(Y + (size_t)row * DM + off + 4 * lane) = make_uint2(pk2(a0 * rstd * gg[0], a1 * rstd * gg[1]), pk2(a2 * rstd * gg[2], a3 * rstd * gg[3]));
        }
    }
}

__device__ __forceinline__ void ph_topk_a(const Ctx& c, const float* SC, float* STOP, int* ITOP) {
    for (int i = c.gt; i < T * 16; i += c.ngt) {
        const float* sc = SC + (size_t)i * 128;
        float pv = INFINITY; int pn = -1;
        for (int it = 0; it < 16; ++it) {
            float bv = -INFINITY; int bn = 1 << 30;
            for (int n = 0; n < 128; ++n) { const float v = sc[n];
                const bool elig = (v < pv) || (v == pv && n > pn);
                if (elig && (v > bv || (v == bv && n < bn))) { bv = v; bn = n; } }
            STOP[(size_t)i * 16 + it] = bv; ITOP[(size_t)i * 16 + it] = bn; pv = bv; pn = bn;
        }
    }
}
__device__ __forceinline__ void ph_topk_b(const Ctx& c, const float* STOP, const int* ITOP, int* IDX, float* GATE) {
    LAS float* my = (LAS float*)c.lds + c.tid * 33;
    for (int i = c.gt; i < T * 8; i += c.ngt) {
        for (int k = 0; k < 32; ++k) my[k] = STOP[(size_t)i * 32 + k];
        float pv = INFINITY; int pn = -1; float best0 = 0.f, den = 0.f;
        float ev[16];
#pragma unroll
        for (int it = 0; it < 16; ++it) {
            float bv = -INFINITY; int bn = 1 << 30;
            for (int f = 0; f < 256; ++f) { const float v = my[f >> 4] + my[16 + (f & 15)];
                const bool elig = (v < pv) || (v == pv && f > pn);
                if (elig && (v > bv || (v == bv && f < bn))) { bv = v; bn = f; } }
            pv = bv; pn = bn;
            if (it == 0) best0 = bv;
            ev[it] = expf(bv - best0); den += ev[it];
            IDX[(size_t)i * 16 + it] = ITOP[(size_t)i * 32 + (bn >> 4)] * 128 + ITOP[(size_t)i * 32 + 16 + (bn & 15)];
        }
#pragma unroll
        for (int it = 0; it < 16; ++it) GATE[(size_t)i * 16 + it] = ev[it] / den;
    }
}

__device__ __forceinline__ void ph_gather(const Ctx& c, const bf16* HN, const int* IDX, const float* GATE, const bf16* PU, const bf16* PV, float* X) {
    const int lane = c.lane;
    for (int t = c.gw; t < T; t += c.ngw) {
        float hn[16]; unpack8(*(const uint4*)(HN + (size_t)t * DM + 8 * lane), hn); unpack8(*(const uint4*)(HN + (size_t)t * DM + 512 + 8 * lane), hn + 8);
        float y[16];
#pragma unroll
        for (int e = 0; e < 16; ++e) y[e] = 0.f;
        for (int k = 0; k < 128; ++k) {
            const int e = IDX[(size_t)t * 128 + k]; const float gt = GATE[(size_t)t * 128 + k];
            const bf16* ur = PU + (size_t)e * DM; const bf16* vr = PV + (size_t)e * DM;
            float u[16]; unpack8(*(const uint4*)(ur + 8 * lane), u); unpack8(*(const uint4*)(ur + 512 + 8 * lane), u + 8);
            float d = 0.f;
#pragma unroll
            for (int q = 0; q < 16; ++q) d += u[q] * hn[q];
            d = wave_sum(d);
            const float w = gt * gelu_f(d);
            float v[16]; unpack8(*(const uint4*)(vr + 8 * lane), v); unpack8(*(const uint4*)(vr + 512 + 8 * lane), v + 8);
#pragma unroll
            for (int q = 0; q < 16; ++q) y[q] += w * v[q];
        }
        float4* xo = (float4*)(X + (size_t)t * DM + 8 * lane);
        float4 p0 = xo[0], p1 = xo[1]; p0.x += y[0]; p0.y += y[1]; p0.z += y[2]; p0.w += y[3]; p1.x += y[4]; p1.y += y[5]; p1.z += y[6]; p1.w += y[7]; xo[0] = p0; xo[1] = p1;
        xo = (float4*)(X + (size_t)t * DM + 512 + 8 * lane);
        p0 = xo[0]; p1 = xo[1]; p0.x += y[8]; p0.y += y[9]; p0.z += y[10]; p0.w += y[11]; p1.x += y[12]; p1.y += y[13]; p1.z += y[14]; p1.w += y[15]; xo[0] = p0; xo[1] = p1;
    }
}
namespace att {
typedef short bf16x8 __attribute__((ext_vector_type(8)));
typedef short s16x4 __attribute__((ext_vector_type(4)));
typedef float f32x16 __attribute__((ext_vector_type(16)));
typedef unsigned u32x4 __attribute__((ext_vector_type(4)));
constexpr int KT = 64, KBYTES = KT * DQK * 2, VBYTES = KT * DV * 2, BUFB = KBYTES + VBYTES;
constexpr int OFF_WS = 2 * BUFB, OFF_MO = 0, OFF_ML = 65536, LDS_NEED = OFF_WS + 8 * 64 * 4;
constexpr float THR = 8.f;
__device__ __forceinline__ int kswz(int row, int c) { return row * 384 + (((c & ~7) | ((c & 7) ^ ((row >> 1) & 7))) << 4); }
__device__ __forceinline__ int v_st(int k, int c) { const int kk = (k & ~0xC) | ((k & 4) << 1) | ((k & 8) >> 1); return ((kk >> 3) * 4 + (c >> 5)) * 512 + ((kk & 7) * 32 + (c & 31)) * 2; }
__device__ __forceinline__ int v_rd_base(int lane) { return ((lane & 3) << 3) | (((lane >> 2) & 3) << 6) | (((lane >> 4) & 1) << 5) | (((lane >> 5) & 1) << 8); }
__device__ __forceinline__ int crow(int r, int hi) { return (r & 3) + 8 * (r >> 2) + 4 * hi; }
__device__ __forceinline__ unsigned cvtpk(float lo, float hi) { unsigned r; asm volatile("v_cvt_pk_bf16_f32 %0, %1, %2" : "=v"(r) : "v"(lo), "v"(hi)); return r; }
#define ATT_SBAR() __builtin_amdgcn_sched_barrier(0)

__device__ __forceinline__ void attn_unit(LAS unsigned char* lds, const bf16* Qg, const bf16* Kg, const bf16* Vg, bf16* AO, int bh, int qb, int tid) {
    const int lane = tid & 63, wid = __builtin_amdgcn_readfirstlane(tid >> 6), qsub = wid & 3, kh = wid >> 2, r32 = lane & 31, hi = lane >> 5;
    const int q0 = qb * 128, NT = 2 * (qb + 1);
    const size_t rowbase = (size_t)bh * SEQ;
    bf16x8 qr[12];
    { const bf16* qp = Qg + (rowbase + q0 + 32 * qsub + r32) * DQK + 8 * hi;
#pragma unroll
      for (int ks = 0; ks < 12; ++ks) qr[ks] = *(const bf16x8*)(qp + 16 * ks); }
    int ksrc[3], vsrc[2];
#pragma unroll
    for (int j = 0; j < 3; ++j) { const int L = (wid + 8 * j) * 64 + lane, row = L / 24, cp = L - row * 24, c = (cp & ~7) | ((cp & 7) ^ ((row >> 1) & 7)); ksrc[j] = row * DQK + c * 8; }
#pragma unroll
    for (int j = 0; j < 2; ++j) { const int X = ((wid + 8 * j) * 64 + lane) * 16, sub = X >> 9, within = (X & 511) >> 1, kk = ((sub >> 2) << 3) | (within >> 5);
        const int k = (kk & ~0xC) | ((kk & 4) << 1) | ((kk & 8) >> 1), c = (sub & 3) * 32 + (within & 31); vsrc[j] = k * DV + c; }
    const bf16* Kt = Kg + rowbase * DQK; const bf16* Vt = Vg + rowbase * DV;
#define ATT_STAGE(t, bo) do { const bf16* kp_ = Kt + (size_t)(t) * (KT * DQK); const bf16* vp_ = Vt + (size_t)(t) * (KT * DV); \
        _Pragma("unroll") for (int j_ = 0; j_ < 3; ++j_) __builtin_amdgcn_global_load_lds((const unsigned*)(kp_ + ksrc[j_]), (LAS unsigned*)(lds + (bo) + (wid + 8 * j_) * 1024), 16, 0, 0); \
        _Pragma("unroll") for (int j_ = 0; j_ < 2; ++j_) __builtin_amdgcn_global_load_lds((const unsigned*)(vp_ + vsrc[j_]), (LAS unsigned*)(lds + (bo) + KBYTES + (wid + 8 * j_) * 1024), 16, 0, 0); } while (0)
    const int krow = 32 * kh + r32, kf = (krow >> 1) & 7;
    int kb[4];
#pragma unroll
    for (int j = 0; j < 4; ++j) kb[j] = krow * 384 + ((((2 * j + hi) & 7) ^ kf) << 4);
    const int vb = KBYTES + v_rd_base(lane) + kh * 8192;
    LAS float* wsf = (LAS float*)(lds + OFF_WS) + wid * 64;
    float m_reg = -1e30f, l_reg = 0.f; f32x16 o[4];
#pragma unroll
    for (int d = 0; d < 4; ++d) o[d] = f32x16{};
    const int rb = 32 * qsub;
    ATT_STAGE(0, 0);
    asm volatile("s_waitcnt vmcnt(0)" ::: "memory");
    __syncthreads();
    for (int t = 0; t < NT; ++t) {
        const int bo = (t & 1) * BUFB;
        if (t + 1 < NT) ATT_STAGE(t + 1, BUFB - bo);
        const int kboff = 64 * t + 32 * kh - q0;
        const bool act = kboff <= rb, diag = kboff == rb;
        if (act) {
            f32x16 p = f32x16{};
#pragma unroll
            for (int ks = 0; ks < 12; ++ks) {
                const bf16x8 kfr = *(const LAS bf16x8*)(lds + bo + kb[ks & 3] + (ks >> 2) * 128);
                p = __builtin_amdgcn_mfma_f32_32x32x16_bf16(kfr, qr[ks], p, 0, 0, 0);
            }
            if (diag) {
#pragma unroll
                for (int r = 0; r < 16; ++r) if (crow(r, hi) > r32) p[r] = -__builtin_inff();
            }
            float pmax = p[0];
#pragma unroll
            for (int r = 1; r < 16; ++r) pmax = fmaxf(pmax, p[r]);
            { auto rr = __builtin_amdgcn_permlane32_swap(__float_as_uint(pmax), __float_as_uint(pmax), false, false);
              pmax = fmaxf(__uint_as_float(rr[0]), __uint_as_float(rr[1])); }
            float alpha = 1.f;
            if (!__all(pmax - m_reg <= THR)) { const float mn = fmaxf(m_reg, pmax); alpha = __builtin_amdgcn_exp2f(m_reg - mn); m_reg = mn; }
#pragma unroll
            for (int r = 0; r < 16; ++r) p[r] = __builtin_amdgcn_exp2f(p[r] - m_reg);
            float ps = 0.f;
#pragma unroll
            for (int r = 0; r < 16; ++r) ps += p[r];
            { auto rr = __builtin_amdgcn_permlane32_swap(__float_as_uint(ps), __float_as_uint(ps), false, false);
              ps = __uint_as_float(rr[0]) + __uint_as_float(rr[1]); }
            l_reg = l_reg * alpha + ps;
            if (__any(alpha < 1.f)) {
                if (hi == 0) wsf[r32] = alpha;
                asm volatile("s_waitcnt lgkmcnt(0)" ::: "memory");
#pragma unroll
                for (int r = 0; r < 16; ++r) { const float al = wsf[crow(r, hi)];
#pragma unroll
                    for (int d = 0; d < 4; ++d) o[d][r] *= al; }
            }
            bf16x8 pa0, pa1;
#define ATT_PK4(B_, OUT) do { unsigned a0 = cvtpk(p[B_ + 0], p[B_ + 1]), a1 = cvtpk(p[B_ + 2], p[B_ + 3]); unsigned b0 = cvtpk(p[B_ + 4], p[B_ + 5]), b1 = cvtpk(p[B_ + 6], p[B_ + 7]); \
            auto r0 = __builtin_amdgcn_permlane32_swap(a0, b0, false, false); auto r1 = __builtin_amdgcn_permlane32_swap(a1, b1, false, false); \
            u32x4 w_ = {r0[0], r1[0], r0[1], r1[1]}; OUT = __builtin_bit_cast(bf16x8, w_); } while (0)
            ATT_PK4(0, pa0); ATT_PK4(8, pa1);
#undef ATT_PK4
            const int vaddr = (int)(uintptr_t)lds + bo + vb;
#define ATT_TRRD(dst, off) asm volatile("ds_read_b64_tr_b16 %0, %1 offset:%2" : "=&v"(dst) : "v"(vaddr), "i"(off) : "memory")
#define ATT_PV(d0) do { s16x4 l0, h0, l1, h1; \
            ATT_TRRD(l0, (d0) * 512); ATT_TRRD(h0, (d0) * 512 + 2048); ATT_TRRD(l1, (d0) * 512 + 4096); ATT_TRRD(h1, (d0) * 512 + 6144); \
            asm volatile("s_waitcnt lgkmcnt(0)" ::: "memory"); ATT_SBAR(); \
            o[d0] = __builtin_amdgcn_mfma_f32_32x32x16_bf16(pa0, (bf16x8){l0[0], l0[1], l0[2], l0[3], h0[0], h0[1], h0[2], h0[3]}, o[d0], 0, 0, 0); \
            o[d0] = __builtin_amdgcn_mfma_f32_32x32x16_bf16(pa1, (bf16x8){l1[0], l1[1], l1[2], l1[3], h1[0], h1[1], h1[2], h1[3]}, o[d0], 0, 0, 0); } while (0)
            ATT_PV(0); ATT_PV(1); ATT_PV(2); ATT_PV(3);
#undef ATT_PV
#undef ATT_TRRD
        }
        asm volatile("s_waitcnt vmcnt(0)" ::: "memory");
        __syncthreads();
    }
    LAS float* MO = (LAS float*)(lds + OFF_MO) + qsub * 4096; LAS float* ML = (LAS float*)(lds + OFF_ML) + qsub * 64;
    if (kh == 1) {
        if (hi == 0) { ML[2 * r32] = m_reg; ML[2 * r32 + 1] = l_reg; }
#pragma unroll
        for (int d = 0; d < 4; ++d)
#pragma unroll
            for (int r = 0; r < 16; ++r) MO[(d * 16 + r) * 64 + lane] = o[d][r];
    }
    __syncthreads();
    if (kh == 0) {
        const float m1 = ML[2 * r32], l1 = ML[2 * r32 + 1];
        const float mm = fmaxf(m_reg, m1), f0 = __builtin_amdgcn_exp2f(m_reg - mm), f1 = __builtin_amdgcn_exp2f(m1 - mm);
        const float il = 1.f / (l_reg * f0 + l1 * f1);
        if (hi == 0) { wsf[r32] = f0 * il; wsf[32 + r32] = f1 * il; }
        asm volatile("s_waitcnt lgkmcnt(0)" ::: "memory");
        const int b = bh / NH, h = bh % NH;
        bf16* Ow = AO + ((size_t)b * SEQ + q0 + rb) * 512 + h * DV;
#pragma unroll
        for (int r = 0; r < 16; ++r) { const int orow = crow(r, hi); const float g0 = wsf[orow], g1 = wsf[32 + orow];
#pragma unroll
            for (int d = 0; d < 4; ++d) { const float v = o[d][r] * g0 + MO[(d * 16 + r) * 64 + lane] * g1; const float vn = __shfl_xor(v, 1);
                if ((r32 & 1) == 0) *(unsigned*)(Ow + (size_t)orow * 512 + d * 32 + r32) = cvtpk(v, vn); } }
    }
    __syncthreads();
#undef ATT_STAGE
}
__device__ __forceinline__ void attn_phase(LAS unsigned char* lds, const bf16* Qg, const bf16* Kg, const bf16* Vg, bf16* AO, int G, int bid, int tid) {
    const int npair = NB * NH * 32;
    for (int v0 = bid; v0 < npair; v0 += G) {
        const int vcu = (G % 8 == 0 && npair % G == 0) ? (v0 % 8) * (npair / 8) + v0 / 8 : v0;
        const int bh = vcu >> 5, s = vcu & 31;
        for (int u = 0; u < 2; ++u) attn_unit(lds, Qg, Kg, Vg, AO, bh, u ? s : 63 - s, tid);
    }
}
#undef ATT_SBAR
}
#ifndef MK_SIMPLE_ATTN
#define MK_SIMPLE_ATTN 0
#endif
#ifndef MK_SIMPLE_GEMM
#define MK_SIMPLE_GEMM 0
#endif
constexpr int NPH_LAYER = 16, NPH = 1 + NL * NPH_LAYER;
struct GD { const bf16* A; const bf16* Bt; void* C; const float* aux0; const bf16* aux1; int lda, M, N, K, ldc, kind; };
template <class Epi> __device__ __forceinline__ void run_gemm(const Ctx& c, const bf16* A, int lda, const bf16* Bt, int M, int N, int K, const Epi& E) {
    pg8::Gemm g{A, Bt, M, N, K, lda}; pg8::StaticOrder S; S.init(M, N, c.G, c.bid);
    pg8::gemm_phase<Epi, pg8::StaticOrder, true, true>(c.lds, g, S, E);
}
#define AS4 __attribute__((address_space(4)))
__global__ void __launch_bounds__(NTHR, 2) mega(Args a_) {
    extern __shared__ __attribute__((aligned(16))) unsigned char lds_raw[];
    {   const int t0 = threadIdx.x;
        for (int u = t0; u < (LDS_BYTES - RING_BYTES) / 4; u += NTHR) ((LAS unsigned*)((LAS unsigned char*)lds_raw + RING_BYTES))[u] = 0u; }
    __syncthreads();
    volatile LAS unsigned* MISC = (volatile LAS unsigned*)((LAS unsigned char*)lds_raw + MISC_OFF);
    XcdBarrier bar; bar.bar = (unsigned*)(a_.ws + WS_CTL) + CW_BAR; bar.x = 0; bar.st = MISC + 8;
    const int ph_lo = a_.ph_lo, ph_hi = a_.ph_hi;
    if (ph_hi - ph_lo > 1) bar = xcd_barrier_post((unsigned*)(a_.ws + WS_CTL) + CW_BAR, MISC + 8);

    int p = ph_lo;
    if (p == 0) {
        const Args AS4* ap0 = (const Args AS4*)__builtin_amdgcn_kernarg_segment_ptr(); Ctx c0; c0.lds = (LAS unsigned char*)lds_raw; c0.tid = threadIdx.x; c0.lane = c0.tid & 63; c0.wave = __builtin_amdgcn_readfirstlane(c0.tid >> 6);
        c0.G = gridDim.x; c0.bid = blockIdx.x; c0.gw = c0.wave * c0.G + c0.bid; c0.ngw = NWAVES * c0.G; c0.gt = c0.bid * NTHR + c0.tid; c0.ngt = c0.G * NTHR;
        ph_prep(*ap0, c0);
        if (p + 1 < ph_hi) xcd_barrier(bar);
        p = 1;
    }
    for (; p < ph_hi; ++p) {
        const Args AS4* ap = (const Args AS4*)__builtin_amdgcn_kernarg_segment_ptr(); asm volatile("" : "+s"(ap));
        int tid_ = threadIdx.x; asm volatile("" : "+v"(tid_));
#define a (*ap)
        Ctx c; c.lds = (LAS unsigned char*)lds_raw; c.tid = tid_; c.lane = c.tid & 63; c.wave = __builtin_amdgcn_readfirstlane(c.tid >> 6);
        { int G_ = gridDim.x, bid_ = blockIdx.x; asm volatile("" : "+s"(G_), "+s"(bid_)); c.G = G_; c.bid = bid_; }
        c.gw = c.wave * c.G + c.bid; c.ngw = NWAVES * c.G; c.gt = c.bid * NTHR + c.tid; c.ngt = c.G * NTHR;
        bf16 *WINT = WSP(bf16, WS_WINT), *WUQT = WSP(bf16, WS_WUQT), *WUKVT = WSP(bf16, WS_WUKVT), *GLUT = WSP(bf16, WS_GLUT), *WOUTT = WSP(bf16, WS_WOUTT),
             *WQT = WSP(bf16, WS_WQT), *SUBKT = WSP(bf16, WS_SUBKT), *PU = WSP(bf16, WS_PU), *PV = WSP(bf16, WS_PV);
        float *COS = WSP(float, WS_COS), *SIN = WSP(float, WS_SIN);
        bf16 *XB = WSP(bf16, WS_XB), *Z = WSP(bf16, WS_Z), *QRAW = WSP(bf16, WS_QRAW), *KVRAW = WSP(bf16, WS_KVRAW), *QB = WSP(bf16, WS_QB), *KB = WSP(bf16, WS_KB),
             *VB = WSP(bf16, WS_VB), *CQN = WSP(bf16, WS_CQN), *CKVN = WSP(bf16, WS_CKVN), *AO = WSP(bf16, WS_AO), *ROUT = WSP(bf16, WS_ROUT), *Y = WSP(bf16, WS_Y),
             *YG = WSP(bf16, WS_YG), *SOUT = WSP(bf16, WS_SOUT), *QP = WSP(bf16, WS_QP);
        float *XC = WSP(float, WS_XC), *AA = WSP(float, WS_AA), *BT = WSP(float, WS_BT), *SC = WSP(float, WS_SC), *STOP = WSP(float, WS_STOP), *GATE = WSP(float, WS_GATE);
        int *ITOP = WSP(int, WS_ITOP), *IDX = WSP(int, WS_IDX);
        float* out = a.out;
        {
            const int l = (p - 1) / NPH_LAYER, k = (p - 1) % NPH_LAYER;
            const float* xin = (l == 0) ? INF(0) : out;
            GD gd; gd.kind = 0; gd.A = nullptr; gd.Bt = nullptr; gd.C = nullptr; gd.aux0 = nullptr; gd.aux1 = nullptr; gd.lda = 0; gd.M = T; gd.N = 0; gd.K = 0; gd.ldc = 0;
#define SETG(kind_, A_, lda_, Bt_, M_, N_, K_, C_, ldc_, aux0_, aux1_) do { gd.kind = kind_; gd.A = A_; gd.lda = lda_; gd.Bt = Bt_; gd.M = M_; gd.N = N_; gd.K = K_; gd.C = (void*)(C_); gd.ldc = ldc_; gd.aux0 = aux0_; gd.aux1 = aux1_; } while (0)
            switch (k) {
            case 0: ph_rowprep(c, xin, INF(2) + l * DM, XB); break;
            case 1: SETG(1, XB, DM, WINT + (size_t)l * ZW * DM, T, ZW, DM, Z, ZW, nullptr, nullptr); break;
            case 2: ph_zstats(c, Z, INF(4) + l * 256, INF(6) + l * 128, CQN, CKVN); ph_lru_xc(c, Z, INF(20) + l * 1024, INF(21) + l * 256, XC); break;
            case 3: SETG(1, CQN, 256, WUQT + (size_t)l * 768 * 256, T, 768, 256, QRAW, 768, nullptr, nullptr); break;
            case 4: SETG(1, CKVN, 128, WUKVT + (size_t)l * 1024 * 128, T, 1024, 128, KVRAW, 1024, nullptr, nullptr);
                    ph_lru_gates(c, XC, INF(22) + l * 16384, INF(23) + l * 256, INF(24) + l * 16384, INF(25) + l * 256, INF(26) + l * 256, AA, BT); break;
            case 5: ph_qkfin(c, QRAW, KVRAW, Z, INF(8) + l * DQK, INF(9) + l * DQK, COS, SIN, QB, KB, VB); break;
            case 6:
                ph_s5_simple(c, Z, INF(10) + l * 1024, INF(11) + l * 1024, INF(12) + l * 16, INF(13) + l * 16384, INF(14) + l * 16384, INF(15) + l * 16384, INF(16) + l * 16384, INF(17) + l * 256, YG);
                ph_lru_scan(c, AA, BT, Z, ROUT);
#if MK_SIMPLE_ATTN
                ph_attn_simple(c, QB, KB, VB, AO);
#else
                __syncthreads(); att::attn_phase(c.lds, QB, KB, VB, AO, c.G, c.bid, c.tid);
#endif
                break;
            case 7: SETG(3, YG, 256, GLUT + (size_t)l * 65536, T, 256, 256, SOUT, 256, INF(19) + l * 256, YG); break;
            case 8: ph_mixnorm(c, AO, SOUT, ROUT, INF(27) + l * DM, Y); break;
            case 9: SETG(2, Y, DM, WOUTT + (size_t)l * DM * DM, T, DM, DM, out, DM, xin, nullptr); break;
            case 10: ph_rowprep(c, out, INF(29) + l * DM, XB); break;
            case 11: SETG(1, XB, DM, WQT + (size_t)l * 2048 * DM, T, 2048, DM, QP, 2048, nullptr, nullptr); break;
            case 12: SETG(2, QP, 256, SUBKT + (size_t)l * 65536, T * 8, 256, 256, SC, 256, nullptr, nullptr); break;
            case 13: ph_topk_a(c, SC, STOP, ITOP); break;
            case 14: ph_topk_b(c, STOP, ITOP, IDX, GATE); break;
            default: ph_gather(c, XB, IDX, GATE, PU + (size_t)l * 16384 * DM, PV + (size_t)l * 16384 * DM, out); break;
            }
#undef SETG
#if MK_SIMPLE_GEMM
            if (gd.kind == 1) gemm_simple<EPI_BF16>(c, gd.A, gd.lda, gd.Bt, gd.M, gd.N, gd.K, gd.C, gd.ldc, nullptr, nullptr);
            else if (gd.kind == 2) { if (gd.aux0) gemm_simple<EPI_RESID>(c, gd.A, gd.lda, gd.Bt, gd.M, gd.N, gd.K, gd.C, gd.ldc, gd.aux0, nullptr); else gemm_simple<EPI_F32>(c, gd.A, gd.lda, gd.Bt, gd.M, gd.N, gd.K, gd.C, gd.ldc, nullptr, nullptr); }
            else if (gd.kind == 3) gemm_simple<EPI_GLU>(c, gd.A, gd.lda, gd.Bt, gd.M, gd.N, gd.K, gd.C, gd.ldc, gd.aux0, gd.aux1);
#else
            if (gd.kind == 1) run_gemm(c, gd.A, gd.lda, gd.Bt, gd.M, gd.N, gd.K, pg8::EpiBf16<0>{(bf16*)gd.C, gd.ldc, nullptr, 0, 0, 1.f});
            else if (gd.kind == 2) run_gemm(c, gd.A, gd.lda, gd.Bt, gd.M, gd.N, gd.K, pg8::EpiF32{(float*)gd.C, gd.ldc, gd.aux0});
            else if (gd.kind == 3) run_gemm(c, gd.A, gd.lda, gd.Bt, gd.M, gd.N, gd.K, pg8::EpiGlu{(bf16*)gd.C, gd.ldc, gd.aux0, gd.aux1});
#endif
        }
        if (p + 1 < ph_hi) { XcdBarrier b2 = bar; unsigned* bb = (unsigned*)(a.ws + WS_CTL) + CW_BAR; unsigned bx = bar.x; asm volatile("" : "+s"(bb), "+s"(bx)); b2.bar = bb; b2.x = bx; xcd_barrier(b2); }
#undef a
    }
}

extern "C" void kernel_launch(void* const* d_in, const int* in_sizes, int n_in, void* d_out, int out_size, void* d_ws, size_t ws_size, hipStream_t stream) {
    static int grid = 0;
    if (grid == 0) {
        if (n_in != 34 || out_size != T * DM || ws_size < WS_END) { fprintf(stderr, "kernel_launch: unexpected shapes (n_in %d out %d ws %zu)\n", n_in, out_size, ws_size); grid = -1; return; }
        int dev = 0, cus = 0, per_cu = 0;
        if (hipGetDevice(&dev) != hipSuccess || hipDeviceGetAttribute(&cus, hipDeviceAttributeMultiprocessorCount, dev) != hipSuccess) { grid = -1; return; }
        if (hipFuncSetAttribute((const void*)mega, hipFuncAttributeMaxDynamicSharedMemorySize, LDS_BYTES) != hipSuccess) { fprintf(stderr, "kernel_launch: hipFuncSetAttribute failed\n"); grid = -1; return; }
        if (hipOccupancyMaxActiveBlocksPerMultiprocessor(&per_cu, (const void*)mega, NTHR, LDS_BYTES) != hipSuccess || per_cu < 1) { fprintf(stderr, "kernel_launch: occupancy query says %d blocks per CU\n", per_cu); }
        (void)hipGetLastError();
        grid = cus;
    }
    if (grid < 0) return;
    (void)hipMemsetAsync((char*)d_ws + WS_CTL, 0, CTL_ZERO_BYTES, stream);
    Args a{};
    for (int i = 0; i < 34; ++i) a.in[i] = d_in[i];
    a.out = (float*)d_out; a.ws = (unsigned char*)d_ws;
#if MK_PER_PHASE
    for (int p = 0; p < NPH; ++p) { a.ph_lo = p; a.ph_hi = p + 1; hipLaunchKernelGGL(mega, dim3(grid), dim3(NTHR), LDS_BYTES, stream, a); }
#else
    a.ph_lo = 0; a.ph_hi = NPH;
    hipLaunchKernelGGL(mega, dim3(grid), dim3(NTHR), LDS_BYTES, stream, a);
#endif
}
```

```cpp
#include <hip/hip_runtime.h>
#include <cstdint>
#include <cstdio>

#ifndef MK_PER_PHASE
#define MK_PER_PHASE 0
#endif

typedef unsigned short bf16;
typedef unsigned int u32;

constexpr int NB = 2, SEQ = 8192, T = NB * SEQ, DM = 1024, NL = 2;
constexpr int ZW = 1280;
constexpr int ZC_CQ = 0, ZC_CKV = 256, ZC_KR = 384, ZC_U = 512, ZC_X = 768, ZC_G = 1024;
constexpr int NH = 4, DQK = 192, DV = 128;
constexpr float EPS = 1e-6f;
constexpr float QSCALE = 0.07216878364870322f * 1.4426950408889634f;

constexpr size_t MiB = 1u << 20;
constexpr size_t WS_CTL = 0, CTL_ZERO_BYTES = 1 * MiB, WS_WINT = 1 * MiB, WS_WUQT = 7 * MiB, WS_WUKVT = 8 * MiB, WS_GLUT = 9 * MiB, WS_WOUTT = 10 * MiB,
                 WS_WQT = 14 * MiB, WS_SUBKT = 22 * MiB, WS_COS = 23 * MiB, WS_SIN = 25 * MiB, WS_PU = 28 * MiB, WS_PV = 92 * MiB,
                 WS_XB = 156 * MiB, WS_Z = 188 * MiB, WS_RA = 228 * MiB, WS_RB = 356 * MiB, WS_CKVN = 420 * MiB, WS_AO = 424 * MiB,
                 WS_ROUT = 440 * MiB, WS_Y = 448 * MiB, WS_IDX = 480 * MiB, WS_GATE = 488 * MiB, WS_S5A = 496 * MiB, WS_S5C = WS_S5A + 128 * 1024, WS_S5L = WS_S5A + 256 * 1024,
                 WS_SE = 497 * MiB, WS_SH = 501 * MiB, WS_LPE = 505 * MiB, WS_LH = 506 * MiB, WS_END = 507 * MiB;
constexpr size_t WS_QRAW = WS_RA, WS_KVRAW = WS_RA + 24 * MiB, WS_QB = WS_RA + 56 * MiB, WS_KB = WS_RA + 80 * MiB, WS_VB = WS_RA + 104 * MiB,
                 WS_CQN = WS_RA + 120 * MiB, WS_SC = WS_RA;
constexpr size_t WS_XC = WS_RB, WS_AA = WS_RB + 16 * MiB, WS_BT = WS_RB + 32 * MiB, WS_YG = WS_RB + 48 * MiB, WS_SOUT = WS_RB + 56 * MiB, WS_QP = WS_RB;
constexpr size_t WS_STOP = WS_Z, WS_ITOP = WS_Z + 16 * MiB;
constexpr int CW_BAR = 4096;

__device__ __forceinline__ float bf2f(bf16 h) { return __uint_as_float((u32)h << 16); }
__device__ __forceinline__ bf16 f2bf(float f) { u32 u = __float_as_uint(f); return (bf16)((u + 0x7fffu + ((u >> 16) & 1u)) >> 16); }
__device__ __forceinline__ u32 pk2(float lo, float hi) { return (u32)f2bf(lo) | ((u32)f2bf(hi) << 16); }
__device__ __forceinline__ float wave_sum(float v) {
#pragma unroll
    for (int o = 32; o > 0; o >>= 1) v += __shfl_xor(v, o);
    return v;
}
__device__ __forceinline__ float wave_max(float v) {
#pragma unroll
    for (int o = 32; o > 0; o >>= 1) v = fmaxf(v, __shfl_xor(v, o));
    return v;
}
__device__ __forceinline__ float gelu_f(float x) { return 0.5f * x * (1.f + erff(x * 0.70710678118654752f)); }
__device__ __forceinline__ float sigmoid_f(float x) { return 1.f / (1.f + __expf(-x)); }
__device__ __forceinline__ void unpack8(uint4 w, float* o) {
    o[0] = __uint_as_float(w.x << 16); o[1] = __uint_as_float(w.x & 0xffff0000u);
    o[2] = __uint_as_float(w.y << 16); o[3] = __uint_as_float(w.y & 0xffff0000u);
    o[4] = __uint_as_float(w.z << 16); o[5] = __uint_as_float(w.z & 0xffff0000u);
    o[6] = __uint_as_float(w.w << 16); o[7] = __uint_as_float(w.w & 0xffff0000u);
}
__device__ __forceinline__ void sincos_acc(float x, float& s, float& c) {
    const float k = rintf(x * 0.15915494309189535f);
    float r = fmaf(-k, 6.28125f, x);
    r = fmaf(-k, 1.9350051879882812e-3f, r);
    r = fmaf(-k, 3.0199160335e-7f, r);
    const float f = r * 0.15915494309189535f;
    s = __builtin_amdgcn_sinf(f); c = __builtin_amdgcn_cosf(f);
}
namespace pg8 {
#define PG8_LAS __attribute__((address_space(3)))
typedef unsigned short bf16_t;
typedef short bf16x8 __attribute__((ext_vector_type(8)));
typedef float f32x4 __attribute__((ext_vector_type(4)));
typedef unsigned u32x4 __attribute__((ext_vector_type(4)));
constexpr int BM = 256, BK = 64, HALF = 128, HTB = HALF * BK * 2  , STAGE_BYTES = 8 * HTB, NXCD = 8, WGM = 8;

__host__ __device__ __forceinline__ int lds_byte(int r, int c) { const int st = (r >> 4) * 2 + (c >> 5), rr = r & 15, cc = c & 31, ob = rr * 64 + cc * 2; return st * 1024 + (ob ^ (((ob >> 9) & 1) << 5)); }
__host__ __device__ __forceinline__ void stage_rc(int b, int& R, int& C) { const int st = b / 1024, sb = b % 1024, swz = sb ^ (((sb >> 9) & 1) << 5); R = (st >> 1) * 16 + swz / 64; C = (st & 1) * 32 + (swz % 64) / 2; }
__host__ __device__ __forceinline__ int perm32(int rho) { const int n = rho >> 4, i = rho & 15; return 8 * (i >> 2) + 4 * n + (i & 3); }

struct Unit { int pm, pn; };
struct Gemm { const bf16_t* A; const bf16_t* Bt; int M, N, K, lda; };

struct StaticOrder {
    int nM, nN, nwg, G, c;
    __host__ __device__ void init(int M, int N, int G_, int c_) { nM = M / BM; nN = N / BM; nwg = nM * nN; G = G_; c = c_; }
    __host__ __device__ bool next(int i, Unit& u) const {
        const long L = (long)i * G + c; if (L >= nwg) return false;
        int wgid = (int)L; { const int q = nwg / NXCD, r = nwg % NXCD, xcd = wgid % NXCD, off = wgid / NXCD; wgid = (xcd < r ? xcd * (q + 1) : r * (q + 1) + (xcd - r) * q) + off; }
        const int nig = WGM * nN, gid = wgid / nig, fm = gid * WGM, gsz = (nM - fm) < WGM ? (nM - fm) : WGM;
        u.pm = fm + ((wgid % nig) % gsz); u.pn = (wgid % nig) / gsz; return true;
    }
    __device__ __forceinline__ void a_ready(const Unit&) const {}
    __device__ __forceinline__ void done(const Unit&) const {}
};

__device__ __forceinline__ unsigned cvt_pk_bf16(float lo, float hi) { unsigned r; asm volatile("v_cvt_pk_bf16_f32 %0, %1, %2" : "=v"(r) : "v"(lo), "v"(hi)); return r; }
typedef float f32x2 __attribute__((ext_vector_type(2)));
__device__ __forceinline__ f32x2 gelu_pk(f32x2 v) {
    const f32x2 av = __builtin_elementwise_abs(v), d = av * 0.2316418882f + 1.0f;
    f32x2 t; t.x = __builtin_amdgcn_rcpf(d.x); t.y = __builtin_amdgcn_rcpf(d.y);
    f32x2 q = t * 0.5307027145f + (-0.7265760135f); q = q * t + 0.7107068705f; q = q * t + (-0.142248368f); q = q * t + 0.127414796f; q = q * t;
    const f32x2 s = (v * v) * (-0.72134752044f);
    f32x2 e; e.x = __builtin_amdgcn_exp2f(s.x); e.y = __builtin_amdgcn_exp2f(s.y);
    const f32x2 m = v * (q * e), r = v - m;
    f32x2 o; o.x = v.x < 0.f ? m.x : r.x; o.y = v.y < 0.f ? m.y : r.y; return o;
}

template <int ACT  > struct EpiBf16 {
    static constexpr bool PERM = true, AFTER_DRAIN = false; static_assert(ACT == 0 || ACT == 1, "EpiBf16: ACT is 0 (none) or 1 (gelu_pk)");
    bf16_t* O; int ldc; const float* bias; int split_cols; size_t split_stride; float scale0;
    __device__ __forceinline__ void operator()(const f32x4 (&acc)[2][2][4][2], const Unit& u, int wr, int wc, int fr, int fq) const {
        const int row0 = u.pm * BM + wr * 64 + fr; int colt = u.pn * BM; bf16_t* base = O;
        float sc = 1.f; if (split_cols) { const int t = colt / split_cols; base += (size_t)t * split_stride; colt -= t * split_cols; if (t == 0) sc = scale0; }
        const int col0 = colt + wc * 32 + 8 * fq, bcol0 = u.pn * BM + wc * 32 + 8 * fq;
        f32x4 bv[2][2];
#pragma unroll
        for (int bj = 0; bj < 2; ++bj)
#pragma unroll
            for (int n = 0; n < 2; ++n) bv[bj][n] = bias ? *(const f32x4*)(bias + bcol0 + bj * HALF + 4 * n) : (f32x4){0.f, 0.f, 0.f, 0.f};
#pragma unroll
        for (int ai = 0; ai < 2; ++ai)
#pragma unroll
            for (int m = 0; m < 4; ++m) { bf16_t* rowp = base + (size_t)(row0 + ai * HALF + m * 16) * ldc + col0;
#pragma unroll
                for (int bj = 0; bj < 2; ++bj) { f32x4 v0 = acc[ai][bj][m][0] + bv[bj][0], v1 = acc[ai][bj][m][1] + bv[bj][1];
                    if (ACT == 1) { f32x2 a = gelu_pk((f32x2){v0[0], v0[1]}), b = gelu_pk((f32x2){v0[2], v0[3]}), c = gelu_pk((f32x2){v1[0], v1[1]}), d = gelu_pk((f32x2){v1[2], v1[3]});
                        v0 = (f32x4){a.x, a.y, b.x, b.y}; v1 = (f32x4){c.x, c.y, d.x, d.y}; }
                    v0 = v0 * sc; v1 = v1 * sc; u32x4 w; w.x = cvt_pk_bf16(v0[0], v0[1]); w.y = cvt_pk_bf16(v0[2], v0[3]); w.z = cvt_pk_bf16(v1[0], v1[1]); w.w = cvt_pk_bf16(v1[2], v1[3]);
                    *(u32x4*)(rowp + bj * HALF) = w; } }
    }
};


struct EpiF32 {
    static constexpr bool PERM = false, AFTER_DRAIN = false;
    float* C; int ldc; const float* resid;
    __device__ __forceinline__ void operator()(const f32x4 (&acc)[2][2][4][2], const Unit& u, int wr, int wc, int fr, int fq) const {
        const int row0 = u.pm * BM + wr * 64 + fr, col0 = u.pn * BM + wc * 32 + 4 * fq;
#pragma unroll
        for (int ai = 0; ai < 2; ++ai)
#pragma unroll
            for (int m = 0; m < 4; ++m) { const size_t rb = (size_t)(row0 + ai * HALF + m * 16) * ldc + col0;
#pragma unroll
                for (int bj = 0; bj < 2; ++bj)
#pragma unroll
                    for (int n = 0; n < 2; ++n) { const size_t ix = rb + bj * HALF + n * 16; f32x4 v = acc[ai][bj][m][n];
                        if (resid) v += *(const f32x4*)(resid + ix);
                        *(f32x4*)(C + ix) = v; } }
    }
};
struct EpiGlu {
    static constexpr bool PERM = true, AFTER_DRAIN = false;
    bf16_t* O; int ldc; const float* bias; const bf16_t* YG;
    __device__ __forceinline__ void operator()(const f32x4 (&acc)[2][2][4][2], const Unit& u, int wr, int wc, int fr, int fq) const {
        const int row0 = u.pm * BM + wr * 64 + fr, col0 = u.pn * BM + wc * 32 + 8 * fq;
#pragma unroll
        for (int ai = 0; ai < 2; ++ai)
#pragma unroll
            for (int m = 0; m < 4; ++m) { const size_t rb = (size_t)(row0 + ai * HALF + m * 16) * ldc + col0;
#pragma unroll
                for (int bj = 0; bj < 2; ++bj) { const size_t ix = rb + bj * HALF;
                    const f32x4 b0 = *(const f32x4*)(bias + col0 + bj * HALF), b1 = *(const f32x4*)(bias + col0 + bj * HALF + 4);
                    const u32x4 yw = *(const u32x4*)(YG + ix);
                    f32x4 v0 = acc[ai][bj][m][0] + b0, v1 = acc[ai][bj][m][1] + b1; float o[8];
#pragma unroll
                    for (int e = 0; e < 4; ++e) { const unsigned w = e == 0 ? yw.x : e == 1 ? yw.y : e == 2 ? yw.z : yw.w;
                        const float y0 = __uint_as_float(w << 16), y1 = __uint_as_float(w & 0xffff0000u);
                        const float a0 = e < 2 ? v0[2 * e] : v1[2 * e - 4], a1 = e < 2 ? v0[2 * e + 1] : v1[2 * e - 3];
                        o[2 * e] = y0 / (1.f + __expf(-a0)); o[2 * e + 1] = y1 / (1.f + __expf(-a1)); }
                    u32x4 w; w.x = cvt_pk_bf16(o[0], o[1]); w.y = cvt_pk_bf16(o[2], o[3]); w.z = cvt_pk_bf16(o[4], o[5]); w.w = cvt_pk_bf16(o[6], o[7]);
                    *(u32x4*)(O + ix) = w; } }
    }
};
template <class Epi, class Sched, bool ALIGN_EPI = false, bool SP2 = false>
__device__ __forceinline__ void gemm_phase(PG8_LAS unsigned char* lds, const Gemm g, const Sched& S, const Epi& E) {
    int tid_l = threadIdx.x; asm volatile("" : "+v"(tid_l));
    const int tid = tid_l, wid = __builtin_amdgcn_readfirstlane(tid >> 6), lane = tid & 63, wr = wid >> 2, wc = wid & 3, fr = lane & 15, fq = lane >> 4;
    const int K = g.K, nt = K / BK;
    unsigned voffA[2], voffB[2];
#pragma unroll
    for (int i = 0; i < 2; ++i) { int R, C; stage_rc(tid * 16 + i * 8192, R, C); const int Rb = Epi::PERM ? ((R & ~31) + perm32(R & 31)) : R;
        voffA[i] = (unsigned)(R * g.lda + C) * 2u; voffB[i] = (unsigned)(Rb * K + C) * 2u; }
    const size_t kstep = (size_t)(BK * 2);
    const size_t hsA = (size_t)HALF * g.lda * 2, hsB = (size_t)HALF * K * 2;
    const size_t tsA = 2 * hsA, tsB = 2 * hsB;
    const unsigned ldsw = (unsigned)wid * 1024u;
    const int aoff = lds_byte(wr * 64 + fr, fq * 8), boff = lds_byte(wc * 32 + fr, fq * 8);
#define PG8_SA(b, h) (((b) * 2 + (h)) * HTB)
#define PG8_SB(b, h) ((4 + (b) * 2 + (h)) * HTB)
#define PG8_STAGE(bufoff, gbase, voff) do { _Pragma("unroll") for (int _i = 0; _i < 2; ++_i) \
        __builtin_amdgcn_global_load_lds((const unsigned*)((const char*)(gbase) + (voff)[_i]), (PG8_LAS unsigned*)(lds + (bufoff) + ldsw + _i * 8192), 16, 0, 0); } while (0)
#define PG8_LDA(dst, b, h) do { _Pragma("unroll") for (int m = 0; m < 4; ++m) _Pragma("unroll") for (int k = 0; k < 2; ++k) dst[m][k] = *(const PG8_LAS bf16x8*)(lds + PG8_SA(b, h) + aoff + m * 2048 + k * 1024); } while (0)
#define PG8_LDB(dst, b, h) do { _Pragma("unroll") for (int n = 0; n < 2; ++n) _Pragma("unroll") for (int k = 0; k < 2; ++k) dst[n][k] = *(const PG8_LAS bf16x8*)(lds + PG8_SB(b, h) + boff + n * 2048 + k * 1024); } while (0)
#define PG8_MMA(ai, bj, At, Bt) do { __builtin_amdgcn_s_setprio(1); _Pragma("unroll") for (int m = 0; m < 4; ++m) _Pragma("unroll") for (int n = 0; n < 2; ++n) _Pragma("unroll") for (int k = 0; k < 2; ++k) \
        acc[ai][bj][m][n] = __builtin_amdgcn_mfma_f32_16x16x32_bf16(Bt[n][k], At[m][k], acc[ai][bj][m][n], 0, 0, 0); __builtin_amdgcn_s_setprio(0); } while (0)
#define PG8_WAIT_V(n) asm volatile("s_waitcnt vmcnt(" #n ")" ::: "memory")
#define PG8_WAIT_L(n) asm volatile("s_waitcnt lgkmcnt(" #n ")" ::: "memory")
#define PG8_BAR __builtin_amdgcn_s_barrier()
#define PG8_SCHED __builtin_amdgcn_sched_barrier(0)
    Unit cur, nxt; int ui = 0;
    if (!S.next(0, cur)) return;
    f32x4 acc[2][2][4][2];
#pragma unroll
    for (int a = 0; a < 2; ++a)
#pragma unroll
        for (int b = 0; b < 2; ++b)
#pragma unroll
            for (int m = 0; m < 4; ++m)
#pragma unroll
                for (int n = 0; n < 2; ++n) acc[a][b][m][n] = (f32x4){0.f, 0.f, 0.f, 0.f};
    bf16x8 At[4][2], B0[2][2], B1[2][2];
    const char* cA = (const char*)g.A + (size_t)cur.pm * tsA; const char* cB = (const char*)g.Bt + (size_t)cur.pn * tsB;
    S.a_ready(cur);
    if constexpr (SP2) {
        PG8_STAGE(PG8_SB(0, 0), cB, voffB); PG8_STAGE(PG8_SB(0, 1), cB + hsB, voffB); PG8_STAGE(PG8_SA(0, 0), cA, voffA); PG8_STAGE(PG8_SA(0, 1), cA + hsA, voffA);
        if (wr == 1) PG8_BAR;
        PG8_WAIT_V(2); PG8_BAR;
        PG8_STAGE(PG8_SB(1, 0), cB + kstep, voffB); PG8_STAGE(PG8_SA(1, 0), cA + kstep, voffA); PG8_STAGE(PG8_SB(1, 1), cB + hsB + kstep, voffB);
        PG8_WAIT_V(6); PG8_BAR;
    } else {
        PG8_STAGE(PG8_SB(0, 0), cB, voffB); PG8_STAGE(PG8_SA(0, 0), cA, voffA); PG8_STAGE(PG8_SB(0, 1), cB + hsB, voffB); PG8_STAGE(PG8_SA(0, 1), cA + hsA, voffA);
        if (wr == 1) PG8_BAR;
        PG8_WAIT_V(4); PG8_BAR;
        PG8_STAGE(PG8_SB(1, 0), cB + kstep, voffB); PG8_STAGE(PG8_SA(1, 0), cA + kstep, voffA); PG8_STAGE(PG8_SB(1, 1), cB + hsB + kstep, voffB);
        PG8_WAIT_V(6); PG8_BAR;
    }
    for (;;) {
        const bool has_next = S.next(ui + 1, nxt);
        const char* nA = has_next ? (const char*)g.A + (size_t)nxt.pm * tsA : cA; const char* nB = has_next ? (const char*)g.Bt + (size_t)nxt.pn * tsB : cB;
        for (int t = 0; t < nt; t += 2) {
            const bool last = (t == nt - 2);
            const char* a1 = cA + (size_t)(t + 1) * kstep;
            const char* a2 = last ? nA : cA + (size_t)(t + 2) * kstep; const char* b2 = last ? nB : cB + (size_t)(t + 2) * kstep;
            const char* a3 = a2 + kstep; const char* b3 = b2 + kstep;
            if (last && has_next) S.a_ready(nxt);
            if constexpr (SP2) {
            PG8_LDB(B0, 0, 0); PG8_LDB(B1, 0, 1); PG8_SCHED; PG8_LDA(At, 0, 0); PG8_STAGE(PG8_SA(1, 1), a1 + hsA, voffA);
            PG8_WAIT_V(8); PG8_WAIT_L(0); PG8_BAR; PG8_MMA(0, 0, At, B0); PG8_MMA(0, 1, At, B1); PG8_BAR; PG8_SCHED;
            PG8_LDA(At, 0, 1); PG8_STAGE(PG8_SB(0, 0), b2, voffB); PG8_STAGE(PG8_SB(0, 1), b2 + hsB, voffB); PG8_STAGE(PG8_SA(0, 0), a2, voffA);
            PG8_WAIT_V(8); PG8_WAIT_L(0); PG8_BAR; PG8_MMA(1, 0, At, B0); PG8_MMA(1, 1, At, B1); PG8_BAR; PG8_SCHED;
            PG8_LDB(B0, 1, 0); PG8_LDB(B1, 1, 1); PG8_SCHED; PG8_LDA(At, 1, 0); PG8_STAGE(PG8_SA(0, 1), a2 + hsA, voffA);
            PG8_WAIT_V(8); PG8_WAIT_L(0); PG8_BAR; PG8_MMA(0, 0, At, B0); PG8_MMA(0, 1, At, B1); PG8_BAR; PG8_SCHED;
            PG8_LDA(At, 1, 1); PG8_STAGE(PG8_SB(1, 0), b3, voffB); PG8_STAGE(PG8_SB(1, 1), b3 + hsB, voffB); PG8_STAGE(PG8_SA(1, 0), a3, voffA);
            PG8_WAIT_V(8); PG8_WAIT_L(0); PG8_BAR; PG8_MMA(1, 0, At, B0); PG8_MMA(1, 1, At, B1); PG8_BAR; PG8_SCHED;
            } else {
            PG8_LDB(B0, 0, 0); PG8_SCHED; PG8_LDA(At, 0, 0); PG8_STAGE(PG8_SA(1, 1), a1 + hsA, voffA);
            PG8_WAIT_L(8); PG8_BAR; PG8_WAIT_L(0); PG8_MMA(0, 0, At, B0); PG8_BAR; PG8_SCHED;
            PG8_LDB(B1, 0, 1); PG8_STAGE(PG8_SB(0, 0), b2, voffB);
            PG8_BAR; PG8_WAIT_L(0); PG8_MMA(0, 1, At, B1); PG8_BAR;
            PG8_LDA(At, 0, 1); PG8_STAGE(PG8_SA(0, 0), a2, voffA);
            PG8_BAR; PG8_WAIT_L(0); PG8_MMA(1, 0, At, B0); PG8_BAR; PG8_SCHED;
            PG8_STAGE(PG8_SB(0, 1), b2 + hsB, voffB);
            PG8_WAIT_V(6); PG8_BAR; PG8_MMA(1, 1, At, B1); PG8_BAR;
            PG8_LDB(B0, 1, 0); PG8_SCHED; PG8_LDA(At, 1, 0); PG8_STAGE(PG8_SA(0, 1), a2 + hsA, voffA);
            PG8_WAIT_L(8); PG8_BAR; PG8_WAIT_L(0); PG8_MMA(0, 0, At, B0); PG8_BAR; PG8_SCHED;
            PG8_LDB(B1, 1, 1); PG8_STAGE(PG8_SB(1, 0), b3, voffB);
            PG8_BAR; PG8_WAIT_L(0); PG8_MMA(0, 1, At, B1); PG8_BAR;
            PG8_LDA(At, 1, 1); PG8_STAGE(PG8_SA(1, 0), a3, voffA);
            PG8_BAR; PG8_WAIT_L(0); PG8_MMA(1, 0, At, B0); PG8_BAR; PG8_SCHED;
            PG8_STAGE(PG8_SB(1, 1), b3 + hsB, voffB);
            PG8_WAIT_V(6); PG8_BAR; PG8_MMA(1, 1, At, B1); PG8_BAR;
            }
        }
        if constexpr (ALIGN_EPI) { if (wr == 0) PG8_BAR; }
        if constexpr (!Epi::AFTER_DRAIN) { E(acc, cur, wr, wc, fr, fq); S.done(cur); }
        if (!has_next) break;
#pragma unroll
        for (int a = 0; a < 2; ++a)
#pragma unroll
            for (int b = 0; b < 2; ++b)
#pragma unroll
                for (int m = 0; m < 4; ++m)
#pragma unroll
                    for (int n = 0; n < 2; ++n) acc[a][b][m][n] = (f32x4){0.f, 0.f, 0.f, 0.f};
        cur = nxt; cA = nA; cB = nB; ++ui;
        if constexpr (ALIGN_EPI) { if (wr == 1) PG8_BAR; }
    }
    PG8_WAIT_V(0);
    if constexpr (!ALIGN_EPI) { if (wr == 0) PG8_BAR; }
    PG8_BAR;
    if constexpr (Epi::AFTER_DRAIN) { E.fused(acc, cur, wr, wc, fr, fq, lds, wid, lane); S.done(cur); }
#undef PG8_SA
#undef PG8_SB
#undef PG8_STAGE
#undef PG8_LDA
#undef PG8_LDB
#undef PG8_MMA
#undef PG8_WAIT_V
#undef PG8_WAIT_L
#undef PG8_BAR
#undef PG8_SCHED
}
}
#define GAS __attribute__((address_space(1)))
#define LAS __attribute__((address_space(3)))
#define XB_TMO      128
#define XB_XCNT(j)  (256  + 64 * (j))
#define XB_XSUB(j)  (1280 + 64 * (j))
#define XB_XGEN(j)  (2304 + 64 * (j))
#define XB_TOP      3328
#define XB_TOPGEN   3392
#define XCD_BAR_WORDS 3456
#define XB_SPIN_CAP (1u << 25)
__device__ __forceinline__ unsigned xb_ld(unsigned* p)              { return __hip_atomic_load(p, __ATOMIC_RELAXED, __HIP_MEMORY_SCOPE_AGENT); }
__device__ __forceinline__ unsigned xb_add(unsigned* p, unsigned v) { return __hip_atomic_fetch_add(p, v, __ATOMIC_RELAXED, __HIP_MEMORY_SCOPE_AGENT); }
__device__ __forceinline__ unsigned xb_xcc_id() { return (unsigned)__builtin_amdgcn_s_getreg((3 << 11) | 20) & 0xFu; }
#define XB_SPIN(cond, bar) do { unsigned _sp = 0; while (cond) { __builtin_amdgcn_s_sleep(1); \
    if ((++_sp & 255u) == 0u) { if (xb_ld(&(bar)[XB_TMO])) break; if (_sp > XB_SPIN_CAP) { atomicAdd(&(bar)[XB_TMO], 1u); break; } } } } while (0)
struct XcdBarrier { unsigned* bar; unsigned x; volatile LAS unsigned* st; };
__device__ __forceinline__ XcdBarrier xcd_barrier_post(unsigned* bar, volatile LAS unsigned* st) {
    XcdBarrier b; b.bar = bar; b.x = xb_xcc_id(); b.st = st;
    if (threadIdx.x == 0) (void)xb_add(&bar[XB_XCNT(b.x)], 1u);
    return b;
}
__device__ __forceinline__ void xcd_barrier_complete(unsigned* bar, unsigned x, unsigned& nloc, unsigned& nx) {
    const unsigned G = gridDim.x * gridDim.y * gridDim.z;
    unsigned sum, cnt, mine, sp = 0u;
    for (;;) {
        sum = 0u; cnt = 0u; mine = 0u;
#pragma unroll
        for (unsigned j = 0; j < 16; ++j) { const unsigned c = xb_ld(&bar[XB_XCNT(j)]); sum += c; cnt += (c > 0u) ? 1u : 0u; mine = (j == x) ? c : mine; }
        if (sum == G) break;
        __builtin_amdgcn_s_sleep(1);
        if ((++sp & 255u) == 0u) { if (xb_ld(&bar[XB_TMO])) break; if (sp > XB_SPIN_CAP) { atomicAdd(&bar[XB_TMO], 1u); break; } }
    }
    nloc = mine > 0u ? mine : 1u; nx = cnt > 0u ? cnt : 1u;
}
__device__ __forceinline__ void xcd_barrier(const XcdBarrier& b) {
    asm volatile("s_waitcnt vmcnt(0)" ::: "memory");
    __syncthreads();
    if (threadIdx.x == 0) {
        unsigned* bar = b.bar;
        __builtin_amdgcn_s_waitcnt(0);
        unsigned nloc = b.st[0], nx = b.st[1];
        if (nloc == 0u) { xcd_barrier_complete(bar, b.x, nloc, nx); b.st[0] = nloc; b.st[1] = nx; }
        const unsigned old = xb_add(&bar[XB_XSUB(b.x)], 1u);
        const unsigned gen = old / nloc;
        if (old + 1u == (gen + 1u) * nloc) {
            __builtin_amdgcn_fence(__ATOMIC_RELEASE, "agent");
            asm volatile("s_waitcnt vmcnt(0)" ::: "memory");
            const unsigned og = xb_add(&bar[XB_TOP], 1u);
            const unsigned tg = og / nx;
            if (og + 1u == (tg + 1u) * nx) xb_add(&bar[XB_TOPGEN], 1u);
            else XB_SPIN(xb_ld(&bar[XB_TOPGEN]) == tg, bar);
            __builtin_amdgcn_fence(__ATOMIC_ACQUIRE, "agent");
            xb_add(&bar[XB_XGEN(b.x)], 1u);
            asm volatile("s_waitcnt vmcnt(0)" ::: "memory");
        } else {
            XB_SPIN(xb_ld(&bar[XB_XGEN(b.x)]) == gen, bar);
            __builtin_amdgcn_fence(__ATOMIC_ACQUIRE, "agent");
            asm volatile("s_waitcnt vmcnt(0)" ::: "memory");
        }
    }
    __syncthreads();
}
namespace s5f {
typedef short bf16x8 __attribute__((ext_vector_type(8)));
typedef float f32x4 __attribute__((ext_vector_type(4)));
typedef unsigned u32x2 __attribute__((ext_vector_type(2)));
constexpr int LC = 32, NCH = SEQ / LC, RS = 272, WBYTES = LC * RS;
__device__ __forceinline__ void build_tables(const float* a_re, const float* a_im, const float* log_dt, const float* b_re, const float* b_im, const float* c_re, const float* c_im,
                                             bf16* S5A, bf16* S5C, float2* S5L, int gt, int ngt) {
    for (int i = gt; i < 16 * 64; i += ngt) {
        const int g = i >> 6;
        const float are = a_re[i], aim = a_im[i], dt = expf(log_dt[g]);
        const float mag = expf(are * dt); float sn, cs; sincos_acc(aim * dt, sn, cs);
        const float lre = mag * cs, lim = mag * sn;
        const float xr = lre - 1.f, xi = lim, den = are * are + aim * aim;
        const float cr = (xr * are + xi * aim) / den, ci = (xi * are - xr * aim) / den;
        S5L[i] = make_float2(lre, lim);
        const int p = i & 63;
        for (int k = 0; k < 16; ++k) { const float br = b_re[i * 16 + k], bi = b_im[i * 16 + k];
            S5A[((size_t)g * 128 + 2 * p) * 16 + k] = f2bf(cr * br - ci * bi); S5A[((size_t)g * 128 + 2 * p + 1) * 16 + k] = f2bf(cr * bi + ci * br);
            S5C[((size_t)g * 16 + k) * 128 + 2 * p] = f2bf(c_re[(g * 16 + k) * 64 + p]); S5C[((size_t)g * 16 + k) * 128 + 2 * p + 1] = f2bf(-c_im[(g * 16 + k) * 64 + p]); }
    }
}
template <bool FULL> __device__ __forceinline__ void chunk(LAS unsigned char* wl, const bf16* Z, const bf16x8 (&afr)[8], const bf16x8 (&cfr)[4], float lre, float lim, float& hre, float& him,
                                                           int b, int ch, int g, int lane, const float* dsk, bf16* YG) {
    const int l15 = lane & 15, q4 = lane >> 4;
    const size_t t0 = (size_t)b * SEQ + (size_t)ch * LC;
#pragma unroll
    for (int nb = 0; nb < 2; ++nb) {
        bf16x8 ufr = bf16x8{};
        if (q4 < 2) ufr = *(const bf16x8*)(Z + (t0 + 16 * nb + l15) * ZW + ZC_U + g * 16 + 8 * q4);
#pragma unroll
        for (int mb = 0; mb < 8; ++mb) {
            f32x4 d = __builtin_amdgcn_mfma_f32_16x16x32_bf16(afr[mb], ufr, f32x4{0.f, 0.f, 0.f, 0.f}, 0, 0, 0);
            *(LAS u32x2*)(wl + (16 * nb + l15) * RS + (16 * mb + 4 * q4) * 2) = u32x2{pk2(d[0], d[1]), pk2(d[2], d[3])};
        }
    }
#pragma unroll 8
    for (int k = 0; k < LC; ++k) {
        LAS unsigned* wp = (LAS unsigned*)(wl + k * RS + 4 * lane);
        const unsigned w = *wp; const float bre = __uint_as_float(w << 16), bim = __uint_as_float(w & 0xffff0000u);
        const float nre = fmaf(lre, hre, fmaf(-lim, him, bre)), nim = fmaf(lre, him, fmaf(lim, hre, bim)); hre = nre; him = nim;
        if (FULL) *wp = pk2(hre, him);
    }
    if (FULL) {
#pragma unroll
        for (int nb = 0; nb < 2; ++nb) {
            f32x4 y = f32x4{0.f, 0.f, 0.f, 0.f};
#pragma unroll
            for (int ks = 0; ks < 4; ++ks) {
                const bf16x8 hfr = *(const LAS bf16x8*)(wl + (16 * nb + l15) * RS + (32 * ks + 8 * q4) * 2);
                y = __builtin_amdgcn_mfma_f32_16x16x32_bf16(cfr[ks], hfr, y, 0, 0, 0);
            }
            const size_t t = t0 + 16 * nb + l15; const int co = 4 * q4;
            const uint2 uw = *(const uint2*)(Z + t * ZW + ZC_U + g * 16 + co);
            const float4 dd = *(const float4*)(dsk + g * 16 + co);
            const float y0 = y[0] + dd.x * __uint_as_float(uw.x << 16), y1 = y[1] + dd.y * __uint_as_float(uw.x & 0xffff0000u),
                        y2 = y[2] + dd.z * __uint_as_float(uw.y << 16), y3 = y[3] + dd.w * __uint_as_float(uw.y & 0xffff0000u);
            *(uint2*)(YG + t * 256 + g * 16 + co) = make_uint2(pk2(gelu_f(y0), gelu_f(y1)), pk2(gelu_f(y2), gelu_f(y3)));
        }
    }
}
template <bool FULL> __device__ __forceinline__ void pass(LAS unsigned char* lds, const bf16* Z, const bf16* S5A, const bf16* S5C, const float2* S5L, const float* dsk,
                                                          float2* SE, const float2* SH, bf16* YG, int gw, int ngw, int wave, int lane) {
    LAS unsigned char* wl = lds + wave * WBYTES;
    const int g = gw & 15, l15 = lane & 15, q4 = lane >> 4;
    bf16x8 afr[8], cfr[4];
#pragma unroll
    for (int mb = 0; mb < 8; ++mb) { afr[mb] = bf16x8{}; if (q4 < 2) afr[mb] = *(const bf16x8*)(S5A + ((size_t)g * 128 + 16 * mb + l15) * 16 + 8 * q4); }
#pragma unroll
    for (int ks = 0; ks < 4; ++ks) { cfr[ks] = bf16x8{}; if (FULL) cfr[ks] = *(const bf16x8*)(S5C + ((size_t)g * 16 + l15) * 128 + 32 * ks + 8 * q4); }
    const float2 lam = S5L[g * 64 + lane];
    for (int it = gw >> 4; it < NB * NCH; it += ngw >> 4) {
        const int b = it / NCH, ch = it % NCH;
        float hre = 0.f, him = 0.f;
        if (FULL) { const float2 h0 = SH[((size_t)it * 16 + g) * 64 + lane]; hre = h0.x; him = h0.y; }
        chunk<FULL>(wl, Z, afr, cfr, lam.x, lam.y, hre, him, b, ch, g, lane, dsk, YG);
        if (!FULL) SE[((size_t)it * 16 + g) * 64 + lane] = make_float2(hre, him);
    }
}
__device__ __forceinline__ void carry(const float2* S5L, const float2* SE, float2* SH, int gw, int ngw, int lane) {
    for (int item = gw; item < NB * 16; item += ngw) {
        const int b = item >> 4, g = item & 15;
        float2 lam = S5L[g * 64 + lane];
#pragma unroll
        for (int i = 0; i < 5; ++i) { const float re = lam.x * lam.x - lam.y * lam.y, im = 2.f * lam.x * lam.y; lam.x = re; lam.y = im; }
        float hre = 0.f, him = 0.f;
#pragma unroll 8
        for (int c = 0; c < NCH; ++c) { const size_t ix = (((size_t)b * NCH + c) * 16 + g) * 64 + lane;
            SH[ix] = make_float2(hre, him);
            const float2 e = SE[ix];
            const float nre = lam.x * hre - lam.y * him + e.x, nim = lam.x * him + lam.y * hre + e.y; hre = nre; him = nim; }
    }
}
}
namespace lruf {
typedef float f32x4 __attribute__((ext_vector_type(4)));
constexpr int LC = 32, NCH = SEQ / LC, XS = 68;
__device__ __forceinline__ void pass_a(LAS unsigned char* lds, const bf16* Z, const float* cw, const float* cb, const float* wa, const float* ba, const float* wx, const float* bx, const float* lam,
                                       float* AA, float* BT, float2* LPE, int gw, int ngw, int wave, int lane) {
    LAS float* xt = (LAS float*)lds + wave * (LC * XS);
    for (int item = gw; item < NB * NCH * 4; item += ngw) {
        const int h = item & 3, bc = item >> 2, b = bc / NCH, ch = bc % NCH, c = h * 64 + lane;
        const size_t t0 = (size_t)b * SEQ + (size_t)ch * LC;
        const float w0 = cw[c], w1 = cw[256 + c], w2 = cw[512 + c], w3 = cw[768 + c], bias = cb[c];
        float z0 = 0.f, z1 = 0.f, z2 = 0.f;
        if (ch > 0) { z0 = bf2f(Z[(t0 - 3) * ZW + ZC_X + c]); z1 = bf2f(Z[(t0 - 2) * ZW + ZC_X + c]); z2 = bf2f(Z[(t0 - 1) * ZW + ZC_X + c]); }
        float xc[LC];
#pragma unroll
        for (int k = 0; k < LC; ++k) { const float z3 = bf2f(Z[(t0 + k) * ZW + ZC_X + c]); xc[k] = bias + w0 * z0 + w1 * z1 + w2 * z2 + w3 * z3; z0 = z1; z1 = z2; z2 = z3; xt[k * XS + lane] = xc[k]; }
        float ra[LC], rx[LC];
        { const float b0 = ba[c], b1 = bx[c];
#pragma unroll
          for (int k = 0; k < LC; ++k) { ra[k] = b0; rx[k] = b1; } }
        const float* wap = wa + (size_t)h * 4096 + lane; const float* wxp = wx + (size_t)h * 4096 + lane;
        for (int i = 0; i < 64; i += 4) {
            const float a0 = wap[(i + 0) * 64], a1 = wap[(i + 1) * 64], a2 = wap[(i + 2) * 64], a3 = wap[(i + 3) * 64];
            const float x0 = wxp[(i + 0) * 64], x1 = wxp[(i + 1) * 64], x2 = wxp[(i + 2) * 64], x3 = wxp[(i + 3) * 64];
#pragma unroll
            for (int k = 0; k < LC; ++k) { const f32x4 v = *(const LAS f32x4*)(xt + k * XS + i);
                ra[k] += v.x * a0 + v.y * a1 + v.z * a2 + v.w * a3; rx[k] += v.x * x0 + v.y * x1 + v.z * x2 + v.w * x3; }
        }
        const float lsg8 = -8.f * log1pf(expf(-lam[c]));
        float hloc = 0.f, prod = 1.f;
#pragma unroll
        for (int k = 0; k < LC; ++k) {
            const float r = sigmoid_f(ra[k]), ig = sigmoid_f(rx[k]);
            const float la = r * lsg8, av = expf(la), bt = sqrtf(-expm1f(2.f * la)) * (ig * xc[k]);
            AA[(t0 + k) * 256 + c] = av; BT[(t0 + k) * 256 + c] = bt;
            hloc = av * hloc + bt; prod *= av;
        }
        LPE[(size_t)bc * 256 + c] = make_float2(prod, hloc);
    }
}
__device__ __forceinline__ void carry(const float2* LPE, float* LH, int gt, int ngt) {
    for (int i = gt; i < NB * 256; i += ngt) { const int b = i >> 8, c = i & 255;
        float h = 0.f;
#pragma unroll 8
        for (int ch = 0; ch < NCH; ++ch) { const size_t ix = ((size_t)b * NCH + ch) * 256 + c; LH[ix] = h; const float2 pe = LPE[ix]; h = pe.x * h + pe.y; } }
}
__device__ __forceinline__ void pass_b(const float* AA, const float* BT, const float* LH, const bf16* Z, bf16* ROUT, int gt, int ngt) {
    for (int i = gt; i < NB * NCH * 256; i += ngt) { const int c = i & 255, bc = i >> 8; const size_t t0 = (size_t)bc * LC;
        float h = LH[i];
#pragma unroll 8
        for (int k = 0; k < LC; ++k) { const size_t t = t0 + k;
            h = AA[t * 256 + c] * h + BT[t * 256 + c];
            ROUT[t * 256 + c] = f2bf(h * gelu_f(bf2f(Z[t * ZW + ZC_G + c]))); } }
}
}
constexpr int NWAVES = 8, NTHR = 512;
constexpr int RING_BYTES = 131072, MISC_OFF = RING_BYTES + 320, LDS_BYTES = 147456;
struct Args { const void* in[34]; float* out; unsigned char* ws; int ph_lo, ph_hi; };
struct Ctx { LAS unsigned char* lds; int tid, lane, wave, G, bid, gw, ngw, gt, ngt; };
#define INF(i) ((const float*)a.in[i])
#define WSP(T_, off) ((T_*)(a.ws + (off)))

__device__ __forceinline__ void prep_tile(const float* W, int K, int N, bf16* WT, int Nout, int mapmode, int item, LAS float* tile, int t256) {
    const int nbn = Nout / 32, kb = item / nbn, nb = item % nbn, n0 = nb * 32, k0 = kb * 32, tx = t256 & 31, ty = t256 >> 5;
    for (int i = ty; i < 32; i += 8) {
        const int n = n0 + tx; int src = n;
        if (mapmode == 1) { if (n < 448) src = n; else if (n < 512) src = -1; else src = n - 64; }
        tile[i * 33 + tx] = (src >= 0 && src < N) ? W[(size_t)(k0 + i) * N + src] : 0.f;
    }
    __syncthreads();
    for (int i = ty; i < 32; i += 8) WT[(size_t)(n0 + i) * K + k0 + tx] = f2bf(tile[tx * 33 + i]);
    __syncthreads();
}
template <class ArgsRef> __device__ __forceinline__ void ph_prep(const ArgsRef& a, const Ctx& c) {
    const int sub = c.tid >> 8, t256 = c.tid & 255; LAS float* tile = (LAS float*)c.lds + sub * (32 * 33);
    constexpr int NT0 = 1280, NT1 = 192, NT2 = 128, NT3 = 64, NT4 = 1024, NT5 = 2048, NTL = NT0 + NT1 + NT2 + NT3 + NT4 + NT5, NTOT = NL * NTL;
    const int nsb = c.G * 2;
    for (int it0 = c.bid * 2; it0 < NTOT; it0 += nsb) {
        int it = it0 + sub; if (it >= NTOT) it = NTOT - 1;
        const int l = it / NTL; int r = it % NTL;
        if (r < NT0) prep_tile(INF(3) + (size_t)l * DM * 1216, DM, 1216, WSP(bf16, WS_WINT) + (size_t)l * ZW * DM, ZW, 1, r, tile, t256);
        else if ((r -= NT0) < NT1) prep_tile(INF(5) + (size_t)l * 256 * 768, 256, 768, WSP(bf16, WS_WUQT) + (size_t)l * 768 * 256, 768, 0, r, tile, t256);
        else if ((r -= NT1) < NT2) prep_tile(INF(7) + (size_t)l * 128 * 1024, 128, 1024, WSP(bf16, WS_WUKVT) + (size_t)l * 1024 * 128, 1024, 0, r, tile, t256);
        else if ((r -= NT2) < NT3) prep_tile(INF(18) + (size_t)l * 65536, 256, 256, WSP(bf16, WS_GLUT) + (size_t)l * 65536, 256, 0, r, tile, t256);
        else if ((r -= NT3) < NT4) prep_tile(INF(28) + (size_t)l * DM * DM, DM, DM, WSP(bf16, WS_WOUTT) + (size_t)l * DM * DM, DM, 0, r, tile, t256);
        else { r -= NT4; prep_tile(INF(30) + (size_t)l * DM * 2048, DM, 2048, WSP(bf16, WS_WQT) + (size_t)l * 2048 * DM, 2048, 0, r, tile, t256); }
    }
    for (int i = c.gt; i < NL * 65536; i += c.ngt) { const int l = i >> 16, e = i & 65535, r = e >> 8, cc = e & 255, pp = r >> 7, n = r & 127, p = cc >> 7, d = cc & 127;
        WSP(bf16, WS_SUBKT)[i] = (p == pp) ? f2bf(INF(31)[(size_t)l * 32768 + (pp * 128 + n) * 128 + d]) : (bf16)0; }
    { const size_t n4 = (size_t)NL * 16384 * DM / 4; const float4* u = (const float4*)a.in[32]; const float4* v = (const float4*)a.in[33]; uint2* pu = WSP(uint2, WS_PU); uint2* pv = WSP(uint2, WS_PV);
      for (size_t i = c.gt; i < n4; i += c.ngt) { const float4 x = u[i]; pu[i] = make_uint2(pk2(x.x, x.y), pk2(x.z, x.w)); const float4 y = v[i]; pv[i] = make_uint2(pk2(y.x, y.y), pk2(y.z, y.w)); } }
    for (int i = c.gt; i < T * 32; i += c.ngt) { const int t = i >> 5, j = i & 31;
        const float freq = exp2f(-(float)j * 0.41524101186092033f);
        const float ang = (float)((const int*)a.in[1])[t] * freq; float s, cs; sincos_acc(ang, s, cs);
        WSP(float, WS_COS)[i] = cs; WSP(float, WS_SIN)[i] = s; }
    for (int l = 0; l < NL; ++l)
        s5f::build_tables(INF(10) + l * 1024, INF(11) + l * 1024, INF(12) + l * 16, INF(13) + l * 16384, INF(14) + l * 16384, INF(15) + l * 16384, INF(16) + l * 16384,
                          WSP(bf16, WS_S5A) + (size_t)l * 32768, WSP(bf16, WS_S5C) + (size_t)l * 32768, WSP(float2, WS_S5L) + l * 1024, c.gt, c.ngt);
}

__device__ __forceinline__ void ph_rowprep(const Ctx& c, const float* x, const float* gain, bf16* XB) {
    for (int row = c.gw; row < T; row += c.ngw) {
        const float4* xr = (const float4*)(x + (size_t)row * DM) + c.lane;
        float4 v[4]; float ss = 0.f;
#pragma unroll
        for (int j = 0; j < 4; ++j) { v[j] = xr[64 * j]; ss += v[j].x * v[j].x + v[j].y * v[j].y + v[j].z * v[j].z + v[j].w * v[j].w; }
        const float rstd = rsqrtf(wave_sum(ss) * (1.f / DM) + EPS);
        uint2* o = (uint2*)(XB + (size_t)row * DM) + c.lane;
#pragma unroll
        for (int j = 0; j < 4; ++j) { const float4 g = ((const float4*)gain)[c.lane + 64 * j];
            o[64 * j] = make_uint2(pk2(v[j].x * rstd * g.x, v[j].y * rstd * g.y), pk2(v[j].z * rstd * g.z, v[j].w * rstd * g.w)); }
    }
}

enum { EPI_BF16 = 0, EPI_F32 = 1, EPI_GLU = 2, EPI_RESID = 3 };
template <int EPI> __device__ __forceinline__ void gemm_simple(const Ctx& c, const bf16* A, int lda, const bf16* Bt, int M, int N, int K, void* C, int ldc, const float* aux0, const bf16* aux1) {
    LAS float* As = (LAS float*)c.lds; LAS float* Bs = As + 16 * 132;
    const int tid = c.tid, tx = tid & 15, ty = tid >> 4, nN = N / 64, ntile = (M / 128) * nN;
    for (int tile = c.bid; tile < ntile; tile += c.G) {
        const int m0 = (tile / nN) * 128, n0 = (tile % nN) * 64;
        float acc[4][4];
#pragma unroll
        for (int i = 0; i < 4; ++i)
#pragma unroll
            for (int j = 0; j < 4; ++j) acc[i][j] = 0.f;
        const int lr = tid >> 2, lk = (tid & 3) * 4;
        for (int k0 = 0; k0 < K; k0 += 16) {
            { const uint2 w = *(const uint2*)(A + (size_t)(m0 + lr) * lda + k0 + lk);
              As[lk * 132 + lr] = __uint_as_float(w.x << 16); As[(lk + 1) * 132 + lr] = __uint_as_float(w.x & 0xffff0000u); As[(lk + 2) * 132 + lr] = __uint_as_float(w.y << 16); As[(lk + 3) * 132 + lr] = __uint_as_float(w.y & 0xffff0000u); }
            if (tid < 256) { const uint2 w = *(const uint2*)(Bt + (size_t)(n0 + lr) * K + k0 + lk);
              Bs[lk * 68 + lr] = __uint_as_float(w.x << 16); Bs[(lk + 1) * 68 + lr] = __uint_as_float(w.x & 0xffff0000u); Bs[(lk + 2) * 68 + lr] = __uint_as_float(w.y << 16); Bs[(lk + 3) * 68 + lr] = __uint_as_float(w.y & 0xffff0000u); }
            __syncthreads();
#pragma unroll
            for (int kk = 0; kk < 16; ++kk) {
                float av[4], bv[4];
#pragma unroll
                for (int i = 0; i < 4; ++i) { av[i] = As[kk * 132 + ty * 4 + i]; bv[i] = Bs[kk * 68 + tx * 4 + i]; }
#pragma unroll
                for (int i = 0; i < 4; ++i)
#pragma unroll
                    for (int j = 0; j < 4; ++j) acc[i][j] += av[i] * bv[j];
            }
            __syncthreads();
        }
#pragma unroll
        for (int i = 0; i < 4; ++i)
#pragma unroll
            for (int j = 0; j < 4; ++j) {
                const int row = m0 + ty * 4 + i, col = n0 + tx * 4 + j; const size_t ix = (size_t)row * ldc + col; const float v = acc[i][j];
                if (EPI == EPI_BF16) ((bf16*)C)[ix] = f2bf(v);
                else if (EPI == EPI_F32) ((float*)C)[ix] = v;
                else if (EPI == EPI_GLU) { const float yg = bf2f(aux1[ix]); ((bf16*)C)[ix] = f2bf(yg * sigmoid_f(v + aux0[col])); }
                else { ((float*)C)[ix] = aux0[ix] + v; }
            }
    }
}

__device__ __forceinline__ void ph_zstats(const Ctx& c, const bf16* Z, const float* qan, const float* kvan, bf16* CQN, bf16* CKVN) {
    for (int row = c.gw; row < T; row += c.ngw) {
        const bf16* zr = Z + (size_t)row * ZW; const int lane = c.lane;
        { const uint2 w = *(const uint2*)(zr + ZC_CQ + 4 * lane);
          float a0 = __uint_as_float(w.x << 16), a1 = __uint_as_float(w.x & 0xffff0000u), a2 = __uint_as_float(w.y << 16), a3 = __uint_as_float(w.y & 0xffff0000u);
          const float rstd = rsqrtf(wave_sum(a0 * a0 + a1 * a1 + a2 * a2 + a3 * a3) * (1.f / 256) + EPS);
          const float4 g = ((const float4*)qan)[lane];
          *(uint2*)(CQN + (size_t)row * 256 + 4 * lane) = make_uint2(pk2(a0 * rstd * g.x, a1 * rstd * g.y), pk2(a2 * rstd * g.z, a3 * rstd * g.w)); }
        { const u32 w = *(const u32*)(zr + ZC_CKV + 2 * lane);
          float a0 = __uint_as_float(w << 16), a1 = __uint_as_float(w & 0xffff0000u);
          const float rstd = rsqrtf(wave_sum(a0 * a0 + a1 * a1) * (1.f / 128) + EPS);
          const float2 g = ((const float2*)kvan)[lane];
          *(u32*)(CKVN + (size_t)row * 128 + 2 * lane) = pk2(a0 * rstd * g.x, a1 * rstd * g.y); }
    }
}

__device__ __forceinline__ void ph_qkfin(const Ctx& c, const bf16* QRAW, const bf16* KVRAW, const bf16* Z, const float* qn, const float* kn, const float* COS, const float* SIN, bf16* QB, bf16* KB, bf16* VB) {
    const int lane = c.lane;
    for (int w = c.gw; w < T * NH; w += c.ngw) {
        const int t = w >> 2, h = w & 3, b = t / SEQ, s = t % SEQ; const size_t bh = (size_t)b * NH + h;
        const float cs = COS[t * 32 + (lane & 31)], sn = SIN[t * 32 + (lane & 31)];
        {   const bf16* p = QRAW + (size_t)t * 768 + h * DQK;
            float v0 = bf2f(p[lane]), v1 = bf2f(p[lane + 64]), v2 = bf2f(p[lane + 128]);
            const float rstd = rsqrtf(wave_sum(v0 * v0 + v1 * v1 + v2 * v2) * (1.f / DQK) + EPS);
            v0 *= rstd * qn[lane]; v1 *= rstd * qn[lane + 64]; v2 *= rstd * qn[lane + 128];
            const float pr = __shfl_xor(v2, 32);
            const float r2 = (lane < 32) ? (v2 * cs - pr * sn) : (pr * sn + v2 * cs);
            bf16* o = QB + (bh * SEQ + s) * DQK;
            o[lane] = f2bf(v0 * QSCALE); o[lane + 64] = f2bf(v1 * QSCALE); o[lane + 128] = f2bf(r2 * QSCALE); }
        {   const bf16* p = KVRAW + (size_t)t * 1024 + h * 256;
            float v0 = bf2f(p[lane]), v1 = bf2f(p[lane + 64]), v2 = bf2f(Z[(size_t)t * ZW + ZC_KR + lane]);
            const float rstd = rsqrtf(wave_sum(v0 * v0 + v1 * v1 + v2 * v2) * (1.f / DQK) + EPS);
            v0 *= rstd * kn[lane]; v1 *= rstd * kn[lane + 64]; v2 *= rstd * kn[lane + 128];
            const float pr = __shfl_xor(v2, 32);
            const float r2 = (lane < 32) ? (v2 * cs - pr * sn) : (pr * sn + v2 * cs);
            bf16* o = KB + (bh * SEQ + s) * DQK;
            o[lane] = f2bf(v0); o[lane + 64] = f2bf(v1); o[lane + 128] = f2bf(r2);
            bf16* ov = VB + (bh * SEQ + s) * DV;
            ov[lane] = p[128 + lane]; ov[lane + 64] = p[192 + lane]; }
    }
}

__device__ __forceinline__ void ph_attn_simple(const Ctx& c, const bf16* QB, const bf16* KB, const bf16* VB, bf16* AO) {
    LAS float* qs = (LAS float*)c.lds + c.wave * DQK; const int lane = c.lane;
    for (int gq = c.gw; gq < NB * NH * SEQ; gq += c.ngw) {
        const int bh = gq / SEQ, q = gq % SEQ;
        const bf16* qp = QB + ((size_t)bh * SEQ + q) * DQK;
        qs[lane] = bf2f(qp[lane]); qs[lane + 64] = bf2f(qp[lane + 64]); qs[lane + 128] = bf2f(qp[lane + 128]);
        asm volatile("s_waitcnt lgkmcnt(0)" ::: "memory");
        float m = -1e30f, l = 0.f, o0 = 0.f, o1 = 0.f;
        const int ntile = q / 64 + 1;
        for (int kt = 0; kt < ntile; ++kt) {
            const int key = kt * 64 + lane;
            const uint4* kp = (const uint4*)(KB + ((size_t)bh * SEQ + key) * DQK);
            float sc = 0.f;
#pragma unroll 4
            for (int cc = 0; cc < 24; ++cc) { float kv[8]; unpack8(kp[cc], kv);
#pragma unroll
                for (int e = 0; e < 8; ++e) sc += kv[e] * qs[cc * 8 + e]; }
            if (key > q) sc = -INFINITY;
            const float mn = fmaxf(m, wave_max(sc));
            const float p = exp2f(sc - mn), al = exp2f(m - mn);
            l = l * al + wave_sum(p); o0 *= al; o1 *= al; m = mn;
            const u32* vp = (const u32*)(VB + ((size_t)bh * SEQ + kt * 64) * DV) + lane;
#pragma unroll 8
            for (int k = 0; k < 64; ++k) { const float pk = __shfl(p, k); const u32 w = vp[(size_t)k * (DV / 2)];
                o0 += pk * __uint_as_float(w << 16); o1 += pk * __uint_as_float(w & 0xffff0000u); }
        }
        const int b = bh / NH, h = bh % NH; const float il = 1.f / l;
        *(u32*)(AO + ((size_t)b * SEQ + q) * 512 + h * DV + 2 * lane) = pk2(o0 * il, o1 * il);
    }
}

__device__ __forceinline__ void ph_s5_simple(const Ctx& c, const bf16* Z, const float* a_re, const float* a_im, const float* log_dt, const float* b_re, const float* b_im,
                                             const float* c_re, const float* c_im, const float* dsk, bf16* YG) {
    for (int item = c.gw; item < NB * 16; item += c.ngw) {
        const int b = item >> 4, g = item & 15, p = c.lane;
        const float are = a_re[g * 64 + p], aim = a_im[g * 64 + p], dt = expf(log_dt[g]);
        const float mag = expf(are * dt); float sn, cs; sincos_acc(aim * dt, sn, cs);
        const float lre = mag * cs, lim = mag * sn;
        const float xr = lre - 1.f, xi = lim, den = are * are + aim * aim;
        const float cr = (xr * are + xi * aim) / den, ci = (xi * are - xr * aim) / den;
        float Bre[16], Bim[16], Cre[16], Cim[16];
#pragma unroll
        for (int k = 0; k < 16; ++k) { const float br = b_re[(g * 64 + p) * 16 + k], bi = b_im[(g * 64 + p) * 16 + k];
            Bre[k] = cr * br - ci * bi; Bim[k] = cr * bi + ci * br; Cre[k] = c_re[(g * 16 + k) * 64 + p]; Cim[k] = c_im[(g * 16 + k) * 64 + p]; }
        const float D = (p < 16) ? dsk[g * 16 + p] : 0.f;
        float hre = 0.f, him = 0.f;
        for (int s = 0; s < SEQ; ++s) {
            const bf16* up = Z + (size_t)(b * SEQ + s) * ZW + ZC_U + g * 16;
            float u[16]; unpack8(*(const uint4*)up, u); unpack8(*(const uint4*)(up + 8), u + 8);
            float bre = 0.f, bim = 0.f;
#pragma unroll
            for (int k = 0; k < 16; ++k) { bre += Bre[k] * u[k]; bim += Bim[k] * u[k]; }
            const float nre = lre * hre - lim * him + bre, nim = lre * him + lim * hre + bim; hre = nre; him = nim;
            float my = 0.f;
#pragma unroll
            for (int k = 0; k < 16; ++k) { const float v = wave_sum(Cre[k] * hre - Cim[k] * him); if (p == k) my = v + D * u[k]; }
            if (p < 16) YG[(size_t)(b * SEQ + s) * 256 + g * 16 + p] = f2bf(gelu_f(my));
        }
    }
}

__device__ __forceinline__ void ph_lru_xc(const Ctx& c, const bf16* Z, const float* cw, const float* cb, float* XC) {
    for (int i = c.gt; i < T * 256; i += c.ngt) { const int t = i >> 8, ch = i & 255, s = t % SEQ;
        float acc = cb[ch];
#pragma unroll
        for (int j = 0; j < 4; ++j) { const int ss = s - 3 + j; if (ss >= 0) acc += cw[j * 256 + ch] * bf2f(Z[(size_t)(t - 3 + j) * ZW + ZC_X + ch]); }
        XC[i] = acc; }
}
__device__ __forceinline__ void ph_lru_gates(const Ctx& c, const float* XC, const float* wa, const float* ba, const float* wx, const float* bx, const float* lam, float* AA, float* BT) {
    for (int i = c.gt; i < T * 256; i += c.ngt) { const int t = i >> 8, ch = i & 255, h = ch >> 6, j = ch & 63;
        const float* xr = XC + (size_t)t * 256 + h * 64;
        float ra = ba[ch], rx = bx[ch];
        for (int k = 0; k < 64; ++k) { const float xv = xr[k]; ra += xv * wa[(h * 64 + k) * 64 + j]; rx += xv * wx[(h * 64 + k) * 64 + j]; }
        const float r = sigmoid_f(ra), ig = sigmoid_f(rx);
        const float lsg = -log1pf(expf(-lam[ch]));
        const float la = 8.f * r * lsg, av = expf(la);
        AA[i] = av; BT[i] = sqrtf(-expm1f(2.f * la)) * (ig * XC[i]); }
}
__device__ __forceinline__ void ph_lru_scan(const Ctx& c, const float* AA, const float* BT, const bf16* Z, bf16* ROUT) {
    for (int item = c.gw; item < NB * 4; item += c.ngw) {
        const int i = item * 64 + c.lane, b = i >> 8, ch = i & 255;
        float h = 0.f;
#pragma unroll 8
        for (int s = 0; s < SEQ; ++s) { const size_t t = (size_t)b * SEQ + s;
            h = AA[t * 256 + ch] * h + BT[t * 256 + ch];
            ROUT[t * 256 + ch] = f2bf(h * gelu_f(bf2f(Z[t * ZW + ZC_G + ch]))); }
    }
}

__device__ __forceinline__ void ph_mixnorm(const Ctx& c, const bf16* AO, const bf16* SOUT, const bf16* ROUT, const float* g, bf16* Y) {
    const int lane = c.lane;
    for (int row = c.gw; row < T; row += c.ngw) {
        {   float v[8]; unpack8(*(const uint4*)(AO + (size_t)row * 512 + 8 * lane), v);
            float ss = 0.f;
#pragma unroll
            for (int e = 0; e < 8; ++e) ss += v[e] * v[e];
            const float rstd = rsqrtf(wave_sum(ss) * (1.f / 512) + EPS); const float* gg = g + 8 * lane;
            *(uint4*)(Y + (size_t)row * DM + 8 * lane) = make_uint4(pk2(v[0] * rstd * gg[0], v[1] * rstd * gg[1]), pk2(v[2] * rstd * gg[2], v[3] * rstd * gg[3]),
                                                                    pk2(v[4] * rstd * gg[4], v[5] * rstd * gg[5]), pk2(v[6] * rstd * gg[6], v[7] * rstd * gg[7])); }
#pragma unroll
        for (int part = 0; part < 2; ++part) {
            const bf16* src = part == 0 ? SOUT : ROUT; const int off = 512 + 256 * part;
            const uint2 w = *(const uint2*)(src + (size_t)row * 256 + 4 * lane);
            float a0 = __uint_as_float(w.x << 16), a1 = __uint_as_float(w.x & 0xffff0000u), a2 = __uint_as_float(w.y << 16), a3 = __uint_as_float(w.y & 0xffff0000u);
            const float rstd = rsqrtf(wave_sum(a0 * a0 + a1 * a1 + a2 * a2 + a3 * a3) * (1.f / 256) + EPS); const float* gg = g + off + 4 * lane;
            *(uint2*)(Y + (size_t)row * DM + off + 4 * lane) = make_uint2(pk2(a0 * rstd * gg[0], a1 * rstd * gg[1]), pk2(a2 * rstd * gg[2], a3 * rstd * gg[3]));
        }
    }
}

__device__ __forceinline__ void ph_topk_a(const Ctx& c, const float* SC, float* STOP, int* ITOP) {
    for (int i = c.gt; i < T * 16; i += c.ngt) {
        const float* sc = SC + (size_t)i * 128;
        float pv = INFINITY; int pn = -1;
        for (int it = 0; it < 16; ++it) {
            float bv = -INFINITY; int bn = 1 << 30;
            for (int n = 0; n < 128; ++n) { const float v = sc[n];
                const bool elig = (v < pv) || (v == pv && n > pn);
                if (elig && (v > bv || (v == bv && n < bn))) { bv = v; bn = n; } }
            STOP[(size_t)i * 16 + it] = bv; ITOP[(size_t)i * 16 + it] = bn; pv = bv; pn = bn;
        }
    }
}
__device__ __forceinline__ void ph_topk_b(const Ctx& c, const float* STOP, const int* ITOP, int* IDX, float* GATE) {
    LAS float* my = (LAS float*)c.lds + c.tid * 33;
    for (int i = c.gt; i < T * 8; i += c.ngt) {
        for (int k = 0; k < 32; ++k) my[k] = STOP[(size_t)i * 32 + k];
        float pv = INFINITY; int pn = -1; float best0 = 0.f, den = 0.f;
        float ev[16];
#pragma unroll
        for (int it = 0; it < 16; ++it) {
            float bv = -INFINITY; int bn = 1 << 30;
            for (int f = 0; f < 256; ++f) { const float v = my[f >> 4] + my[16 + (f & 15)];
                const bool elig = (v < pv) || (v == pv && f > pn);
                if (elig && (v > bv || (v == bv && f < bn))) { bv = v; bn = f; } }
            pv = bv; pn = bn;
            if (it == 0) best0 = bv;
            ev[it] = expf(bv - best0); den += ev[it];
            IDX[(size_t)i * 16 + it] = ITOP[(size_t)i * 32 + (bn >> 4)] * 128 + ITOP[(size_t)i * 32 + 16 + (bn & 15)];
        }
#pragma unroll
        for (int it = 0; it < 16; ++it) GATE[(size_t)i * 16 + it] = ev[it] / den;
    }
}

__device__ __forceinline__ void ph_gather(const Ctx& c, const bf16* HN, const int* IDX, const float* GATE, const bf16* PU, const bf16* PV, float* X) {
    const int lane = c.lane;
    for (int t = c.gw; t < T; t += c.ngw) {
        float hn[16]; unpack8(*(const uint4*)(HN + (size_t)t * DM + 8 * lane), hn); unpack8(*(const uint4*)(HN + (size_t)t * DM + 512 + 8 * lane), hn + 8);
        float y[16];
#pragma unroll
        for (int e = 0; e < 16; ++e) y[e] = 0.f;
        for (int k = 0; k < 128; ++k) {
            const int e = IDX[(size_t)t * 128 + k]; const float gt = GATE[(size_t)t * 128 + k];
            const bf16* ur = PU + (size_t)e * DM; const bf16* vr = PV + (size_t)e * DM;
            float u[16]; unpack8(*(const uint4*)(ur + 8 * lane), u); unpack8(*(const uint4*)(ur + 512 + 8 * lane), u + 8);
            float d = 0.f;
#pragma unroll
            for (int q = 0; q < 16; ++q) d += u[q] * hn[q];
            d = wave_sum(d);
            const float w = gt * gelu_f(d);
            float v[16]; unpack8(*(const uint4*)(vr + 8 * lane), v); unpack8(*(const uint4*)(vr + 512 + 8 * lane), v + 8);
#pragma unroll
            for (int q = 0; q < 16; ++q) y[q] += w * v[q];
        }
        float4* xo = (float4*)(X + (size_t)t * DM + 8 * lane);
        float4 p0 = xo[0], p1 = xo[1]; p0.x += y[0]; p0.y += y[1]; p0.z += y[2]; p0.w += y[3]; p1.x += y[4]; p1.y += y[5]; p1.z += y[6]; p1.w += y[7]; xo[0] = p0; xo[1] = p1;
        xo = (float4*)(X + (size_t)t * DM + 512 + 8 * lane);
        p0 = xo[0]; p1 = xo[1]; p0.x += y[8]; p0.y += y[9]; p0.z += y[10]; p0.w += y[11]; p1.x += y[12]; p1.y += y[13]; p1.z += y[14]; p1.w += y[15]; xo[0] = p0; xo[1] = p1;
    }
}
namespace att {
typedef short bf16x8 __attribute__((ext_vector_type(8)));
typedef short s16x4 __attribute__((ext_vector_type(4)));
typedef float f32x16 __attribute__((ext_vector_type(16)));
typedef unsigned u32x4 __attribute__((ext_vector_type(4)));
constexpr int KT = 64, KBYTES = KT * DQK * 2, VBYTES = KT * DV * 2, BUFB = KBYTES + VBYTES;
constexpr int OFF_WS = 2 * BUFB, OFF_MO = 0, OFF_ML = 65536, LDS_NEED = OFF_WS + 8 * 64 * 4;
constexpr float THR = 8.f;
__device__ __forceinline__ int kswz(int row, int c) { return row * 384 + (((c & ~7) | ((c & 7) ^ ((row >> 1) & 7))) << 4); }
__device__ __forceinline__ int v_st(int k, int c) { const int kk = (k & ~0xC) | ((k & 4) << 1) | ((k & 8) >> 1); return ((kk >> 3) * 4 + (c >> 5)) * 512 + ((kk & 7) * 32 + (c & 31)) * 2; }
__device__ __forceinline__ int v_rd_base(int lane) { return ((lane & 3) << 3) | (((lane >> 2) & 3) << 6) | (((lane >> 4) & 1) << 5) | (((lane >> 5) & 1) << 8); }
__device__ __forceinline__ int crow(int r, int hi) { return (r & 3) + 8 * (r >> 2) + 4 * hi; }
__device__ __forceinline__ unsigned cvtpk(float lo, float hi) { unsigned r; asm volatile("v_cvt_pk_bf16_f32 %0, %1, %2" : "=v"(r) : "v"(lo), "v"(hi)); return r; }
#define ATT_SBAR() __builtin_amdgcn_sched_barrier(0)

__device__ __forceinline__ void attn_unit(LAS unsigned char* lds, const bf16* Qg, const bf16* Kg, const bf16* Vg, bf16* AO, int bh, int qb, int tid) {
    const int lane = tid & 63, wid = __builtin_amdgcn_readfirstlane(tid >> 6), qsub = wid & 3, kh = wid >> 2, r32 = lane & 31, hi = lane >> 5;
    const int q0 = qb * 128, NT = 2 * (qb + 1);
    const size_t rowbase = (size_t)bh * SEQ;
    bf16x8 qr[12];
    { const bf16* qp = Qg + (rowbase + q0 + 32 * qsub + r32) * DQK + 8 * hi;
#pragma unroll
      for (int ks = 0; ks < 12; ++ks) qr[ks] = *(const bf16x8*)(qp + 16 * ks); }
    int ksrc[3], vsrc[2];
#pragma unroll
    for (int j = 0; j < 3; ++j) { const int L = (wid + 8 * j) * 64 + lane, row = L / 24, cp = L - row * 24, c = (cp & ~7) | ((cp & 7) ^ ((row >> 1) & 7)); ksrc[j] = row * DQK + c * 8; }
#pragma unroll
    for (int j = 0; j < 2; ++j) { const int X = ((wid + 8 * j) * 64 + lane) * 16, sub = X >> 9, within = (X & 511) >> 1, kk = ((sub >> 2) << 3) | (within >> 5);
        const int k = (kk & ~0xC) | ((kk & 4) << 1) | ((kk & 8) >> 1), c = (sub & 3) * 32 + (within & 31); vsrc[j] = k * DV + c; }
    const bf16* Kt = Kg + rowbase * DQK; const bf16* Vt = Vg + rowbase * DV;
#define ATT_STAGE(t, bo) do { const bf16* kp_ = Kt + (size_t)(t) * (KT * DQK); const bf16* vp_ = Vt + (size_t)(t) * (KT * DV); \
        _Pragma("unroll") for (int j_ = 0; j_ < 3; ++j_) __builtin_amdgcn_global_load_lds((const unsigned*)(kp_ + ksrc[j_]), (LAS unsigned*)(lds + (bo) + (wid + 8 * j_) * 1024), 16, 0, 0); \
        _Pragma("unroll") for (int j_ = 0; j_ < 2; ++j_) __builtin_amdgcn_global_load_lds((const unsigned*)(vp_ + vsrc[j_]), (LAS unsigned*)(lds + (bo) + KBYTES + (wid + 8 * j_) * 1024), 16, 0, 0); } while (0)
    const int krow = 32 * kh + r32, kf = (krow >> 1) & 7;
    int kb[4];
#pragma unroll
    for (int j = 0; j < 4; ++j) kb[j] = krow * 384 + ((((2 * j + hi) & 7) ^ kf) << 4);
    const int vb = KBYTES + v_rd_base(lane) + kh * 8192;
    LAS float* wsf = (LAS float*)(lds + OFF_WS) + wid * 64;
    float m_reg = -1e30f, l_reg = 0.f; f32x16 o[4];
#pragma unroll
    for (int d = 0; d < 4; ++d) o[d] = f32x16{};
    const int rb = 32 * qsub;
    ATT_STAGE(0, 0);
    asm volatile("s_waitcnt vmcnt(0)" ::: "memory");
    __syncthreads();
    for (int t = 0; t < NT; ++t) {
        const int bo = (t & 1) * BUFB;
        if (t + 1 < NT) ATT_STAGE(t + 1, BUFB - bo);
        const int kboff = 64 * t + 32 * kh - q0;
        const bool act = kboff <= rb, diag = kboff == rb;
        if (act) {
            f32x16 p = f32x16{};
#pragma unroll
            for (int ks = 0; ks < 12; ++ks) {
                const bf16x8 kfr = *(const LAS bf16x8*)(lds + bo + kb[ks & 3] + (ks >> 2) * 128);
                p = __builtin_amdgcn_mfma_f32_32x32x16_bf16(kfr, qr[ks], p, 0, 0, 0);
            }
            if (diag) {
#pragma unroll
                for (int r = 0; r < 16; ++r) if (crow(r, hi) > r32) p[r] = -__builtin_inff();
            }
            float pmax = p[0];
#pragma unroll
            for (int r = 1; r < 16; ++r) pmax = fmaxf(pmax, p[r]);
            { auto rr = __builtin_amdgcn_permlane32_swap(__float_as_uint(pmax), __float_as_uint(pmax), false, false);
              pmax = fmaxf(__uint_as_float(rr[0]), __uint_as_float(rr[1])); }
            float alpha = 1.f;
            if (!__all(pmax - m_reg <= THR)) { const float mn = fmaxf(m_reg, pmax); alpha = __builtin_amdgcn_exp2f(m_reg - mn); m_reg = mn; }
#pragma unroll
            for (int r = 0; r < 16; ++r) p[r] = __builtin_amdgcn_exp2f(p[r] - m_reg);
            float ps = 0.f;
#pragma unroll
            for (int r = 0; r < 16; ++r) ps += p[r];
            { auto rr = __builtin_amdgcn_permlane32_swap(__float_as_uint(ps), __float_as_uint(ps), false, false);
              ps = __uint_as_float(rr[0]) + __uint_as_float(rr[1]); }
            l_reg = l_reg * alpha + ps;
            if (__any(alpha < 1.f)) {
                if (hi == 0) wsf[r32] = alpha;
                asm volatile("s_waitcnt lgkmcnt(0)" ::: "memory");
#pragma unroll
                for (int r = 0; r < 16; ++r) { const float al = wsf[crow(r, hi)];
#pragma unroll
                    for (int d = 0; d < 4; ++d) o[d][r] *= al; }
            }
            bf16x8 pa0, pa1;
#define ATT_PK4(B_, OUT) do { unsigned a0 = cvtpk(p[B_ + 0], p[B_ + 1]), a1 = cvtpk(p[B_ + 2], p[B_ + 3]); unsigned b0 = cvtpk(p[B_ + 4], p[B_ + 5]), b1 = cvtpk(p[B_ + 6], p[B_ + 7]); \
            auto r0 = __builtin_amdgcn_permlane32_swap(a0, b0, false, false); auto r1 = __builtin_amdgcn_permlane32_swap(a1, b1, false, false); \
            u32x4 w_ = {r0[0], r1[0], r0[1], r1[1]}; OUT = __builtin_bit_cast(bf16x8, w_); } while (0)
            ATT_PK4(0, pa0); ATT_PK4(8, pa1);
#undef ATT_PK4
            const int vaddr = (int)(uintptr_t)lds + bo + vb;
#define ATT_TRRD(dst, off) asm volatile("ds_read_b64_tr_b16 %0, %1 offset:%2" : "=&v"(dst) : "v"(vaddr), "i"(off) : "memory")
#define ATT_PV(d0) do { s16x4 l0, h0, l1, h1; \
            ATT_TRRD(l0, (d0) * 512); ATT_TRRD(h0, (d0) * 512 + 2048); ATT_TRRD(l1, (d0) * 512 + 4096); ATT_TRRD(h1, (d0) * 512 + 6144); \
            asm volatile("s_waitcnt lgkmcnt(0)" ::: "memory"); ATT_SBAR(); \
            o[d0] = __builtin_amdgcn_mfma_f32_32x32x16_bf16(pa0, (bf16x8){l0[0], l0[1], l0[2], l0[3], h0[0], h0[1], h0[2], h0[3]}, o[d0], 0, 0, 0); \
            o[d0] = __builtin_amdgcn_mfma_f32_32x32x16_bf16(pa1, (bf16x8){l1[0], l1[1], l1[2], l1[3], h1[0], h1[1], h1[2], h1[3]}, o[d0], 0, 0, 0); } while (0)
            ATT_PV(0); ATT_PV(1); ATT_PV(2); ATT_PV(3);
#undef ATT_PV
#undef ATT_TRRD
        }
        asm volatile("s_waitcnt vmcnt(0)" ::: "memory");
        __syncthreads();
    }
    LAS float* MO = (LAS float*)(lds + OFF_MO) + qsub * 4096; LAS float* ML = (LAS float*)(lds + OFF_ML) + qsub * 64;
    if (kh == 1) {
        if (hi == 0) { ML[2 * r32] = m_reg; ML[2 * r32 + 1] = l_reg; }
#pragma unroll
        for (int d = 0; d < 4; ++d)
#pragma unroll
            for (int r = 0; r < 16; ++r) MO[(d * 16 + r) * 64 + lane] = o[d][r];
    }
    __syncthreads();
    if (kh == 0) {
        const float m1 = ML[2 * r32], l1 = ML[2 * r32 + 1];
        const float mm = fmaxf(m_reg, m1), f0 = __builtin_amdgcn_exp2f(m_reg - mm), f1 = __builtin_amdgcn_exp2f(m1 - mm);
        const float il = 1.f / (l_reg * f0 + l1 * f1);
        if (hi == 0) { wsf[r32] = f0 * il; wsf[32 + r32] = f1 * il; }
        asm volatile("s_waitcnt lgkmcnt(0)" ::: "memory");
        const int b = bh / NH, h = bh % NH;
        bf16* Ow = AO + ((size_t)b * SEQ + q0 + rb) * 512 + h * DV;
#pragma unroll
        for (int r = 0; r < 16; ++r) { const int orow = crow(r, hi); const float g0 = wsf[orow], g1 = wsf[32 + orow];
#pragma unroll
            for (int d = 0; d < 4; ++d) { const float v = o[d][r] * g0 + MO[(d * 16 + r) * 64 + lane] * g1; const float vn = __shfl_xor(v, 1);
                if ((r32 & 1) == 0) *(unsigned*)(Ow + (size_t)orow * 512 + d * 32 + r32) = cvtpk(v, vn); } }
    }
    __syncthreads();
#undef ATT_STAGE
}
__device__ __forceinline__ void attn_phase(LAS unsigned char* lds, const bf16* Qg, const bf16* Kg, const bf16* Vg, bf16* AO, int G, int bid, int tid) {
    const int npair = NB * NH * 32;
    for (int v0 = bid; v0 < npair; v0 += G) {
        const int vcu = (G % 8 == 0 && npair % G == 0) ? (v0 % 8) * (npair / 8) + v0 / 8 : v0;
        const int bh = vcu >> 5, s = vcu & 31;
        for (int u = 0; u < 2; ++u) attn_unit(lds, Qg, Kg, Vg, AO, bh, u ? s : 63 - s, tid);
    }
}
#undef ATT_SBAR
}
#ifndef MK_SIMPLE_SCAN
#define MK_SIMPLE_SCAN 0
#endif
#ifndef MK_SIMPLE_ATTN
#define MK_SIMPLE_ATTN 0
#endif
#ifndef MK_SIMPLE_GEMM
#define MK_SIMPLE_GEMM 0
#endif
constexpr int NPH_LAYER = 16, NPH = 1 + NL * NPH_LAYER;
struct GD { const bf16* A; const bf16* Bt; void* C; const float* aux0; const bf16* aux1; int lda, M, N, K, ldc, kind; };
template <class Epi> __device__ __forceinline__ void run_gemm(const Ctx& c, const bf16* A, int lda, const bf16* Bt, int M, int N, int K, const Epi& E) {
    pg8::Gemm g{A, Bt, M, N, K, lda}; pg8::StaticOrder S; S.init(M, N, c.G, c.bid);
    pg8::gemm_phase<Epi, pg8::StaticOrder, true, true>(c.lds, g, S, E);
}
#define AS4 __attribute__((address_space(4)))
__global__ void __launch_bounds__(NTHR, 2) mega(Args a_) {
    extern __shared__ __attribute__((aligned(16))) unsigned char lds_raw[];
    {   const int t0 = threadIdx.x;
        for (int u = t0; u < (LDS_BYTES - RING_BYTES) / 4; u += NTHR) ((LAS unsigned*)((LAS unsigned char*)lds_raw + RING_BYTES))[u] = 0u; }
    __syncthreads();
    volatile LAS unsigned* MISC = (volatile LAS unsigned*)((LAS unsigned char*)lds_raw + MISC_OFF);
    XcdBarrier bar; bar.bar = (unsigned*)(a_.ws + WS_CTL) + CW_BAR; bar.x = 0; bar.st = MISC + 8;
    const int ph_lo = a_.ph_lo, ph_hi = a_.ph_hi;
    if (ph_hi - ph_lo > 1) bar = xcd_barrier_post((unsigned*)(a_.ws + WS_CTL) + CW_BAR, MISC + 8);

    int p = ph_lo;
    if (p == 0) {
        const Args AS4* ap0 = (const Args AS4*)__builtin_amdgcn_kernarg_segment_ptr(); Ctx c0; c0.lds = (LAS unsigned char*)lds_raw; c0.tid = threadIdx.x; c0.lane = c0.tid & 63; c0.wave = __builtin_amdgcn_readfirstlane(c0.tid >> 6);
        c0.G = gridDim.x; c0.bid = blockIdx.x; c0.gw = c0.wave * c0.G + c0.bid; c0.ngw = NWAVES * c0.G; c0.gt = c0.bid * NTHR + c0.tid; c0.ngt = c0.G * NTHR;
        ph_prep(*ap0, c0);
        if (p + 1 < ph_hi) xcd_barrier(bar);
        p = 1;
    }
    for (; p < ph_hi; ++p) {
        const Args AS4* ap = (const Args AS4*)__builtin_amdgcn_kernarg_segment_ptr(); asm volatile("" : "+s"(ap));
        int tid_ = threadIdx.x; asm volatile("" : "+v"(tid_));
#define a (*ap)
        Ctx c; c.lds = (LAS unsigned char*)lds_raw; c.tid = tid_; c.lane = c.tid & 63; c.wave = __builtin_amdgcn_readfirstlane(c.tid >> 6);
        { int G_ = gridDim.x, bid_ = blockIdx.x; asm volatile("" : "+s"(G_), "+s"(bid_)); c.G = G_; c.bid = bid_; }
        c.gw = c.wave * c.G + c.bid; c.ngw = NWAVES * c.G; c.gt = c.bid * NTHR + c.tid; c.ngt = c.G * NTHR;
        bf16 *WINT = WSP(bf16, WS_WINT), *WUQT = WSP(bf16, WS_WUQT), *WUKVT = WSP(bf16, WS_WUKVT), *GLUT = WSP(bf16, WS_GLUT), *WOUTT = WSP(bf16, WS_WOUTT),
             *WQT = WSP(bf16, WS_WQT), *SUBKT = WSP(bf16, WS_SUBKT), *PU = WSP(bf16, WS_PU), *PV = WSP(bf16, WS_PV);
        float *COS = WSP(float, WS_COS), *SIN = WSP(float, WS_SIN);
        bf16 *XB = WSP(bf16, WS_XB), *Z = WSP(bf16, WS_Z), *QRAW = WSP(bf16, WS_QRAW), *KVRAW = WSP(bf16, WS_KVRAW), *QB = WSP(bf16, WS_QB), *KB = WSP(bf16, WS_KB),
             *VB = WSP(bf16, WS_VB), *CQN = WSP(bf16, WS_CQN), *CKVN = WSP(bf16, WS_CKVN), *AO = WSP(bf16, WS_AO), *ROUT = WSP(bf16, WS_ROUT), *Y = WSP(bf16, WS_Y),
             *YG = WSP(bf16, WS_YG), *SOUT = WSP(bf16, WS_SOUT), *QP = WSP(bf16, WS_QP);
        float *XC = WSP(float, WS_XC), *AA = WSP(float, WS_AA), *BT = WSP(float, WS_BT), *SC = WSP(float, WS_SC), *STOP = WSP(float, WS_STOP), *GATE = WSP(float, WS_GATE);
        int *ITOP = WSP(int, WS_ITOP), *IDX = WSP(int, WS_IDX);
        float* out = a.out;
        {
            const int l = (p - 1) / NPH_LAYER, k = (p - 1) % NPH_LAYER;
            const float* xin = (l == 0) ? INF(0) : out;
            GD gd; gd.kind = 0; gd.A = nullptr; gd.Bt = nullptr; gd.C = nullptr; gd.aux0 = nullptr; gd.aux1 = nullptr; gd.lda = 0; gd.M = T; gd.N = 0; gd.K = 0; gd.ldc = 0;
#define SETG(kind_, A_, lda_, Bt_, M_, N_, K_, C_, ldc_, aux0_, aux1_) do { gd.kind = kind_; gd.A = A_; gd.lda = lda_; gd.Bt = Bt_; gd.M = M_; gd.N = N_; gd.K = K_; gd.C = (void*)(C_); gd.ldc = ldc_; gd.aux0 = aux0_; gd.aux1 = aux1_; } while (0)
            switch (k) {
            case 0: ph_rowprep(c, xin, INF(2) + l * DM, XB); break;
            case 1: SETG(1, XB, DM, WINT + (size_t)l * ZW * DM, T, ZW, DM, Z, ZW, nullptr, nullptr); break;
            case 2: ph_zstats(c, Z, INF(4) + l * 256, INF(6) + l * 128, CQN, CKVN);
#if MK_SIMPLE_SCAN
                ph_lru_xc(c, Z, INF(20) + l * 1024, INF(21) + l * 256, XC);
#else
                s5f::pass<false>(c.lds, Z, WSP(bf16, WS_S5A) + (size_t)l * 32768, WSP(bf16, WS_S5C) + (size_t)l * 32768, WSP(float2, WS_S5L) + l * 1024, INF(17) + l * 256, WSP(float2, WS_SE), WSP(float2, WS_SH), YG, c.gw, c.ngw, c.wave, c.lane);
                __syncthreads();
                lruf::pass_a(c.lds, Z, INF(20) + l * 1024, INF(21) + l * 256, INF(22) + l * 16384, INF(23) + l * 256, INF(24) + l * 16384, INF(25) + l * 256, INF(26) + l * 256, AA, BT, WSP(float2, WS_LPE), c.gw, c.ngw, c.wave, c.lane);
#endif
                break;
            case 3: SETG(1, CQN, 256, WUQT + (size_t)l * 768 * 256, T, 768, 256, QRAW, 768, nullptr, nullptr);
#if !MK_SIMPLE_SCAN
                s5f::carry(WSP(float2, WS_S5L) + l * 1024, WSP(float2, WS_SE), WSP(float2, WS_SH), c.gw, c.ngw, c.lane);
                lruf::carry(WSP(float2, WS_LPE), WSP(float, WS_LH), c.gt, c.ngt);
#endif
                break;
            case 4: SETG(1, CKVN, 128, WUKVT + (size_t)l * 1024 * 128, T, 1024, 128, KVRAW, 1024, nullptr, nullptr);
#if MK_SIMPLE_SCAN
                ph_lru_gates(c, XC, INF(22) + l * 16384, INF(23) + l * 256, INF(24) + l * 16384, INF(25) + l * 256, INF(26) + l * 256, AA, BT);
#endif
                break;
            case 5: ph_qkfin(c, QRAW, KVRAW, Z, INF(8) + l * DQK, INF(9) + l * DQK, COS, SIN, QB, KB, VB); break;
            case 6:
#if MK_SIMPLE_SCAN
                ph_s5_simple(c, Z, INF(10) + l * 1024, INF(11) + l * 1024, INF(12) + l * 16, INF(13) + l * 16384, INF(14) + l * 16384, INF(15) + l * 16384, INF(16) + l * 16384, INF(17) + l * 256, YG);
                ph_lru_scan(c, AA, BT, Z, ROUT);
#else
                s5f::pass<true>(c.lds, Z, WSP(bf16, WS_S5A) + (size_t)l * 32768, WSP(bf16, WS_S5C) + (size_t)l * 32768, WSP(float2, WS_S5L) + l * 1024, INF(17) + l * 256, WSP(float2, WS_SE), WSP(float2, WS_SH), YG, c.gw, c.ngw, c.wave, c.lane);
                lruf::pass_b(AA, BT, WSP(float, WS_LH), Z, ROUT, c.gt, c.ngt);
#endif
#if MK_SIMPLE_ATTN
                ph_attn_simple(c, QB, KB, VB, AO);
#else
                __syncthreads(); att::attn_phase(c.lds, QB, KB, VB, AO, c.G, c.bid, c.tid);
#endif
                break;
            case 7: SETG(3, YG, 256, GLUT + (size_t)l * 65536, T, 256, 256, SOUT, 256, INF(19) + l * 256, YG); break;
            case 8: ph_mixnorm(c, AO, SOUT, ROUT, INF(27) + l * DM, Y); break;
            case 9: SETG(2, Y, DM, WOUTT + (size_t)l * DM * DM, T, DM, DM, out, DM, xin, nullptr); break;
            case 10: ph_rowprep(c, out, INF(29) + l * DM, XB); break;
            case 11: SETG(1, XB, DM, WQT + (size_t)l * 2048 * DM, T, 2048, DM, QP, 2048, nullptr, nullptr); break;
            case 12: SETG(2, QP, 256, SUBKT + (size_t)l * 65536, T * 8, 256, 256, SC, 256, nullptr, nullptr); break;
            case 13: ph_topk_a(c, SC, STOP, ITOP); break;
            case 14: ph_topk_b(c, STOP, ITOP, IDX, GATE); break;
            default: ph_gather(c, XB, IDX, GATE, PU + (size_t)l * 16384 * DM, PV + (size_t)l * 16384 * DM, out); break;
            }
#undef SETG
#if MK_SIMPLE_GEMM
            if (gd.kind == 1) gemm_simple<EPI_BF16>(c, gd.A, gd.lda, gd.Bt, gd.M, gd.N, gd.K, gd.C, gd.ldc, nullptr, nullptr);
            else if (gd.kind == 2) { if (gd.aux0) gemm_simple<EPI_RESID>(c, gd.A, gd.lda, gd.Bt, gd.M, gd.N, gd.K, gd.C, gd.ldc, gd.aux0, nullptr); else gemm_simple<EPI_F32>(c, gd.A, gd.lda, gd.Bt, gd.M, gd.N, gd.K, gd.C, gd.ldc, nullptr, nullptr); }
            else if (gd.kind == 3) gemm_simple<EPI_GLU>(c, gd.A, gd.lda, gd.Bt, gd.M, gd.N, gd.K, gd.C, gd.ldc, gd.aux0, gd.aux1);
#else
            if (gd.kind == 1) run_gemm(c, gd.A, gd.lda, gd.Bt, gd.M, gd.N, gd.K, pg8::EpiBf16<0>{(bf16*)gd.C, gd.ldc, nullptr, 0, 0, 1.f});
            else if (gd.kind == 2) run_gemm(c, gd.A, gd.lda, gd.Bt, gd.M, gd.N, gd.K, pg8::EpiF32{(float*)gd.C, gd.ldc, gd.aux0});
            else if (gd.kind == 3) run_gemm(c, gd.A, gd.lda, gd.Bt, gd.M, gd.N, gd.K, pg8::EpiGlu{(bf16*)gd.C, gd.ldc, gd.aux0, gd.aux1});
#endif
        }
        if (p + 1 < ph_hi) { XcdBarrier b2 = bar; unsigned* bb = (unsigned*)(a.ws + WS_CTL) + CW_BAR; unsigned bx = bar.x; asm volatile("" : "+s"(bb), "+s"(bx)); b2.bar = bb; b2.x = bx; xcd_barrier(b2); }
#undef a
    }
}

extern "C" void kernel_launch(void* const* d_in, const int* in_sizes, int n_in, void* d_out, int out_size, void* d_ws, size_t ws_size, hipStream_t stream) {
    static int grid = 0;
    if (grid == 0) {
        if (n_in != 34 || out_size != T * DM || ws_size < WS_END) { fprintf(stderr, "kernel_launch: unexpected shapes (n_in %d out %d ws %zu)\n", n_in, out_size, ws_size); grid = -1; return; }
        int dev = 0, cus = 0, per_cu = 0;
        if (hipGetDevice(&dev) != hipSuccess || hipDeviceGetAttribute(&cus, hipDeviceAttributeMultiprocessorCount, dev) != hipSuccess) { grid = -1; return; }
        if (hipFuncSetAttribute((const void*)mega, hipFuncAttributeMaxDynamicSharedMemorySize, LDS_BYTES) != hipSuccess) { fprintf(stderr, "kernel_launch: hipFuncSetAttribute failed\n"); grid = -1; return; }
        if (hipOccupancyMaxActiveBlocksPerMultiprocessor(&per_cu, (const void*)mega, NTHR, LDS_BYTES) != hipSuccess || per_cu < 1) { fprintf(stderr, "kernel_launch: occupancy query says %d blocks per CU\n", per_cu); }
        (void)hipGetLastError();
        grid = cus;
    }
    if (grid < 0) return;
    (void)hipMemsetAsync((char*)d_ws + WS_CTL, 0, CTL_ZERO_BYTES, stream);
    Args a{};
    for (int i = 0; i < 34; ++i) a.in[i] = d_in[i];
    a.out = (float*)d_out; a.ws = (unsigned char*)d_ws;
#if MK_PER_PHASE
    for (int p = 0; p < NPH; ++p) { a.ph_lo = p; a.ph_hi = p + 1; hipLaunchKernelGGL(mega, dim3(grid), dim3(NTHR), LDS_BYTES, stream, a); }
#else
    a.ph_lo = 0; a.ph_hi = NPH;
    hipLaunchKernelGGL(mega, dim3(grid), dim3(NTHR), LDS_BYTES, stream, a);
#endif
}
```

```cpp
#include <hip/hip_runtime.h>
#include <cstdint>
#include <cstdio>

#ifndef MK_PER_PHASE
#define MK_PER_PHASE 0
#endif

typedef unsigned short bf16;
typedef unsigned int u32;

constexpr int NB = 2, SEQ = 8192, T = NB * SEQ, DM = 1024, NL = 2;
constexpr int ZW = 1280;
constexpr int ZC_CQ = 0, ZC_CKV = 256, ZC_KR = 384, ZC_U = 512, ZC_X = 768, ZC_G = 1024;
constexpr int NH = 4, DQK = 192, DV = 128;
constexpr float EPS = 1e-6f;
constexpr float QSCALE = 0.07216878364870322f * 1.4426950408889634f;

constexpr size_t MiB = 1u << 20;
constexpr size_t WS_CTL = 0, CTL_ZERO_BYTES = 1 * MiB, WS_WINT = 1 * MiB, WS_WUQT = 7 * MiB, WS_WUKVT = 8 * MiB, WS_GLUT = 9 * MiB, WS_WOUTT = 10 * MiB,
                 WS_WQT = 14 * MiB, WS_SUBKT = 22 * MiB, WS_COS = 23 * MiB, WS_SIN = 25 * MiB, WS_PU = 28 * MiB, WS_PV = 92 * MiB,
                 WS_XB = 156 * MiB, WS_Z = 188 * MiB, WS_RA = 228 * MiB, WS_RB = 356 * MiB, WS_CKVN = 420 * MiB, WS_AO = 424 * MiB,
                 WS_ROUT = 440 * MiB, WS_Y = 448 * MiB, WS_IDX = 480 * MiB, WS_GATE = 488 * MiB, WS_S5A = 496 * MiB, WS_S5C = WS_S5A + 128 * 1024, WS_S5L = WS_S5A + 256 * 1024,
                 WS_SE = 497 * MiB, WS_SH = 501 * MiB, WS_LPE = 505 * MiB, WS_LH = 506 * MiB, WS_END = 507 * MiB;
constexpr size_t WS_QRAW = WS_RA, WS_KVRAW = WS_RA + 24 * MiB, WS_QB = WS_RA + 56 * MiB, WS_KB = WS_RA + 80 * MiB, WS_VB = WS_RA + 104 * MiB,
                 WS_CQN = WS_RA + 120 * MiB, WS_SC = WS_RA;
constexpr size_t WS_XC = WS_RB, WS_AA = WS_RB + 16 * MiB, WS_BT = WS_RB + 32 * MiB, WS_YG = WS_RB + 48 * MiB, WS_SOUT = WS_RB + 56 * MiB, WS_QP = WS_RB;
constexpr size_t WS_STOP = WS_Z, WS_ITOP = WS_Z + 16 * MiB;
constexpr int CW_BAR = 4096;

__device__ __forceinline__ float bf2f(bf16 h) { return __uint_as_float((u32)h << 16); }
__device__ __forceinline__ bf16 f2bf(float f) { u32 u = __float_as_uint(f); return (bf16)((u + 0x7fffu + ((u >> 16) & 1u)) >> 16); }
__device__ __forceinline__ u32 pk2(float lo, float hi) { return (u32)f2bf(lo) | ((u32)f2bf(hi) << 16); }
__device__ __forceinline__ float wave_sum(float v) {
#pragma unroll
    for (int o = 32; o > 0; o >>= 1) v += __shfl_xor(v, o);
    return v;
}
__device__ __forceinline__ float wave_max(float v) {
#pragma unroll
    for (int o = 32; o > 0; o >>= 1) v = fmaxf(v, __shfl_xor(v, o));
    return v;
}
__device__ __forceinline__ float gelu_f(float x) { return 0.5f * x * (1.f + erff(x * 0.70710678118654752f)); }
__device__ __forceinline__ float sigmoid_f(float x) { return 1.f / (1.f + __expf(-x)); }
__device__ __forceinline__ void unpack8(uint4 w, float* o) {
    o[0] = __uint_as_float(w.x << 16); o[1] = __uint_as_float(w.x & 0xffff0000u);
    o[2] = __uint_as_float(w.y << 16); o[3] = __uint_as_float(w.y & 0xffff0000u);
    o[4] = __uint_as_float(w.z << 16); o[5] = __uint_as_float(w.z & 0xffff0000u);
    o[6] = __uint_as_float(w.w << 16); o[7] = __uint_as_float(w.w & 0xffff0000u);
}
__device__ __forceinline__ void sincos_acc(float x, float& s, float& c) {
    const float k = rintf(x * 0.15915494309189535f);
    float r = fmaf(-k, 6.28125f, x);
    r = fmaf(-k, 1.9350051879882812e-3f, r);
    r = fmaf(-k, 3.0199160335e-7f, r);
    const float f = r * 0.15915494309189535f;
    s = __builtin_amdgcn_sinf(f); c = __builtin_amdgcn_cosf(f);
}
namespace pg8 {
#define PG8_LAS __attribute__((address_space(3)))
typedef unsigned short bf16_t;
typedef short bf16x8 __attribute__((ext_vector_type(8)));
typedef float f32x4 __attribute__((ext_vector_type(4)));
typedef unsigned u32x4 __attribute__((ext_vector_type(4)));
constexpr int BM = 256, BK = 64, HALF = 128, HTB = HALF * BK * 2  , STAGE_BYTES = 8 * HTB, NXCD = 8, WGM = 8;

__host__ __device__ __forceinline__ int lds_byte(int r, int c) { const int st = (r >> 4) * 2 + (c >> 5), rr = r & 15, cc = c & 31, ob = rr * 64 + cc * 2; return st * 1024 + (ob ^ (((ob >> 9) & 1) << 5)); }
__host__ __device__ __forceinline__ void stage_rc(int b, int& R, int& C) { const int st = b / 1024, sb = b % 1024, swz = sb ^ (((sb >> 9) & 1) << 5); R = (st >> 1) * 16 + swz / 64; C = (st & 1) * 32 + (swz % 64) / 2; }
__host__ __device__ __forceinline__ int perm32(int rho) { const int n = rho >> 4, i = rho & 15; return 8 * (i >> 2) + 4 * n + (i & 3); }

struct Unit { int pm, pn; };
struct Gemm { const bf16_t* A; const bf16_t* Bt; int M, N, K, lda; };

struct StaticOrder {
    int nM, nN, nwg, G, c;
    __host__ __device__ void init(int M, int N, int G_, int c_) { nM = M / BM; nN = N / BM; nwg = nM * nN; G = G_; c = c_; }
    __host__ __device__ bool next(int i, Unit& u) const {
        const long L = (long)i * G + c; if (L >= nwg) return false;
        int wgid = (int)L; { const int q = nwg / NXCD, r = nwg % NXCD, xcd = wgid % NXCD, off = wgid / NXCD; wgid = (xcd < r ? xcd * (q + 1) : r * (q + 1) + (xcd - r) * q) + off; }
        const int nig = WGM * nN, gid = wgid / nig, fm = gid * WGM, gsz = (nM - fm) < WGM ? (nM - fm) : WGM;
        u.pm = fm + ((wgid % nig) % gsz); u.pn = (wgid % nig) / gsz; return true;
    }
    __device__ __forceinline__ void a_ready(const Unit&) const {}
    __device__ __forceinline__ void done(const Unit&) const {}
};

__device__ __forceinline__ unsigned cvt_pk_bf16(float lo, float hi) { unsigned r; asm volatile("v_cvt_pk_bf16_f32 %0, %1, %2" : "=v"(r) : "v"(lo), "v"(hi)); return r; }
typedef float f32x2 __attribute__((ext_vector_type(2)));
__device__ __forceinline__ f32x2 gelu_pk(f32x2 v) {
    const f32x2 av = __builtin_elementwise_abs(v), d = av * 0.2316418882f + 1.0f;
    f32x2 t; t.x = __builtin_amdgcn_rcpf(d.x); t.y = __builtin_amdgcn_rcpf(d.y);
    f32x2 q = t * 0.5307027145f + (-0.7265760135f); q = q * t + 0.7107068705f; q = q * t + (-0.142248368f); q = q * t + 0.127414796f; q = q * t;
    const f32x2 s = (v * v) * (-0.72134752044f);
    f32x2 e; e.x = __builtin_amdgcn_exp2f(s.x); e.y = __builtin_amdgcn_exp2f(s.y);
    const f32x2 m = v * (q * e), r = v - m;
    f32x2 o; o.x = v.x < 0.f ? m.x : r.x; o.y = v.y < 0.f ? m.y : r.y; return o;
}

template <int ACT  > struct EpiBf16 {
    static constexpr bool PERM = true, AFTER_DRAIN = false; static_assert(ACT == 0 || ACT == 1, "EpiBf16: ACT is 0 (none) or 1 (gelu_pk)");
    bf16_t* O; int ldc; const float* bias; int split_cols; size_t split_stride; float scale0;
    __device__ __forceinline__ void operator()(const f32x4 (&acc)[2][2][4][2], const Unit& u, int wr, int wc, int fr, int fq) const {
        const int row0 = u.pm * BM + wr * 64 + fr; int colt = u.pn * BM; bf16_t* base = O;
        float sc = 1.f; if (split_cols) { const int t = colt / split_cols; base += (size_t)t * split_stride; colt -= t * split_cols; if (t == 0) sc = scale0; }
        const int col0 = colt + wc * 32 + 8 * fq, bcol0 = u.pn * BM + wc * 32 + 8 * fq;
        f32x4 bv[2][2];
#pragma unroll
        for (int bj = 0; bj < 2; ++bj)
#pragma unroll
            for (int n = 0; n < 2; ++n) bv[bj][n] = bias ? *(const f32x4*)(bias + bcol0 + bj * HALF + 4 * n) : (f32x4){0.f, 0.f, 0.f, 0.f};
#pragma unroll
        for (int ai = 0; ai < 2; ++ai)
#pragma unroll
            for (int m = 0; m < 4; ++m) { bf16_t* rowp = base + (size_t)(row0 + ai * HALF + m * 16) * ldc + col0;
#pragma unroll
                for (int bj = 0; bj < 2; ++bj) { f32x4 v0 = acc[ai][bj][m][0] + bv[bj][0], v1 = acc[ai][bj][m][1] + bv[bj][1];
                    if (ACT == 1) { f32x2 a = gelu_pk((f32x2){v0[0], v0[1]}), b = gelu_pk((f32x2){v0[2], v0[3]}), c = gelu_pk((f32x2){v1[0], v1[1]}), d = gelu_pk((f32x2){v1[2], v1[3]});
                        v0 = (f32x4){a.x, a.y, b.x, b.y}; v1 = (f32x4){c.x, c.y, d.x, d.y}; }
                    v0 = v0 * sc; v1 = v1 * sc; u32x4 w; w.x = cvt_pk_bf16(v0[0], v0[1]); w.y = cvt_pk_bf16(v0[2], v0[3]); w.z = cvt_pk_bf16(v1[0], v1[1]); w.w = cvt_pk_bf16(v1[2], v1[3]);
                    *(u32x4*)(rowp + bj * HALF) = w; } }
    }
};


struct EpiF32 {
    static constexpr bool PERM = false, AFTER_DRAIN = false;
    float* C; int ldc; const float* resid;
    __device__ __forceinline__ void operator()(const f32x4 (&acc)[2][2][4][2], const Unit& u, int wr, int wc, int fr, int fq) const {
        const int row0 = u.pm * BM + wr * 64 + fr, col0 = u.pn * BM + wc * 32 + 4 * fq;
#pragma unroll
        for (int ai = 0; ai < 2; ++ai)
#pragma unroll
            for (int m = 0; m < 4; ++m) { const size_t rb = (size_t)(row0 + ai * HALF + m * 16) * ldc + col0;
#pragma unroll
                for (int bj = 0; bj < 2; ++bj)
#pragma unroll
                    for (int n = 0; n < 2; ++n) { const size_t ix = rb + bj * HALF + n * 16; f32x4 v = acc[ai][bj][m][n];
                        if (resid) v += *(const f32x4*)(resid + ix);
                        *(f32x4*)(C + ix) = v; } }
    }
};
struct EpiGlu {
    static constexpr bool PERM = true, AFTER_DRAIN = false;
    bf16_t* O; int ldc; const float* bias; const bf16_t* YG;
    __device__ __forceinline__ void operator()(const f32x4 (&acc)[2][2][4][2], const Unit& u, int wr, int wc, int fr, int fq) const {
        const int row0 = u.pm * BM + wr * 64 + fr, col0 = u.pn * BM + wc * 32 + 8 * fq;
#pragma unroll
        for (int ai = 0; ai < 2; ++ai)
#pragma unroll
            for (int m = 0; m < 4; ++m) { const size_t rb = (size_t)(row0 + ai * HALF + m * 16) * ldc + col0;
#pragma unroll
                for (int bj = 0; bj < 2; ++bj) { const size_t ix = rb + bj * HALF;
                    const f32x4 b0 = *(const f32x4*)(bias + col0 + bj * HALF), b1 = *(const f32x4*)(bias + col0 + bj * HALF + 4);
                    const u32x4 yw = *(const u32x4*)(YG + ix);
                    f32x4 v0 = acc[ai][bj][m][0] + b0, v1 = acc[ai][bj][m][1] + b1; float o[8];
#pragma unroll
                    for (int e = 0; e < 4; ++e) { const unsigned w = e == 0 ? yw.x : e == 1 ? yw.y : e == 2 ? yw.z : yw.w;
                        const float y0 = __uint_as_float(w << 16), y1 = __uint_as_float(w & 0xffff0000u);
                        const float a0 = e < 2 ? v0[2 * e] : v1[2 * e - 4], a1 = e < 2 ? v0[2 * e + 1] : v1[2 * e - 3];
                        o[2 * e] = y0 / (1.f + __expf(-a0)); o[2 * e + 1] = y1 / (1.f + __expf(-a1)); }
                    u32x4 w; w.x = cvt_pk_bf16(o[0], o[1]); w.y = cvt_pk_bf16(o[2], o[3]); w.z = cvt_pk_bf16(o[4], o[5]); w.w = cvt_pk_bf16(o[6], o[7]);
                    *(u32x4*)(O + ix) = w; } }
    }
};
template <class Epi, class Sched, bool ALIGN_EPI = false, bool SP2 = false>
__device__ __forceinline__ void gemm_phase(PG8_LAS unsigned char* lds, const Gemm g, const Sched& S, const Epi& E) {
    int tid_l = threadIdx.x; asm volatile("" : "+v"(tid_l));
    const int tid = tid_l, wid = __builtin_amdgcn_readfirstlane(tid >> 6), lane = tid & 63, wr = wid >> 2, wc = wid & 3, fr = lane & 15, fq = lane >> 4;
    const int K = g.K, nt = K / BK;
    unsigned voffA[2], voffB[2];
#pragma unroll
    for (int i = 0; i < 2; ++i) { int R, C; stage_rc(tid * 16 + i * 8192, R, C); const int Rb = Epi::PERM ? ((R & ~31) + perm32(R & 31)) : R;
        voffA[i] = (unsigned)(R * g.lda + C) * 2u; voffB[i] = (unsigned)(Rb * K + C) * 2u; }
    const size_t kstep = (size_t)(BK * 2);
    const size_t hsA = (size_t)HALF * g.lda * 2, hsB = (size_t)HALF * K * 2;
    const size_t tsA = 2 * hsA, tsB = 2 * hsB;
    const unsigned ldsw = (unsigned)wid * 1024u;
    const int aoff = lds_byte(wr * 64 + fr, fq * 8), boff = lds_byte(wc * 32 + fr, fq * 8);
#define PG8_SA(b, h) (((b) * 2 + (h)) * HTB)
#define PG8_SB(b, h) ((4 + (b) * 2 + (h)) * HTB)
#define PG8_STAGE(bufoff, gbase, voff) do { _Pragma("unroll") for (int _i = 0; _i < 2; ++_i) \
        __builtin_amdgcn_global_load_lds((const unsigned*)((const char*)(gbase) + (voff)[_i]), (PG8_LAS unsigned*)(lds + (bufoff) + ldsw + _i * 8192), 16, 0, 0); } while (0)
#define PG8_LDA(dst, b, h) do { _Pragma("unroll") for (int m = 0; m < 4; ++m) _Pragma("unroll") for (int k = 0; k < 2; ++k) dst[m][k] = *(const PG8_LAS bf16x8*)(lds + PG8_SA(b, h) + aoff + m * 2048 + k * 1024); } while (0)
#define PG8_LDB(dst, b, h) do { _Pragma("unroll") for (int n = 0; n < 2; ++n) _Pragma("unroll") for (int k = 0; k < 2; ++k) dst[n][k] = *(const PG8_LAS bf16x8*)(lds + PG8_SB(b, h) + boff + n * 2048 + k * 1024); } while (0)
#define PG8_MMA(ai, bj, At, Bt) do { __builtin_amdgcn_s_setprio(1); _Pragma("unroll") for (int m = 0; m < 4; ++m) _Pragma("unroll") for (int n = 0; n < 2; ++n) _Pragma("unroll") for (int k = 0; k < 2; ++k) \
        acc[ai][bj][m][n] = __builtin_amdgcn_mfma_f32_16x16x32_bf16(Bt[n][k], At[m][k], acc[ai][bj][m][n], 0, 0, 0); __builtin_amdgcn_s_setprio(0); } while (0)
#define PG8_WAIT_V(n) asm volatile("s_waitcnt vmcnt(" #n ")" ::: "memory")
#define PG8_WAIT_L(n) asm volatile("s_waitcnt lgkmcnt(" #n ")" ::: "memory")
#define PG8_BAR __builtin_amdgcn_s_barrier()
#define PG8_SCHED __builtin_amdgcn_sched_barrier(0)
    Unit cur, nxt; int ui = 0;
    if (!S.next(0, cur)) return;
    f32x4 acc[2][2][4][2];
#pragma unroll
    for (int a = 0; a < 2; ++a)
#pragma unroll
        for (int b = 0; b < 2; ++b)
#pragma unroll
            for (int m = 0; m < 4; ++m)
#pragma unroll
                for (int n = 0; n < 2; ++n) acc[a][b][m][n] = (f32x4){0.f, 0.f, 0.f, 0.f};
    bf16x8 At[4][2], B0[2][2], B1[2][2];
    const char* cA = (const char*)g.A + (size_t)cur.pm * tsA; const char* cB = (const char*)g.Bt + (size_t)cur.pn * tsB;
    S.a_ready(cur);
    if constexpr (SP2) {
        PG8_STAGE(PG8_SB(0, 0), cB, voffB); PG8_STAGE(PG8_SB(0, 1), cB + hsB, voffB); PG8_STAGE(PG8_SA(0, 0), cA, voffA); PG8_STAGE(PG8_SA(0, 1), cA + hsA, voffA);
        if (wr == 1) PG8_BAR;
        PG8_WAIT_V(2); PG8_BAR;
        PG8_STAGE(PG8_SB(1, 0), cB + kstep, voffB); PG8_STAGE(PG8_SA(1, 0), cA + kstep, voffA); PG8_STAGE(PG8_SB(1, 1), cB + hsB + kstep, voffB);
        PG8_WAIT_V(6); PG8_BAR;
    } else {
        PG8_STAGE(PG8_SB(0, 0), cB, voffB); PG8_STAGE(PG8_SA(0, 0), cA, voffA); PG8_STAGE(PG8_SB(0, 1), cB + hsB, voffB); PG8_STAGE(PG8_SA(0, 1), cA + hsA, voffA);
        if (wr == 1) PG8_BAR;
        PG8_WAIT_V(4); PG8_BAR;
        PG8_STAGE(PG8_SB(1, 0), cB + kstep, voffB); PG8_STAGE(PG8_SA(1, 0), cA + kstep, voffA); PG8_STAGE(PG8_SB(1, 1), cB + hsB + kstep, voffB);
        PG8_WAIT_V(6); PG8_BAR;
    }
    for (;;) {
        const bool has_next = S.next(ui + 1, nxt);
        const char* nA = has_next ? (const char*)g.A + (size_t)nxt.pm * tsA : cA; const char* nB = has_next ? (const char*)g.Bt + (size_t)nxt.pn * tsB : cB;
        for (int t = 0; t < nt; t += 2) {
            const bool last = (t == nt - 2);
            const char* a1 = cA + (size_t)(t + 1) * kstep;
            const char* a2 = last ? nA : cA + (size_t)(t + 2) * kstep; const char* b2 = last ? nB : cB + (size_t)(t + 2) * kstep;
            const char* a3 = a2 + kstep; const char* b3 = b2 + kstep;
            if (last && has_next) S.a_ready(nxt);
            if constexpr (SP2) {
            PG8_LDB(B0, 0, 0); PG8_LDB(B1, 0, 1); PG8_SCHED; PG8_LDA(At, 0, 0); PG8_STAGE(PG8_SA(1, 1), a1 + hsA, voffA);
            PG8_WAIT_V(8); PG8_WAIT_L(0); PG8_BAR; PG8_MMA(0, 0, At, B0); PG8_MMA(0, 1, At, B1); PG8_BAR; PG8_SCHED;
            PG8_LDA(At, 0, 1); PG8_STAGE(PG8_SB(0, 0), b2, voffB); PG8_STAGE(PG8_SB(0, 1), b2 + hsB, voffB); PG8_STAGE(PG8_SA(0, 0), a2, voffA);
            PG8_WAIT_V(8); PG8_WAIT_L(0); PG8_BAR; PG8_MMA(1, 0, At, B0); PG8_MMA(1, 1, At, B1); PG8_BAR; PG8_SCHED;
            PG8_LDB(B0, 1, 0); PG8_LDB(B1, 1, 1); PG8_SCHED; PG8_LDA(At, 1, 0); PG8_STAGE(PG8_SA(0, 1), a2 + hsA, voffA);
            PG8_WAIT_V(8); PG8_WAIT_L(0); PG8_BAR; PG8_MMA(0, 0, At, B0); PG8_MMA(0, 1, At, B1); PG8_BAR; PG8_SCHED;
            PG8_LDA(At, 1, 1); PG8_STAGE(PG8_SB(1, 0), b3, voffB); PG8_STAGE(PG8_SB(1, 1), b3 + hsB, voffB); PG8_STAGE(PG8_SA(1, 0), a3, voffA);
            PG8_WAIT_V(8); PG8_WAIT_L(0); PG8_BAR; PG8_MMA(1, 0, At, B0); PG8_MMA(1, 1, At, B1); PG8_BAR; PG8_SCHED;
            } else {
            PG8_LDB(B0, 0, 0); PG8_SCHED; PG8_LDA(At, 0, 0); PG8_STAGE(PG8_SA(1, 1), a1 + hsA, voffA);
            PG8_WAIT_L(8); PG8_BAR; PG8_WAIT_L(0); PG8_MMA(0, 0, At, B0); PG8_BAR; PG8_SCHED;
            PG8_LDB(B1, 0, 1); PG8_STAGE(PG8_SB(0, 0), b2, voffB);
            PG8_BAR; PG8_WAIT_L(0); PG8_MMA(0, 1, At, B1); PG8_BAR;
            PG8_LDA(At, 0, 1); PG8_STAGE(PG8_SA(0, 0), a2, voffA);
            PG8_BAR; PG8_WAIT_L(0); PG8_MMA(1, 0, At, B0); PG8_BAR; PG8_SCHED;
            PG8_STAGE(PG8_SB(0, 1), b2 + hsB, voffB);
            PG8_WAIT_V(6); PG8_BAR; PG8_MMA(1, 1, At, B1); PG8_BAR;
            PG8_LDB(B0, 1, 0); PG8_SCHED; PG8_LDA(At, 1, 0); PG8_STAGE(PG8_SA(0, 1), a2 + hsA, voffA);
            PG8_WAIT_L(8); PG8_BAR; PG8_WAIT_L(0); PG8_MMA(0, 0, At, B0); PG8_BAR; PG8_SCHED;
            PG8_LDB(B1, 1, 1); PG8_STAGE(PG8_SB(1, 0), b3, voffB);
            PG8_BAR; PG8_WAIT_L(0); PG8_MMA(0, 1, At, B1); PG8_BAR;
            PG8_LDA(At, 1, 1); PG8_STAGE(PG8_SA(1, 0), a3, voffA);
            PG8_BAR; PG8_WAIT_L(0); PG8_MMA(1, 0, At, B0); PG8_BAR; PG8_SCHED;
            PG8_STAGE(PG8_SB(1, 1), b3 + hsB, voffB);
            PG8_WAIT_V(6); PG8_BAR; PG8_MMA(1, 1, At, B1); PG8_BAR;
            }
        }
        if constexpr (ALIGN_EPI) { if (wr == 0) PG8_BAR; }
        if constexpr (!Epi::AFTER_DRAIN) { E(acc, cur, wr, wc, fr, fq); S.done(cur); }
        if (!has_next) break;
#pragma unroll
        for (int a = 0; a < 2; ++a)
#pragma unroll
            for (int b = 0; b < 2; ++b)
#pragma unroll
                for (int m = 0; m < 4; ++m)
#pragma unroll
                    for (int n = 0; n < 2; ++n) acc[a][b][m][n] = (f32x4){0.f, 0.f, 0.f, 0.f};
        cur = nxt; cA = nA; cB = nB; ++ui;
        if constexpr (ALIGN_EPI) { if (wr == 1) PG8_BAR; }
    }
    PG8_WAIT_V(0);
    if constexpr (!ALIGN_EPI) { if (wr == 0) PG8_BAR; }
    PG8_BAR;
    if constexpr (Epi::AFTER_DRAIN) { E.fused(acc, cur, wr, wc, fr, fq, lds, wid, lane); S.done(cur); }
#undef PG8_SA
#undef PG8_SB
#undef PG8_STAGE
#undef PG8_LDA
#undef PG8_LDB
#undef PG8_MMA
#undef PG8_WAIT_V
#undef PG8_WAIT_L
#undef PG8_BAR
#undef PG8_SCHED
}
}
#define GAS __attribute__((address_space(1)))
#define LAS __attribute__((address_space(3)))
#define XB_TMO      128
#define XB_XCNT(j)  (256  + 64 * (j))
#define XB_XSUB(j)  (1280 + 64 * (j))
#define XB_XGEN(j)  (2304 + 64 * (j))
#define XB_TOP      3328
#define XB_TOPGEN   3392
#define XCD_BAR_WORDS 3456
#define XB_SPIN_CAP (1u << 25)
__device__ __forceinline__ unsigned xb_ld(unsigned* p)              { return __hip_atomic_load(p, __ATOMIC_RELAXED, __HIP_MEMORY_SCOPE_AGENT); }
__device__ __forceinline__ unsigned xb_add(unsigned* p, unsigned v) { return __hip_atomic_fetch_add(p, v, __ATOMIC_RELAXED, __HIP_MEMORY_SCOPE_AGENT); }
__device__ __forceinline__ unsigned xb_xcc_id() { return (unsigned)__builtin_amdgcn_s_getreg((3 << 11) | 20) & 0xFu; }
#define XB_SPIN(cond, bar) do { unsigned _sp = 0; while (cond) { __builtin_amdgcn_s_sleep(1); \
    if ((++_sp & 255u) == 0u) { if (xb_ld(&(bar)[XB_TMO])) break; if (_sp > XB_SPIN_CAP) { atomicAdd(&(bar)[XB_TMO], 1u); break; } } } } while (0)
struct XcdBarrier { unsigned* bar; unsigned x; volatile LAS unsigned* st; };
__device__ __forceinline__ XcdBarrier xcd_barrier_post(unsigned* bar, volatile LAS unsigned* st) {
    XcdBarrier b; b.bar = bar; b.x = xb_xcc_id(); b.st = st;
    if (threadIdx.x == 0) (void)xb_add(&bar[XB_XCNT(b.x)], 1u);
    return b;
}
__device__ __forceinline__ void xcd_barrier_complete(unsigned* bar, unsigned x, unsigned& nloc, unsigned& nx) {
    const unsigned G = gridDim.x * gridDim.y * gridDim.z;
    unsigned sum, cnt, mine, sp = 0u;
    for (;;) {
        sum = 0u; cnt = 0u; mine = 0u;
#pragma unroll
        for (unsigned j = 0; j < 16; ++j) { const unsigned c = xb_ld(&bar[XB_XCNT(j)]); sum += c; cnt += (c > 0u) ? 1u : 0u; mine = (j == x) ? c : mine; }
        if (sum == G) break;
        __builtin_amdgcn_s_sleep(1);
        if ((++sp & 255u) == 0u) { if (xb_ld(&bar[XB_TMO])) break; if (sp > XB_SPIN_CAP) { atomicAdd(&bar[XB_TMO], 1u); break; } }
    }
    nloc = mine > 0u ? mine : 1u; nx = cnt > 0u ? cnt : 1u;
}
__device__ __forceinline__ void xcd_barrier(const XcdBarrier& b) {
    asm volatile("s_waitcnt vmcnt(0)" ::: "memory");
    __syncthreads();
    if (threadIdx.x == 0) {
        unsigned* bar = b.bar;
        __builtin_amdgcn_s_waitcnt(0);
        unsigned nloc = b.st[0], nx = b.st[1];
        if (nloc == 0u) { xcd_barrier_complete(bar, b.x, nloc, nx); b.st[0] = nloc; b.st[1] = nx; }
        const unsigned old = xb_add(&bar[XB_XSUB(b.x)], 1u);
        const unsigned gen = old / nloc;
        if (old + 1u == (gen + 1u) * nloc) {
            __builtin_amdgcn_fence(__ATOMIC_RELEASE, "agent");
            asm volatile("s_waitcnt vmcnt(0)" ::: "memory");
            const unsigned og = xb_add(&bar[XB_TOP], 1u);
            const unsigned tg = og / nx;
            if (og + 1u == (tg + 1u) * nx) xb_add(&bar[XB_TOPGEN], 1u);
            else XB_SPIN(xb_ld(&bar[XB_TOPGEN]) == tg, bar);
            __builtin_amdgcn_fence(__ATOMIC_ACQUIRE, "agent");
            xb_add(&bar[XB_XGEN(b.x)], 1u);
            asm volatile("s_waitcnt vmcnt(0)" ::: "memory");
        } else {
            XB_SPIN(xb_ld(&bar[XB_XGEN(b.x)]) == gen, bar);
            __builtin_amdgcn_fence(__ATOMIC_ACQUIRE, "agent");
            asm volatile("s_waitcnt vmcnt(0)" ::: "memory");
        }
    }
    __syncthreads();
}
namespace s5f {
typedef short bf16x8 __attribute__((ext_vector_type(8)));
typedef float f32x4 __attribute__((ext_vector_type(4)));
typedef unsigned u32x2 __attribute__((ext_vector_type(2)));
constexpr int LC = 32, NCH = SEQ / LC, RS = 272, WBYTES = LC * RS;
__device__ __forceinline__ void build_tables(const float* a_re, const float* a_im, const float* log_dt, const float* b_re, const float* b_im, const float* c_re, const float* c_im,
                                             bf16* S5A, bf16* S5C, float2* S5L, int gt, int ngt) {
    for (int i = gt; i < 16 * 64; i += ngt) {
        const int g = i >> 6;
        const float are = a_re[i], aim = a_im[i], dt = expf(log_dt[g]);
        const float mag = expf(are * dt); float sn, cs; sincos_acc(aim * dt, sn, cs);
        const float lre = mag * cs, lim = mag * sn;
        const float xr = lre - 1.f, xi = lim, den = are * are + aim * aim;
        const float cr = (xr * are + xi * aim) / den, ci = (xi * are - xr * aim) / den;
        S5L[i] = make_float2(lre, lim);
        const int p = i & 63;
        for (int k = 0; k < 16; ++k) { const float br = b_re[i * 16 + k], bi = b_im[i * 16 + k];
            S5A[((size_t)g * 128 + 2 * p) * 16 + k] = f2bf(cr * br - ci * bi); S5A[((size_t)g * 128 + 2 * p + 1) * 16 + k] = f2bf(cr * bi + ci * br);
            S5C[((size_t)g * 16 + k) * 128 + 2 * p] = f2bf(c_re[(g * 16 + k) * 64 + p]); S5C[((size_t)g * 16 + k) * 128 + 2 * p + 1] = f2bf(-c_im[(g * 16 + k) * 64 + p]); }
    }
}
template <bool FULL> __device__ __forceinline__ void chunk(LAS unsigned char* wl, const bf16* Z, const bf16x8 (&afr)[8], const bf16x8 (&cfr)[4], float lre, float lim, float& hre, float& him,
                                                           int b, int ch, int g, int lane, const float* dsk, bf16* YG) {
    const int l15 = lane & 15, q4 = lane >> 4;
    const size_t t0 = (size_t)b * SEQ + (size_t)ch * LC;
#pragma unroll
    for (int nb = 0; nb < 2; ++nb) {
        bf16x8 ufr = bf16x8{};
        if (q4 < 2) ufr = *(const bf16x8*)(Z + (t0 + 16 * nb + l15) * ZW + ZC_U + g * 16 + 8 * q4);
#pragma unroll
        for (int mb = 0; mb < 8; ++mb) {
            f32x4 d = __builtin_amdgcn_mfma_f32_16x16x32_bf16(afr[mb], ufr, f32x4{0.f, 0.f, 0.f, 0.f}, 0, 0, 0);
            *(LAS u32x2*)(wl + (16 * nb + l15) * RS + (16 * mb + 4 * q4) * 2) = u32x2{pk2(d[0], d[1]), pk2(d[2], d[3])};
        }
    }
#pragma unroll 8
    for (int k = 0; k < LC; ++k) {
        LAS unsigned* wp = (LAS unsigned*)(wl + k * RS + 4 * lane);
        const unsigned w = *wp; const float bre = __uint_as_float(w << 16), bim = __uint_as_float(w & 0xffff0000u);
        const float nre = fmaf(lre, hre, fmaf(-lim, him, bre)), nim = fmaf(lre, him, fmaf(lim, hre, bim)); hre = nre; him = nim;
        if (FULL) *wp = pk2(hre, him);
    }
    if (FULL) {
#pragma unroll
        for (int nb = 0; nb < 2; ++nb) {
            f32x4 y = f32x4{0.f, 0.f, 0.f, 0.f};
#pragma unroll
            for (int ks = 0; ks < 4; ++ks) {
                const bf16x8 hfr = *(const LAS bf16x8*)(wl + (16 * nb + l15) * RS + (32 * ks + 8 * q4) * 2);
                y = __builtin_amdgcn_mfma_f32_16x16x32_bf16(cfr[ks], hfr, y, 0, 0, 0);
            }
            const size_t t = t0 + 16 * nb + l15; const int co = 4 * q4;
            const uint2 uw = *(const uint2*)(Z + t * ZW + ZC_U + g * 16 + co);
            const float4 dd = *(const float4*)(dsk + g * 16 + co);
            const float y0 = y[0] + dd.x * __uint_as_float(uw.x << 16), y1 = y[1] + dd.y * __uint_as_float(uw.x & 0xffff0000u),
                        y2 = y[2] + dd.z * __uint_as_float(uw.y << 16), y3 = y[3] + dd.w * __uint_as_float(uw.y & 0xffff0000u);
            *(uint2*)(YG + t * 256 + g * 16 + co) = make_uint2(pk2(gelu_f(y0), gelu_f(y1)), pk2(gelu_f(y2), gelu_f(y3)));
        }
    }
}
template <bool FULL> __device__ __forceinline__ void pass(LAS unsigned char* lds, const bf16* Z, const bf16* S5A, const bf16* S5C, const float2* S5L, const float* dsk,
                                                          float2* SE, const float2* SH, bf16* YG, int gw, int ngw, int wave, int lane) {
    LAS unsigned char* wl = lds + wave * WBYTES;
    const int g = gw & 15, l15 = lane & 15, q4 = lane >> 4;
    bf16x8 afr[8], cfr[4];
#pragma unroll
    for (int mb = 0; mb < 8; ++mb) { afr[mb] = bf16x8{}; if (q4 < 2) afr[mb] = *(const bf16x8*)(S5A + ((size_t)g * 128 + 16 * mb + l15) * 16 + 8 * q4); }
#pragma unroll
    for (int ks = 0; ks < 4; ++ks) { cfr[ks] = bf16x8{}; if (FULL) cfr[ks] = *(const bf16x8*)(S5C + ((size_t)g * 16 + l15) * 128 + 32 * ks + 8 * q4); }
    const float2 lam = S5L[g * 64 + lane];
    for (int it = gw >> 4; it < NB * NCH; it += ngw >> 4) {
        const int b = it / NCH, ch = it % NCH;
        float hre = 0.f, him = 0.f;
        if (FULL) { const float2 h0 = SH[((size_t)it * 16 + g) * 64 + lane]; hre = h0.x; him = h0.y; }
        chunk<FULL>(wl, Z, afr, cfr, lam.x, lam.y, hre, him, b, ch, g, lane, dsk, YG);
        if (!FULL) SE[((size_t)it * 16 + g) * 64 + lane] = make_float2(hre, him);
    }
}
__device__ __forceinline__ void carry(const float2* S5L, const float2* SE, float2* SH, int gw, int ngw, int lane) {
    for (int item = gw; item < NB * 16; item += ngw) {
        const int b = item >> 4, g = item & 15;
        float2 lam = S5L[g * 64 + lane];
#pragma unroll
        for (int i = 0; i < 5; ++i) { const float re = lam.x * lam.x - lam.y * lam.y, im = 2.f * lam.x * lam.y; lam.x = re; lam.y = im; }
        float hre = 0.f, him = 0.f;
#pragma unroll 8
        for (int c = 0; c < NCH; ++c) { const size_t ix = (((size_t)b * NCH + c) * 16 + g) * 64 + lane;
            SH[ix] = make_float2(hre, him);
            const float2 e = SE[ix];
            const float nre = lam.x * hre - lam.y * him + e.x, nim = lam.x * him + lam.y * hre + e.y; hre = nre; him = nim; }
    }
}
}
namespace lruf {
typedef float f32x4 __attribute__((ext_vector_type(4)));
constexpr int LC = 32, NCH = SEQ / LC, XS = 68;
__device__ __forceinline__ void pass_a(LAS unsigned char* lds, const bf16* Z, const float* cw, const float* cb, const float* wa, const float* ba, const float* wx, const float* bx, const float* lam,
                                       float* AA, float* BT, float2* LPE, int gw, int ngw, int wave, int lane) {
    LAS float* xt = (LAS float*)lds + wave * (LC * XS);
    for (int item = gw; item < NB * NCH * 4; item += ngw) {
        const int h = item & 3, bc = item >> 2, b = bc / NCH, ch = bc % NCH, c = h * 64 + lane;
        const size_t t0 = (size_t)b * SEQ + (size_t)ch * LC;
        const float w0 = cw[c], w1 = cw[256 + c], w2 = cw[512 + c], w3 = cw[768 + c], bias = cb[c];
        float z0 = 0.f, z1 = 0.f, z2 = 0.f;
        if (ch > 0) { z0 = bf2f(Z[(t0 - 3) * ZW + ZC_X + c]); z1 = bf2f(Z[(t0 - 2) * ZW + ZC_X + c]); z2 = bf2f(Z[(t0 - 1) * ZW + ZC_X + c]); }
        float xc[LC];
#pragma unroll
        for (int k = 0; k < LC; ++k) { const float z3 = bf2f(Z[(t0 + k) * ZW + ZC_X + c]); xc[k] = bias + w0 * z0 + w1 * z1 + w2 * z2 + w3 * z3; z0 = z1; z1 = z2; z2 = z3; xt[k * XS + lane] = xc[k]; }
        float ra[LC], rx[LC];
        { const float b0 = ba[c], b1 = bx[c];
#pragma unroll
          for (int k = 0; k < LC; ++k) { ra[k] = b0; rx[k] = b1; } }
        const float* wap = wa + (size_t)h * 4096 + lane; const float* wxp = wx + (size_t)h * 4096 + lane;
        for (int i = 0; i < 64; i += 4) {
            const float a0 = wap[(i + 0) * 64], a1 = wap[(i + 1) * 64], a2 = wap[(i + 2) * 64], a3 = wap[(i + 3) * 64];
            const float x0 = wxp[(i + 0) * 64], x1 = wxp[(i + 1) * 64], x2 = wxp[(i + 2) * 64], x3 = wxp[(i + 3) * 64];
#pragma unroll
            for (int k = 0; k < LC; ++k) { const f32x4 v = *(const LAS f32x4*)(xt + k * XS + i);
                ra[k] += v.x * a0 + v.y * a1 + v.z * a2 + v.w * a3; rx[k] += v.x * x0 + v.y * x1 + v.z * x2 + v.w * x3; }
        }
        const float lsg8 = -8.f * log1pf(expf(-lam[c]));
        float hloc = 0.f, prod = 1.f;
#pragma unroll
        for (int k = 0; k < LC; ++k) {
            const float r = sigmoid_f(ra[k]), ig = sigmoid_f(rx[k]);
            const float la = r * lsg8, av = expf(la), bt = sqrtf(-expm1f(2.f * la)) * (ig * xc[k]);
            AA[(t0 + k) * 256 + c] = av; BT[(t0 + k) * 256 + c] = bt;
            hloc = av * hloc + bt; prod *= av;
        }
        LPE[(size_t)bc * 256 + c] = make_float2(prod, hloc);
    }
}
__device__ __forceinline__ void carry(const float2* LPE, float* LH, int gt, int ngt) {
    for (int i = gt; i < NB * 256; i += ngt) { const int b = i >> 8, c = i & 255;
        float h = 0.f;
#pragma unroll 8
        for (int ch = 0; ch < NCH; ++ch) { const size_t ix = ((size_t)b * NCH + ch) * 256 + c; LH[ix] = h; const float2 pe = LPE[ix]; h = pe.x * h + pe.y; } }
}
__device__ __forceinline__ void pass_b(const float* AA, const float* BT, const float* LH, const bf16* Z, bf16* ROUT, int gt, int ngt) {
    for (int i = gt; i < NB * NCH * 256; i += ngt) { const int c = i & 255, bc = i >> 8; const size_t t0 = (size_t)bc * LC;
        float h = LH[i];
#pragma unroll 8
        for (int k = 0; k < LC; ++k) { const size_t t = t0 + k;
            h = AA[t * 256 + c] * h + BT[t * 256 + c];
            ROUT[t * 256 + c] = f2bf(h * gelu_f(bf2f(Z[t * ZW + ZC_G + c]))); } }
}
}
namespace tk {
__device__ const unsigned char PAIR_TAB[64] = {
    0x00,0x01,0x02,0x03,0x04,0x05,0x06,0x07,0x08,0x09,0x0a,0x0b,0x0c,0x0d,0x0e,0x0f, 0x10,0x11,0x12,0x13,0x14,0x15,0x16,0x17, 0x20,0x21,0x22,0x23,0x24, 0x30,0x31,0x32,0x33,
    0x40,0x41,0x42, 0x50,0x51, 0x60,0x61, 0x70,0x71, 0x80,0x90,0xa0,0xb0,0xc0,0xd0,0xe0,0xf0, 0,0,0,0,0,0,0,0,0,0,0,0,0,0};
template <int CTRL> __device__ __forceinline__ float dppf(float v) { return __builtin_bit_cast(float, __builtin_amdgcn_update_dpp(0, __builtin_bit_cast(int, v), CTRL, 0xf, 0xf, true)); }
__device__ __forceinline__ float swz16(float v) { return __builtin_bit_cast(float, __builtin_amdgcn_ds_swizzle(__builtin_bit_cast(int, v), 0x401F)); }
__device__ __forceinline__ float hmax32(float v) {
    v = fmaxf(v, dppf<0xB1>(v)); v = fmaxf(v, dppf<0x4E>(v)); v = fmaxf(v, dppf<0x141>(v)); v = fmaxf(v, dppf<0x140>(v)); v = fmaxf(v, swz16(v)); return v; }
__device__ __forceinline__ float wmax64(float v) { v = hmax32(v); auto rr = __builtin_amdgcn_permlane32_swap(__float_as_uint(v), __float_as_uint(v), false, false);
    return fmaxf(__uint_as_float(rr[0]), __uint_as_float(rr[1])); }
#define TK_CX(a, b) do { const float hi_ = fmaxf(a, b), lo_ = fminf(a, b); a = hi_; b = lo_; } while (0)
__device__ __forceinline__ void topk_phase(const float* SC, int* IDX, float* GATE, int gw, int ngw, int lane) {
    const float NEG = -__builtin_inff();
    const int j = lane & 31;
    const unsigned pc = PAIR_TAB[lane]; const int pa = pc >> 4, pb = pc & 15;
    for (int row = gw; row < T * 8; row += ngw) {
        const float4 v = *(const float4*)(SC + (size_t)row * 256 + 4 * lane);
        float k0 = __uint_as_float((__float_as_uint(v.x) & ~127u) | (unsigned)(4 * j)), k1 = __uint_as_float((__float_as_uint(v.y) & ~127u) | (unsigned)(4 * j + 1)),
              k2 = __uint_as_float((__float_as_uint(v.z) & ~127u) | (unsigned)(4 * j + 2)), k3 = __uint_as_float((__float_as_uint(v.w) & ~127u) | (unsigned)(4 * j + 3));
        TK_CX(k0, k1); TK_CX(k2, k3); TK_CX(k0, k2); TK_CX(k1, k3); TK_CX(k1, k2);
        float mykey = NEG;
#pragma unroll
        for (int i = 0; i < 16; ++i) {
            const float w = hmax32(k0);
            if (j == i) mykey = w;
            if (k0 == w) { k0 = k1; k1 = k2; k2 = k3; k3 = NEG; }
        }
        const float s0 = __shfl(mykey, pa), s1 = __shfl(mykey, 32 + pb);
        float ck = (lane < 50) ? __uint_as_float((__float_as_uint(s0 + s1) & ~63u) | (unsigned)lane) : NEG;
        float win = NEG, w0 = 0.f;
#pragma unroll
        for (int i = 0; i < 16; ++i) {
            const float w = wmax64(ck);
            if (i == 0) w0 = w;
            if (lane == i) win = w;
            if (ck == w) ck = NEG;
        }
        const int code = (int)(__float_as_uint(win) & 63u);
        const unsigned pcw = (unsigned)__shfl((int)pc, code);
        const int i0 = (int)(__float_as_uint(__shfl(mykey, (int)(pcw >> 4))) & 127u), i1 = (int)(__float_as_uint(__shfl(mykey, 32 + (int)(pcw & 15))) & 127u);
        float e = (lane < 16) ? __expf(win - w0) : 0.f;
        float sum = e; sum += dppf<0xB1>(sum); sum += dppf<0x4E>(sum); sum += dppf<0x141>(sum); sum += dppf<0x140>(sum);
        if (lane < 16) { IDX[(size_t)row * 16 + lane] = i0 * 128 + i1; GATE[(size_t)row * 16 + lane] = e / sum; }
    }
}
#undef TK_CX
}
constexpr int NWAVES = 8, NTHR = 512;
constexpr int RING_BYTES = 131072, MISC_OFF = RING_BYTES + 320, LDS_BYTES = 147456;
struct Args { const void* in[34]; float* out; unsigned char* ws; int ph_lo, ph_hi; };
struct Ctx { LAS unsigned char* lds; int tid, lane, wave, G, bid, gw, ngw, gt, ngt; };
#define INF(i) ((const float*)a.in[i])
#define WSP(T_, off) ((T_*)(a.ws + (off)))

__device__ __forceinline__ void prep_tile(const float* W, int K, int N, bf16* WT, int Nout, int mapmode, int item, LAS float* tile, int t256) {
    const int nbn = Nout / 32, kb = item / nbn, nb = item % nbn, n0 = nb * 32, k0 = kb * 32, tx = t256 & 31, ty = t256 >> 5;
    for (int i = ty; i < 32; i += 8) {
        const int n = n0 + tx; int src = n;
        if (mapmode == 1) { if (n < 448) src = n; else if (n < 512) src = -1; else src = n - 64; }
        tile[i * 33 + tx] = (src >= 0 && src < N) ? W[(size_t)(k0 + i) * N + src] : 0.f;
    }
    __syncthreads();
    for (int i = ty; i < 32; i += 8) WT[(size_t)(n0 + i) * K + k0 + tx] = f2bf(tile[tx * 33 + i]);
    __syncthreads();
}
template <class ArgsRef> __device__ __forceinline__ void ph_prep(const ArgsRef& a, const Ctx& c) {
    const int sub = c.tid >> 8, t256 = c.tid & 255; LAS float* tile = (LAS float*)c.lds + sub * (32 * 33);
    constexpr int NT0 = 1280, NT1 = 192, NT2 = 128, NT3 = 64, NT4 = 1024, NT5 = 2048, NTL = NT0 + NT1 + NT2 + NT3 + NT4 + NT5, NTOT = NL * NTL;
    const int nsb = c.G * 2;
    for (int it0 = c.bid * 2; it0 < NTOT; it0 += nsb) {
        int it = it0 + sub; if (it >= NTOT) it = NTOT - 1;
        const int l = it / NTL; int r = it % NTL;
        if (r < NT0) prep_tile(INF(3) + (size_t)l * DM * 1216, DM, 1216, WSP(bf16, WS_WINT) + (size_t)l * ZW * DM, ZW, 1, r, tile, t256);
        else if ((r -= NT0) < NT1) prep_tile(INF(5) + (size_t)l * 256 * 768, 256, 768, WSP(bf16, WS_WUQT) + (size_t)l * 768 * 256, 768, 0, r, tile, t256);
        else if ((r -= NT1) < NT2) prep_tile(INF(7) + (size_t)l * 128 * 1024, 128, 1024, WSP(bf16, WS_WUKVT) + (size_t)l * 1024 * 128, 1024, 0, r, tile, t256);
        else if ((r -= NT2) < NT3) prep_tile(INF(18) + (size_t)l * 65536, 256, 256, WSP(bf16, WS_GLUT) + (size_t)l * 65536, 256, 0, r, tile, t256);
        else if ((r -= NT3) < NT4) prep_tile(INF(28) + (size_t)l * DM * DM, DM, DM, WSP(bf16, WS_WOUTT) + (size_t)l * DM * DM, DM, 0, r, tile, t256);
        else { r -= NT4; prep_tile(INF(30) + (size_t)l * DM * 2048, DM, 2048, WSP(bf16, WS_WQT) + (size_t)l * 2048 * DM, 2048, 0, r, tile, t256); }
    }
    for (int i = c.gt; i < NL * 65536; i += c.ngt) { const int l = i >> 16, e = i & 65535, r = e >> 8, cc = e & 255, pp = r >> 7, n = r & 127, p = cc >> 7, d = cc & 127;
        WSP(bf16, WS_SUBKT)[i] = (p == pp) ? f2bf(INF(31)[(size_t)l * 32768 + (pp * 128 + n) * 128 + d]) : (bf16)0; }
    { const size_t n4 = (size_t)NL * 16384 * DM / 4; const float4* u = (const float4*)a.in[32]; const float4* v = (const float4*)a.in[33]; uint2* pu = WSP(uint2, WS_PU); uint2* pv = WSP(uint2, WS_PV);
      for (size_t i = c.gt; i < n4; i += c.ngt) { const float4 x = u[i]; pu[i] = make_uint2(pk2(x.x, x.y), pk2(x.z, x.w)); const float4 y = v[i]; pv[i] = make_uint2(pk2(y.x, y.y), pk2(y.z, y.w)); } }
    for (int i = c.gt; i < T * 32; i += c.ngt) { const int t = i >> 5, j = i & 31;
        const float freq = exp2f(-(float)j * 0.41524101186092033f);
        const float ang = (float)((const int*)a.in[1])[t] * freq; float s, cs; sincos_acc(ang, s, cs);
        WSP(float, WS_COS)[i] = cs; WSP(float, WS_SIN)[i] = s; }
    for (int l = 0; l < NL; ++l)
        s5f::build_tables(INF(10) + l * 1024, INF(11) + l * 1024, INF(12) + l * 16, INF(13) + l * 16384, INF(14) + l * 16384, INF(15) + l * 16384, INF(16) + l * 16384,
                          WSP(bf16, WS_S5A) + (size_t)l * 32768, WSP(bf16, WS_S5C) + (size_t)l * 32768, WSP(float2, WS_S5L) + l * 1024, c.gt, c.ngt);
}

__device__ __forceinline__ void ph_rowprep(const Ctx& c, const float* x, const float* gain, bf16* XB) {
    for (int row = c.gw; row < T; row += c.ngw) {
        const float4* xr = (const float4*)(x + (size_t)row * DM) + c.lane;
        float4 v[4]; float ss = 0.f;
#pragma unroll
        for (int j = 0; j < 4; ++j) { v[j] = xr[64 * j]; ss += v[j].x * v[j].x + v[j].y * v[j].y + v[j].z * v[j].z + v[j].w * v[j].w; }
        const float rstd = rsqrtf(wave_sum(ss) * (1.f / DM) + EPS);
        uint2* o = (uint2*)(XB + (size_t)row * DM) + c.lane;
#pragma unroll
        for (int j = 0; j < 4; ++j) { const float4 g = ((const float4*)gain)[c.lane + 64 * j];
            o[64 * j] = make_uint2(pk2(v[j].x * rstd * g.x, v[j].y * rstd * g.y), pk2(v[j].z * rstd * g.z, v[j].w * rstd * g.w)); }
    }
}

enum { EPI_BF16 = 0, EPI_F32 = 1, EPI_GLU = 2, EPI_RESID = 3 };
template <int EPI> __device__ __forceinline__ void gemm_simple(const Ctx& c, const bf16* A, int lda, const bf16* Bt, int M, int N, int K, void* C, int ldc, const float* aux0, const bf16* aux1) {
    LAS float* As = (LAS float*)c.lds; LAS float* Bs = As + 16 * 132;
    const int tid = c.tid, tx = tid & 15, ty = tid >> 4, nN = N / 64, ntile = (M / 128) * nN;
    for (int tile = c.bid; tile < ntile; tile += c.G) {
        const int m0 = (tile / nN) * 128, n0 = (tile % nN) * 64;
        float acc[4][4];
#pragma unroll
        for (int i = 0; i < 4; ++i)
#pragma unroll
            for (int j = 0; j < 4; ++j) acc[i][j] = 0.f;
        const int lr = tid >> 2, lk = (tid & 3) * 4;
        for (int k0 = 0; k0 < K; k0 += 16) {
            { const uint2 w = *(const uint2*)(A + (size_t)(m0 + lr) * lda + k0 + lk);
              As[lk * 132 + lr] = __uint_as_float(w.x << 16); As[(lk + 1) * 132 + lr] = __uint_as_float(w.x & 0xffff0000u); As[(lk + 2) * 132 + lr] = __uint_as_float(w.y << 16); As[(lk + 3) * 132 + lr] = __uint_as_float(w.y & 0xffff0000u); }
            if (tid < 256) { const uint2 w = *(const uint2*)(Bt + (size_t)(n0 + lr) * K + k0 + lk);
              Bs[lk * 68 + lr] = __uint_as_float(w.x << 16); Bs[(lk + 1) * 68 + lr] = __uint_as_float(w.x & 0xffff0000u); Bs[(lk + 2) * 68 + lr] = __uint_as_float(w.y << 16); Bs[(lk + 3) * 68 + lr] = __uint_as_float(w.y & 0xffff0000u); }
            __syncthreads();
#pragma unroll
            for (int kk = 0; kk < 16; ++kk) {
                float av[4], bv[4];
#pragma unroll
                for (int i = 0; i < 4; ++i) { av[i] = As[kk * 132 + ty * 4 + i]; bv[i] = Bs[kk * 68 + tx * 4 + i]; }
#pragma unroll
                for (int i = 0; i < 4; ++i)
#pragma unroll
                    for (int j = 0; j < 4; ++j) acc[i][j] += av[i] * bv[j];
            }
            __syncthreads();
        }
#pragma unroll
        for (int i = 0; i < 4; ++i)
#pragma unroll
            for (int j = 0; j < 4; ++j) {
                const int row = m0 + ty * 4 + i, col = n0 + tx * 4 + j; const size_t ix = (size_t)row * ldc + col; const float v = acc[i][j];
                if (EPI == EPI_BF16) ((bf16*)C)[ix] = f2bf(v);
                else if (EPI == EPI_F32) ((float*)C)[ix] = v;
                else if (EPI == EPI_GLU) { const float yg = bf2f(aux1[ix]); ((bf16*)C)[ix] = f2bf(yg * sigmoid_f(v + aux0[col])); }
                else { ((float*)C)[ix] = aux0[ix] + v; }
            }
    }
}

__device__ __forceinline__ void ph_zstats(const Ctx& c, const bf16* Z, const float* qan, const float* kvan, bf16* CQN, bf16* CKVN) {
    for (int row = c.gw; row < T; row += c.ngw) {
        const bf16* zr = Z + (size_t)row * ZW; const int lane = c.lane;
        { const uint2 w = *(const uint2*)(zr + ZC_CQ + 4 * lane);
          float a0 = __uint_as_float(w.x << 16), a1 = __uint_as_float(w.x & 0xffff0000u), a2 = __uint_as_float(w.y << 16), a3 = __uint_as_float(w.y & 0xffff0000u);
          const float rstd = rsqrtf(wave_sum(a0 * a0 + a1 * a1 + a2 * a2 + a3 * a3) * (1.f / 256) + EPS);
          const float4 g = ((const float4*)qan)[lane];
          *(uint2*)(CQN + (size_t)row * 256 + 4 * lane) = make_uint2(pk2(a0 * rstd * g.x, a1 * rstd * g.y), pk2(a2 * rstd * g.z, a3 * rstd * g.w)); }
        { const u32 w = *(const u32*)(zr + ZC_CKV + 2 * lane);
          float a0 = __uint_as_float(w << 16), a1 = __uint_as_float(w & 0xffff0000u);
          const float rstd = rsqrtf(wave_sum(a0 * a0 + a1 * a1) * (1.f / 128) + EPS);
          const float2 g = ((const float2*)kvan)[lane];
          *(u32*)(CKVN + (size_t)row * 128 + 2 * lane) = pk2(a0 * rstd * g.x, a1 * rstd * g.y); }
    }
}

__device__ __forceinline__ void ph_qkfin(const Ctx& c, const bf16* QRAW, const bf16* KVRAW, const bf16* Z, const float* qn, const float* kn, const float* COS, const float* SIN, bf16* QB, bf16* KB, bf16* VB) {
    const int lane = c.lane;
    for (int w = c.gw; w < T * NH; w += c.ngw) {
        const int t = w >> 2, h = w & 3, b = t / SEQ, s = t % SEQ; const size_t bh = (size_t)b * NH + h;
        const float cs = COS[t * 32 + (lane & 31)], sn = SIN[t * 32 + (lane & 31)];
        {   const bf16* p = QRAW + (size_t)t * 768 + h * DQK;
            float v0 = bf2f(p[lane]), v1 = bf2f(p[lane + 64]), v2 = bf2f(p[lane + 128]);
            const float rstd = rsqrtf(wave_sum(v0 * v0 + v1 * v1 + v2 * v2) * (1.f / DQK) + EPS);
            v0 *= rstd * qn[lane]; v1 *= rstd * qn[lane + 64]; v2 *= rstd * qn[lane + 128];
            const float pr = __shfl_xor(v2, 32);
            const float r2 = (lane < 32) ? (v2 * cs - pr * sn) : (pr * sn + v2 * cs);
            bf16* o = QB + (bh * SEQ + s) * DQK;
            o[lane] = f2bf(v0 * QSCALE); o[lane + 64] = f2bf(v1 * QSCALE); o[lane + 128] = f2bf(r2 * QSCALE); }
        {   const bf16* p = KVRAW + (size_t)t * 1024 + h * 256;
            float v0 = bf2f(p[lane]), v1 = bf2f(p[lane + 64]), v2 = bf2f(Z[(size_t)t * ZW + ZC_KR + lane]);
            const float rstd = rsqrtf(wave_sum(v0 * v0 + v1 * v1 + v2 * v2) * (1.f / DQK) + EPS);
            v0 *= rstd * kn[lane]; v1 *= rstd * kn[lane + 64]; v2 *= rstd * kn[lane + 128];
            const float pr = __shfl_xor(v2, 32);
            const float r2 = (lane < 32) ? (v2 * cs - pr * sn) : (pr * sn + v2 * cs);
            bf16* o = KB + (bh * SEQ + s) * DQK;
            o[lane] = f2bf(v0); o[lane + 64] = f2bf(v1); o[lane + 128] = f2bf(r2);
            bf16* ov = VB + (bh * SEQ + s) * DV;
            ov[lane] = p[128 + lane]; ov[lane + 64] = p[192 + lane]; }
    }
}

__device__ __forceinline__ void ph_attn_simple(const Ctx& c, const bf16* QB, const bf16* KB, const bf16* VB, bf16* AO) {
    LAS float* qs = (LAS float*)c.lds + c.wave * DQK; const int lane = c.lane;
    for (int gq = c.gw; gq < NB * NH * SEQ; gq += c.ngw) {
        const int bh = gq / SEQ, q = gq % SEQ;
        const bf16* qp = QB + ((size_t)bh * SEQ + q) * DQK;
        qs[lane] = bf2f(qp[lane]); qs[lane + 64] = bf2f(qp[lane + 64]); qs[lane + 128] = bf2f(qp[lane + 128]);
        asm volatile("s_waitcnt lgkmcnt(0)" ::: "memory");
        float m = -1e30f, l = 0.f, o0 = 0.f, o1 = 0.f;
        const int ntile = q / 64 + 1;
        for (int kt = 0; kt < ntile; ++kt) {
            const int key = kt * 64 + lane;
            const uint4* kp = (const uint4*)(KB + ((size_t)bh * SEQ + key) * DQK);
            float sc = 0.f;
#pragma unroll 4
            for (int cc = 0; cc < 24; ++cc) { float kv[8]; unpack8(kp[cc], kv);
#pragma unroll
                for (int e = 0; e < 8; ++e) sc += kv[e] * qs[cc * 8 + e]; }
            if (key > q) sc = -INFINITY;
            const float mn = fmaxf(m, wave_max(sc));
            const float p = exp2f(sc - mn), al = exp2f(m - mn);
            l = l * al + wave_sum(p); o0 *= al; o1 *= al; m = mn;
            const u32* vp = (const u32*)(VB + ((size_t)bh * SEQ + kt * 64) * DV) + lane;
#pragma unroll 8
            for (int k = 0; k < 64; ++k) { const float pk = __shfl(p, k); const u32 w = vp[(size_t)k * (DV / 2)];
                o0 += pk * __uint_as_float(w << 16); o1 += pk * __uint_as_float(w & 0xffff0000u); }
        }
        const int b = bh / NH, h = bh % NH; const float il = 1.f / l;
        *(u32*)(AO + ((size_t)b * SEQ + q) * 512 + h * DV + 2 * lane) = pk2(o0 * il, o1 * il);
    }
}

__device__ __forceinline__ void ph_s5_simple(const Ctx& c, const bf16* Z, const float* a_re, const float* a_im, const float* log_dt, const float* b_re, const float* b_im,
                                             const float* c_re, const float* c_im, const float* dsk, bf16* YG) {
    for (int item = c.gw; item < NB * 16; item += c.ngw) {
        const int b = item >> 4, g = item & 15, p = c.lane;
        const float are = a_re[g * 64 + p], aim = a_im[g * 64 + p], dt = expf(log_dt[g]);
        const float mag = expf(are * dt); float sn, cs; sincos_acc(aim * dt, sn, cs);
        const float lre = mag * cs, lim = mag * sn;
        const float xr = lre - 1.f, xi = lim, den = are * are + aim * aim;
        const float cr = (xr * are + xi * aim) / den, ci = (xi * are - xr * aim) / den;
        float Bre[16], Bim[16], Cre[16], Cim[16];
#pragma unroll
        for (int k = 0; k < 16; ++k) { const float br = b_re[(g * 64 + p) * 16 + k], bi = b_im[(g * 64 + p) * 16 + k];
            Bre[k] = cr * br - ci * bi; Bim[k] = cr * bi + ci * br; Cre[k] = c_re[(g * 16 + k) * 64 + p]; Cim[k] = c_im[(g * 16 + k) * 64 + p]; }
        const float D = (p < 16) ? dsk[g * 16 + p] : 0.f;
        float hre = 0.f, him = 0.f;
        for (int s = 0; s < SEQ; ++s) {
            const bf16* up = Z + (size_t)(b * SEQ + s) * ZW + ZC_U + g * 16;
            float u[16]; unpack8(*(const uint4*)up, u); unpack8(*(const uint4*)(up + 8), u + 8);
            float bre = 0.f, bim = 0.f;
#pragma unroll
            for (int k = 0; k < 16; ++k) { bre += Bre[k] * u[k]; bim += Bim[k] * u[k]; }
            const float nre = lre * hre - lim * him + bre, nim = lre * him + lim * hre + bim; hre = nre; him = nim;
            float my = 0.f;
#pragma unroll
            for (int k = 0; k < 16; ++k) { const float v = wave_sum(Cre[k] * hre - Cim[k] * him); if (p == k) my = v + D * u[k]; }
            if (p < 16) YG[(size_t)(b * SEQ + s) * 256 + g * 16 + p] = f2bf(gelu_f(my));
        }
    }
}

__device__ __forceinline__ void ph_lru_xc(const Ctx& c, const bf16* Z, const float* cw, const float* cb, float* XC) {
    for (int i = c.gt; i < T * 256; i += c.ngt) { const int t = i >> 8, ch = i & 255, s = t % SEQ;
        float acc = cb[ch];
#pragma unroll
        for (int j = 0; j < 4; ++j) { const int ss = s - 3 + j; if (ss >= 0) acc += cw[j * 256 + ch] * bf2f(Z[(size_t)(t - 3 + j) * ZW + ZC_X + ch]); }
        XC[i] = acc; }
}
__device__ __forceinline__ void ph_lru_gates(const Ctx& c, const float* XC, const float* wa, const float* ba, const float* wx, const float* bx, const float* lam, float* AA, float* BT) {
    for (int i = c.gt; i < T * 256; i += c.ngt) { const int t = i >> 8, ch = i & 255, h = ch >> 6, j = ch & 63;
        const float* xr = XC + (size_t)t * 256 + h * 64;
        float ra = ba[ch], rx = bx[ch];
        for (int k = 0; k < 64; ++k) { const float xv = xr[k]; ra += xv * wa[(h * 64 + k) * 64 + j]; rx += xv * wx[(h * 64 + k) * 64 + j]; }
        const float r = sigmoid_f(ra), ig = sigmoid_f(rx);
        const float lsg = -log1pf(expf(-lam[ch]));
        const float la = 8.f * r * lsg, av = expf(la);
        AA[i] = av; BT[i] = sqrtf(-expm1f(2.f * la)) * (ig * XC[i]); }
}
__device__ __forceinline__ void ph_lru_scan(const Ctx& c, const float* AA, const float* BT, const bf16* Z, bf16* ROUT) {
    for (int item = c.gw; item < NB * 4; item += c.ngw) {
        const int i = item * 64 + c.lane, b = i >> 8, ch = i & 255;
        float h = 0.f;
#pragma unroll 8
        for (int s = 0; s < SEQ; ++s) { const size_t t = (size_t)b * SEQ + s;
            h = AA[t * 256 + ch] * h + BT[t * 256 + ch];
            ROUT[t * 256 + ch] = f2bf(h * gelu_f(bf2f(Z[t * ZW + ZC_G + ch]))); }
    }
}

__device__ __forceinline__ void ph_mixnorm(const Ctx& c, const bf16* AO, const bf16* SOUT, const bf16* ROUT, const float* g, bf16* Y) {
    const int lane = c.lane;
    for (int row = c.gw; row < T; row += c.ngw) {
        {   float v[8]; unpack8(*(const uint4*)(AO + (size_t)row * 512 + 8 * lane), v);
            float ss = 0.f;
#pragma unroll
            for (int e = 0; e < 8; ++e) ss += v[e] * v[e];
            const float rstd = rsqrtf(wave_sum(ss) * (1.f / 512) + EPS); const float* gg = g + 8 * lane;
            *(uint4*)(Y + (size_t)row * DM + 8 * lane) = make_uint4(pk2(v[0] * rstd * gg[0], v[1] * rstd * gg[1]), pk2(v[2] * rstd * gg[2], v[3] * rstd * gg[3]),
                                                                    pk2(v[4] * rstd * gg[4], v[5] * rstd * gg[5]), pk2(v[6] * rstd * gg[6], v[7] * rstd * gg[7])); }
#pragma unroll
        for (int part = 0; part < 2; ++part) {
            const bf16* src = part == 0 ? SOUT : ROUT; const int off = 512 + 256 * part;
            const uint2 w = *(const uint2*)(src + (size_t)row * 256 + 4 * lane);
            float a0 = __uint_as_float(w.x << 16), a1 = __uint_as_float(w.x & 0xffff0000u), a2 = __uint_as_float(w.y << 16), a3 = __uint_as_float(w.y & 0xffff0000u);
            const float rstd = rsqrtf(wave_sum(a0 * a0 + a1 * a1 + a2 * a2 + a3 * a3) * (1.f / 256) + EPS); const float* gg = g + off + 4 * lane;
            *(uint2*)(Y + (size_t)row * DM + off + 4 * lane) = make_uint2(pk2(a0 * rstd * gg[0], a1 * rstd * gg[1]), pk2(a2 * rstd * gg[2], a3 * rstd * gg[3]));
        }
    }
}

__device__ __forceinline__ void ph_topk_a(const Ctx& c, const float* SC, float* STOP, int* ITOP) {
    for (int i = c.gt; i < T * 16; i += c.ngt) {
        const float* sc = SC + (size_t)i * 128;
        float pv = INFINITY; int pn = -1;
        for (int it = 0; it < 16; ++it) {
            float bv = -INFINITY; int bn = 1 << 30;
            for (int n = 0; n < 128; ++n) { const float v = sc[n];
                const bool elig = (v < pv) || (v == pv && n > pn);
                if (elig && (v > bv || (v == bv && n < bn))) { bv = v; bn = n; } }
            STOP[(size_t)i * 16 + it] = bv; ITOP[(size_t)i * 16 + it] = bn; pv = bv; pn = bn;
        }
    }
}
__device__ __forceinline__ void ph_topk_b(const Ctx& c, const float* STOP, const int* ITOP, int* IDX, float* GATE) {
    LAS float* my = (LAS float*)c.lds + c.tid * 33;
    for (int i = c.gt; i < T * 8; i += c.ngt) {
        for (int k = 0; k < 32; ++k) my[k] = STOP[(size_t)i * 32 + k];
        float pv = INFINITY; int pn = -1; float best0 = 0.f, den = 0.f;
        float ev[16];
#pragma unroll
        for (int it = 0; it < 16; ++it) {
            float bv = -INFINITY; int bn = 1 << 30;
            for (int f = 0; f < 256; ++f) { const float v = my[f >> 4] + my[16 + (f & 15)];
                const bool elig = (v < pv) || (v == pv && f > pn);
                if (elig && (v > bv || (v == bv && f < bn))) { bv = v; bn = f; } }
            pv = bv; pn = bn;
            if (it == 0) best0 = bv;
            ev[it] = expf(bv - best0); den += ev[it];
            IDX[(size_t)i * 16 + it] = ITOP[(size_t)i * 32 + (bn >> 4)] * 128 + ITOP[(size_t)i * 32 + 16 + (bn & 15)];
        }
#pragma unroll
        for (int it = 0; it < 16; ++it) GATE[(size_t)i * 16 + it] = ev[it] / den;
    }
}

__device__ __forceinline__ void ph_gather(const Ctx& c, const bf16* HN, const int* IDX, const float* GATE, const bf16* PU, const bf16* PV, float* X) {
    const int lane = c.lane;
    for (int t = c.gw; t < T; t += c.ngw) {
        float hn[16]; unpack8(*(const uint4*)(HN + (size_t)t * DM + 8 * lane), hn); unpack8(*(const uint4*)(HN + (size_t)t * DM + 512 + 8 * lane), hn + 8);
        float y[16];
#pragma unroll
        for (int e = 0; e < 16; ++e) y[e] = 0.f;
        for (int k = 0; k < 128; ++k) {
            const int e = IDX[(size_t)t * 128 + k]; const float gt = GATE[(size_t)t * 128 + k];
            const bf16* ur = PU + (size_t)e * DM; const bf16* vr = PV + (size_t)e * DM;
            float u[16]; unpack8(*(const uint4*)(ur + 8 * lane), u); unpack8(*(const uint4*)(ur + 512 + 8 * lane), u + 8);
            float d = 0.f;
#pragma unroll
            for (int q = 0; q < 16; ++q) d += u[q] * hn[q];
            d = wave_sum(d);
            const float w = gt * gelu_f(d);
            float v[16]; unpack8(*(const uint4*)(vr + 8 * lane), v); unpack8(*(const uint4*)(vr + 512 + 8 * lane), v + 8);
#pragma unroll
            for (int q = 0; q < 16; ++q) y[q] += w * v[q];
        }
        float4* xo = (float4*)(X + (size_t)t * DM + 8 * lane);
        float4 p0 = xo[0], p1 = xo[1]; p0.x += y[0]; p0.y += y[1]; p0.z += y[2]; p0.w += y[3]; p1.x += y[4]; p1.y += y[5]; p1.z += y[6]; p1.w += y[7]; xo[0] = p0; xo[1] = p1;
        xo = (float4*)(X + (size_t)t * DM + 512 + 8 * lane);
        p0 = xo[0]; p1 = xo[1]; p0.x += y[8]; p0.y += y[9]; p0.z += y[10]; p0.w += y[11]; p1.x += y[12]; p1.y += y[13]; p1.z += y[14]; p1.w += y[15]; xo[0] = p0; xo[1] = p1;
    }
}
namespace att {
typedef short bf16x8 __attribute__((ext_vector_type(8)));
typedef short s16x4 __attribute__((ext_vector_type(4)));
typedef float f32x16 __attribute__((ext_vector_type(16)));
typedef unsigned u32x4 __attribute__((ext_vector_type(4)));
constexpr int KT = 64, KBYTES = KT * DQK * 2, VBYTES = KT * DV * 2, BUFB = KBYTES + VBYTES;
constexpr int OFF_WS = 2 * BUFB, OFF_MO = 0, OFF_ML = 65536, LDS_NEED = OFF_WS + 8 * 64 * 4;
constexpr float THR = 8.f;
__device__ __forceinline__ int kswz(int row, int c) { return row * 384 + (((c & ~7) | ((c & 7) ^ ((row >> 1) & 7))) << 4); }
__device__ __forceinline__ int v_st(int k, int c) { const int kk = (k & ~0xC) | ((k & 4) << 1) | ((k & 8) >> 1); return ((kk >> 3) * 4 + (c >> 5)) * 512 + ((kk & 7) * 32 + (c & 31)) * 2; }
__device__ __forceinline__ int v_rd_base(int lane) { return ((lane & 3) << 3) | (((lane >> 2) & 3) << 6) | (((lane >> 4) & 1) << 5) | (((lane >> 5) & 1) << 8); }
__device__ __forceinline__ int crow(int r, int hi) { return (r & 3) + 8 * (r >> 2) + 4 * hi; }
__device__ __forceinline__ unsigned cvtpk(float lo, float hi) { unsigned r; asm volatile("v_cvt_pk_bf16_f32 %0, %1, %2" : "=v"(r) : "v"(lo), "v"(hi)); return r; }
#define ATT_SBAR() __builtin_amdgcn_sched_barrier(0)

__device__ __forceinline__ void attn_unit(LAS unsigned char* lds, const bf16* Qg, const bf16* Kg, const bf16* Vg, bf16* AO, int bh, int qb, int tid) {
    const int lane = tid & 63, wid = __builtin_amdgcn_readfirstlane(tid >> 6), qsub = wid & 3, kh = wid >> 2, r32 = lane & 31, hi = lane >> 5;
    const int q0 = qb * 128, NT = 2 * (qb + 1);
    const size_t rowbase = (size_t)bh * SEQ;
    bf16x8 qr[12];
    { const bf16* qp = Qg + (rowbase + q0 + 32 * qsub + r32) * DQK + 8 * hi;
#pragma unroll
      for (int ks = 0; ks < 12; ++ks) qr[ks] = *(const bf16x8*)(qp + 16 * ks); }
    int ksrc[3], vsrc[2];
#pragma unroll
    for (int j = 0; j < 3; ++j) { const int L = (wid + 8 * j) * 64 + lane, row = L / 24, cp = L - row * 24, c = (cp & ~7) | ((cp & 7) ^ ((row >> 1) & 7)); ksrc[j] = row * DQK + c * 8; }
#pragma unroll
    for (int j = 0; j < 2; ++j) { const int X = ((wid + 8 * j) * 64 + lane) * 16, sub = X >> 9, within = (X & 511) >> 1, kk = ((sub >> 2) << 3) | (within >> 5);
        const int k = (kk & ~0xC) | ((kk & 4) << 1) | ((kk & 8) >> 1), c = (sub & 3) * 32 + (within & 31); vsrc[j] = k * DV + c; }
    const bf16* Kt = Kg + rowbase * DQK; const bf16* Vt = Vg + rowbase * DV;
#define ATT_STAGE(t, bo) do { const bf16* kp_ = Kt + (size_t)(t) * (KT * DQK); const bf16* vp_ = Vt + (size_t)(t) * (KT * DV); \
        _Pragma("unroll") for (int j_ = 0; j_ < 3; ++j_) __builtin_amdgcn_global_load_lds((const unsigned*)(kp_ + ksrc[j_]), (LAS unsigned*)(lds + (bo) + (wid + 8 * j_) * 1024), 16, 0, 0); \
        _Pragma("unroll") for (int j_ = 0; j_ < 2; ++j_) __builtin_amdgcn_global_load_lds((const unsigned*)(vp_ + vsrc[j_]), (LAS unsigned*)(lds + (bo) + KBYTES + (wid + 8 * j_) * 1024), 16, 0, 0); } while (0)
    const int krow = 32 * kh + r32, kf = (krow >> 1) & 7;
    int kb[4];
#pragma unroll
    for (int j = 0; j < 4; ++j) kb[j] = krow * 384 + ((((2 * j + hi) & 7) ^ kf) << 4);
    const int vb = KBYTES + v_rd_base(lane) + kh * 8192;
    LAS float* wsf = (LAS float*)(lds + OFF_WS) + wid * 64;
    float m_reg = -1e30f, l_reg = 0.f; f32x16 o[4];
#pragma unroll
    for (int d = 0; d < 4; ++d) o[d] = f32x16{};
    const int rb = 32 * qsub;
    ATT_STAGE(0, 0);
    asm volatile("s_waitcnt vmcnt(0)" ::: "memory");
    __syncthreads();
    for (int t = 0; t < NT; ++t) {
        const int bo = (t & 1) * BUFB;
        if (t + 1 < NT) ATT_STAGE(t + 1, BUFB - bo);
        const int kboff = 64 * t + 32 * kh - q0;
        const bool act = kboff <= rb, diag = kboff == rb;
        if (act) {
            f32x16 p = f32x16{};
#pragma unroll
            for (int ks = 0; ks < 12; ++ks) {
                const bf16x8 kfr = *(const LAS bf16x8*)(lds + bo + kb[ks & 3] + (ks >> 2) * 128);
                p = __builtin_amdgcn_mfma_f32_32x32x16_bf16(kfr, qr[ks], p, 0, 0, 0);
            }
            if (diag) {
#pragma unroll
                for (int r = 0; r < 16; ++r) if (crow(r, hi) > r32) p[r] = -__builtin_inff();
            }
            float pmax = p[0];
#pragma unroll
            for (int r = 1; r < 16; ++r) pmax = fmaxf(pmax, p[r]);
            { auto rr = __builtin_amdgcn_permlane32_swap(__float_as_uint(pmax), __float_as_uint(pmax), false, false);
              pmax = fmaxf(__uint_as_float(rr[0]), __uint_as_float(rr[1])); }
            float alpha = 1.f;
            if (!__all(pmax - m_reg <= THR)) { const float mn = fmaxf(m_reg, pmax); alpha = __builtin_amdgcn_exp2f(m_reg - mn); m_reg = mn; }
#pragma unroll
            for (int r = 0; r < 16; ++r) p[r] = __builtin_amdgcn_exp2f(p[r] - m_reg);
            float ps = 0.f;
#pragma unroll
            for (int r = 0; r < 16; ++r) ps += p[r];
            { auto rr = __builtin_amdgcn_permlane32_swap(__float_as_uint(ps), __float_as_uint(ps), false, false);
              ps = __uint_as_float(rr[0]) + __uint_as_float(rr[1]); }
            l_reg = l_reg * alpha + ps;
            if (__any(alpha < 1.f)) {
                if (hi == 0) wsf[r32] = alpha;
                asm volatile("s_waitcnt lgkmcnt(0)" ::: "memory");
#pragma unroll
                for (int r = 0; r < 16; ++r) { const float al = wsf[crow(r, hi)];
#pragma unroll
                    for (int d = 0; d < 4; ++d) o[d][r] *= al; }
            }
            bf16x8 pa0, pa1;
#define ATT_PK4(B_, OUT) do { unsigned a0 = cvtpk(p[B_ + 0], p[B_ + 1]), a1 = cvtpk(p[B_ + 2], p[B_ + 3]); unsigned b0 = cvtpk(p[B_ + 4], p[B_ + 5]), b1 = cvtpk(p[B_ + 6], p[B_ + 7]); \
            auto r0 = __builtin_amdgcn_permlane32_swap(a0, b0, false, false); auto r1 = __builtin_amdgcn_permlane32_swap(a1, b1, false, false); \
            u32x4 w_ = {r0[0], r1[0], r0[1], r1[1]}; OUT = __builtin_bit_cast(bf16x8, w_); } while (0)
            ATT_PK4(0, pa0); ATT_PK4(8, pa1);
#undef ATT_PK4
            const int vaddr = (int)(uintptr_t)lds + bo + vb;
#define ATT_TRRD(dst, off) asm volatile("ds_read_b64_tr_b16 %0, %1 offset:%2" : "=&v"(dst) : "v"(vaddr), "i"(off) : "memory")
#define ATT_PV(d0) do { s16x4 l0, h0, l1, h1; \
            ATT_TRRD(l0, (d0) * 512); ATT_TRRD(h0, (d0) * 512 + 2048); ATT_TRRD(l1, (d0) * 512 + 4096); ATT_TRRD(h1, (d0) * 512 + 6144); \
            asm volatile("s_waitcnt lgkmcnt(0)" ::: "memory"); ATT_SBAR(); \
            o[d0] = __builtin_amdgcn_mfma_f32_32x32x16_bf16(pa0, (bf16x8){l0[0], l0[1], l0[2], l0[3], h0[0], h0[1], h0[2], h0[3]}, o[d0], 0, 0, 0); \
            o[d0] = __builtin_amdgcn_mfma_f32_32x32x16_bf16(pa1, (bf16x8){l1[0], l1[1], l1[2], l1[3], h1[0], h1[1], h1[2], h1[3]}, o[d0], 0, 0, 0); } while (0)
            ATT_PV(0); ATT_PV(1); ATT_PV(2); ATT_PV(3);
#undef ATT_PV
#undef ATT_TRRD
        }
        asm volatile("s_waitcnt vmcnt(0)" ::: "memory");
        __syncthreads();
    }
    LAS float* MO = (LAS float*)(lds + OFF_MO) + qsub * 4096; LAS float* ML = (LAS float*)(lds + OFF_ML) + qsub * 64;
    if (kh == 1) {
        if (hi == 0) { ML[2 * r32] = m_reg; ML[2 * r32 + 1] = l_reg; }
#pragma unroll
        for (int d = 0; d < 4; ++d)
#pragma unroll
            for (int r = 0; r < 16; ++r) MO[(d * 16 + r) * 64 + lane] = o[d][r];
    }
    __syncthreads();
    if (kh == 0) {
        const float m1 = ML[2 * r32], l1 = ML[2 * r32 + 1];
        const float mm = fmaxf(m_reg, m1), f0 = __builtin_amdgcn_exp2f(m_reg - mm), f1 = __builtin_amdgcn_exp2f(m1 - mm);
        const float il = 1.f / (l_reg * f0 + l1 * f1);
        if (hi == 0) { wsf[r32] = f0 * il; wsf[32 + r32] = f1 * il; }
        asm volatile("s_waitcnt lgkmcnt(0)" ::: "memory");
        const int b = bh / NH, h = bh % NH;
        bf16* Ow = AO + ((size_t)b * SEQ + q0 + rb) * 512 + h * DV;
#pragma unroll
        for (int r = 0; r < 16; ++r) { const int orow = crow(r, hi); const float g0 = wsf[orow], g1 = wsf[32 + orow];
#pragma unroll
            for (int d = 0; d < 4; ++d) { const float v = o[d][r] * g0 + MO[(d * 16 + r) * 64 + lane] * g1; const float vn = __shfl_xor(v, 1);
                if ((r32 & 1) == 0) *(unsigned*)(Ow + (size_t)orow * 512 + d * 32 + r32) = cvtpk(v, vn); } }
    }
    __syncthreads();
#undef ATT_STAGE
}
__device__ __forceinline__ void attn_phase(LAS unsigned char* lds, const bf16* Qg, const bf16* Kg, const bf16* Vg, bf16* AO, int G, int bid, int tid) {
    const int npair = NB * NH * 32;
    for (int v0 = bid; v0 < npair; v0 += G) {
        const int vcu = (G % 8 == 0 && npair % G == 0) ? (v0 % 8) * (npair / 8) + v0 / 8 : v0;
        const int bh = vcu >> 5, s = vcu & 31;
        for (int u = 0; u < 2; ++u) attn_unit(lds, Qg, Kg, Vg, AO, bh, u ? s : 63 - s, tid);
    }
}
#undef ATT_SBAR
}
#ifndef MK_SIMPLE_TOPK
#define MK_SIMPLE_TOPK 0
#endif
#ifndef MK_SIMPLE_SCAN
#define MK_SIMPLE_SCAN 0
#endif
#ifndef MK_SIMPLE_ATTN
#define MK_SIMPLE_ATTN 0
#endif
#ifndef MK_SIMPLE_GEMM
#define MK_SIMPLE_GEMM 0
#endif
constexpr int NPH_LAYER = 16, NPH = 1 + NL * NPH_LAYER;
struct GD { const bf16* A; const bf16* Bt; void* C; const float* aux0; const bf16* aux1; int lda, M, N, K, ldc, kind; };
template <class Epi> __device__ __forceinline__ void run_gemm(const Ctx& c, const bf16* A, int lda, const bf16* Bt, int M, int N, int K, const Epi& E) {
    pg8::Gemm g{A, Bt, M, N, K, lda}; pg8::StaticOrder S; S.init(M, N, c.G, c.bid);
    pg8::gemm_phase<Epi, pg8::StaticOrder, true, true>(c.lds, g, S, E);
}
#define AS4 __attribute__((address_space(4)))
__global__ void __launch_bounds__(NTHR, 2) mega(Args a_) {
    extern __shared__ __attribute__((aligned(16))) unsigned char lds_raw[];
    {   const int t0 = threadIdx.x;
        for (int u = t0; u < (LDS_BYTES - RING_BYTES) / 4; u += NTHR) ((LAS unsigned*)((LAS unsigned char*)lds_raw + RING_BYTES))[u] = 0u; }
    __syncthreads();
    volatile LAS unsigned* MISC = (volatile LAS unsigned*)((LAS unsigned char*)lds_raw + MISC_OFF);
    XcdBarrier bar; bar.bar = (unsigned*)(a_.ws + WS_CTL) + CW_BAR; bar.x = 0; bar.st = MISC + 8;
    const int ph_lo = a_.ph_lo, ph_hi = a_.ph_hi;
    if (ph_hi - ph_lo > 1) bar = xcd_barrier_post((unsigned*)(a_.ws + WS_CTL) + CW_BAR, MISC + 8);

    int p = ph_lo;
    if (p == 0) {
        const Args AS4* ap0 = (const Args AS4*)__builtin_amdgcn_kernarg_segment_ptr(); Ctx c0; c0.lds = (LAS unsigned char*)lds_raw; c0.tid = threadIdx.x; c0.lane = c0.tid & 63; c0.wave = __builtin_amdgcn_readfirstlane(c0.tid >> 6);
        c0.G = gridDim.x; c0.bid = blockIdx.x; c0.gw = c0.wave * c0.G + c0.bid; c0.ngw = NWAVES * c0.G; c0.gt = c0.bid * NTHR + c0.tid; c0.ngt = c0.G * NTHR;
        ph_prep(*ap0, c0);
        if (p + 1 < ph_hi) xcd_barrier(bar);
        p = 1;
    }
    for (; p < ph_hi; ++p) {
        const Args AS4* ap = (const Args AS4*)__builtin_amdgcn_kernarg_segment_ptr(); asm volatile("" : "+s"(ap));
        int tid_ = threadIdx.x; asm volatile("" : "+v"(tid_));
#define a (*ap)
        Ctx c; c.lds = (LAS unsigned char*)lds_raw; c.tid = tid_; c.lane = c.tid & 63; c.wave = __builtin_amdgcn_readfirstlane(c.tid >> 6);
        { int G_ = gridDim.x, bid_ = blockIdx.x; asm volatile("" : "+s"(G_), "+s"(bid_)); c.G = G_; c.bid = bid_; }
        c.gw = c.wave * c.G + c.bid; c.ngw = NWAVES * c.G; c.gt = c.bid * NTHR + c.tid; c.ngt = c.G * NTHR;
        bf16 *WINT = WSP(bf16, WS_WINT), *WUQT = WSP(bf16, WS_WUQT), *WUKVT = WSP(bf16, WS_WUKVT), *GLUT = WSP(bf16, WS_GLUT), *WOUTT = WSP(bf16, WS_WOUTT),
             *WQT = WSP(bf16, WS_WQT), *SUBKT = WSP(bf16, WS_SUBKT), *PU = WSP(bf16, WS_PU), *PV = WSP(bf16, WS_PV);
        float *COS = WSP(float, WS_COS), *SIN = WSP(float, WS_SIN);
        bf16 *XB = WSP(bf16, WS_XB), *Z = WSP(bf16, WS_Z), *QRAW = WSP(bf16, WS_QRAW), *KVRAW = WSP(bf16, WS_KVRAW), *QB = WSP(bf16, WS_QB), *KB = WSP(bf16, WS_KB),
             *VB = WSP(bf16, WS_VB), *CQN = WSP(bf16, WS_CQN), *CKVN = WSP(bf16, WS_CKVN), *AO = WSP(bf16, WS_AO), *ROUT = WSP(bf16, WS_ROUT), *Y = WSP(bf16, WS_Y),
             *YG = WSP(bf16, WS_YG), *SOUT = WSP(bf16, WS_SOUT), *QP = WSP(bf16, WS_QP);
        float *XC = WSP(float, WS_XC), *AA = WSP(float, WS_AA), *BT = WSP(float, WS_BT), *SC = WSP(float, WS_SC), *STOP = WSP(float, WS_STOP), *GATE = WSP(float, WS_GATE);
        int *ITOP = WSP(int, WS_ITOP), *IDX = WSP(int, WS_IDX);
        float* out = a.out;
        {
            const int l = (p - 1) / NPH_LAYER, k = (p - 1) % NPH_LAYER;
            const float* xin = (l == 0) ? INF(0) : out;
            GD gd; gd.kind = 0; gd.A = nullptr; gd.Bt = nullptr; gd.C = nullptr; gd.aux0 = nullptr; gd.aux1 = nullptr; gd.lda = 0; gd.M = T; gd.N = 0; gd.K = 0; gd.ldc = 0;
#define SETG(kind_, A_, lda_, Bt_, M_, N_, K_, C_, ldc_, aux0_, aux1_) do { gd.kind = kind_; gd.A = A_; gd.lda = lda_; gd.Bt = Bt_; gd.M = M_; gd.N = N_; gd.K = K_; gd.C = (void*)(C_); gd.ldc = ldc_; gd.aux0 = aux0_; gd.aux1 = aux1_; } while (0)
            switch (k) {
            case 0: ph_rowprep(c, xin, INF(2) + l * DM, XB); break;
            case 1: SETG(1, XB, DM, WINT + (size_t)l * ZW * DM, T, ZW, DM, Z, ZW, nullptr, nullptr); break;
            case 2: ph_zstats(c, Z, INF(4) + l * 256, INF(6) + l * 128, CQN, CKVN);
#if MK_SIMPLE_SCAN
                ph_lru_xc(c, Z, INF(20) + l * 1024, INF(21) + l * 256, XC);
#else
                s5f::pass<false>(c.lds, Z, WSP(bf16, WS_S5A) + (size_t)l * 32768, WSP(bf16, WS_S5C) + (size_t)l * 32768, WSP(float2, WS_S5L) + l * 1024, INF(17) + l * 256, WSP(float2, WS_SE), WSP(float2, WS_SH), YG, c.gw, c.ngw, c.wave, c.lane);
                __syncthreads();
                lruf::pass_a(c.lds, Z, INF(20) + l * 1024, INF(21) + l * 256, INF(22) + l * 16384, INF(23) + l * 256, INF(24) + l * 16384, INF(25) + l * 256, INF(26) + l * 256, AA, BT, WSP(float2, WS_LPE), c.gw, c.ngw, c.wave, c.lane);
#endif
                break;
            case 3: SETG(1, CQN, 256, WUQT + (size_t)l * 768 * 256, T, 768, 256, QRAW, 768, nullptr, nullptr);
#if !MK_SIMPLE_SCAN
                s5f::carry(WSP(float2, WS_S5L) + l * 1024, WSP(float2, WS_SE), WSP(float2, WS_SH), c.gw, c.ngw, c.lane);
                lruf::carry(WSP(float2, WS_LPE), WSP(float, WS_LH), c.gt, c.ngt);
#endif
                break;
            case 4: SETG(1, CKVN, 128, WUKVT + (size_t)l * 1024 * 128, T, 1024, 128, KVRAW, 1024, nullptr, nullptr);
#if MK_SIMPLE_SCAN
                ph_lru_gates(c, XC, INF(22) + l * 16384, INF(23) + l * 256, INF(24) + l * 16384, INF(25) + l * 256, INF(26) + l * 256, AA, BT);
#endif
                break;
            case 5: ph_qkfin(c, QRAW, KVRAW, Z, INF(8) + l * DQK, INF(9) + l * DQK, COS, SIN, QB, KB, VB); break;
            case 6:
#if MK_SIMPLE_SCAN
                ph_s5_simple(c, Z, INF(10) + l * 1024, INF(11) + l * 1024, INF(12) + l * 16, INF(13) + l * 16384, INF(14) + l * 16384, INF(15) + l * 16384, INF(16) + l * 16384, INF(17) + l * 256, YG);
                ph_lru_scan(c, AA, BT, Z, ROUT);
#else
                s5f::pass<true>(c.lds, Z, WSP(bf16, WS_S5A) + (size_t)l * 32768, WSP(bf16, WS_S5C) + (size_t)l * 32768, WSP(float2, WS_S5L) + l * 1024, INF(17) + l * 256, WSP(float2, WS_SE), WSP(float2, WS_SH), YG, c.gw, c.ngw, c.wave, c.lane);
                lruf::pass_b(AA, BT, WSP(float, WS_LH), Z, ROUT, c.gt, c.ngt);
#endif
#if MK_SIMPLE_ATTN
                ph_attn_simple(c, QB, KB, VB, AO);
#else
                __syncthreads(); att::attn_phase(c.lds, QB, KB, VB, AO, c.G, c.bid, c.tid);
#endif
                break;
            case 7: SETG(3, YG, 256, GLUT + (size_t)l * 65536, T, 256, 256, SOUT, 256, INF(19) + l * 256, YG); break;
            case 8: ph_mixnorm(c, AO, SOUT, ROUT, INF(27) + l * DM, Y); break;
            case 9: SETG(2, Y, DM, WOUTT + (size_t)l * DM * DM, T, DM, DM, out, DM, xin, nullptr); break;
            case 10: ph_rowprep(c, out, INF(29) + l * DM, XB); break;
            case 11: SETG(1, XB, DM, WQT + (size_t)l * 2048 * DM, T, 2048, DM, QP, 2048, nullptr, nullptr); break;
            case 12: SETG(2, QP, 256, SUBKT + (size_t)l * 65536, T * 8, 256, 256, SC, 256, nullptr, nullptr); break;
#if MK_SIMPLE_TOPK
            case 13: ph_topk_a(c, SC, STOP, ITOP); break;
            case 14: ph_topk_b(c, STOP, ITOP, IDX, GATE); break;
#else
            case 13: tk::topk_phase(SC, IDX, GATE, c.gw, c.ngw, c.lane); break;
            case 14: break;
#endif
            default: ph_gather(c, XB, IDX, GATE, PU + (size_t)l * 16384 * DM, PV + (size_t)l * 16384 * DM, out); break;
            }
#undef SETG
#if MK_SIMPLE_GEMM
            if (gd.kind == 1) gemm_simple<EPI_BF16>(c, gd.A, gd.lda, gd.Bt, gd.M, gd.N, gd.K, gd.C, gd.ldc, nullptr, nullptr);
            else if (gd.kind == 2) { if (gd.aux0) gemm_simple<EPI_RESID>(c, gd.A, gd.lda, gd.Bt, gd.M, gd.N, gd.K, gd.C, gd.ldc, gd.aux0, nullptr); else gemm_simple<EPI_F32>(c, gd.A, gd.lda, gd.Bt, gd.M, gd.N, gd.K, gd.C, gd.ldc, nullptr, nullptr); }
            else if (gd.kind == 3) gemm_simple<EPI_GLU>(c, gd.A, gd.lda, gd.Bt, gd.M, gd.N, gd.K, gd.C, gd.ldc, gd.aux0, gd.aux1);
#else
            if (gd.kind == 1) run_gemm(c, gd.A, gd.lda, gd.Bt, gd.M, gd.N, gd.K, pg8::EpiBf16<0>{(bf16*)gd.C, gd.ldc, nullptr, 0, 0, 1.f});
            else if (gd.kind == 2) run_gemm(c, gd.A, gd.lda, gd.Bt, gd.M, gd.N, gd.K, pg8::EpiF32{(float*)gd.C, gd.ldc, gd.aux0});
            else if (gd.kind == 3) run_gemm(c, gd.A, gd.lda, gd.Bt, gd.M, gd.N, gd.K, pg8::EpiGlu{(bf16*)gd.C, gd.ldc, gd.aux0, gd.aux1});
#endif
        }
        if (p + 1 < ph_hi) { XcdBarrier b2 = bar; unsigned* bb = (unsigned*)(a.ws + WS_CTL) + CW_BAR; unsigned bx = bar.x; asm volatile("" : "+s"(bb), "+s"(bx)); b2.bar = bb; b2.x = bx; xcd_barrier(b2); }
#undef a
    }
}

extern "C" void kernel_launch(void* const* d_in, const int* in_sizes, int n_in, void* d_out, int out_size, void* d_ws, size_t ws_size, hipStream_t stream) {
    static int grid = 0;
    if (grid == 0) {
        if (n_in != 34 || out_size != T * DM || ws_size < WS_END) { fprintf(stderr, "kernel_launch: unexpected shapes (n_in %d out %d ws %zu)\n", n_in, out_size, ws_size); grid = -1; return; }
        int dev = 0, cus = 0, per_cu = 0;
        if (hipGetDevice(&dev) != hipSuccess || hipDeviceGetAttribute(&cus, hipDeviceAttributeMultiprocessorCount, dev) != hipSuccess) { grid = -1; return; }
        if (hipFuncSetAttribute((const void*)mega, hipFuncAttributeMaxDynamicSharedMemorySize, LDS_BYTES) != hipSuccess) { fprintf(stderr, "kernel_launch: hipFuncSetAttribute failed\n"); grid = -1; return; }
        if (hipOccupancyMaxActiveBlocksPerMultiprocessor(&per_cu, (const void*)mega, NTHR, LDS_BYTES) != hipSuccess || per_cu < 1) { fprintf(stderr, "kernel_launch: occupancy query says %d blocks per CU\n", per_cu); }
        (void)hipGetLastError();
        grid = cus;
    }
    if (grid < 0) return;
    (void)hipMemsetAsync((char*)d_ws + WS_CTL, 0, CTL_ZERO_BYTES, stream);
    Args a{};
    for (int i = 0; i < 34; ++i) a.in[i] = d_in[i];
    a.out = (float*)d_out; a.ws = (unsigned char*)d_ws;
#if MK_PER_PHASE
    for (int p = 0; p < NPH; ++p) { a.ph_lo = p; a.ph_hi = p + 1; hipLaunchKernelGGL(mega, dim3(grid), dim3(NTHR), LDS_BYTES, stream, a); }
#else
    a.ph_lo = 0; a.ph_hi = NPH;
    hipLaunchKernelGGL(mega, dim3(grid), dim3(NTHR), LDS_BYTES, stream, a);
#endif
}
```

```cpp
#include <hip/hip_runtime.h>
#include <cstdint>
#include <cstdio>

#ifndef MK_PER_PHASE
#define MK_PER_PHASE 0
#endif

typedef unsigned short bf16;
typedef unsigned int u32;

constexpr int NB = 2, SEQ = 8192, T = NB * SEQ, DM = 1024, NL = 2;
constexpr int ZW = 1280;
constexpr int ZC_CQ = 0, ZC_CKV = 256, ZC_KR = 384, ZC_U = 512, ZC_X = 768, ZC_G = 1024;
constexpr int NH = 4, DQK = 192, DV = 128;
constexpr float EPS = 1e-6f;
constexpr float QSCALE = 0.07216878364870322f * 1.4426950408889634f;

constexpr size_t MiB = 1u << 20;
constexpr size_t WS_CTL = 0, CTL_ZERO_BYTES = 1 * MiB, WS_WINT = 1 * MiB, WS_WUQT = 7 * MiB, WS_WUKVT = 8 * MiB, WS_GLUT = 9 * MiB, WS_WOUTT = 10 * MiB,
                 WS_WQT = 14 * MiB, WS_SUBKT = 22 * MiB, WS_COS = 23 * MiB, WS_SIN = 25 * MiB, WS_PU = 28 * MiB, WS_PV = 92 * MiB,
                 WS_XB = 156 * MiB, WS_Z = 188 * MiB, WS_RA = 228 * MiB, WS_RB = 356 * MiB, WS_CKVN = 420 * MiB, WS_AO = 424 * MiB,
                 WS_ROUT = 440 * MiB, WS_Y = 448 * MiB, WS_IDX = 480 * MiB, WS_GATE = 488 * MiB, WS_S5A = 496 * MiB, WS_S5C = WS_S5A + 128 * 1024, WS_S5L = WS_S5A + 256 * 1024,
                 WS_SE = 497 * MiB, WS_SH = 501 * MiB, WS_LPE = 505 * MiB, WS_LH = 506 * MiB, WS_END = 507 * MiB;
constexpr size_t WS_QRAW = WS_RA, WS_KVRAW = WS_RA + 24 * MiB, WS_QB = WS_RA + 56 * MiB, WS_KB = WS_RA + 80 * MiB, WS_VB = WS_RA + 104 * MiB,
                 WS_CQN = WS_RA + 120 * MiB, WS_SC = WS_RA;
constexpr size_t WS_XC = WS_RB, WS_AA = WS_RB + 16 * MiB, WS_BT = WS_RB + 32 * MiB, WS_YG = WS_RB + 48 * MiB, WS_SOUT = WS_RB + 56 * MiB, WS_QP = WS_RB;
constexpr size_t WS_STOP = WS_Z, WS_ITOP = WS_Z + 16 * MiB;
constexpr int CW_BAR = 4096;

__device__ __forceinline__ float bf2f(bf16 h) { return __uint_as_float((u32)h << 16); }
__device__ __forceinline__ bf16 f2bf(float f) { u32 u = __float_as_uint(f); return (bf16)((u + 0x7fffu + ((u >> 16) & 1u)) >> 16); }
__device__ __forceinline__ u32 pk2(float lo, float hi) { return (u32)f2bf(lo) | ((u32)f2bf(hi) << 16); }
__device__ __forceinline__ float wave_sum(float v) {
#pragma unroll
    for (int o = 32; o > 0; o >>= 1) v += __shfl_xor(v, o);
    return v;
}
__device__ __forceinline__ float wave_max(float v) {
#pragma unroll
    for (int o = 32; o > 0; o >>= 1) v = fmaxf(v, __shfl_xor(v, o));
    return v;
}
__device__ __forceinline__ float gelu_f(float x) { return 0.5f * x * (1.f + erff(x * 0.70710678118654752f)); }
__device__ __forceinline__ float sigmoid_f(float x) { return 1.f / (1.f + __expf(-x)); }
__device__ __forceinline__ void unpack8(uint4 w, float* o) {
    o[0] = __uint_as_float(w.x << 16); o[1] = __uint_as_float(w.x & 0xffff0000u);
    o[2] = __uint_as_float(w.y << 16); o[3] = __uint_as_float(w.y & 0xffff0000u);
    o[4] = __uint_as_float(w.z << 16); o[5] = __uint_as_float(w.z & 0xffff0000u);
    o[6] = __uint_as_float(w.w << 16); o[7] = __uint_as_float(w.w & 0xffff0000u);
}
__device__ __forceinline__ void sincos_acc(float x, float& s, float& c) {
    const float k = rintf(x * 0.15915494309189535f);
    float r = fmaf(-k, 6.28125f, x);
    r = fmaf(-k, 1.9350051879882812e-3f, r);
    r = fmaf(-k, 3.0199160335e-7f, r);
    const float f = r * 0.15915494309189535f;
    s = __builtin_amdgcn_sinf(f); c = __builtin_amdgcn_cosf(f);
}
namespace pg8 {
#define PG8_LAS __attribute__((address_space(3)))
typedef unsigned short bf16_t;
typedef short bf16x8 __attribute__((ext_vector_type(8)));
typedef float f32x4 __attribute__((ext_vector_type(4)));
typedef unsigned u32x4 __attribute__((ext_vector_type(4)));
constexpr int BM = 256, BK = 64, HALF = 128, HTB = HALF * BK * 2  , STAGE_BYTES = 8 * HTB, NXCD = 8, WGM = 8;

__host__ __device__ __forceinline__ int lds_byte(int r, int c) { const int st = (r >> 4) * 2 + (c >> 5), rr = r & 15, cc = c & 31, ob = rr * 64 + cc * 2; return st * 1024 + (ob ^ (((ob >> 9) & 1) << 5)); }
__host__ __device__ __forceinline__ void stage_rc(int b, int& R, int& C) { const int st = b / 1024, sb = b % 1024, swz = sb ^ (((sb >> 9) & 1) << 5); R = (st >> 1) * 16 + swz / 64; C = (st & 1) * 32 + (swz % 64) / 2; }
__host__ __device__ __forceinline__ int perm32(int rho) { const int n = rho >> 4, i = rho & 15; return 8 * (i >> 2) + 4 * n + (i & 3); }

struct Unit { int pm, pn; };
struct Gemm { const bf16_t* A; const bf16_t* Bt; int M, N, K, lda; };

struct StaticOrder {
    int nM, nN, nwg, G, c;
    __host__ __device__ void init(int M, int N, int G_, int c_) { nM = M / BM; nN = N / BM; nwg = nM * nN; G = G_; c = c_; }
    __host__ __device__ bool next(int i, Unit& u) const {
        const long L = (long)i * G + c; if (L >= nwg) return false;
        int wgid = (int)L; { const int q = nwg / NXCD, r = nwg % NXCD, xcd = wgid % NXCD, off = wgid / NXCD; wgid = (xcd < r ? xcd * (q + 1) : r * (q + 1) + (xcd - r) * q) + off; }
        const int nig = WGM * nN, gid = wgid / nig, fm = gid * WGM, gsz = (nM - fm) < WGM ? (nM - fm) : WGM;
        u.pm = fm + ((wgid % nig) % gsz); u.pn = (wgid % nig) / gsz; return true;
    }
    __device__ __forceinline__ void a_ready(const Unit&) const {}
    __device__ __forceinline__ void done(const Unit&) const {}
};

__device__ __forceinline__ unsigned cvt_pk_bf16(float lo, float hi) { unsigned r; asm volatile("v_cvt_pk_bf16_f32 %0, %1, %2" : "=v"(r) : "v"(lo), "v"(hi)); return r; }
typedef float f32x2 __attribute__((ext_vector_type(2)));
__device__ __forceinline__ f32x2 gelu_pk(f32x2 v) {
    const f32x2 av = __builtin_elementwise_abs(v), d = av * 0.2316418882f + 1.0f;
    f32x2 t; t.x = __builtin_amdgcn_rcpf(d.x); t.y = __builtin_amdgcn_rcpf(d.y);
    f32x2 q = t * 0.5307027145f + (-0.7265760135f); q = q * t + 0.7107068705f; q = q * t + (-0.142248368f); q = q * t + 0.127414796f; q = q * t;
    const f32x2 s = (v * v) * (-0.72134752044f);
    f32x2 e; e.x = __builtin_amdgcn_exp2f(s.x); e.y = __builtin_amdgcn_exp2f(s.y);
    const f32x2 m = v * (q * e), r = v - m;
    f32x2 o; o.x = v.x < 0.f ? m.x : r.x; o.y = v.y < 0.f ? m.y : r.y; return o;
}

template <int ACT  > struct EpiBf16 {
    static constexpr bool PERM = true, AFTER_DRAIN = false; static_assert(ACT == 0 || ACT == 1, "EpiBf16: ACT is 0 (none) or 1 (gelu_pk)");
    bf16_t* O; int ldc; const float* bias; int split_cols; size_t split_stride; float scale0;
    __device__ __forceinline__ void operator()(const f32x4 (&acc)[2][2][4][2], const Unit& u, int wr, int wc, int fr, int fq) const {
        const int row0 = u.pm * BM + wr * 64 + fr; int colt = u.pn * BM; bf16_t* base = O;
        float sc = 1.f; if (split_cols) { const int t = colt / split_cols; base += (size_t)t * split_stride; colt -= t * split_cols; if (t == 0) sc = scale0; }
        const int col0 = colt + wc * 32 + 8 * fq, bcol0 = u.pn * BM + wc * 32 + 8 * fq;
        f32x4 bv[2][2];
#pragma unroll
        for (int bj = 0; bj < 2; ++bj)
#pragma unroll
            for (int n = 0; n < 2; ++n) bv[bj][n] = bias ? *(const f32x4*)(bias + bcol0 + bj * HALF + 4 * n) : (f32x4){0.f, 0.f, 0.f, 0.f};
#pragma unroll
        for (int ai = 0; ai < 2; ++ai)
#pragma unroll
            for (int m = 0; m < 4; ++m) { bf16_t* rowp = base + (size_t)(row0 + ai * HALF + m * 16) * ldc + col0;
#pragma unroll
                for (int bj = 0; bj < 2; ++bj) { f32x4 v0 = acc[ai][bj][m][0] + bv[bj][0], v1 = acc[ai][bj][m][1] + bv[bj][1];
                    if (ACT == 1) { f32x2 a = gelu_pk((f32x2){v0[0], v0[1]}), b = gelu_pk((f32x2){v0[2], v0[3]}), c = gelu_pk((f32x2){v1[0], v1[1]}), d = gelu_pk((f32x2){v1[2], v1[3]});
                        v0 = (f32x4){a.x, a.y, b.x, b.y}; v1 = (f32x4){c.x, c.y, d.x, d.y}; }
                    v0 = v0 * sc; v1 = v1 * sc; u32x4 w; w.x = cvt_pk_bf16(v0[0], v0[1]); w.y = cvt_pk_bf16(v0[2], v0[3]); w.z = cvt_pk_bf16(v1[0], v1[1]); w.w = cvt_pk_bf16(v1[2], v1[3]);
                    *(u32x4*)(rowp + bj * HALF) = w; } }
    }
};


struct EpiF32 {
    static constexpr bool PERM = false, AFTER_DRAIN = false;
    float* C; int ldc; const float* resid;
    __device__ __forceinline__ void operator()(const f32x4 (&acc)[2][2][4][2], const Unit& u, int wr, int wc, int fr, int fq) const {
        const int row0 = u.pm * BM + wr * 64 + fr, col0 = u.pn * BM + wc * 32 + 4 * fq;
#pragma unroll
        for (int ai = 0; ai < 2; ++ai)
#pragma unroll
            for (int m = 0; m < 4; ++m) { const size_t rb = (size_t)(row0 + ai * HALF + m * 16) * ldc + col0;
#pragma unroll
                for (int bj = 0; bj < 2; ++bj)
#pragma unroll
                    for (int n = 0; n < 2; ++n) { const size_t ix = rb + bj * HALF + n * 16; f32x4 v = acc[ai][bj][m][n];
                        if (resid) v += *(const f32x4*)(resid + ix);
                        *(f32x4*)(C + ix) = v; } }
    }
};
struct EpiGlu {
    static constexpr bool PERM = true, AFTER_DRAIN = false;
    bf16_t* O; int ldc; const float* bias; const bf16_t* YG;
    __device__ __forceinline__ void operator()(const f32x4 (&acc)[2][2][4][2], const Unit& u, int wr, int wc, int fr, int fq) const {
        const int row0 = u.pm * BM + wr * 64 + fr, col0 = u.pn * BM + wc * 32 + 8 * fq;
#pragma unroll
        for (int ai = 0; ai < 2; ++ai)
#pragma unroll
            for (int m = 0; m < 4; ++m) { const size_t rb = (size_t)(row0 + ai * HALF + m * 16) * ldc + col0;
#pragma unroll
                for (int bj = 0; bj < 2; ++bj) { const size_t ix = rb + bj * HALF;
                    const f32x4 b0 = *(const f32x4*)(bias + col0 + bj * HALF), b1 = *(const f32x4*)(bias + col0 + bj * HALF + 4);
                    const u32x4 yw = *(const u32x4*)(YG + ix);
                    f32x4 v0 = acc[ai][bj][m][0] + b0, v1 = acc[ai][bj][m][1] + b1; float o[8];
#pragma unroll
                    for (int e = 0; e < 4; ++e) { const unsigned w = e == 0 ? yw.x : e == 1 ? yw.y : e == 2 ? yw.z : yw.w;
                        const float y0 = __uint_as_float(w << 16), y1 = __uint_as_float(w & 0xffff0000u);
                        const float a0 = e < 2 ? v0[2 * e] : v1[2 * e - 4], a1 = e < 2 ? v0[2 * e + 1] : v1[2 * e - 3];
                        o[2 * e] = y0 / (1.f + __expf(-a0)); o[2 * e + 1] = y1 / (1.f + __expf(-a1)); }
                    u32x4 w; w.x = cvt_pk_bf16(o[0], o[1]); w.y = cvt_pk_bf16(o[2], o[3]); w.z = cvt_pk_bf16(o[4], o[5]); w.w = cvt_pk_bf16(o[6], o[7]);
                    *(u32x4*)(O + ix) = w; } }
    }
};
template <class Epi, class Sched, bool ALIGN_EPI = false, bool SP2 = false>
__device__ __forceinline__ void gemm_phase(PG8_LAS unsigned char* lds, const Gemm g, const Sched& S, const Epi& E) {
    int tid_l = threadIdx.x; asm volatile("" : "+v"(tid_l));
    const int tid = tid_l, wid = __builtin_amdgcn_readfirstlane(tid >> 6), lane = tid & 63, wr = wid >> 2, wc = wid & 3, fr = lane & 15, fq = lane >> 4;
    const int K = g.K, nt = K / BK;
    unsigned voffA[2], voffB[2];
#pragma unroll
    for (int i = 0; i < 2; ++i) { int R, C; stage_rc(tid * 16 + i * 8192, R, C); const int Rb = Epi::PERM ? ((R & ~31) + perm32(R & 31)) : R;
        voffA[i] = (unsigned)(R * g.lda + C) * 2u; voffB[i] = (unsigned)(Rb * K + C) * 2u; }
    const size_t kstep = (size_t)(BK * 2);
    const size_t hsA = (size_t)HALF * g.lda * 2, hsB = (size_t)HALF * K * 2;
    const size_t tsA = 2 * hsA, tsB = 2 * hsB;
    const unsigned ldsw = (unsigned)wid * 1024u;
    const int aoff = lds_byte(wr * 64 + fr, fq * 8), boff = lds_byte(wc * 32 + fr, fq * 8);
#define PG8_SA(b, h) (((b) * 2 + (h)) * HTB)
#define PG8_SB(b, h) ((4 + (b) * 2 + (h)) * HTB)
#define PG8_STAGE(bufoff, gbase, voff) do { _Pragma("unroll") for (int _i = 0; _i < 2; ++_i) \
        __builtin_amdgcn_global_load_lds((const unsigned*)((const char*)(gbase) + (voff)[_i]), (PG8_LAS unsigned*)(lds + (bufoff) + ldsw + _i * 8192), 16, 0, 0); } while (0)
#define PG8_LDA(dst, b, h) do { _Pragma("unroll") for (int m = 0; m < 4; ++m) _Pragma("unroll") for (int k = 0; k < 2; ++k) dst[m][k] = *(const PG8_LAS bf16x8*)(lds + PG8_SA(b, h) + aoff + m * 2048 + k * 1024); } while (0)
#define PG8_LDB(dst, b, h) do { _Pragma("unroll") for (int n = 0; n < 2; ++n) _Pragma("unroll") for (int k = 0; k < 2; ++k) dst[n][k] = *(const PG8_LAS bf16x8*)(lds + PG8_SB(b, h) + boff + n * 2048 + k * 1024); } while (0)
#define PG8_MMA(ai, bj, At, Bt) do { __builtin_amdgcn_s_setprio(1); _Pragma("unroll") for (int m = 0; m < 4; ++m) _Pragma("unroll") for (int n = 0; n < 2; ++n) _Pragma("unroll") for (int k = 0; k < 2; ++k) \
        acc[ai][bj][m][n] = __builtin_amdgcn_mfma_f32_16x16x32_bf16(Bt[n][k], At[m][k], acc[ai][bj][m][n], 0, 0, 0); __builtin_amdgcn_s_setprio(0); } while (0)
#define PG8_WAIT_V(n) asm volatile("s_waitcnt vmcnt(" #n ")" ::: "memory")
#define PG8_WAIT_L(n) asm volatile("s_waitcnt lgkmcnt(" #n ")" ::: "memory")
#define PG8_BAR __builtin_amdgcn_s_barrier()
#define PG8_SCHED __builtin_amdgcn_sched_barrier(0)
    Unit cur, nxt; int ui = 0;
    if (!S.next(0, cur)) return;
    f32x4 acc[2][2][4][2];
#pragma unroll
    for (int a = 0; a < 2; ++a)
#pragma unroll
        for (int b = 0; b < 2; ++b)
#pragma unroll
            for (int m = 0; m < 4; ++m)
#pragma unroll
                for (int n = 0; n < 2; ++n) acc[a][b][m][n] = (f32x4){0.f, 0.f, 0.f, 0.f};
    bf16x8 At[4][2], B0[2][2], B1[2][2];
    const char* cA = (const char*)g.A + (size_t)cur.pm * tsA; const char* cB = (const char*)g.Bt + (size_t)cur.pn * tsB;
    S.a_ready(cur);
    if constexpr (SP2) {
        PG8_STAGE(PG8_SB(0, 0), cB, voffB); PG8_STAGE(PG8_SB(0, 1), cB + hsB, voffB); PG8_STAGE(PG8_SA(0, 0), cA, voffA); PG8_STAGE(PG8_SA(0, 1), cA + hsA, voffA);
        if (wr == 1) PG8_BAR;
        PG8_WAIT_V(2); PG8_BAR;
        PG8_STAGE(PG8_SB(1, 0), cB + kstep, voffB); PG8_STAGE(PG8_SA(1, 0), cA + kstep, voffA); PG8_STAGE(PG8_SB(1, 1), cB + hsB + kstep, voffB);
        PG8_WAIT_V(6); PG8_BAR;
    } else {
        PG8_STAGE(PG8_SB(0, 0), cB, voffB); PG8_STAGE(PG8_SA(0, 0), cA, voffA); PG8_STAGE(PG8_SB(0, 1), cB + hsB, voffB); PG8_STAGE(PG8_SA(0, 1), cA + hsA, voffA);
        if (wr == 1) PG8_BAR;
        PG8_WAIT_V(4); PG8_BAR;
        PG8_STAGE(PG8_SB(1, 0), cB + kstep, voffB); PG8_STAGE(PG8_SA(1, 0), cA + kstep, voffA); PG8_STAGE(PG8_SB(1, 1), cB + hsB + kstep, voffB);
        PG8_WAIT_V(6); PG8_BAR;
    }
    for (;;) {
        const bool has_next = S.next(ui + 1, nxt);
        const char* nA = has_next ? (const char*)g.A + (size_t)nxt.pm * tsA : cA; const char* nB = has_next ? (const char*)g.Bt + (size_t)nxt.pn * tsB : cB;
        for (int t = 0; t < nt; t += 2) {
            const bool last = (t == nt - 2);
            const char* a1 = cA + (size_t)(t + 1) * kstep;
            const char* a2 = last ? nA : cA + (size_t)(t + 2) * kstep; const char* b2 = last ? nB : cB + (size_t)(t + 2) * kstep;
            const char* a3 = a2 + kstep; const char* b3 = b2 + kstep;
            if (last && has_next) S.a_ready(nxt);
            if constexpr (SP2) {
            PG8_LDB(B0, 0, 0); PG8_LDB(B1, 0, 1); PG8_SCHED; PG8_LDA(At, 0, 0); PG8_STAGE(PG8_SA(1, 1), a1 + hsA, voffA);
            PG8_WAIT_V(8); PG8_WAIT_L(0); PG8_BAR; PG8_MMA(0, 0, At, B0); PG8_MMA(0, 1, At, B1); PG8_BAR; PG8_SCHED;
            PG8_LDA(At, 0, 1); PG8_STAGE(PG8_SB(0, 0), b2, voffB); PG8_STAGE(PG8_SB(0, 1), b2 + hsB, voffB); PG8_STAGE(PG8_SA(0, 0), a2, voffA);
            PG8_WAIT_V(8); PG8_WAIT_L(0); PG8_BAR; PG8_MMA(1, 0, At, B0); PG8_MMA(1, 1, At, B1); PG8_BAR; PG8_SCHED;
            PG8_LDB(B0, 1, 0); PG8_LDB(B1, 1, 1); PG8_SCHED; PG8_LDA(At, 1, 0); PG8_STAGE(PG8_SA(0, 1), a2 + hsA, voffA);
            PG8_WAIT_V(8); PG8_WAIT_L(0); PG8_BAR; PG8_MMA(0, 0, At, B0); PG8_MMA(0, 1, At, B1); PG8_BAR; PG8_SCHED;
            PG8_LDA(At, 1, 1); PG8_STAGE(PG8_SB(1, 0), b3, voffB); PG8_STAGE(PG8_SB(1, 1), b3 + hsB, voffB); PG8_STAGE(PG8_SA(1, 0), a3, voffA);
            PG8_WAIT_V(8); PG8_WAIT_L(0); PG8_BAR; PG8_MMA(1, 0, At, B0); PG8_MMA(1, 1, At, B1); PG8_BAR; PG8_SCHED;
            } else {
            PG8_LDB(B0, 0, 0); PG8_SCHED; PG8_LDA(At, 0, 0); PG8_STAGE(PG8_SA(1, 1), a1 + hsA, voffA);
            PG8_WAIT_L(8); PG8_BAR; PG8_WAIT_L(0); PG8_MMA(0, 0, At, B0); PG8_BAR; PG8_SCHED;
            PG8_LDB(B1, 0, 1); PG8_STAGE(PG8_SB(0, 0), b2, voffB);
            PG8_BAR; PG8_WAIT_L(0); PG8_MMA(0, 1, At, B1); PG8_BAR;
            PG8_LDA(At, 0, 1); PG8_STAGE(PG8_SA(0, 0), a2, voffA);
            PG8_BAR; PG8_WAIT_L(0); PG8_MMA(1, 0, At, B0); PG8_BAR; PG8_SCHED;
            PG8_STAGE(PG8_SB(0, 1), b2 + hsB, voffB);
            PG8_WAIT_V(6); PG8_BAR; PG8_MMA(1, 1, At, B1); PG8_BAR;
            PG8_LDB(B0, 1, 0); PG8_SCHED; PG8_LDA(At, 1, 0); PG8_STAGE(PG8_SA(0, 1), a2 + hsA, voffA);
            PG8_WAIT_L(8); PG8_BAR; PG8_WAIT_L(0); PG8_MMA(0, 0, At, B0); PG8_BAR; PG8_SCHED;
            PG8_LDB(B1, 1, 1); PG8_STAGE(PG8_SB(1, 0), b3, voffB);
            PG8_BAR; PG8_WAIT_L(0); PG8_MMA(0, 1, At, B1); PG8_BAR;
            PG8_LDA(At, 1, 1); PG8_STAGE(PG8_SA(1, 0), a3, voffA);
            PG8_BAR; PG8_WAIT_L(0); PG8_MMA(1, 0, At, B0); PG8_BAR; PG8_SCHED;
            PG8_STAGE(PG8_SB(1, 1), b3 + hsB, voffB);
            PG8_WAIT_V(6); PG8_BAR; PG8_MMA(1, 1, At, B1); PG8_BAR;
            }
        }
        if constexpr (ALIGN_EPI) { if (wr == 0) PG8_BAR; }
        if constexpr (!Epi::AFTER_DRAIN) { E(acc, cur, wr, wc, fr, fq); S.done(cur); }
        if (!has_next) break;
#pragma unroll
        for (int a = 0; a < 2; ++a)
#pragma unroll
            for (int b = 0; b < 2; ++b)
#pragma unroll
                for (int m = 0; m < 4; ++m)
#pragma unroll
                    for (int n = 0; n < 2; ++n) acc[a][b][m][n] = (f32x4){0.f, 0.f, 0.f, 0.f};
        cur = nxt; cA = nA; cB = nB; ++ui;
        if constexpr (ALIGN_EPI) { if (wr == 1) PG8_BAR; }
    }
    PG8_WAIT_V(0);
    if constexpr (!ALIGN_EPI) { if (wr == 0) PG8_BAR; }
    PG8_BAR;
    if constexpr (Epi::AFTER_DRAIN) { E.fused(acc, cur, wr, wc, fr, fq, lds, wid, lane); S.done(cur); }
#undef PG8_SA
#undef PG8_SB
#undef PG8_STAGE
#undef PG8_LDA
#undef PG8_LDB
#undef PG8_MMA
#undef PG8_WAIT_V
#undef PG8_WAIT_L
#undef PG8_BAR
#undef PG8_SCHED
}
}
#define GAS __attribute__((address_space(1)))
#define LAS __attribute__((address_space(3)))
#define XB_TMO      128
#define XB_XCNT(j)  (256  + 64 * (j))
#define XB_XSUB(j)  (1280 + 64 * (j))
#define XB_XGEN(j)  (2304 + 64 * (j))
#define XB_TOP      3328
#define XB_TOPGEN   3392
#define XCD_BAR_WORDS 3456
#define XB_SPIN_CAP (1u << 25)
__device__ __forceinline__ unsigned xb_ld(unsigned* p)              { return __hip_atomic_load(p, __ATOMIC_RELAXED, __HIP_MEMORY_SCOPE_AGENT); }
__device__ __forceinline__ unsigned xb_add(unsigned* p, unsigned v) { return __hip_atomic_fetch_add(p, v, __ATOMIC_RELAXED, __HIP_MEMORY_SCOPE_AGENT); }
__device__ __forceinline__ unsigned xb_xcc_id() { return (unsigned)__builtin_amdgcn_s_getreg((3 << 11) | 20) & 0xFu; }
#define XB_SPIN(cond, bar) do { unsigned _sp = 0; while (cond) { __builtin_amdgcn_s_sleep(1); \
    if ((++_sp & 255u) == 0u) { if (xb_ld(&(bar)[XB_TMO])) break; if (_sp > XB_SPIN_CAP) { atomicAdd(&(bar)[XB_TMO], 1u); break; } } } } while (0)
struct XcdBarrier { unsigned* bar; unsigned x; volatile LAS unsigned* st; };
__device__ __forceinline__ XcdBarrier xcd_barrier_post(unsigned* bar, volatile LAS unsigned* st) {
    XcdBarrier b; b.bar = bar; b.x = xb_xcc_id(); b.st = st;
    if (threadIdx.x == 0) (void)xb_add(&bar[XB_XCNT(b.x)], 1u);
    return b;
}
__device__ __forceinline__ void xcd_barrier_complete(unsigned* bar, unsigned x, unsigned& nloc, unsigned& nx) {
    const unsigned G = gridDim.x * gridDim.y * gridDim.z;
    unsigned sum, cnt, mine, sp = 0u;
    for (;;) {
        sum = 0u; cnt = 0u; mine = 0u;
#pragma unroll
        for (unsigned j = 0; j < 16; ++j) { const unsigned c = xb_ld(&bar[XB_XCNT(j)]); sum += c; cnt += (c > 0u) ? 1u : 0u; mine = (j == x) ? c : mine; }
        if (sum == G) break;
        __builtin_amdgcn_s_sleep(1);
        if ((++sp & 255u) == 0u) { if (xb_ld(&bar[XB_TMO])) break; if (sp > XB_SPIN_CAP) { atomicAdd(&bar[XB_TMO], 1u); break; } }
    }
    nloc = mine > 0u ? mine : 1u; nx = cnt > 0u ? cnt : 1u;
}
__device__ __forceinline__ void xcd_barrier(const XcdBarrier& b) {
    asm volatile("s_waitcnt vmcnt(0)" ::: "memory");
    __syncthreads();
    if (threadIdx.x == 0) {
        unsigned* bar = b.bar;
        __builtin_amdgcn_s_waitcnt(0);
        unsigned nloc = b.st[0], nx = b.st[1];
        if (nloc == 0u) { xcd_barrier_complete(bar, b.x, nloc, nx); b.st[0] = nloc; b.st[1] = nx; }
        const unsigned old = xb_add(&bar[XB_XSUB(b.x)], 1u);
        const unsigned gen = old / nloc;
        if (old + 1u == (gen + 1u) * nloc) {
            __builtin_amdgcn_fence(__ATOMIC_RELEASE, "agent");
            asm volatile("s_waitcnt vmcnt(0)" ::: "memory");
            const unsigned og = xb_add(&bar[XB_TOP], 1u);
            const unsigned tg = og / nx;
            if (og + 1u == (tg + 1u) * nx) xb_add(&bar[XB_TOPGEN], 1u);
            else XB_SPIN(xb_ld(&bar[XB_TOPGEN]) == tg, bar);
            __builtin_amdgcn_fence(__ATOMIC_ACQUIRE, "agent");
            xb_add(&bar[XB_XGEN(b.x)], 1u);
            asm volatile("s_waitcnt vmcnt(0)" ::: "memory");
        } else {
            XB_SPIN(xb_ld(&bar[XB_XGEN(b.x)]) == gen, bar);
            __builtin_amdgcn_fence(__ATOMIC_ACQUIRE, "agent");
            asm volatile("s_waitcnt vmcnt(0)" ::: "memory");
        }
    }
    __syncthreads();
}
namespace s5f {
typedef short bf16x8 __attribute__((ext_vector_type(8)));
typedef float f32x4 __attribute__((ext_vector_type(4)));
typedef unsigned u32x2 __attribute__((ext_vector_type(2)));
constexpr int LC = 32, NCH = SEQ / LC, RS = 272, WBYTES = LC * RS;
__device__ __forceinline__ void build_tables(const float* a_re, const float* a_im, const float* log_dt, const float* b_re, const float* b_im, const float* c_re, const float* c_im,
                                             bf16* S5A, bf16* S5C, float2* S5L, int gt, int ngt) {
    for (int i = gt; i < 16 * 64; i += ngt) {
        const int g = i >> 6;
        const float are = a_re[i], aim = a_im[i], dt = expf(log_dt[g]);
        const float mag = expf(are * dt); float sn, cs; sincos_acc(aim * dt, sn, cs);
        const float lre = mag * cs, lim = mag * sn;
        const float xr = lre - 1.f, xi = lim, den = are * are + aim * aim;
        const float cr = (xr * are + xi * aim) / den, ci = (xi * are - xr * aim) / den;
        S5L[i] = make_float2(lre, lim);
        const int p = i & 63;
        for (int k = 0; k < 16; ++k) { const float br = b_re[i * 16 + k], bi = b_im[i * 16 + k];
            S5A[((size_t)g * 128 + 2 * p) * 16 + k] = f2bf(cr * br - ci * bi); S5A[((size_t)g * 128 + 2 * p + 1) * 16 + k] = f2bf(cr * bi + ci * br);
            S5C[((size_t)g * 16 + k) * 128 + 2 * p] = f2bf(c_re[(g * 16 + k) * 64 + p]); S5C[((size_t)g * 16 + k) * 128 + 2 * p + 1] = f2bf(-c_im[(g * 16 + k) * 64 + p]); }
    }
}
template <bool FULL> __device__ __forceinline__ void chunk(LAS unsigned char* wl, const bf16* Z, const bf16x8 (&afr)[8], const bf16x8 (&cfr)[4], float lre, float lim, float& hre, float& him,
                                                           int b, int ch, int g, int lane, const float* dsk, bf16* YG) {
    const int l15 = lane & 15, q4 = lane >> 4;
    const size_t t0 = (size_t)b * SEQ + (size_t)ch * LC;
#pragma unroll
    for (int nb = 0; nb < 2; ++nb) {
        bf16x8 ufr = bf16x8{};
        if (q4 < 2) ufr = *(const bf16x8*)(Z + (t0 + 16 * nb + l15) * ZW + ZC_U + g * 16 + 8 * q4);
#pragma unroll
        for (int mb = 0; mb < 8; ++mb) {
            f32x4 d = __builtin_amdgcn_mfma_f32_16x16x32_bf16(afr[mb], ufr, f32x4{0.f, 0.f, 0.f, 0.f}, 0, 0, 0);
            *(LAS u32x2*)(wl + (16 * nb + l15) * RS + (16 * mb + 4 * q4) * 2) = u32x2{pk2(d[0], d[1]), pk2(d[2], d[3])};
        }
    }
#pragma unroll 8
    for (int k = 0; k < LC; ++k) {
        LAS unsigned* wp = (LAS unsigned*)(wl + k * RS + 4 * lane);
        const unsigned w = *wp; const float bre = __uint_as_float(w << 16), bim = __uint_as_float(w & 0xffff0000u);
        const float nre = fmaf(lre, hre, fmaf(-lim, him, bre)), nim = fmaf(lre, him, fmaf(lim, hre, bim)); hre = nre; him = nim;
        if (FULL) *wp = pk2(hre, him);
    }
    if (FULL) {
#pragma unroll
        for (int nb = 0; nb < 2; ++nb) {
            f32x4 y = f32x4{0.f, 0.f, 0.f, 0.f};
#pragma unroll
            for (int ks = 0; ks < 4; ++ks) {
                const bf16x8 hfr = *(const LAS bf16x8*)(wl + (16 * nb + l15) * RS + (32 * ks + 8 * q4) * 2);
                y = __builtin_amdgcn_mfma_f32_16x16x32_bf16(cfr[ks], hfr, y, 0, 0, 0);
            }
            const size_t t = t0 + 16 * nb + l15; const int co = 4 * q4;
            const uint2 uw = *(const uint2*)(Z + t * ZW + ZC_U + g * 16 + co);
            const float4 dd = *(const float4*)(dsk + g * 16 + co);
            const float y0 = y[0] + dd.x * __uint_as_float(uw.x << 16), y1 = y[1] + dd.y * __uint_as_float(uw.x & 0xffff0000u),
                        y2 = y[2] + dd.z * __uint_as_float(uw.y << 16), y3 = y[3] + dd.w * __uint_as_float(uw.y & 0xffff0000u);
            *(uint2*)(YG + t * 256 + g * 16 + co) = make_uint2(pk2(gelu_f(y0), gelu_f(y1)), pk2(gelu_f(y2), gelu_f(y3)));
        }
    }
}
template <bool FULL> __device__ __forceinline__ void pass(LAS unsigned char* lds, const bf16* Z, const bf16* S5A, const bf16* S5C, const float2* S5L, const float* dsk,
                                                          float2* SE, const float2* SH, bf16* YG, int gw, int ngw, int wave, int lane) {
    LAS unsigned char* wl = lds + wave * WBYTES;
    const int g = gw & 15, l15 = lane & 15, q4 = lane >> 4;
    bf16x8 afr[8], cfr[4];
#pragma unroll
    for (int mb = 0; mb < 8; ++mb) { afr[mb] = bf16x8{}; if (q4 < 2) afr[mb] = *(const bf16x8*)(S5A + ((size_t)g * 128 + 16 * mb + l15) * 16 + 8 * q4); }
#pragma unroll
    for (int ks = 0; ks < 4; ++ks) { cfr[ks] = bf16x8{}; if (FULL) cfr[ks] = *(const bf16x8*)(S5C + ((size_t)g * 16 + l15) * 128 + 32 * ks + 8 * q4); }
    const float2 lam = S5L[g * 64 + lane];
    for (int it = gw >> 4; it < NB * NCH; it += ngw >> 4) {
        const int b = it / NCH, ch = it % NCH;
        float hre = 0.f, him = 0.f;
        if (FULL) { const float2 h0 = SH[((size_t)it * 16 + g) * 64 + lane]; hre = h0.x; him = h0.y; }
        chunk<FULL>(wl, Z, afr, cfr, lam.x, lam.y, hre, him, b, ch, g, lane, dsk, YG);
        if (!FULL) SE[((size_t)it * 16 + g) * 64 + lane] = make_float2(hre, him);
    }
}
__device__ __forceinline__ void carry(const float2* S5L, const float2* SE, float2* SH, int gw, int ngw, int lane) {
    for (int item = gw; item < NB * 16; item += ngw) {
        const int b = item >> 4, g = item & 15;
        float2 lam = S5L[g * 64 + lane];
#pragma unroll
        for (int i = 0; i < 5; ++i) { const float re = lam.x * lam.x - lam.y * lam.y, im = 2.f * lam.x * lam.y; lam.x = re; lam.y = im; }
        float hre = 0.f, him = 0.f;
#pragma unroll 8
        for (int c = 0; c < NCH; ++c) { const size_t ix = (((size_t)b * NCH + c) * 16 + g) * 64 + lane;
            SH[ix] = make_float2(hre, him);
            const float2 e = SE[ix];
            const float nre = lam.x * hre - lam.y * him + e.x, nim = lam.x * him + lam.y * hre + e.y; hre = nre; him = nim; }
    }
}
}
namespace lruf {
typedef float f32x4 __attribute__((ext_vector_type(4)));
constexpr int LC = 32, NCH = SEQ / LC, XS = 68;
__device__ __forceinline__ void pass_a(LAS unsigned char* lds, const bf16* Z, const float* cw, const float* cb, const float* wa, const float* ba, const float* wx, const float* bx, const float* lam,
                                       float* AA, float* BT, float2* LPE, int gw, int ngw, int wave, int lane) {
    LAS float* xt = (LAS float*)lds + wave * (LC * XS);
    for (int item = gw; item < NB * NCH * 4; item += ngw) {
        const int h = item & 3, bc = item >> 2, b = bc / NCH, ch = bc % NCH, c = h * 64 + lane;
        const size_t t0 = (size_t)b * SEQ + (size_t)ch * LC;
        const float w0 = cw[c], w1 = cw[256 + c], w2 = cw[512 + c], w3 = cw[768 + c], bias = cb[c];
        float z0 = 0.f, z1 = 0.f, z2 = 0.f;
        if (ch > 0) { z0 = bf2f(Z[(t0 - 3) * ZW + ZC_X + c]); z1 = bf2f(Z[(t0 - 2) * ZW + ZC_X + c]); z2 = bf2f(Z[(t0 - 1) * ZW + ZC_X + c]); }
        float xc[LC];
#pragma unroll
        for (int k = 0; k < LC; ++k) { const float z3 = bf2f(Z[(t0 + k) * ZW + ZC_X + c]); xc[k] = bias + w0 * z0 + w1 * z1 + w2 * z2 + w3 * z3; z0 = z1; z1 = z2; z2 = z3; xt[k * XS + lane] = xc[k]; }
        float ra[LC], rx[LC];
        { const float b0 = ba[c], b1 = bx[c];
#pragma unroll
          for (int k = 0; k < LC; ++k) { ra[k] = b0; rx[k] = b1; } }
        const float* wap = wa + (size_t)h * 4096 + lane; const float* wxp = wx + (size_t)h * 4096 + lane;
        for (int i = 0; i < 64; i += 4) {
            const float a0 = wap[(i + 0) * 64], a1 = wap[(i + 1) * 64], a2 = wap[(i + 2) * 64], a3 = wap[(i + 3) * 64];
            const float x0 = wxp[(i + 0) * 64], x1 = wxp[(i + 1) * 64], x2 = wxp[(i + 2) * 64], x3 = wxp[(i + 3) * 64];
#pragma unroll
            for (int k = 0; k < LC; ++k) { const f32x4 v = *(const LAS f32x4*)(xt + k * XS + i);
                ra[k] += v.x * a0 + v.y * a1 + v.z * a2 + v.w * a3; rx[k] += v.x * x0 + v.y * x1 + v.z * x2 + v.w * x3; }
        }
        const float lsg8 = -8.f * log1pf(expf(-lam[c]));
        float hloc = 0.f, prod = 1.f;
#pragma unroll
        for (int k = 0; k < LC; ++k) {
            const float r = sigmoid_f(ra[k]), ig = sigmoid_f(rx[k]);
            const float la = r * lsg8, av = expf(la), bt = sqrtf(-expm1f(2.f * la)) * (ig * xc[k]);
            AA[(t0 + k) * 256 + c] = av; BT[(t0 + k) * 256 + c] = bt;
            hloc = av * hloc + bt; prod *= av;
        }
        LPE[(size_t)bc * 256 + c] = make_float2(prod, hloc);
    }
}
__device__ __forceinline__ void carry(const float2* LPE, float* LH, int gt, int ngt) {
    for (int i = gt; i < NB * 256; i += ngt) { const int b = i >> 8, c = i & 255;
        float h = 0.f;
#pragma unroll 8
        for (int ch = 0; ch < NCH; ++ch) { const size_t ix = ((size_t)b * NCH + ch) * 256 + c; LH[ix] = h; const float2 pe = LPE[ix]; h = pe.x * h + pe.y; } }
}
__device__ __forceinline__ void pass_b(const float* AA, const float* BT, const float* LH, const bf16* Z, bf16* ROUT, int gt, int ngt) {
    for (int i = gt; i < NB * NCH * 256; i += ngt) { const int c = i & 255, bc = i >> 8; const size_t t0 = (size_t)bc * LC;
        float h = LH[i];
#pragma unroll 8
        for (int k = 0; k < LC; ++k) { const size_t t = t0 + k;
            h = AA[t * 256 + c] * h + BT[t * 256 + c];
            ROUT[t * 256 + c] = f2bf(h * gelu_f(bf2f(Z[t * ZW + ZC_G + c]))); } }
}
}
namespace tk {
__device__ const unsigned char PAIR_TAB[64] = {
    0x00,0x01,0x02,0x03,0x04,0x05,0x06,0x07,0x08,0x09,0x0a,0x0b,0x0c,0x0d,0x0e,0x0f, 0x10,0x11,0x12,0x13,0x14,0x15,0x16,0x17, 0x20,0x21,0x22,0x23,0x24, 0x30,0x31,0x32,0x33,
    0x40,0x41,0x42, 0x50,0x51, 0x60,0x61, 0x70,0x71, 0x80,0x90,0xa0,0xb0,0xc0,0xd0,0xe0,0xf0, 0,0,0,0,0,0,0,0,0,0,0,0,0,0};
template <int CTRL> __device__ __forceinline__ float dppf(float v) { return __builtin_bit_cast(float, __builtin_amdgcn_update_dpp(0, __builtin_bit_cast(int, v), CTRL, 0xf, 0xf, true)); }
__device__ __forceinline__ float swz16(float v) { return __builtin_bit_cast(float, __builtin_amdgcn_ds_swizzle(__builtin_bit_cast(int, v), 0x401F)); }
__device__ __forceinline__ float hmax32(float v) {
    v = fmaxf(v, dppf<0xB1>(v)); v = fmaxf(v, dppf<0x4E>(v)); v = fmaxf(v, dppf<0x141>(v)); v = fmaxf(v, dppf<0x140>(v)); v = fmaxf(v, swz16(v)); return v; }
__device__ __forceinline__ float wmax64(float v) { v = hmax32(v); auto rr = __builtin_amdgcn_permlane32_swap(__float_as_uint(v), __float_as_uint(v), false, false);
    return fmaxf(__uint_as_float(rr[0]), __uint_as_float(rr[1])); }
#define TK_CX(a, b) do { const float hi_ = fmaxf(a, b), lo_ = fminf(a, b); a = hi_; b = lo_; } while (0)
__device__ __forceinline__ void topk_phase(const float* SC, int* IDX, float* GATE, int gw, int ngw, int lane) {
    const float NEG = -__builtin_inff();
    const int j = lane & 31;
    const unsigned pc = PAIR_TAB[lane]; const int pa = pc >> 4, pb = pc & 15;
    for (int row = gw; row < T * 8; row += ngw) {
        const float4 v = *(const float4*)(SC + (size_t)row * 256 + 4 * lane);
        float k0 = __uint_as_float((__float_as_uint(v.x) & ~127u) | (unsigned)(4 * j)), k1 = __uint_as_float((__float_as_uint(v.y) & ~127u) | (unsigned)(4 * j + 1)),
              k2 = __uint_as_float((__float_as_uint(v.z) & ~127u) | (unsigned)(4 * j + 2)), k3 = __uint_as_float((__float_as_uint(v.w) & ~127u) | (unsigned)(4 * j + 3));
        TK_CX(k0, k1); TK_CX(k2, k3); TK_CX(k0, k2); TK_CX(k1, k3); TK_CX(k1, k2);
        float mykey = NEG;
#pragma unroll
        for (int i = 0; i < 16; ++i) {
            const float w = hmax32(k0);
            if (j == i) mykey = w;
            if (k0 == w) { k0 = k1; k1 = k2; k2 = k3; k3 = NEG; }
        }
        const float s0 = __shfl(mykey, pa), s1 = __shfl(mykey, 32 + pb);
        float ck = (lane < 50) ? __uint_as_float((__float_as_uint(s0 + s1) & ~63u) | (unsigned)lane) : NEG;
        float win = NEG, w0 = 0.f;
#pragma unroll
        for (int i = 0; i < 16; ++i) {
            const float w = wmax64(ck);
            if (i == 0) w0 = w;
            if (lane == i) win = w;
            if (ck == w) ck = NEG;
        }
        const int code = (int)(__float_as_uint(win) & 63u);
        const unsigned pcw = (unsigned)__shfl((int)pc, code);
        const int i0 = (int)(__float_as_uint(__shfl(mykey, (int)(pcw >> 4))) & 127u), i1 = (int)(__float_as_uint(__shfl(mykey, 32 + (int)(pcw & 15))) & 127u);
        float e = (lane < 16) ? __expf(win - w0) : 0.f;
        float sum = e; sum += dppf<0xB1>(sum); sum += dppf<0x4E>(sum); sum += dppf<0x141>(sum); sum += dppf<0x140>(sum);
        if (lane < 16) { IDX[(size_t)row * 16 + lane] = i0 * 128 + i1; GATE[(size_t)row * 16 + lane] = e / sum; }
    }
}
#undef TK_CX
}
namespace pgf {
typedef float f32x2 __attribute__((ext_vector_type(2)));
typedef unsigned u32x4 __attribute__((ext_vector_type(4)));
constexpr float USCALE = 64.f, VSCALE = 4.f;
__device__ __forceinline__ unsigned pack4_fp8(float a, float b, float c, float d) {
    int w = __builtin_amdgcn_cvt_pk_fp8_f32(a, b, 0, false); w = __builtin_amdgcn_cvt_pk_fp8_f32(c, d, w, true); return (unsigned)w; }
__device__ __forceinline__ void unpack16(const u32x4 w, float* o) {
#pragma unroll
    for (int d = 0; d < 4; ++d) { const f32x2 lo = __builtin_amdgcn_cvt_pk_f32_fp8((int)w[d], false), hi = __builtin_amdgcn_cvt_pk_f32_fp8((int)w[d], true);
        o[4 * d] = lo.x; o[4 * d + 1] = lo.y; o[4 * d + 2] = hi.x; o[4 * d + 3] = hi.y; }
}
__device__ __forceinline__ void convert(const float* in, unsigned char* out8, size_t n, float scale, int gt, int ngt) {
    const size_t n16 = n / 16;
    for (size_t i = gt; i < n16; i += ngt) {
        const float4* p = (const float4*)(in + i * 16);
        const float4 a = p[0], b = p[1], c = p[2], d = p[3];
        u32x4 w; w.x = pack4_fp8(a.x * scale, a.y * scale, a.z * scale, a.w * scale); w.y = pack4_fp8(b.x * scale, b.y * scale, b.z * scale, b.w * scale);
        w.z = pack4_fp8(c.x * scale, c.y * scale, c.z * scale, c.w * scale); w.w = pack4_fp8(d.x * scale, d.y * scale, d.z * scale, d.w * scale);
        *(u32x4*)(out8 + i * 16) = w;
    }
}
__device__ __forceinline__ void gather(const bf16* HN, const int* IDX, const float* GATE, const unsigned char* PU8, const unsigned char* PV8, float* X, int gw, int ngw, int lane) {
    for (int t = gw; t < T; t += ngw) {
        float hn[16]; unpack8(*(const uint4*)(HN + (size_t)t * DM + 16 * lane), hn); unpack8(*(const uint4*)(HN + (size_t)t * DM + 16 * lane + 8), hn + 8);
        const int id0 = IDX[(size_t)t * 128 + lane], id1 = IDX[(size_t)t * 128 + 64 + lane];
        const float g0 = GATE[(size_t)t * 128 + lane], g1 = GATE[(size_t)t * 128 + 64 + lane];
        float y[16];
#pragma unroll
        for (int e = 0; e < 16; ++e) y[e] = 0.f;
        for (int kb = 0; kb < 128; kb += 4) {
            int eid[4]; float gt4[4]; u32x4 uw[4], vw[4];
#pragma unroll
            for (int q = 0; q < 4; ++q) { const int k = kb + q;
                eid[q] = __builtin_amdgcn_readlane(k < 64 ? id0 : id1, k & 63); gt4[q] = __builtin_bit_cast(float, __builtin_amdgcn_readlane(__builtin_bit_cast(int, k < 64 ? g0 : g1), k & 63)); }
#pragma unroll
            for (int q = 0; q < 4; ++q) { uw[q] = *(const u32x4*)(PU8 + (size_t)eid[q] * DM + 16 * lane); vw[q] = *(const u32x4*)(PV8 + (size_t)eid[q] * DM + 16 * lane); }
#pragma unroll
            for (int q = 0; q < 4; ++q) {
                float u[16]; unpack16(uw[q], u);
                float d0 = 0.f, d1 = 0.f;
#pragma unroll
                for (int e = 0; e < 16; e += 2) { d0 = fmaf(u[e], hn[e], d0); d1 = fmaf(u[e + 1], hn[e + 1], d1); }
                const float d = wave_sum(d0 + d1) * (1.f / USCALE);
                const float w = gt4[q] * gelu_f(d) * (1.f / VSCALE);
                float v[16]; unpack16(vw[q], v);
#pragma unroll
                for (int e = 0; e < 16; ++e) y[e] = fmaf(w, v[e], y[e]);
            }
        }
        float4* xo = (float4*)(X + (size_t)t * DM + 16 * lane);
#pragma unroll
        for (int q = 0; q < 4; ++q) { float4 p = xo[q]; p.x += y[4 * q]; p.y += y[4 * q + 1]; p.z += y[4 * q + 2]; p.w += y[4 * q + 3]; xo[q] = p; }
    }
}
}
constexpr int NWAVES = 8, NTHR = 512;
constexpr int RING_BYTES = 131072, MISC_OFF = RING_BYTES + 320, LDS_BYTES = 147456;
struct Args { const void* in[34]; float* out; unsigned char* ws; int ph_lo, ph_hi; };
struct Ctx { LAS unsigned char* lds; int tid, lane, wave, G, bid, gw, ngw, gt, ngt; };
#define INF(i) ((const float*)a.in[i])
#define WSP(T_, off) ((T_*)(a.ws + (off)))

__device__ __forceinline__ void prep_tile(const float* W, int K, int N, bf16* WT, int Nout, int mapmode, int item, LAS float* tile, int t256) {
    const int nbn = Nout / 32, kb = item / nbn, nb = item % nbn, n0 = nb * 32, k0 = kb * 32, tx = t256 & 31, ty = t256 >> 5;
    for (int i = ty; i < 32; i += 8) {
        const int n = n0 + tx; int src = n;
        if (mapmode == 1) { if (n < 448) src = n; else if (n < 512) src = -1; else src = n - 64; }
        tile[i * 33 + tx] = (src >= 0 && src < N) ? W[(size_t)(k0 + i) * N + src] : 0.f;
    }
    __syncthreads();
    for (int i = ty; i < 32; i += 8) WT[(size_t)(n0 + i) * K + k0 + tx] = f2bf(tile[tx * 33 + i]);
    __syncthreads();
}
template <class ArgsRef> __device__ __forceinline__ void ph_prep(const ArgsRef& a, const Ctx& c) {
    const int sub = c.tid >> 8, t256 = c.tid & 255; LAS float* tile = (LAS float*)c.lds + sub * (32 * 33);
    constexpr int NT0 = 1280, NT1 = 192, NT2 = 128, NT3 = 64, NT4 = 1024, NT5 = 2048, NTL = NT0 + NT1 + NT2 + NT3 + NT4 + NT5, NTOT = NL * NTL;
    const int nsb = c.G * 2;
    for (int it0 = c.bid * 2; it0 < NTOT; it0 += nsb) {
        int it = it0 + sub; if (it >= NTOT) it = NTOT - 1;
        const int l = it / NTL; int r = it % NTL;
        if (r < NT0) prep_tile(INF(3) + (size_t)l * DM * 1216, DM, 1216, WSP(bf16, WS_WINT) + (size_t)l * ZW * DM, ZW, 1, r, tile, t256);
        else if ((r -= NT0) < NT1) prep_tile(INF(5) + (size_t)l * 256 * 768, 256, 768, WSP(bf16, WS_WUQT) + (size_t)l * 768 * 256, 768, 0, r, tile, t256);
        else if ((r -= NT1) < NT2) prep_tile(INF(7) + (size_t)l * 128 * 1024, 128, 1024, WSP(bf16, WS_WUKVT) + (size_t)l * 1024 * 128, 1024, 0, r, tile, t256);
        else if ((r -= NT2) < NT3) prep_tile(INF(18) + (size_t)l * 65536, 256, 256, WSP(bf16, WS_GLUT) + (size_t)l * 65536, 256, 0, r, tile, t256);
        else if ((r -= NT3) < NT4) prep_tile(INF(28) + (size_t)l * DM * DM, DM, DM, WSP(bf16, WS_WOUTT) + (size_t)l * DM * DM, DM, 0, r, tile, t256);
        else { r -= NT4; prep_tile(INF(30) + (size_t)l * DM * 2048, DM, 2048, WSP(bf16, WS_WQT) + (size_t)l * 2048 * DM, 2048, 0, r, tile, t256); }
    }
    for (int i = c.gt; i < NL * 65536; i += c.ngt) { const int l = i >> 16, e = i & 65535, r = e >> 8, cc = e & 255, pp = r >> 7, n = r & 127, p = cc >> 7, d = cc & 127;
        WSP(bf16, WS_SUBKT)[i] = (p == pp) ? f2bf(INF(31)[(size_t)l * 32768 + (pp * 128 + n) * 128 + d]) : (bf16)0; }
    pgf::convert((const float*)a.in[32], WSP(unsigned char, WS_PU), (size_t)NL * 16384 * DM, pgf::USCALE, c.gt, c.ngt);
    pgf::convert((const float*)a.in[33], WSP(unsigned char, WS_PV), (size_t)NL * 16384 * DM, pgf::VSCALE, c.gt, c.ngt);
    for (int i = c.gt; i < T * 32; i += c.ngt) { const int t = i >> 5, j = i & 31;
        const float freq = exp2f(-(float)j * 0.41524101186092033f);
        const float ang = (float)((const int*)a.in[1])[t] * freq; float s, cs; sincos_acc(ang, s, cs);
        WSP(float, WS_COS)[i] = cs; WSP(float, WS_SIN)[i] = s; }
    for (int l = 0; l < NL; ++l)
        s5f::build_tables(INF(10) + l * 1024, INF(11) + l * 1024, INF(12) + l * 16, INF(13) + l * 16384, INF(14) + l * 16384, INF(15) + l * 16384, INF(16) + l * 16384,
                          WSP(bf16, WS_S5A) + (size_t)l * 32768, WSP(bf16, WS_S5C) + (size_t)l * 32768, WSP(float2, WS_S5L) + l * 1024, c.gt, c.ngt);
}

__device__ __forceinline__ void ph_rowprep(const Ctx& c, const float* x, const float* gain, bf16* XB) {
    for (int row = c.gw; row < T; row += c.ngw) {
        const float4* xr = (const float4*)(x + (size_t)row * DM) + c.lane;
        float4 v[4]; float ss = 0.f;
#pragma unroll
        for (int j = 0; j < 4; ++j) { v[j] = xr[64 * j]; ss += v[j].x * v[j].x + v[j].y * v[j].y + v[j].z * v[j].z + v[j].w * v[j].w; }
        const float rstd = rsqrtf(wave_sum(ss) * (1.f / DM) + EPS);
        uint2* o = (uint2*)(XB + (size_t)row * DM) + c.lane;
#pragma unroll
        for (int j = 0; j < 4; ++j) { const float4 g = ((const float4*)gain)[c.lane + 64 * j];
            o[64 * j] = make_uint2(pk2(v[j].x * rstd * g.x, v[j].y * rstd * g.y), pk2(v[j].z * rstd * g.z, v[j].w * rstd * g.w)); }
    }
}

enum { EPI_BF16 = 0, EPI_F32 = 1, EPI_GLU = 2, EPI_RESID = 3 };
template <int EPI> __device__ __forceinline__ void gemm_simple(const Ctx& c, const bf16* A, int lda, const bf16* Bt, int M, int N, int K, void* C, int ldc, const float* aux0, const bf16* aux1) {
    LAS float* As = (LAS float*)c.lds; LAS float* Bs = As + 16 * 132;
    const int tid = c.tid, tx = tid & 15, ty = tid >> 4, nN = N / 64, ntile = (M / 128) * nN;
    for (int tile = c.bid; tile < ntile; tile += c.G) {
        const int m0 = (tile / nN) * 128, n0 = (tile % nN) * 64;
        float acc[4][4];
#pragma unroll
        for (int i = 0; i < 4; ++i)
#pragma unroll
            for (int j = 0; j < 4; ++j) acc[i][j] = 0.f;
        const int lr = tid >> 2, lk = (tid & 3) * 4;
        for (int k0 = 0; k0 < K; k0 += 16) {
            { const uint2 w = *(const uint2*)(A + (size_t)(m0 + lr) * lda + k0 + lk);
              As[lk * 132 + lr] = __uint_as_float(w.x << 16); As[(lk + 1) * 132 + lr] = __uint_as_float(w.x & 0xffff0000u); As[(lk + 2) * 132 + lr] = __uint_as_float(w.y << 16); As[(lk + 3) * 132 + lr] = __uint_as_float(w.y & 0xffff0000u); }
            if (tid < 256) { const uint2 w = *(const uint2*)(Bt + (size_t)(n0 + lr) * K + k0 + lk);
              Bs[lk * 68 + lr] = __uint_as_float(w.x << 16); Bs[(lk + 1) * 68 + lr] = __uint_as_float(w.x & 0xffff0000u); Bs[(lk + 2) * 68 + lr] = __uint_as_float(w.y << 16); Bs[(lk + 3) * 68 + lr] = __uint_as_float(w.y & 0xffff0000u); }
            __syncthreads();
#pragma unroll
            for (int kk = 0; kk < 16; ++kk) {
                float av[4], bv[4];
#pragma unroll
                for (int i = 0; i < 4; ++i) { av[i] = As[kk * 132 + ty * 4 + i]; bv[i] = Bs[kk * 68 + tx * 4 + i]; }
#pragma unroll
                for (int i = 0; i < 4; ++i)
#pragma unroll
                    for (int j = 0; j < 4; ++j) acc[i][j] += av[i] * bv[j];
            }
            __syncthreads();
        }
#pragma unroll
        for (int i = 0; i < 4; ++i)
#pragma unroll
            for (int j = 0; j < 4; ++j) {
                const int row = m0 + ty * 4 + i, col = n0 + tx * 4 + j; const size_t ix = (size_t)row * ldc + col; const float v = acc[i][j];
                if (EPI == EPI_BF16) ((bf16*)C)[ix] = f2bf(v);
                else if (EPI == EPI_F32) ((float*)C)[ix] = v;
                else if (EPI == EPI_GLU) { const float yg = bf2f(aux1[ix]); ((bf16*)C)[ix] = f2bf(yg * sigmoid_f(v + aux0[col])); }
                else { ((float*)C)[ix] = aux0[ix] + v; }
            }
    }
}

__device__ __forceinline__ void ph_zstats(const Ctx& c, const bf16* Z, const float* qan, const float* kvan, bf16* CQN, bf16* CKVN) {
    for (int row = c.gw; row < T; row += c.ngw) {
        const bf16* zr = Z + (size_t)row * ZW; const int lane = c.lane;
        { const uint2 w = *(const uint2*)(zr + ZC_CQ + 4 * lane);
          float a0 = __uint_as_float(w.x << 16), a1 = __uint_as_float(w.x & 0xffff0000u), a2 = __uint_as_float(w.y << 16), a3 = __uint_as_float(w.y & 0xffff0000u);
          const float rstd = rsqrtf(wave_sum(a0 * a0 + a1 * a1 + a2 * a2 + a3 * a3) * (1.f / 256) + EPS);
          const float4 g = ((const float4*)qan)[lane];
          *(uint2*)(CQN + (size_t)row * 256 + 4 * lane) = make_uint2(pk2(a0 * rstd * g.x, a1 * rstd * g.y), pk2(a2 * rstd * g.z, a3 * rstd * g.w)); }
        { const u32 w = *(const u32*)(zr + ZC_CKV + 2 * lane);
          float a0 = __uint_as_float(w << 16), a1 = __uint_as_float(w & 0xffff0000u);
          const float rstd = rsqrtf(wave_sum(a0 * a0 + a1 * a1) * (1.f / 128) + EPS);
          const float2 g = ((const float2*)kvan)[lane];
          *(u32*)(CKVN + (size_t)row * 128 + 2 * lane) = pk2(a0 * rstd * g.x, a1 * rstd * g.y); }
    }
}

__device__ __forceinline__ void ph_qkfin(const Ctx& c, const bf16* QRAW, const bf16* KVRAW, const bf16* Z, const float* qn, const float* kn, const float* COS, const float* SIN, bf16* QB, bf16* KB, bf16* VB) {
    const int lane = c.lane;
    for (int w = c.gw; w < T * NH; w += c.ngw) {
        const int t = w >> 2, h = w & 3, b = t / SEQ, s = t % SEQ; const size_t bh = (size_t)b * NH + h;
        const float cs = COS[t * 32 + (lane & 31)], sn = SIN[t * 32 + (lane & 31)];
        {   const bf16* p = QRAW + (size_t)t * 768 + h * DQK;
            float v0 = bf2f(p[lane]), v1 = bf2f(p[lane + 64]), v2 = bf2f(p[lane + 128]);
            const float rstd = rsqrtf(wave_sum(v0 * v0 + v1 * v1 + v2 * v2) * (1.f / DQK) + EPS);
            v0 *= rstd * qn[lane]; v1 *= rstd * qn[lane + 64]; v2 *= rstd * qn[lane + 128];
            const float pr = __shfl_xor(v2, 32);
            const float r2 = (lane < 32) ? (v2 * cs - pr * sn) : (pr * sn + v2 * cs);
            bf16* o = QB + (bh * SEQ + s) * DQK;
            o[lane] = f2bf(v0 * QSCALE); o[lane + 64] = f2bf(v1 * QSCALE); o[lane + 128] = f2bf(r2 * QSCALE); }
        {   const bf16* p = KVRAW + (size_t)t * 1024 + h * 256;
            float v0 = bf2f(p[lane]), v1 = bf2f(p[lane + 64]), v2 = bf2f(Z[(size_t)t * ZW + ZC_KR + lane]);
            const float rstd = rsqrtf(wave_sum(v0 * v0 + v1 * v1 + v2 * v2) * (1.f / DQK) + EPS);
            v0 *= rstd * kn[lane]; v1 *= rstd * kn[lane + 64]; v2 *= rstd * kn[lane + 128];
            const float pr = __shfl_xor(v2, 32);
            const float r2 = (lane < 32) ? (v2 * cs - pr * sn) : (pr * sn + v2 * cs);
            bf16* o = KB + (bh * SEQ + s) * DQK;
            o[lane] = f2bf(v0); o[lane + 64] = f2bf(v1); o[lane + 128] = f2bf(r2);
            bf16* ov = VB + (bh * SEQ + s) * DV;
            ov[lane] = p[128 + lane]; ov[lane + 64] = p[192 + lane]; }
    }
}

__device__ __forceinline__ void ph_attn_simple(const Ctx& c, const bf16* QB, const bf16* KB, const bf16* VB, bf16* AO) {
    LAS float* qs = (LAS float*)c.lds + c.wave * DQK; const int lane = c.lane;
    for (int gq = c.gw; gq < NB * NH * SEQ; gq += c.ngw) {
        const int bh = gq / SEQ, q = gq % SEQ;
        const bf16* qp = QB + ((size_t)bh * SEQ + q) * DQK;
        qs[lane] = bf2f(qp[lane]); qs[lane + 64] = bf2f(qp[lane + 64]); qs[lane + 128] = bf2f(qp[lane + 128]);
        asm volatile("s_waitcnt lgkmcnt(0)" ::: "memory");
        float m = -1e30f, l = 0.f, o0 = 0.f, o1 = 0.f;
        const int ntile = q / 64 + 1;
        for (int kt = 0; kt < ntile; ++kt) {
            const int key = kt * 64 + lane;
            const uint4* kp = (const uint4*)(KB + ((size_t)bh * SEQ + key) * DQK);
            float sc = 0.f;
#pragma unroll 4
            for (int cc = 0; cc < 24; ++cc) { float kv[8]; unpack8(kp[cc], kv);
#pragma unroll
                for (int e = 0; e < 8; ++e) sc += kv[e] * qs[cc * 8 + e]; }
            if (key > q) sc = -INFINITY;
            const float mn = fmaxf(m, wave_max(sc));
            const float p = exp2f(sc - mn), al = exp2f(m - mn);
            l = l * al + wave_sum(p); o0 *= al; o1 *= al; m = mn;
            const u32* vp = (const u32*)(VB + ((size_t)bh * SEQ + kt * 64) * DV) + lane;
#pragma unroll 8
            for (int k = 0; k < 64; ++k) { const float pk = __shfl(p, k); const u32 w = vp[(size_t)k * (DV / 2)];
                o0 += pk * __uint_as_float(w << 16); o1 += pk * __uint_as_float(w & 0xffff0000u); }
        }
        const int b = bh / NH, h = bh % NH; const float il = 1.f / l;
        *(u32*)(AO + ((size_t)b * SEQ + q) * 512 + h * DV + 2 * lane) = pk2(o0 * il, o1 * il);
    }
}

__device__ __forceinline__ void ph_s5_simple(const Ctx& c, const bf16* Z, const float* a_re, const float* a_im, const float* log_dt, const float* b_re, const float* b_im,
                                             const float* c_re, const float* c_im, const float* dsk, bf16* YG) {
    for (int item = c.gw; item < NB * 16; item += c.ngw) {
        const int b = item >> 4, g = item & 15, p = c.lane;
        const float are = a_re[g * 64 + p], aim = a_im[g * 64 + p], dt = expf(log_dt[g]);
        const float mag = expf(are * dt); float sn, cs; sincos_acc(aim * dt, sn, cs);
        const float lre = mag * cs, lim = mag * sn;
        const float xr = lre - 1.f, xi = lim, den = are * are + aim * aim;
        const float cr = (xr * are + xi * aim) / den, ci = (xi * are - xr * aim) / den;
        float Bre[16], Bim[16], Cre[16], Cim[16];
#pragma unroll
        for (int k = 0; k < 16; ++k) { const float br = b_re[(g * 64 + p) * 16 + k], bi = b_im[(g * 64 + p) * 16 + k];
            Bre[k] = cr * br - ci * bi; Bim[k] = cr * bi + ci * br; Cre[k] = c_re[(g * 16 + k) * 64 + p]; Cim[k] = c_im[(g * 16 + k) * 64 + p]; }
        const float D = (p < 16) ? dsk[g * 16 + p] : 0.f;
        float hre = 0.f, him = 0.f;
        for (int s = 0; s < SEQ; ++s) {
            const bf16* up = Z + (size_t)(b * SEQ + s) * ZW + ZC_U + g * 16;
            float u[16]; unpack8(*(const uint4*)up, u); unpack8(*(const uint4*)(up + 8), u + 8);
            float bre = 0.f, bim = 0.f;
#pragma unroll
            for (int k = 0; k < 16; ++k) { bre += Bre[k] * u[k]; bim += Bim[k] * u[k]; }
            const float nre = lre * hre - lim * him + bre, nim = lre * him + lim * hre + bim; hre = nre; him = nim;
            float my = 0.f;
#pragma unroll
            for (int k = 0; k < 16; ++k) { const float v = wave_sum(Cre[k] * hre - Cim[k] * him); if (p == k) my = v + D * u[k]; }
            if (p < 16) YG[(size_t)(b * SEQ + s) * 256 + g * 16 + p] = f2bf(gelu_f(my));
        }
    }
}

__device__ __forceinline__ void ph_lru_xc(const Ctx& c, const bf16* Z, const float* cw, const float* cb, float* XC) {
    for (int i = c.gt; i < T * 256; i += c.ngt) { const int t = i >> 8, ch = i & 255, s = t % SEQ;
        float acc = cb[ch];
#pragma unroll
        for (int j = 0; j < 4; ++j) { const int ss = s - 3 + j; if (ss >= 0) acc += cw[j * 256 + ch] * bf2f(Z[(size_t)(t - 3 + j) * ZW + ZC_X + ch]); }
        XC[i] = acc; }
}
__device__ __forceinline__ void ph_lru_gates(const Ctx& c, const float* XC, const float* wa, const float* ba, const float* wx, const float* bx, const float* lam, float* AA, float* BT) {
    for (int i = c.gt; i < T * 256; i += c.ngt) { const int t = i >> 8, ch = i & 255, h = ch >> 6, j = ch & 63;
        const float* xr = XC + (size_t)t * 256 + h * 64;
        float ra = ba[ch], rx = bx[ch];
        for (int k = 0; k < 64; ++k) { const float xv = xr[k]; ra += xv * wa[(h * 64 + k) * 64 + j]; rx += xv * wx[(h * 64 + k) * 64 + j]; }
        const float r = sigmoid_f(ra), ig = sigmoid_f(rx);
        const float lsg = -log1pf(expf(-lam[ch]));
        const float la = 8.f * r * lsg, av = expf(la);
        AA[i] = av; BT[i] = sqrtf(-expm1f(2.f * la)) * (ig * XC[i]); }
}
__device__ __forceinline__ void ph_lru_scan(const Ctx& c, const float* AA, const float* BT, const bf16* Z, bf16* ROUT) {
    for (int item = c.gw; item < NB * 4; item += c.ngw) {
        const int i = item * 64 + c.lane, b = i >> 8, ch = i & 255;
        float h = 0.f;
#pragma unroll 8
        for (int s = 0; s < SEQ; ++s) { const size_t t = (size_t)b * SEQ + s;
            h = AA[t * 256 + ch] * h + BT[t * 256 + ch];
            ROUT[t * 256 + ch] = f2bf(h * gelu_f(bf2f(Z[t * ZW + ZC_G + ch]))); }
    }
}

__device__ __forceinline__ void ph_mixnorm(const Ctx& c, const bf16* AO, const bf16* SOUT, const bf16* ROUT, const float* g, bf16* Y) {
    const int lane = c.lane;
    for (int row = c.gw; row < T; row += c.ngw) {
        {   float v[8]; unpack8(*(const uint4*)(AO + (size_t)row * 512 + 8 * lane), v);
            float ss = 0.f;
#pragma unroll
            for (int e = 0; e < 8; ++e) ss += v[e] * v[e];
            const float rstd = rsqrtf(wave_sum(ss) * (1.f / 512) + EPS); const float* gg = g + 8 * lane;
            *(uint4*)(Y + (size_t)row * DM + 8 * lane) = make_uint4(pk2(v[0] * rstd * gg[0], v[1] * rstd * gg[1]), pk2(v[2] * rstd * gg[2], v[3] * rstd * gg[3]),
                                                                    pk2(v[4] * rstd * gg[4], v[5] * rstd * gg[5]), pk2(v[6] * rstd * gg[6], v[7] * rstd * gg[7])); }
#pragma unroll
        for (int part = 0; part < 2; ++part) {
            const bf16* src = part == 0 ? SOUT : ROUT; const int off = 512 + 256 * part;
            const uint2 w = *(const uint2*)(src + (size_t)row * 256 + 4 * lane);
            float a0 = __uint_as_float(w.x << 16), a1 = __uint_as_float(w.x & 0xffff0000u), a2 = __uint_as_float(w.y << 16), a3 = __uint_as_float(w.y & 0xffff0000u);
            const float rstd = rsqrtf(wave_sum(a0 * a0 + a1 * a1 + a2 * a2 + a3 * a3) * (1.f / 256) + EPS); const float* gg = g + off + 4 * lane;
            *(uint2*)(Y + (size_t)row * DM + off + 4 * lane) = make_uint2(pk2(a0 * rstd * gg[0], a1 * rstd * gg[1]), pk2(a2 * rstd * gg[2], a3 * rstd * gg[3]));
        }
    }
}

__device__ __forceinline__ void ph_topk_a(const Ctx& c, const float* SC, float* STOP, int* ITOP) {
    for (int i = c.gt; i < T * 16; i += c.ngt) {
        const float* sc = SC + (size_t)i * 128;
        float pv = INFINITY; int pn = -1;
        for (int it = 0; it < 16; ++it) {
            float bv = -INFINITY; int bn = 1 << 30;
            for (int n = 0; n < 128; ++n) { const float v = sc[n];
                const bool elig = (v < pv) || (v == pv && n > pn);
                if (elig && (v > bv || (v == bv && n < bn))) { bv = v; bn = n; } }
            STOP[(size_t)i * 16 + it] = bv; ITOP[(size_t)i * 16 + it] = bn; pv = bv; pn = bn;
        }
    }
}
__device__ __forceinline__ void ph_topk_b(const Ctx& c, const float* STOP, const int* ITOP, int* IDX, float* GATE) {
    LAS float* my = (LAS float*)c.lds + c.tid * 33;
    for (int i = c.gt; i < T * 8; i += c.ngt) {
        for (int k = 0; k < 32; ++k) my[k] = STOP[(size_t)i * 32 + k];
        float pv = INFINITY; int pn = -1; float best0 = 0.f, den = 0.f;
        float ev[16];
#pragma unroll
        for (int it = 0; it < 16; ++it) {
            float bv = -INFINITY; int bn = 1 << 30;
            for (int f = 0; f < 256; ++f) { const float v = my[f >> 4] + my[16 + (f & 15)];
                const bool elig = (v < pv) || (v == pv && f > pn);
                if (elig && (v > bv || (v == bv && f < bn))) { bv = v; bn = f; } }
            pv = bv; pn = bn;
            if (it == 0) best0 = bv;
            ev[it] = expf(bv - best0); den += ev[it];
            IDX[(size_t)i * 16 + it] = ITOP[(size_t)i * 32 + (bn >> 4)] * 128 + ITOP[(size_t)i * 32 + 16 + (bn & 15)];
        }
#pragma unroll
        for (int it = 0; it < 16; ++it) GATE[(size_t)i * 16 + it] = ev[it] / den;
    }
}

__device__ __forceinline__ void ph_gather(const Ctx& c, const bf16* HN, const int* IDX, const float* GATE, const bf16* PU, const bf16* PV, float* X) {
    const int lane = c.lane;
    for (int t = c.gw; t < T; t += c.ngw) {
        float hn[16]; unpack8(*(const uint4*)(HN + (size_t)t * DM + 8 * lane), hn); unpack8(*(const uint4*)(HN + (size_t)t * DM + 512 + 8 * lane), hn + 8);
        float y[16];
#pragma unroll
        for (int e = 0; e < 16; ++e) y[e] = 0.f;
        for (int k = 0; k < 128; ++k) {
            const int e = IDX[(size_t)t * 128 + k]; const float gt = GATE[(size_t)t * 128 + k];
            const bf16* ur = PU + (size_t)e * DM; const bf16* vr = PV + (size_t)e * DM;
            float u[16]; unpack8(*(const uint4*)(ur + 8 * lane), u); unpack8(*(const uint4*)(ur + 512 + 8 * lane), u + 8);
            float d = 0.f;
#pragma unroll
            for (int q = 0; q < 16; ++q) d += u[q] * hn[q];
            d = wave_sum(d);
            const float w = gt * gelu_f(d);
            float v[16]; unpack8(*(const uint4*)(vr + 8 * lane), v); unpack8(*(const uint4*)(vr + 512 + 8 * lane), v + 8);
#pragma unroll
            for (int q = 0; q < 16; ++q) y[q] += w * v[q];
        }
        float4* xo = (float4*)(X + (size_t)t * DM + 8 * lane);
        float4 p0 = xo[0], p1 = xo[1]; p0.x += y[0]; p0.y += y[1]; p0.z += y[2]; p0.w += y[3]; p1.x += y[4]; p1.y += y[5]; p1.z += y[6]; p1.w += y[7]; xo[0] = p0; xo[1] = p1;
        xo = (float4*)(X + (size_t)t * DM + 512 + 8 * lane);
        p0 = xo[0]; p1 = xo[1]; p0.x += y[8]; p0.y += y[9]; p0.z += y[10]; p0.w += y[11]; p1.x += y[12]; p1.y += y[13]; p1.z += y[14]; p1.w += y[15]; xo[0] = p0; xo[1] = p1;
    }
}
namespace att {
typedef short bf16x8 __attribute__((ext_vector_type(8)));
typedef short s16x4 __attribute__((ext_vector_type(4)));
typedef float f32x16 __attribute__((ext_vector_type(16)));
typedef unsigned u32x4 __attribute__((ext_vector_type(4)));
constexpr int KT = 64, KBYTES = KT * DQK * 2, VBYTES = KT * DV * 2, BUFB = KBYTES + VBYTES;
constexpr int OFF_WS = 2 * BUFB, OFF_MO = 0, OFF_ML = 65536, LDS_NEED = OFF_WS + 8 * 64 * 4;
constexpr float THR = 8.f;
__device__ __forceinline__ int kswz(int row, int c) { return row * 384 + (((c & ~7) | ((c & 7) ^ ((row >> 1) & 7))) << 4); }
__device__ __forceinline__ int v_st(int k, int c) { const int kk = (k & ~0xC) | ((k & 4) << 1) | ((k & 8) >> 1); return ((kk >> 3) * 4 + (c >> 5)) * 512 + ((kk & 7) * 32 + (c & 31)) * 2; }
__device__ __forceinline__ int v_rd_base(int lane) { return ((lane & 3) << 3) | (((lane >> 2) & 3) << 6) | (((lane >> 4) & 1) << 5) | (((lane >> 5) & 1) << 8); }
__device__ __forceinline__ int crow(int r, int hi) { return (r & 3) + 8 * (r >> 2) + 4 * hi; }
__device__ __forceinline__ unsigned cvtpk(float lo, float hi) { unsigned r; asm volatile("v_cvt_pk_bf16_f32 %0, %1, %2" : "=v"(r) : "v"(lo), "v"(hi)); return r; }
#define ATT_SBAR() __builtin_amdgcn_sched_barrier(0)

__device__ __forceinline__ void attn_unit(LAS unsigned char* lds, const bf16* Qg, const bf16* Kg, const bf16* Vg, bf16* AO, int bh, int qb, int tid) {
    const int lane = tid & 63, wid = __builtin_amdgcn_readfirstlane(tid >> 6), qsub = wid & 3, kh = wid >> 2, r32 = lane & 31, hi = lane >> 5;
    const int q0 = qb * 128, NT = 2 * (qb + 1);
    const size_t rowbase = (size_t)bh * SEQ;
    bf16x8 qr[12];
    { const bf16* qp = Qg + (rowbase + q0 + 32 * qsub + r32) * DQK + 8 * hi;
#pragma unroll
      for (int ks = 0; ks < 12; ++ks) qr[ks] = *(const bf16x8*)(qp + 16 * ks); }
    int ksrc[3], vsrc[2];
#pragma unroll
    for (int j = 0; j < 3; ++j) { const int L = (wid + 8 * j) * 64 + lane, row = L / 24, cp = L - row * 24, c = (cp & ~7) | ((cp & 7) ^ ((row >> 1) & 7)); ksrc[j] = row * DQK + c * 8; }
#pragma unroll
    for (int j = 0; j < 2; ++j) { const int X = ((wid + 8 * j) * 64 + lane) * 16, sub = X >> 9, within = (X & 511) >> 1, kk = ((sub >> 2) << 3) | (within >> 5);
        const int k = (kk & ~0xC) | ((kk & 4) << 1) | ((kk & 8) >> 1), c = (sub & 3) * 32 + (within & 31); vsrc[j] = k * DV + c; }
    const bf16* Kt = Kg + rowbase * DQK; const bf16* Vt = Vg + rowbase * DV;
#define ATT_STAGE(t, bo) do { const bf16* kp_ = Kt + (size_t)(t) * (KT * DQK); const bf16* vp_ = Vt + (size_t)(t) * (KT * DV); \
        _Pragma("unroll") for (int j_ = 0; j_ < 3; ++j_) __builtin_amdgcn_global_load_lds((const unsigned*)(kp_ + ksrc[j_]), (LAS unsigned*)(lds + (bo) + (wid + 8 * j_) * 1024), 16, 0, 0); \
        _Pragma("unroll") for (int j_ = 0; j_ < 2; ++j_) __builtin_amdgcn_global_load_lds((const unsigned*)(vp_ + vsrc[j_]), (LAS unsigned*)(lds + (bo) + KBYTES + (wid + 8 * j_) * 1024), 16, 0, 0); } while (0)
    const int krow = 32 * kh + r32, kf = (krow >> 1) & 7;
    int kb[4];
#pragma unroll
    for (int j = 0; j < 4; ++j) kb[j] = krow * 384 + ((((2 * j + hi) & 7) ^ kf) << 4);
    const int vb = KBYTES + v_rd_base(lane) + kh * 8192;
    LAS float* wsf = (LAS float*)(lds + OFF_WS) + wid * 64;
    float m_reg = -1e30f, l_reg = 0.f; f32x16 o[4];
#pragma unroll
    for (int d = 0; d < 4; ++d) o[d] = f32x16{};
    const int rb = 32 * qsub;
    ATT_STAGE(0, 0);
    asm volatile("s_waitcnt vmcnt(0)" ::: "memory");
    __syncthreads();
    for (int t = 0; t < NT; ++t) {
        const int bo = (t & 1) * BUFB;
        if (t + 1 < NT) ATT_STAGE(t + 1, BUFB - bo);
        const int kboff = 64 * t + 32 * kh - q0;
        const bool act = kboff <= rb, diag = kboff == rb;
        if (act) {
            f32x16 p = f32x16{};
#pragma unroll
            for (int ks = 0; ks < 12; ++ks) {
                const bf16x8 kfr = *(const LAS bf16x8*)(lds + bo + kb[ks & 3] + (ks >> 2) * 128);
                p = __builtin_amdgcn_mfma_f32_32x32x16_bf16(kfr, qr[ks], p, 0, 0, 0);
            }
            if (diag) {
#pragma unroll
                for (int r = 0; r < 16; ++r) if (crow(r, hi) > r32) p[r] = -__builtin_inff();
            }
            float pmax = p[0];
#pragma unroll
            for (int r = 1; r < 16; ++r) pmax = fmaxf(pmax, p[r]);
            { auto rr = __builtin_amdgcn_permlane32_swap(__float_as_uint(pmax), __float_as_uint(pmax), false, false);
              pmax = fmaxf(__uint_as_float(rr[0]), __uint_as_float(rr[1])); }
            float alpha = 1.f;
            if (!__all(pmax - m_reg <= THR)) { const float mn = fmaxf(m_reg, pmax); alpha = __builtin_amdgcn_exp2f(m_reg - mn); m_reg = mn; }
#pragma unroll
            for (int r = 0; r < 16; ++r) p[r] = __builtin_amdgcn_exp2f(p[r] - m_reg);
            float ps = 0.f;
#pragma unroll
            for (int r = 0; r < 16; ++r) ps += p[r];
            { auto rr = __builtin_amdgcn_permlane32_swap(__float_as_uint(ps), __float_as_uint(ps), false, false);
              ps = __uint_as_float(rr[0]) + __uint_as_float(rr[1]); }
            l_reg = l_reg * alpha + ps;
            if (__any(alpha < 1.f)) {
                if (hi == 0) wsf[r32] = alpha;
                asm volatile("s_waitcnt lgkmcnt(0)" ::: "memory");
#pragma unroll
                for (int r = 0; r < 16; ++r) { const float al = wsf[crow(r, hi)];
#pragma unroll
                    for (int d = 0; d < 4; ++d) o[d][r] *= al; }
            }
            bf16x8 pa0, pa1;
#define ATT_PK4(B_, OUT) do { unsigned a0 = cvtpk(p[B_ + 0], p[B_ + 1]), a1 = cvtpk(p[B_ + 2], p[B_ + 3]); unsigned b0 = cvtpk(p[B_ + 4], p[B_ + 5]), b1 = cvtpk(p[B_ + 6], p[B_ + 7]); \
            auto r0 = __builtin_amdgcn_permlane32_swap(a0, b0, false, false); auto r1 = __builtin_amdgcn_permlane32_swap(a1, b1, false, false); \
            u32x4 w_ = {r0[0], r1[0], r0[1], r1[1]}; OUT = __builtin_bit_cast(bf16x8, w_); } while (0)
            ATT_PK4(0, pa0); ATT_PK4(8, pa1);
#undef ATT_PK4
            const int vaddr = (int)(uintptr_t)lds + bo + vb;
#define ATT_TRRD(dst, off) asm volatile("ds_read_b64_tr_b16 %0, %1 offset:%2" : "=&v"(dst) : "v"(vaddr), "i"(off) : "memory")
#define ATT_PV(d0) do { s16x4 l0, h0, l1, h1; \
            ATT_TRRD(l0, (d0) * 512); ATT_TRRD(h0, (d0) * 512 + 2048); ATT_TRRD(l1, (d0) * 512 + 4096); ATT_TRRD(h1, (d0) * 512 + 6144); \
            asm volatile("s_waitcnt lgkmcnt(0)" ::: "memory"); ATT_SBAR(); \
            o[d0] = __builtin_amdgcn_mfma_f32_32x32x16_bf16(pa0, (bf16x8){l0[0], l0[1], l0[2], l0[3], h0[0], h0[1], h0[2], h0[3]}, o[d0], 0, 0, 0); \
            o[d0] = __builtin_amdgcn_mfma_f32_32x32x16_bf16(pa1, (bf16x8){l1[0], l1[1], l1[2], l1[3], h1[0], h1[1], h1[2], h1[3]}, o[d0], 0, 0, 0); } while (0)
            ATT_PV(0); ATT_PV(1); ATT_PV(2); ATT_PV(3);
#undef ATT_PV
#undef ATT_TRRD
        }
        asm volatile("s_waitcnt vmcnt(0)" ::: "memory");
        __syncthreads();
    }
    LAS float* MO = (LAS float*)(lds + OFF_MO) + qsub * 4096; LAS float* ML = (LAS float*)(lds + OFF_ML) + qsub * 64;
    if (kh == 1) {
        if (hi == 0) { ML[2 * r32] = m_reg; ML[2 * r32 + 1] = l_reg; }
#pragma unroll
        for (int d = 0; d < 4; ++d)
#pragma unroll
            for (int r = 0; r < 16; ++r) MO[(d * 16 + r) * 64 + lane] = o[d][r];
    }
    __syncthreads();
    if (kh == 0) {
        const float m1 = ML[2 * r32], l1 = ML[2 * r32 + 1];
        const float mm = fmaxf(m_reg, m1), f0 = __builtin_amdgcn_exp2f(m_reg - mm), f1 = __builtin_amdgcn_exp2f(m1 - mm);
        const float il = 1.f / (l_reg * f0 + l1 * f1);
        if (hi == 0) { wsf[r32] = f0 * il; wsf[32 + r32] = f1 * il; }
        asm volatile("s_waitcnt lgkmcnt(0)" ::: "memory");
        const int b = bh / NH, h = bh % NH;
        bf16* Ow = AO + ((size_t)b * SEQ + q0 + rb) * 512 + h * DV;
#pragma unroll
        for (int r = 0; r < 16; ++r) { const int orow = crow(r, hi); const float g0 = wsf[orow], g1 = wsf[32 + orow];
#pragma unroll
            for (int d = 0; d < 4; ++d) { const float v = o[d][r] * g0 + MO[(d * 16 + r) * 64 + lane] * g1; const float vn = __shfl_xor(v, 1);
                if ((r32 & 1) == 0) *(unsigned*)(Ow + (size_t)orow * 512 + d * 32 + r32) = cvtpk(v, vn); } }
    }
    __syncthreads();
#undef ATT_STAGE
}
__device__ __forceinline__ void attn_phase(LAS unsigned char* lds, const bf16* Qg, const bf16* Kg, const bf16* Vg, bf16* AO, int G, int bid, int tid) {
    const int npair = NB * NH * 32;
    for (int v0 = bid; v0 < npair; v0 += G) {
        const int vcu = (G % 8 == 0 && npair % G == 0) ? (v0 % 8) * (npair / 8) + v0 / 8 : v0;
        const int bh = vcu >> 5, s = vcu & 31;
        for (int u = 0; u < 2; ++u) attn_unit(lds, Qg, Kg, Vg, AO, bh, u ? s : 63 - s, tid);
    }
}
#undef ATT_SBAR
}
#ifndef MK_SIMPLE_TOPK
#define MK_SIMPLE_TOPK 0
#endif
#ifndef MK_SIMPLE_SCAN
#define MK_SIMPLE_SCAN 0
#endif
#ifndef MK_SIMPLE_ATTN
#define MK_SIMPLE_ATTN 0
#endif
#ifndef MK_SIMPLE_GEMM
#define MK_SIMPLE_GEMM 0
#endif
constexpr int NPH_LAYER = 16, NPH = 1 + NL * NPH_LAYER;
struct GD { const bf16* A; const bf16* Bt; void* C; const float* aux0; const bf16* aux1; int lda, M, N, K, ldc, kind; };
template <class Epi> __device__ __forceinline__ void run_gemm(const Ctx& c, const bf16* A, int lda, const bf16* Bt, int M, int N, int K, const Epi& E) {
    pg8::Gemm g{A, Bt, M, N, K, lda}; pg8::StaticOrder S; S.init(M, N, c.G, c.bid);
    pg8::gemm_phase<Epi, pg8::StaticOrder, true, true>(c.lds, g, S, E);
}
#define AS4 __attribute__((address_space(4)))
__global__ void __launch_bounds__(NTHR, 2) mega(Args a_) {
    extern __shared__ __attribute__((aligned(16))) unsigned char lds_raw[];
    {   const int t0 = threadIdx.x;
        for (int u = t0; u < (LDS_BYTES - RING_BYTES) / 4; u += NTHR) ((LAS unsigned*)((LAS unsigned char*)lds_raw + RING_BYTES))[u] = 0u; }
    __syncthreads();
    volatile LAS unsigned* MISC = (volatile LAS unsigned*)((LAS unsigned char*)lds_raw + MISC_OFF);
    XcdBarrier bar; bar.bar = (unsigned*)(a_.ws + WS_CTL) + CW_BAR; bar.x = 0; bar.st = MISC + 8;
    const int ph_lo = a_.ph_lo, ph_hi = a_.ph_hi;
    if (ph_hi - ph_lo > 1) bar = xcd_barrier_post((unsigned*)(a_.ws + WS_CTL) + CW_BAR, MISC + 8);

    int p = ph_lo;
    if (p == 0) {
        const Args AS4* ap0 = (const Args AS4*)__builtin_amdgcn_kernarg_segment_ptr(); Ctx c0; c0.lds = (LAS unsigned char*)lds_raw; c0.tid = threadIdx.x; c0.lane = c0.tid & 63; c0.wave = __builtin_amdgcn_readfirstlane(c0.tid >> 6);
        c0.G = gridDim.x; c0.bid = blockIdx.x; c0.gw = c0.wave * c0.G + c0.bid; c0.ngw = NWAVES * c0.G; c0.gt = c0.bid * NTHR + c0.tid; c0.ngt = c0.G * NTHR;
        ph_prep(*ap0, c0);
        if (p + 1 < ph_hi) xcd_barrier(bar);
        p = 1;
    }
    for (; p < ph_hi; ++p) {
        const Args AS4* ap = (const Args AS4*)__builtin_amdgcn_kernarg_segment_ptr(); asm volatile("" : "+s"(ap));
        int tid_ = threadIdx.x; asm volatile("" : "+v"(tid_));
#define a (*ap)
        Ctx c; c.lds = (LAS unsigned char*)lds_raw; c.tid = tid_; c.lane = c.tid & 63; c.wave = __builtin_amdgcn_readfirstlane(c.tid >> 6);
        { int G_ = gridDim.x, bid_ = blockIdx.x; asm volatile("" : "+s"(G_), "+s"(bid_)); c.G = G_; c.bid = bid_; }
        c.gw = c.wave * c.G + c.bid; c.ngw = NWAVES * c.G; c.gt = c.bid * NTHR + c.tid; c.ngt = c.G * NTHR;
        bf16 *WINT = WSP(bf16, WS_WINT), *WUQT = WSP(bf16, WS_WUQT), *WUKVT = WSP(bf16, WS_WUKVT), *GLUT = WSP(bf16, WS_GLUT), *WOUTT = WSP(bf16, WS_WOUTT),
             *WQT = WSP(bf16, WS_WQT), *SUBKT = WSP(bf16, WS_SUBKT), *PU = WSP(bf16, WS_PU), *PV = WSP(bf16, WS_PV);
        float *COS = WSP(float, WS_COS), *SIN = WSP(float, WS_SIN);
        bf16 *XB = WSP(bf16, WS_XB), *Z = WSP(bf16, WS_Z), *QRAW = WSP(bf16, WS_QRAW), *KVRAW = WSP(bf16, WS_KVRAW), *QB = WSP(bf16, WS_QB), *KB = WSP(bf16, WS_KB),
             *VB = WSP(bf16, WS_VB), *CQN = WSP(bf16, WS_CQN), *CKVN = WSP(bf16, WS_CKVN), *AO = WSP(bf16, WS_AO), *ROUT = WSP(bf16, WS_ROUT), *Y = WSP(bf16, WS_Y),
             *YG = WSP(bf16, WS_YG), *SOUT = WSP(bf16, WS_SOUT), *QP = WSP(bf16, WS_QP);
        float *XC = WSP(float, WS_XC), *AA = WSP(float, WS_AA), *BT = WSP(float, WS_BT), *SC = WSP(float, WS_SC), *STOP = WSP(float, WS_STOP), *GATE = WSP(float, WS_GATE);
        int *ITOP = WSP(int, WS_ITOP), *IDX = WSP(int, WS_IDX);
        float* out = a.out;
        {
            const int l = (p - 1) / NPH_LAYER, k = (p - 1) % NPH_LAYER;
            const float* xin = (l == 0) ? INF(0) : out;
            GD gd; gd.kind = 0; gd.A = nullptr; gd.Bt = nullptr; gd.C = nullptr; gd.aux0 = nullptr; gd.aux1 = nullptr; gd.lda = 0; gd.M = T; gd.N = 0; gd.K = 0; gd.ldc = 0;
#define SETG(kind_, A_, lda_, Bt_, M_, N_, K_, C_, ldc_, aux0_, aux1_) do { gd.kind = kind_; gd.A = A_; gd.lda = lda_; gd.Bt = Bt_; gd.M = M_; gd.N = N_; gd.K = K_; gd.C = (void*)(C_); gd.ldc = ldc_; gd.aux0 = aux0_; gd.aux1 = aux1_; } while (0)
            switch (k) {
            case 0: ph_rowprep(c, xin, INF(2) + l * DM, XB); break;
            case 1: SETG(1, XB, DM, WINT + (size_t)l * ZW * DM, T, ZW, DM, Z, ZW, nullptr, nullptr); break;
            case 2: ph_zstats(c, Z, INF(4) + l * 256, INF(6) + l * 128, CQN, CKVN);
#if MK_SIMPLE_SCAN
                ph_lru_xc(c, Z, INF(20) + l * 1024, INF(21) + l * 256, XC);
#else
                s5f::pass<false>(c.lds, Z, WSP(bf16, WS_S5A) + (size_t)l * 32768, WSP(bf16, WS_S5C) + (size_t)l * 32768, WSP(float2, WS_S5L) + l * 1024, INF(17) + l * 256, WSP(float2, WS_SE), WSP(float2, WS_SH), YG, c.gw, c.ngw, c.wave, c.lane);
                __syncthreads();
                lruf::pass_a(c.lds, Z, INF(20) + l * 1024, INF(21) + l * 256, INF(22) + l * 16384, INF(23) + l * 256, INF(24) + l * 16384, INF(25) + l * 256, INF(26) + l * 256, AA, BT, WSP(float2, WS_LPE), c.gw, c.ngw, c.wave, c.lane);
#endif
                break;
            case 3: SETG(1, CQN, 256, WUQT + (size_t)l * 768 * 256, T, 768, 256, QRAW, 768, nullptr, nullptr);
#if !MK_SIMPLE_SCAN
                s5f::carry(WSP(float2, WS_S5L) + l * 1024, WSP(float2, WS_SE), WSP(float2, WS_SH), c.gw, c.ngw, c.lane);
                lruf::carry(WSP(float2, WS_LPE), WSP(float, WS_LH), c.gt, c.ngt);
#endif
                break;
            case 4: SETG(1, CKVN, 128, WUKVT + (size_t)l * 1024 * 128, T, 1024, 128, KVRAW, 1024, nullptr, nullptr);
#if MK_SIMPLE_SCAN
                ph_lru_gates(c, XC, INF(22) + l * 16384, INF(23) + l * 256, INF(24) + l * 16384, INF(25) + l * 256, INF(26) + l * 256, AA, BT);
#endif
                break;
            case 5: ph_qkfin(c, QRAW, KVRAW, Z, INF(8) + l * DQK, INF(9) + l * DQK, COS, SIN, QB, KB, VB); break;
            case 6:
#if MK_SIMPLE_SCAN
                ph_s5_simple(c, Z, INF(10) + l * 1024, INF(11) + l * 1024, INF(12) + l * 16, INF(13) + l * 16384, INF(14) + l * 16384, INF(15) + l * 16384, INF(16) + l * 16384, INF(17) + l * 256, YG);
                ph_lru_scan(c, AA, BT, Z, ROUT);
#else
                s5f::pass<true>(c.lds, Z, WSP(bf16, WS_S5A) + (size_t)l * 32768, WSP(bf16, WS_S5C) + (size_t)l * 32768, WSP(float2, WS_S5L) + l * 1024, INF(17) + l * 256, WSP(float2, WS_SE), WSP(float2, WS_SH), YG, c.gw, c.ngw, c.wave, c.lane);
                lruf::pass_b(AA, BT, WSP(float, WS_LH), Z, ROUT, c.gt, c.ngt);
#endif
#if MK_SIMPLE_ATTN
                ph_attn_simple(c, QB, KB, VB, AO);
#else
                __syncthreads(); att::attn_phase(c.lds, QB, KB, VB, AO, c.G, c.bid, c.tid);
#endif
                break;
            case 7: SETG(3, YG, 256, GLUT + (size_t)l * 65536, T, 256, 256, SOUT, 256, INF(19) + l * 256, YG); break;
            case 8: ph_mixnorm(c, AO, SOUT, ROUT, INF(27) + l * DM, Y); break;
            case 9: SETG(2, Y, DM, WOUTT + (size_t)l * DM * DM, T, DM, DM, out, DM, xin, nullptr); break;
            case 10: ph_rowprep(c, out, INF(29) + l * DM, XB); break;
            case 11: SETG(1, XB, DM, WQT + (size_t)l * 2048 * DM, T, 2048, DM, QP, 2048, nullptr, nullptr); break;
            case 12: SETG(2, QP, 256, SUBKT + (size_t)l * 65536, T * 8, 256, 256, SC, 256, nullptr, nullptr); break;
#if MK_SIMPLE_TOPK
            case 13: ph_topk_a(c, SC, STOP, ITOP); break;
            case 14: ph_topk_b(c, STOP, ITOP, IDX, GATE); break;
#else
            case 13: tk::topk_phase(SC, IDX, GATE, c.gw, c.ngw, c.lane); break;
            case 14: break;
#endif
            default: pgf::gather(XB, IDX, GATE, WSP(unsigned char, WS_PU) + (size_t)l * 16384 * DM, WSP(unsigned char, WS_PV) + (size_t)l * 16384 * DM, out, c.gw, c.ngw, c.lane); break;
            }
#undef SETG
#if MK_SIMPLE_GEMM
            if (gd.kind == 1) gemm_simple<EPI_BF16>(c, gd.A, gd.lda, gd.Bt, gd.M, gd.N, gd.K, gd.C, gd.ldc, nullptr, nullptr);
            else if (gd.kind == 2) { if (gd.aux0) gemm_simple<EPI_RESID>(c, gd.A, gd.lda, gd.Bt, gd.M, gd.N, gd.K, gd.C, gd.ldc, gd.aux0, nullptr); else gemm_simple<EPI_F32>(c, gd.A, gd.lda, gd.Bt, gd.M, gd.N, gd.K, gd.C, gd.ldc, nullptr, nullptr); }
            else if (gd.kind == 3) gemm_simple<EPI_GLU>(c, gd.A, gd.lda, gd.Bt, gd.M, gd.N, gd.K, gd.C, gd.ldc, gd.aux0, gd.aux1);
#else
            if (gd.kind == 1) run_gemm(c, gd.A, gd.lda, gd.Bt, gd.M, gd.N, gd.K, pg8::EpiBf16<0>{(bf16*)gd.C, gd.ldc, nullptr, 0, 0, 1.f});
            else if (gd.kind == 2) run_gemm(c, gd.A, gd.lda, gd.Bt, gd.M, gd.N, gd.K, pg8::EpiF32{(float*)gd.C, gd.ldc, gd.aux0});
            else if (gd.kind == 3) run_gemm(c, gd.A, gd.lda, gd.Bt, gd.M, gd.N, gd.K, pg8::EpiGlu{(bf16*)gd.C, gd.ldc, gd.aux0, gd.aux1});
#endif
        }
        if (p + 1 < ph_hi) { XcdBarrier b2 = bar; unsigned* bb = (unsigned*)(a.ws + WS_CTL) + CW_BAR; unsigned bx = bar.x; asm volatile("" : "+s"(bb), "+s"(bx)); b2.bar = bb; b2.x = bx; xcd_barrier(b2); }
#undef a
    }
}

extern "C" void kernel_launch(void* const* d_in, const int* in_sizes, int n_in, void* d_out, int out_size, void* d_ws, size_t ws_size, hipStream_t stream) {
    static int grid = 0;
    if (grid == 0) {
        if (n_in != 34 || out_size != T * DM || ws_size < WS_END) { fprintf(stderr, "kernel_launch: unexpected shapes (n_in %d out %d ws %zu)\n", n_in, out_size, ws_size); grid = -1; return; }
        int dev = 0, cus = 0, per_cu = 0;
        if (hipGetDevice(&dev) != hipSuccess || hipDeviceGetAttribute(&cus, hipDeviceAttributeMultiprocessorCount, dev) != hipSuccess) { grid = -1; return; }
        if (hipFuncSetAttribute((const void*)mega, hipFuncAttributeMaxDynamicSharedMemorySize, LDS_BYTES) != hipSuccess) { fprintf(stderr, "kernel_launch: hipFuncSetAttribute failed\n"); grid = -1; return; }
        if (hipOccupancyMaxActiveBlocksPerMultiprocessor(&per_cu, (const void*)mega, NTHR, LDS_BYTES) != hipSuccess || per_cu < 1) { fprintf(stderr, "kernel_launch: occupancy query says %d blocks per CU\n", per_cu); }
        (void)hipGetLastError();
        grid = cus;
    }
    if (grid < 0) return;
    (void)hipMemsetAsync((char*)d_ws + WS_CTL, 0, CTL_ZERO_BYTES, stream);
    Args a{};
    for (int i = 0; i < 34; ++i) a.in[i] = d_in[i];
    a.out = (float*)d_out; a.ws = (unsigned char*)d_ws;
#if MK_PER_PHASE
    for (int p = 0; p < NPH; ++p) { a.ph_lo = p; a.ph_hi = p + 1; hipLaunchKernelGGL(mega, dim3(grid), dim3(NTHR), LDS_BYTES, stream, a); }
#else
    a.ph_lo = 0; a.ph_hi = NPH;
    hipLaunchKernelGGL(mega, dim3(grid), dim3(NTHR), LDS_BYTES, stream, a);
#endif
}
```

```cpp
#include <hip/hip_runtime.h>
#include <cstdint>
#include <cstdio>

#ifndef MK_PER_PHASE
#define MK_PER_PHASE 0
#endif

typedef unsigned short bf16;
typedef unsigned int u32;

constexpr int NB = 2, SEQ = 8192, T = NB * SEQ, DM = 1024, NL = 2;
constexpr int ZW = 1280;
constexpr int ZC_CQ = 0, ZC_CKV = 256, ZC_KR = 384, ZC_U = 512, ZC_X = 768, ZC_G = 1024;
constexpr int NH = 4, DQK = 192, DV = 128;
constexpr float EPS = 1e-6f;
constexpr float QSCALE = 0.07216878364870322f * 1.4426950408889634f;

constexpr size_t MiB = 1u << 20;
constexpr size_t WS_CTL = 0, CTL_ZERO_BYTES = 1 * MiB, WS_WINT = 1 * MiB, WS_WUQT = 7 * MiB, WS_WUKVT = 8 * MiB, WS_GLUT = 9 * MiB, WS_WOUTT = 10 * MiB,
                 WS_WQT = 14 * MiB, WS_SUBKT = 22 * MiB, WS_COS = 23 * MiB, WS_SIN = 25 * MiB, WS_PU = 28 * MiB, WS_PV = 92 * MiB,
                 WS_XB = 156 * MiB, WS_Z = 188 * MiB, WS_RA = 228 * MiB, WS_RB = 356 * MiB, WS_CKVN = 420 * MiB, WS_AO = 424 * MiB,
                 WS_ROUT = 440 * MiB, WS_Y = 448 * MiB, WS_IDX = 480 * MiB, WS_GATE = 488 * MiB, WS_S5A = 496 * MiB, WS_S5C = WS_S5A + 128 * 1024, WS_S5L = WS_S5A + 256 * 1024,
                 WS_SE = 497 * MiB, WS_SH = 501 * MiB, WS_LPE = 505 * MiB, WS_LH = 506 * MiB, WS_END = 507 * MiB;
constexpr size_t WS_QRAW = WS_RA, WS_KVRAW = WS_RA + 24 * MiB, WS_QB = WS_RA + 56 * MiB, WS_KB = WS_RA + 80 * MiB, WS_VB = WS_RA + 104 * MiB,
                 WS_CQN = WS_RA + 120 * MiB, WS_SC = WS_RA;
constexpr size_t WS_XC = WS_RB, WS_AA = WS_RB + 16 * MiB, WS_BT = WS_RB + 32 * MiB, WS_YG = WS_RB + 48 * MiB, WS_SOUT = WS_RB + 56 * MiB, WS_QP = WS_RB;
constexpr size_t WS_STOP = WS_Z, WS_ITOP = WS_Z + 16 * MiB;
constexpr int CW_BAR = 4096;

__device__ __forceinline__ float bf2f(bf16 h) { return __uint_as_float((u32)h << 16); }
__device__ __forceinline__ bf16 f2bf(float f) { u32 u = __float_as_uint(f); return (bf16)((u + 0x7fffu + ((u >> 16) & 1u)) >> 16); }
__device__ __forceinline__ u32 pk2(float lo, float hi) { return (u32)f2bf(lo) | ((u32)f2bf(hi) << 16); }
__device__ __forceinline__ float wave_sum(float v) {
#pragma unroll
    for (int o = 32; o > 0; o >>= 1) v += __shfl_xor(v, o);
    return v;
}
__device__ __forceinline__ float wave_max(float v) {
#pragma unroll
    for (int o = 32; o > 0; o >>= 1) v = fmaxf(v, __shfl_xor(v, o));
    return v;
}
__device__ __forceinline__ float gelu_f(float x) { return 0.5f * x * (1.f + erff(x * 0.70710678118654752f)); }
__device__ __forceinline__ float sigmoid_f(float x) { return 1.f / (1.f + __expf(-x)); }
__device__ __forceinline__ void unpack8(uint4 w, float* o) {
    o[0] = __uint_as_float(w.x << 16); o[1] = __uint_as_float(w.x & 0xffff0000u);
    o[2] = __uint_as_float(w.y << 16); o[3] = __uint_as_float(w.y & 0xffff0000u);
    o[4] = __uint_as_float(w.z << 16); o[5] = __uint_as_float(w.z & 0xffff0000u);
    o[6] = __uint_as_float(w.w << 16); o[7] = __uint_as_float(w.w & 0xffff0000u);
}
__device__ __forceinline__ void sincos_acc(float x, float& s, float& c) {
    const float k = rintf(x * 0.15915494309189535f);
    float r = fmaf(-k, 6.28125f, x);
    r = fmaf(-k, 1.9350051879882812e-3f, r);
    r = fmaf(-k, 3.0199160335e-7f, r);
    const float f = r * 0.15915494309189535f;
    s = __builtin_amdgcn_sinf(f); c = __builtin_amdgcn_cosf(f);
}
namespace pg8 {
#define PG8_LAS __attribute__((address_space(3)))
typedef unsigned short bf16_t;
typedef short bf16x8 __attribute__((ext_vector_type(8)));
typedef float f32x4 __attribute__((ext_vector_type(4)));
typedef unsigned u32x4 __attribute__((ext_vector_type(4)));
constexpr int BM = 256, BK = 64, HALF = 128, HTB = HALF * BK * 2  , STAGE_BYTES = 8 * HTB, NXCD = 8, WGM = 8;

__host__ __device__ __forceinline__ int lds_byte(int r, int c) { const int st = (r >> 4) * 2 + (c >> 5), rr = r & 15, cc = c & 31, ob = rr * 64 + cc * 2; return st * 1024 + (ob ^ (((ob >> 9) & 1) << 5)); }
__host__ __device__ __forceinline__ void stage_rc(int b, int& R, int& C) { const int st = b / 1024, sb = b % 1024, swz = sb ^ (((sb >> 9) & 1) << 5); R = (st >> 1) * 16 + swz / 64; C = (st & 1) * 32 + (swz % 64) / 2; }
__host__ __device__ __forceinline__ int perm32(int rho) { const int n = rho >> 4, i = rho & 15; return 8 * (i >> 2) + 4 * n + (i & 3); }

struct Unit { int pm, pn; };
struct Gemm { const bf16_t* A; const bf16_t* Bt; int M, N, K, lda; };

struct StaticOrder {
    int nM, nN, nwg, G, c;
    __host__ __device__ void init(int M, int N, int G_, int c_) { nM = M / BM; nN = N / BM; nwg = nM * nN; G = G_; c = c_; }
    __host__ __device__ bool next(int i, Unit& u) const {
        const long L = (long)i * G + c; if (L >= nwg) return false;
        int wgid = (int)L; { const int q = nwg / NXCD, r = nwg % NXCD, xcd = wgid % NXCD, off = wgid / NXCD; wgid = (xcd < r ? xcd * (q + 1) : r * (q + 1) + (xcd - r) * q) + off; }
        const int nig = WGM * nN, gid = wgid / nig, fm = gid * WGM, gsz = (nM - fm) < WGM ? (nM - fm) : WGM;
        u.pm = fm + ((wgid % nig) % gsz); u.pn = (wgid % nig) / gsz; return true;
    }
    __device__ __forceinline__ void a_ready(const Unit&) const {}
    __device__ __forceinline__ void done(const Unit&) const {}
};

__device__ __forceinline__ unsigned cvt_pk_bf16(float lo, float hi) { unsigned r; asm volatile("v_cvt_pk_bf16_f32 %0, %1, %2" : "=v"(r) : "v"(lo), "v"(hi)); return r; }
typedef float f32x2 __attribute__((ext_vector_type(2)));
__device__ __forceinline__ f32x2 gelu_pk(f32x2 v) {
    const f32x2 av = __builtin_elementwise_abs(v), d = av * 0.2316418882f + 1.0f;
    f32x2 t; t.x = __builtin_amdgcn_rcpf(d.x); t.y = __builtin_amdgcn_rcpf(d.y);
    f32x2 q = t * 0.5307027145f + (-0.7265760135f); q = q * t + 0.7107068705f; q = q * t + (-0.142248368f); q = q * t + 0.127414796f; q = q * t;
    const f32x2 s = (v * v) * (-0.72134752044f);
    f32x2 e; e.x = __builtin_amdgcn_exp2f(s.x); e.y = __builtin_amdgcn_exp2f(s.y);
    const f32x2 m = v * (q * e), r = v - m;
    f32x2 o; o.x = v.x < 0.f ? m.x : r.x; o.y = v.y < 0.f ? m.y : r.y; return o;
}

template <int ACT  > struct EpiBf16 {
    static constexpr bool PERM = true, AFTER_DRAIN = false; static_assert(ACT == 0 || ACT == 1, "EpiBf16: ACT is 0 (none) or 1 (gelu_pk)");
    bf16_t* O; int ldc; const float* bias; int split_cols; size_t split_stride; float scale0;
    __device__ __forceinline__ void operator()(const f32x4 (&acc)[2][2][4][2], const Unit& u, int wr, int wc, int fr, int fq) const {
        const int row0 = u.pm * BM + wr * 64 + fr; int colt = u.pn * BM; bf16_t* base = O;
        float sc = 1.f; if (split_cols) { const int t = colt / split_cols; base += (size_t)t * split_stride; colt -= t * split_cols; if (t == 0) sc = scale0; }
        const int col0 = colt + wc * 32 + 8 * fq, bcol0 = u.pn * BM + wc * 32 + 8 * fq;
        f32x4 bv[2][2];
#pragma unroll
        for (int bj = 0; bj < 2; ++bj)
#pragma unroll
            for (int n = 0; n < 2; ++n) bv[bj][n] = bias ? *(const f32x4*)(bias + bcol0 + bj * HALF + 4 * n) : (f32x4){0.f, 0.f, 0.f, 0.f};
#pragma unroll
        for (int ai = 0; ai < 2; ++ai)
#pragma unroll
            for (int m = 0; m < 4; ++m) { bf16_t* rowp = base + (size_t)(row0 + ai * HALF + m * 16) * ldc + col0;
#pragma unroll
                for (int bj = 0; bj < 2; ++bj) { f32x4 v0 = acc[ai][bj][m][0] + bv[bj][0], v1 = acc[ai][bj][m][1] + bv[bj][1];
                    if (ACT == 1) { f32x2 a = gelu_pk((f32x2){v0[0], v0[1]}), b = gelu_pk((f32x2){v0[2], v0[3]}), c = gelu_pk((f32x2){v1[0], v1[1]}), d = gelu_pk((f32x2){v1[2], v1[3]});
                        v0 = (f32x4){a.x, a.y, b.x, b.y}; v1 = (f32x4){c.x, c.y, d.x, d.y}; }
                    v0 = v0 * sc; v1 = v1 * sc; u32x4 w; w.x = cvt_pk_bf16(v0[0], v0[1]); w.y = cvt_pk_bf16(v0[2], v0[3]); w.z = cvt_pk_bf16(v1[0], v1[1]); w.w = cvt_pk_bf16(v1[2], v1[3]);
                    *(u32x4*)(rowp + bj * HALF) = w; } }
    }
};


struct EpiF32 {
    static constexpr bool PERM = false, AFTER_DRAIN = false;
    float* C; int ldc; const float* resid;
    __device__ __forceinline__ void operator()(const f32x4 (&acc)[2][2][4][2], const Unit& u, int wr, int wc, int fr, int fq) const {
        const int row0 = u.pm * BM + wr * 64 + fr, col0 = u.pn * BM + wc * 32 + 4 * fq;
#pragma unroll
        for (int ai = 0; ai < 2; ++ai)
#pragma unroll
            for (int m = 0; m < 4; ++m) { const size_t rb = (size_t)(row0 + ai * HALF + m * 16) * ldc + col0;
#pragma unroll
                for (int bj = 0; bj < 2; ++bj)
#pragma unroll
                    for (int n = 0; n < 2; ++n) { const size_t ix = rb + bj * HALF + n * 16; f32x4 v = acc[ai][bj][m][n];
                        if (resid) v += *(const f32x4*)(resid + ix);
                        *(f32x4*)(C + ix) = v; } }
    }
};
struct EpiGlu {
    static constexpr bool PERM = true, AFTER_DRAIN = false;
    bf16_t* O; int ldc; const float* bias; const bf16_t* YG;
    __device__ __forceinline__ void operator()(const f32x4 (&acc)[2][2][4][2], const Unit& u, int wr, int wc, int fr, int fq) const {
        const int row0 = u.pm * BM + wr * 64 + fr, col0 = u.pn * BM + wc * 32 + 8 * fq;
#pragma unroll
        for (int ai = 0; ai < 2; ++ai)
#pragma unroll
            for (int m = 0; m < 4; ++m) { const size_t rb = (size_t)(row0 + ai * HALF + m * 16) * ldc + col0;
#pragma unroll
                for (int bj = 0; bj < 2; ++bj) { const size_t ix = rb + bj * HALF;
                    const f32x4 b0 = *(const f32x4*)(bias + col0 + bj * HALF), b1 = *(const f32x4*)(bias + col0 + bj * HALF + 4);
                    const u32x4 yw = *(const u32x4*)(YG + ix);
                    f32x4 v0 = acc[ai][bj][m][0] + b0, v1 = acc[ai][bj][m][1] + b1; float o[8];
#pragma unroll
                    for (int e = 0; e < 4; ++e) { const unsigned w = e == 0 ? yw.x : e == 1 ? yw.y : e == 2 ? yw.z : yw.w;
                        const float y0 = __uint_as_float(w << 16), y1 = __uint_as_float(w & 0xffff0000u);
                        const float a0 = e < 2 ? v0[2 * e] : v1[2 * e - 4], a1 = e < 2 ? v0[2 * e + 1] : v1[2 * e - 3];
                        o[2 * e] = y0 / (1.f + __expf(-a0)); o[2 * e + 1] = y1 / (1.f + __expf(-a1)); }
                    u32x4 w; w.x = cvt_pk_bf16(o[0], o[1]); w.y = cvt_pk_bf16(o[2], o[3]); w.z = cvt_pk_bf16(o[4], o[5]); w.w = cvt_pk_bf16(o[6], o[7]);
                    *(u32x4*)(O + ix) = w; } }
    }
};
template <class Epi, class Sched, bool ALIGN_EPI = false, bool SP2 = false>
__device__ __forceinline__ void gemm_phase(PG8_LAS unsigned char* lds, const Gemm g, const Sched& S, const Epi& E) {
    int tid_l = threadIdx.x; asm volatile("" : "+v"(tid_l));
    const int tid = tid_l, wid = __builtin_amdgcn_readfirstlane(tid >> 6), lane = tid & 63, wr = wid >> 2, wc = wid & 3, fr = lane & 15, fq = lane >> 4;
    const int K = g.K, nt = K / BK;
    unsigned voffA[2], voffB[2];
#pragma unroll
    for (int i = 0; i < 2; ++i) { int R, C; stage_rc(tid * 16 + i * 8192, R, C); const int Rb = Epi::PERM ? ((R & ~31) + perm32(R & 31)) : R;
        voffA[i] = (unsigned)(R * g.lda + C) * 2u; voffB[i] = (unsigned)(Rb * K + C) * 2u; }
    const size_t kstep = (size_t)(BK * 2);
    const size_t hsA = (size_t)HALF * g.lda * 2, hsB = (size_t)HALF * K * 2;
    const size_t tsA = 2 * hsA, tsB = 2 * hsB;
    const unsigned ldsw = (unsigned)wid * 1024u;
    const int aoff = lds_byte(wr * 64 + fr, fq * 8), boff = lds_byte(wc * 32 + fr, fq * 8);
#define PG8_SA(b, h) (((b) * 2 + (h)) * HTB)
#define PG8_SB(b, h) ((4 + (b) * 2 + (h)) * HTB)
#define PG8_STAGE(bufoff, gbase, voff) do { _Pragma("unroll") for (int _i = 0; _i < 2; ++_i) \
        __builtin_amdgcn_global_load_lds((const unsigned*)((const char*)(gbase) + (voff)[_i]), (PG8_LAS unsigned*)(lds + (bufoff) + ldsw + _i * 8192), 16, 0, 0); } while (0)
#define PG8_LDA(dst, b, h) do { _Pragma("unroll") for (int m = 0; m < 4; ++m) _Pragma("unroll") for (int k = 0; k < 2; ++k) dst[m][k] = *(const PG8_LAS bf16x8*)(lds + PG8_SA(b, h) + aoff + m * 2048 + k * 1024); } while (0)
#define PG8_LDB(dst, b, h) do { _Pragma("unroll") for (int n = 0; n < 2; ++n) _Pragma("unroll") for (int k = 0; k < 2; ++k) dst[n][k] = *(const PG8_LAS bf16x8*)(lds + PG8_SB(b, h) + boff + n * 2048 + k * 1024); } while (0)
#define PG8_MMA(ai, bj, At, Bt) do { __builtin_amdgcn_s_setprio(1); _Pragma("unroll") for (int m = 0; m < 4; ++m) _Pragma("unroll") for (int n = 0; n < 2; ++n) _Pragma("unroll") for (int k = 0; k < 2; ++k) \
        acc[ai][bj][m][n] = __builtin_amdgcn_mfma_f32_16x16x32_bf16(Bt[n][k], At[m][k], acc[ai][bj][m][n], 0, 0, 0); __builtin_amdgcn_s_setprio(0); } while (0)
#define PG8_WAIT_V(n) asm volatile("s_waitcnt vmcnt(" #n ")" ::: "memory")
#define PG8_WAIT_L(n) asm volatile("s_waitcnt lgkmcnt(" #n ")" ::: "memory")
#define PG8_BAR __builtin_amdgcn_s_barrier()
#define PG8_SCHED __builtin_amdgcn_sched_barrier(0)
    Unit cur, nxt; int ui = 0;
    if (!S.next(0, cur)) return;
    f32x4 acc[2][2][4][2];
#pragma unroll
    for (int a = 0; a < 2; ++a)
#pragma unroll
        for (int b = 0; b < 2; ++b)
#pragma unroll
            for (int m = 0; m < 4; ++m)
#pragma unroll
                for (int n = 0; n < 2; ++n) acc[a][b][m][n] = (f32x4){0.f, 0.f, 0.f, 0.f};
    bf16x8 At[4][2], B0[2][2], B1[2][2];
    const char* cA = (const char*)g.A + (size_t)cur.pm * tsA; const char* cB = (const char*)g.Bt + (size_t)cur.pn * tsB;
    S.a_ready(cur);
    if constexpr (SP2) {
        PG8_STAGE(PG8_SB(0, 0), cB, voffB); PG8_STAGE(PG8_SB(0, 1), cB + hsB, voffB); PG8_STAGE(PG8_SA(0, 0), cA, voffA); PG8_STAGE(PG8_SA(0, 1), cA + hsA, voffA);
        if (wr == 1) PG8_BAR;
        PG8_WAIT_V(2); PG8_BAR;
        PG8_STAGE(PG8_SB(1, 0), cB + kstep, voffB); PG8_STAGE(PG8_SA(1, 0), cA + kstep, voffA); PG8_STAGE(PG8_SB(1, 1), cB + hsB + kstep, voffB);
        PG8_WAIT_V(6); PG8_BAR;
    } else {
        PG8_STAGE(PG8_SB(0, 0), cB, voffB); PG8_STAGE(PG8_SA(0, 0), cA, voffA); PG8_STAGE(PG8_SB(0, 1), cB + hsB, voffB); PG8_STAGE(PG8_SA(0, 1), cA + hsA, voffA);
        if (wr == 1) PG8_BAR;
        PG8_WAIT_V(4); PG8_BAR;
        PG8_STAGE(PG8_SB(1, 0), cB + kstep, voffB); PG8_STAGE(PG8_SA(1, 0), cA + kstep, voffA); PG8_STAGE(PG8_SB(1, 1), cB + hsB + kstep, voffB);
        PG8_WAIT_V(6); PG8_BAR;
    }
    for (;;) {
        const bool has_next = S.next(ui + 1, nxt);
        const char* nA = has_next ? (const char*)g.A + (size_t)nxt.pm * tsA : cA; const char* nB = has_next ? (const char*)g.Bt + (size_t)nxt.pn * tsB : cB;
        for (int t = 0; t < nt; t += 2) {
            const bool last = (t == nt - 2);
            const char* a1 = cA + (size_t)(t + 1) * kstep;
            const char* a2 = last ? nA : cA + (size_t)(t + 2) * kstep; const char* b2 = last ? nB : cB + (size_t)(t + 2) * kstep;
            const char* a3 = a2 + kstep; const char* b3 = b2 + kstep;
            if (last && has_next) S.a_ready(nxt);
            if constexpr (SP2) {
            PG8_LDB(B0, 0, 0); PG8_LDB(B1, 0, 1); PG8_SCHED; PG8_LDA(At, 0, 0); PG8_STAGE(PG8_SA(1, 1), a1 + hsA, voffA);
            PG8_WAIT_V(8); PG8_WAIT_L(0); PG8_BAR; PG8_MMA(0, 0, At, B0); PG8_MMA(0, 1, At, B1); PG8_BAR; PG8_SCHED;
            PG8_LDA(At, 0, 1); PG8_STAGE(PG8_SB(0, 0), b2, voffB); PG8_STAGE(PG8_SB(0, 1), b2 + hsB, voffB); PG8_STAGE(PG8_SA(0, 0), a2, voffA);
            PG8_WAIT_V(8); PG8_WAIT_L(0); PG8_BAR; PG8_MMA(1, 0, At, B0); PG8_MMA(1, 1, At, B1); PG8_BAR; PG8_SCHED;
            PG8_LDB(B0, 1, 0); PG8_LDB(B1, 1, 1); PG8_SCHED; PG8_LDA(At, 1, 0); PG8_STAGE(PG8_SA(0, 1), a2 + hsA, voffA);
            PG8_WAIT_V(8); PG8_WAIT_L(0); PG8_BAR; PG8_MMA(0, 0, At, B0); PG8_MMA(0, 1, At, B1); PG8_BAR; PG8_SCHED;
            PG8_LDA(At, 1, 1); PG8_STAGE(PG8_SB(1, 0), b3, voffB); PG8_STAGE(PG8_SB(1, 1), b3 + hsB, voffB); PG8_STAGE(PG8_SA(1, 0), a3, voffA);
            PG8_WAIT_V(8); PG8_WAIT_L(0); PG8_BAR; PG8_MMA(1, 0, At, B0); PG8_MMA(1, 1, At, B1); PG8_BAR; PG8_SCHED;
            } else {
            PG8_LDB(B0, 0, 0); PG8_SCHED; PG8_LDA(At, 0, 0); PG8_STAGE(PG8_SA(1, 1), a1 + hsA, voffA);
            PG8_WAIT_L(8); PG8_BAR; PG8_WAIT_L(0); PG8_MMA(0, 0, At, B0); PG8_BAR; PG8_SCHED;
            PG8_LDB(B1, 0, 1); PG8_STAGE(PG8_SB(0, 0), b2, voffB);
            PG8_BAR; PG8_WAIT_L(0); PG8_MMA(0, 1, At, B1); PG8_BAR;
            PG8_LDA(At, 0, 1); PG8_STAGE(PG8_SA(0, 0), a2, voffA);
            PG8_BAR; PG8_WAIT_L(0); PG8_MMA(1, 0, At, B0); PG8_BAR; PG8_SCHED;
            PG8_STAGE(PG8_SB(0, 1), b2 + hsB, voffB);
            PG8_WAIT_V(6); PG8_BAR; PG8_MMA(1, 1, At, B1); PG8_BAR;
            PG8_LDB(B0, 1, 0); PG8_SCHED; PG8_LDA(At, 1, 0); PG8_STAGE(PG8_SA(0, 1), a2 + hsA, voffA);
            PG8_WAIT_L(8); PG8_BAR; PG8_WAIT_L(0); PG8_MMA(0, 0, At, B0); PG8_BAR; PG8_SCHED;
            PG8_LDB(B1, 1, 1); PG8_STAGE(PG8_SB(1, 0), b3, voffB);
            PG8_BAR; PG8_WAIT_L(0); PG8_MMA(0, 1, At, B1); PG8_BAR;
            PG8_LDA(At, 1, 1); PG8_STAGE(PG8_SA(1, 0), a3, voffA);
            PG8_BAR; PG8_WAIT_L(0); PG8_MMA(1, 0, At, B0); PG8_BAR; PG8_SCHED;
            PG8_STAGE(PG8_SB(1, 1), b3 + hsB, voffB);
            PG8_WAIT_V(6); PG8_BAR; PG8_MMA(1, 1, At, B1); PG8_BAR;
            }
        }
        if constexpr (ALIGN_EPI) { if (wr == 0) PG8_BAR; }
        if constexpr (!Epi::AFTER_DRAIN) { E(acc, cur, wr, wc, fr, fq); S.done(cur); }
        if (!has_next) break;
#pragma unroll
        for (int a = 0; a < 2; ++a)
#pragma unroll
            for (int b = 0; b < 2; ++b)
#pragma unroll
                for (int m = 0; m < 4; ++m)
#pragma unroll
                    for (int n = 0; n < 2; ++n) acc[a][b][m][n] = (f32x4){0.f, 0.f, 0.f, 0.f};
        cur = nxt; cA = nA; cB = nB; ++ui;
        if constexpr (ALIGN_EPI) { if (wr == 1) PG8_BAR; }
    }
    PG8_WAIT_V(0);
    if constexpr (!ALIGN_EPI) { if (wr == 0) PG8_BAR; }
    PG8_BAR;
    if constexpr (Epi::AFTER_DRAIN) { E.fused(acc, cur, wr, wc, fr, fq, lds, wid, lane); S.done(cur); }
#undef PG8_SA
#undef PG8_SB
#undef PG8_STAGE
#undef PG8_LDA
#undef PG8_LDB
#undef PG8_MMA
#undef PG8_WAIT_V
#undef PG8_WAIT_L
#undef PG8_BAR
#undef PG8_SCHED
}
}
#define GAS __attribute__((address_space(1)))
#define LAS __attribute__((address_space(3)))
#define XB_TMO      128
#define XB_XCNT(j)  (256  + 64 * (j))
#define XB_XSUB(j)  (1280 + 64 * (j))
#define XB_XGEN(j)  (2304 + 64 * (j))
#define XB_TOP      3328
#define XB_TOPGEN   3392
#define XCD_BAR_WORDS 3456
#define XB_SPIN_CAP (1u << 25)
__device__ __forceinline__ unsigned xb_ld(unsigned* p)              { return __hip_atomic_load(p, __ATOMIC_RELAXED, __HIP_MEMORY_SCOPE_AGENT); }
__device__ __forceinline__ unsigned xb_add(unsigned* p, unsigned v) { return __hip_atomic_fetch_add(p, v, __ATOMIC_RELAXED, __HIP_MEMORY_SCOPE_AGENT); }
__device__ __forceinline__ unsigned xb_xcc_id() { return (unsigned)__builtin_amdgcn_s_getreg((3 << 11) | 20) & 0xFu; }
#define XB_SPIN(cond, bar) do { unsigned _sp = 0; while (cond) { __builtin_amdgcn_s_sleep(1); \
    if ((++_sp & 255u) == 0u) { if (xb_ld(&(bar)[XB_TMO])) break; if (_sp > XB_SPIN_CAP) { atomicAdd(&(bar)[XB_TMO], 1u); break; } } } } while (0)
struct XcdBarrier { unsigned* bar; unsigned x; volatile LAS unsigned* st; };
__device__ __forceinline__ XcdBarrier xcd_barrier_post(unsigned* bar, volatile LAS unsigned* st) {
    XcdBarrier b; b.bar = bar; b.x = xb_xcc_id(); b.st = st;
    if (threadIdx.x == 0) (void)xb_add(&bar[XB_XCNT(b.x)], 1u);
    return b;
}
__device__ __forceinline__ void xcd_barrier_complete(unsigned* bar, unsigned x, unsigned& nloc, unsigned& nx) {
    const unsigned G = gridDim.x * gridDim.y * gridDim.z;
    unsigned sum, cnt, mine, sp = 0u;
    for (;;) {
        sum = 0u; cnt = 0u; mine = 0u;
#pragma unroll
        for (unsigned j = 0; j < 16; ++j) { const unsigned c = xb_ld(&bar[XB_XCNT(j)]); sum += c; cnt += (c > 0u) ? 1u : 0u; mine = (j == x) ? c : mine; }
        if (sum == G) break;
        __builtin_amdgcn_s_sleep(1);
        if ((++sp & 255u) == 0u) { if (xb_ld(&bar[XB_TMO])) break; if (sp > XB_SPIN_CAP) { atomicAdd(&bar[XB_TMO], 1u); break; } }
    }
    nloc = mine > 0u ? mine : 1u; nx = cnt > 0u ? cnt : 1u;
}
__device__ __forceinline__ void xcd_barrier(const XcdBarrier& b) {
    asm volatile("s_waitcnt vmcnt(0)" ::: "memory");
    __syncthreads();
    if (threadIdx.x == 0) {
        unsigned* bar = b.bar;
        __builtin_amdgcn_s_waitcnt(0);
        unsigned nloc = b.st[0], nx = b.st[1];
        if (nloc == 0u) { xcd_barrier_complete(bar, b.x, nloc, nx); b.st[0] = nloc; b.st[1] = nx; }
        const unsigned old = xb_add(&bar[XB_XSUB(b.x)], 1u);
        const unsigned gen = old / nloc;
        if (old + 1u == (gen + 1u) * nloc) {
            __builtin_amdgcn_fence(__ATOMIC_RELEASE, "agent");
            asm volatile("s_waitcnt vmcnt(0)" ::: "memory");
            const unsigned og = xb_add(&bar[XB_TOP], 1u);
            const unsigned tg = og / nx;
            if (og + 1u == (tg + 1u) * nx) xb_add(&bar[XB_TOPGEN], 1u);
            else XB_SPIN(xb_ld(&bar[XB_TOPGEN]) == tg, bar);
            __builtin_amdgcn_fence(__ATOMIC_ACQUIRE, "agent");
            xb_add(&bar[XB_XGEN(b.x)], 1u);
            asm volatile("s_waitcnt vmcnt(0)" ::: "memory");
        } else {
            XB_SPIN(xb_ld(&bar[XB_XGEN(b.x)]) == gen, bar);
            __builtin_amdgcn_fence(__ATOMIC_ACQUIRE, "agent");
            asm volatile("s_waitcnt vmcnt(0)" ::: "memory");
        }
    }
    __syncthreads();
}
namespace s5f {
typedef short bf16x8 __attribute__((ext_vector_type(8)));
typedef float f32x4 __attribute__((ext_vector_type(4)));
typedef unsigned u32x2 __attribute__((ext_vector_type(2)));
constexpr int LC = 32, NCH = SEQ / LC, RS = 272, WBYTES = LC * RS;
__device__ __forceinline__ void build_tables(const float* a_re, const float* a_im, const float* log_dt, const float* b_re, const float* b_im, const float* c_re, const float* c_im,
                                             bf16* S5A, bf16* S5C, float2* S5L, int gt, int ngt) {
    for (int i = gt; i < 16 * 64; i += ngt) {
        const int g = i >> 6;
        const float are = a_re[i], aim = a_im[i], dt = expf(log_dt[g]);
        const float mag = expf(are * dt); float sn, cs; sincos_acc(aim * dt, sn, cs);
        const float lre = mag * cs, lim = mag * sn;
        const float xr = lre - 1.f, xi = lim, den = are * are + aim * aim;
        const float cr = (xr * are + xi * aim) / den, ci = (xi * are - xr * aim) / den;
        S5L[i] = make_float2(lre, lim);
        const int p = i & 63;
        for (int k = 0; k < 16; ++k) { const float br = b_re[i * 16 + k], bi = b_im[i * 16 + k];
            S5A[((size_t)g * 128 + 2 * p) * 16 + k] = f2bf(cr * br - ci * bi); S5A[((size_t)g * 128 + 2 * p + 1) * 16 + k] = f2bf(cr * bi + ci * br);
            S5C[((size_t)g * 16 + k) * 128 + 2 * p] = f2bf(c_re[(g * 16 + k) * 64 + p]); S5C[((size_t)g * 16 + k) * 128 + 2 * p + 1] = f2bf(-c_im[(g * 16 + k) * 64 + p]); }
    }
}
template <bool FULL> __device__ __forceinline__ void chunk(LAS unsigned char* wl, const bf16* Z, const bf16x8 (&afr)[8], const bf16x8 (&cfr)[4], float lre, float lim, float& hre, float& him,
                                                           int b, int ch, int g, int lane, const float* dsk, bf16* YG) {
    const int l15 = lane & 15, q4 = lane >> 4;
    const size_t t0 = (size_t)b * SEQ + (size_t)ch * LC;
#pragma unroll
    for (int nb = 0; nb < 2; ++nb) {
        bf16x8 ufr = bf16x8{};
        if (q4 < 2) ufr = *(const bf16x8*)(Z + (t0 + 16 * nb + l15) * ZW + ZC_U + g * 16 + 8 * q4);
#pragma unroll
        for (int mb = 0; mb < 8; ++mb) {
            f32x4 d = __builtin_amdgcn_mfma_f32_16x16x32_bf16(afr[mb], ufr, f32x4{0.f, 0.f, 0.f, 0.f}, 0, 0, 0);
            *(LAS u32x2*)(wl + (16 * nb + l15) * RS + (16 * mb + 4 * q4) * 2) = u32x2{pk2(d[0], d[1]), pk2(d[2], d[3])};
        }
    }
#pragma unroll 8
    for (int k = 0; k < LC; ++k) {
        LAS unsigned* wp = (LAS unsigned*)(wl + k * RS + 4 * lane);
        const unsigned w = *wp; const float bre = __uint_as_float(w << 16), bim = __uint_as_float(w & 0xffff0000u);
        const float nre = fmaf(lre, hre, fmaf(-lim, him, bre)), nim = fmaf(lre, him, fmaf(lim, hre, bim)); hre = nre; him = nim;
        if (FULL) *wp = pk2(hre, him);
    }
    if (FULL) {
#pragma unroll
        for (int nb = 0; nb < 2; ++nb) {
            f32x4 y = f32x4{0.f, 0.f, 0.f, 0.f};
#pragma unroll
            for (int ks = 0; ks < 4; ++ks) {
                const bf16x8 hfr = *(const LAS bf16x8*)(wl + (16 * nb + l15) * RS + (32 * ks + 8 * q4) * 2);
                y = __builtin_amdgcn_mfma_f32_16x16x32_bf16(cfr[ks], hfr, y, 0, 0, 0);
            }
            const size_t t = t0 + 16 * nb + l15; const int co = 4 * q4;
            const uint2 uw = *(const uint2*)(Z + t * ZW + ZC_U + g * 16 + co);
            const float4 dd = *(const float4*)(dsk + g * 16 + co);
            const float y0 = y[0] + dd.x * __uint_as_float(uw.x << 16), y1 = y[1] + dd.y * __uint_as_float(uw.x & 0xffff0000u),
                        y2 = y[2] + dd.z * __uint_as_float(uw.y << 16), y3 = y[3] + dd.w * __uint_as_float(uw.y & 0xffff0000u);
            *(uint2*)(YG + t * 256 + g * 16 + co) = make_uint2(pk2(gelu_f(y0), gelu_f(y1)), pk2(gelu_f(y2), gelu_f(y3)));
        }
    }
}
template <bool FULL> __device__ __forceinline__ void pass(LAS unsigned char* lds, const bf16* Z, const bf16* S5A, const bf16* S5C, const float2* S5L, const float* dsk,
                                                          float2* SE, const float2* SH, bf16* YG, int gw, int ngw, int wave, int lane) {
    LAS unsigned char* wl = lds + wave * WBYTES;
    const int g = gw & 15, l15 = lane & 15, q4 = lane >> 4;
    bf16x8 afr[8], cfr[4];
#pragma unroll
    for (int mb = 0; mb < 8; ++mb) { afr[mb] = bf16x8{}; if (q4 < 2) afr[mb] = *(const bf16x8*)(S5A + ((size_t)g * 128 + 16 * mb + l15) * 16 + 8 * q4); }
#pragma unroll
    for (int ks = 0; ks < 4; ++ks) { cfr[ks] = bf16x8{}; if (FULL) cfr[ks] = *(const bf16x8*)(S5C + ((size_t)g * 16 + l15) * 128 + 32 * ks + 8 * q4); }
    const float2 lam = S5L[g * 64 + lane];
    for (int it = gw >> 4; it < NB * NCH; it += ngw >> 4) {
        const int b = it / NCH, ch = it % NCH;
        float hre = 0.f, him = 0.f;
        if (FULL) { const float2 h0 = SH[((size_t)it * 16 + g) * 64 + lane]; hre = h0.x; him = h0.y; }
        chunk<FULL>(wl, Z, afr, cfr, lam.x, lam.y, hre, him, b, ch, g, lane, dsk, YG);
        if (!FULL) SE[((size_t)it * 16 + g) * 64 + lane] = make_float2(hre, him);
    }
}
__device__ __forceinline__ void carry(const float2* S5L, const float2* SE, float2* SH, int gw, int ngw, int lane) {
    for (int item = gw; item < NB * 16; item += ngw) {
        const int b = item >> 4, g = item & 15;
        float2 lam = S5L[g * 64 + lane];
#pragma unroll
        for (int i = 0; i < 5; ++i) { const float re = lam.x * lam.x - lam.y * lam.y, im = 2.f * lam.x * lam.y; lam.x = re; lam.y = im; }
        float hre = 0.f, him = 0.f;
#pragma unroll 8
        for (int c = 0; c < NCH; ++c) { const size_t ix = (((size_t)b * NCH + c) * 16 + g) * 64 + lane;
            SH[ix] = make_float2(hre, him);
            const float2 e = SE[ix];
            const float nre = lam.x * hre - lam.y * him + e.x, nim = lam.x * him + lam.y * hre + e.y; hre = nre; him = nim; }
    }
}
}
namespace lruf {
typedef float f32x4 __attribute__((ext_vector_type(4)));
constexpr int LC = 32, NCH = SEQ / LC, XS = 68;
__device__ __forceinline__ void pass_a(LAS unsigned char* lds, const bf16* Z, const float* cw, const float* cb, const float* wa, const float* ba, const float* wx, const float* bx, const float* lam,
                                       float* AA, float* BT, float2* LPE, int gw, int ngw, int wave, int lane) {
    LAS float* xt = (LAS float*)lds + wave * (LC * XS);
    for (int item = gw; item < NB * NCH * 4; item += ngw) {
        const int h = item & 3, bc = item >> 2, b = bc / NCH, ch = bc % NCH, c = h * 64 + lane;
        const size_t t0 = (size_t)b * SEQ + (size_t)ch * LC;
        const float w0 = cw[c], w1 = cw[256 + c], w2 = cw[512 + c], w3 = cw[768 + c], bias = cb[c];
        float z0 = 0.f, z1 = 0.f, z2 = 0.f;
        if (ch > 0) { z0 = bf2f(Z[(t0 - 3) * ZW + ZC_X + c]); z1 = bf2f(Z[(t0 - 2) * ZW + ZC_X + c]); z2 = bf2f(Z[(t0 - 1) * ZW + ZC_X + c]); }
        float xc[LC];
#pragma unroll
        for (int k = 0; k < LC; ++k) { const float z3 = bf2f(Z[(t0 + k) * ZW + ZC_X + c]); xc[k] = bias + w0 * z0 + w1 * z1 + w2 * z2 + w3 * z3; z0 = z1; z1 = z2; z2 = z3; xt[k * XS + lane] = xc[k]; }
        float ra[LC], rx[LC];
        { const float b0 = ba[c], b1 = bx[c];
#pragma unroll
          for (int k = 0; k < LC; ++k) { ra[k] = b0; rx[k] = b1; } }
        const float* wap = wa + (size_t)h * 4096 + lane; const float* wxp = wx + (size_t)h * 4096 + lane;
        for (int i = 0; i < 64; i += 4) {
            const float a0 = wap[(i + 0) * 64], a1 = wap[(i + 1) * 64], a2 = wap[(i + 2) * 64], a3 = wap[(i + 3) * 64];
            const float x0 = wxp[(i + 0) * 64], x1 = wxp[(i + 1) * 64], x2 = wxp[(i + 2) * 64], x3 = wxp[(i + 3) * 64];
#pragma unroll
            for (int k = 0; k < LC; ++k) { const f32x4 v = *(const LAS f32x4*)(xt + k * XS + i);
                ra[k] += v.x * a0 + v.y * a1 + v.z * a2 + v.w * a3; rx[k] += v.x * x0 + v.y * x1 + v.z * x2 + v.w * x3; }
        }
        const float lsg8 = -8.f * log1pf(expf(-lam[c]));
        float hloc = 0.f, prod = 1.f;
#pragma unroll
        for (int k = 0; k < LC; ++k) {
            const float r = sigmoid_f(ra[k]), ig = sigmoid_f(rx[k]);
            const float la = r * lsg8, av = expf(la), bt = sqrtf(-expm1f(2.f * la)) * (ig * xc[k]);
            AA[(t0 + k) * 256 + c] = av; BT[(t0 + k) * 256 + c] = bt;
            hloc = av * hloc + bt; prod *= av;
        }
        LPE[(size_t)bc * 256 + c] = make_float2(prod, hloc);
    }
}
__device__ __forceinline__ void carry(const float2* LPE, float* LH, int gt, int ngt) {
    for (int i = gt; i < NB * 256; i += ngt) { const int b = i >> 8, c = i & 255;
        float h = 0.f;
#pragma unroll 8
        for (int ch = 0; ch < NCH; ++ch) { const size_t ix = ((size_t)b * NCH + ch) * 256 + c; LH[ix] = h; const float2 pe = LPE[ix]; h = pe.x * h + pe.y; } }
}
__device__ __forceinline__ void pass_b(const float* AA, const float* BT, const float* LH, const bf16* Z, bf16* ROUT, int gt, int ngt) {
    for (int i = gt; i < NB * NCH * 256; i += ngt) { const int c = i & 255, bc = i >> 8; const size_t t0 = (size_t)bc * LC;
        float h = LH[i];
#pragma unroll 8
        for (int k = 0; k < LC; ++k) { const size_t t = t0 + k;
            h = AA[t * 256 + c] * h + BT[t * 256 + c];
            ROUT[t * 256 + c] = f2bf(h * gelu_f(bf2f(Z[t * ZW + ZC_G + c]))); } }
}
}
namespace tk {
typedef short bf16x8 __attribute__((ext_vector_type(8)));
typedef float f32x4 __attribute__((ext_vector_type(4)));
__device__ const unsigned char PAIR_TAB[64] = {
    0x00,0x01,0x02,0x03,0x04,0x05,0x06,0x07,0x08,0x09,0x0a,0x0b,0x0c,0x0d,0x0e,0x0f, 0x10,0x11,0x12,0x13,0x14,0x15,0x16,0x17, 0x20,0x21,0x22,0x23,0x24, 0x30,0x31,0x32,0x33,
    0x40,0x41,0x42, 0x50,0x51, 0x60,0x61, 0x70,0x71, 0x80,0x90,0xa0,0xb0,0xc0,0xd0,0xe0,0xf0, 0,0,0,0,0,0,0,0,0,0,0,0,0,0};
template <int CTRL> __device__ __forceinline__ float dppf(float v) { return __builtin_bit_cast(float, __builtin_amdgcn_update_dpp(0, __builtin_bit_cast(int, v), CTRL, 0xf, 0xf, true)); }
__device__ __forceinline__ float rmax16(float v) { v = fmaxf(v, dppf<0xB1>(v)); v = fmaxf(v, dppf<0x4E>(v)); v = fmaxf(v, dppf<0x141>(v)); v = fmaxf(v, dppf<0x140>(v)); return v; }
__device__ __forceinline__ float rsum16(float v) { v += dppf<0xB1>(v); v += dppf<0x4E>(v); v += dppf<0x141>(v); v += dppf<0x140>(v); return v; }
#define TK_CX(a, b) do { const float hi_ = fmaxf(a, b), lo_ = fminf(a, b); a = hi_; b = lo_; } while (0)
__device__ __forceinline__ float packkey(float v, unsigned id, unsigned mask) { return __uint_as_float((__float_as_uint(v) & ~mask) | id); }
__device__ __forceinline__ void select16(float (&k)[4][8], float (&top)[4], int l15) {
    const float NEG = -__builtin_inff();
#pragma unroll
    for (int r = 0; r < 4; ++r) {
        TK_CX(k[r][0], k[r][1]); TK_CX(k[r][2], k[r][3]); TK_CX(k[r][4], k[r][5]); TK_CX(k[r][6], k[r][7]);
        TK_CX(k[r][0], k[r][2]); TK_CX(k[r][1], k[r][3]); TK_CX(k[r][4], k[r][6]); TK_CX(k[r][5], k[r][7]);
        TK_CX(k[r][1], k[r][2]); TK_CX(k[r][5], k[r][6]);
        TK_CX(k[r][0], k[r][4]); TK_CX(k[r][1], k[r][5]); TK_CX(k[r][2], k[r][6]); TK_CX(k[r][3], k[r][7]);
        TK_CX(k[r][2], k[r][4]); TK_CX(k[r][3], k[r][5]);
        TK_CX(k[r][1], k[r][2]); TK_CX(k[r][3], k[r][4]); TK_CX(k[r][5], k[r][6]);
        top[r] = NEG;
    }
#pragma unroll
    for (int i = 0; i < 16; ++i)
#pragma unroll
        for (int r = 0; r < 4; ++r) {
            const float w = rmax16(k[r][0]);
            if (l15 == i) top[r] = w;
            if (k[r][0] == w) {
#pragma unroll
                for (int e = 0; e < 7; ++e) k[r][e] = k[r][e + 1];
                k[r][7] = NEG; }
        }
}
__device__ __forceinline__ void topk_phase(const bf16* QP, const bf16* SUBKB, int* IDX, float* GATE, int gw, int ngw, int lane) {
    const float NEG = -__builtin_inff();
    const int l15 = lane & 15, q4 = lane >> 4, gbase = 16 * q4;
    unsigned pcs[4];
#pragma unroll
    for (int j = 0; j < 4; ++j) pcs[j] = PAIR_TAB[l15 + 16 * j];
    for (int item = gw; item < T * 8 / 16; item += ngw) {
        const size_t R0 = (size_t)item * 16;
        const bf16* qrow = QP + (R0 + l15) * 256 + 8 * q4;
        float topA[4], topB[4];
#pragma unroll
        for (int p = 0; p < 2; ++p) {
            f32x4 acc[8];
#pragma unroll
            for (int nb = 0; nb < 8; ++nb) acc[nb] = f32x4{0.f, 0.f, 0.f, 0.f};
#pragma unroll 1
            for (int ks = 0; ks < 4; ++ks) {
                const bf16x8 afr = *(const bf16x8*)(qrow + p * 128 + 32 * ks);
#pragma unroll
                for (int nb = 0; nb < 8; ++nb) {
                    const bf16x8 bfr = *(const bf16x8*)(SUBKB + ((size_t)(p * 128 + 16 * nb + l15) * 128 + 32 * ks + 8 * q4));
                    acc[nb] = __builtin_amdgcn_mfma_f32_16x16x32_bf16(afr, bfr, acc[nb], 0, 0, 0);
                }
            }
            float k[4][8];
#pragma unroll
            for (int r = 0; r < 4; ++r)
#pragma unroll
                for (int nb = 0; nb < 8; ++nb) k[r][nb] = packkey(acc[nb][r], (unsigned)(16 * nb + l15), 127u);
            if (p == 0) select16(k, topA, l15); else select16(k, topB, l15);
        }
        float c[4][4];
#pragma unroll
        for (int r = 0; r < 4; ++r) {
#pragma unroll
            for (int j = 0; j < 4; ++j) {
                const float s0 = __shfl(topA[r], gbase + (int)(pcs[j] >> 4)), s1 = __shfl(topB[r], gbase + (int)(pcs[j] & 15));
                c[r][j] = (l15 + 16 * j < 50) ? packkey(s0 + s1, (unsigned)(l15 + 16 * j), 63u) : NEG;
            }
            TK_CX(c[r][0], c[r][1]); TK_CX(c[r][2], c[r][3]); TK_CX(c[r][0], c[r][2]); TK_CX(c[r][1], c[r][3]); TK_CX(c[r][1], c[r][2]);
        }
        float win[4], w0[4];
#pragma unroll
        for (int r = 0; r < 4; ++r) { win[r] = NEG; w0[r] = 0.f; }
#pragma unroll
        for (int i = 0; i < 16; ++i)
#pragma unroll
            for (int r = 0; r < 4; ++r) {
                const float w = rmax16(c[r][0]);
                if (i == 0) w0[r] = w;
                if (l15 == i) win[r] = w;
                if (c[r][0] == w) { c[r][0] = c[r][1]; c[r][1] = c[r][2]; c[r][2] = c[r][3]; c[r][3] = NEG; }
            }
#pragma unroll
        for (int r = 0; r < 4; ++r) {
            const unsigned pcw = PAIR_TAB[__float_as_uint(win[r]) & 63u];
            const int i0 = (int)(__float_as_uint(__shfl(topA[r], gbase + (int)(pcw >> 4))) & 127u), i1 = (int)(__float_as_uint(__shfl(topB[r], gbase + (int)(pcw & 15))) & 127u);
            const float e = __expf(win[r] - w0[r]); const float sum = rsum16(e);
            const size_t row = R0 + 4 * q4 + r;
            IDX[row * 16 + l15] = i0 * 128 + i1; GATE[row * 16 + l15] = e / sum;
        }
    }
}
#undef TK_CX
}
namespace pgf {
typedef float f32x2 __attribute__((ext_vector_type(2)));
typedef unsigned u32x4 __attribute__((ext_vector_type(4)));
constexpr float USCALE = 64.f, VSCALE = 4.f;
__device__ __forceinline__ unsigned pack4_fp8(float a, float b, float c, float d) {
    int w = __builtin_amdgcn_cvt_pk_fp8_f32(a, b, 0, false); w = __builtin_amdgcn_cvt_pk_fp8_f32(c, d, w, true); return (unsigned)w; }
__device__ __forceinline__ void unpack16(const u32x4 w, float* o) {
#pragma unroll
    for (int d = 0; d < 4; ++d) { const f32x2 lo = __builtin_amdgcn_cvt_pk_f32_fp8((int)w[d], false), hi = __builtin_amdgcn_cvt_pk_f32_fp8((int)w[d], true);
        o[4 * d] = lo.x; o[4 * d + 1] = lo.y; o[4 * d + 2] = hi.x; o[4 * d + 3] = hi.y; }
}
__device__ __forceinline__ void convert(const float* in, unsigned char* out8, size_t n, float scale, int gt, int ngt) {
    const size_t n16 = n / 16;
    for (size_t i = gt; i < n16; i += ngt) {
        const float4* p = (const float4*)(in + i * 16);
        const float4 a = p[0], b = p[1], c = p[2], d = p[3];
        u32x4 w; w.x = pack4_fp8(a.x * scale, a.y * scale, a.z * scale, a.w * scale); w.y = pack4_fp8(b.x * scale, b.y * scale, b.z * scale, b.w * scale);
        w.z = pack4_fp8(c.x * scale, c.y * scale, c.z * scale, c.w * scale); w.w = pack4_fp8(d.x * scale, d.y * scale, d.z * scale, d.w * scale);
        *(u32x4*)(out8 + i * 16) = w;
    }
}
__device__ __forceinline__ void gather(const bf16* HN, const int* IDX, const float* GATE, const unsigned char* PU8, const unsigned char* PV8, float* X, int gw, int ngw, int lane) {
    for (int t = gw; t < T; t += ngw) {
        float hn[16]; unpack8(*(const uint4*)(HN + (size_t)t * DM + 16 * lane), hn); unpack8(*(const uint4*)(HN + (size_t)t * DM + 16 * lane + 8), hn + 8);
        const int id0 = IDX[(size_t)t * 128 + lane], id1 = IDX[(size_t)t * 128 + 64 + lane];
        const float g0 = GATE[(size_t)t * 128 + lane], g1 = GATE[(size_t)t * 128 + 64 + lane];
        float y[16];
#pragma unroll
        for (int e = 0; e < 16; ++e) y[e] = 0.f;
        for (int kb = 0; kb < 128; kb += 4) {
            int eid[4]; float gt4[4]; u32x4 uw[4], vw[4];
#pragma unroll
            for (int q = 0; q < 4; ++q) { const int k = kb + q;
                eid[q] = __builtin_amdgcn_readlane(k < 64 ? id0 : id1, k & 63); gt4[q] = __builtin_bit_cast(float, __builtin_amdgcn_readlane(__builtin_bit_cast(int, k < 64 ? g0 : g1), k & 63)); }
#pragma unroll
            for (int q = 0; q < 4; ++q) { uw[q] = *(const u32x4*)(PU8 + (size_t)eid[q] * DM + 16 * lane); vw[q] = *(const u32x4*)(PV8 + (size_t)eid[q] * DM + 16 * lane); }
#pragma unroll
            for (int q = 0; q < 4; ++q) {
                float u[16]; unpack16(uw[q], u);
                float d0 = 0.f, d1 = 0.f;
#pragma unroll
                for (int e = 0; e < 16; e += 2) { d0 = fmaf(u[e], hn[e], d0); d1 = fmaf(u[e + 1], hn[e + 1], d1); }
                const float d = wave_sum(d0 + d1) * (1.f / USCALE);
                const float w = gt4[q] * gelu_f(d) * (1.f / VSCALE);
                float v[16]; unpack16(vw[q], v);
#pragma unroll
                for (int e = 0; e < 16; ++e) y[e] = fmaf(w, v[e], y[e]);
            }
        }
        float4* xo = (float4*)(X + (size_t)t * DM + 16 * lane);
#pragma unroll
        for (int q = 0; q < 4; ++q) { float4 p = xo[q]; p.x += y[4 * q]; p.y += y[4 * q + 1]; p.z += y[4 * q + 2]; p.w += y[4 * q + 3]; xo[q] = p; }
    }
}
}
constexpr int NWAVES = 8, NTHR = 512;
constexpr int RING_BYTES = 131072, MISC_OFF = RING_BYTES + 320, LDS_BYTES = 147456;
struct Args { const void* in[34]; float* out; unsigned char* ws; int ph_lo, ph_hi; };
struct Ctx { LAS unsigned char* lds; int tid, lane, wave, G, bid, gw, ngw, gt, ngt; };
#define INF(i) ((const float*)a.in[i])
#define WSP(T_, off) ((T_*)(a.ws + (off)))

__device__ __forceinline__ void prep_tile(const float* W, int K, int N, bf16* WT, int Nout, int mapmode, int item, LAS float* tile, int t256) {
    const int nbn = Nout / 32, kb = item / nbn, nb = item % nbn, n0 = nb * 32, k0 = kb * 32, tx = t256 & 31, ty = t256 >> 5;
    for (int i = ty; i < 32; i += 8) {
        const int n = n0 + tx; int src = n;
        if (mapmode == 1) { if (n < 448) src = n; else if (n < 512) src = -1; else src = n - 64; }
        tile[i * 33 + tx] = (src >= 0 && src < N) ? W[(size_t)(k0 + i) * N + src] : 0.f;
    }
    __syncthreads();
    for (int i = ty; i < 32; i += 8) WT[(size_t)(n0 + i) * K + k0 + tx] = f2bf(tile[tx * 33 + i]);
    __syncthreads();
}
template <class ArgsRef> __device__ __forceinline__ void ph_prep(const ArgsRef& a, const Ctx& c) {
    const int sub = c.tid >> 8, t256 = c.tid & 255; LAS float* tile = (LAS float*)c.lds + sub * (32 * 33);
    constexpr int NT0 = 1280, NT1 = 192, NT2 = 128, NT3 = 64, NT4 = 1024, NT5 = 2048, NTL = NT0 + NT1 + NT2 + NT3 + NT4 + NT5, NTOT = NL * NTL;
    const int nsb = c.G * 2;
    for (int it0 = c.bid * 2; it0 < NTOT; it0 += nsb) {
        int it = it0 + sub; if (it >= NTOT) it = NTOT - 1;
        const int l = it / NTL; int r = it % NTL;
        if (r < NT0) prep_tile(INF(3) + (size_t)l * DM * 1216, DM, 1216, WSP(bf16, WS_WINT) + (size_t)l * ZW * DM, ZW, 1, r, tile, t256);
        else if ((r -= NT0) < NT1) prep_tile(INF(5) + (size_t)l * 256 * 768, 256, 768, WSP(bf16, WS_WUQT) + (size_t)l * 768 * 256, 768, 0, r, tile, t256);
        else if ((r -= NT1) < NT2) prep_tile(INF(7) + (size_t)l * 128 * 1024, 128, 1024, WSP(bf16, WS_WUKVT) + (size_t)l * 1024 * 128, 1024, 0, r, tile, t256);
        else if ((r -= NT2) < NT3) prep_tile(INF(18) + (size_t)l * 65536, 256, 256, WSP(bf16, WS_GLUT) + (size_t)l * 65536, 256, 0, r, tile, t256);
        else if ((r -= NT3) < NT4) prep_tile(INF(28) + (size_t)l * DM * DM, DM, DM, WSP(bf16, WS_WOUTT) + (size_t)l * DM * DM, DM, 0, r, tile, t256);
        else { r -= NT4; prep_tile(INF(30) + (size_t)l * DM * 2048, DM, 2048, WSP(bf16, WS_WQT) + (size_t)l * 2048 * DM, 2048, 0, r, tile, t256); }
    }
    for (int i = c.gt; i < NL * 32768; i += c.ngt) WSP(bf16, WS_SUBKT)[i] = f2bf(INF(31)[i]);
    pgf::convert((const float*)a.in[32], WSP(unsigned char, WS_PU), (size_t)NL * 16384 * DM, pgf::USCALE, c.gt, c.ngt);
    pgf::convert((const float*)a.in[33], WSP(unsigned char, WS_PV), (size_t)NL * 16384 * DM, pgf::VSCALE, c.gt, c.ngt);
    for (int i = c.gt; i < T * 32; i += c.ngt) { const int t = i >> 5, j = i & 31;
        const float freq = exp2f(-(float)j * 0.41524101186092033f);
        const float ang = (float)((const int*)a.in[1])[t] * freq; float s, cs; sincos_acc(ang, s, cs);
        WSP(float, WS_COS)[i] = cs; WSP(float, WS_SIN)[i] = s; }
    for (int l = 0; l < NL; ++l)
        s5f::build_tables(INF(10) + l * 1024, INF(11) + l * 1024, INF(12) + l * 16, INF(13) + l * 16384, INF(14) + l * 16384, INF(15) + l * 16384, INF(16) + l * 16384,
                          WSP(bf16, WS_S5A) + (size_t)l * 32768, WSP(bf16, WS_S5C) + (size_t)l * 32768, WSP(float2, WS_S5L) + l * 1024, c.gt, c.ngt);
}

__device__ __forceinline__ void ph_rowprep(const Ctx& c, const float* x, const float* gain, bf16* XB) {
    for (int row = c.gw; row < T; row += c.ngw) {
        const float4* xr = (const float4*)(x + (size_t)row * DM) + c.lane;
        float4 v[4]; float ss = 0.f;
#pragma unroll
        for (int j = 0; j < 4; ++j) { v[j] = xr[64 * j]; ss += v[j].x * v[j].x + v[j].y * v[j].y + v[j].z * v[j].z + v[j].w * v[j].w; }
        const float rstd = rsqrtf(wave_sum(ss) * (1.f / DM) + EPS);
        uint2* o = (uint2*)(XB + (size_t)row * DM) + c.lane;
#pragma unroll
        for (int j = 0; j < 4; ++j) { const float4 g = ((const float4*)gain)[c.lane + 64 * j];
            o[64 * j] = make_uint2(pk2(v[j].x * rstd * g.x, v[j].y * rstd * g.y), pk2(v[j].z * rstd * g.z, v[j].w * rstd * g.w)); }
    }
}

enum { EPI_BF16 = 0, EPI_F32 = 1, EPI_GLU = 2, EPI_RESID = 3 };
template <int EPI> __device__ __forceinline__ void gemm_simple(const Ctx& c, const bf16* A, int lda, const bf16* Bt, int M, int N, int K, void* C, int ldc, const float* aux0, const bf16* aux1) {
    LAS float* As = (LAS float*)c.lds; LAS float* Bs = As + 16 * 132;
    const int tid = c.tid, tx = tid & 15, ty = tid >> 4, nN = N / 64, ntile = (M / 128) * nN;
    for (int tile = c.bid; tile < ntile; tile += c.G) {
        const int m0 = (tile / nN) * 128, n0 = (tile % nN) * 64;
        float acc[4][4];
#pragma unroll
        for (int i = 0; i < 4; ++i)
#pragma unroll
            for (int j = 0; j < 4; ++j) acc[i][j] = 0.f;
        const int lr = tid >> 2, lk = (tid & 3) * 4;
        for (int k0 = 0; k0 < K; k0 += 16) {
            { const uint2 w = *(const uint2*)(A + (size_t)(m0 + lr) * lda + k0 + lk);
              As[lk * 132 + lr] = __uint_as_float(w.x << 16); As[(lk + 1) * 132 + lr] = __uint_as_float(w.x & 0xffff0000u); As[(lk + 2) * 132 + lr] = __uint_as_float(w.y << 16); As[(lk + 3) * 132 + lr] = __uint_as_float(w.y & 0xffff0000u); }
            if (tid < 256) { const uint2 w = *(const uint2*)(Bt + (size_t)(n0 + lr) * K + k0 + lk);
              Bs[lk * 68 + lr] = __uint_as_float(w.x << 16); Bs[(lk + 1) * 68 + lr] = __uint_as_float(w.x & 0xffff0000u); Bs[(lk + 2) * 68 + lr] = __uint_as_float(w.y << 16); Bs[(lk + 3) * 68 + lr] = __uint_as_float(w.y & 0xffff0000u); }
            __syncthreads();
#pragma unroll
            for (int kk = 0; kk < 16; ++kk) {
                float av[4], bv[4];
#pragma unroll
                for (int i = 0; i < 4; ++i) { av[i] = As[kk * 132 + ty * 4 + i]; bv[i] = Bs[kk * 68 + tx * 4 + i]; }
#pragma unroll
                for (int i = 0; i < 4; ++i)
#pragma unroll
                    for (int j = 0; j < 4; ++j) acc[i][j] += av[i] * bv[j];
            }
            __syncthreads();
        }
#pragma unroll
        for (int i = 0; i < 4; ++i)
#pragma unroll
            for (int j = 0; j < 4; ++j) {
                const int row = m0 + ty * 4 + i, col = n0 + tx * 4 + j; const size_t ix = (size_t)row * ldc + col; const float v = acc[i][j];
                if (EPI == EPI_BF16) ((bf16*)C)[ix] = f2bf(v);
                else if (EPI == EPI_F32) ((float*)C)[ix] = v;
                else if (EPI == EPI_GLU) { const float yg = bf2f(aux1[ix]); ((bf16*)C)[ix] = f2bf(yg * sigmoid_f(v + aux0[col])); }
                else { ((float*)C)[ix] = aux0[ix] + v; }
            }
    }
}

__device__ __forceinline__ void ph_zstats(const Ctx& c, const bf16* Z, const float* qan, const float* kvan, bf16* CQN, bf16* CKVN) {
    for (int row = c.gw; row < T; row += c.ngw) {
        const bf16* zr = Z + (size_t)row * ZW; const int lane = c.lane;
        { const uint2 w = *(const uint2*)(zr + ZC_CQ + 4 * lane);
          float a0 = __uint_as_float(w.x << 16), a1 = __uint_as_float(w.x & 0xffff0000u), a2 = __uint_as_float(w.y << 16), a3 = __uint_as_float(w.y & 0xffff0000u);
          const float rstd = rsqrtf(wave_sum(a0 * a0 + a1 * a1 + a2 * a2 + a3 * a3) * (1.f / 256) + EPS);
          const float4 g = ((const float4*)qan)[lane];
          *(uint2*)(CQN + (size_t)row * 256 + 4 * lane) = make_uint2(pk2(a0 * rstd * g.x, a1 * rstd * g.y), pk2(a2 * rstd * g.z, a3 * rstd * g.w)); }
        { const u32 w = *(const u32*)(zr + ZC_CKV + 2 * lane);
          float a0 = __uint_as_float(w << 16), a1 = __uint_as_float(w & 0xffff0000u);
          const float rstd = rsqrtf(wave_sum(a0 * a0 + a1 * a1) * (1.f / 128) + EPS);
          const float2 g = ((const float2*)kvan)[lane];
          *(u32*)(CKVN + (size_t)row * 128 + 2 * lane) = pk2(a0 * rstd * g.x, a1 * rstd * g.y); }
    }
}

__device__ __forceinline__ void ph_qkfin(const Ctx& c, const bf16* QRAW, const bf16* KVRAW, const bf16* Z, const float* qn, const float* kn, const float* COS, const float* SIN, bf16* QB, bf16* KB, bf16* VB) {
    const int lane = c.lane;
    for (int w = c.gw; w < T * NH; w += c.ngw) {
        const int t = w >> 2, h = w & 3, b = t / SEQ, s = t % SEQ; const size_t bh = (size_t)b * NH + h;
        const float cs = COS[t * 32 + (lane & 31)], sn = SIN[t * 32 + (lane & 31)];
        {   const bf16* p = QRAW + (size_t)t * 768 + h * DQK;
            float v0 = bf2f(p[lane]), v1 = bf2f(p[lane + 64]), v2 = bf2f(p[lane + 128]);
            const float rstd = rsqrtf(wave_sum(v0 * v0 + v1 * v1 + v2 * v2) * (1.f / DQK) + EPS);
            v0 *= rstd * qn[lane]; v1 *= rstd * qn[lane + 64]; v2 *= rstd * qn[lane + 128];
            const float pr = __shfl_xor(v2, 32);
            const float r2 = (lane < 32) ? (v2 * cs - pr * sn) : (pr * sn + v2 * cs);
            bf16* o = QB + (bh * SEQ + s) * DQK;
            o[lane] = f2bf(v0 * QSCALE); o[lane + 64] = f2bf(v1 * QSCALE); o[lane + 128] = f2bf(r2 * QSCALE); }
        {   const bf16* p = KVRAW + (size_t)t * 1024 + h * 256;
            float v0 = bf2f(p[lane]), v1 = bf2f(p[lane + 64]), v2 = bf2f(Z[(size_t)t * ZW + ZC_KR + lane]);
            const float rstd = rsqrtf(wave_sum(v0 * v0 + v1 * v1 + v2 * v2) * (1.f / DQK) + EPS);
            v0 *= rstd * kn[lane]; v1 *= rstd * kn[lane + 64]; v2 *= rstd * kn[lane + 128];
            const float pr = __shfl_xor(v2, 32);
            const float r2 = (lane < 32) ? (v2 * cs - pr * sn) : (pr * sn + v2 * cs);
            bf16* o = KB + (bh * SEQ + s) * DQK;
            o[lane] = f2bf(v0); o[lane + 64] = f2bf(v1); o[lane + 128] = f2bf(r2);
            bf16* ov = VB + (bh * SEQ + s) * DV;
            ov[lane] = p[128 + lane]; ov[lane + 64] = p[192 + lane]; }
    }
}

__device__ __forceinline__ void ph_attn_simple(const Ctx& c, const bf16* QB, const bf16* KB, const bf16* VB, bf16* AO) {
    LAS float* qs = (LAS float*)c.lds + c.wave * DQK; const int lane = c.lane;
    for (int gq = c.gw; gq < NB * NH * SEQ; gq += c.ngw) {
        const int bh = gq / SEQ, q = gq % SEQ;
        const bf16* qp = QB + ((size_t)bh * SEQ + q) * DQK;
        qs[lane] = bf2f(qp[lane]); qs[lane + 64] = bf2f(qp[lane + 64]); qs[lane + 128] = bf2f(qp[lane + 128]);
        asm volatile("s_waitcnt lgkmcnt(0)" ::: "memory");
        float m = -1e30f, l = 0.f, o0 = 0.f, o1 = 0.f;
        const int ntile = q / 64 + 1;
        for (int kt = 0; kt < ntile; ++kt) {
            const int key = kt * 64 + lane;
            const uint4* kp = (const uint4*)(KB + ((size_t)bh * SEQ + key) * DQK);
            float sc = 0.f;
#pragma unroll 4
            for (int cc = 0; cc < 24; ++cc) { float kv[8]; unpack8(kp[cc], kv);
#pragma unroll
                for (int e = 0; e < 8; ++e) sc += kv[e] * qs[cc * 8 + e]; }
            if (key > q) sc = -INFINITY;
            const float mn = fmaxf(m, wave_max(sc));
            const float p = exp2f(sc - mn), al = exp2f(m - mn);
            l = l * al + wave_sum(p); o0 *= al; o1 *= al; m = mn;
            const u32* vp = (const u32*)(VB + ((size_t)bh * SEQ + kt * 64) * DV) + lane;
#pragma unroll 8
            for (int k = 0; k < 64; ++k) { const float pk = __shfl(p, k); const u32 w = vp[(size_t)k * (DV / 2)];
                o0 += pk * __uint_as_float(w << 16); o1 += pk * __uint_as_float(w & 0xffff0000u); }
        }
        const int b = bh / NH, h = bh % NH; const float il = 1.f / l;
        *(u32*)(AO + ((size_t)b * SEQ + q) * 512 + h * DV + 2 * lane) = pk2(o0 * il, o1 * il);
    }
}

__device__ __forceinline__ void ph_s5_simple(const Ctx& c, const bf16* Z, const float* a_re, const float* a_im, const float* log_dt, const float* b_re, const float* b_im,
                                             const float* c_re, const float* c_im, const float* dsk, bf16* YG) {
    for (int item = c.gw; item < NB * 16; item += c.ngw) {
        const int b = item >> 4, g = item & 15, p = c.lane;
        const float are = a_re[g * 64 + p], aim = a_im[g * 64 + p], dt = expf(log_dt[g]);
        const float mag = expf(are * dt); float sn, cs; sincos_acc(aim * dt, sn, cs);
        const float lre = mag * cs, lim = mag * sn;
        const float xr = lre - 1.f, xi = lim, den = are * are + aim * aim;
        const float cr = (xr * are + xi * aim) / den, ci = (xi * are - xr * aim) / den;
        float Bre[16], Bim[16], Cre[16], Cim[16];
#pragma unroll
        for (int k = 0; k < 16; ++k) { const float br = b_re[(g * 64 + p) * 16 + k], bi = b_im[(g * 64 + p) * 16 + k];
            Bre[k] = cr * br - ci * bi; Bim[k] = cr * bi + ci * br; Cre[k] = c_re[(g * 16 + k) * 64 + p]; Cim[k] = c_im[(g * 16 + k) * 64 + p]; }
        const float D = (p < 16) ? dsk[g * 16 + p] : 0.f;
        float hre = 0.f, him = 0.f;
        for (int s = 0; s < SEQ; ++s) {
            const bf16* up = Z + (size_t)(b * SEQ + s) * ZW + ZC_U + g * 16;
            float u[16]; unpack8(*(const uint4*)up, u); unpack8(*(const uint4*)(up + 8), u + 8);
            float bre = 0.f, bim = 0.f;
#pragma unroll
            for (int k = 0; k < 16; ++k) { bre += Bre[k] * u[k]; bim += Bim[k] * u[k]; }
            const float nre = lre * hre - lim * him + bre, nim = lre * him + lim * hre + bim; hre = nre; him = nim;
            float my = 0.f;
#pragma unroll
            for (int k = 0; k < 16; ++k) { const float v = wave_sum(Cre[k] * hre - Cim[k] * him); if (p == k) my = v + D * u[k]; }
            if (p < 16) YG[(size_t)(b * SEQ + s) * 256 + g * 16 + p] = f2bf(gelu_f(my));
        }
    }
}

__device__ __forceinline__ void ph_lru_xc(const Ctx& c, const bf16* Z, const float* cw, const float* cb, float* XC) {
    for (int i = c.gt; i < T * 256; i += c.ngt) { const int t = i >> 8, ch = i & 255, s = t % SEQ;
        float acc = cb[ch];
#pragma unroll
        for (int j = 0; j < 4; ++j) { const int ss = s - 3 + j; if (ss >= 0) acc += cw[j * 256 + ch] * bf2f(Z[(size_t)(t - 3 + j) * ZW + ZC_X + ch]); }
        XC[i] = acc; }
}
__device__ __forceinline__ void ph_lru_gates(const Ctx& c, const float* XC, const float* wa, const float* ba, const float* wx, const float* bx, const float* lam, float* AA, float* BT) {
    for (int i = c.gt; i < T * 256; i += c.ngt) { const int t = i >> 8, ch = i & 255, h = ch >> 6, j = ch & 63;
        const float* xr = XC + (size_t)t * 256 + h * 64;
        float ra = ba[ch], rx = bx[ch];
        for (int k = 0; k < 64; ++k) { const float xv = xr[k]; ra += xv * wa[(h * 64 + k) * 64 + j]; rx += xv * wx[(h * 64 + k) * 64 + j]; }
        const float r = sigmoid_f(ra), ig = sigmoid_f(rx);
        const float lsg = -log1pf(expf(-lam[ch]));
        const float la = 8.f * r * lsg, av = expf(la);
        AA[i] = av; BT[i] = sqrtf(-expm1f(2.f * la)) * (ig * XC[i]); }
}
__device__ __forceinline__ void ph_lru_scan(const Ctx& c, const float* AA, const float* BT, const bf16* Z, bf16* ROUT) {
    for (int item = c.gw; item < NB * 4; item += c.ngw) {
        const int i = item * 64 + c.lane, b = i >> 8, ch = i & 255;
        float h = 0.f;
#pragma unroll 8
        for (int s = 0; s < SEQ; ++s) { const size_t t = (size_t)b * SEQ + s;
            h = AA[t * 256 + ch] * h + BT[t * 256 + ch];
            ROUT[t * 256 + ch] = f2bf(h * gelu_f(bf2f(Z[t * ZW + ZC_G + ch]))); }
    }
}

__device__ __forceinline__ void ph_mixnorm(const Ctx& c, const bf16* AO, const bf16* SOUT, const bf16* ROUT, const float* g, bf16* Y) {
    const int lane = c.lane;
    for (int row = c.gw; row < T; row += c.ngw) {
        {   float v[8]; unpack8(*(const uint4*)(AO + (size_t)row * 512 + 8 * lane), v);
            float ss = 0.f;
#pragma unroll
            for (int e = 0; e < 8; ++e) ss += v[e] * v[e];
            const float rstd = rsqrtf(wave_sum(ss) * (1.f / 512) + EPS); const float* gg = g + 8 * lane;
            *(uint4*)(Y + (size_t)row * DM + 8 * lane) = make_uint4(pk2(v[0] * rstd * gg[0], v[1] * rstd * gg[1]), pk2(v[2] * rstd * gg[2], v[3] * rstd * gg[3]),
                                                                    pk2(v[4] * rstd * gg[4], v[5] * rstd * gg[5]), pk2(v[6] * rstd * gg[6], v[7] * rstd * gg[7])); }
#pragma unroll
        for (int part = 0; part < 2; ++part) {
            const bf16* src = part == 0 ? SOUT : ROUT; const int off = 512 + 256 * part;
            const uint2 w = *(const uint2*)(src + (size_t)row * 256 + 4 * lane);
            float a0 = __uint_as_float(w.x << 16), a1 = __uint_as_float(w.x & 0xffff0000u), a2 = __uint_as_float(w.y << 16), a3 = __uint_as_float(w.y & 0xffff0000u);
            const float rstd = rsqrtf(wave_sum(a0 * a0 + a1 * a1 + a2 * a2 + a3 * a3) * (1.f / 256) + EPS); const float* gg = g + off + 4 * lane;
            *(uint2*)(Y + (size_t)row * DM + off + 4 * lane) = make_uint2(pk2(a0 * rstd * gg[0], a1 * rstd * gg[1]), pk2(a2 * rstd * gg[2], a3 * rstd * gg[3]));
        }
    }
}

__device__ __forceinline__ void ph_topk_a(const Ctx& c, const float* SC, float* STOP, int* ITOP) {
    for (int i = c.gt; i < T * 16; i += c.ngt) {
        const float* sc = SC + (size_t)i * 128;
        float pv = INFINITY; int pn = -1;
        for (int it = 0; it < 16; ++it) {
            float bv = -INFINITY; int bn = 1 << 30;
            for (int n = 0; n < 128; ++n) { const float v = sc[n];
                const bool elig = (v < pv) || (v == pv && n > pn);
                if (elig && (v > bv || (v == bv && n < bn))) { bv = v; bn = n; } }
            STOP[(size_t)i * 16 + it] = bv; ITOP[(size_t)i * 16 + it] = bn; pv = bv; pn = bn;
        }
    }
}
__device__ __forceinline__ void ph_topk_b(const Ctx& c, const float* STOP, const int* ITOP, int* IDX, float* GATE) {
    LAS float* my = (LAS float*)c.lds + c.tid * 33;
    for (int i = c.gt; i < T * 8; i += c.ngt) {
        for (int k = 0; k < 32; ++k) my[k] = STOP[(size_t)i * 32 + k];
        float pv = INFINITY; int pn = -1; float best0 = 0.f, den = 0.f;
        float ev[16];
#pragma unroll
        for (int it = 0; it < 16; ++it) {
            float bv = -INFINITY; int bn = 1 << 30;
            for (int f = 0; f < 256; ++f) { const float v = my[f >> 4] + my[16 + (f & 15)];
                const bool elig = (v < pv) || (v == pv && f > pn);
                if (elig && (v > bv || (v == bv && f < bn))) { bv = v; bn = f; } }
            pv = bv; pn = bn;
            if (it == 0) best0 = bv;
            ev[it] = expf(bv - best0); den += ev[it];
            IDX[(size_t)i * 16 + it] = ITOP[(size_t)i * 32 + (bn >> 4)] * 128 + ITOP[(size_t)i * 32 + 16 + (bn & 15)];
        }
#pragma unroll
        for (int it = 0; it < 16; ++it) GATE[(size_t)i * 16 + it] = ev[it] / den;
    }
}

__device__ __forceinline__ void ph_gather(const Ctx& c, const bf16* HN, const int* IDX, const float* GATE, const bf16* PU, const bf16* PV, float* X) {
    const int lane = c.lane;
    for (int t = c.gw; t < T; t += c.ngw) {
        float hn[16]; unpack8(*(const uint4*)(HN + (size_t)t * DM + 8 * lane), hn); unpack8(*(const uint4*)(HN + (size_t)t * DM + 512 + 8 * lane), hn + 8);
        float y[16];
#pragma unroll
        for (int e = 0; e < 16; ++e) y[e] = 0.f;
        for (int k = 0; k < 128; ++k) {
            const int e = IDX[(size_t)t * 128 + k]; const float gt = GATE[(size_t)t * 128 + k];
            const bf16* ur = PU + (size_t)e * DM; const bf16* vr = PV + (size_t)e * DM;
            float u[16]; unpack8(*(const uint4*)(ur + 8 * lane), u); unpack8(*(const uint4*)(ur + 512 + 8 * lane), u + 8);
            float d = 0.f;
#pragma unroll
            for (int q = 0; q < 16; ++q) d += u[q] * hn[q];
            d = wave_sum(d);
            const float w = gt * gelu_f(d);
            float v[16]; unpack8(*(const uint4*)(vr + 8 * lane), v); unpack8(*(const uint4*)(vr + 512 + 8 * lane), v + 8);
#pragma unroll
            for (int q = 0; q < 16; ++q) y[q] += w * v[q];
        }
        float4* xo = (float4*)(X + (size_t)t * DM + 8 * lane);
        float4 p0 = xo[0], p1 = xo[1]; p0.x += y[0]; p0.y += y[1]; p0.z += y[2]; p0.w += y[3]; p1.x += y[4]; p1.y += y[5]; p1.z += y[6]; p1.w += y[7]; xo[0] = p0; xo[1] = p1;
        xo = (float4*)(X + (size_t)t * DM + 512 + 8 * lane);
        p0 = xo[0]; p1 = xo[1]; p0.x += y[8]; p0.y += y[9]; p0.z += y[10]; p0.w += y[11]; p1.x += y[12]; p1.y += y[13]; p1.z += y[14]; p1.w += y[15]; xo[0] = p0; xo[1] = p1;
    }
}
namespace att {
typedef short bf16x8 __attribute__((ext_vector_type(8)));
typedef short s16x4 __attribute__((ext_vector_type(4)));
typedef float f32x16 __attribute__((ext_vector_type(16)));
typedef unsigned u32x4 __attribute__((ext_vector_type(4)));
constexpr int KT = 64, KBYTES = KT * DQK * 2, VBYTES = KT * DV * 2, BUFB = KBYTES + VBYTES;
constexpr int OFF_WS = 2 * BUFB, OFF_MO = 0, OFF_ML = 65536, LDS_NEED = OFF_WS + 8 * 64 * 4;
constexpr float THR = 8.f;
__device__ __forceinline__ int kswz(int row, int c) { return row * 384 + (((c & ~7) | ((c & 7) ^ ((row >> 1) & 7))) << 4); }
__device__ __forceinline__ int v_st(int k, int c) { const int kk = (k & ~0xC) | ((k & 4) << 1) | ((k & 8) >> 1); return ((kk >> 3) * 4 + (c >> 5)) * 512 + ((kk & 7) * 32 + (c & 31)) * 2; }
__device__ __forceinline__ int v_rd_base(int lane) { return ((lane & 3) << 3) | (((lane >> 2) & 3) << 6) | (((lane >> 4) & 1) << 5) | (((lane >> 5) & 1) << 8); }
__device__ __forceinline__ int crow(int r, int hi) { return (r & 3) + 8 * (r >> 2) + 4 * hi; }
__device__ __forceinline__ unsigned cvtpk(float lo, float hi) { unsigned r; asm volatile("v_cvt_pk_bf16_f32 %0, %1, %2" : "=v"(r) : "v"(lo), "v"(hi)); return r; }
#define ATT_SBAR() __builtin_amdgcn_sched_barrier(0)

__device__ __forceinline__ void attn_unit(LAS unsigned char* lds, const bf16* Qg, const bf16* Kg, const bf16* Vg, bf16* AO, int bh, int qb, int tid) {
    const int lane = tid & 63, wid = __builtin_amdgcn_readfirstlane(tid >> 6), qsub = wid & 3, kh = wid >> 2, r32 = lane & 31, hi = lane >> 5;
    const int q0 = qb * 128, NT = 2 * (qb + 1);
    const size_t rowbase = (size_t)bh * SEQ;
    bf16x8 qr[12];
    { const bf16* qp = Qg + (rowbase + q0 + 32 * qsub + r32) * DQK + 8 * hi;
#pragma unroll
      for (int ks = 0; ks < 12; ++ks) qr[ks] = *(const bf16x8*)(qp + 16 * ks); }
    int ksrc[3], vsrc[2];
#pragma unroll
    for (int j = 0; j < 3; ++j) { const int L = (wid + 8 * j) * 64 + lane, row = L / 24, cp = L - row * 24, c = (cp & ~7) | ((cp & 7) ^ ((row >> 1) & 7)); ksrc[j] = row * DQK + c * 8; }
#pragma unroll
    for (int j = 0; j < 2; ++j) { const int X = ((wid + 8 * j) * 64 + lane) * 16, sub = X >> 9, within = (X & 511) >> 1, kk = ((sub >> 2) << 3) | (within >> 5);
        const int k = (kk & ~0xC) | ((kk & 4) << 1) | ((kk & 8) >> 1), c = (sub & 3) * 32 + (within & 31); vsrc[j] = k * DV + c; }
    const bf16* Kt = Kg + rowbase * DQK; const bf16* Vt = Vg + rowbase * DV;
#define ATT_STAGE(t, bo) do { const bf16* kp_ = Kt + (size_t)(t) * (KT * DQK); const bf16* vp_ = Vt + (size_t)(t) * (KT * DV); \
        _Pragma("unroll") for (int j_ = 0; j_ < 3; ++j_) __builtin_amdgcn_global_load_lds((const unsigned*)(kp_ + ksrc[j_]), (LAS unsigned*)(lds + (bo) + (wid + 8 * j_) * 1024), 16, 0, 0); \
        _Pragma("unroll") for (int j_ = 0; j_ < 2; ++j_) __builtin_amdgcn_global_load_lds((const unsigned*)(vp_ + vsrc[j_]), (LAS unsigned*)(lds + (bo) + KBYTES + (wid + 8 * j_) * 1024), 16, 0, 0); } while (0)
    const int krow = 32 * kh + r32, kf = (krow >> 1) & 7;
    int kb[4];
#pragma unroll
    for (int j = 0; j < 4; ++j) kb[j] = krow * 384 + ((((2 * j + hi) & 7) ^ kf) << 4);
    const int vb = KBYTES + v_rd_base(lane) + kh * 8192;
    LAS float* wsf = (LAS float*)(lds + OFF_WS) + wid * 64;
    float m_reg = -1e30f, l_reg = 0.f; f32x16 o[4];
#pragma unroll
    for (int d = 0; d < 4; ++d) o[d] = f32x16{};
    const int rb = 32 * qsub;
    ATT_STAGE(0, 0);
    asm volatile("s_waitcnt vmcnt(0)" ::: "memory");
    __syncthreads();
    for (int t = 0; t < NT; ++t) {
        const int bo = (t & 1) * BUFB;
        if (t + 1 < NT) ATT_STAGE(t + 1, BUFB - bo);
        const int kboff = 64 * t + 32 * kh - q0;
        const bool act = kboff <= rb, diag = kboff == rb;
        if (act) {
            f32x16 p = f32x16{};
#pragma unroll
            for (int ks = 0; ks < 12; ++ks) {
                const bf16x8 kfr = *(const LAS bf16x8*)(lds + bo + kb[ks & 3] + (ks >> 2) * 128);
                p = __builtin_amdgcn_mfma_f32_32x32x16_bf16(kfr, qr[ks], p, 0, 0, 0);
            }
            if (diag) {
#pragma unroll
                for (int r = 0; r < 16; ++r) if (crow(r, hi) > r32) p[r] = -__builtin_inff();
            }
            float pmax = p[0];
#pragma unroll
            for (int r = 1; r < 16; ++r) pmax = fmaxf(pmax, p[r]);
            { auto rr = __builtin_amdgcn_permlane32_swap(__float_as_uint(pmax), __float_as_uint(pmax), false, false);
              pmax = fmaxf(__uint_as_float(rr[0]), __uint_as_float(rr[1])); }
            float alpha = 1.f;
            if (!__all(pmax - m_reg <= THR)) { const float mn = fmaxf(m_reg, pmax); alpha = __builtin_amdgcn_exp2f(m_reg - mn); m_reg = mn; }
#pragma unroll
            for (int r = 0; r < 16; ++r) p[r] = __builtin_amdgcn_exp2f(p[r] - m_reg);
            float ps = 0.f;
#pragma unroll
            for (int r = 0; r < 16; ++r) ps += p[r];
            { auto rr = __builtin_amdgcn_permlane32_swap(__float_as_uint(ps), __float_as_uint(ps), false, false);
              ps = __uint_as_float(rr[0]) + __uint_as_float(rr[1]); }
            l_reg = l_reg * alpha + ps;
            if (__any(alpha < 1.f)) {
                if (hi == 0) wsf[r32] = alpha;
                asm volatile("s_waitcnt lgkmcnt(0)" ::: "memory");
#pragma unroll
                for (int r = 0; r < 16; ++r) { const float al = wsf[crow(r, hi)];
#pragma unroll
                    for (int d = 0; d < 4; ++d) o[d][r] *= al; }
            }
            bf16x8 pa0, pa1;
#define ATT_PK4(B_, OUT) do { unsigned a0 = cvtpk(p[B_ + 0], p[B_ + 1]), a1 = cvtpk(p[B_ + 2], p[B_ + 3]); unsigned b0 = cvtpk(p[B_ + 4], p[B_ + 5]), b1 = cvtpk(p[B_ + 6], p[B_ + 7]); \
            auto r0 = __builtin_amdgcn_permlane32_swap(a0, b0, false, false); auto r1 = __builtin_amdgcn_permlane32_swap(a1, b1, false, false); \
            u32x4 w_ = {r0[0], r1[0], r0[1], r1[1]}; OUT = __builtin_bit_cast(bf16x8, w_); } while (0)
            ATT_PK4(0, pa0); ATT_PK4(8, pa1);
#undef ATT_PK4
            const int vaddr = (int)(uintptr_t)lds + bo + vb;
#define ATT_TRRD(dst, off) asm volatile("ds_read_b64_tr_b16 %0, %1 offset:%2" : "=&v"(dst) : "v"(vaddr), "i"(off) : "memory")
#define ATT_PV(d0) do { s16x4 l0, h0, l1, h1; \
            ATT_TRRD(l0, (d0) * 512); ATT_TRRD(h0, (d0) * 512 + 2048); ATT_TRRD(l1, (d0) * 512 + 4096); ATT_TRRD(h1, (d0) * 512 + 6144); \
            asm volatile("s_waitcnt lgkmcnt(0)" ::: "memory"); ATT_SBAR(); \
            o[d0] = __builtin_amdgcn_mfma_f32_32x32x16_bf16(pa0, (bf16x8){l0[0], l0[1], l0[2], l0[3], h0[0], h0[1], h0[2], h0[3]}, o[d0], 0, 0, 0); \
            o[d0] = __builtin_amdgcn_mfma_f32_32x32x16_bf16(pa1, (bf16x8){l1[0], l1[1], l1[2], l1[3], h1[0], h1[1], h1[2], h1[3]}, o[d0], 0, 0, 0); } while (0)
            ATT_PV(0); ATT_PV(1); ATT_PV(2); ATT_PV(3);
#undef ATT_PV
#undef ATT_TRRD
        }
        asm volatile("s_waitcnt vmcnt(0)" ::: "memory");
        __syncthreads();
    }
    LAS float* MO = (LAS float*)(lds + OFF_MO) + qsub * 4096; LAS float* ML = (LAS float*)(lds + OFF_ML) + qsub * 64;
    if (kh == 1) {
        if (hi == 0) { ML[2 * r32] = m_reg; ML[2 * r32 + 1] = l_reg; }
#pragma unroll
        for (int d = 0; d < 4; ++d)
#pragma unroll
            for (int r = 0; r < 16; ++r) MO[(d * 16 + r) * 64 + lane] = o[d][r];
    }
    __syncthreads();
    if (kh == 0) {
        const float m1 = ML[2 * r32], l1 = ML[2 * r32 + 1];
        const float mm = fmaxf(m_reg, m1), f0 = __builtin_amdgcn_exp2f(m_reg - mm), f1 = __builtin_amdgcn_exp2f(m1 - mm);
        const float il = 1.f / (l_reg * f0 + l1 * f1);
        if (hi == 0) { wsf[r32] = f0 * il; wsf[32 + r32] = f1 * il; }
        asm volatile("s_waitcnt lgkmcnt(0)" ::: "memory");
        const int b = bh / NH, h = bh % NH;
        bf16* Ow = AO + ((size_t)b * SEQ + q0 + rb) * 512 + h * DV;
#pragma unroll
        for (int r = 0; r < 16; ++r) { const int orow = crow(r, hi); const float g0 = wsf[orow], g1 = wsf[32 + orow];
#pragma unroll
            for (int d = 0; d < 4; ++d) { const float v = o[d][r] * g0 + MO[(d * 16 + r) * 64 + lane] * g1; const float vn = __shfl_xor(v, 1);
                if ((r32 & 1) == 0) *(unsigned*)(Ow + (size_t)orow * 512 + d * 32 + r32) = cvtpk(v, vn); } }
    }
    __syncthreads();
#undef ATT_STAGE
}
__device__ __forceinline__ void attn_phase(LAS unsigned char* lds, const bf16* Qg, const bf16* Kg, const bf16* Vg, bf16* AO, int G, int bid, int tid) {
    const int npair = NB * NH * 32;
    for (int v0 = bid; v0 < npair; v0 += G) {
        const int vcu = (G % 8 == 0 && npair % G == 0) ? (v0 % 8) * (npair / 8) + v0 / 8 : v0;
        const int bh = vcu >> 5, s = vcu & 31;
        for (int u = 0; u < 2; ++u) attn_unit(lds, Qg, Kg, Vg, AO, bh, u ? s : 63 - s, tid);
    }
}
#undef ATT_SBAR
}
#ifndef MK_PROBE
#define MK_PROBE 0
#endif
#ifndef PROBE_A_LO
#define PROBE_A_LO 0
#define PROBE_A_HI 1
#define PROBE_B_LO 16
#define PROBE_B_HI 17
#endif
#define TS_OFF 8192
#ifndef MK_DUP
#define MK_DUP 0
#endif
#ifndef MK_SIMPLE_TOPK
#define MK_SIMPLE_TOPK 0
#endif
#ifndef MK_SIMPLE_SCAN
#define MK_SIMPLE_SCAN 0
#endif
#ifndef MK_SIMPLE_ATTN
#define MK_SIMPLE_ATTN 0
#endif
#ifndef MK_SIMPLE_GEMM
#define MK_SIMPLE_GEMM 0
#endif
constexpr int NPH_LAYER = 14, NPH = 1 + NL * NPH_LAYER;
struct GD { const bf16* A; const bf16* Bt; void* C; const float* aux0; const bf16* aux1; int lda, M, N, K, ldc, kind; };
template <class Epi> __device__ __forceinline__ void run_gemm(const Ctx& c, const bf16* A, int lda, const bf16* Bt, int M, int N, int K, const Epi& E) {
    pg8::Gemm g{A, Bt, M, N, K, lda}; pg8::StaticOrder S; S.init(M, N, c.G, c.bid);
    pg8::gemm_phase<Epi, pg8::StaticOrder, true, true>(c.lds, g, S, E);
}
#define AS4 __attribute__((address_space(4)))
__global__ void __launch_bounds__(NTHR, 2) mega(Args a_) {
    extern __shared__ __attribute__((aligned(16))) unsigned char lds_raw[];
    {   const int t0 = threadIdx.x;
        for (int u = t0; u < (LDS_BYTES - RING_BYTES) / 4; u += NTHR) ((LAS unsigned*)((LAS unsigned char*)lds_raw + RING_BYTES))[u] = 0u; }
    __syncthreads();
    volatile LAS unsigned* MISC = (volatile LAS unsigned*)((LAS unsigned char*)lds_raw + MISC_OFF);
    XcdBarrier bar; bar.bar = (unsigned*)(a_.ws + WS_CTL) + CW_BAR; bar.x = 0; bar.st = MISC + 8;
    const int ph_lo = a_.ph_lo, ph_hi = a_.ph_hi;
    if (ph_hi - ph_lo > 1) bar = xcd_barrier_post((unsigned*)(a_.ws + WS_CTL) + CW_BAR, MISC + 8);

#if MK_PROBE
    unsigned long long* ts = (unsigned long long*)(a_.ws + WS_CTL + TS_OFF); const bool stamper = (blockIdx.x == 0 && threadIdx.x == 0);
    if (stamper) ts[0] = __builtin_amdgcn_s_memrealtime();
#endif
    int p = ph_lo;
    if (p == 0) {
        const Args AS4* ap0 = (const Args AS4*)__builtin_amdgcn_kernarg_segment_ptr(); Ctx c0; c0.lds = (LAS unsigned char*)lds_raw; c0.tid = threadIdx.x; c0.lane = c0.tid & 63; c0.wave = __builtin_amdgcn_readfirstlane(c0.tid >> 6);
        c0.G = gridDim.x; c0.bid = blockIdx.x; c0.gw = c0.wave * c0.G + c0.bid; c0.ngw = NWAVES * c0.G; c0.gt = c0.bid * NTHR + c0.tid; c0.ngt = c0.G * NTHR;
        ph_prep(*ap0, c0);
#if MK_DUP & 1
        __syncthreads(); ph_prep(*ap0, c0);
#endif
        if (p + 1 < ph_hi) xcd_barrier(bar);
        p = 1;
#if MK_PROBE
        if (stamper) ts[1] = __builtin_amdgcn_s_memrealtime();
#endif
    }
    for (; p < ph_hi; ++p) {
        const Args AS4* ap = (const Args AS4*)__builtin_amdgcn_kernarg_segment_ptr(); asm volatile("" : "+s"(ap));
        int tid_ = threadIdx.x; asm volatile("" : "+v"(tid_));
#define a (*ap)
        Ctx c; c.lds = (LAS unsigned char*)lds_raw; c.tid = tid_; c.lane = c.tid & 63; c.wave = __builtin_amdgcn_readfirstlane(c.tid >> 6);
        { int G_ = gridDim.x, bid_ = blockIdx.x; asm volatile("" : "+s"(G_), "+s"(bid_)); c.G = G_; c.bid = bid_; }
        c.gw = c.wave * c.G + c.bid; c.ngw = NWAVES * c.G; c.gt = c.bid * NTHR + c.tid; c.ngt = c.G * NTHR;
        bf16 *WINT = WSP(bf16, WS_WINT), *WUQT = WSP(bf16, WS_WUQT), *WUKVT = WSP(bf16, WS_WUKVT), *GLUT = WSP(bf16, WS_GLUT), *WOUTT = WSP(bf16, WS_WOUTT),
             *WQT = WSP(bf16, WS_WQT), *SUBKT = WSP(bf16, WS_SUBKT), *PU = WSP(bf16, WS_PU), *PV = WSP(bf16, WS_PV);
        float *COS = WSP(float, WS_COS), *SIN = WSP(float, WS_SIN);
        bf16 *XB = WSP(bf16, WS_XB), *Z = WSP(bf16, WS_Z), *QRAW = WSP(bf16, WS_QRAW), *KVRAW = WSP(bf16, WS_KVRAW), *QB = WSP(bf16, WS_QB), *KB = WSP(bf16, WS_KB),
             *VB = WSP(bf16, WS_VB), *CQN = WSP(bf16, WS_CQN), *CKVN = WSP(bf16, WS_CKVN), *AO = WSP(bf16, WS_AO), *ROUT = WSP(bf16, WS_ROUT), *Y = WSP(bf16, WS_Y),
             *YG = WSP(bf16, WS_YG), *SOUT = WSP(bf16, WS_SOUT), *QP = WSP(bf16, WS_QP);
        float *XC = WSP(float, WS_XC), *AA = WSP(float, WS_AA), *BT = WSP(float, WS_BT), *SC = WSP(float, WS_SC), *STOP = WSP(float, WS_STOP), *GATE = WSP(float, WS_GATE);
        int *ITOP = WSP(int, WS_ITOP), *IDX = WSP(int, WS_IDX);
        float* out = a.out;
        {
            const int l = (p - 1) / NPH_LAYER, k = (p - 1) % NPH_LAYER;
            const float* xin = (l == 0) ? INF(0) : out;
            GD gd; gd.kind = 0; gd.A = nullptr; gd.Bt = nullptr; gd.C = nullptr; gd.aux0 = nullptr; gd.aux1 = nullptr; gd.lda = 0; gd.M = T; gd.N = 0; gd.K = 0; gd.ldc = 0;
#define SETG(kind_, A_, lda_, Bt_, M_, N_, K_, C_, ldc_, aux0_, aux1_) do { gd.kind = kind_; gd.A = A_; gd.lda = lda_; gd.Bt = Bt_; gd.M = M_; gd.N = N_; gd.K = K_; gd.C = (void*)(C_); gd.ldc = ldc_; gd.aux0 = aux0_; gd.aux1 = aux1_; } while (0)
            switch (k) {
            case 0: ph_rowprep(c, xin, INF(2) + l * DM, XB); break;
            case 1: SETG(1, XB, DM, WINT + (size_t)l * ZW * DM, T, ZW, DM, Z, ZW, nullptr, nullptr); break;
            case 2: ph_zstats(c, Z, INF(4) + l * 256, INF(6) + l * 128, CQN, CKVN);
#if MK_SIMPLE_SCAN
                ph_lru_xc(c, Z, INF(20) + l * 1024, INF(21) + l * 256, XC);
#else
                s5f::pass<false>(c.lds, Z, WSP(bf16, WS_S5A) + (size_t)l * 32768, WSP(bf16, WS_S5C) + (size_t)l * 32768, WSP(float2, WS_S5L) + l * 1024, INF(17) + l * 256, WSP(float2, WS_SE), WSP(float2, WS_SH), YG, c.gw, c.ngw, c.wave, c.lane);
                __syncthreads();
                lruf::pass_a(c.lds, Z, INF(20) + l * 1024, INF(21) + l * 256, INF(22) + l * 16384, INF(23) + l * 256, INF(24) + l * 16384, INF(25) + l * 256, INF(26) + l * 256, AA, BT, WSP(float2, WS_LPE), c.gw, c.ngw, c.wave, c.lane);
#endif
                break;
            case 3: SETG(1, CQN, 256, WUQT + (size_t)l * 768 * 256, T, 768, 256, QRAW, 768, nullptr, nullptr);
#if !MK_SIMPLE_SCAN
                s5f::carry(WSP(float2, WS_S5L) + l * 1024, WSP(float2, WS_SE), WSP(float2, WS_SH), c.gw, c.ngw, c.lane);
                lruf::carry(WSP(float2, WS_LPE), WSP(float, WS_LH), c.gt, c.ngt);
#endif
                break;
            case 4: SETG(1, CKVN, 128, WUKVT + (size_t)l * 1024 * 128, T, 1024, 128, KVRAW, 1024, nullptr, nullptr);
#if MK_SIMPLE_SCAN
                ph_lru_gates(c, XC, INF(22) + l * 16384, INF(23) + l * 256, INF(24) + l * 16384, INF(25) + l * 256, INF(26) + l * 256, AA, BT);
#endif
                break;
            case 5: ph_qkfin(c, QRAW, KVRAW, Z, INF(8) + l * DQK, INF(9) + l * DQK, COS, SIN, QB, KB, VB); break;
            case 6:
#if MK_DUP & 2
            for (int rep_ = 0; rep_ < 2; ++rep_) {
#endif
#if MK_SIMPLE_SCAN
                ph_s5_simple(c, Z, INF(10) + l * 1024, INF(11) + l * 1024, INF(12) + l * 16, INF(13) + l * 16384, INF(14) + l * 16384, INF(15) + l * 16384, INF(16) + l * 16384, INF(17) + l * 256, YG);
                ph_lru_scan(c, AA, BT, Z, ROUT);
#else
                s5f::pass<true>(c.lds, Z, WSP(bf16, WS_S5A) + (size_t)l * 32768, WSP(bf16, WS_S5C) + (size_t)l * 32768, WSP(float2, WS_S5L) + l * 1024, INF(17) + l * 256, WSP(float2, WS_SE), WSP(float2, WS_SH), YG, c.gw, c.ngw, c.wave, c.lane);
                lruf::pass_b(AA, BT, WSP(float, WS_LH), Z, ROUT, c.gt, c.ngt);
#endif
#if MK_SIMPLE_ATTN
                ph_attn_simple(c, QB, KB, VB, AO);
#else
                __syncthreads(); att::attn_phase(c.lds, QB, KB, VB, AO, c.G, c.bid, c.tid);
#endif
#if MK_DUP & 2
            __syncthreads(); }
#endif
                break;
            case 7: SETG(3, YG, 256, GLUT + (size_t)l * 65536, T, 256, 256, SOUT, 256, INF(19) + l * 256, YG); break;
            case 8: ph_mixnorm(c, AO, SOUT, ROUT, INF(27) + l * DM, Y); break;
            case 9: SETG(2, Y, DM, WOUTT + (size_t)l * DM * DM, T, DM, DM, out, DM, xin, nullptr); break;
            case 10: ph_rowprep(c, out, INF(29) + l * DM, XB); break;
            case 11: SETG(1, XB, DM, WQT + (size_t)l * 2048 * DM, T, 2048, DM, QP, 2048, nullptr, nullptr); break;
            case 12: tk::topk_phase(QP, SUBKT + (size_t)l * 32768, IDX, GATE, c.gw, c.ngw, c.lane); break;
            default:
#if MK_DUP & 8
                pgf::gather(XB, IDX, GATE, WSP(unsigned char, WS_PU) + (size_t)l * 16384 * DM, WSP(unsigned char, WS_PV) + (size_t)l * 16384 * DM, SC, c.gw, c.ngw, c.lane);
#endif
                pgf::gather(XB, IDX, GATE, WSP(unsigned char, WS_PU) + (size_t)l * 16384 * DM, WSP(unsigned char, WS_PV) + (size_t)l * 16384 * DM, out, c.gw, c.ngw, c.lane); break;
            }
#undef SETG
#if MK_SIMPLE_GEMM
            if (gd.kind == 1) gemm_simple<EPI_BF16>(c, gd.A, gd.lda, gd.Bt, gd.M, gd.N, gd.K, gd.C, gd.ldc, nullptr, nullptr);
            else if (gd.kind == 2) { if (gd.aux0) gemm_simple<EPI_RESID>(c, gd.A, gd.lda, gd.Bt, gd.M, gd.N, gd.K, gd.C, gd.ldc, gd.aux0, nullptr); else gemm_simple<EPI_F32>(c, gd.A, gd.lda, gd.Bt, gd.M, gd.N, gd.K, gd.C, gd.ldc, nullptr, nullptr); }
            else if (gd.kind == 3) gemm_simple<EPI_GLU>(c, gd.A, gd.lda, gd.Bt, gd.M, gd.N, gd.K, gd.C, gd.ldc, gd.aux0, gd.aux1);
#else
            if (gd.kind == 1) run_gemm(c, gd.A, gd.lda, gd.Bt, gd.M, gd.N, gd.K, pg8::EpiBf16<0>{(bf16*)gd.C, gd.ldc, nullptr, 0, 0, 1.f});
            else if (gd.kind == 2) run_gemm(c, gd.A, gd.lda, gd.Bt, gd.M, gd.N, gd.K, pg8::EpiF32{(float*)gd.C, gd.ldc, gd.aux0});
            else if (gd.kind == 3) run_gemm(c, gd.A, gd.lda, gd.Bt, gd.M, gd.N, gd.K, pg8::EpiGlu{(bf16*)gd.C, gd.ldc, gd.aux0, gd.aux1});
#endif
        }
        if (p + 1 < ph_hi) { XcdBarrier b2 = bar; unsigned* bb = (unsigned*)(a.ws + WS_CTL) + CW_BAR; unsigned bx = bar.x; asm volatile("" : "+s"(bb), "+s"(bx)); b2.bar = bb; b2.x = bx; xcd_barrier(b2); }
#if MK_PROBE
        if (p + 1 == ph_hi) xcd_barrier(bar);
        if (stamper) ts[p + 1] = __builtin_amdgcn_s_memrealtime();
#endif
#undef a
    }
#if MK_PROBE
    xcd_barrier(bar);
    {   const unsigned long long* tsr = (const unsigned long long*)(a_.ws + WS_CTL + TS_OFF);
        const unsigned long long ta0 = __hip_atomic_load(tsr + PROBE_A_LO, __ATOMIC_RELAXED, __HIP_MEMORY_SCOPE_AGENT), ta1 = __hip_atomic_load(tsr + PROBE_A_HI, __ATOMIC_RELAXED, __HIP_MEMORY_SCOPE_AGENT);
        const unsigned long long tb0 = __hip_atomic_load(tsr + PROBE_B_LO, __ATOMIC_RELAXED, __HIP_MEMORY_SCOPE_AGENT), tb1 = __hip_atomic_load(tsr + PROBE_B_HI, __ATOMIC_RELAXED, __HIP_MEMORY_SCOPE_AGENT);
        const float da_us = (float)(ta1 - ta0) * 0.01f, db_us = (float)(tb1 - tb0) * 0.01f;
        const float eps = sqrtf(db_us * 1e-4f);
        float* o = a_.out;
        for (size_t i = (size_t)blockIdx.x * NTHR + threadIdx.x; i < (size_t)T * DM; i += (size_t)gridDim.x * NTHR) { float v = o[i] * (1.f + eps); if (i == 0) v += da_us * 0.1f; o[i] = v; }
    }
#endif
}

extern "C" void kernel_launch(void* const* d_in, const int* in_sizes, int n_in, void* d_out, int out_size, void* d_ws, size_t ws_size, hipStream_t stream) {
    static int grid = 0;
    if (grid == 0) {
        if (n_in != 34 || out_size != T * DM || ws_size < WS_END) { fprintf(stderr, "kernel_launch: unexpected shapes (n_in %d out %d ws %zu)\n", n_in, out_size, ws_size); grid = -1; return; }
        int dev = 0, cus = 0, per_cu = 0;
        if (hipGetDevice(&dev) != hipSuccess || hipDeviceGetAttribute(&cus, hipDeviceAttributeMultiprocessorCount, dev) != hipSuccess) { grid = -1; return; }
        if (hipFuncSetAttribute((const void*)mega, hipFuncAttributeMaxDynamicSharedMemorySize, LDS_BYTES) != hipSuccess) { fprintf(stderr, "kernel_launch: hipFuncSetAttribute failed\n"); grid = -1; return; }
        if (hipOccupancyMaxActiveBlocksPerMultiprocessor(&per_cu, (const void*)mega, NTHR, LDS_BYTES) != hipSuccess || per_cu < 1) { fprintf(stderr, "kernel_launch: occupancy query says %d blocks per CU\n", per_cu); }
        (void)hipGetLastError();
        grid = cus;
    }
    if (grid < 0) return;
    (void)hipMemsetAsync((char*)d_ws + WS_CTL, 0, CTL_ZERO_BYTES, stream);
    Args a{};
    for (int i = 0; i < 34; ++i) a.in[i] = d_in[i];
    a.out = (float*)d_out; a.ws = (unsigned char*)d_ws;
#if MK_PER_PHASE
    for (int p = 0; p < NPH; ++p) { a.ph_lo = p; a.ph_hi = p + 1; hipLaunchKernelGGL(mega, dim3(grid), dim3(NTHR), LDS_BYTES, stream, a); }
#else
    a.ph_lo = 0; a.ph_hi = NPH;
    hipLaunchKernelGGL(mega, dim3(grid), dim3(NTHR), LDS_BYTES, stream, a);
#endif
}
```

```cpp
#include <hip/hip_runtime.h>
#include <cstdint>
#include <cstdio>

#ifndef MK_PER_PHASE
#define MK_PER_PHASE 0
#endif

typedef unsigned short bf16;
typedef unsigned int u32;

constexpr int NB = 2, SEQ = 8192, T = NB * SEQ, DM = 1024, NL = 2;
constexpr int ZW = 1280;
constexpr int ZC_CQ = 0, ZC_CKV = 256, ZC_KR = 384, ZC_U = 512, ZC_X = 768, ZC_G = 1024;
constexpr int NH = 4, DQK = 192, DV = 128;
constexpr float EPS = 1e-6f;
constexpr float QSCALE = 0.07216878364870322f * 1.4426950408889634f;

constexpr size_t MiB = 1u << 20;
constexpr size_t WS_CTL = 0, CTL_ZERO_BYTES = 1 * MiB, WS_WINT = 1 * MiB, WS_WUQT = 7 * MiB, WS_WUKVT = 8 * MiB, WS_GLUT = 9 * MiB, WS_WOUTT = 10 * MiB,
                 WS_WQT = 14 * MiB, WS_SUBKT = 22 * MiB, WS_COS = 23 * MiB, WS_SIN = 25 * MiB, WS_PU = 28 * MiB, WS_PV = 92 * MiB,
                 WS_XB = 156 * MiB, WS_Z = 188 * MiB, WS_RA = 228 * MiB, WS_RB = 356 * MiB, WS_CKVN = 420 * MiB, WS_AO = 424 * MiB,
                 WS_ROUT = 440 * MiB, WS_Y = 448 * MiB, WS_IDX = 480 * MiB, WS_GATE = 488 * MiB, WS_S5A = 496 * MiB, WS_S5C = WS_S5A + 128 * 1024, WS_S5L = WS_S5A + 256 * 1024,
                 WS_SE = 497 * MiB, WS_SH = 501 * MiB, WS_LPE = 505 * MiB, WS_LH = 506 * MiB, WS_ROWSS = WS_LH + 512 * 1024, WS_END = 508 * MiB;
constexpr size_t WS_QRAW = WS_RA, WS_KVRAW = WS_RA + 24 * MiB, WS_QB = WS_RA + 56 * MiB, WS_KB = WS_RA + 80 * MiB, WS_VB = WS_RA + 104 * MiB,
                 WS_CQN = WS_RA + 120 * MiB, WS_SC = WS_RA;
constexpr size_t WS_XC = WS_RB, WS_AA = WS_RB + 16 * MiB, WS_BT = WS_RB + 32 * MiB, WS_YG = WS_RB + 48 * MiB, WS_SOUT = WS_RB + 56 * MiB, WS_QP = WS_RB;
constexpr size_t WS_STOP = WS_Z, WS_ITOP = WS_Z + 16 * MiB;
constexpr int CW_BAR = 4096;

__device__ __forceinline__ float bf2f(bf16 h) { return __uint_as_float((u32)h << 16); }
__device__ __forceinline__ bf16 f2bf(float f) { u32 u = __float_as_uint(f); return (bf16)((u + 0x7fffu + ((u >> 16) & 1u)) >> 16); }
__device__ __forceinline__ u32 pk2(float lo, float hi) { return (u32)f2bf(lo) | ((u32)f2bf(hi) << 16); }
__device__ __forceinline__ float wave_sum(float v) {
#pragma unroll
    for (int o = 32; o > 0; o >>= 1) v += __shfl_xor(v, o);
    return v;
}
__device__ __forceinline__ float wave_max(float v) {
#pragma unroll
    for (int o = 32; o > 0; o >>= 1) v = fmaxf(v, __shfl_xor(v, o));
    return v;
}
__device__ __forceinline__ float gelu_f(float x) { return 0.5f * x * (1.f + erff(x * 0.70710678118654752f)); }
__device__ __forceinline__ float sigmoid_f(float x) { return 1.f / (1.f + __expf(-x)); }
__device__ __forceinline__ void unpack8(uint4 w, float* o) {
    o[0] = __uint_as_float(w.x << 16); o[1] = __uint_as_float(w.x & 0xffff0000u);
    o[2] = __uint_as_float(w.y << 16); o[3] = __uint_as_float(w.y & 0xffff0000u);
    o[4] = __uint_as_float(w.z << 16); o[5] = __uint_as_float(w.z & 0xffff0000u);
    o[6] = __uint_as_float(w.w << 16); o[7] = __uint_as_float(w.w & 0xffff0000u);
}
__device__ __forceinline__ void sincos_acc(float x, float& s, float& c) {
    const float k = rintf(x * 0.15915494309189535f);
    float r = fmaf(-k, 6.28125f, x);
    r = fmaf(-k, 1.9350051879882812e-3f, r);
    r = fmaf(-k, 3.0199160335e-7f, r);
    const float f = r * 0.15915494309189535f;
    s = __builtin_amdgcn_sinf(f); c = __builtin_amdgcn_cosf(f);
}
namespace pg8 {
#define PG8_LAS __attribute__((address_space(3)))
typedef unsigned short bf16_t;
typedef short bf16x8 __attribute__((ext_vector_type(8)));
typedef float f32x4 __attribute__((ext_vector_type(4)));
typedef unsigned u32x4 __attribute__((ext_vector_type(4)));
constexpr int BM = 256, BK = 64, HALF = 128, HTB = HALF * BK * 2  , STAGE_BYTES = 8 * HTB, NXCD = 8, WGM = 8;

__host__ __device__ __forceinline__ int lds_byte(int r, int c) { const int st = (r >> 4) * 2 + (c >> 5), rr = r & 15, cc = c & 31, ob = rr * 64 + cc * 2; return st * 1024 + (ob ^ (((ob >> 9) & 1) << 5)); }
__host__ __device__ __forceinline__ void stage_rc(int b, int& R, int& C) { const int st = b / 1024, sb = b % 1024, swz = sb ^ (((sb >> 9) & 1) << 5); R = (st >> 1) * 16 + swz / 64; C = (st & 1) * 32 + (swz % 64) / 2; }
__host__ __device__ __forceinline__ int perm32(int rho) { const int n = rho >> 4, i = rho & 15; return 8 * (i >> 2) + 4 * n + (i & 3); }

struct Unit { int pm, pn; };
struct Gemm { const bf16_t* A; const bf16_t* Bt; int M, N, K, lda; };

struct StaticOrder {
    int nM, nN, nwg, G, c;
    __host__ __device__ void init(int M, int N, int G_, int c_) { nM = M / BM; nN = N / BM; nwg = nM * nN; G = G_; c = c_; }
    __host__ __device__ bool next(int i, Unit& u) const {
        const long L = (long)i * G + c; if (L >= nwg) return false;
        int wgid = (int)L; { const int q = nwg / NXCD, r = nwg % NXCD, xcd = wgid % NXCD, off = wgid / NXCD; wgid = (xcd < r ? xcd * (q + 1) : r * (q + 1) + (xcd - r) * q) + off; }
        const int nig = WGM * nN, gid = wgid / nig, fm = gid * WGM, gsz = (nM - fm) < WGM ? (nM - fm) : WGM;
        u.pm = fm + ((wgid % nig) % gsz); u.pn = (wgid % nig) / gsz; return true;
    }
    __device__ __forceinline__ void a_ready(const Unit&) const {}
    __device__ __forceinline__ void done(const Unit&) const {}
};

__device__ __forceinline__ unsigned cvt_pk_bf16(float lo, float hi) { unsigned r; asm volatile("v_cvt_pk_bf16_f32 %0, %1, %2" : "=v"(r) : "v"(lo), "v"(hi)); return r; }
typedef float f32x2 __attribute__((ext_vector_type(2)));
__device__ __forceinline__ f32x2 gelu_pk(f32x2 v) {
    const f32x2 av = __builtin_elementwise_abs(v), d = av * 0.2316418882f + 1.0f;
    f32x2 t; t.x = __builtin_amdgcn_rcpf(d.x); t.y = __builtin_amdgcn_rcpf(d.y);
    f32x2 q = t * 0.5307027145f + (-0.7265760135f); q = q * t + 0.7107068705f; q = q * t + (-0.142248368f); q = q * t + 0.127414796f; q = q * t;
    const f32x2 s = (v * v) * (-0.72134752044f);
    f32x2 e; e.x = __builtin_amdgcn_exp2f(s.x); e.y = __builtin_amdgcn_exp2f(s.y);
    const f32x2 m = v * (q * e), r = v - m;
    f32x2 o; o.x = v.x < 0.f ? m.x : r.x; o.y = v.y < 0.f ? m.y : r.y; return o;
}

template <int ACT  > struct EpiBf16 {
    static constexpr bool PERM = true, AFTER_DRAIN = false; static_assert(ACT == 0 || ACT == 1, "EpiBf16: ACT is 0 (none) or 1 (gelu_pk)");
    bf16_t* O; int ldc; const float* bias; int split_cols; size_t split_stride; float scale0;
    __device__ __forceinline__ void operator()(const f32x4 (&acc)[2][2][4][2], const Unit& u, int wr, int wc, int fr, int fq) const {
        const int row0 = u.pm * BM + wr * 64 + fr; int colt = u.pn * BM; bf16_t* base = O;
        float sc = 1.f; if (split_cols) { const int t = colt / split_cols; base += (size_t)t * split_stride; colt -= t * split_cols; if (t == 0) sc = scale0; }
        const int col0 = colt + wc * 32 + 8 * fq, bcol0 = u.pn * BM + wc * 32 + 8 * fq;
        f32x4 bv[2][2];
#pragma unroll
        for (int bj = 0; bj < 2; ++bj)
#pragma unroll
            for (int n = 0; n < 2; ++n) bv[bj][n] = bias ? *(const f32x4*)(bias + bcol0 + bj * HALF + 4 * n) : (f32x4){0.f, 0.f, 0.f, 0.f};
#pragma unroll
        for (int ai = 0; ai < 2; ++ai)
#pragma unroll
            for (int m = 0; m < 4; ++m) { bf16_t* rowp = base + (size_t)(row0 + ai * HALF + m * 16) * ldc + col0;
#pragma unroll
                for (int bj = 0; bj < 2; ++bj) { f32x4 v0 = acc[ai][bj][m][0] + bv[bj][0], v1 = acc[ai][bj][m][1] + bv[bj][1];
                    if (ACT == 1) { f32x2 a = gelu_pk((f32x2){v0[0], v0[1]}), b = gelu_pk((f32x2){v0[2], v0[3]}), c = gelu_pk((f32x2){v1[0], v1[1]}), d = gelu_pk((f32x2){v1[2], v1[3]});
                        v0 = (f32x4){a.x, a.y, b.x, b.y}; v1 = (f32x4){c.x, c.y, d.x, d.y}; }
                    v0 = v0 * sc; v1 = v1 * sc; u32x4 w; w.x = cvt_pk_bf16(v0[0], v0[1]); w.y = cvt_pk_bf16(v0[2], v0[3]); w.z = cvt_pk_bf16(v1[0], v1[1]); w.w = cvt_pk_bf16(v1[2], v1[3]);
                    *(u32x4*)(rowp + bj * HALF) = w; } }
    }
};


struct EpiF32 {
    static constexpr bool PERM = false, AFTER_DRAIN = false;
    float* C; int ldc; const float* resid;
    __device__ __forceinline__ void operator()(const f32x4 (&acc)[2][2][4][2], const Unit& u, int wr, int wc, int fr, int fq) const {
        const int row0 = u.pm * BM + wr * 64 + fr, col0 = u.pn * BM + wc * 32 + 4 * fq;
#pragma unroll
        for (int ai = 0; ai < 2; ++ai)
#pragma unroll
            for (int m = 0; m < 4; ++m) { const size_t rb = (size_t)(row0 + ai * HALF + m * 16) * ldc + col0;
#pragma unroll
                for (int bj = 0; bj < 2; ++bj)
#pragma unroll
                    for (int n = 0; n < 2; ++n) { const size_t ix = rb + bj * HALF + n * 16; f32x4 v = acc[ai][bj][m][n];
                        if (resid) v += *(const f32x4*)(resid + ix);
                        *(f32x4*)(C + ix) = v; } }
    }
};

struct EpiOut {
    static constexpr bool PERM = false, AFTER_DRAIN = false;
    float* C; int ldc; const float* resid; const float* g; bf16_t* XB; float* rowss;
    __device__ __forceinline__ void operator()(const f32x4 (&acc)[2][2][4][2], const Unit& u, int wr, int wc, int fr, int fq) const {
        typedef unsigned u32x2 __attribute__((ext_vector_type(2)));
        const int row0 = u.pm * BM + wr * 64 + fr, col0 = u.pn * BM + wc * 32 + 4 * fq;
#pragma unroll
        for (int ai = 0; ai < 2; ++ai)
#pragma unroll
            for (int m = 0; m < 4; ++m) { const int row = row0 + ai * HALF + m * 16; const size_t rb = (size_t)row * ldc + col0; float ss = 0.f;
#pragma unroll
                for (int bj = 0; bj < 2; ++bj)
#pragma unroll
                    for (int n = 0; n < 2; ++n) { const size_t ix = rb + bj * HALF + n * 16; const f32x4 v = acc[ai][bj][m][n] + *(const f32x4*)(resid + ix);
                        *(f32x4*)(C + ix) = v; ss += (v[0] * v[0] + v[1] * v[1]) + (v[2] * v[2] + v[3] * v[3]);
                        const f32x4 gg = *(const f32x4*)(g + col0 + bj * HALF + n * 16);
                        u32x2 w; w.x = cvt_pk_bf16(v[0] * gg[0], v[1] * gg[1]); w.y = cvt_pk_bf16(v[2] * gg[2], v[3] * gg[3]); *(u32x2*)(XB + ix) = w; }
                ss += __shfl_xor(ss, 16); ss += __shfl_xor(ss, 32);
                if (fq == 0) rowss[(size_t)row * 16 + u.pn * 4 + wc] = ss; }
    }
};
struct EpiGlu {
    static constexpr bool PERM = true, AFTER_DRAIN = false;
    bf16_t* O; int ldc; const float* bias; const bf16_t* YG;
    __device__ __forceinline__ void operator()(const f32x4 (&acc)[2][2][4][2], const Unit& u, int wr, int wc, int fr, int fq) const {
        const int row0 = u.pm * BM + wr * 64 + fr, col0 = u.pn * BM + wc * 32 + 8 * fq;
#pragma unroll
        for (int ai = 0; ai < 2; ++ai)
#pragma unroll
            for (int m = 0; m < 4; ++m) { const size_t rb = (size_t)(row0 + ai * HALF + m * 16) * ldc + col0;
#pragma unroll
                for (int bj = 0; bj < 2; ++bj) { const size_t ix = rb + bj * HALF;
                    const f32x4 b0 = *(const f32x4*)(bias + col0 + bj * HALF), b1 = *(const f32x4*)(bias + col0 + bj * HALF + 4);
                    const u32x4 yw = *(const u32x4*)(YG + ix);
                    f32x4 v0 = acc[ai][bj][m][0] + b0, v1 = acc[ai][bj][m][1] + b1; float o[8];
#pragma unroll
                    for (int e = 0; e < 4; ++e) { const unsigned w = e == 0 ? yw.x : e == 1 ? yw.y : e == 2 ? yw.z : yw.w;
                        const float y0 = __uint_as_float(w << 16), y1 = __uint_as_float(w & 0xffff0000u);
                        const float a0 = e < 2 ? v0[2 * e] : v1[2 * e - 4], a1 = e < 2 ? v0[2 * e + 1] : v1[2 * e - 3];
                        o[2 * e] = y0 / (1.f + __expf(-a0)); o[2 * e + 1] = y1 / (1.f + __expf(-a1)); }
                    u32x4 w; w.x = cvt_pk_bf16(o[0], o[1]); w.y = cvt_pk_bf16(o[2], o[3]); w.z = cvt_pk_bf16(o[4], o[5]); w.w = cvt_pk_bf16(o[6], o[7]);
                    *(u32x4*)(O + ix) = w; } }
    }
};
template <class Epi, class Sched, bool ALIGN_EPI = false, bool SP2 = false>
__device__ __forceinline__ void gemm_phase(PG8_LAS unsigned char* lds, const Gemm g, const Sched& S, const Epi& E) {
    int tid_l = threadIdx.x; asm volatile("" : "+v"(tid_l));
    const int tid = tid_l, wid = __builtin_amdgcn_readfirstlane(tid >> 6), lane = tid & 63, wr = wid >> 2, wc = wid & 3, fr = lane & 15, fq = lane >> 4;
    const int K = g.K, nt = K / BK;
    unsigned voffA[2], voffB[2];
#pragma unroll
    for (int i = 0; i < 2; ++i) { int R, C; stage_rc(tid * 16 + i * 8192, R, C); const int Rb = Epi::PERM ? ((R & ~31) + perm32(R & 31)) : R;
        voffA[i] = (unsigned)(R * g.lda + C) * 2u; voffB[i] = (unsigned)(Rb * K + C) * 2u; }
    const size_t kstep = (size_t)(BK * 2);
    const size_t hsA = (size_t)HALF * g.lda * 2, hsB = (size_t)HALF * K * 2;
    const size_t tsA = 2 * hsA, tsB = 2 * hsB;
    const unsigned ldsw = (unsigned)wid * 1024u;
    const int aoff = lds_byte(wr * 64 + fr, fq * 8), boff = lds_byte(wc * 32 + fr, fq * 8);
#define PG8_SA(b, h) (((b) * 2 + (h)) * HTB)
#define PG8_SB(b, h) ((4 + (b) * 2 + (h)) * HTB)
#define PG8_STAGE(bufoff, gbase, voff) do { _Pragma("unroll") for (int _i = 0; _i < 2; ++_i) \
        __builtin_amdgcn_global_load_lds((const unsigned*)((const char*)(gbase) + (voff)[_i]), (PG8_LAS unsigned*)(lds + (bufoff) + ldsw + _i * 8192), 16, 0, 0); } while (0)
#define PG8_LDA(dst, b, h) do { _Pragma("unroll") for (int m = 0; m < 4; ++m) _Pragma("unroll") for (int k = 0; k < 2; ++k) dst[m][k] = *(const PG8_LAS bf16x8*)(lds + PG8_SA(b, h) + aoff + m * 2048 + k * 1024); } while (0)
#define PG8_LDB(dst, b, h) do { _Pragma("unroll") for (int n = 0; n < 2; ++n) _Pragma("unroll") for (int k = 0; k < 2; ++k) dst[n][k] = *(const PG8_LAS bf16x8*)(lds + PG8_SB(b, h) + boff + n * 2048 + k * 1024); } while (0)
#define PG8_MMA(ai, bj, At, Bt) do { __builtin_amdgcn_s_setprio(1); _Pragma("unroll") for (int m = 0; m < 4; ++m) _Pragma("unroll") for (int n = 0; n < 2; ++n) _Pragma("unroll") for (int k = 0; k < 2; ++k) \
        acc[ai][bj][m][n] = __builtin_amdgcn_mfma_f32_16x16x32_bf16(Bt[n][k], At[m][k], acc[ai][bj][m][n], 0, 0, 0); __builtin_amdgcn_s_setprio(0); } while (0)
#define PG8_WAIT_V(n) asm volatile("s_waitcnt vmcnt(" #n ")" ::: "memory")
#define PG8_WAIT_L(n) asm volatile("s_waitcnt lgkmcnt(" #n ")" ::: "memory")
#define PG8_BAR __builtin_amdgcn_s_barrier()
#define PG8_SCHED __builtin_amdgcn_sched_barrier(0)
    Unit cur, nxt; int ui = 0;
    if (!S.next(0, cur)) return;
    f32x4 acc[2][2][4][2];
#pragma unroll
    for (int a = 0; a < 2; ++a)
#pragma unroll
        for (int b = 0; b < 2; ++b)
#pragma unroll
            for (int m = 0; m < 4; ++m)
#pragma unroll
                for (int n = 0; n < 2; ++n) acc[a][b][m][n] = (f32x4){0.f, 0.f, 0.f, 0.f};
    bf16x8 At[4][2], B0[2][2], B1[2][2];
    const char* cA = (const char*)g.A + (size_t)cur.pm * tsA; const char* cB = (const char*)g.Bt + (size_t)cur.pn * tsB;
    S.a_ready(cur);
    if constexpr (SP2) {
        PG8_STAGE(PG8_SB(0, 0), cB, voffB); PG8_STAGE(PG8_SB(0, 1), cB + hsB, voffB); PG8_STAGE(PG8_SA(0, 0), cA, voffA); PG8_STAGE(PG8_SA(0, 1), cA + hsA, voffA);
        if (wr == 1) PG8_BAR;
        PG8_WAIT_V(2); PG8_BAR;
        PG8_STAGE(PG8_SB(1, 0), cB + kstep, voffB); PG8_STAGE(PG8_SA(1, 0), cA + kstep, voffA); PG8_STAGE(PG8_SB(1, 1), cB + hsB + kstep, voffB);
        PG8_WAIT_V(6); PG8_BAR;
    } else {
        PG8_STAGE(PG8_SB(0, 0), cB, voffB); PG8_STAGE(PG8_SA(0, 0), cA, voffA); PG8_STAGE(PG8_SB(0, 1), cB + hsB, voffB); PG8_STAGE(PG8_SA(0, 1), cA + hsA, voffA);
        if (wr == 1) PG8_BAR;
        PG8_WAIT_V(4); PG8_BAR;
        PG8_STAGE(PG8_SB(1, 0), cB + kstep, voffB); PG8_STAGE(PG8_SA(1, 0), cA + kstep, voffA); PG8_STAGE(PG8_SB(1, 1), cB + hsB + kstep, voffB);
        PG8_WAIT_V(6); PG8_BAR;
    }
    for (;;) {
        const bool has_next = S.next(ui + 1, nxt);
        const char* nA = has_next ? (const char*)g.A + (size_t)nxt.pm * tsA : cA; const char* nB = has_next ? (const char*)g.Bt + (size_t)nxt.pn * tsB : cB;
        for (int t = 0; t < nt; t += 2) {
            const bool last = (t == nt - 2);
            const char* a1 = cA + (size_t)(t + 1) * kstep;
            const char* a2 = last ? nA : cA + (size_t)(t + 2) * kstep; const char* b2 = last ? nB : cB + (size_t)(t + 2) * kstep;
            const char* a3 = a2 + kstep; const char* b3 = b2 + kstep;
            if (last && has_next) S.a_ready(nxt);
            if constexpr (SP2) {
            PG8_LDB(B0, 0, 0); PG8_LDB(B1, 0, 1); PG8_SCHED; PG8_LDA(At, 0, 0); PG8_STAGE(PG8_SA(1, 1), a1 + hsA, voffA);
            PG8_WAIT_V(8); PG8_WAIT_L(0); PG8_BAR; PG8_MMA(0, 0, At, B0); PG8_MMA(0, 1, At, B1); PG8_BAR; PG8_SCHED;
            PG8_LDA(At, 0, 1); PG8_STAGE(PG8_SB(0, 0), b2, voffB); PG8_STAGE(PG8_SB(0, 1), b2 + hsB, voffB); PG8_STAGE(PG8_SA(0, 0), a2, voffA);
            PG8_WAIT_V(8); PG8_WAIT_L(0); PG8_BAR; PG8_MMA(1, 0, At, B0); PG8_MMA(1, 1, At, B1); PG8_BAR; PG8_SCHED;
            PG8_LDB(B0, 1, 0); PG8_LDB(B1, 1, 1); PG8_SCHED; PG8_LDA(At, 1, 0); PG8_STAGE(PG8_SA(0, 1), a2 + hsA, voffA);
            PG8_WAIT_V(8); PG8_WAIT_L(0); PG8_BAR; PG8_MMA(0, 0, At, B0); PG8_MMA(0, 1, At, B1); PG8_BAR; PG8_SCHED;
            PG8_LDA(At, 1, 1); PG8_STAGE(PG8_SB(1, 0), b3, voffB); PG8_STAGE(PG8_SB(1, 1), b3 + hsB, voffB); PG8_STAGE(PG8_SA(1, 0), a3, voffA);
            PG8_WAIT_V(8); PG8_WAIT_L(0); PG8_BAR; PG8_MMA(1, 0, At, B0); PG8_MMA(1, 1, At, B1); PG8_BAR; PG8_SCHED;
            } else {
            PG8_LDB(B0, 0, 0); PG8_SCHED; PG8_LDA(At, 0, 0); PG8_STAGE(PG8_SA(1, 1), a1 + hsA, voffA);
            PG8_WAIT_L(8); PG8_BAR; PG8_WAIT_L(0); PG8_MMA(0, 0, At, B0); PG8_BAR; PG8_SCHED;
            PG8_LDB(B1, 0, 1); PG8_STAGE(PG8_SB(0, 0), b2, voffB);
            PG8_BAR; PG8_WAIT_L(0); PG8_MMA(0, 1, At, B1); PG8_BAR;
            PG8_LDA(At, 0, 1); PG8_STAGE(PG8_SA(0, 0), a2, voffA);
            PG8_BAR; PG8_WAIT_L(0); PG8_MMA(1, 0, At, B0); PG8_BAR; PG8_SCHED;
            PG8_STAGE(PG8_SB(0, 1), b2 + hsB, voffB);
            PG8_WAIT_V(6); PG8_BAR; PG8_MMA(1, 1, At, B1); PG8_BAR;
            PG8_LDB(B0, 1, 0); PG8_SCHED; PG8_LDA(At, 1, 0); PG8_STAGE(PG8_SA(0, 1), a2 + hsA, voffA);
            PG8_WAIT_L(8); PG8_BAR; PG8_WAIT_L(0); PG8_MMA(0, 0, At, B0); PG8_BAR; PG8_SCHED;
            PG8_LDB(B1, 1, 1); PG8_STAGE(PG8_SB(1, 0), b3, voffB);
            PG8_BAR; PG8_WAIT_L(0); PG8_MMA(0, 1, At, B1); PG8_BAR;
            PG8_LDA(At, 1, 1); PG8_STAGE(PG8_SA(1, 0), a3, voffA);
            PG8_BAR; PG8_WAIT_L(0); PG8_MMA(1, 0, At, B0); PG8_BAR; PG8_SCHED;
            PG8_STAGE(PG8_SB(1, 1), b3 + hsB, voffB);
            PG8_WAIT_V(6); PG8_BAR; PG8_MMA(1, 1, At, B1); PG8_BAR;
            }
        }
        if constexpr (ALIGN_EPI) { if (wr == 0) PG8_BAR; }
        if constexpr (!Epi::AFTER_DRAIN) { E(acc, cur, wr, wc, fr, fq); S.done(cur); }
        if (!has_next) break;
#pragma unroll
        for (int a = 0; a < 2; ++a)
#pragma unroll
            for (int b = 0; b < 2; ++b)
#pragma unroll
                for (int m = 0; m < 4; ++m)
#pragma unroll
                    for (int n = 0; n < 2; ++n) acc[a][b][m][n] = (f32x4){0.f, 0.f, 0.f, 0.f};
        cur = nxt; cA = nA; cB = nB; ++ui;
        if constexpr (ALIGN_EPI) { if (wr == 1) PG8_BAR; }
    }
    PG8_WAIT_V(0);
    if constexpr (!ALIGN_EPI) { if (wr == 0) PG8_BAR; }
    PG8_BAR;
    if constexpr (Epi::AFTER_DRAIN) { E.fused(acc, cur, wr, wc, fr, fq, lds, wid, lane); S.done(cur); }
#undef PG8_SA
#undef PG8_SB
#undef PG8_STAGE
#undef PG8_LDA
#undef PG8_LDB
#undef PG8_MMA
#undef PG8_WAIT_V
#undef PG8_WAIT_L
#undef PG8_BAR
#undef PG8_SCHED
}
}
#define GAS __attribute__((address_space(1)))
#define LAS __attribute__((address_space(3)))
#define XB_TMO      128
#define XB_XCNT(j)  (256  + 64 * (j))
#define XB_XSUB(j)  (1280 + 64 * (j))
#define XB_XGEN(j)  (2304 + 64 * (j))
#define XB_TOP      3328
#define XB_TOPGEN   3392
#define XCD_BAR_WORDS 3456
#define XB_SPIN_CAP (1u << 25)
__device__ __forceinline__ unsigned xb_ld(unsigned* p)              { return __hip_atomic_load(p, __ATOMIC_RELAXED, __HIP_MEMORY_SCOPE_AGENT); }
__device__ __forceinline__ unsigned xb_add(unsigned* p, unsigned v) { return __hip_atomic_fetch_add(p, v, __ATOMIC_RELAXED, __HIP_MEMORY_SCOPE_AGENT); }
__device__ __forceinline__ unsigned xb_xcc_id() { return (unsigned)__builtin_amdgcn_s_getreg((3 << 11) | 20) & 0xFu; }
#define XB_SPIN(cond, bar) do { unsigned _sp = 0; while (cond) { __builtin_amdgcn_s_sleep(1); \
    if ((++_sp & 255u) == 0u) { if (xb_ld(&(bar)[XB_TMO])) break; if (_sp > XB_SPIN_CAP) { atomicAdd(&(bar)[XB_TMO], 1u); break; } } } } while (0)
struct XcdBarrier { unsigned* bar; unsigned x; volatile LAS unsigned* st; };
__device__ __forceinline__ XcdBarrier xcd_barrier_post(unsigned* bar, volatile LAS unsigned* st) {
    XcdBarrier b; b.bar = bar; b.x = xb_xcc_id(); b.st = st;
    if (threadIdx.x == 0) (void)xb_add(&bar[XB_XCNT(b.x)], 1u);
    return b;
}
__device__ __forceinline__ void xcd_barrier_complete(unsigned* bar, unsigned x, unsigned& nloc, unsigned& nx) {
    const unsigned G = gridDim.x * gridDim.y * gridDim.z;
    unsigned sum, cnt, mine, sp = 0u;
    for (;;) {
        sum = 0u; cnt = 0u; mine = 0u;
#pragma unroll
        for (unsigned j = 0; j < 16; ++j) { const unsigned c = xb_ld(&bar[XB_XCNT(j)]); sum += c; cnt += (c > 0u) ? 1u : 0u; mine = (j == x) ? c : mine; }
        if (sum == G) break;
        __builtin_amdgcn_s_sleep(1);
        if ((++sp & 255u) == 0u) { if (xb_ld(&bar[XB_TMO])) break; if (sp > XB_SPIN_CAP) { atomicAdd(&bar[XB_TMO], 1u); break; } }
    }
    nloc = mine > 0u ? mine : 1u; nx = cnt > 0u ? cnt : 1u;
}
__device__ __forceinline__ void xcd_barrier(const XcdBarrier& b) {
    asm volatile("s_waitcnt vmcnt(0)" ::: "memory");
    __syncthreads();
    if (threadIdx.x == 0) {
        unsigned* bar = b.bar;
        __builtin_amdgcn_s_waitcnt(0);
        unsigned nloc = b.st[0], nx = b.st[1];
        if (nloc == 0u) { xcd_barrier_complete(bar, b.x, nloc, nx); b.st[0] = nloc; b.st[1] = nx; }
        const unsigned old = xb_add(&bar[XB_XSUB(b.x)], 1u);
        const unsigned gen = old / nloc;
        if (old + 1u == (gen + 1u) * nloc) {
            __builtin_amdgcn_fence(__ATOMIC_RELEASE, "agent");
            asm volatile("s_waitcnt vmcnt(0)" ::: "memory");
            const unsigned og = xb_add(&bar[XB_TOP], 1u);
            const unsigned tg = og / nx;
            if (og + 1u == (tg + 1u) * nx) xb_add(&bar[XB_TOPGEN], 1u);
            else XB_SPIN(xb_ld(&bar[XB_TOPGEN]) == tg, bar);
            __builtin_amdgcn_fence(__ATOMIC_ACQUIRE, "agent");
            xb_add(&bar[XB_XGEN(b.x)], 1u);
            asm volatile("s_waitcnt vmcnt(0)" ::: "memory");
        } else {
            XB_SPIN(xb_ld(&bar[XB_XGEN(b.x)]) == gen, bar);
            __builtin_amdgcn_fence(__ATOMIC_ACQUIRE, "agent");
            asm volatile("s_waitcnt vmcnt(0)" ::: "memory");
        }
    }
    __syncthreads();
}
namespace s5f {
typedef short bf16x8 __attribute__((ext_vector_type(8)));
typedef float f32x4 __attribute__((ext_vector_type(4)));
typedef unsigned u32x2 __attribute__((ext_vector_type(2)));
constexpr int LC = 32, NCH = SEQ / LC, RS = 272, WBYTES = LC * RS;
__device__ __forceinline__ void build_tables(const float* a_re, const float* a_im, const float* log_dt, const float* b_re, const float* b_im, const float* c_re, const float* c_im,
                                             bf16* S5A, bf16* S5C, float2* S5L, int gt, int ngt) {
    for (int i = gt; i < 16 * 64; i += ngt) {
        const int g = i >> 6;
        const float are = a_re[i], aim = a_im[i], dt = expf(log_dt[g]);
        const float mag = expf(are * dt); float sn, cs; sincos_acc(aim * dt, sn, cs);
        const float lre = mag * cs, lim = mag * sn;
        const float xr = lre - 1.f, xi = lim, den = are * are + aim * aim;
        const float cr = (xr * are + xi * aim) / den, ci = (xi * are - xr * aim) / den;
        S5L[i] = make_float2(lre, lim);
        const int p = i & 63;
        for (int k = 0; k < 16; ++k) { const float br = b_re[i * 16 + k], bi = b_im[i * 16 + k];
            S5A[((size_t)g * 128 + 2 * p) * 16 + k] = f2bf(cr * br - ci * bi); S5A[((size_t)g * 128 + 2 * p + 1) * 16 + k] = f2bf(cr * bi + ci * br);
            S5C[((size_t)g * 16 + k) * 128 + 2 * p] = f2bf(c_re[(g * 16 + k) * 64 + p]); S5C[((size_t)g * 16 + k) * 128 + 2 * p + 1] = f2bf(-c_im[(g * 16 + k) * 64 + p]); }
    }
}
template <bool FULL> __device__ __forceinline__ void chunk(LAS unsigned char* wl, const bf16* Z, const bf16x8 (&afr)[8], const bf16x8 (&cfr)[4], float lre, float lim, float& hre, float& him,
                                                           int b, int ch, int g, int lane, const float* dsk, bf16* YG) {
    const int l15 = lane & 15, q4 = lane >> 4;
    const size_t t0 = (size_t)b * SEQ + (size_t)ch * LC;
#pragma unroll
    for (int nb = 0; nb < 2; ++nb) {
        bf16x8 ufr = bf16x8{};
        if (q4 < 2) ufr = *(const bf16x8*)(Z + (t0 + 16 * nb + l15) * ZW + ZC_U + g * 16 + 8 * q4);
#pragma unroll
        for (int mb = 0; mb < 8; ++mb) {
            f32x4 d = __builtin_amdgcn_mfma_f32_16x16x32_bf16(afr[mb], ufr, f32x4{0.f, 0.f, 0.f, 0.f}, 0, 0, 0);
            *(LAS u32x2*)(wl + (16 * nb + l15) * RS + (16 * mb + 4 * q4) * 2) = u32x2{pk2(d[0], d[1]), pk2(d[2], d[3])};
        }
    }
#pragma unroll 8
    for (int k = 0; k < LC; ++k) {
        LAS unsigned* wp = (LAS unsigned*)(wl + k * RS + 4 * lane);
        const unsigned w = *wp; const float bre = __uint_as_float(w << 16), bim = __uint_as_float(w & 0xffff0000u);
        const float nre = fmaf(lre, hre, fmaf(-lim, him, bre)), nim = fmaf(lre, him, fmaf(lim, hre, bim)); hre = nre; him = nim;
        if (FULL) *wp = pk2(hre, him);
    }
    if (FULL) {
#pragma unroll
        for (int nb = 0; nb < 2; ++nb) {
            f32x4 y = f32x4{0.f, 0.f, 0.f, 0.f};
#pragma unroll
            for (int ks = 0; ks < 4; ++ks) {
                const bf16x8 hfr = *(const LAS bf16x8*)(wl + (16 * nb + l15) * RS + (32 * ks + 8 * q4) * 2);
                y = __builtin_amdgcn_mfma_f32_16x16x32_bf16(cfr[ks], hfr, y, 0, 0, 0);
            }
            const size_t t = t0 + 16 * nb + l15; const int co = 4 * q4;
            const uint2 uw = *(const uint2*)(Z + t * ZW + ZC_U + g * 16 + co);
            const float4 dd = *(const float4*)(dsk + g * 16 + co);
            const float y0 = y[0] + dd.x * __uint_as_float(uw.x << 16), y1 = y[1] + dd.y * __uint_as_float(uw.x & 0xffff0000u),
                        y2 = y[2] + dd.z * __uint_as_float(uw.y << 16), y3 = y[3] + dd.w * __uint_as_float(uw.y & 0xffff0000u);
            *(uint2*)(YG + t * 256 + g * 16 + co) = make_uint2(pk2(gelu_f(y0), gelu_f(y1)), pk2(gelu_f(y2), gelu_f(y3)));
        }
    }
}
template <bool FULL> __device__ __forceinline__ void pass(LAS unsigned char* lds, const bf16* Z, const bf16* S5A, const bf16* S5C, const float2* S5L, const float* dsk,
                                                          float2* SE, const float2* SH, bf16* YG, int gw, int ngw, int wave, int lane) {
    LAS unsigned char* wl = lds + wave * WBYTES;
    const int g = gw & 15, l15 = lane & 15, q4 = lane >> 4;
    bf16x8 afr[8], cfr[4];
#pragma unroll
    for (int mb = 0; mb < 8; ++mb) { afr[mb] = bf16x8{}; if (q4 < 2) afr[mb] = *(const bf16x8*)(S5A + ((size_t)g * 128 + 16 * mb + l15) * 16 + 8 * q4); }
#pragma unroll
    for (int ks = 0; ks < 4; ++ks) { cfr[ks] = bf16x8{}; if (FULL) cfr[ks] = *(const bf16x8*)(S5C + ((size_t)g * 16 + l15) * 128 + 32 * ks + 8 * q4); }
    const float2 lam = S5L[g * 64 + lane];
    for (int it = gw >> 4; it < NB * NCH; it += ngw >> 4) {
        const int b = it / NCH, ch = it % NCH;
        float hre = 0.f, him = 0.f;
        if (FULL) { const float2 h0 = SH[((size_t)it * 16 + g) * 64 + lane]; hre = h0.x; him = h0.y; }
        chunk<FULL>(wl, Z, afr, cfr, lam.x, lam.y, hre, him, b, ch, g, lane, dsk, YG);
        if (!FULL) SE[((size_t)it * 16 + g) * 64 + lane] = make_float2(hre, him);
    }
}
__device__ __forceinline__ void carry_wg(LAS unsigned char* lds, const float2* S5L, const float2* SE, float2* SH, int item, int wave, int lane) {
    typedef float f32x2v __attribute__((ext_vector_type(2)));
    LAS f32x2v* tot = (LAS f32x2v*)lds;
    const int b = item >> 4, g = item & 15;
    float2 L = S5L[g * 64 + lane];
#pragma unroll
    for (int i = 0; i < 5; ++i) { const float re = L.x * L.x - L.y * L.y, im = 2.f * L.x * L.y; L.x = re; L.y = im; }
    float hre = 0.f, him = 0.f;
    const size_t base = (((size_t)b * NCH + 32 * wave) * 16 + g) * 64 + lane;
    float2 e[32];
#pragma unroll
    for (int c = 0; c < 32; ++c) e[c] = SE[base + (size_t)c * 1024];
#pragma unroll
    for (int c = 0; c < 32; ++c) { const float nre = L.x * hre - L.y * him + e[c].x, nim = L.x * him + L.y * hre + e[c].y; e[c] = make_float2(hre, him); hre = nre; him = nim; }
    tot[wave * 64 + lane] = f32x2v{hre, him};
    float2 LS = L;
#pragma unroll
    for (int i = 0; i < 5; ++i) { const float re = LS.x * LS.x - LS.y * LS.y, im = 2.f * LS.x * LS.y; LS.x = re; LS.y = im; }
    __syncthreads();
    float cre = 0.f, cim = 0.f;
    for (int w = 0; w < wave; ++w) { const f32x2v s = tot[w * 64 + lane]; const float nre = LS.x * cre - LS.y * cim + s.x, nim = LS.x * cim + LS.y * cre + s.y; cre = nre; cim = nim; }
#pragma unroll
    for (int c = 0; c < 32; ++c) { SH[base + (size_t)c * 1024] = make_float2(e[c].x + cre, e[c].y + cim); const float nre = L.x * cre - L.y * cim, nim = L.x * cim + L.y * cre; cre = nre; cim = nim; }
    __syncthreads();
}
}
namespace lruf {
typedef float f32x4 __attribute__((ext_vector_type(4)));
constexpr int LC = 32, NCH = SEQ / LC, XS = 68;
__device__ __forceinline__ void pass_a(LAS unsigned char* lds, const bf16* Z, const float* cw, const float* cb, const float* wa, const float* ba, const float* wx, const float* bx, const float* lam,
                                       float* AA, float* BT, float2* LPE, int gw, int ngw, int wave, int lane) {
    LAS float* xt = (LAS float*)lds + wave * (LC * XS);
    for (int item = gw; item < NB * NCH * 4; item += ngw) {
        const int h = item & 3, bc = item >> 2, b = bc / NCH, ch = bc % NCH, c = h * 64 + lane;
        const size_t t0 = (size_t)b * SEQ + (size_t)ch * LC;
        const float w0 = cw[c], w1 = cw[256 + c], w2 = cw[512 + c], w3 = cw[768 + c], bias = cb[c];
        float z0 = 0.f, z1 = 0.f, z2 = 0.f;
        if (ch > 0) { z0 = bf2f(Z[(t0 - 3) * ZW + ZC_X + c]); z1 = bf2f(Z[(t0 - 2) * ZW + ZC_X + c]); z2 = bf2f(Z[(t0 - 1) * ZW + ZC_X + c]); }
        float xc[LC];
#pragma unroll
        for (int k = 0; k < LC; ++k) { const float z3 = bf2f(Z[(t0 + k) * ZW + ZC_X + c]); xc[k] = bias + w0 * z0 + w1 * z1 + w2 * z2 + w3 * z3; z0 = z1; z1 = z2; z2 = z3; xt[k * XS + lane] = xc[k]; }
        float ra[LC], rx[LC];
        { const float b0 = ba[c], b1 = bx[c];
#pragma unroll
          for (int k = 0; k < LC; ++k) { ra[k] = b0; rx[k] = b1; } }
        const float* wap = wa + (size_t)h * 4096 + lane; const float* wxp = wx + (size_t)h * 4096 + lane;
        for (int i = 0; i < 64; i += 4) {
            const float a0 = wap[(i + 0) * 64], a1 = wap[(i + 1) * 64], a2 = wap[(i + 2) * 64], a3 = wap[(i + 3) * 64];
            const float x0 = wxp[(i + 0) * 64], x1 = wxp[(i + 1) * 64], x2 = wxp[(i + 2) * 64], x3 = wxp[(i + 3) * 64];
#pragma unroll
            for (int k = 0; k < LC; ++k) { const f32x4 v = *(const LAS f32x4*)(xt + k * XS + i);
                ra[k] += v.x * a0 + v.y * a1 + v.z * a2 + v.w * a3; rx[k] += v.x * x0 + v.y * x1 + v.z * x2 + v.w * x3; }
        }
        const float lsg8 = -8.f * log1pf(expf(-lam[c]));
        float hloc = 0.f, prod = 1.f;
#pragma unroll
        for (int k = 0; k < LC; ++k) {
            const float r = sigmoid_f(ra[k]), ig = sigmoid_f(rx[k]);
            const float la = r * lsg8, av = expf(la), bt = sqrtf(-expm1f(2.f * la)) * (ig * xc[k]);
            AA[(t0 + k) * 256 + c] = av; BT[(t0 + k) * 256 + c] = bt;
            hloc = av * hloc + bt; prod *= av;
        }
        LPE[(size_t)bc * 256 + c] = make_float2(prod, hloc);
    }
}
__device__ __forceinline__ void carry_wg(LAS unsigned char* lds, const float2* LPE, float* LH, int item, int wave, int lane) {
    typedef float f32x2v __attribute__((ext_vector_type(2)));
    LAS f32x2v* tot = (LAS f32x2v*)lds;
    const int b = item >> 2, ch = (item & 3) * 64 + lane;
    const size_t base = ((size_t)b * NCH + 32 * wave) * 256 + ch;
    float2 pe[32];
#pragma unroll
    for (int c = 0; c < 32; ++c) pe[c] = LPE[base + (size_t)c * 256];
    float h = 0.f, prod = 1.f;
#pragma unroll
    for (int c = 0; c < 32; ++c) { const float p = pe[c].x, e = pe[c].y; pe[c] = make_float2(prod, h); h = p * h + e; prod *= p; }
    tot[wave * 64 + lane] = f32x2v{prod, h};
    __syncthreads();
    float cin = 0.f;
    for (int w = 0; w < wave; ++w) { const f32x2v s = tot[w * 64 + lane]; cin = s.x * cin + s.y; }
#pragma unroll
    for (int c = 0; c < 32; ++c) LH[base + (size_t)c * 256] = pe[c].y + pe[c].x * cin;
    __syncthreads();
}
__device__ __forceinline__ void pass_b(const float* AA, const float* BT, const float* LH, const bf16* Z, bf16* ROUT, int gt, int ngt) {
    for (int i = gt; i < NB * NCH * 256; i += ngt) { const int c = i & 255, bc = i >> 8; const size_t t0 = (size_t)bc * LC;
        float h = LH[i];
#pragma unroll 8
        for (int k = 0; k < LC; ++k) { const size_t t = t0 + k;
            h = AA[t * 256 + c] * h + BT[t * 256 + c];
            ROUT[t * 256 + c] = f2bf(h * gelu_f(bf2f(Z[t * ZW + ZC_G + c]))); } }
}
}
namespace pgf {
typedef float f32x2 __attribute__((ext_vector_type(2)));
typedef unsigned u32x4 __attribute__((ext_vector_type(4)));
constexpr float USCALE = 64.f, VSCALE = 4.f;
__device__ __forceinline__ unsigned pack4_fp8(float a, float b, float c, float d) {
    int w = __builtin_amdgcn_cvt_pk_fp8_f32(a, b, 0, false); w = __builtin_amdgcn_cvt_pk_fp8_f32(c, d, w, true); return (unsigned)w; }
__device__ __forceinline__ void unpack16(const u32x4 w, float* o) {
#pragma unroll
    for (int d = 0; d < 4; ++d) { const f32x2 lo = __builtin_amdgcn_cvt_pk_f32_fp8((int)w[d], false), hi = __builtin_amdgcn_cvt_pk_f32_fp8((int)w[d], true);
        o[4 * d] = lo.x; o[4 * d + 1] = lo.y; o[4 * d + 2] = hi.x; o[4 * d + 3] = hi.y; }
}
__device__ __forceinline__ void convert(const float* in, unsigned char* out8, size_t n, float scale, int gt, int ngt) {
    const size_t n16 = n / 16;
    for (size_t i = gt; i < n16; i += ngt) {
        const float4* p = (const float4*)(in + i * 16);
        const float4 a = p[0], b = p[1], c = p[2], d = p[3];
        u32x4 w; w.x = pack4_fp8(a.x * scale, a.y * scale, a.z * scale, a.w * scale); w.y = pack4_fp8(b.x * scale, b.y * scale, b.z * scale, b.w * scale);
        w.z = pack4_fp8(c.x * scale, c.y * scale, c.z * scale, c.w * scale); w.w = pack4_fp8(d.x * scale, d.y * scale, d.z * scale, d.w * scale);
        *(u32x4*)(out8 + i * 16) = w;
    }
}
template <int EMASK = 0x3fff, bool LOADONLY = false> __device__ __forceinline__ void gather(const bf16* HN, const int* IDX, const float* GATE, const unsigned char* PU8, const unsigned char* PV8, float* X, int gw, int ngw, int lane) {
    for (int t = gw; t < T; t += ngw) {
        float hn[16]; unpack8(*(const uint4*)(HN + (size_t)t * DM + 16 * lane), hn); unpack8(*(const uint4*)(HN + (size_t)t * DM + 16 * lane + 8), hn + 8);
        const int id0 = IDX[(size_t)t * 128 + lane], id1 = IDX[(size_t)t * 128 + 64 + lane];
        const float g0 = GATE[(size_t)t * 128 + lane], g1 = GATE[(size_t)t * 128 + 64 + lane];
        float y[16];
#pragma unroll
        for (int e = 0; e < 16; ++e) y[e] = 0.f;
        for (int kb = 0; kb < 128; kb += 4) {
            int eid[4]; float gt4[4]; u32x4 uw[4], vw[4];
#pragma unroll
            for (int q = 0; q < 4; ++q) { const int k = kb + q;
                eid[q] = __builtin_amdgcn_readlane(k < 64 ? id0 : id1, k & 63) & EMASK; gt4[q] = __builtin_bit_cast(float, __builtin_amdgcn_readlane(__builtin_bit_cast(int, k < 64 ? g0 : g1), k & 63)); }
#pragma unroll
            for (int q = 0; q < 4; ++q) { uw[q] = *(const u32x4*)(PU8 + (size_t)eid[q] * DM + 16 * lane); vw[q] = *(const u32x4*)(PV8 + (size_t)eid[q] * DM + 16 * lane); }
            if (LOADONLY) {
#pragma unroll
                for (int q = 0; q < 4; ++q) { y[0] += __uint_as_float((uw[q][0] ^ vw[q][1]) & 0x3f800000u); y[1] += __uint_as_float((uw[q][2] ^ vw[q][3]) & 0x3f800000u); y[2] += __uint_as_float((uw[q][1] ^ vw[q][0] ^ uw[q][3] ^ vw[q][2]) & 0x3f800000u); }
            } else
#pragma unroll
            for (int q = 0; q < 4; ++q) {
                float u[16]; unpack16(uw[q], u);
                float d0 = 0.f, d1 = 0.f;
#pragma unroll
                for (int e = 0; e < 16; e += 2) { d0 = fmaf(u[e], hn[e], d0); d1 = fmaf(u[e + 1], hn[e + 1], d1); }
                const float d = wave_sum(d0 + d1) * (1.f / USCALE);
                const float w = gt4[q] * gelu_f(d) * (1.f / VSCALE);
                float v[16]; unpack16(vw[q], v);
#pragma unroll
                for (int e = 0; e < 16; ++e) y[e] = fmaf(w, v[e], y[e]);
            }
        }
        float4* xo = (float4*)(X + (size_t)t * DM + 16 * lane);
#pragma unroll
        for (int q = 0; q < 4; ++q) { float4 p = xo[q]; p.x += y[4 * q]; p.y += y[4 * q + 1]; p.z += y[4 * q + 2]; p.w += y[4 * q + 3]; xo[q] = p; }
    }
}
}
namespace tk {
__device__ __forceinline__ float row_rstd(const float* ROWSS, size_t t) { const float4* p = (const float4*)(ROWSS + t * 16); const float4 a = p[0], b = p[1], c = p[2], d = p[3];
    const float s = (((a.x + a.y) + (a.z + a.w)) + ((b.x + b.y) + (b.z + b.w))) + (((c.x + c.y) + (c.z + c.w)) + ((d.x + d.y) + (d.z + d.w))); return rsqrtf(s * (1.f / DM) + EPS); }
typedef short bf16x8 __attribute__((ext_vector_type(8)));
typedef float f32x4 __attribute__((ext_vector_type(4)));
__device__ const unsigned char PAIR_TAB[64] = {
    0x00,0x01,0x02,0x03,0x04,0x05,0x06,0x07,0x08,0x09,0x0a,0x0b,0x0c,0x0d,0x0e,0x0f, 0x10,0x11,0x12,0x13,0x14,0x15,0x16,0x17, 0x20,0x21,0x22,0x23,0x24, 0x30,0x31,0x32,0x33,
    0x40,0x41,0x42, 0x50,0x51, 0x60,0x61, 0x70,0x71, 0x80,0x90,0xa0,0xb0,0xc0,0xd0,0xe0,0xf0, 0,0,0,0,0,0,0,0,0,0,0,0,0,0};
template <int CTRL> __device__ __forceinline__ float dppf(float v) { return __builtin_bit_cast(float, __builtin_amdgcn_update_dpp(0, __builtin_bit_cast(int, v), CTRL, 0xf, 0xf, true)); }
__device__ __forceinline__ float rmax16(float v) { v = fmaxf(v, dppf<0xB1>(v)); v = fmaxf(v, dppf<0x4E>(v)); v = fmaxf(v, dppf<0x141>(v)); v = fmaxf(v, dppf<0x140>(v)); return v; }
__device__ __forceinline__ float rsum16(float v) { v += dppf<0xB1>(v); v += dppf<0x4E>(v); v += dppf<0x141>(v); v += dppf<0x140>(v); return v; }
#define TK_CX(a, b) do { const float hi_ = fmaxf(a, b), lo_ = fminf(a, b); a = hi_; b = lo_; } while (0)
__device__ __forceinline__ float packkey(float v, unsigned id, unsigned mask) { return __uint_as_float((__float_as_uint(v) & ~mask) | id); }
__device__ __forceinline__ void select16(float (&k)[4][8], float (&top)[4], int l15) {
    const float NEG = -__builtin_inff();
#pragma unroll
    for (int r = 0; r < 4; ++r) {
        TK_CX(k[r][0], k[r][1]); TK_CX(k[r][2], k[r][3]); TK_CX(k[r][4], k[r][5]); TK_CX(k[r][6], k[r][7]);
        TK_CX(k[r][0], k[r][2]); TK_CX(k[r][1], k[r][3]); TK_CX(k[r][4], k[r][6]); TK_CX(k[r][5], k[r][7]);
        TK_CX(k[r][1], k[r][2]); TK_CX(k[r][5], k[r][6]);
        TK_CX(k[r][0], k[r][4]); TK_CX(k[r][1], k[r][5]); TK_CX(k[r][2], k[r][6]); TK_CX(k[r][3], k[r][7]);
        TK_CX(k[r][2], k[r][4]); TK_CX(k[r][3], k[r][5]);
        TK_CX(k[r][1], k[r][2]); TK_CX(k[r][3], k[r][4]); TK_CX(k[r][5], k[r][6]);
        top[r] = NEG;
    }
#pragma unroll
    for (int i = 0; i < 16; ++i)
#pragma unroll
        for (int r = 0; r < 4; ++r) {
            const float w = rmax16(k[r][0]);
            if (l15 == i) top[r] = w;
            if (k[r][0] == w) {
#pragma unroll
                for (int e = 0; e < 7; ++e) k[r][e] = k[r][e + 1];
                k[r][7] = NEG; }
        }
}
template <bool FUSE> __device__ __forceinline__ void topk_phase(const bf16* QP, const bf16* SUBKB, int* IDX, float* GATE, bf16* HN, const unsigned char* PU8, const unsigned char* PV8, float* X, const float* ROWSS, const float* gnext, int gw, int ngw, int lane) {
    const float NEG = -__builtin_inff();
    const int l15 = lane & 15, q4 = lane >> 4, gbase = 16 * q4;
    unsigned pcs[4];
#pragma unroll
    for (int j = 0; j < 4; ++j) pcs[j] = PAIR_TAB[l15 + 16 * j];
    for (int item = gw; item < T * 8 / 16; item += ngw) {
        const size_t R0 = (size_t)item * 16;
        const float rstd_g = row_rstd(ROWSS, (size_t)item * 2 + (q4 >> 1));
        const bf16* qrow = QP + (R0 + l15) * 256 + 8 * q4;
        float topA[4], topB[4];
#pragma unroll
        for (int p = 0; p < 2; ++p) {
            f32x4 acc[8];
#pragma unroll
            for (int nb = 0; nb < 8; ++nb) acc[nb] = f32x4{0.f, 0.f, 0.f, 0.f};
#pragma unroll 1
            for (int ks = 0; ks < 4; ++ks) {
                const bf16x8 afr = *(const bf16x8*)(qrow + p * 128 + 32 * ks);
#pragma unroll
                for (int nb = 0; nb < 8; ++nb) {
                    const bf16x8 bfr = *(const bf16x8*)(SUBKB + ((size_t)(p * 128 + 16 * nb + l15) * 128 + 32 * ks + 8 * q4));
                    acc[nb] = __builtin_amdgcn_mfma_f32_16x16x32_bf16(afr, bfr, acc[nb], 0, 0, 0);
                }
            }
            float k[4][8];
#pragma unroll
            for (int r = 0; r < 4; ++r)
#pragma unroll
                for (int nb = 0; nb < 8; ++nb) k[r][nb] = packkey(acc[nb][r], (unsigned)(16 * nb + l15), 127u);
            if (p == 0) select16(k, topA, l15); else select16(k, topB, l15);
        }
        float c[4][4];
#pragma unroll
        for (int r = 0; r < 4; ++r) {
#pragma unroll
            for (int j = 0; j < 4; ++j) {
                const float s0 = __shfl(topA[r], gbase + (int)(pcs[j] >> 4)), s1 = __shfl(topB[r], gbase + (int)(pcs[j] & 15));
                c[r][j] = (l15 + 16 * j < 50) ? packkey(s0 + s1, (unsigned)(l15 + 16 * j), 63u) : NEG;
            }
            TK_CX(c[r][0], c[r][1]); TK_CX(c[r][2], c[r][3]); TK_CX(c[r][0], c[r][2]); TK_CX(c[r][1], c[r][3]); TK_CX(c[r][1], c[r][2]);
        }
        float win[4], w0[4];
#pragma unroll
        for (int r = 0; r < 4; ++r) { win[r] = NEG; w0[r] = 0.f; }
#pragma unroll
        for (int i = 0; i < 16; ++i)
#pragma unroll
            for (int r = 0; r < 4; ++r) {
                const float w = rmax16(c[r][0]);
                if (i == 0) w0[r] = w;
                if (l15 == i) win[r] = w;
                if (c[r][0] == w) { c[r][0] = c[r][1]; c[r][1] = c[r][2]; c[r][2] = c[r][3]; c[r][3] = NEG; }
            }
        int idr[4]; float gtr[4];
#pragma unroll
        for (int r = 0; r < 4; ++r) {
            const unsigned pcw = PAIR_TAB[__float_as_uint(win[r]) & 63u];
            const int i0 = (int)(__float_as_uint(__shfl(topA[r], gbase + (int)(pcw >> 4))) & 127u), i1 = (int)(__float_as_uint(__shfl(topB[r], gbase + (int)(pcw & 15))) & 127u);
            const float e = __expf((win[r] - w0[r]) * rstd_g); const float sum = rsum16(e);
            idr[r] = i0 * 128 + i1; gtr[r] = e / sum;
            if (!FUSE) { const size_t row = R0 + 4 * q4 + r; IDX[row * 16 + l15] = idr[r]; GATE[row * 16 + l15] = gtr[r]; }
        }
        if (FUSE) {
#pragma unroll 1
            for (int tau = 0; tau < 2; ++tau) {
                const size_t t = (size_t)item * 2 + tau;
                const float rstd_t = row_rstd(ROWSS, t);
                float hn[16]; unpack8(*(const uint4*)(HN + t * DM + 16 * lane), hn); unpack8(*(const uint4*)(HN + t * DM + 16 * lane + 8), hn + 8);
                float y[16];
#pragma unroll
                for (int e = 0; e < 16; ++e) y[e] = 0.f;
#pragma unroll
                for (int r = 0; r < 4; ++r) {
#pragma unroll 1
                    for (int kb = 0; kb < 32; kb += 4) {
                        int eid[4]; float gt4[4]; pgf::u32x4 uw[4], vw[4];
#pragma unroll
                        for (int q = 0; q < 4; ++q) { const int src = 32 * tau + kb + q;
                            eid[q] = __builtin_amdgcn_readlane(idr[r], src); gt4[q] = __builtin_bit_cast(float, __builtin_amdgcn_readlane(__builtin_bit_cast(int, gtr[r]), src)); }
#pragma unroll
                        for (int q = 0; q < 4; ++q) { uw[q] = *(const pgf::u32x4*)(PU8 + (size_t)eid[q] * DM + 16 * lane); vw[q] = *(const pgf::u32x4*)(PV8 + (size_t)eid[q] * DM + 16 * lane); }
#pragma unroll
                        for (int q = 0; q < 4; ++q) {
                            float u[16]; pgf::unpack16(uw[q], u);
                            float d0 = 0.f, d1 = 0.f;
#pragma unroll
                            for (int e = 0; e < 16; e += 2) { d0 = fmaf(u[e], hn[e], d0); d1 = fmaf(u[e + 1], hn[e + 1], d1); }
                            const float d = wave_sum(d0 + d1) * (rstd_t * (1.f / pgf::USCALE));
                            const float w = gt4[q] * gelu_f(d) * (1.f / pgf::VSCALE);
                            float v[16]; pgf::unpack16(vw[q], v);
#pragma unroll
                            for (int e = 0; e < 16; ++e) y[e] = fmaf(w, v[e], y[e]);
                        }
                    }
                }
                float4* xo = (float4*)(X + t * DM + 16 * lane);
                float ssn = 0.f;
#pragma unroll
                for (int q = 0; q < 4; ++q) { float4 pp = xo[q]; pp.x += y[4 * q]; pp.y += y[4 * q + 1]; pp.z += y[4 * q + 2]; pp.w += y[4 * q + 3]; xo[q] = pp;
                    y[4 * q] = pp.x; y[4 * q + 1] = pp.y; y[4 * q + 2] = pp.z; y[4 * q + 3] = pp.w; ssn += (pp.x * pp.x + pp.y * pp.y) + (pp.z * pp.z + pp.w * pp.w); }
                if (gnext) {
                    const float rn = rsqrtf(wave_sum(ssn) * (1.f / DM) + EPS); const float4* gp = (const float4*)(gnext + 16 * lane);
                    uint4 o0, o1; float4 ga = gp[0], gb = gp[1], gc = gp[2], gd4 = gp[3];
                    o0.x = pk2(y[0] * rn * ga.x, y[1] * rn * ga.y); o0.y = pk2(y[2] * rn * ga.z, y[3] * rn * ga.w); o0.z = pk2(y[4] * rn * gb.x, y[5] * rn * gb.y); o0.w = pk2(y[6] * rn * gb.z, y[7] * rn * gb.w);
                    o1.x = pk2(y[8] * rn * gc.x, y[9] * rn * gc.y); o1.y = pk2(y[10] * rn * gc.z, y[11] * rn * gc.w); o1.z = pk2(y[12] * rn * gd4.x, y[13] * rn * gd4.y); o1.w = pk2(y[14] * rn * gd4.z, y[15] * rn * gd4.w);
                    *(uint4*)(HN + t * DM + 16 * lane) = o0; *(uint4*)(HN + t * DM + 16 * lane + 8) = o1;
                }
            }
        }
    }
}
#undef TK_CX
}
constexpr int NWAVES = 8, NTHR = 512;
constexpr int RING_BYTES = 131072, MISC_OFF = RING_BYTES + 320, LDS_BYTES = 147456;
struct Args { const void* in[34]; float* out; unsigned char* ws; int ph_lo, ph_hi; };
struct Ctx { LAS unsigned char* lds; int tid, lane, wave, G, bid, gw, ngw, gt, ngt; };
#define INF(i) ((const float*)a.in[i])
#define WSP(T_, off) ((T_*)(a.ws + (off)))

__device__ __forceinline__ void ph_rowprep(const Ctx& c, const float* x, const float* gain, bf16* XB);
__device__ __forceinline__ void prep_tile(const float* W, int K, int N, bf16* WT, int Nout, int mapmode, int item, LAS float* tile, int t256) {
    const int nbn = Nout / 32, kb = item / nbn, nb = item % nbn, n0 = nb * 32, k0 = kb * 32, tx = t256 & 31, ty = t256 >> 5;
    for (int i = ty; i < 32; i += 8) {
        const int n = n0 + tx; int src = n;
        if (mapmode == 1) { if (n < 448) src = n; else if (n < 512) src = -1; else src = n - 64; }
        tile[i * 33 + tx] = (src >= 0 && src < N) ? W[(size_t)(k0 + i) * N + src] : 0.f;
    }
    __syncthreads();
    for (int i = ty; i < 32; i += 8) WT[(size_t)(n0 + i) * K + k0 + tx] = f2bf(tile[tx * 33 + i]);
    __syncthreads();
}
template <class ArgsRef> __device__ __forceinline__ void ph_prep(const ArgsRef& a, const Ctx& c) {
    const int sub = c.tid >> 8, t256 = c.tid & 255; LAS float* tile = (LAS float*)c.lds + sub * (32 * 33);
    constexpr int NT0 = 1280, NT1 = 192, NT2 = 128, NT3 = 64, NT4 = 1024, NT5 = 2048, NTL = NT0 + NT1 + NT2 + NT3 + NT4 + NT5, NTOT = NL * NTL;
    const int nsb = c.G * 2;
    for (int it0 = c.bid * 2; it0 < NTOT; it0 += nsb) {
        int it = it0 + sub; if (it >= NTOT) it = NTOT - 1;
        const int l = it / NTL; int r = it % NTL;
        if (r < NT0) prep_tile(INF(3) + (size_t)l * DM * 1216, DM, 1216, WSP(bf16, WS_WINT) + (size_t)l * ZW * DM, ZW, 1, r, tile, t256);
        else if ((r -= NT0) < NT1) prep_tile(INF(5) + (size_t)l * 256 * 768, 256, 768, WSP(bf16, WS_WUQT) + (size_t)l * 768 * 256, 768, 0, r, tile, t256);
        else if ((r -= NT1) < NT2) prep_tile(INF(7) + (size_t)l * 128 * 1024, 128, 1024, WSP(bf16, WS_WUKVT) + (size_t)l * 1024 * 128, 1024, 0, r, tile, t256);
        else if ((r -= NT2) < NT3) prep_tile(INF(18) + (size_t)l * 65536, 256, 256, WSP(bf16, WS_GLUT) + (size_t)l * 65536, 256, 0, r, tile, t256);
        else if ((r -= NT3) < NT4) prep_tile(INF(28) + (size_t)l * DM * DM, DM, DM, WSP(bf16, WS_WOUTT) + (size_t)l * DM * DM, DM, 0, r, tile, t256);
        else { r -= NT4; prep_tile(INF(30) + (size_t)l * DM * 2048, DM, 2048, WSP(bf16, WS_WQT) + (size_t)l * 2048 * DM, 2048, 0, r, tile, t256); }
    }
    for (int i = c.gt; i < NL * 32768; i += c.ngt) WSP(bf16, WS_SUBKT)[i] = f2bf(INF(31)[i]);
    pgf::convert((const float*)a.in[32], WSP(unsigned char, WS_PU), (size_t)NL * 16384 * DM, pgf::USCALE, c.gt, c.ngt);
    pgf::convert((const float*)a.in[33], WSP(unsigned char, WS_PV), (size_t)NL * 16384 * DM, pgf::VSCALE, c.gt, c.ngt);
    for (int i = c.gt; i < T * 32; i += c.ngt) { const int t = i >> 5, j = i & 31;
        const float freq = exp2f(-(float)j * 0.41524101186092033f);
        const float ang = (float)((const int*)a.in[1])[t] * freq; float s, cs; sincos_acc(ang, s, cs);
        WSP(float, WS_COS)[i] = cs; WSP(float, WS_SIN)[i] = s; }
    for (int l = 0; l < NL; ++l)
        s5f::build_tables(INF(10) + l * 1024, INF(11) + l * 1024, INF(12) + l * 16, INF(13) + l * 16384, INF(14) + l * 16384, INF(15) + l * 16384, INF(16) + l * 16384,
                          WSP(bf16, WS_S5A) + (size_t)l * 32768, WSP(bf16, WS_S5C) + (size_t)l * 32768, WSP(float2, WS_S5L) + l * 1024, c.gt, c.ngt);
    ph_rowprep(c, INF(0), INF(2), WSP(bf16, WS_XB));
}

__device__ __forceinline__ void ph_rowprep(const Ctx& c, const float* x, const float* gain, bf16* XB) {
    for (int row = c.gw; row < T; row += c.ngw) {
        const float4* xr = (const float4*)(x + (size_t)row * DM) + c.lane;
        float4 v[4]; float ss = 0.f;
#pragma unroll
        for (int j = 0; j < 4; ++j) { v[j] = xr[64 * j]; ss += v[j].x * v[j].x + v[j].y * v[j].y + v[j].z * v[j].z + v[j].w * v[j].w; }
        const float rstd = rsqrtf(wave_sum(ss) * (1.f / DM) + EPS);
        uint2* o = (uint2*)(XB + (size_t)row * DM) + c.lane;
#pragma unroll
        for (int j = 0; j < 4; ++j) { const float4 g = ((const float4*)gain)[c.lane + 64 * j];
            o[64 * j] = make_uint2(pk2(v[j].x * rstd * g.x, v[j].y * rstd * g.y), pk2(v[j].z * rstd * g.z, v[j].w * rstd * g.w)); }
    }
}

enum { EPI_BF16 = 0, EPI_F32 = 1, EPI_GLU = 2, EPI_RESID = 3 };
template <int EPI> __device__ __forceinline__ void gemm_simple(const Ctx& c, const bf16* A, int lda, const bf16* Bt, int M, int N, int K, void* C, int ldc, const float* aux0, const bf16* aux1) {
    LAS float* As = (LAS float*)c.lds; LAS float* Bs = As + 16 * 132;
    const int tid = c.tid, tx = tid & 15, ty = tid >> 4, nN = N / 64, ntile = (M / 128) * nN;
    for (int tile = c.bid; tile < ntile; tile += c.G) {
        const int m0 = (tile / nN) * 128, n0 = (tile % nN) * 64;
        float acc[4][4];
#pragma unroll
        for (int i = 0; i < 4; ++i)
#pragma unroll
            for (int j = 0; j < 4; ++j) acc[i][j] = 0.f;
        const int lr = tid >> 2, lk = (tid & 3) * 4;
        for (int k0 = 0; k0 < K; k0 += 16) {
            { const uint2 w = *(const uint2*)(A + (size_t)(m0 + lr) * lda + k0 + lk);
              As[lk * 132 + lr] = __uint_as_float(w.x << 16); As[(lk + 1) * 132 + lr] = __uint_as_float(w.x & 0xffff0000u); As[(lk + 2) * 132 + lr] = __uint_as_float(w.y << 16); As[(lk + 3) * 132 + lr] = __uint_as_float(w.y & 0xffff0000u); }
            if (tid < 256) { const uint2 w = *(const uint2*)(Bt + (size_t)(n0 + lr) * K + k0 + lk);
              Bs[lk * 68 + lr] = __uint_as_float(w.x << 16); Bs[(lk + 1) * 68 + lr] = __uint_as_float(w.x & 0xffff0000u); Bs[(lk + 2) * 68 + lr] = __uint_as_float(w.y << 16); Bs[(lk + 3) * 68 + lr] = __uint_as_float(w.y & 0xffff0000u); }
            __syncthreads();
#pragma unroll
            for (int kk = 0; kk < 16; ++kk) {
                float av[4], bv[4];
#pragma unroll
                for (int i = 0; i < 4; ++i) { av[i] = As[kk * 132 + ty * 4 + i]; bv[i] = Bs[kk * 68 + tx * 4 + i]; }
#pragma unroll
                for (int i = 0; i < 4; ++i)
#pragma unroll
                    for (int j = 0; j < 4; ++j) acc[i][j] += av[i] * bv[j];
            }
            __syncthreads();
        }
#pragma unroll
        for (int i = 0; i < 4; ++i)
#pragma unroll
            for (int j = 0; j < 4; ++j) {
                const int row = m0 + ty * 4 + i, col = n0 + tx * 4 + j; const size_t ix = (size_t)row * ldc + col; const float v = acc[i][j];
                if (EPI == EPI_BF16) ((bf16*)C)[ix] = f2bf(v);
                else if (EPI == EPI_F32) ((float*)C)[ix] = v;
                else if (EPI == EPI_GLU) { const float yg = bf2f(aux1[ix]); ((bf16*)C)[ix] = f2bf(yg * sigmoid_f(v + aux0[col])); }
                else { ((float*)C)[ix] = aux0[ix] + v; }
            }
    }
}

__device__ __forceinline__ void ph_zstats(const Ctx& c, const bf16* Z, const float* qan, const float* kvan, bf16* CQN, bf16* CKVN) {
    for (int row = c.gw; row < T; row += c.ngw) {
        const bf16* zr = Z + (size_t)row * ZW; const int lane = c.lane;
        { const uint2 w = *(const uint2*)(zr + ZC_CQ + 4 * lane);
          float a0 = __uint_as_float(w.x << 16), a1 = __uint_as_float(w.x & 0xffff0000u), a2 = __uint_as_float(w.y << 16), a3 = __uint_as_float(w.y & 0xffff0000u);
          const float rstd = rsqrtf(wave_sum(a0 * a0 + a1 * a1 + a2 * a2 + a3 * a3) * (1.f / 256) + EPS);
          const float4 g = ((const float4*)qan)[lane];
          *(uint2*)(CQN + (size_t)row * 256 + 4 * lane) = make_uint2(pk2(a0 * rstd * g.x, a1 * rstd * g.y), pk2(a2 * rstd * g.z, a3 * rstd * g.w)); }
        { const u32 w = *(const u32*)(zr + ZC_CKV + 2 * lane);
          float a0 = __uint_as_float(w << 16), a1 = __uint_as_float(w & 0xffff0000u);
          const float rstd = rsqrtf(wave_sum(a0 * a0 + a1 * a1) * (1.f / 128) + EPS);
          const float2 g = ((const float2*)kvan)[lane];
          *(u32*)(CKVN + (size_t)row * 128 + 2 * lane) = pk2(a0 * rstd * g.x, a1 * rstd * g.y); }
    }
}

__device__ __forceinline__ void ph_qkfin(const Ctx& c, const bf16* QRAW, const bf16* KVRAW, const bf16* Z, const float* qn, const float* kn, const float* COS, const float* SIN, bf16* QB, bf16* KB, bf16* VB) {
    const int lane = c.lane;
    for (int w = c.gw; w < T * NH; w += c.ngw) {
        const int t = w >> 2, h = w & 3, b = t / SEQ, s = t % SEQ; const size_t bh = (size_t)b * NH + h;
        const float cs = COS[t * 32 + (lane & 31)], sn = SIN[t * 32 + (lane & 31)];
        {   const bf16* p = QRAW + (size_t)t * 768 + h * DQK;
            float v0 = bf2f(p[lane]), v1 = bf2f(p[lane + 64]), v2 = bf2f(p[lane + 128]);
            const float rstd = rsqrtf(wave_sum(v0 * v0 + v1 * v1 + v2 * v2) * (1.f / DQK) + EPS);
            v0 *= rstd * qn[lane]; v1 *= rstd * qn[lane + 64]; v2 *= rstd * qn[lane + 128];
            const float pr = __shfl_xor(v2, 32);
            const float r2 = (lane < 32) ? (v2 * cs - pr * sn) : (pr * sn + v2 * cs);
            bf16* o = QB + (bh * SEQ + s) * DQK;
            o[lane] = f2bf(v0 * QSCALE); o[lane + 64] = f2bf(v1 * QSCALE); o[lane + 128] = f2bf(r2 * QSCALE); }
        {   const bf16* p = KVRAW + (size_t)t * 1024 + h * 256;
            float v0 = bf2f(p[lane]), v1 = bf2f(p[lane + 64]), v2 = bf2f(Z[(size_t)t * ZW + ZC_KR + lane]);
            const float rstd = rsqrtf(wave_sum(v0 * v0 + v1 * v1 + v2 * v2) * (1.f / DQK) + EPS);
            v0 *= rstd * kn[lane]; v1 *= rstd * kn[lane + 64]; v2 *= rstd * kn[lane + 128];
            const float pr = __shfl_xor(v2, 32);
            const float r2 = (lane < 32) ? (v2 * cs - pr * sn) : (pr * sn + v2 * cs);
            bf16* o = KB + (bh * SEQ + s) * DQK;
            o[lane] = f2bf(v0); o[lane + 64] = f2bf(v1); o[lane + 128] = f2bf(r2);
            bf16* ov = VB + (bh * SEQ + s) * DV;
            ov[lane] = p[128 + lane]; ov[lane + 64] = p[192 + lane]; }
    }
}

__device__ __forceinline__ void ph_attn_simple(const Ctx& c, const bf16* QB, const bf16* KB, const bf16* VB, bf16* AO) {
    LAS float* qs = (LAS float*)c.lds + c.wave * DQK; const int lane = c.lane;
    for (int gq = c.gw; gq < NB * NH * SEQ; gq += c.ngw) {
        const int bh = gq / SEQ, q = gq % SEQ;
        const bf16* qp = QB + ((size_t)bh * SEQ + q) * DQK;
        qs[lane] = bf2f(qp[lane]); qs[lane + 64] = bf2f(qp[lane + 64]); qs[lane + 128] = bf2f(qp[lane + 128]);
        asm volatile("s_waitcnt lgkmcnt(0)" ::: "memory");
        float m = -1e30f, l = 0.f, o0 = 0.f, o1 = 0.f;
        const int ntile = q / 64 + 1;
        for (int kt = 0; kt < ntile; ++kt) {
            const int key = kt * 64 + lane;
            const uint4* kp = (const uint4*)(KB + ((size_t)bh * SEQ + key) * DQK);
            float sc = 0.f;
#pragma unroll 4
            for (int cc = 0; cc < 24; ++cc) { float kv[8]; unpack8(kp[cc], kv);
#pragma unroll
                for (int e = 0; e < 8; ++e) sc += kv[e] * qs[cc * 8 + e]; }
            if (key > q) sc = -INFINITY;
            const float mn = fmaxf(m, wave_max(sc));
            const float p = exp2f(sc - mn), al = exp2f(m - mn);
            l = l * al + wave_sum(p); o0 *= al; o1 *= al; m = mn;
            const u32* vp = (const u32*)(VB + ((size_t)bh * SEQ + kt * 64) * DV) + lane;
#pragma unroll 8
            for (int k = 0; k < 64; ++k) { const float pk = __shfl(p, k); const u32 w = vp[(size_t)k * (DV / 2)];
                o0 += pk * __uint_as_float(w << 16); o1 += pk * __uint_as_float(w & 0xffff0000u); }
        }
        const int b = bh / NH, h = bh % NH; const float il = 1.f / l;
        *(u32*)(AO + ((size_t)b * SEQ + q) * 512 + h * DV + 2 * lane) = pk2(o0 * il, o1 * il);
    }
}

__device__ __forceinline__ void ph_s5_simple(const Ctx& c, const bf16* Z, const float* a_re, const float* a_im, const float* log_dt, const float* b_re, const float* b_im,
                                             const float* c_re, const float* c_im, const float* dsk, bf16* YG) {
    for (int item = c.gw; item < NB * 16; item += c.ngw) {
        const int b = item >> 4, g = item & 15, p = c.lane;
        const float are = a_re[g * 64 + p], aim = a_im[g * 64 + p], dt = expf(log_dt[g]);
        const float mag = expf(are * dt); float sn, cs; sincos_acc(aim * dt, sn, cs);
        const float lre = mag * cs, lim = mag * sn;
        const float xr = lre - 1.f, xi = lim, den = are * are + aim * aim;
        const float cr = (xr * are + xi * aim) / den, ci = (xi * are - xr * aim) / den;
        float Bre[16], Bim[16], Cre[16], Cim[16];
#pragma unroll
        for (int k = 0; k < 16; ++k) { const float br = b_re[(g * 64 + p) * 16 + k], bi = b_im[(g * 64 + p) * 16 + k];
            Bre[k] = cr * br - ci * bi; Bim[k] = cr * bi + ci * br; Cre[k] = c_re[(g * 16 + k) * 64 + p]; Cim[k] = c_im[(g * 16 + k) * 64 + p]; }
        const float D = (p < 16) ? dsk[g * 16 + p] : 0.f;
        float hre = 0.f, him = 0.f;
        for (int s = 0; s < SEQ; ++s) {
            const bf16* up = Z + (size_t)(b * SEQ + s) * ZW + ZC_U + g * 16;
            float u[16]; unpack8(*(const uint4*)up, u); unpack8(*(const uint4*)(up + 8), u + 8);
            float bre = 0.f, bim = 0.f;
#pragma unroll
            for (int k = 0; k < 16; ++k) { bre += Bre[k] * u[k]; bim += Bim[k] * u[k]; }
            const float nre = lre * hre - lim * him + bre, nim = lre * him + lim * hre + bim; hre = nre; him = nim;
            float my = 0.f;
#pragma unroll
            for (int k = 0; k < 16; ++k) { const float v = wave_sum(Cre[k] * hre - Cim[k] * him); if (p == k) my = v + D * u[k]; }
            if (p < 16) YG[(size_t)(b * SEQ + s) * 256 + g * 16 + p] = f2bf(gelu_f(my));
        }
    }
}

__device__ __forceinline__ void ph_lru_xc(const Ctx& c, const bf16* Z, const float* cw, const float* cb, float* XC) {
    for (int i = c.gt; i < T * 256; i += c.ngt) { const int t = i >> 8, ch = i & 255, s = t % SEQ;
        float acc = cb[ch];
#pragma unroll
        for (int j = 0; j < 4; ++j) { const int ss = s - 3 + j; if (ss >= 0) acc += cw[j * 256 + ch] * bf2f(Z[(size_t)(t - 3 + j) * ZW + ZC_X + ch]); }
        XC[i] = acc; }
}
__device__ __forceinline__ void ph_lru_gates(const Ctx& c, const float* XC, const float* wa, const float* ba, const float* wx, const float* bx, const float* lam, float* AA, float* BT) {
    for (int i = c.gt; i < T * 256; i += c.ngt) { const int t = i >> 8, ch = i & 255, h = ch >> 6, j = ch & 63;
        const float* xr = XC + (size_t)t * 256 + h * 64;
        float ra = ba[ch], rx = bx[ch];
        for (int k = 0; k < 64; ++k) { const float xv = xr[k]; ra += xv * wa[(h * 64 + k) * 64 + j]; rx += xv * wx[(h * 64 + k) * 64 + j]; }
        const float r = sigmoid_f(ra), ig = sigmoid_f(rx);
        const float lsg = -log1pf(expf(-lam[ch]));
        const float la = 8.f * r * lsg, av = expf(la);
        AA[i] = av; BT[i] = sqrtf(-expm1f(2.f * la)) * (ig * XC[i]); }
}
__device__ __forceinline__ void ph_lru_scan(const Ctx& c, const float* AA, const float* BT, const bf16* Z, bf16* ROUT) {
    for (int item = c.gw; item < NB * 4; item += c.ngw) {
        const int i = item * 64 + c.lane, b = i >> 8, ch = i & 255;
        float h = 0.f;
#pragma unroll 8
        for (int s = 0; s < SEQ; ++s) { const size_t t = (size_t)b * SEQ + s;
            h = AA[t * 256 + ch] * h + BT[t * 256 + ch];
            ROUT[t * 256 + ch] = f2bf(h * gelu_f(bf2f(Z[t * ZW + ZC_G + ch]))); }
    }
}

__device__ __forceinline__ void ph_mixnorm(const Ctx& c, const bf16* AO, const bf16* SOUT, const bf16* ROUT, const float* g, bf16* Y) {
    const int lane = c.lane;
    for (int row = c.gw; row < T; row += c.ngw) {
        {   float v[8]; unpack8(*(const uint4*)(AO + (size_t)row * 512 + 8 * lane), v);
            float ss = 0.f;
#pragma unroll
            for (int e = 0; e < 8; ++e) ss += v[e] * v[e];
            const float rstd = rsqrtf(wave_sum(ss) * (1.f / 512) + EPS); const float* gg = g + 8 * lane;
            *(uint4*)(Y + (size_t)row * DM + 8 * lane) = make_uint4(pk2(v[0] * rstd * gg[0], v[1] * rstd * gg[1]), pk2(v[2] * rstd * gg[2], v[3] * rstd * gg[3]),
                                                                    pk2(v[4] * rstd * gg[4], v[5] * rstd * gg[5]), pk2(v[6] * rstd * gg[6], v[7] * rstd * gg[7])); }
#pragma unroll
        for (int part = 0; part < 2; ++part) {
            const bf16* src = part == 0 ? SOUT : ROUT; const int off = 512 + 256 * part;
            const uint2 w = *(const uint2*)(src + (size_t)row * 256 + 4 * lane);
            float a0 = __uint_as_float(w.x << 16), a1 = __uint_as_float(w.x & 0xffff0000u), a2 = __uint_as_float(w.y << 16), a3 = __uint_as_float(w.y & 0xffff0000u);
            const float rstd = rsqrtf(wave_sum(a0 * a0 + a1 * a1 + a2 * a2 + a3 * a3) * (1.f / 256) + EPS); const float* gg = g + off + 4 * lane;
            *(uint2*)(Y + (size_t)row * DM + off + 4 * lane) = make_uint2(pk2(a0 * rstd * gg[0], a1 * rstd * gg[1]), pk2(a2 * rstd * gg[2], a3 * rstd * gg[3]));
        }
    }
}

__device__ __forceinline__ void ph_topk_a(const Ctx& c, const float* SC, float* STOP, int* ITOP) {
    for (int i = c.gt; i < T * 16; i += c.ngt) {
        const float* sc = SC + (size_t)i * 128;
        float pv = INFINITY; int pn = -1;
        for (int it = 0; it < 16; ++it) {
            float bv = -INFINITY; int bn = 1 << 30;
            for (int n = 0; n < 128; ++n) { const float v = sc[n];
                const bool elig = (v < pv) || (v == pv && n > pn);
                if (elig && (v > bv || (v == bv && n < bn))) { bv = v; bn = n; } }
            STOP[(size_t)i * 16 + it] = bv; ITOP[(size_t)i * 16 + it] = bn; pv = bv; pn = bn;
        }
    }
}
__device__ __forceinline__ void ph_topk_b(const Ctx& c, const float* STOP, const int* ITOP, int* IDX, float* GATE) {
    LAS float* my = (LAS float*)c.lds + c.tid * 33;
    for (int i = c.gt; i < T * 8; i += c.ngt) {
        for (int k = 0; k < 32; ++k) my[k] = STOP[(size_t)i * 32 + k];
        float pv = INFINITY; int pn = -1; float best0 = 0.f, den = 0.f;
        float ev[16];
#pragma unroll
        for (int it = 0; it < 16; ++it) {
            float bv = -INFINITY; int bn = 1 << 30;
            for (int f = 0; f < 256; ++f) { const float v = my[f >> 4] + my[16 + (f & 15)];
                const bool elig = (v < pv) || (v == pv && f > pn);
                if (elig && (v > bv || (v == bv && f < bn))) { bv = v; bn = f; } }
            pv = bv; pn = bn;
            if (it == 0) best0 = bv;
            ev[it] = expf(bv - best0); den += ev[it];
            IDX[(size_t)i * 16 + it] = ITOP[(size_t)i * 32 + (bn >> 4)] * 128 + ITOP[(size_t)i * 32 + 16 + (bn & 15)];
        }
#pragma unroll
        for (int it = 0; it < 16; ++it) GATE[(size_t)i * 16 + it] = ev[it] / den;
    }
}

__device__ __forceinline__ void ph_gather(const Ctx& c, const bf16* HN, const int* IDX, const float* GATE, const bf16* PU, const bf16* PV, float* X) {
    const int lane = c.lane;
    for (int t = c.gw; t < T; t += c.ngw) {
        float hn[16]; unpack8(*(const uint4*)(HN + (size_t)t * DM + 8 * lane), hn); unpack8(*(const uint4*)(HN + (size_t)t * DM + 512 + 8 * lane), hn + 8);
        float y[16];
#pragma unroll
        for (int e = 0; e < 16; ++e) y[e] = 0.f;
        for (int k = 0; k < 128; ++k) {
            const int e = IDX[(size_t)t * 128 + k]; const float gt = GATE[(size_t)t * 128 + k];
            const bf16* ur = PU + (size_t)e * DM; const bf16* vr = PV + (size_t)e * DM;
            float u[16]; unpack8(*(const uint4*)(ur + 8 * lane), u); unpack8(*(const uint4*)(ur + 512 + 8 * lane), u + 8);
            float d = 0.f;
#pragma unroll
            for (int q = 0; q < 16; ++q) d += u[q] * hn[q];
            d = wave_sum(d);
            const float w = gt * gelu_f(d);
            float v[16]; unpack8(*(const uint4*)(vr + 8 * lane), v); unpack8(*(const uint4*)(vr + 512 + 8 * lane), v + 8);
#pragma unroll
            for (int q = 0; q < 16; ++q) y[q] += w * v[q];
        }
        float4* xo = (float4*)(X + (size_t)t * DM + 8 * lane);
        float4 p0 = xo[0], p1 = xo[1]; p0.x += y[0]; p0.y += y[1]; p0.z += y[2]; p0.w += y[3]; p1.x += y[4]; p1.y += y[5]; p1.z += y[6]; p1.w += y[7]; xo[0] = p0; xo[1] = p1;
        xo = (float4*)(X + (size_t)t * DM + 512 + 8 * lane);
        p0 = xo[0]; p1 = xo[1]; p0.x += y[8]; p0.y += y[9]; p0.z += y[10]; p0.w += y[11]; p1.x += y[12]; p1.y += y[13]; p1.z += y[14]; p1.w += y[15]; xo[0] = p0; xo[1] = p1;
    }
}
namespace att {
typedef short bf16x8 __attribute__((ext_vector_type(8)));
typedef short s16x4 __attribute__((ext_vector_type(4)));
typedef float f32x16 __attribute__((ext_vector_type(16)));
typedef unsigned u32x4 __attribute__((ext_vector_type(4)));
constexpr int KT = 64, KBYTES = KT * DQK * 2, VBYTES = KT * DV * 2, BUFB = KBYTES + VBYTES;
constexpr int OFF_WS = 2 * BUFB, OFF_MO = 0, OFF_ML = 65536, LDS_NEED = OFF_WS + 8 * 64 * 4;
constexpr float THR = 8.f;
__device__ __forceinline__ int kswz(int row, int c) { return row * 384 + (((c & ~7) | ((c & 7) ^ ((row >> 1) & 7))) << 4); }
__device__ __forceinline__ int v_st(int k, int c) { const int kk = (k & ~0xC) | ((k & 4) << 1) | ((k & 8) >> 1); return ((kk >> 3) * 4 + (c >> 5)) * 512 + ((kk & 7) * 32 + (c & 31)) * 2; }
__device__ __forceinline__ int v_rd_base(int lane) { return ((lane & 3) << 3) | (((lane >> 2) & 3) << 6) | (((lane >> 4) & 1) << 5) | (((lane >> 5) & 1) << 8); }
__device__ __forceinline__ int crow(int r, int hi) { return (r & 3) + 8 * (r >> 2) + 4 * hi; }
__device__ __forceinline__ unsigned cvtpk(float lo, float hi) { unsigned r; asm volatile("v_cvt_pk_bf16_f32 %0, %1, %2" : "=v"(r) : "v"(lo), "v"(hi)); return r; }
#define ATT_SBAR() __builtin_amdgcn_sched_barrier(0)

__device__ __forceinline__ void attn_unit(LAS unsigned char* lds, const bf16* Qg, const bf16* Kg, const bf16* Vg, bf16* AO, int bh, int qb, int tid) {
    const int lane = tid & 63, wid = __builtin_amdgcn_readfirstlane(tid >> 6), qsub = wid & 3, kh = wid >> 2, r32 = lane & 31, hi = lane >> 5;
    const int q0 = qb * 128, NT = 2 * (qb + 1);
    const size_t rowbase = (size_t)bh * SEQ;
    bf16x8 qr[12];
    { const bf16* qp = Qg + (rowbase + q0 + 32 * qsub + r32) * DQK + 8 * hi;
#pragma unroll
      for (int ks = 0; ks < 12; ++ks) qr[ks] = *(const bf16x8*)(qp + 16 * ks); }
    int ksrc[3], vsrc[2];
#pragma unroll
    for (int j = 0; j < 3; ++j) { const int L = (wid + 8 * j) * 64 + lane, row = L / 24, cp = L - row * 24, c = (cp & ~7) | ((cp & 7) ^ ((row >> 1) & 7)); ksrc[j] = row * DQK + c * 8; }
#pragma unroll
    for (int j = 0; j < 2; ++j) { const int X = ((wid + 8 * j) * 64 + lane) * 16, sub = X >> 9, within = (X & 511) >> 1, kk = ((sub >> 2) << 3) | (within >> 5);
        const int k = (kk & ~0xC) | ((kk & 4) << 1) | ((kk & 8) >> 1), c = (sub & 3) * 32 + (within & 31); vsrc[j] = k * DV + c; }
    const bf16* Kt = Kg + rowbase * DQK; const bf16* Vt = Vg + rowbase * DV;
#define ATT_STAGE(t, bo) do { const bf16* kp_ = Kt + (size_t)(t) * (KT * DQK); const bf16* vp_ = Vt + (size_t)(t) * (KT * DV); \
        _Pragma("unroll") for (int j_ = 0; j_ < 3; ++j_) __builtin_amdgcn_global_load_lds((const unsigned*)(kp_ + ksrc[j_]), (LAS unsigned*)(lds + (bo) + (wid + 8 * j_) * 1024), 16, 0, 0); \
        _Pragma("unroll") for (int j_ = 0; j_ < 2; ++j_) __builtin_amdgcn_global_load_lds((const unsigned*)(vp_ + vsrc[j_]), (LAS unsigned*)(lds + (bo) + KBYTES + (wid + 8 * j_) * 1024), 16, 0, 0); } while (0)
    const int krow = 32 * kh + r32, kf = (krow >> 1) & 7;
    int kb[4];
#pragma unroll
    for (int j = 0; j < 4; ++j) kb[j] = krow * 384 + ((((2 * j + hi) & 7) ^ kf) << 4);
    const int vb = KBYTES + v_rd_base(lane) + kh * 8192;
    LAS float* wsf = (LAS float*)(lds + OFF_WS) + wid * 64;
    float m_reg = -1e30f, l_reg = 0.f; f32x16 o[4];
#pragma unroll
    for (int d = 0; d < 4; ++d) o[d] = f32x16{};
    const int rb = 32 * qsub;
    ATT_STAGE(0, 0);
    asm volatile("s_waitcnt vmcnt(0)" ::: "memory");
    __syncthreads();
    for (int t = 0; t < NT; ++t) {
        const int bo = (t & 1) * BUFB;
        if (t + 1 < NT) ATT_STAGE(t + 1, BUFB - bo);
        const int kboff = 64 * t + 32 * kh - q0;
        const bool act = kboff <= rb, diag = kboff == rb;
        if (act) {
            f32x16 p = f32x16{};
#pragma unroll
            for (int ks = 0; ks < 12; ++ks) {
                const bf16x8 kfr = *(const LAS bf16x8*)(lds + bo + kb[ks & 3] + (ks >> 2) * 128);
                p = __builtin_amdgcn_mfma_f32_32x32x16_bf16(kfr, qr[ks], p, 0, 0, 0);
            }
            if (diag) {
#pragma unroll
                for (int r = 0; r < 16; ++r) if (crow(r, hi) > r32) p[r] = -__builtin_inff();
            }
            float pmax = p[0];
#pragma unroll
            for (int r = 1; r < 16; ++r) pmax = fmaxf(pmax, p[r]);
            { auto rr = __builtin_amdgcn_permlane32_swap(__float_as_uint(pmax), __float_as_uint(pmax), false, false);
              pmax = fmaxf(__uint_as_float(rr[0]), __uint_as_float(rr[1])); }
            float alpha = 1.f;
            if (!__all(pmax - m_reg <= THR)) { const float mn = fmaxf(m_reg, pmax); alpha = __builtin_amdgcn_exp2f(m_reg - mn); m_reg = mn; }
#pragma unroll
            for (int r = 0; r < 16; ++r) p[r] = __builtin_amdgcn_exp2f(p[r] - m_reg);
            float ps = 0.f;
#pragma unroll
            for (int r = 0; r < 16; ++r) ps += p[r];
            { auto rr = __builtin_amdgcn_permlane32_swap(__float_as_uint(ps), __float_as_uint(ps), false, false);
              ps = __uint_as_float(rr[0]) + __uint_as_float(rr[1]); }
            l_reg = l_reg * alpha + ps;
            if (__any(alpha < 1.f)) {
                if (hi == 0) wsf[r32] = alpha;
                asm volatile("s_waitcnt lgkmcnt(0)" ::: "memory");
#pragma unroll
                for (int r = 0; r < 16; ++r) { const float al = wsf[crow(r, hi)];
#pragma unroll
                    for (int d = 0; d < 4; ++d) o[d][r] *= al; }
            }
            bf16x8 pa0, pa1;
#define ATT_PK4(B_, OUT) do { unsigned a0 = cvtpk(p[B_ + 0], p[B_ + 1]), a1 = cvtpk(p[B_ + 2], p[B_ + 3]); unsigned b0 = cvtpk(p[B_ + 4], p[B_ + 5]), b1 = cvtpk(p[B_ + 6], p[B_ + 7]); \
            auto r0 = __builtin_amdgcn_permlane32_swap(a0, b0, false, false); auto r1 = __builtin_amdgcn_permlane32_swap(a1, b1, false, false); \
            u32x4 w_ = {r0[0], r1[0], r0[1], r1[1]}; OUT = __builtin_bit_cast(bf16x8, w_); } while (0)
            ATT_PK4(0, pa0); ATT_PK4(8, pa1);
#undef ATT_PK4
            const int vaddr = (int)(uintptr_t)lds + bo + vb;
#define ATT_TRRD(dst, off) asm volatile("ds_read_b64_tr_b16 %0, %1 offset:%2" : "=&v"(dst) : "v"(vaddr), "i"(off) : "memory")
#define ATT_PV(d0) do { s16x4 l0, h0, l1, h1; \
            ATT_TRRD(l0, (d0) * 512); ATT_TRRD(h0, (d0) * 512 + 2048); ATT_TRRD(l1, (d0) * 512 + 4096); ATT_TRRD(h1, (d0) * 512 + 6144); \
            asm volatile("s_waitcnt lgkmcnt(0)" ::: "memory"); ATT_SBAR(); \
            o[d0] = __builtin_amdgcn_mfma_f32_32x32x16_bf16(pa0, (bf16x8){l0[0], l0[1], l0[2], l0[3], h0[0], h0[1], h0[2], h0[3]}, o[d0], 0, 0, 0); \
            o[d0] = __builtin_amdgcn_mfma_f32_32x32x16_bf16(pa1, (bf16x8){l1[0], l1[1], l1[2], l1[3], h1[0], h1[1], h1[2], h1[3]}, o[d0], 0, 0, 0); } while (0)
            ATT_PV(0); ATT_PV(1); ATT_PV(2); ATT_PV(3);
#undef ATT_PV
#undef ATT_TRRD
        }
        asm volatile("s_waitcnt vmcnt(0)" ::: "memory");
        __syncthreads();
    }
    LAS float* MO = (LAS float*)(lds + OFF_MO) + qsub * 4096; LAS float* ML = (LAS float*)(lds + OFF_ML) + qsub * 64;
    if (kh == 1) {
        if (hi == 0) { ML[2 * r32] = m_reg; ML[2 * r32 + 1] = l_reg; }
#pragma unroll
        for (int d = 0; d < 4; ++d)
#pragma unroll
            for (int r = 0; r < 16; ++r) MO[(d * 16 + r) * 64 + lane] = o[d][r];
    }
    __syncthreads();
    if (kh == 0) {
        const float m1 = ML[2 * r32], l1 = ML[2 * r32 + 1];
        const float mm = fmaxf(m_reg, m1), f0 = __builtin_amdgcn_exp2f(m_reg - mm), f1 = __builtin_amdgcn_exp2f(m1 - mm);
        const float il = 1.f / (l_reg * f0 + l1 * f1);
        if (hi == 0) { wsf[r32] = f0 * il; wsf[32 + r32] = f1 * il; }
        asm volatile("s_waitcnt lgkmcnt(0)" ::: "memory");
        const int b = bh / NH, h = bh % NH;
        bf16* Ow = AO + ((size_t)b * SEQ + q0 + rb) * 512 + h * DV;
#pragma unroll
        for (int r = 0; r < 16; ++r) { const int orow = crow(r, hi); const float g0 = wsf[orow], g1 = wsf[32 + orow];
#pragma unroll
            for (int d = 0; d < 4; ++d) { const float v = o[d][r] * g0 + MO[(d * 16 + r) * 64 + lane] * g1; const float vn = __shfl_xor(v, 1);
                if ((r32 & 1) == 0) *(unsigned*)(Ow + (size_t)orow * 512 + d * 32 + r32) = cvtpk(v, vn); } }
    }
    __syncthreads();
#undef ATT_STAGE
}
__device__ __forceinline__ void attn_phase(LAS unsigned char* lds, const bf16* Qg, const bf16* Kg, const bf16* Vg, bf16* AO, int G, int bid, int tid) {
    const int npair = NB * NH * 32;
    for (int v0 = bid; v0 < npair; v0 += G) {
        const int vcu = (G % 8 == 0 && npair % G == 0) ? (v0 % 8) * (npair / 8) + v0 / 8 : v0;
        const int bh = vcu >> 5, s = vcu & 31;
        for (int u = 0; u < 2; ++u) attn_unit(lds, Qg, Kg, Vg, AO, bh, u ? s : 63 - s, tid);
    }
}
#undef ATT_SBAR
}
#ifndef MK_PROBE
#define MK_PROBE 0
#endif
#ifndef PROBE_A_LO
#define PROBE_A_LO 0
#define PROBE_A_HI 1
#define PROBE_B_LO 16
#define PROBE_B_HI 17
#endif
#define TS_OFF 8192
#ifndef MK_DUP
#define MK_DUP 0
#endif
#ifndef MK_DUP_LOADONLY
#define MK_DUP_LOADONLY false
#endif
#ifndef MK_DUP_EMASK
#define MK_DUP_EMASK 0x3fff
#endif
#ifndef MK_SIMPLE_TOPK
#define MK_SIMPLE_TOPK 0
#endif
#ifndef MK_SIMPLE_SCAN
#define MK_SIMPLE_SCAN 0
#endif
#ifndef MK_SIMPLE_ATTN
#define MK_SIMPLE_ATTN 0
#endif
#ifndef MK_SIMPLE_GEMM
#define MK_SIMPLE_GEMM 0
#endif
constexpr int NPH_LAYER = 10, NPH = 1 + NL * NPH_LAYER;
struct GD { const bf16* A; const bf16* Bt; void* C; const float* aux0; const bf16* aux1; int lda, M, N, K, ldc, kind; };
template <class Epi> __device__ __forceinline__ void run_gemm(const Ctx& c, const bf16* A, int lda, const bf16* Bt, int M, int N, int K, const Epi& E) {
    pg8::Gemm g{A, Bt, M, N, K, lda}; pg8::StaticOrder S; S.init(M, N, c.G, c.bid);
    pg8::gemm_phase<Epi, pg8::StaticOrder, true, true>(c.lds, g, S, E);
}
#define AS4 __attribute__((address_space(4)))
__global__ void __launch_bounds__(NTHR, 2) mega(Args a_) {
    extern __shared__ __attribute__((aligned(16))) unsigned char lds_raw[];
    {   const int t0 = threadIdx.x;
        for (int u = t0; u < (LDS_BYTES - RING_BYTES) / 4; u += NTHR) ((LAS unsigned*)((LAS unsigned char*)lds_raw + RING_BYTES))[u] = 0u; }
    __syncthreads();
    volatile LAS unsigned* MISC = (volatile LAS unsigned*)((LAS unsigned char*)lds_raw + MISC_OFF);
    XcdBarrier bar; bar.bar = (unsigned*)(a_.ws + WS_CTL) + CW_BAR; bar.x = 0; bar.st = MISC + 8;
    const int ph_lo = a_.ph_lo, ph_hi = a_.ph_hi;
    if (ph_hi - ph_lo > 1) bar = xcd_barrier_post((unsigned*)(a_.ws + WS_CTL) + CW_BAR, MISC + 8);

#if MK_PROBE
    unsigned long long* ts = (unsigned long long*)(a_.ws + WS_CTL + TS_OFF); const bool stamper = (blockIdx.x == 0 && threadIdx.x == 0);
    if (stamper) ts[0] = __builtin_amdgcn_s_memrealtime();
#endif
    int p = ph_lo;
    if (p == 0) {
        const Args AS4* ap0 = (const Args AS4*)__builtin_amdgcn_kernarg_segment_ptr(); Ctx c0; c0.lds = (LAS unsigned char*)lds_raw; c0.tid = threadIdx.x; c0.lane = c0.tid & 63; c0.wave = __builtin_amdgcn_readfirstlane(c0.tid >> 6);
        c0.G = gridDim.x; c0.bid = blockIdx.x; c0.gw = c0.wave * c0.G + c0.bid; c0.ngw = NWAVES * c0.G; c0.gt = c0.bid * NTHR + c0.tid; c0.ngt = c0.G * NTHR;
        ph_prep(*ap0, c0);
#if MK_DUP & 1
        __syncthreads(); ph_prep(*ap0, c0);
#endif
        if (p + 1 < ph_hi) xcd_barrier(bar);
        p = 1;
#if MK_PROBE
        if (stamper) ts[1] = __builtin_amdgcn_s_memrealtime();
#endif
    }
    for (; p < ph_hi; ++p) {
        const Args AS4* ap = (const Args AS4*)__builtin_amdgcn_kernarg_segment_ptr(); asm volatile("" : "+s"(ap));
        int tid_ = threadIdx.x; asm volatile("" : "+v"(tid_));
#define a (*ap)
        Ctx c; c.lds = (LAS unsigned char*)lds_raw; c.tid = tid_; c.lane = c.tid & 63; c.wave = __builtin_amdgcn_readfirstlane(c.tid >> 6);
        { int G_ = gridDim.x, bid_ = blockIdx.x; asm volatile("" : "+s"(G_), "+s"(bid_)); c.G = G_; c.bid = bid_; }
        c.gw = c.wave * c.G + c.bid; c.ngw = NWAVES * c.G; c.gt = c.bid * NTHR + c.tid; c.ngt = c.G * NTHR;
        bf16 *WINT = WSP(bf16, WS_WINT), *WUQT = WSP(bf16, WS_WUQT), *WUKVT = WSP(bf16, WS_WUKVT), *GLUT = WSP(bf16, WS_GLUT), *WOUTT = WSP(bf16, WS_WOUTT),
             *WQT = WSP(bf16, WS_WQT), *SUBKT = WSP(bf16, WS_SUBKT), *PU = WSP(bf16, WS_PU), *PV = WSP(bf16, WS_PV);
        float *COS = WSP(float, WS_COS), *SIN = WSP(float, WS_SIN);
        bf16 *XB = WSP(bf16, WS_XB), *Z = WSP(bf16, WS_Z), *QRAW = WSP(bf16, WS_QRAW), *KVRAW = WSP(bf16, WS_KVRAW), *QB = WSP(bf16, WS_QB), *KB = WSP(bf16, WS_KB),
             *VB = WSP(bf16, WS_VB), *CQN = WSP(bf16, WS_CQN), *CKVN = WSP(bf16, WS_CKVN), *AO = WSP(bf16, WS_AO), *ROUT = WSP(bf16, WS_ROUT), *Y = WSP(bf16, WS_Y),
             *YG = WSP(bf16, WS_YG), *SOUT = WSP(bf16, WS_SOUT), *QP = WSP(bf16, WS_QP);
        float *XC = WSP(float, WS_XC), *AA = WSP(float, WS_AA), *BT = WSP(float, WS_BT), *SC = WSP(float, WS_SC), *STOP = WSP(float, WS_STOP), *GATE = WSP(float, WS_GATE);
        int *ITOP = WSP(int, WS_ITOP), *IDX = WSP(int, WS_IDX);
        float* out = a.out;
        {
            const int l = (p - 1) / NPH_LAYER, k = (p - 1) % NPH_LAYER;
            const float* xin = (l == 0) ? INF(0) : out;
            GD gd, gd2; gd.kind = 0; gd.A = nullptr; gd.Bt = nullptr; gd.C = nullptr; gd.aux0 = nullptr; gd.aux1 = nullptr; gd.lda = 0; gd.M = T; gd.N = 0; gd.K = 0; gd.ldc = 0; gd2 = gd;
#define SETG(G_, kind_, A_, lda_, Bt_, M_, N_, K_, C_, ldc_, aux0_, aux1_) do { G_.kind = kind_; G_.A = A_; G_.lda = lda_; G_.Bt = Bt_; G_.M = M_; G_.N = N_; G_.K = K_; G_.C = (void*)(C_); G_.ldc = ldc_; G_.aux0 = aux0_; G_.aux1 = aux1_; } while (0)
            float* ROWSS = WSP(float, WS_ROWSS);
            switch (k) {
            case 0: SETG(gd, 1, XB, DM, WINT + (size_t)l * ZW * DM, T, ZW, DM, Z, ZW, nullptr, nullptr); break;
            case 1: ph_zstats(c, Z, INF(4) + l * 256, INF(6) + l * 128, CQN, CKVN);
                s5f::pass<false>(c.lds, Z, WSP(bf16, WS_S5A) + (size_t)l * 32768, WSP(bf16, WS_S5C) + (size_t)l * 32768, WSP(float2, WS_S5L) + l * 1024, INF(17) + l * 256, WSP(float2, WS_SE), WSP(float2, WS_SH), YG, c.gw, c.ngw, c.wave, c.lane);
                __syncthreads();
                lruf::pass_a(c.lds, Z, INF(20) + l * 1024, INF(21) + l * 256, INF(22) + l * 16384, INF(23) + l * 256, INF(24) + l * 16384, INF(25) + l * 256, INF(26) + l * 256, AA, BT, WSP(float2, WS_LPE), c.gw, c.ngw, c.wave, c.lane);
                break;
            case 2:
                for (int it = c.bid; it < 232; it += c.G) {
                    if (it >= 224) lruf::carry_wg(c.lds, WSP(float2, WS_LPE), WSP(float, WS_LH), it - 224, c.wave, c.lane);
                    else if (it >= 192) s5f::carry_wg(c.lds, WSP(float2, WS_S5L) + l * 1024, WSP(float2, WS_SE), WSP(float2, WS_SH), it - 192, c.wave, c.lane);
                }
                SETG(gd, 1, CQN, 256, WUQT + (size_t)l * 768 * 256, T, 768, 256, QRAW, 768, nullptr, nullptr);
                SETG(gd2, 1, CKVN, 128, WUKVT + (size_t)l * 1024 * 128, T, 1024, 128, KVRAW, 1024, nullptr, nullptr);
                break;
            case 3: ph_qkfin(c, QRAW, KVRAW, Z, INF(8) + l * DQK, INF(9) + l * DQK, COS, SIN, QB, KB, VB); break;
            case 4:
#if MK_DUP & 2
            for (int rep_ = 0; rep_ < 2; ++rep_) {
#endif
                s5f::pass<true>(c.lds, Z, WSP(bf16, WS_S5A) + (size_t)l * 32768, WSP(bf16, WS_S5C) + (size_t)l * 32768, WSP(float2, WS_S5L) + l * 1024, INF(17) + l * 256, WSP(float2, WS_SE), WSP(float2, WS_SH), YG, c.gw, c.ngw, c.wave, c.lane);
                lruf::pass_b(AA, BT, WSP(float, WS_LH), Z, ROUT, c.gt, c.ngt);
                __syncthreads(); att::attn_phase(c.lds, QB, KB, VB, AO, c.G, c.bid, c.tid);
#if MK_DUP & 2
            __syncthreads(); }
#endif
                break;
            case 5: SETG(gd, 3, YG, 256, GLUT + (size_t)l * 65536, T, 256, 256, SOUT, 256, INF(19) + l * 256, YG); break;
            case 6: ph_mixnorm(c, AO, SOUT, ROUT, INF(27) + l * DM, Y); break;
            case 7: SETG(gd, 2, Y, DM, WOUTT + (size_t)l * DM * DM, T, DM, DM, out, DM, xin, nullptr); break;
            case 8: SETG(gd, 1, XB, DM, WQT + (size_t)l * 2048 * DM, T, 2048, DM, QP, 2048, nullptr, nullptr); break;
            default: tk::topk_phase<true>(QP, SUBKT + (size_t)l * 32768, IDX, GATE, XB, WSP(unsigned char, WS_PU) + (size_t)l * 16384 * DM, WSP(unsigned char, WS_PV) + (size_t)l * 16384 * DM, out, ROWSS,
                                          (l + 1 < NL) ? INF(2) + (l + 1) * DM : nullptr, c.gw, c.ngw, c.lane); break;
            }
#undef SETG
            for (int gi = 0; gi < 2; ++gi) {
                const GD g = gi ? gd2 : gd;
                if (g.kind == 1) run_gemm(c, g.A, g.lda, g.Bt, g.M, g.N, g.K, pg8::EpiBf16<0>{(bf16*)g.C, g.ldc, nullptr, 0, 0, 1.f});
                else if (g.kind == 2) run_gemm(c, g.A, g.lda, g.Bt, g.M, g.N, g.K, pg8::EpiOut{(float*)g.C, g.ldc, g.aux0, INF(29) + l * DM, XB, ROWSS});
                else if (g.kind == 3) run_gemm(c, g.A, g.lda, g.Bt, g.M, g.N, g.K, pg8::EpiGlu{(bf16*)g.C, g.ldc, g.aux0, g.aux1});
            }
        }
        if (p + 1 < ph_hi) { XcdBarrier b2 = bar; unsigned* bb = (unsigned*)(a.ws + WS_CTL) + CW_BAR; unsigned bx = bar.x; asm volatile("" : "+s"(bb), "+s"(bx)); b2.bar = bb; b2.x = bx; xcd_barrier(b2); }
#if MK_PROBE
        if (p + 1 == ph_hi) xcd_barrier(bar);
        if (stamper) ts[p + 1] = __builtin_amdgcn_s_memrealtime();
#endif
#undef a
    }
#if MK_PROBE
    xcd_barrier(bar);
    {   const unsigned long long* tsr = (const unsigned long long*)(a_.ws + WS_CTL + TS_OFF);
        const unsigned long long ta0 = __hip_atomic_load(tsr + PROBE_A_LO, __ATOMIC_RELAXED, __HIP_MEMORY_SCOPE_AGENT), ta1 = __hip_atomic_load(tsr + PROBE_A_HI, __ATOMIC_RELAXED, __HIP_MEMORY_SCOPE_AGENT);
        const unsigned long long tb0 = __hip_atomic_load(tsr + PROBE_B_LO, __ATOMIC_RELAXED, __HIP_MEMORY_SCOPE_AGENT), tb1 = __hip_atomic_load(tsr + PROBE_B_HI, __ATOMIC_RELAXED, __HIP_MEMORY_SCOPE_AGENT);
        const float da_us = (float)(ta1 - ta0) * 0.01f, db_us = (float)(tb1 - tb0) * 0.01f;
        const float eps = sqrtf(db_us * 1e-4f);
        float* o = a_.out;
        for (size_t i = (size_t)blockIdx.x * NTHR + threadIdx.x; i < (size_t)T * DM; i += (size_t)gridDim.x * NTHR) { float v = o[i] * (1.f + eps); if (i == 0) v += da_us * 0.1f; o[i] = v; }
    }
#endif
}

extern "C" void kernel_launch(void* const* d_in, const int* in_sizes, int n_in, void* d_out, int out_size, void* d_ws, size_t ws_size, hipStream_t stream) {
    static int grid = 0;
    if (grid == 0) {
        if (n_in != 34 || out_size != T * DM || ws_size < WS_END) { fprintf(stderr, "kernel_launch: unexpected shapes (n_in %d out %d ws %zu)\n", n_in, out_size, ws_size); grid = -1; return; }
        int dev = 0, cus = 0, per_cu = 0;
        if (hipGetDevice(&dev) != hipSuccess || hipDeviceGetAttribute(&cus, hipDeviceAttributeMultiprocessorCount, dev) != hipSuccess) { grid = -1; return; }
        if (hipFuncSetAttribute((const void*)mega, hipFuncAttributeMaxDynamicSharedMemorySize, LDS_BYTES) != hipSuccess) { fprintf(stderr, "kernel_launch: hipFuncSetAttribute failed\n"); grid = -1; return; }
        if (hipOccupancyMaxActiveBlocksPerMultiprocessor(&per_cu, (const void*)mega, NTHR, LDS_BYTES) != hipSuccess || per_cu < 1) { fprintf(stderr, "kernel_launch: occupancy query says %d blocks per CU\n", per_cu); }
        (void)hipGetLastError();
        grid = cus;
    }
    if (grid < 0) return;
    (void)hipMemsetAsync((char*)d_ws + WS_CTL, 0, CTL_ZERO_BYTES, stream);
    Args a{};
    for (int i = 0; i < 34; ++i) a.in[i] = d_in[i];
    a.out = (float*)d_out; a.ws = (unsigned char*)d_ws;
#if MK_PER_PHASE
    for (int p = 0; p < NPH; ++p) { a.ph_lo = p; a.ph_hi = p + 1; hipLaunchKernelGGL(mega, dim3(grid), dim3(NTHR), LDS_BYTES, stream, a); }
#else
    a.ph_lo = 0; a.ph_hi = NPH;
    hipLaunchKernelGGL(mega, dim3(grid), dim3(NTHR), LDS_BYTES, stream, a);
#endif
}
```

```cpp
#include <hip/hip_runtime.h>
#include <cstdint>
#include <cstdio>

#ifndef MK_PER_PHASE
#define MK_PER_PHASE 0
#endif

typedef unsigned short bf16;
typedef unsigned int u32;

constexpr int NB = 2, SEQ = 8192, T = NB * SEQ, DM = 1024, NL = 2;
constexpr int ZW = 1280;
constexpr int ZC_CQ = 0, ZC_CKV = 256, ZC_KR = 384, ZC_U = 512, ZC_X = 768, ZC_G = 1024;
constexpr int NH = 4, DQK = 192, DV = 128;
constexpr float EPS = 1e-6f;
constexpr float QSCALE = 0.07216878364870322f * 1.4426950408889634f;

constexpr size_t MiB = 1u << 20;
constexpr size_t WS_CTL = 0, CTL_ZERO_BYTES = 1 * MiB, WS_WINT = 1 * MiB, WS_WUQT = 7 * MiB, WS_WUKVT = 8 * MiB, WS_GLUT = 9 * MiB, WS_WOUTT = 10 * MiB,
                 WS_WQT = 14 * MiB, WS_SUBKT = 22 * MiB, WS_COS = 23 * MiB, WS_SIN = 25 * MiB, WS_PU = 28 * MiB, WS_PV = 92 * MiB,
                 WS_XB = 156 * MiB, WS_Z = 188 * MiB, WS_RA = 228 * MiB, WS_RB = 356 * MiB, WS_CKVN = 420 * MiB, WS_AO = 424 * MiB,
                 WS_ROUT = 440 * MiB, WS_Y = 448 * MiB, WS_IDX = 480 * MiB, WS_GATE = 488 * MiB, WS_S5A = 496 * MiB, WS_S5C = WS_S5A + 128 * 1024, WS_S5L = WS_S5A + 256 * 1024,
                 WS_SE = 497 * MiB, WS_SH = 501 * MiB, WS_LPE = 505 * MiB, WS_LH = 506 * MiB, WS_ROWSS = WS_LH + 512 * 1024, WS_END = 508 * MiB;
constexpr size_t WS_QRAW = WS_RA, WS_KVRAW = WS_RA + 24 * MiB, WS_QB = WS_RA + 56 * MiB, WS_KB = WS_RA + 80 * MiB, WS_VB = WS_RA + 104 * MiB,
                 WS_CQN = WS_RA + 120 * MiB, WS_SC = WS_RA;
constexpr size_t WS_XC = WS_RB, WS_AA = WS_RB + 16 * MiB, WS_BT = WS_RB + 32 * MiB, WS_YG = WS_RB + 48 * MiB, WS_SOUT = WS_RB + 56 * MiB, WS_QP = WS_RB;
constexpr size_t WS_STOP = WS_Z, WS_ITOP = WS_Z + 16 * MiB;
constexpr int CW_BAR = 4096;

__device__ __forceinline__ float bf2f(bf16 h) { return __uint_as_float((u32)h << 16); }
__device__ __forceinline__ bf16 f2bf(float f) { u32 u = __float_as_uint(f); return (bf16)((u + 0x7fffu + ((u >> 16) & 1u)) >> 16); }
__device__ __forceinline__ u32 pk2(float lo, float hi) { return (u32)f2bf(lo) | ((u32)f2bf(hi) << 16); }
__device__ __forceinline__ float wave_sum(float v) {
#pragma unroll
    for (int o = 32; o > 0; o >>= 1) v += __shfl_xor(v, o);
    return v;
}
__device__ __forceinline__ float wave_max(float v) {
#pragma unroll
    for (int o = 32; o > 0; o >>= 1) v = fmaxf(v, __shfl_xor(v, o));
    return v;
}
__device__ __forceinline__ float gelu_f(float x) { return 0.5f * x * (1.f + erff(x * 0.70710678118654752f)); }
__device__ __forceinline__ float sigmoid_f(float x) { return 1.f / (1.f + __expf(-x)); }
__device__ __forceinline__ void unpack8(uint4 w, float* o) {
    o[0] = __uint_as_float(w.x << 16); o[1] = __uint_as_float(w.x & 0xffff0000u);
    o[2] = __uint_as_float(w.y << 16); o[3] = __uint_as_float(w.y & 0xffff0000u);
    o[4] = __uint_as_float(w.z << 16); o[5] = __uint_as_float(w.z & 0xffff0000u);
    o[6] = __uint_as_float(w.w << 16); o[7] = __uint_as_float(w.w & 0xffff0000u);
}
__device__ __forceinline__ void sincos_acc(float x, float& s, float& c) {
    const float k = rintf(x * 0.15915494309189535f);
    float r = fmaf(-k, 6.28125f, x);
    r = fmaf(-k, 1.9350051879882812e-3f, r);
    r = fmaf(-k, 3.0199160335e-7f, r);
    const float f = r * 0.15915494309189535f;
    s = __builtin_amdgcn_sinf(f); c = __builtin_amdgcn_cosf(f);
}
namespace pg8 {
#define PG8_LAS __attribute__((address_space(3)))
typedef unsigned short bf16_t;
typedef short bf16x8 __attribute__((ext_vector_type(8)));
typedef float f32x4 __attribute__((ext_vector_type(4)));
typedef unsigned u32x4 __attribute__((ext_vector_type(4)));
constexpr int BM = 256, BK = 64, HALF = 128, HTB = HALF * BK * 2  , STAGE_BYTES = 8 * HTB, NXCD = 8, WGM = 8;

__host__ __device__ __forceinline__ int lds_byte(int r, int c) { const int st = (r >> 4) * 2 + (c >> 5), rr = r & 15, cc = c & 31, ob = rr * 64 + cc * 2; return st * 1024 + (ob ^ (((ob >> 9) & 1) << 5)); }
__host__ __device__ __forceinline__ void stage_rc(int b, int& R, int& C) { const int st = b / 1024, sb = b % 1024, swz = sb ^ (((sb >> 9) & 1) << 5); R = (st >> 1) * 16 + swz / 64; C = (st & 1) * 32 + (swz % 64) / 2; }
__host__ __device__ __forceinline__ int perm32(int rho) { const int n = rho >> 4, i = rho & 15; return 8 * (i >> 2) + 4 * n + (i & 3); }

struct Unit { int pm, pn; };
struct Gemm { const bf16_t* A; const bf16_t* Bt; int M, N, K, lda; };

struct StaticOrder {
    int nM, nN, nwg, G, c;
    __host__ __device__ void init(int M, int N, int G_, int c_) { nM = M / BM; nN = N / BM; nwg = nM * nN; G = G_; c = c_; }
    __host__ __device__ bool next(int i, Unit& u) const {
        const long L = (long)i * G + c; if (L >= nwg) return false;
        int wgid = (int)L; { const int q = nwg / NXCD, r = nwg % NXCD, xcd = wgid % NXCD, off = wgid / NXCD; wgid = (xcd < r ? xcd * (q + 1) : r * (q + 1) + (xcd - r) * q) + off; }
        const int nig = WGM * nN, gid = wgid / nig, fm = gid * WGM, gsz = (nM - fm) < WGM ? (nM - fm) : WGM;
        u.pm = fm + ((wgid % nig) % gsz); u.pn = (wgid % nig) / gsz; return true;
    }
    __device__ __forceinline__ void a_ready(const Unit&) const {}
    __device__ __forceinline__ void done(const Unit&) const {}
};

__device__ __forceinline__ unsigned cvt_pk_bf16(float lo, float hi) { unsigned r; asm volatile("v_cvt_pk_bf16_f32 %0, %1, %2" : "=v"(r) : "v"(lo), "v"(hi)); return r; }
typedef float f32x2 __attribute__((ext_vector_type(2)));
__device__ __forceinline__ f32x2 gelu_pk(f32x2 v) {
    const f32x2 av = __builtin_elementwise_abs(v), d = av * 0.2316418882f + 1.0f;
    f32x2 t; t.x = __builtin_amdgcn_rcpf(d.x); t.y = __builtin_amdgcn_rcpf(d.y);
    f32x2 q = t * 0.5307027145f + (-0.7265760135f); q = q * t + 0.7107068705f; q = q * t + (-0.142248368f); q = q * t + 0.127414796f; q = q * t;
    const f32x2 s = (v * v) * (-0.72134752044f);
    f32x2 e; e.x = __builtin_amdgcn_exp2f(s.x); e.y = __builtin_amdgcn_exp2f(s.y);
    const f32x2 m = v * (q * e), r = v - m;
    f32x2 o; o.x = v.x < 0.f ? m.x : r.x; o.y = v.y < 0.f ? m.y : r.y; return o;
}

template <int ACT  > struct EpiBf16 {
    static constexpr bool PERM = true, AFTER_DRAIN = false; static_assert(ACT == 0 || ACT == 1, "EpiBf16: ACT is 0 (none) or 1 (gelu_pk)");
    bf16_t* O; int ldc; const float* bias; int split_cols; size_t split_stride; float scale0;
    __device__ __forceinline__ void operator()(const f32x4 (&acc)[2][2][4][2], const Unit& u, int wr, int wc, int fr, int fq) const {
        const int row0 = u.pm * BM + wr * 64 + fr; int colt = u.pn * BM; bf16_t* base = O;
        float sc = 1.f; if (split_cols) { const int t = colt / split_cols; base += (size_t)t * split_stride; colt -= t * split_cols; if (t == 0) sc = scale0; }
        const int col0 = colt + wc * 32 + 8 * fq, bcol0 = u.pn * BM + wc * 32 + 8 * fq;
        f32x4 bv[2][2];
#pragma unroll
        for (int bj = 0; bj < 2; ++bj)
#pragma unroll
            for (int n = 0; n < 2; ++n) bv[bj][n] = bias ? *(const f32x4*)(bias + bcol0 + bj * HALF + 4 * n) : (f32x4){0.f, 0.f, 0.f, 0.f};
#pragma unroll
        for (int ai = 0; ai < 2; ++ai)
#pragma unroll
            for (int m = 0; m < 4; ++m) { bf16_t* rowp = base + (size_t)(row0 + ai * HALF + m * 16) * ldc + col0;
#pragma unroll
                for (int bj = 0; bj < 2; ++bj) { f32x4 v0 = acc[ai][bj][m][0] + bv[bj][0], v1 = acc[ai][bj][m][1] + bv[bj][1];
                    if (ACT == 1) { f32x2 a = gelu_pk((f32x2){v0[0], v0[1]}), b = gelu_pk((f32x2){v0[2], v0[3]}), c = gelu_pk((f32x2){v1[0], v1[1]}), d = gelu_pk((f32x2){v1[2], v1[3]});
                        v0 = (f32x4){a.x, a.y, b.x, b.y}; v1 = (f32x4){c.x, c.y, d.x, d.y}; }
                    v0 = v0 * sc; v1 = v1 * sc; u32x4 w; w.x = cvt_pk_bf16(v0[0], v0[1]); w.y = cvt_pk_bf16(v0[2], v0[3]); w.z = cvt_pk_bf16(v1[0], v1[1]); w.w = cvt_pk_bf16(v1[2], v1[3]);
                    *(u32x4*)(rowp + bj * HALF) = w; } }
    }
};


struct EpiF32 {
    static constexpr bool PERM = false, AFTER_DRAIN = false;
    float* C; int ldc; const float* resid;
    __device__ __forceinline__ void operator()(const f32x4 (&acc)[2][2][4][2], const Unit& u, int wr, int wc, int fr, int fq) const {
        const int row0 = u.pm * BM + wr * 64 + fr, col0 = u.pn * BM + wc * 32 + 4 * fq;
#pragma unroll
        for (int ai = 0; ai < 2; ++ai)
#pragma unroll
            for (int m = 0; m < 4; ++m) { const size_t rb = (size_t)(row0 + ai * HALF + m * 16) * ldc + col0;
#pragma unroll
                for (int bj = 0; bj < 2; ++bj)
#pragma unroll
                    for (int n = 0; n < 2; ++n) { const size_t ix = rb + bj * HALF + n * 16; f32x4 v = acc[ai][bj][m][n];
                        if (resid) v += *(const f32x4*)(resid + ix);
                        *(f32x4*)(C + ix) = v; } }
    }
};

struct EpiOut {
    static constexpr bool PERM = false, AFTER_DRAIN = false;
    float* C; int ldc; const float* resid; const float* g; bf16_t* XB; float* rowss;
    __device__ __forceinline__ void operator()(const f32x4 (&acc)[2][2][4][2], const Unit& u, int wr, int wc, int fr, int fq) const {
        typedef unsigned u32x2 __attribute__((ext_vector_type(2)));
        const int row0 = u.pm * BM + wr * 64 + fr, col0 = u.pn * BM + wc * 32 + 4 * fq;
#pragma unroll
        for (int ai = 0; ai < 2; ++ai)
#pragma unroll
            for (int m = 0; m < 4; ++m) { const int row = row0 + ai * HALF + m * 16; const size_t rb = (size_t)row * ldc + col0; float ss = 0.f;
#pragma unroll
                for (int bj = 0; bj < 2; ++bj)
#pragma unroll
                    for (int n = 0; n < 2; ++n) { const size_t ix = rb + bj * HALF + n * 16; const f32x4 v = acc[ai][bj][m][n] + *(const f32x4*)(resid + ix);
                        *(f32x4*)(C + ix) = v; ss += (v[0] * v[0] + v[1] * v[1]) + (v[2] * v[2] + v[3] * v[3]);
                        const f32x4 gg = *(const f32x4*)(g + col0 + bj * HALF + n * 16);
                        u32x2 w; w.x = cvt_pk_bf16(v[0] * gg[0], v[1] * gg[1]); w.y = cvt_pk_bf16(v[2] * gg[2], v[3] * gg[3]); *(u32x2*)(XB + ix) = w; }
                ss += __shfl_xor(ss, 16); ss += __shfl_xor(ss, 32);
                if (fq == 0) rowss[(size_t)row * 16 + u.pn * 4 + wc] = ss; }
    }
};
struct EpiGlu {
    static constexpr bool PERM = true, AFTER_DRAIN = false;
    bf16_t* O; int ldc; const float* bias; const bf16_t* YG;
    __device__ __forceinline__ void operator()(const f32x4 (&acc)[2][2][4][2], const Unit& u, int wr, int wc, int fr, int fq) const {
        const int row0 = u.pm * BM + wr * 64 + fr, col0 = u.pn * BM + wc * 32 + 8 * fq;
#pragma unroll
        for (int ai = 0; ai < 2; ++ai)
#pragma unroll
            for (int m = 0; m < 4; ++m) { const size_t rb = (size_t)(row0 + ai * HALF + m * 16) * ldc + col0;
#pragma unroll
                for (int bj = 0; bj < 2; ++bj) { const size_t ix = rb + bj * HALF;
                    const f32x4 b0 = *(const f32x4*)(bias + col0 + bj * HALF), b1 = *(const f32x4*)(bias + col0 + bj * HALF + 4);
                    const u32x4 yw = *(const u32x4*)(YG + ix);
                    f32x4 v0 = acc[ai][bj][m][0] + b0, v1 = acc[ai][bj][m][1] + b1; float o[8];
#pragma unroll
                    for (int e = 0; e < 4; ++e) { const unsigned w = e == 0 ? yw.x : e == 1 ? yw.y : e == 2 ? yw.z : yw.w;
                        const float y0 = __uint_as_float(w << 16), y1 = __uint_as_float(w & 0xffff0000u);
                        const float a0 = e < 2 ? v0[2 * e] : v1[2 * e - 4], a1 = e < 2 ? v0[2 * e + 1] : v1[2 * e - 3];
                        o[2 * e] = y0 / (1.f + __expf(-a0)); o[2 * e + 1] = y1 / (1.f + __expf(-a1)); }
                    u32x4 w; w.x = cvt_pk_bf16(o[0], o[1]); w.y = cvt_pk_bf16(o[2], o[3]); w.z = cvt_pk_bf16(o[4], o[5]); w.w = cvt_pk_bf16(o[6], o[7]);
                    *(u32x4*)(O + ix) = w; } }
    }
};
template <class Epi, class Sched, bool ALIGN_EPI = false, bool SP2 = false>
__device__ __forceinline__ void gemm_phase(PG8_LAS unsigned char* lds, const Gemm g, const Sched& S, const Epi& E) {
    int tid_l = threadIdx.x; asm volatile("" : "+v"(tid_l));
    const int tid = tid_l, wid = __builtin_amdgcn_readfirstlane(tid >> 6), lane = tid & 63, wr = wid >> 2, wc = wid & 3, fr = lane & 15, fq = lane >> 4;
    const int K = g.K, nt = K / BK;
    unsigned voffA[2], voffB[2];
#pragma unroll
    for (int i = 0; i < 2; ++i) { int R, C; stage_rc(tid * 16 + i * 8192, R, C); const int Rb = Epi::PERM ? ((R & ~31) + perm32(R & 31)) : R;
        voffA[i] = (unsigned)(R * g.lda + C) * 2u; voffB[i] = (unsigned)(Rb * K + C) * 2u; }
    const size_t kstep = (size_t)(BK * 2);
    const size_t hsA = (size_t)HALF * g.lda * 2, hsB = (size_t)HALF * K * 2;
    const size_t tsA = 2 * hsA, tsB = 2 * hsB;
    const unsigned ldsw = (unsigned)wid * 1024u;
    const int aoff = lds_byte(wr * 64 + fr, fq * 8), boff = lds_byte(wc * 32 + fr, fq * 8);
#define PG8_SA(b, h) (((b) * 2 + (h)) * HTB)
#define PG8_SB(b, h) ((4 + (b) * 2 + (h)) * HTB)
#define PG8_STAGE(bufoff, gbase, voff) do { _Pragma("unroll") for (int _i = 0; _i < 2; ++_i) \
        __builtin_amdgcn_global_load_lds((const unsigned*)((const char*)(gbase) + (voff)[_i]), (PG8_LAS unsigned*)(lds + (bufoff) + ldsw + _i * 8192), 16, 0, 0); } while (0)
#define PG8_LDA(dst, b, h) do { _Pragma("unroll") for (int m = 0; m < 4; ++m) _Pragma("unroll") for (int k = 0; k < 2; ++k) dst[m][k] = *(const PG8_LAS bf16x8*)(lds + PG8_SA(b, h) + aoff + m * 2048 + k * 1024); } while (0)
#define PG8_LDB(dst, b, h) do { _Pragma("unroll") for (int n = 0; n < 2; ++n) _Pragma("unroll") for (int k = 0; k < 2; ++k) dst[n][k] = *(const PG8_LAS bf16x8*)(lds + PG8_SB(b, h) + boff + n * 2048 + k * 1024); } while (0)
#define PG8_MMA(ai, bj, At, Bt) do { __builtin_amdgcn_s_setprio(1); _Pragma("unroll") for (int m = 0; m < 4; ++m) _Pragma("unroll") for (int n = 0; n < 2; ++n) _Pragma("unroll") for (int k = 0; k < 2; ++k) \
        acc[ai][bj][m][n] = __builtin_amdgcn_mfma_f32_16x16x32_bf16(Bt[n][k], At[m][k], acc[ai][bj][m][n], 0, 0, 0); __builtin_amdgcn_s_setprio(0); } while (0)
#define PG8_WAIT_V(n) asm volatile("s_waitcnt vmcnt(" #n ")" ::: "memory")
#define PG8_WAIT_L(n) asm volatile("s_waitcnt lgkmcnt(" #n ")" ::: "memory")
#define PG8_BAR __builtin_amdgcn_s_barrier()
#define PG8_SCHED __builtin_amdgcn_sched_barrier(0)
    Unit cur, nxt; int ui = 0;
    if (!S.next(0, cur)) return;
    f32x4 acc[2][2][4][2];
#pragma unroll
    for (int a = 0; a < 2; ++a)
#pragma unroll
        for (int b = 0; b < 2; ++b)
#pragma unroll
            for (int m = 0; m < 4; ++m)
#pragma unroll
                for (int n = 0; n < 2; ++n) acc[a][b][m][n] = (f32x4){0.f, 0.f, 0.f, 0.f};
    bf16x8 At[4][2], B0[2][2], B1[2][2];
    const char* cA = (const char*)g.A + (size_t)cur.pm * tsA; const char* cB = (const char*)g.Bt + (size_t)cur.pn * tsB;
    S.a_ready(cur);
    if constexpr (SP2) {
        PG8_STAGE(PG8_SB(0, 0), cB, voffB); PG8_STAGE(PG8_SB(0, 1), cB + hsB, voffB); PG8_STAGE(PG8_SA(0, 0), cA, voffA); PG8_STAGE(PG8_SA(0, 1), cA + hsA, voffA);
        if (wr == 1) PG8_BAR;
        PG8_WAIT_V(2); PG8_BAR;
        PG8_STAGE(PG8_SB(1, 0), cB + kstep, voffB); PG8_STAGE(PG8_SA(1, 0), cA + kstep, voffA); PG8_STAGE(PG8_SB(1, 1), cB + hsB + kstep, voffB);
        PG8_WAIT_V(6); PG8_BAR;
    } else {
        PG8_STAGE(PG8_SB(0, 0), cB, voffB); PG8_STAGE(PG8_SA(0, 0), cA, voffA); PG8_STAGE(PG8_SB(0, 1), cB + hsB, voffB); PG8_STAGE(PG8_SA(0, 1), cA + hsA, voffA);
        if (wr == 1) PG8_BAR;
        PG8_WAIT_V(4); PG8_BAR;
        PG8_STAGE(PG8_SB(1, 0), cB + kstep, voffB); PG8_STAGE(PG8_SA(1, 0), cA + kstep, voffA); PG8_STAGE(PG8_SB(1, 1), cB + hsB + kstep, voffB);
        PG8_WAIT_V(6); PG8_BAR;
    }
    for (;;) {
        const bool has_next = S.next(ui + 1, nxt);
        const char* nA = has_next ? (const char*)g.A + (size_t)nxt.pm * tsA : cA; const char* nB = has_next ? (const char*)g.Bt + (size_t)nxt.pn * tsB : cB;
        for (int t = 0; t < nt; t += 2) {
            const bool last = (t == nt - 2);
            const char* a1 = cA + (size_t)(t + 1) * kstep;
            const char* a2 = last ? nA : cA + (size_t)(t + 2) * kstep; const char* b2 = last ? nB : cB + (size_t)(t + 2) * kstep;
            const char* a3 = a2 + kstep; const char* b3 = b2 + kstep;
            if (last && has_next) S.a_ready(nxt);
            if constexpr (SP2) {
            PG8_LDB(B0, 0, 0); PG8_LDB(B1, 0, 1); PG8_SCHED; PG8_LDA(At, 0, 0); PG8_STAGE(PG8_SA(1, 1), a1 + hsA, voffA);
            PG8_WAIT_V(8); PG8_WAIT_L(0); PG8_BAR; PG8_MMA(0, 0, At, B0); PG8_MMA(0, 1, At, B1); PG8_BAR; PG8_SCHED;
            PG8_LDA(At, 0, 1); PG8_STAGE(PG8_SB(0, 0), b2, voffB); PG8_STAGE(PG8_SB(0, 1), b2 + hsB, voffB); PG8_STAGE(PG8_SA(0, 0), a2, voffA);
            PG8_WAIT_V(8); PG8_WAIT_L(0); PG8_BAR; PG8_MMA(1, 0, At, B0); PG8_MMA(1, 1, At, B1); PG8_BAR; PG8_SCHED;
            PG8_LDB(B0, 1, 0); PG8_LDB(B1, 1, 1); PG8_SCHED; PG8_LDA(At, 1, 0); PG8_STAGE(PG8_SA(0, 1), a2 + hsA, voffA);
            PG8_WAIT_V(8); PG8_WAIT_L(0); PG8_BAR; PG8_MMA(0, 0, At, B0); PG8_MMA(0, 1, At, B1); PG8_BAR; PG8_SCHED;
            PG8_LDA(At, 1, 1); PG8_STAGE(PG8_SB(1, 0), b3, voffB); PG8_STAGE(PG8_SB(1, 1), b3 + hsB, voffB); PG8_STAGE(PG8_SA(1, 0), a3, voffA);
            PG8_WAIT_V(8); PG8_WAIT_L(0); PG8_BAR; PG8_MMA(1, 0, At, B0); PG8_MMA(1, 1, At, B1); PG8_BAR; PG8_SCHED;
            } else {
            PG8_LDB(B0, 0, 0); PG8_SCHED; PG8_LDA(At, 0, 0); PG8_STAGE(PG8_SA(1, 1), a1 + hsA, voffA);
            PG8_WAIT_L(8); PG8_BAR; PG8_WAIT_L(0); PG8_MMA(0, 0, At, B0); PG8_BAR; PG8_SCHED;
            PG8_LDB(B1, 0, 1); PG8_STAGE(PG8_SB(0, 0), b2, voffB);
            PG8_BAR; PG8_WAIT_L(0); PG8_MMA(0, 1, At, B1); PG8_BAR;
            PG8_LDA(At, 0, 1); PG8_STAGE(PG8_SA(0, 0), a2, voffA);
            PG8_BAR; PG8_WAIT_L(0); PG8_MMA(1, 0, At, B0); PG8_BAR; PG8_SCHED;
            PG8_STAGE(PG8_SB(0, 1), b2 + hsB, voffB);
            PG8_WAIT_V(6); PG8_BAR; PG8_MMA(1, 1, At, B1); PG8_BAR;
            PG8_LDB(B0, 1, 0); PG8_SCHED; PG8_LDA(At, 1, 0); PG8_STAGE(PG8_SA(0, 1), a2 + hsA, voffA);
            PG8_WAIT_L(8); PG8_BAR; PG8_WAIT_L(0); PG8_MMA(0, 0, At, B0); PG8_BAR; PG8_SCHED;
            PG8_LDB(B1, 1, 1); PG8_STAGE(PG8_SB(1, 0), b3, voffB);
            PG8_BAR; PG8_WAIT_L(0); PG8_MMA(0, 1, At, B1); PG8_BAR;
            PG8_LDA(At, 1, 1); PG8_STAGE(PG8_SA(1, 0), a3, voffA);
            PG8_BAR; PG8_WAIT_L(0); PG8_MMA(1, 0, At, B0); PG8_BAR; PG8_SCHED;
            PG8_STAGE(PG8_SB(1, 1), b3 + hsB, voffB);
            PG8_WAIT_V(6); PG8_BAR; PG8_MMA(1, 1, At, B1); PG8_BAR;
            }
        }
        if constexpr (ALIGN_EPI) { if (wr == 0) PG8_BAR; }
        if constexpr (!Epi::AFTER_DRAIN) { E(acc, cur, wr, wc, fr, fq); S.done(cur); }
        if (!has_next) break;
#pragma unroll
        for (int a = 0; a < 2; ++a)
#pragma unroll
            for (int b = 0; b < 2; ++b)
#pragma unroll
                for (int m = 0; m < 4; ++m)
#pragma unroll
                    for (int n = 0; n < 2; ++n) acc[a][b][m][n] = (f32x4){0.f, 0.f, 0.f, 0.f};
        cur = nxt; cA = nA; cB = nB; ++ui;
        if constexpr (ALIGN_EPI) { if (wr == 1) PG8_BAR; }
    }
    PG8_WAIT_V(0);
    if constexpr (!ALIGN_EPI) { if (wr == 0) PG8_BAR; }
    PG8_BAR;
    if constexpr (Epi::AFTER_DRAIN) { E.fused(acc, cur, wr, wc, fr, fq, lds, wid, lane); S.done(cur); }
#undef PG8_SA
#undef PG8_SB
#undef PG8_STAGE
#undef PG8_LDA
#undef PG8_LDB
#undef PG8_MMA
#undef PG8_WAIT_V
#undef PG8_WAIT_L
#undef PG8_BAR
#undef PG8_SCHED
}
}
#define GAS __attribute__((address_space(1)))
#define LAS __attribute__((address_space(3)))
#define XB_TMO      128
#define XB_XCNT(j)  (256  + 64 * (j))
#define XB_XSUB(j)  (1280 + 64 * (j))
#define XB_XGEN(j)  (2304 + 64 * (j))
#define XB_TOP      3328
#define XB_TOPGEN   3392
#define XCD_BAR_WORDS 3456
#define XB_SPIN_CAP (1u << 25)
__device__ __forceinline__ unsigned xb_ld(unsigned* p)              { return __hip_atomic_load(p, __ATOMIC_RELAXED, __HIP_MEMORY_SCOPE_AGENT); }
__device__ __forceinline__ unsigned xb_add(unsigned* p, unsigned v) { return __hip_atomic_fetch_add(p, v, __ATOMIC_RELAXED, __HIP_MEMORY_SCOPE_AGENT); }
__device__ __forceinline__ unsigned xb_xcc_id() { return (unsigned)__builtin_amdgcn_s_getreg((3 << 11) | 20) & 0xFu; }
#define XB_SPIN(cond, bar) do { unsigned _sp = 0; while (cond) { __builtin_amdgcn_s_sleep(1); \
    if ((++_sp & 255u) == 0u) { if (xb_ld(&(bar)[XB_TMO])) break; if (_sp > XB_SPIN_CAP) { atomicAdd(&(bar)[XB_TMO], 1u); break; } } } } while (0)
struct XcdBarrier { unsigned* bar; unsigned x; volatile LAS unsigned* st; };
__device__ __forceinline__ XcdBarrier xcd_barrier_post(unsigned* bar, volatile LAS unsigned* st) {
    XcdBarrier b; b.bar = bar; b.x = xb_xcc_id(); b.st = st;
    if (threadIdx.x == 0) (void)xb_add(&bar[XB_XCNT(b.x)], 1u);
    return b;
}
__device__ __forceinline__ void xcd_barrier_complete(unsigned* bar, unsigned x, unsigned& nloc, unsigned& nx) {
    const unsigned G = gridDim.x * gridDim.y * gridDim.z;
    unsigned sum, cnt, mine, sp = 0u;
    for (;;) {
        sum = 0u; cnt = 0u; mine = 0u;
#pragma unroll
        for (unsigned j = 0; j < 16; ++j) { const unsigned c = xb_ld(&bar[XB_XCNT(j)]); sum += c; cnt += (c > 0u) ? 1u : 0u; mine = (j == x) ? c : mine; }
        if (sum == G) break;
        __builtin_amdgcn_s_sleep(1);
        if ((++sp & 255u) == 0u) { if (xb_ld(&bar[XB_TMO])) break; if (sp > XB_SPIN_CAP) { atomicAdd(&bar[XB_TMO], 1u); break; } }
    }
    nloc = mine > 0u ? mine : 1u; nx = cnt > 0u ? cnt : 1u;
}
__device__ __forceinline__ void xcd_barrier(const XcdBarrier& b) {
    asm volatile("s_waitcnt vmcnt(0)" ::: "memory");
    __syncthreads();
    if (threadIdx.x == 0) {
        unsigned* bar = b.bar;
        __builtin_amdgcn_s_waitcnt(0);
        unsigned nloc = b.st[0], nx = b.st[1];
        if (nloc == 0u) { xcd_barrier_complete(bar, b.x, nloc, nx); b.st[0] = nloc; b.st[1] = nx; }
        const unsigned old = xb_add(&bar[XB_XSUB(b.x)], 1u);
        const unsigned gen = old / nloc;
        if (old + 1u == (gen + 1u) * nloc) {
            __builtin_amdgcn_fence(__ATOMIC_RELEASE, "agent");
            asm volatile("s_waitcnt vmcnt(0)" ::: "memory");
            const unsigned og = xb_add(&bar[XB_TOP], 1u);
            const unsigned tg = og / nx;
            if (og + 1u == (tg + 1u) * nx) xb_add(&bar[XB_TOPGEN], 1u);
            else XB_SPIN(xb_ld(&bar[XB_TOPGEN]) == tg, bar);
            __builtin_amdgcn_fence(__ATOMIC_ACQUIRE, "agent");
            xb_add(&bar[XB_XGEN(b.x)], 1u);
            asm volatile("s_waitcnt vmcnt(0)" ::: "memory");
        } else {
            XB_SPIN(xb_ld(&bar[XB_XGEN(b.x)]) == gen, bar);
            __builtin_amdgcn_fence(__ATOMIC_ACQUIRE, "agent");
            asm volatile("s_waitcnt vmcnt(0)" ::: "memory");
        }
    }
    __syncthreads();
}
namespace s5f {
typedef short bf16x8 __attribute__((ext_vector_type(8)));
typedef float f32x4 __attribute__((ext_vector_type(4)));
typedef unsigned u32x2 __attribute__((ext_vector_type(2)));
constexpr int LC = 32, NCH = SEQ / LC, RS = 272, WBYTES = LC * RS;
__device__ __forceinline__ void build_tables(const float* a_re, const float* a_im, const float* log_dt, const float* b_re, const float* b_im, const float* c_re, const float* c_im,
                                             bf16* S5A, bf16* S5C, float2* S5L, int gt, int ngt) {
    for (int i = gt; i < 16 * 64; i += ngt) {
        const int g = i >> 6;
        const float are = a_re[i], aim = a_im[i], dt = expf(log_dt[g]);
        const float mag = expf(are * dt); float sn, cs; sincos_acc(aim * dt, sn, cs);
        const float lre = mag * cs, lim = mag * sn;
        const float xr = lre - 1.f, xi = lim, den = are * are + aim * aim;
        const float cr = (xr * are + xi * aim) / den, ci = (xi * are - xr * aim) / den;
        S5L[i] = make_float2(lre, lim);
        const int p = i & 63;
        for (int k = 0; k < 16; ++k) { const float br = b_re[i * 16 + k], bi = b_im[i * 16 + k];
            S5A[((size_t)g * 128 + 2 * p) * 16 + k] = f2bf(cr * br - ci * bi); S5A[((size_t)g * 128 + 2 * p + 1) * 16 + k] = f2bf(cr * bi + ci * br);
            S5C[((size_t)g * 16 + k) * 128 + 2 * p] = f2bf(c_re[(g * 16 + k) * 64 + p]); S5C[((size_t)g * 16 + k) * 128 + 2 * p + 1] = f2bf(-c_im[(g * 16 + k) * 64 + p]); }
    }
}
template <bool FULL> __device__ __forceinline__ void chunk(LAS unsigned char* wl, const bf16* Z, const bf16x8 (&afr)[8], const bf16x8 (&cfr)[4], float lre, float lim, float& hre, float& him,
                                                           int b, int ch, int g, int lane, const float* dsk, bf16* YG) {
    const int l15 = lane & 15, q4 = lane >> 4;
    const size_t t0 = (size_t)b * SEQ + (size_t)ch * LC;
#pragma unroll
    for (int nb = 0; nb < 2; ++nb) {
        bf16x8 ufr = bf16x8{};
        if (q4 < 2) ufr = *(const bf16x8*)(Z + (t0 + 16 * nb + l15) * ZW + ZC_U + g * 16 + 8 * q4);
#pragma unroll
        for (int mb = 0; mb < 8; ++mb) {
            f32x4 d = __builtin_amdgcn_mfma_f32_16x16x32_bf16(afr[mb], ufr, f32x4{0.f, 0.f, 0.f, 0.f}, 0, 0, 0);
            *(LAS u32x2*)(wl + (16 * nb + l15) * RS + (16 * mb + 4 * q4) * 2) = u32x2{pk2(d[0], d[1]), pk2(d[2], d[3])};
        }
    }
#pragma unroll 8
    for (int k = 0; k < LC; ++k) {
        LAS unsigned* wp = (LAS unsigned*)(wl + k * RS + 4 * lane);
        const unsigned w = *wp; const float bre = __uint_as_float(w << 16), bim = __uint_as_float(w & 0xffff0000u);
        const float nre = fmaf(lre, hre, fmaf(-lim, him, bre)), nim = fmaf(lre, him, fmaf(lim, hre, bim)); hre = nre; him = nim;
        if (FULL) *wp = pk2(hre, him);
    }
    if (FULL) {
#pragma unroll
        for (int nb = 0; nb < 2; ++nb) {
            f32x4 y = f32x4{0.f, 0.f, 0.f, 0.f};
#pragma unroll
            for (int ks = 0; ks < 4; ++ks) {
                const bf16x8 hfr = *(const LAS bf16x8*)(wl + (16 * nb + l15) * RS + (32 * ks + 8 * q4) * 2);
                y = __builtin_amdgcn_mfma_f32_16x16x32_bf16(cfr[ks], hfr, y, 0, 0, 0);
            }
            const size_t t = t0 + 16 * nb + l15; const int co = 4 * q4;
            const uint2 uw = *(const uint2*)(Z + t * ZW + ZC_U + g * 16 + co);
            const float4 dd = *(const float4*)(dsk + g * 16 + co);
            const float y0 = y[0] + dd.x * __uint_as_float(uw.x << 16), y1 = y[1] + dd.y * __uint_as_float(uw.x & 0xffff0000u),
                        y2 = y[2] + dd.z * __uint_as_float(uw.y << 16), y3 = y[3] + dd.w * __uint_as_float(uw.y & 0xffff0000u);
            *(uint2*)(YG + t * 256 + g * 16 + co) = make_uint2(pk2(gelu_f(y0), gelu_f(y1)), pk2(gelu_f(y2), gelu_f(y3)));
        }
    }
}
template <bool FULL> __device__ __forceinline__ void pass(LAS unsigned char* lds, const bf16* Z, const bf16* S5A, const bf16* S5C, const float2* S5L, const float* dsk,
                                                          float2* SE, const float2* SH, bf16* YG, int gw, int ngw, int wave, int lane) {
    LAS unsigned char* wl = lds + wave * WBYTES;
    const int g = gw & 15, l15 = lane & 15, q4 = lane >> 4;
    bf16x8 afr[8], cfr[4];
#pragma unroll
    for (int mb = 0; mb < 8; ++mb) { afr[mb] = bf16x8{}; if (q4 < 2) afr[mb] = *(const bf16x8*)(S5A + ((size_t)g * 128 + 16 * mb + l15) * 16 + 8 * q4); }
#pragma unroll
    for (int ks = 0; ks < 4; ++ks) { cfr[ks] = bf16x8{}; if (FULL) cfr[ks] = *(const bf16x8*)(S5C + ((size_t)g * 16 + l15) * 128 + 32 * ks + 8 * q4); }
    const float2 lam = S5L[g * 64 + lane];
    for (int it = gw >> 4; it < NB * NCH; it += ngw >> 4) {
        const int b = it / NCH, ch = it % NCH;
        float hre = 0.f, him = 0.f;
        if (FULL) { const float2 h0 = SH[((size_t)it * 16 + g) * 64 + lane]; hre = h0.x; him = h0.y; }
        chunk<FULL>(wl, Z, afr, cfr, lam.x, lam.y, hre, him, b, ch, g, lane, dsk, YG);
        if (!FULL) SE[((size_t)it * 16 + g) * 64 + lane] = make_float2(hre, him);
    }
}
__device__ __forceinline__ void carry_wg(LAS unsigned char* lds, const float2* S5L, const float2* SE, float2* SH, int item, int wave, int lane) {
    typedef float f32x2v __attribute__((ext_vector_type(2)));
    LAS f32x2v* tot = (LAS f32x2v*)lds;
    const int b = item >> 4, g = item & 15;
    float2 L = S5L[g * 64 + lane];
#pragma unroll
    for (int i = 0; i < 5; ++i) { const float re = L.x * L.x - L.y * L.y, im = 2.f * L.x * L.y; L.x = re; L.y = im; }
    float hre = 0.f, him = 0.f;
    const size_t base = (((size_t)b * NCH + 32 * wave) * 16 + g) * 64 + lane;
    float2 e[32];
#pragma unroll
    for (int c = 0; c < 32; ++c) e[c] = SE[base + (size_t)c * 1024];
#pragma unroll
    for (int c = 0; c < 32; ++c) { const float nre = L.x * hre - L.y * him + e[c].x, nim = L.x * him + L.y * hre + e[c].y; e[c] = make_float2(hre, him); hre = nre; him = nim; }
    tot[wave * 64 + lane] = f32x2v{hre, him};
    float2 LS = L;
#pragma unroll
    for (int i = 0; i < 5; ++i) { const float re = LS.x * LS.x - LS.y * LS.y, im = 2.f * LS.x * LS.y; LS.x = re; LS.y = im; }
    __syncthreads();
    float cre = 0.f, cim = 0.f;
    for (int w = 0; w < wave; ++w) { const f32x2v s = tot[w * 64 + lane]; const float nre = LS.x * cre - LS.y * cim + s.x, nim = LS.x * cim + LS.y * cre + s.y; cre = nre; cim = nim; }
#pragma unroll
    for (int c = 0; c < 32; ++c) { SH[base + (size_t)c * 1024] = make_float2(e[c].x + cre, e[c].y + cim); const float nre = L.x * cre - L.y * cim, nim = L.x * cim + L.y * cre; cre = nre; cim = nim; }
    __syncthreads();
}
}
namespace lruf {
typedef float f32x4 __attribute__((ext_vector_type(4)));
constexpr int LC = 32, NCH = SEQ / LC, XS = 68;
__device__ __forceinline__ void pass_a(LAS unsigned char* lds, const bf16* Z, const float* cw, const float* cb, const float* wa, const float* ba, const float* wx, const float* bx, const float* lam,
                                       float* AA, float* BT, float2* LPE, int gw, int ngw, int wave, int lane) {
    LAS float* xt = (LAS float*)lds + wave * (LC * XS);
    for (int item = gw; item < NB * NCH * 4; item += ngw) {
        const int h = item & 3, bc = item >> 2, b = bc / NCH, ch = bc % NCH, c = h * 64 + lane;
        const size_t t0 = (size_t)b * SEQ + (size_t)ch * LC;
        const float w0 = cw[c], w1 = cw[256 + c], w2 = cw[512 + c], w3 = cw[768 + c], bias = cb[c];
        float z0 = 0.f, z1 = 0.f, z2 = 0.f;
        if (ch > 0) { z0 = bf2f(Z[(t0 - 3) * ZW + ZC_X + c]); z1 = bf2f(Z[(t0 - 2) * ZW + ZC_X + c]); z2 = bf2f(Z[(t0 - 1) * ZW + ZC_X + c]); }
        float xc[LC];
#pragma unroll
        for (int k = 0; k < LC; ++k) { const float z3 = bf2f(Z[(t0 + k) * ZW + ZC_X + c]); xc[k] = bias + w0 * z0 + w1 * z1 + w2 * z2 + w3 * z3; z0 = z1; z1 = z2; z2 = z3; xt[k * XS + lane] = xc[k]; }
        float ra[LC], rx[LC];
        { const float b0 = ba[c], b1 = bx[c];
#pragma unroll
          for (int k = 0; k < LC; ++k) { ra[k] = b0; rx[k] = b1; } }
        const float* wap = wa + (size_t)h * 4096 + lane; const float* wxp = wx + (size_t)h * 4096 + lane;
        for (int i = 0; i < 64; i += 4) {
            const float a0 = wap[(i + 0) * 64], a1 = wap[(i + 1) * 64], a2 = wap[(i + 2) * 64], a3 = wap[(i + 3) * 64];
            const float x0 = wxp[(i + 0) * 64], x1 = wxp[(i + 1) * 64], x2 = wxp[(i + 2) * 64], x3 = wxp[(i + 3) * 64];
#pragma unroll
            for (int k = 0; k < LC; ++k) { const f32x4 v = *(const LAS f32x4*)(xt + k * XS + i);
                ra[k] += v.x * a0 + v.y * a1 + v.z * a2 + v.w * a3; rx[k] += v.x * x0 + v.y * x1 + v.z * x2 + v.w * x3; }
        }
        const float lsg8 = -8.f * log1pf(expf(-lam[c]));
        float hloc = 0.f, prod = 1.f;
#pragma unroll
        for (int k = 0; k < LC; ++k) {
            const float r = sigmoid_f(ra[k]), ig = sigmoid_f(rx[k]);
            const float la = r * lsg8, av = expf(la), bt = sqrtf(-expm1f(2.f * la)) * (ig * xc[k]);
            AA[(t0 + k) * 256 + c] = av; BT[(t0 + k) * 256 + c] = bt;
            hloc = av * hloc + bt; prod *= av;
        }
        LPE[(size_t)bc * 256 + c] = make_float2(prod, hloc);
    }
}
__device__ __forceinline__ void carry_wg(LAS unsigned char* lds, const float2* LPE, float* LH, int item, int wave, int lane) {
    typedef float f32x2v __attribute__((ext_vector_type(2)));
    LAS f32x2v* tot = (LAS f32x2v*)lds;
    const int b = item >> 2, ch = (item & 3) * 64 + lane;
    const size_t base = ((size_t)b * NCH + 32 * wave) * 256 + ch;
    float2 pe[32];
#pragma unroll
    for (int c = 0; c < 32; ++c) pe[c] = LPE[base + (size_t)c * 256];
    float h = 0.f, prod = 1.f;
#pragma unroll
    for (int c = 0; c < 32; ++c) { const float p = pe[c].x, e = pe[c].y; pe[c] = make_float2(prod, h); h = p * h + e; prod *= p; }
    tot[wave * 64 + lane] = f32x2v{prod, h};
    __syncthreads();
    float cin = 0.f;
    for (int w = 0; w < wave; ++w) { const f32x2v s = tot[w * 64 + lane]; cin = s.x * cin + s.y; }
#pragma unroll
    for (int c = 0; c < 32; ++c) LH[base + (size_t)c * 256] = pe[c].y + pe[c].x * cin;
    __syncthreads();
}
__device__ __forceinline__ void pass_b(const float* AA, const float* BT, const float* LH, const bf16* Z, bf16* ROUT, int gt, int ngt) {
    for (int i = gt; i < NB * NCH * 256; i += ngt) { const int c = i & 255, bc = i >> 8; const size_t t0 = (size_t)bc * LC;
        float h = LH[i];
#pragma unroll 8
        for (int k = 0; k < LC; ++k) { const size_t t = t0 + k;
            h = AA[t * 256 + c] * h + BT[t * 256 + c];
            ROUT[t * 256 + c] = f2bf(h * gelu_f(bf2f(Z[t * ZW + ZC_G + c]))); } }
}
}
namespace pgf {
typedef float f32x2 __attribute__((ext_vector_type(2)));
typedef unsigned u32x4 __attribute__((ext_vector_type(4)));
constexpr float USCALE = 64.f, VSCALE = 4.f;
__device__ __forceinline__ unsigned pack4_fp8(float a, float b, float c, float d) {
    int w = __builtin_amdgcn_cvt_pk_fp8_f32(a, b, 0, false); w = __builtin_amdgcn_cvt_pk_fp8_f32(c, d, w, true); return (unsigned)w; }
__device__ __forceinline__ void unpack16(const u32x4 w, float* o) {
#pragma unroll
    for (int d = 0; d < 4; ++d) { const f32x2 lo = __builtin_amdgcn_cvt_pk_f32_fp8((int)w[d], false), hi = __builtin_amdgcn_cvt_pk_f32_fp8((int)w[d], true);
        o[4 * d] = lo.x; o[4 * d + 1] = lo.y; o[4 * d + 2] = hi.x; o[4 * d + 3] = hi.y; }
}
__device__ __forceinline__ void convert(const float* in, unsigned char* out8, size_t n, float scale, int gt, int ngt) {
    const size_t n16 = n / 16;
    for (size_t i = gt; i < n16; i += ngt) {
        const float4* p = (const float4*)(in + i * 16);
        const float4 a = p[0], b = p[1], c = p[2], d = p[3];
        u32x4 w; w.x = pack4_fp8(a.x * scale, a.y * scale, a.z * scale, a.w * scale); w.y = pack4_fp8(b.x * scale, b.y * scale, b.z * scale, b.w * scale);
        w.z = pack4_fp8(c.x * scale, c.y * scale, c.z * scale, c.w * scale); w.w = pack4_fp8(d.x * scale, d.y * scale, d.z * scale, d.w * scale);
        *(u32x4*)(out8 + i * 16) = w;
    }
}
template <int EMASK = 0x3fff, bool LOADONLY = false> __device__ __forceinline__ void gather(const bf16* HN, const int* IDX, const float* GATE, const unsigned char* PU8, const unsigned char* PV8, float* X, int gw, int ngw, int lane) {
    for (int t = gw; t < T; t += ngw) {
        float hn[16]; unpack8(*(const uint4*)(HN + (size_t)t * DM + 16 * lane), hn); unpack8(*(const uint4*)(HN + (size_t)t * DM + 16 * lane + 8), hn + 8);
        const int id0 = IDX[(size_t)t * 128 + lane], id1 = IDX[(size_t)t * 128 + 64 + lane];
        const float g0 = GATE[(size_t)t * 128 + lane], g1 = GATE[(size_t)t * 128 + 64 + lane];
        float y[16];
#pragma unroll
        for (int e = 0; e < 16; ++e) y[e] = 0.f;
        for (int kb = 0; kb < 128; kb += 4) {
            int eid[4]; float gt4[4]; u32x4 uw[4], vw[4];
#pragma unroll
            for (int q = 0; q < 4; ++q) { const int k = kb + q;
                eid[q] = __builtin_amdgcn_readlane(k < 64 ? id0 : id1, k & 63) & EMASK; gt4[q] = __builtin_bit_cast(float, __builtin_amdgcn_readlane(__builtin_bit_cast(int, k < 64 ? g0 : g1), k & 63)); }
#pragma unroll
            for (int q = 0; q < 4; ++q) { uw[q] = *(const u32x4*)(PU8 + (size_t)eid[q] * DM + 16 * lane); vw[q] = *(const u32x4*)(PV8 + (size_t)eid[q] * DM + 16 * lane); }
            if (LOADONLY) {
#pragma unroll
                for (int q = 0; q < 4; ++q) { y[0] += __uint_as_float((uw[q][0] ^ vw[q][1]) & 0x3f800000u); y[1] += __uint_as_float((uw[q][2] ^ vw[q][3]) & 0x3f800000u); y[2] += __uint_as_float((uw[q][1] ^ vw[q][0] ^ uw[q][3] ^ vw[q][2]) & 0x3f800000u); }
            } else
#pragma unroll
            for (int q = 0; q < 4; ++q) {
                float u[16]; unpack16(uw[q], u);
                float d0 = 0.f, d1 = 0.f;
#pragma unroll
                for (int e = 0; e < 16; e += 2) { d0 = fmaf(u[e], hn[e], d0); d1 = fmaf(u[e + 1], hn[e + 1], d1); }
                const float d = wave_sum(d0 + d1) * (1.f / USCALE);
                const float w = gt4[q] * gelu_f(d) * (1.f / VSCALE);
                float v[16]; unpack16(vw[q], v);
#pragma unroll
                for (int e = 0; e < 16; ++e) y[e] = fmaf(w, v[e], y[e]);
            }
        }
        float4* xo = (float4*)(X + (size_t)t * DM + 16 * lane);
#pragma unroll
        for (int q = 0; q < 4; ++q) { float4 p = xo[q]; p.x += y[4 * q]; p.y += y[4 * q + 1]; p.z += y[4 * q + 2]; p.w += y[4 * q + 3]; xo[q] = p; }
    }
}
}
namespace tk {
__device__ __forceinline__ float row_rstd(const float* ROWSS, size_t t) { const float4* p = (const float4*)(ROWSS + t * 16); const float4 a = p[0], b = p[1], c = p[2], d = p[3];
    const float s = (((a.x + a.y) + (a.z + a.w)) + ((b.x + b.y) + (b.z + b.w))) + (((c.x + c.y) + (c.z + c.w)) + ((d.x + d.y) + (d.z + d.w))); return rsqrtf(s * (1.f / DM) + EPS); }
typedef short bf16x8 __attribute__((ext_vector_type(8)));
typedef float f32x4 __attribute__((ext_vector_type(4)));
__device__ const unsigned char PAIR_TAB[64] = {
    0x00,0x01,0x02,0x03,0x04,0x05,0x06,0x07,0x08,0x09,0x0a,0x0b,0x0c,0x0d,0x0e,0x0f, 0x10,0x11,0x12,0x13,0x14,0x15,0x16,0x17, 0x20,0x21,0x22,0x23,0x24, 0x30,0x31,0x32,0x33,
    0x40,0x41,0x42, 0x50,0x51, 0x60,0x61, 0x70,0x71, 0x80,0x90,0xa0,0xb0,0xc0,0xd0,0xe0,0xf0, 0,0,0,0,0,0,0,0,0,0,0,0,0,0};
template <int CTRL> __device__ __forceinline__ float dppf(float v) { return __builtin_bit_cast(float, __builtin_amdgcn_update_dpp(0, __builtin_bit_cast(int, v), CTRL, 0xf, 0xf, true)); }
__device__ __forceinline__ float rmax16(float v) { v = fmaxf(v, dppf<0xB1>(v)); v = fmaxf(v, dppf<0x4E>(v)); v = fmaxf(v, dppf<0x141>(v)); v = fmaxf(v, dppf<0x140>(v)); return v; }
__device__ __forceinline__ float rsum16(float v) { v += dppf<0xB1>(v); v += dppf<0x4E>(v); v += dppf<0x141>(v); v += dppf<0x140>(v); return v; }
#define TK_CX(a, b) do { const float hi_ = fmaxf(a, b), lo_ = fminf(a, b); a = hi_; b = lo_; } while (0)
__device__ __forceinline__ float packkey(float v, unsigned id, unsigned mask) { return __uint_as_float((__float_as_uint(v) & ~mask) | id); }
__device__ __forceinline__ void select16(float (&k)[4][8], float (&top)[4], int l15) {
    const float NEG = -__builtin_inff();
#pragma unroll
    for (int r = 0; r < 4; ++r) {
        TK_CX(k[r][0], k[r][1]); TK_CX(k[r][2], k[r][3]); TK_CX(k[r][4], k[r][5]); TK_CX(k[r][6], k[r][7]);
        TK_CX(k[r][0], k[r][2]); TK_CX(k[r][1], k[r][3]); TK_CX(k[r][4], k[r][6]); TK_CX(k[r][5], k[r][7]);
        TK_CX(k[r][1], k[r][2]); TK_CX(k[r][5], k[r][6]);
        TK_CX(k[r][0], k[r][4]); TK_CX(k[r][1], k[r][5]); TK_CX(k[r][2], k[r][6]); TK_CX(k[r][3], k[r][7]);
        TK_CX(k[r][2], k[r][4]); TK_CX(k[r][3], k[r][5]);
        TK_CX(k[r][1], k[r][2]); TK_CX(k[r][3], k[r][4]); TK_CX(k[r][5], k[r][6]);
        top[r] = NEG;
    }
#pragma unroll
    for (int i = 0; i < 16; ++i)
#pragma unroll
        for (int r = 0; r < 4; ++r) {
            const float w = rmax16(k[r][0]);
            if (l15 == i) top[r] = w;
            if (k[r][0] == w) {
#pragma unroll
                for (int e = 0; e < 7; ++e) k[r][e] = k[r][e + 1];
                k[r][7] = NEG; }
        }
}
template <bool FUSE> __device__ __forceinline__ void topk_phase(const bf16* QP, const bf16* SUBKB, int* IDX, float* GATE, bf16* HN, const unsigned char* PU8, const unsigned char* PV8, float* X, const float* ROWSS, const float* gnext, LAS unsigned char* wl, int gw, int ngw, int lane) {
    const float NEG = -__builtin_inff();
    const int l15 = lane & 15, q4 = lane >> 4, gbase = 16 * q4;
    unsigned pcs[4];
#pragma unroll
    for (int j = 0; j < 4; ++j) pcs[j] = PAIR_TAB[l15 + 16 * j];
    for (int item = gw; item < T * 8 / 16; item += ngw) {
        const size_t R0 = (size_t)item * 16;
        const float rstd_g = row_rstd(ROWSS, (size_t)item * 2 + (q4 >> 1));
        const bf16* qrow = QP + (R0 + l15) * 256 + 8 * q4;
        float topA[4], topB[4];
#pragma unroll
        for (int p = 0; p < 2; ++p) {
            f32x4 acc[8];
#pragma unroll
            for (int nb = 0; nb < 8; ++nb) acc[nb] = f32x4{0.f, 0.f, 0.f, 0.f};
#pragma unroll 1
            for (int ks = 0; ks < 4; ++ks) {
                const bf16x8 afr = *(const bf16x8*)(qrow + p * 128 + 32 * ks);
#pragma unroll
                for (int nb = 0; nb < 8; ++nb) {
                    const bf16x8 bfr = *(const bf16x8*)(SUBKB + ((size_t)(p * 128 + 16 * nb + l15) * 128 + 32 * ks + 8 * q4));
                    acc[nb] = __builtin_amdgcn_mfma_f32_16x16x32_bf16(afr, bfr, acc[nb], 0, 0, 0);
                }
            }
            float k[4][8];
#pragma unroll
            for (int r = 0; r < 4; ++r)
#pragma unroll
                for (int nb = 0; nb < 8; ++nb) k[r][nb] = packkey(acc[nb][r], (unsigned)(16 * nb + l15), 127u);
            if (p == 0) select16(k, topA, l15); else select16(k, topB, l15);
        }
        float c[4][4];
#pragma unroll
        for (int r = 0; r < 4; ++r) {
#pragma unroll
            for (int j = 0; j < 4; ++j) {
                const float s0 = __shfl(topA[r], gbase + (int)(pcs[j] >> 4)), s1 = __shfl(topB[r], gbase + (int)(pcs[j] & 15));
                c[r][j] = (l15 + 16 * j < 50) ? packkey(s0 + s1, (unsigned)(l15 + 16 * j), 63u) : NEG;
            }
            TK_CX(c[r][0], c[r][1]); TK_CX(c[r][2], c[r][3]); TK_CX(c[r][0], c[r][2]); TK_CX(c[r][1], c[r][3]); TK_CX(c[r][1], c[r][2]);
        }
        float win[4], w0[4];
#pragma unroll
        for (int r = 0; r < 4; ++r) { win[r] = NEG; w0[r] = 0.f; }
#pragma unroll
        for (int i = 0; i < 16; ++i)
#pragma unroll
            for (int r = 0; r < 4; ++r) {
                const float w = rmax16(c[r][0]);
                if (i == 0) w0[r] = w;
                if (l15 == i) win[r] = w;
                if (c[r][0] == w) { c[r][0] = c[r][1]; c[r][1] = c[r][2]; c[r][2] = c[r][3]; c[r][3] = NEG; }
            }
        int idr[4]; float gtr[4];
#pragma unroll
        for (int r = 0; r < 4; ++r) {
            const unsigned pcw = PAIR_TAB[__float_as_uint(win[r]) & 63u];
            const int i0 = (int)(__float_as_uint(__shfl(topA[r], gbase + (int)(pcw >> 4))) & 127u), i1 = (int)(__float_as_uint(__shfl(topB[r], gbase + (int)(pcw & 15))) & 127u);
            const float e = __expf((win[r] - w0[r]) * rstd_g); const float sum = rsum16(e);
            idr[r] = i0 * 128 + i1; gtr[r] = e / sum;
            if (!FUSE) { const size_t row = R0 + 4 * q4 + r; IDX[row * 16 + l15] = idr[r]; GATE[row * 16 + l15] = gtr[r]; }
        }
        if (FUSE) {
            typedef float f32x2 __attribute__((ext_vector_type(2)));
            LAS unsigned char* img = wl;
#pragma unroll 1
            for (int tau = 0; tau < 2; ++tau) {
                const size_t t = (size_t)item * 2 + tau;
                const float rstd_t = row_rstd(ROWSS, t);
                {
                    float hn[16]; unpack8(*(const uint4*)(HN + t * DM + 16 * lane), hn); unpack8(*(const uint4*)(HN + t * DM + 16 * lane + 8), hn + 8);
#pragma unroll
                    for (int bq = 0; bq < 2; ++bq) {
                        float h1[8], h2[8]; unsigned w1[2], w2[2];
#pragma unroll
                        for (int d = 0; d < 2; ++d) { w1[d] = pgf::pack4_fp8(hn[8 * bq + 4 * d] * 8.f, hn[8 * bq + 4 * d + 1] * 8.f, hn[8 * bq + 4 * d + 2] * 8.f, hn[8 * bq + 4 * d + 3] * 8.f);
                            const f32x2 lo = __builtin_amdgcn_cvt_pk_f32_fp8((int)w1[d], false), hi = __builtin_amdgcn_cvt_pk_f32_fp8((int)w1[d], true);
                            h1[4 * d] = lo.x; h1[4 * d + 1] = lo.y; h1[4 * d + 2] = hi.x; h1[4 * d + 3] = hi.y; }
#pragma unroll
                        for (int e = 0; e < 8; ++e) h2[e] = (hn[8 * bq + e] * 8.f - h1[e]) * 16.f;
#pragma unroll
                        for (int d = 0; d < 2; ++d) w2[d] = pgf::pack4_fp8(h2[4 * d], h2[4 * d + 1], h2[4 * d + 2], h2[4 * d + 3]);
                        pgf::u32x4 ww; ww.x = w1[0]; ww.y = w1[1]; ww.z = w2[0]; ww.w = w2[1];
                        *(LAS pgf::u32x4*)(img + (8 * (lane >> 2) + 4 * bq + (lane & 3)) * 16) = ww;
                    }
                }
                f32x2 y2[8];
#pragma unroll
                for (int e = 0; e < 8; ++e) y2[e] = f32x2{0.f, 0.f};
#pragma unroll
                for (int r = 0; r < 4; ++r) {
#pragma unroll 1
                    for (int hh = 0; hh < 2; ++hh) {
                        const int srcb = 32 * tau + 16 * hh;
                        const int my_eid = __shfl(idr[r], srcb + l15);
                        const unsigned char* pa = PU8 + (size_t)my_eid * DM + 16 * q4;
                        pgf::u32x4 aw[16], vw[16];
#pragma unroll
                        for (int j = 0; j < 16; ++j) aw[j] = *(const pgf::u32x4*)(pa + 64 * j);
#pragma unroll
                        for (int e = 0; e < 16; ++e) { const int eid = __builtin_amdgcn_readlane(idr[r], srcb + e); vw[e] = *(const pgf::u32x4*)(PV8 + (size_t)eid * DM + 16 * lane); }
                        f32x4 acc = f32x4{0.f, 0.f, 0.f, 0.f};
#pragma unroll
                        for (int j = 0; j < 16; ++j) {
                            const long b0 = *(const LAS long*)(img + ((((2 * j) * 4 + q4) * 2 + (l15 & 1)) << 3)), b1 = *(const LAS long*)(img + ((((2 * j + 1) * 4 + q4) * 2 + (l15 & 1)) << 3));
                            const long a0 = (long)(((unsigned long)aw[j].y << 32) | aw[j].x), a1 = (long)(((unsigned long)aw[j].w << 32) | aw[j].z);
                            acc = __builtin_amdgcn_mfma_f32_16x16x32_fp8_fp8(a0, b0, acc, 0, 0, 0);
                            acc = __builtin_amdgcn_mfma_f32_16x16x32_fp8_fp8(a1, b1, acc, 0, 0, 0);
                        }
                        const float cs = (l15 & 1) ? (1.f / (pgf::USCALE * 128.f)) : (1.f / (pgf::USCALE * 8.f));
                        float dsel = 0.f;
#pragma unroll
                        for (int g4 = 0; g4 < 4; ++g4) { float tt = acc[g4] * cs; tt += dppf<0xB1>(tt); const float got = __shfl(tt, 16 * (l15 >> 2)); dsel = ((l15 & 3) == g4) ? got : dsel; }
                        const float wv = gtr[r] * gelu_f(dsel * rstd_t) * (1.f / pgf::VSCALE);
#pragma unroll
                        for (int e = 0; e < 16; ++e) {
                            const float we = __builtin_bit_cast(float, __builtin_amdgcn_readlane(__builtin_bit_cast(int, wv), srcb + e)); const f32x2 w2v = f32x2{we, we};
#pragma unroll
                            for (int d = 0; d < 4; ++d) { const f32x2 lo = __builtin_amdgcn_cvt_pk_f32_fp8((int)vw[e][d], false), hi = __builtin_amdgcn_cvt_pk_f32_fp8((int)vw[e][d], true);
                                y2[2 * d] = __builtin_elementwise_fma(w2v, lo, y2[2 * d]); y2[2 * d + 1] = __builtin_elementwise_fma(w2v, hi, y2[2 * d + 1]); }
                        }
                    }
                }
                float y[16];
#pragma unroll
                for (int e = 0; e < 8; ++e) { y[2 * e] = y2[e].x; y[2 * e + 1] = y2[e].y; }
                float4* xo = (float4*)(X + t * DM + 16 * lane);
                float ssn = 0.f;
#pragma unroll
                for (int q = 0; q < 4; ++q) { float4 pp = xo[q]; pp.x += y[4 * q]; pp.y += y[4 * q + 1]; pp.z += y[4 * q + 2]; pp.w += y[4 * q + 3]; xo[q] = pp;
                    y[4 * q] = pp.x; y[4 * q + 1] = pp.y; y[4 * q + 2] = pp.z; y[4 * q + 3] = pp.w; ssn += (pp.x * pp.x + pp.y * pp.y) + (pp.z * pp.z + pp.w * pp.w); }
                if (gnext) {
                    const float rn = rsqrtf(wave_sum(ssn) * (1.f / DM) + EPS); const float4* gp = (const float4*)(gnext + 16 * lane);
                    uint4 o0, o1; float4 ga = gp[0], gb = gp[1], gc = gp[2], gd4 = gp[3];
                    o0.x = pk2(y[0] * rn * ga.x, y[1] * rn * ga.y); o0.y = pk2(y[2] * rn * ga.z, y[3] * rn * ga.w); o0.z = pk2(y[4] * rn * gb.x, y[5] * rn * gb.y); o0.w = pk2(y[6] * rn * gb.z, y[7] * rn * gb.w);
                    o1.x = pk2(y[8] * rn * gc.x, y[9] * rn * gc.y); o1.y = pk2(y[10] * rn * gc.z, y[11] * rn * gc.w); o1.z = pk2(y[12] * rn * gd4.x, y[13] * rn * gd4.y); o1.w = pk2(y[14] * rn * gd4.z, y[15] * rn * gd4.w);
                    *(uint4*)(HN + t * DM + 16 * lane) = o0; *(uint4*)(HN + t * DM + 16 * lane + 8) = o1;
                }
            }
        }
    }
}
#undef TK_CX
}
constexpr int NWAVES = 8, NTHR = 512;
constexpr int RING_BYTES = 131072, MISC_OFF = RING_BYTES + 320, LDS_BYTES = 147456;
struct Args { const void* in[34]; float* out; unsigned char* ws; int ph_lo, ph_hi; };
struct Ctx { LAS unsigned char* lds; int tid, lane, wave, G, bid, gw, ngw, gt, ngt; };
#define INF(i) ((const float*)a.in[i])
#define WSP(T_, off) ((T_*)(a.ws + (off)))

__device__ __forceinline__ void ph_rowprep(const Ctx& c, const float* x, const float* gain, bf16* XB);
__device__ __forceinline__ void prep_tile(const float* W, int K, int N, bf16* WT, int Nout, int mapmode, int item, LAS float* tile, int t256) {
    const int nbn = Nout / 32, kb = item / nbn, nb = item % nbn, n0 = nb * 32, k0 = kb * 32, tx = t256 & 31, ty = t256 >> 5;
    for (int i = ty; i < 32; i += 8) {
        const int n = n0 + tx; int src = n;
        if (mapmode == 1) { if (n < 448) src = n; else if (n < 512) src = -1; else src = n - 64; }
        tile[i * 33 + tx] = (src >= 0 && src < N) ? W[(size_t)(k0 + i) * N + src] : 0.f;
    }
    __syncthreads();
    for (int i = ty; i < 32; i += 8) WT[(size_t)(n0 + i) * K + k0 + tx] = f2bf(tile[tx * 33 + i]);
    __syncthreads();
}
template <class ArgsRef> __device__ __forceinline__ void ph_prep(const ArgsRef& a, const Ctx& c) {
    const int sub = c.tid >> 8, t256 = c.tid & 255; LAS float* tile = (LAS float*)c.lds + sub * (32 * 33);
    constexpr int NT0 = 1280, NT1 = 192, NT2 = 128, NT3 = 64, NT4 = 1024, NT5 = 2048, NTL = NT0 + NT1 + NT2 + NT3 + NT4 + NT5, NTOT = NL * NTL;
    const int nsb = c.G * 2;
    for (int it0 = c.bid * 2; it0 < NTOT; it0 += nsb) {
        int it = it0 + sub; if (it >= NTOT) it = NTOT - 1;
        const int l = it / NTL; int r = it % NTL;
        if (r < NT0) prep_tile(INF(3) + (size_t)l * DM * 1216, DM, 1216, WSP(bf16, WS_WINT) + (size_t)l * ZW * DM, ZW, 1, r, tile, t256);
        else if ((r -= NT0) < NT1) prep_tile(INF(5) + (size_t)l * 256 * 768, 256, 768, WSP(bf16, WS_WUQT) + (size_t)l * 768 * 256, 768, 0, r, tile, t256);
        else if ((r -= NT1) < NT2) prep_tile(INF(7) + (size_t)l * 128 * 1024, 128, 1024, WSP(bf16, WS_WUKVT) + (size_t)l * 1024 * 128, 1024, 0, r, tile, t256);
        else if ((r -= NT2) < NT3) prep_tile(INF(18) + (size_t)l * 65536, 256, 256, WSP(bf16, WS_GLUT) + (size_t)l * 65536, 256, 0, r, tile, t256);
        else if ((r -= NT3) < NT4) prep_tile(INF(28) + (size_t)l * DM * DM, DM, DM, WSP(bf16, WS_WOUTT) + (size_t)l * DM * DM, DM, 0, r, tile, t256);
        else { r -= NT4; prep_tile(INF(30) + (size_t)l * DM * 2048, DM, 2048, WSP(bf16, WS_WQT) + (size_t)l * 2048 * DM, 2048, 0, r, tile, t256); }
    }
    for (int i = c.gt; i < NL * 32768; i += c.ngt) WSP(bf16, WS_SUBKT)[i] = f2bf(INF(31)[i]);
    pgf::convert((const float*)a.in[32], WSP(unsigned char, WS_PU), (size_t)NL * 16384 * DM, pgf::USCALE, c.gt, c.ngt);
    pgf::convert((const float*)a.in[33], WSP(unsigned char, WS_PV), (size_t)NL * 16384 * DM, pgf::VSCALE, c.gt, c.ngt);
    for (int i = c.gt; i < T * 32; i += c.ngt) { const int t = i >> 5, j = i & 31;
        const float freq = exp2f(-(float)j * 0.41524101186092033f);
        const float ang = (float)((const int*)a.in[1])[t] * freq; float s, cs; sincos_acc(ang, s, cs);
        WSP(float, WS_COS)[i] = cs; WSP(float, WS_SIN)[i] = s; }
    for (int l = 0; l < NL; ++l)
        s5f::build_tables(INF(10) + l * 1024, INF(11) + l * 1024, INF(12) + l * 16, INF(13) + l * 16384, INF(14) + l * 16384, INF(15) + l * 16384, INF(16) + l * 16384,
                          WSP(bf16, WS_S5A) + (size_t)l * 32768, WSP(bf16, WS_S5C) + (size_t)l * 32768, WSP(float2, WS_S5L) + l * 1024, c.gt, c.ngt);
    ph_rowprep(c, INF(0), INF(2), WSP(bf16, WS_XB));
}

__device__ __forceinline__ void ph_rowprep(const Ctx& c, const float* x, const float* gain, bf16* XB) {
    for (int row = c.gw; row < T; row += c.ngw) {
        const float4* xr = (const float4*)(x + (size_t)row * DM) + c.lane;
        float4 v[4]; float ss = 0.f;
#pragma unroll
        for (int j = 0; j < 4; ++j) { v[j] = xr[64 * j]; ss += v[j].x * v[j].x + v[j].y * v[j].y + v[j].z * v[j].z + v[j].w * v[j].w; }
        const float rstd = rsqrtf(wave_sum(ss) * (1.f / DM) + EPS);
        uint2* o = (uint2*)(XB + (size_t)row * DM) + c.lane;
#pragma unroll
        for (int j = 0; j < 4; ++j) { const float4 g = ((const float4*)gain)[c.lane + 64 * j];
            o[64 * j] = make_uint2(pk2(v[j].x * rstd * g.x, v[j].y * rstd * g.y), pk2(v[j].z * rstd * g.z, v[j].w * rstd * g.w)); }
    }
}

enum { EPI_BF16 = 0, EPI_F32 = 1, EPI_GLU = 2, EPI_RESID = 3 };
template <int EPI> __device__ __forceinline__ void gemm_simple(const Ctx& c, const bf16* A, int lda, const bf16* Bt, int M, int N, int K, void* C, int ldc, const float* aux0, const bf16* aux1) {
    LAS float* As = (LAS float*)c.lds; LAS float* Bs = As + 16 * 132;
    const int tid = c.tid, tx = tid & 15, ty = tid >> 4, nN = N / 64, ntile = (M / 128) * nN;
    for (int tile = c.bid; tile < ntile; tile += c.G) {
        const int m0 = (tile / nN) * 128, n0 = (tile % nN) * 64;
        float acc[4][4];
#pragma unroll
        for (int i = 0; i < 4; ++i)
#pragma unroll
            for (int j = 0; j < 4; ++j) acc[i][j] = 0.f;
        const int lr = tid >> 2, lk = (tid & 3) * 4;
        for (int k0 = 0; k0 < K; k0 += 16) {
            { const uint2 w = *(const uint2*)(A + (size_t)(m0 + lr) * lda + k0 + lk);
              As[lk * 132 + lr] = __uint_as_float(w.x << 16); As[(lk + 1) * 132 + lr] = __uint_as_float(w.x & 0xffff0000u); As[(lk + 2) * 132 + lr] = __uint_as_float(w.y << 16); As[(lk + 3) * 132 + lr] = __uint_as_float(w.y & 0xffff0000u); }
            if (tid < 256) { const uint2 w = *(const uint2*)(Bt + (size_t)(n0 + lr) * K + k0 + lk);
              Bs[lk * 68 + lr] = __uint_as_float(w.x << 16); Bs[(lk + 1) * 68 + lr] = __uint_as_float(w.x & 0xffff0000u); Bs[(lk + 2) * 68 + lr] = __uint_as_float(w.y << 16); Bs[(lk + 3) * 68 + lr] = __uint_as_float(w.y & 0xffff0000u); }
            __syncthreads();
#pragma unroll
            for (int kk = 0; kk < 16; ++kk) {
                float av[4], bv[4];
#pragma unroll
                for (int i = 0; i < 4; ++i) { av[i] = As[kk * 132 + ty * 4 + i]; bv[i] = Bs[kk * 68 + tx * 4 + i]; }
#pragma unroll
                for (int i = 0; i < 4; ++i)
#pragma unroll
                    for (int j = 0; j < 4; ++j) acc[i][j] += av[i] * bv[j];
            }
            __syncthreads();
        }
#pragma unroll
        for (int i = 0; i < 4; ++i)
#pragma unroll
            for (int j = 0; j < 4; ++j) {
                const int row = m0 + ty * 4 + i, col = n0 + tx * 4 + j; const size_t ix = (size_t)row * ldc + col; const float v = acc[i][j];
                if (EPI == EPI_BF16) ((bf16*)C)[ix] = f2bf(v);
                else if (EPI == EPI_F32) ((float*)C)[ix] = v;
                else if (EPI == EPI_GLU) { const float yg = bf2f(aux1[ix]); ((bf16*)C)[ix] = f2bf(yg * sigmoid_f(v + aux0[col])); }
                else { ((float*)C)[ix] = aux0[ix] + v; }
            }
    }
}

__device__ __forceinline__ void ph_zstats(const Ctx& c, const bf16* Z, const float* qan, const float* kvan, bf16* CQN, bf16* CKVN) {
    for (int row = c.gw; row < T; row += c.ngw) {
        const bf16* zr = Z + (size_t)row * ZW; const int lane = c.lane;
        { const uint2 w = *(const uint2*)(zr + ZC_CQ + 4 * lane);
          float a0 = __uint_as_float(w.x << 16), a1 = __uint_as_float(w.x & 0xffff0000u), a2 = __uint_as_float(w.y << 16), a3 = __uint_as_float(w.y & 0xffff0000u);
          const float rstd = rsqrtf(wave_sum(a0 * a0 + a1 * a1 + a2 * a2 + a3 * a3) * (1.f / 256) + EPS);
          const float4 g = ((const float4*)qan)[lane];
          *(uint2*)(CQN + (size_t)row * 256 + 4 * lane) = make_uint2(pk2(a0 * rstd * g.x, a1 * rstd * g.y), pk2(a2 * rstd * g.z, a3 * rstd * g.w)); }
        { const u32 w = *(const u32*)(zr + ZC_CKV + 2 * lane);
          float a0 = __uint_as_float(w << 16), a1 = __uint_as_float(w & 0xffff0000u);
          const float rstd = rsqrtf(wave_sum(a0 * a0 + a1 * a1) * (1.f / 128) + EPS);
          const float2 g = ((const float2*)kvan)[lane];
          *(u32*)(CKVN + (size_t)row * 128 + 2 * lane) = pk2(a0 * rstd * g.x, a1 * rstd * g.y); }
    }
}

__device__ __forceinline__ void ph_qkfin(const Ctx& c, const bf16* QRAW, const bf16* KVRAW, const bf16* Z, const float* qn, const float* kn, const float* COS, const float* SIN, bf16* QB, bf16* KB, bf16* VB) {
    const int lane = c.lane;
    for (int w = c.gw; w < T * NH; w += c.ngw) {
        const int t = w >> 2, h = w & 3, b = t / SEQ, s = t % SEQ; const size_t bh = (size_t)b * NH + h;
        const float cs = COS[t * 32 + (lane & 31)], sn = SIN[t * 32 + (lane & 31)];
        {   const bf16* p = QRAW + (size_t)t * 768 + h * DQK;
            float v0 = bf2f(p[lane]), v1 = bf2f(p[lane + 64]), v2 = bf2f(p[lane + 128]);
            const float rstd = rsqrtf(wave_sum(v0 * v0 + v1 * v1 + v2 * v2) * (1.f / DQK) + EPS);
            v0 *= rstd * qn[lane]; v1 *= rstd * qn[lane + 64]; v2 *= rstd * qn[lane + 128];
            const float pr = __shfl_xor(v2, 32);
            const float r2 = (lane < 32) ? (v2 * cs - pr * sn) : (pr * sn + v2 * cs);
            bf16* o = QB + (bh * SEQ + s) * DQK;
            o[lane] = f2bf(v0 * QSCALE); o[lane + 64] = f2bf(v1 * QSCALE); o[lane + 128] = f2bf(r2 * QSCALE); }
        {   const bf16* p = KVRAW + (size_t)t * 1024 + h * 256;
            float v0 = bf2f(p[lane]), v1 = bf2f(p[lane + 64]), v2 = bf2f(Z[(size_t)t * ZW + ZC_KR + lane]);
            const float rstd = rsqrtf(wave_sum(v0 * v0 + v1 * v1 + v2 * v2) * (1.f / DQK) + EPS);
            v0 *= rstd * kn[lane]; v1 *= rstd * kn[lane + 64]; v2 *= rstd * kn[lane + 128];
            const float pr = __shfl_xor(v2, 32);
            const float r2 = (lane < 32) ? (v2 * cs - pr * sn) : (pr * sn + v2 * cs);
            bf16* o = KB + (bh * SEQ + s) * DQK;
            o[lane] = f2bf(v0); o[lane + 64] = f2bf(v1); o[lane + 128] = f2bf(r2);
            bf16* ov = VB + (bh * SEQ + s) * DV;
            ov[lane] = p[128 + lane]; ov[lane + 64] = p[192 + lane]; }
    }
}

__device__ __forceinline__ void ph_attn_simple(const Ctx& c, const bf16* QB, const bf16* KB, const bf16* VB, bf16* AO) {
    LAS float* qs = (LAS float*)c.lds + c.wave * DQK; const int lane = c.lane;
    for (int gq = c.gw; gq < NB * NH * SEQ; gq += c.ngw) {
        const int bh = gq / SEQ, q = gq % SEQ;
        const bf16* qp = QB + ((size_t)bh * SEQ + q) * DQK;
        qs[lane] = bf2f(qp[lane]); qs[lane + 64] = bf2f(qp[lane + 64]); qs[lane + 128] = bf2f(qp[lane + 128]);
        asm volatile("s_waitcnt lgkmcnt(0)" ::: "memory");
        float m = -1e30f, l = 0.f, o0 = 0.f, o1 = 0.f;
        const int ntile = q / 64 + 1;
        for (int kt = 0; kt < ntile; ++kt) {
            const int key = kt * 64 + lane;
            const uint4* kp = (const uint4*)(KB + ((size_t)bh * SEQ + key) * DQK);
            float sc = 0.f;
#pragma unroll 4
            for (int cc = 0; cc < 24; ++cc) { float kv[8]; unpack8(kp[cc], kv);
#pragma unroll
                for (int e = 0; e < 8; ++e) sc += kv[e] * qs[cc * 8 + e]; }
            if (key > q) sc = -INFINITY;
            const float mn = fmaxf(m, wave_max(sc));
            const float p = exp2f(sc - mn), al = exp2f(m - mn);
            l = l * al + wave_sum(p); o0 *= al; o1 *= al; m = mn;
            const u32* vp = (const u32*)(VB + ((size_t)bh * SEQ + kt * 64) * DV) + lane;
#pragma unroll 8
            for (int k = 0; k < 64; ++k) { const float pk = __shfl(p, k); const u32 w = vp[(size_t)k * (DV / 2)];
                o0 += pk * __uint_as_float(w << 16); o1 += pk * __uint_as_float(w & 0xffff0000u); }
        }
        const int b = bh / NH, h = bh % NH; const float il = 1.f / l;
        *(u32*)(AO + ((size_t)b * SEQ + q) * 512 + h * DV + 2 * lane) = pk2(o0 * il, o1 * il);
    }
}

__device__ __forceinline__ void ph_s5_simple(const Ctx& c, const bf16* Z, const float* a_re, const float* a_im, const float* log_dt, const float* b_re, const float* b_im,
                                             const float* c_re, const float* c_im, const float* dsk, bf16* YG) {
    for (int item = c.gw; item < NB * 16; item += c.ngw) {
        const int b = item >> 4, g = item & 15, p = c.lane;
        const float are = a_re[g * 64 + p], aim = a_im[g * 64 + p], dt = expf(log_dt[g]);
        const float mag = expf(are * dt); float sn, cs; sincos_acc(aim * dt, sn, cs);
        const float lre = mag * cs, lim = mag * sn;
        const float xr = lre - 1.f, xi = lim, den = are * are + aim * aim;
        const float cr = (xr * are + xi * aim) / den, ci = (xi * are - xr * aim) / den;
        float Bre[16], Bim[16], Cre[16], Cim[16];
#pragma unroll
        for (int k = 0; k < 16; ++k) { const float br = b_re[(g * 64 + p) * 16 + k], bi = b_im[(g * 64 + p) * 16 + k];
            Bre[k] = cr * br - ci * bi; Bim[k] = cr * bi + ci * br; Cre[k] = c_re[(g * 16 + k) * 64 + p]; Cim[k] = c_im[(g * 16 + k) * 64 + p]; }
        const float D = (p < 16) ? dsk[g * 16 + p] : 0.f;
        float hre = 0.f, him = 0.f;
        for (int s = 0; s < SEQ; ++s) {
            const bf16* up = Z + (size_t)(b * SEQ + s) * ZW + ZC_U + g * 16;
            float u[16]; unpack8(*(const uint4*)up, u); unpack8(*(const uint4*)(up + 8), u + 8);
            float bre = 0.f, bim = 0.f;
#pragma unroll
            for (int k = 0; k < 16; ++k) { bre += Bre[k] * u[k]; bim += Bim[k] * u[k]; }
            const float nre = lre * hre - lim * him + bre, nim = lre * him + lim * hre + bim; hre = nre; him = nim;
            float my = 0.f;
#pragma unroll
            for (int k = 0; k < 16; ++k) { const float v = wave_sum(Cre[k] * hre - Cim[k] * him); if (p == k) my = v + D * u[k]; }
            if (p < 16) YG[(size_t)(b * SEQ + s) * 256 + g * 16 + p] = f2bf(gelu_f(my));
        }
    }
}

__device__ __forceinline__ void ph_lru_xc(const Ctx& c, const bf16* Z, const float* cw, const float* cb, float* XC) {
    for (int i = c.gt; i < T * 256; i += c.ngt) { const int t = i >> 8, ch = i & 255, s = t % SEQ;
        float acc = cb[ch];
#pragma unroll
        for (int j = 0; j < 4; ++j) { const int ss = s - 3 + j; if (ss >= 0) acc += cw[j * 256 + ch] * bf2f(Z[(size_t)(t - 3 + j) * ZW + ZC_X + ch]); }
        XC[i] = acc; }
}
__device__ __forceinline__ void ph_lru_gates(const Ctx& c, const float* XC, const float* wa, const float* ba, const float* wx, const float* bx, const float* lam, float* AA, float* BT) {
    for (int i = c.gt; i < T * 256; i += c.ngt) { const int t = i >> 8, ch = i & 255, h = ch >> 6, j = ch & 63;
        const float* xr = XC + (size_t)t * 256 + h * 64;
        float ra = ba[ch], rx = bx[ch];
        for (int k = 0; k < 64; ++k) { const float xv = xr[k]; ra += xv * wa[(h * 64 + k) * 64 + j]; rx += xv * wx[(h * 64 + k) * 64 + j]; }
        const float r = sigmoid_f(ra), ig = sigmoid_f(rx);
        const float lsg = -log1pf(expf(-lam[ch]));
        const float la = 8.f * r * lsg, av = expf(la);
        AA[i] = av; BT[i] = sqrtf(-expm1f(2.f * la)) * (ig * XC[i]); }
}
__device__ __forceinline__ void ph_lru_scan(const Ctx& c, const float* AA, const float* BT, const bf16* Z, bf16* ROUT) {
    for (int item = c.gw; item < NB * 4; item += c.ngw) {
        const int i = item * 64 + c.lane, b = i >> 8, ch = i & 255;
        float h = 0.f;
#pragma unroll 8
        for (int s = 0; s < SEQ; ++s) { const size_t t = (size_t)b * SEQ + s;
            h = AA[t * 256 + ch] * h + BT[t * 256 + ch];
            ROUT[t * 256 + ch] = f2bf(h * gelu_f(bf2f(Z[t * ZW + ZC_G + ch]))); }
    }
}

__device__ __forceinline__ void ph_mixnorm(const Ctx& c, const bf16* AO, const bf16* SOUT, const bf16* ROUT, const float* g, bf16* Y) {
    const int lane = c.lane;
    for (int row = c.gw; row < T; row += c.ngw) {
        {   float v[8]; unpack8(*(const uint4*)(AO + (size_t)row * 512 + 8 * lane), v);
            float ss = 0.f;
#pragma unroll
            for (int e = 0; e < 8; ++e) ss += v[e] * v[e];
            const float rstd = rsqrtf(wave_sum(ss) * (1.f / 512) + EPS); const float* gg = g + 8 * lane;
            *(uint4*)(Y + (size_t)row * DM + 8 * lane) = make_uint4(pk2(v[0] * rstd * gg[0], v[1] * rstd * gg[1]), pk2(v[2] * rstd * gg[2], v[3] * rstd * gg[3]),
                                                                    pk2(v[4] * rstd * gg[4], v[5] * rstd * gg[5]), pk2(v[6] * rstd * gg[6], v[7] * rstd * gg[7])); }
#pragma unroll
        for (int part = 0; part < 2; ++part) {
            const bf16* src = part == 0 ? SOUT : ROUT; const int off = 512 + 256 * part;
            const uint2 w = *(const uint2*)(src + (size_t)row * 256 + 4 * lane);
            float a0 = __uint_as_float(w.x << 16), a1 = __uint_as_float(w.x & 0xffff0000u), a2 = __uint_as_float(w.y << 16), a3 = __uint_as_float(w.y & 0xffff0000u);
            const float rstd = rsqrtf(wave_sum(a0 * a0 + a1 * a1 + a2 * a2 + a3 * a3) * (1.f / 256) + EPS); const float* gg = g + off + 4 * lane;
            *(uint2*)(Y + (size_t)row * DM + off + 4 * lane) = make_uint2(pk2(a0 * rstd * gg[0], a1 * rstd * gg[1]), pk2(a2 * rstd * gg[2], a3 * rstd * gg[3]));
        }
    }
}

__device__ __forceinline__ void ph_topk_a(const Ctx& c, const float* SC, float* STOP, int* ITOP) {
    for (int i = c.gt; i < T * 16; i += c.ngt) {
        const float* sc = SC + (size_t)i * 128;
        float pv = INFINITY; int pn = -1;
        for (int it = 0; it < 16; ++it) {
            float bv = -INFINITY; int bn = 1 << 30;
            for (int n = 0; n < 128; ++n) { const float v = sc[n];
                const bool elig = (v < pv) || (v == pv && n > pn);
                if (elig && (v > bv || (v == bv && n < bn))) { bv = v; bn = n; } }
            STOP[(size_t)i * 16 + it] = bv; ITOP[(size_t)i * 16 + it] = bn; pv = bv; pn = bn;
        }
    }
}
__device__ __forceinline__ void ph_topk_b(const Ctx& c, const float* STOP, const int* ITOP, int* IDX, float* GATE) {
    LAS float* my = (LAS float*)c.lds + c.tid * 33;
    for (int i = c.gt; i < T * 8; i += c.ngt) {
        for (int k = 0; k < 32; ++k) my[k] = STOP[(size_t)i * 32 + k];
        float pv = INFINITY; int pn = -1; float best0 = 0.f, den = 0.f;
        float ev[16];
#pragma unroll
        for (int it = 0; it < 16; ++it) {
            float bv = -INFINITY; int bn = 1 << 30;
            for (int f = 0; f < 256; ++f) { const float v = my[f >> 4] + my[16 + (f & 15)];
                const bool elig = (v < pv) || (v == pv && f > pn);
                if (elig && (v > bv || (v == bv && f < bn))) { bv = v; bn = f; } }
            pv = bv; pn = bn;
            if (it == 0) best0 = bv;
            ev[it] = expf(bv - best0); den += ev[it];
            IDX[(size_t)i * 16 + it] = ITOP[(size_t)i * 32 + (bn >> 4)] * 128 + ITOP[(size_t)i * 32 + 16 + (bn & 15)];
        }
#pragma unroll
        for (int it = 0; it < 16; ++it) GATE[(size_t)i * 16 + it] = ev[it] / den;
    }
}

__device__ __forceinline__ void ph_gather(const Ctx& c, const bf16* HN, const int* IDX, const float* GATE, const bf16* PU, const bf16* PV, float* X) {
    const int lane = c.lane;
    for (int t = c.gw; t < T; t += c.ngw) {
        float hn[16]; unpack8(*(const uint4*)(HN + (size_t)t * DM + 8 * lane), hn); unpack8(*(const uint4*)(HN + (size_t)t * DM + 512 + 8 * lane), hn + 8);
        float y[16];
#pragma unroll
        for (int e = 0; e < 16; ++e) y[e] = 0.f;
        for (int k = 0; k < 128; ++k) {
            const int e = IDX[(size_t)t * 128 + k]; const float gt = GATE[(size_t)t * 128 + k];
            const bf16* ur = PU + (size_t)e * DM; const bf16* vr = PV + (size_t)e * DM;
            float u[16]; unpack8(*(const uint4*)(ur + 8 * lane), u); unpack8(*(const uint4*)(ur + 512 + 8 * lane), u + 8);
            float d = 0.f;
#pragma unroll
            for (int q = 0; q < 16; ++q) d += u[q] * hn[q];
            d = wave_sum(d);
            const float w = gt * gelu_f(d);
            float v[16]; unpack8(*(const uint4*)(vr + 8 * lane), v); unpack8(*(const uint4*)(vr + 512 + 8 * lane), v + 8);
#pragma unroll
            for (int q = 0; q < 16; ++q) y[q] += w * v[q];
        }
        float4* xo = (float4*)(X + (size_t)t * DM + 8 * lane);
        float4 p0 = xo[0], p1 = xo[1]; p0.x += y[0]; p0.y += y[1]; p0.z += y[2]; p0.w += y[3]; p1.x += y[4]; p1.y += y[5]; p1.z += y[6]; p1.w += y[7]; xo[0] = p0; xo[1] = p1;
        xo = (float4*)(X + (size_t)t * DM + 512 + 8 * lane);
        p0 = xo[0]; p1 = xo[1]; p0.x += y[8]; p0.y += y[9]; p0.z += y[10]; p0.w += y[11]; p1.x += y[12]; p1.y += y[13]; p1.z += y[14]; p1.w += y[15]; xo[0] = p0; xo[1] = p1;
    }
}
namespace att {
typedef short bf16x8 __attribute__((ext_vector_type(8)));
typedef short s16x4 __attribute__((ext_vector_type(4)));
typedef float f32x16 __attribute__((ext_vector_type(16)));
typedef unsigned u32x4 __attribute__((ext_vector_type(4)));
constexpr int KT = 64, KBYTES = KT * DQK * 2, VBYTES = KT * DV * 2, BUFB = KBYTES + VBYTES;
constexpr int OFF_WS = 2 * BUFB, OFF_MO = 0, OFF_ML = 65536, LDS_NEED = OFF_WS + 8 * 64 * 4;
constexpr float THR = 8.f;
__device__ __forceinline__ int kswz(int row, int c) { return row * 384 + (((c & ~7) | ((c & 7) ^ ((row >> 1) & 7))) << 4); }
__device__ __forceinline__ int v_st(int k, int c) { const int kk = (k & ~0xC) | ((k & 4) << 1) | ((k & 8) >> 1); return ((kk >> 3) * 4 + (c >> 5)) * 512 + ((kk & 7) * 32 + (c & 31)) * 2; }
__device__ __forceinline__ int v_rd_base(int lane) { return ((lane & 3) << 3) | (((lane >> 2) & 3) << 6) | (((lane >> 4) & 1) << 5) | (((lane >> 5) & 1) << 8); }
__device__ __forceinline__ int crow(int r, int hi) { return (r & 3) + 8 * (r >> 2) + 4 * hi; }
__device__ __forceinline__ unsigned cvtpk(float lo, float hi) { unsigned r; asm volatile("v_cvt_pk_bf16_f32 %0, %1, %2" : "=v"(r) : "v"(lo), "v"(hi)); return r; }
#define ATT_SBAR() __builtin_amdgcn_sched_barrier(0)

__device__ __forceinline__ void attn_unit(LAS unsigned char* lds, const bf16* Qg, const bf16* Kg, const bf16* Vg, bf16* AO, int bh, int qb, int tid) {
    const int lane = tid & 63, wid = __builtin_amdgcn_readfirstlane(tid >> 6), qsub = wid & 3, kh = wid >> 2, r32 = lane & 31, hi = lane >> 5;
    const int q0 = qb * 128, NT = 2 * (qb + 1);
    const size_t rowbase = (size_t)bh * SEQ;
    bf16x8 qr[12];
    { const bf16* qp = Qg + (rowbase + q0 + 32 * qsub + r32) * DQK + 8 * hi;
#pragma unroll
      for (int ks = 0; ks < 12; ++ks) qr[ks] = *(const bf16x8*)(qp + 16 * ks); }
    int ksrc[3], vsrc[2];
#pragma unroll
    for (int j = 0; j < 3; ++j) { const int L = (wid + 8 * j) * 64 + lane, row = L / 24, cp = L - row * 24, c = (cp & ~7) | ((cp & 7) ^ ((row >> 1) & 7)); ksrc[j] = row * DQK + c * 8; }
#pragma unroll
    for (int j = 0; j < 2; ++j) { const int X = ((wid + 8 * j) * 64 + lane) * 16, sub = X >> 9, within = (X & 511) >> 1, kk = ((sub >> 2) << 3) | (within >> 5);
        const int k = (kk & ~0xC) | ((kk & 4) << 1) | ((kk & 8) >> 1), c = (sub & 3) * 32 + (within & 31); vsrc[j] = k * DV + c; }
    const bf16* Kt = Kg + rowbase * DQK; const bf16* Vt = Vg + rowbase * DV;
#define ATT_STAGE(t, bo) do { const bf16* kp_ = Kt + (size_t)(t) * (KT * DQK); const bf16* vp_ = Vt + (size_t)(t) * (KT * DV); \
        _Pragma("unroll") for (int j_ = 0; j_ < 3; ++j_) __builtin_amdgcn_global_load_lds((const unsigned*)(kp_ + ksrc[j_]), (LAS unsigned*)(lds + (bo) + (wid + 8 * j_) * 1024), 16, 0, 0); \
        _Pragma("unroll") for (int j_ = 0; j_ < 2; ++j_) __builtin_amdgcn_global_load_lds((const unsigned*)(vp_ + vsrc[j_]), (LAS unsigned*)(lds + (bo) + KBYTES + (wid + 8 * j_) * 1024), 16, 0, 0); } while (0)
    const int krow = 32 * kh + r32, kf = (krow >> 1) & 7;
    int kb[4];
#pragma unroll
    for (int j = 0; j < 4; ++j) kb[j] = krow * 384 + ((((2 * j + hi) & 7) ^ kf) << 4);
    const int vb = KBYTES + v_rd_base(lane) + kh * 8192;
    LAS float* wsf = (LAS float*)(lds + OFF_WS) + wid * 64;
    float m_reg = -1e30f, l_reg = 0.f; f32x16 o[4];
#pragma unroll
    for (int d = 0; d < 4; ++d) o[d] = f32x16{};
    const int rb = 32 * qsub;
    ATT_STAGE(0, 0);
    asm volatile("s_waitcnt vmcnt(0)" ::: "memory");
    __syncthreads();
    for (int t = 0; t < NT; ++t) {
        const int bo = (t & 1) * BUFB;
        if (t + 1 < NT) ATT_STAGE(t + 1, BUFB - bo);
        const int kboff = 64 * t + 32 * kh - q0;
        const bool act = kboff <= rb, diag = kboff == rb;
        if (act) {
            f32x16 p = f32x16{};
#pragma unroll
            for (int ks = 0; ks < 12; ++ks) {
                const bf16x8 kfr = *(const LAS bf16x8*)(lds + bo + kb[ks & 3] + (ks >> 2) * 128);
                p = __builtin_amdgcn_mfma_f32_32x32x16_bf16(kfr, qr[ks], p, 0, 0, 0);
            }
            if (diag) {
#pragma unroll
                for (int r = 0; r < 16; ++r) if (crow(r, hi) > r32) p[r] = -__builtin_inff();
            }
            float pmax = p[0];
#pragma unroll
            for (int r = 1; r < 16; ++r) pmax = fmaxf(pmax, p[r]);
            { auto rr = __builtin_amdgcn_permlane32_swap(__float_as_uint(pmax), __float_as_uint(pmax), false, false);
              pmax = fmaxf(__uint_as_float(rr[0]), __uint_as_float(rr[1])); }
            float alpha = 1.f;
            if (!__all(pmax - m_reg <= THR)) { const float mn = fmaxf(m_reg, pmax); alpha = __builtin_amdgcn_exp2f(m_reg - mn); m_reg = mn; }
#pragma unroll
            for (int r = 0; r < 16; ++r) p[r] = __builtin_amdgcn_exp2f(p[r] - m_reg);
            float ps = 0.f;
#pragma unroll
            for (int r = 0; r < 16; ++r) ps += p[r];
            { auto rr = __builtin_amdgcn_permlane32_swap(__float_as_uint(ps), __float_as_uint(ps), false, false);
              ps = __uint_as_float(rr[0]) + __uint_as_float(rr[1]); }
            l_reg = l_reg * alpha + ps;
            if (__any(alpha < 1.f)) {
                if (hi == 0) wsf[r32] = alpha;
                asm volatile("s_waitcnt lgkmcnt(0)" ::: "memory");
#pragma unroll
                for (int r = 0; r < 16; ++r) { const float al = wsf[crow(r, hi)];
#pragma unroll
                    for (int d = 0; d < 4; ++d) o[d][r] *= al; }
            }
            bf16x8 pa0, pa1;
#define ATT_PK4(B_, OUT) do { unsigned a0 = cvtpk(p[B_ + 0], p[B_ + 1]), a1 = cvtpk(p[B_ + 2], p[B_ + 3]); unsigned b0 = cvtpk(p[B_ + 4], p[B_ + 5]), b1 = cvtpk(p[B_ + 6], p[B_ + 7]); \
            auto r0 = __builtin_amdgcn_permlane32_swap(a0, b0, false, false); auto r1 = __builtin_amdgcn_permlane32_swap(a1, b1, false, false); \
            u32x4 w_ = {r0[0], r1[0], r0[1], r1[1]}; OUT = __builtin_bit_cast(bf16x8, w_); } while (0)
            ATT_PK4(0, pa0); ATT_PK4(8, pa1);
#undef ATT_PK4
            const int vaddr = (int)(uintptr_t)lds + bo + vb;
#define ATT_TRRD(dst, off) asm volatile("ds_read_b64_tr_b16 %0, %1 offset:%2" : "=&v"(dst) : "v"(vaddr), "i"(off) : "memory")
#define ATT_PV(d0) do { s16x4 l0, h0, l1, h1; \
            ATT_TRRD(l0, (d0) * 512); ATT_TRRD(h0, (d0) * 512 + 2048); ATT_TRRD(l1, (d0) * 512 + 4096); ATT_TRRD(h1, (d0) * 512 + 6144); \
            asm volatile("s_waitcnt lgkmcnt(0)" ::: "memory"); ATT_SBAR(); \
            o[d0] = __builtin_amdgcn_mfma_f32_32x32x16_bf16(pa0, (bf16x8){l0[0], l0[1], l0[2], l0[3], h0[0], h0[1], h0[2], h0[3]}, o[d0], 0, 0, 0); \
            o[d0] = __builtin_amdgcn_mfma_f32_32x32x16_bf16(pa1, (bf16x8){l1[0], l1[1], l1[2], l1[3], h1[0], h1[1], h1[2], h1[3]}, o[d0], 0, 0, 0); } while (0)
            ATT_PV(0); ATT_PV(1); ATT_PV(2); ATT_PV(3);
#undef ATT_PV
#undef ATT_TRRD
        }
        asm volatile("s_waitcnt vmcnt(0)" ::: "memory");
        __syncthreads();
    }
    LAS float* MO = (LAS float*)(lds + OFF_MO) + qsub * 4096; LAS float* ML = (LAS float*)(lds + OFF_ML) + qsub * 64;
    if (kh == 1) {
        if (hi == 0) { ML[2 * r32] = m_reg; ML[2 * r32 + 1] = l_reg; }
#pragma unroll
        for (int d = 0; d < 4; ++d)
#pragma unroll
            for (int r = 0; r < 16; ++r) MO[(d * 16 + r) * 64 + lane] = o[d][r];
    }
    __syncthreads();
    if (kh == 0) {
        const float m1 = ML[2 * r32], l1 = ML[2 * r32 + 1];
        const float mm = fmaxf(m_reg, m1), f0 = __builtin_amdgcn_exp2f(m_reg - mm), f1 = __builtin_amdgcn_exp2f(m1 - mm);
        const float il = 1.f / (l_reg * f0 + l1 * f1);
        if (hi == 0) { wsf[r32] = f0 * il; wsf[32 + r32] = f1 * il; }
        asm volatile("s_waitcnt lgkmcnt(0)" ::: "memory");
        const int b = bh / NH, h = bh % NH;
        bf16* Ow = AO + ((size_t)b * SEQ + q0 + rb) * 512 + h * DV;
#pragma unroll
        for (int r = 0; r < 16; ++r) { const int orow = crow(r, hi); const float g0 = wsf[orow], g1 = wsf[32 + orow];
#pragma unroll
            for (int d = 0; d < 4; ++d) { const float v = o[d][r] * g0 + MO[(d * 16 + r) * 64 + lane] * g1; const float vn = __shfl_xor(v, 1);
                if ((r32 & 1) == 0) *(unsigned*)(Ow + (size_t)orow * 512 + d * 32 + r32) = cvtpk(v, vn); } }
    }
    __syncthreads();
#undef ATT_STAGE
}
__device__ __forceinline__ void attn_phase(LAS unsigned char* lds, const bf16* Qg, const bf16* Kg, const bf16* Vg, bf16* AO, int G, int bid, int tid) {
    const int npair = NB * NH * 32;
    for (int v0 = bid; v0 < npair; v0 += G) {
        const int vcu = (G % 8 == 0 && npair % G == 0) ? (v0 % 8) * (npair / 8) + v0 / 8 : v0;
        const int bh = vcu >> 5, s = vcu & 31;
        for (int u = 0; u < 2; ++u) attn_unit(lds, Qg, Kg, Vg, AO, bh, u ? s : 63 - s, tid);
    }
}
#undef ATT_SBAR
}
#ifndef MK_PROBE
#define MK_PROBE 0
#endif
#ifndef PROBE_A_LO
#define PROBE_A_LO 0
#define PROBE_A_HI 1
#define PROBE_B_LO 16
#define PROBE_B_HI 17
#endif
#define TS_OFF 8192
#ifndef MK_DUP
#define MK_DUP 0
#endif
#ifndef MK_DUP_LOADONLY
#define MK_DUP_LOADONLY false
#endif
#ifndef MK_DUP_EMASK
#define MK_DUP_EMASK 0x3fff
#endif
#ifndef MK_SIMPLE_TOPK
#define MK_SIMPLE_TOPK 0
#endif
#ifndef MK_SIMPLE_SCAN
#define MK_SIMPLE_SCAN 0
#endif
#ifndef MK_SIMPLE_ATTN
#define MK_SIMPLE_ATTN 0
#endif
#ifndef MK_SIMPLE_GEMM
#define MK_SIMPLE_GEMM 0
#endif
constexpr int NPH_LAYER = 10, NPH = 1 + NL * NPH_LAYER;
struct GD { const bf16* A; const bf16* Bt; void* C; const float* aux0; const bf16* aux1; int lda, M, N, K, ldc, kind; };
template <class Epi> __device__ __forceinline__ void run_gemm(const Ctx& c, const bf16* A, int lda, const bf16* Bt, int M, int N, int K, const Epi& E) {
    pg8::Gemm g{A, Bt, M, N, K, lda}; pg8::StaticOrder S; S.init(M, N, c.G, c.bid);
    pg8::gemm_phase<Epi, pg8::StaticOrder, true, true>(c.lds, g, S, E);
}
#define AS4 __attribute__((address_space(4)))
__global__ void __launch_bounds__(NTHR, 2) mega(Args a_) {
    extern __shared__ __attribute__((aligned(16))) unsigned char lds_raw[];
    {   const int t0 = threadIdx.x;
        for (int u = t0; u < (LDS_BYTES - RING_BYTES) / 4; u += NTHR) ((LAS unsigned*)((LAS unsigned char*)lds_raw + RING_BYTES))[u] = 0u; }
    __syncthreads();
    volatile LAS unsigned* MISC = (volatile LAS unsigned*)((LAS unsigned char*)lds_raw + MISC_OFF);
    XcdBarrier bar; bar.bar = (unsigned*)(a_.ws + WS_CTL) + CW_BAR; bar.x = 0; bar.st = MISC + 8;
    const int ph_lo = a_.ph_lo, ph_hi = a_.ph_hi;
    if (ph_hi - ph_lo > 1) bar = xcd_barrier_post((unsigned*)(a_.ws + WS_CTL) + CW_BAR, MISC + 8);

#if MK_PROBE
    unsigned long long* ts = (unsigned long long*)(a_.ws + WS_CTL + TS_OFF); const bool stamper = (blockIdx.x == 0 && threadIdx.x == 0);
    if (stamper) ts[0] = __builtin_amdgcn_s_memrealtime();
#endif
    int p = ph_lo;
    if (p == 0) {
        const Args AS4* ap0 = (const Args AS4*)__builtin_amdgcn_kernarg_segment_ptr(); Ctx c0; c0.lds = (LAS unsigned char*)lds_raw; c0.tid = threadIdx.x; c0.lane = c0.tid & 63; c0.wave = __builtin_amdgcn_readfirstlane(c0.tid >> 6);
        c0.G = gridDim.x; c0.bid = blockIdx.x; c0.gw = c0.wave * c0.G + c0.bid; c0.ngw = NWAVES * c0.G; c0.gt = c0.bid * NTHR + c0.tid; c0.ngt = c0.G * NTHR;
        ph_prep(*ap0, c0);
#if MK_DUP & 1
        __syncthreads(); ph_prep(*ap0, c0);
#endif
        if (p + 1 < ph_hi) xcd_barrier(bar);
        p = 1;
#if MK_PROBE
        if (stamper) ts[1] = __builtin_amdgcn_s_memrealtime();
#endif
    }
    for (; p < ph_hi; ++p) {
        const Args AS4* ap = (const Args AS4*)__builtin_amdgcn_kernarg_segment_ptr(); asm volatile("" : "+s"(ap));
        int tid_ = threadIdx.x; asm volatile("" : "+v"(tid_));
#define a (*ap)
        Ctx c; c.lds = (LAS unsigned char*)lds_raw; c.tid = tid_; c.lane = c.tid & 63; c.wave = __builtin_amdgcn_readfirstlane(c.tid >> 6);
        { int G_ = gridDim.x, bid_ = blockIdx.x; asm volatile("" : "+s"(G_), "+s"(bid_)); c.G = G_; c.bid = bid_; }
        c.gw = c.wave * c.G + c.bid; c.ngw = NWAVES * c.G; c.gt = c.bid * NTHR + c.tid; c.ngt = c.G * NTHR;
        bf16 *WINT = WSP(bf16, WS_WINT), *WUQT = WSP(bf16, WS_WUQT), *WUKVT = WSP(bf16, WS_WUKVT), *GLUT = WSP(bf16, WS_GLUT), *WOUTT = WSP(bf16, WS_WOUTT),
             *WQT = WSP(bf16, WS_WQT), *SUBKT = WSP(bf16, WS_SUBKT), *PU = WSP(bf16, WS_PU), *PV = WSP(bf16, WS_PV);
        float *COS = WSP(float, WS_COS), *SIN = WSP(float, WS_SIN);
        bf16 *XB = WSP(bf16, WS_XB), *Z = WSP(bf16, WS_Z), *QRAW = WSP(bf16, WS_QRAW), *KVRAW = WSP(bf16, WS_KVRAW), *QB = WSP(bf16, WS_QB), *KB = WSP(bf16, WS_KB),
             *VB = WSP(bf16, WS_VB), *CQN = WSP(bf16, WS_CQN), *CKVN = WSP(bf16, WS_CKVN), *AO = WSP(bf16, WS_AO), *ROUT = WSP(bf16, WS_ROUT), *Y = WSP(bf16, WS_Y),
             *YG = WSP(bf16, WS_YG), *SOUT = WSP(bf16, WS_SOUT), *QP = WSP(bf16, WS_QP);
        float *XC = WSP(float, WS_XC), *AA = WSP(float, WS_AA), *BT = WSP(float, WS_BT), *SC = WSP(float, WS_SC), *STOP = WSP(float, WS_STOP), *GATE = WSP(float, WS_GATE);
        int *ITOP = WSP(int, WS_ITOP), *IDX = WSP(int, WS_IDX);
        float* out = a.out;
        {
            const int l = (p - 1) / NPH_LAYER, k = (p - 1) % NPH_LAYER;
            const float* xin = (l == 0) ? INF(0) : out;
            GD gd, gd2; gd.kind = 0; gd.A = nullptr; gd.Bt = nullptr; gd.C = nullptr; gd.aux0 = nullptr; gd.aux1 = nullptr; gd.lda = 0; gd.M = T; gd.N = 0; gd.K = 0; gd.ldc = 0; gd2 = gd;
#define SETG(G_, kind_, A_, lda_, Bt_, M_, N_, K_, C_, ldc_, aux0_, aux1_) do { G_.kind = kind_; G_.A = A_; G_.lda = lda_; G_.Bt = Bt_; G_.M = M_; G_.N = N_; G_.K = K_; G_.C = (void*)(C_); G_.ldc = ldc_; G_.aux0 = aux0_; G_.aux1 = aux1_; } while (0)
            float* ROWSS = WSP(float, WS_ROWSS);
            switch (k) {
            case 0: SETG(gd, 1, XB, DM, WINT + (size_t)l * ZW * DM, T, ZW, DM, Z, ZW, nullptr, nullptr); break;
            case 1: ph_zstats(c, Z, INF(4) + l * 256, INF(6) + l * 128, CQN, CKVN);
                s5f::pass<false>(c.lds, Z, WSP(bf16, WS_S5A) + (size_t)l * 32768, WSP(bf16, WS_S5C) + (size_t)l * 32768, WSP(float2, WS_S5L) + l * 1024, INF(17) + l * 256, WSP(float2, WS_SE), WSP(float2, WS_SH), YG, c.gw, c.ngw, c.wave, c.lane);
                __syncthreads();
                lruf::pass_a(c.lds, Z, INF(20) + l * 1024, INF(21) + l * 256, INF(22) + l * 16384, INF(23) + l * 256, INF(24) + l * 16384, INF(25) + l * 256, INF(26) + l * 256, AA, BT, WSP(float2, WS_LPE), c.gw, c.ngw, c.wave, c.lane);
                break;
            case 2:
                for (int it = c.bid; it < 232; it += c.G) {
                    if (it >= 224) lruf::carry_wg(c.lds, WSP(float2, WS_LPE), WSP(float, WS_LH), it - 224, c.wave, c.lane);
                    else if (it >= 192) s5f::carry_wg(c.lds, WSP(float2, WS_S5L) + l * 1024, WSP(float2, WS_SE), WSP(float2, WS_SH), it - 192, c.wave, c.lane);
                }
                SETG(gd, 1, CQN, 256, WUQT + (size_t)l * 768 * 256, T, 768, 256, QRAW, 768, nullptr, nullptr);
                SETG(gd2, 1, CKVN, 128, WUKVT + (size_t)l * 1024 * 128, T, 1024, 128, KVRAW, 1024, nullptr, nullptr);
                break;
            case 3: ph_qkfin(c, QRAW, KVRAW, Z, INF(8) + l * DQK, INF(9) + l * DQK, COS, SIN, QB, KB, VB); break;
            case 4:
#if MK_DUP & 2
            for (int rep_ = 0; rep_ < 2; ++rep_) {
#endif
                s5f::pass<true>(c.lds, Z, WSP(bf16, WS_S5A) + (size_t)l * 32768, WSP(bf16, WS_S5C) + (size_t)l * 32768, WSP(float2, WS_S5L) + l * 1024, INF(17) + l * 256, WSP(float2, WS_SE), WSP(float2, WS_SH), YG, c.gw, c.ngw, c.wave, c.lane);
                lruf::pass_b(AA, BT, WSP(float, WS_LH), Z, ROUT, c.gt, c.ngt);
                __syncthreads(); att::attn_phase(c.lds, QB, KB, VB, AO, c.G, c.bid, c.tid);
#if MK_DUP & 2
            __syncthreads(); }
#endif
                break;
            case 5: SETG(gd, 3, YG, 256, GLUT + (size_t)l * 65536, T, 256, 256, SOUT, 256, INF(19) + l * 256, YG); break;
            case 6: ph_mixnorm(c, AO, SOUT, ROUT, INF(27) + l * DM, Y); break;
            case 7: SETG(gd, 2, Y, DM, WOUTT + (size_t)l * DM * DM, T, DM, DM, out, DM, xin, nullptr); break;
            case 8: SETG(gd, 1, XB, DM, WQT + (size_t)l * 2048 * DM, T, 2048, DM, QP, 2048, nullptr, nullptr); break;
            default: tk::topk_phase<true>(QP, SUBKT + (size_t)l * 32768, IDX, GATE, XB, WSP(unsigned char, WS_PU) + (size_t)l * 16384 * DM, WSP(unsigned char, WS_PV) + (size_t)l * 16384 * DM, out, ROWSS,
                                          (l + 1 < NL) ? INF(2) + (l + 1) * DM : nullptr, c.lds + c.wave * 2048, c.gw, c.ngw, c.lane); break;
            }
#undef SETG
            for (int gi = 0; gi < 2; ++gi) {
                const GD g = gi ? gd2 : gd;
                if (g.kind == 1) run_gemm(c, g.A, g.lda, g.Bt, g.M, g.N, g.K, pg8::EpiBf16<0>{(bf16*)g.C, g.ldc, nullptr, 0, 0, 1.f});
                else if (g.kind == 2) run_gemm(c, g.A, g.lda, g.Bt, g.M, g.N, g.K, pg8::EpiOut{(float*)g.C, g.ldc, g.aux0, INF(29) + l * DM, XB, ROWSS});
                else if (g.kind == 3) run_gemm(c, g.A, g.lda, g.Bt, g.M, g.N, g.K, pg8::EpiGlu{(bf16*)g.C, g.ldc, g.aux0, g.aux1});
            }
        }
        if (p + 1 < ph_hi) { XcdBarrier b2 = bar; unsigned* bb = (unsigned*)(a.ws + WS_CTL) + CW_BAR; unsigned bx = bar.x; asm volatile("" : "+s"(bb), "+s"(bx)); b2.bar = bb; b2.x = bx; xcd_barrier(b2); }
#if MK_PROBE
        if (p + 1 == ph_hi) xcd_barrier(bar);
        if (stamper) ts[p + 1] = __builtin_amdgcn_s_memrealtime();
#endif
#undef a
    }
#if MK_PROBE
    xcd_barrier(bar);
    {   const unsigned long long* tsr = (const unsigned long long*)(a_.ws + WS_CTL + TS_OFF);
        const unsigned long long ta0 = __hip_atomic_load(tsr + PROBE_A_LO, __ATOMIC_RELAXED, __HIP_MEMORY_SCOPE_AGENT), ta1 = __hip_atomic_load(tsr + PROBE_A_HI, __ATOMIC_RELAXED, __HIP_MEMORY_SCOPE_AGENT);
        const unsigned long long tb0 = __hip_atomic_load(tsr + PROBE_B_LO, __ATOMIC_RELAXED, __HIP_MEMORY_SCOPE_AGENT), tb1 = __hip_atomic_load(tsr + PROBE_B_HI, __ATOMIC_RELAXED, __HIP_MEMORY_SCOPE_AGENT);
        const float da_us = (float)(ta1 - ta0) * 0.01f, db_us = (float)(tb1 - tb0) * 0.01f;
        const float eps = sqrtf(db_us * 1e-4f);
        float* o = a_.out;
        for (size_t i = (size_t)blockIdx.x * NTHR + threadIdx.x; i < (size_t)T * DM; i += (size_t)gridDim.x * NTHR) { float v = o[i] * (1.f + eps); if (i == 0) v += da_us * 0.1f; o[i] = v; }
    }
#endif
}

extern "C" void kernel_launch(void* const* d_in, const int* in_sizes, int n_in, void* d_out, int out_size, void* d_ws, size_t ws_size, hipStream_t stream) {
    static int grid = 0;
    if (grid == 0) {
        if (n_in != 34 || out_size != T * DM || ws_size < WS_END) { fprintf(stderr, "kernel_launch: unexpected shapes (n_in %d out %d ws %zu)\n", n_in, out_size, ws_size); grid = -1; return; }
        int dev = 0, cus = 0, per_cu = 0;
        if (hipGetDevice(&dev) != hipSuccess || hipDeviceGetAttribute(&cus, hipDeviceAttributeMultiprocessorCount, dev) != hipSuccess) { grid = -1; return; }
        if (hipFuncSetAttribute((const void*)mega, hipFuncAttributeMaxDynamicSharedMemorySize, LDS_BYTES) != hipSuccess) { fprintf(stderr, "kernel_launch: hipFuncSetAttribute failed\n"); grid = -1; return; }
        if (hipOccupancyMaxActiveBlocksPerMultiprocessor(&per_cu, (const void*)mega, NTHR, LDS_BYTES) != hipSuccess || per_cu < 1) { fprintf(stderr, "kernel_launch: occupancy query says %d blocks per CU\n", per_cu); }
        (void)hipGetLastError();
        grid = cus;
    }
    if (grid < 0) return;
    (void)hipMemsetAsync((char*)d_ws + WS_CTL, 0, CTL_ZERO_BYTES, stream);
    Args a{};
    for (int i = 0; i < 34; ++i) a.in[i] = d_in[i];
    a.out = (float*)d_out; a.ws = (unsigned char*)d_ws;
#if MK_PER_PHASE
    for (int p = 0; p < NPH; ++p) { a.ph_lo = p; a.ph_hi = p + 1; hipLaunchKernelGGL(mega, dim3(grid), dim3(NTHR), LDS_BYTES, stream, a); }
#else
    a.ph_lo = 0; a.ph_hi = NPH;
    hipLaunchKernelGGL(mega, dim3(grid), dim3(NTHR), LDS_BYTES, stream, a);
#endif
}
```

```cpp
#include <hip/hip_runtime.h>
#include <cstdint>
#include <cstdio>

#ifndef MK_PER_PHASE
#define MK_PER_PHASE 0
#endif

typedef unsigned short bf16;
typedef unsigned int u32;

constexpr int NB = 2, SEQ = 8192, T = NB * SEQ, DM = 1024, NL = 2;
constexpr int ZW = 1280;
constexpr int ZC_CQ = 0, ZC_CKV = 256, ZC_KR = 384, ZC_U = 512, ZC_X = 768, ZC_G = 1024;
constexpr int NH = 4, DQK = 192, DV = 128;
constexpr float EPS = 1e-6f;
constexpr float QSCALE = 0.07216878364870322f * 1.4426950408889634f;

constexpr size_t MiB = 1u << 20;
constexpr size_t WS_CTL = 0, CTL_ZERO_BYTES = 1 * MiB, WS_WINT = 1 * MiB, WS_WUQT = 7 * MiB, WS_WUKVT = 8 * MiB, WS_GLUT = 9 * MiB, WS_WOUTT = 10 * MiB,
                 WS_WQT = 14 * MiB, WS_SUBKT = 22 * MiB, WS_COS = 23 * MiB, WS_SIN = 25 * MiB, WS_PU = 28 * MiB, WS_PV = 92 * MiB,
                 WS_XB = 156 * MiB, WS_Z = 188 * MiB, WS_RA = 228 * MiB, WS_RB = 356 * MiB, WS_CKVN = 420 * MiB, WS_AO = 424 * MiB,
                 WS_ROUT = 440 * MiB, WS_Y = 448 * MiB, WS_IDX = 480 * MiB, WS_GATE = 488 * MiB, WS_S5A = 496 * MiB, WS_S5C = WS_S5A + 128 * 1024, WS_S5L = WS_S5A + 256 * 1024,
                 WS_SE = 497 * MiB, WS_SH = 501 * MiB, WS_LPE = 505 * MiB, WS_LH = 506 * MiB, WS_ROWSS = WS_LH + 512 * 1024, WS_END = 508 * MiB;
constexpr size_t WS_QRAW = WS_RA, WS_KVRAW = WS_RA + 24 * MiB, WS_QB = WS_RA + 56 * MiB, WS_KB = WS_RA + 80 * MiB, WS_VB = WS_RA + 104 * MiB,
                 WS_CQN = WS_RA + 120 * MiB, WS_SC = WS_RA;
constexpr size_t WS_XC = WS_RB, WS_AA = WS_RB + 16 * MiB, WS_BT = WS_RB + 32 * MiB, WS_YG = WS_RB + 48 * MiB, WS_SOUT = WS_RB + 56 * MiB, WS_QP = WS_RB;
constexpr size_t WS_STOP = WS_Z, WS_ITOP = WS_Z + 16 * MiB;
constexpr int CW_BAR = 4096;

__device__ __forceinline__ float bf2f(bf16 h) { return __uint_as_float((u32)h << 16); }
__device__ __forceinline__ bf16 f2bf(float f) { u32 u = __float_as_uint(f); return (bf16)((u + 0x7fffu + ((u >> 16) & 1u)) >> 16); }
__device__ __forceinline__ u32 pk2(float lo, float hi) { return (u32)f2bf(lo) | ((u32)f2bf(hi) << 16); }
__device__ __forceinline__ float wave_sum(float v) {
#pragma unroll
    for (int o = 32; o > 0; o >>= 1) v += __shfl_xor(v, o);
    return v;
}
__device__ __forceinline__ float wave_max(float v) {
#pragma unroll
    for (int o = 32; o > 0; o >>= 1) v = fmaxf(v, __shfl_xor(v, o));
    return v;
}
__device__ __forceinline__ float gelu_f(float x) { return 0.5f * x * (1.f + erff(x * 0.70710678118654752f)); }
__device__ __forceinline__ float sigmoid_f(float x) { return 1.f / (1.f + __expf(-x)); }
__device__ __forceinline__ void unpack8(uint4 w, float* o) {
    o[0] = __uint_as_float(w.x << 16); o[1] = __uint_as_float(w.x & 0xffff0000u);
    o[2] = __uint_as_float(w.y << 16); o[3] = __uint_as_float(w.y & 0xffff0000u);
    o[4] = __uint_as_float(w.z << 16); o[5] = __uint_as_float(w.z & 0xffff0000u);
    o[6] = __uint_as_float(w.w << 16); o[7] = __uint_as_float(w.w & 0xffff0000u);
}
__device__ __forceinline__ void sincos_acc(float x, float& s, float& c) {
    const float k = rintf(x * 0.15915494309189535f);
    float r = fmaf(-k, 6.28125f, x);
    r = fmaf(-k, 1.9350051879882812e-3f, r);
    r = fmaf(-k, 3.0199160335e-7f, r);
    const float f = r * 0.15915494309189535f;
    s = __builtin_amdgcn_sinf(f); c = __builtin_amdgcn_cosf(f);
}
namespace pg8 {
#define PG8_LAS __attribute__((address_space(3)))
typedef unsigned short bf16_t;
typedef short bf16x8 __attribute__((ext_vector_type(8)));
typedef float f32x4 __attribute__((ext_vector_type(4)));
typedef unsigned u32x4 __attribute__((ext_vector_type(4)));
constexpr int BM = 256, BK = 64, HALF = 128, HTB = HALF * BK * 2  , STAGE_BYTES = 8 * HTB, NXCD = 8, WGM = 8;

__host__ __device__ __forceinline__ int lds_byte(int r, int c) { const int st = (r >> 4) * 2 + (c >> 5), rr = r & 15, cc = c & 31, ob = rr * 64 + cc * 2; return st * 1024 + (ob ^ (((ob >> 9) & 1) << 5)); }
__host__ __device__ __forceinline__ void stage_rc(int b, int& R, int& C) { const int st = b / 1024, sb = b % 1024, swz = sb ^ (((sb >> 9) & 1) << 5); R = (st >> 1) * 16 + swz / 64; C = (st & 1) * 32 + (swz % 64) / 2; }
__host__ __device__ __forceinline__ int perm32(int rho) { const int n = rho >> 4, i = rho & 15; return 8 * (i >> 2) + 4 * n + (i & 3); }

struct Unit { int pm, pn; };
struct Gemm { const bf16_t* A; const bf16_t* Bt; int M, N, K, lda; };

struct StaticOrder {
    int nM, nN, nwg, G, c;
    __host__ __device__ void init(int M, int N, int G_, int c_) { nM = M / BM; nN = N / BM; nwg = nM * nN; G = G_; c = c_; }
    __host__ __device__ bool next(int i, Unit& u) const {
        const long L = (long)i * G + c; if (L >= nwg) return false;
        int wgid = (int)L; { const int q = nwg / NXCD, r = nwg % NXCD, xcd = wgid % NXCD, off = wgid / NXCD; wgid = (xcd < r ? xcd * (q + 1) : r * (q + 1) + (xcd - r) * q) + off; }
        const int nig = WGM * nN, gid = wgid / nig, fm = gid * WGM, gsz = (nM - fm) < WGM ? (nM - fm) : WGM;
        u.pm = fm + ((wgid % nig) % gsz); u.pn = (wgid % nig) / gsz; return true;
    }
    __device__ __forceinline__ void a_ready(const Unit&) const {}
    __device__ __forceinline__ void done(const Unit&) const {}
};

__device__ __forceinline__ unsigned cvt_pk_bf16(float lo, float hi) { unsigned r; asm volatile("v_cvt_pk_bf16_f32 %0, %1, %2" : "=v"(r) : "v"(lo), "v"(hi)); return r; }
typedef float f32x2 __attribute__((ext_vector_type(2)));
__device__ __forceinline__ f32x2 gelu_pk(f32x2 v) {
    const f32x2 av = __builtin_elementwise_abs(v), d = av * 0.2316418882f + 1.0f;
    f32x2 t; t.x = __builtin_amdgcn_rcpf(d.x); t.y = __builtin_amdgcn_rcpf(d.y);
    f32x2 q = t * 0.5307027145f + (-0.7265760135f); q = q * t + 0.7107068705f; q = q * t + (-0.142248368f); q = q * t + 0.127414796f; q = q * t;
    const f32x2 s = (v * v) * (-0.72134752044f);
    f32x2 e; e.x = __builtin_amdgcn_exp2f(s.x); e.y = __builtin_amdgcn_exp2f(s.y);
    const f32x2 m = v * (q * e), r = v - m;
    f32x2 o; o.x = v.x < 0.f ? m.x : r.x; o.y = v.y < 0.f ? m.y : r.y; return o;
}

template <int ACT  > struct EpiBf16 {
    static constexpr bool PERM = true, AFTER_DRAIN = false; static_assert(ACT == 0 || ACT == 1, "EpiBf16: ACT is 0 (none) or 1 (gelu_pk)");
    bf16_t* O; int ldc; const float* bias; int split_cols; size_t split_stride; float scale0;
    __device__ __forceinline__ void operator()(const f32x4 (&acc)[2][2][4][2], const Unit& u, int wr, int wc, int fr, int fq) const {
        const int row0 = u.pm * BM + wr * 64 + fr; int colt = u.pn * BM; bf16_t* base = O;
        float sc = 1.f; if (split_cols) { const int t = colt / split_cols; base += (size_t)t * split_stride; colt -= t * split_cols; if (t == 0) sc = scale0; }
        const int col0 = colt + wc * 32 + 8 * fq, bcol0 = u.pn * BM + wc * 32 + 8 * fq;
        f32x4 bv[2][2];
#pragma unroll
        for (int bj = 0; bj < 2; ++bj)
#pragma unroll
            for (int n = 0; n < 2; ++n) bv[bj][n] = bias ? *(const f32x4*)(bias + bcol0 + bj * HALF + 4 * n) : (f32x4){0.f, 0.f, 0.f, 0.f};
#pragma unroll
        for (int ai = 0; ai < 2; ++ai)
#pragma unroll
            for (int m = 0; m < 4; ++m) { bf16_t* rowp = base + (size_t)(row0 + ai * HALF + m * 16) * ldc + col0;
#pragma unroll
                for (int bj = 0; bj < 2; ++bj) { f32x4 v0 = acc[ai][bj][m][0] + bv[bj][0], v1 = acc[ai][bj][m][1] + bv[bj][1];
                    if (ACT == 1) { f32x2 a = gelu_pk((f32x2){v0[0], v0[1]}), b = gelu_pk((f32x2){v0[2], v0[3]}), c = gelu_pk((f32x2){v1[0], v1[1]}), d = gelu_pk((f32x2){v1[2], v1[3]});
                        v0 = (f32x4){a.x, a.y, b.x, b.y}; v1 = (f32x4){c.x, c.y, d.x, d.y}; }
                    v0 = v0 * sc; v1 = v1 * sc; u32x4 w; w.x = cvt_pk_bf16(v0[0], v0[1]); w.y = cvt_pk_bf16(v0[2], v0[3]); w.z = cvt_pk_bf16(v1[0], v1[1]); w.w = cvt_pk_bf16(v1[2], v1[3]);
                    *(u32x4*)(rowp + bj * HALF) = w; } }
    }
};


struct EpiF32 {
    static constexpr bool PERM = false, AFTER_DRAIN = false;
    float* C; int ldc; const float* resid;
    __device__ __forceinline__ void operator()(const f32x4 (&acc)[2][2][4][2], const Unit& u, int wr, int wc, int fr, int fq) const {
        const int row0 = u.pm * BM + wr * 64 + fr, col0 = u.pn * BM + wc * 32 + 4 * fq;
#pragma unroll
        for (int ai = 0; ai < 2; ++ai)
#pragma unroll
            for (int m = 0; m < 4; ++m) { const size_t rb = (size_t)(row0 + ai * HALF + m * 16) * ldc + col0;
#pragma unroll
                for (int bj = 0; bj < 2; ++bj)
#pragma unroll
                    for (int n = 0; n < 2; ++n) { const size_t ix = rb + bj * HALF + n * 16; f32x4 v = acc[ai][bj][m][n];
                        if (resid) v += *(const f32x4*)(resid + ix);
                        *(f32x4*)(C + ix) = v; } }
    }
};

struct EpiOut {
    static constexpr bool PERM = false, AFTER_DRAIN = false;
    float* C; int ldc; const float* resid; const float* g; bf16_t* XB; float* rowss;
    __device__ __forceinline__ void operator()(const f32x4 (&acc)[2][2][4][2], const Unit& u, int wr, int wc, int fr, int fq) const {
        typedef unsigned u32x2 __attribute__((ext_vector_type(2)));
        const int row0 = u.pm * BM + wr * 64 + fr, col0 = u.pn * BM + wc * 32 + 4 * fq;
#pragma unroll
        for (int ai = 0; ai < 2; ++ai)
#pragma unroll
            for (int m = 0; m < 4; ++m) { const int row = row0 + ai * HALF + m * 16; const size_t rb = (size_t)row * ldc + col0; float ss = 0.f;
#pragma unroll
                for (int bj = 0; bj < 2; ++bj)
#pragma unroll
                    for (int n = 0; n < 2; ++n) { const size_t ix = rb + bj * HALF + n * 16; const f32x4 v = acc[ai][bj][m][n] + *(const f32x4*)(resid + ix);
                        *(f32x4*)(C + ix) = v; ss += (v[0] * v[0] + v[1] * v[1]) + (v[2] * v[2] + v[3] * v[3]);
                        const f32x4 gg = *(const f32x4*)(g + col0 + bj * HALF + n * 16);
                        u32x2 w; w.x = cvt_pk_bf16(v[0] * gg[0], v[1] * gg[1]); w.y = cvt_pk_bf16(v[2] * gg[2], v[3] * gg[3]); *(u32x2*)(XB + ix) = w; }
                ss += __shfl_xor(ss, 16); ss += __shfl_xor(ss, 32);
                if (fq == 0) rowss[(size_t)row * 16 + u.pn * 4 + wc] = ss; }
    }
};
struct EpiGlu {
    static constexpr bool PERM = true, AFTER_DRAIN = false;
    bf16_t* O; int ldc; const float* bias; const bf16_t* YG;
    __device__ __forceinline__ void operator()(const f32x4 (&acc)[2][2][4][2], const Unit& u, int wr, int wc, int fr, int fq) const {
        const int row0 = u.pm * BM + wr * 64 + fr, col0 = u.pn * BM + wc * 32 + 8 * fq;
#pragma unroll
        for (int ai = 0; ai < 2; ++ai)
#pragma unroll
            for (int m = 0; m < 4; ++m) { const size_t rb = (size_t)(row0 + ai * HALF + m * 16) * ldc + col0;
#pragma unroll
                for (int bj = 0; bj < 2; ++bj) { const size_t ix = rb + bj * HALF;
                    const f32x4 b0 = *(const f32x4*)(bias + col0 + bj * HALF), b1 = *(const f32x4*)(bias + col0 + bj * HALF + 4);
                    const u32x4 yw = *(const u32x4*)(YG + ix);
                    f32x4 v0 = acc[ai][bj][m][0] + b0, v1 = acc[ai][bj][m][1] + b1; float o[8];
#pragma unroll
                    for (int e = 0; e < 4; ++e) { const unsigned w = e == 0 ? yw.x : e == 1 ? yw.y : e == 2 ? yw.z : yw.w;
                        const float y0 = __uint_as_float(w << 16), y1 = __uint_as_float(w & 0xffff0000u);
                        const float a0 = e < 2 ? v0[2 * e] : v1[2 * e - 4], a1 = e < 2 ? v0[2 * e + 1] : v1[2 * e - 3];
                        o[2 * e] = y0 / (1.f + __expf(-a0)); o[2 * e + 1] = y1 / (1.f + __expf(-a1)); }
                    u32x4 w; w.x = cvt_pk_bf16(o[0], o[1]); w.y = cvt_pk_bf16(o[2], o[3]); w.z = cvt_pk_bf16(o[4], o[5]); w.w = cvt_pk_bf16(o[6], o[7]);
                    *(u32x4*)(O + ix) = w; } }
    }
};
template <class Epi, class Sched, bool ALIGN_EPI = false, bool SP2 = false>
__device__ __forceinline__ void gemm_phase(PG8_LAS unsigned char* lds, const Gemm g, const Sched& S, const Epi& E) {
    int tid_l = threadIdx.x; asm volatile("" : "+v"(tid_l));
    const int tid = tid_l, wid = __builtin_amdgcn_readfirstlane(tid >> 6), lane = tid & 63, wr = wid >> 2, wc = wid & 3, fr = lane & 15, fq = lane >> 4;
    const int K = g.K, nt = K / BK;
    unsigned voffA[2], voffB[2];
#pragma unroll
    for (int i = 0; i < 2; ++i) { int R, C; stage_rc(tid * 16 + i * 8192, R, C); const int Rb = Epi::PERM ? ((R & ~31) + perm32(R & 31)) : R;
        voffA[i] = (unsigned)(R * g.lda + C) * 2u; voffB[i] = (unsigned)(Rb * K + C) * 2u; }
    const size_t kstep = (size_t)(BK * 2);
    const size_t hsA = (size_t)HALF * g.lda * 2, hsB = (size_t)HALF * K * 2;
    const size_t tsA = 2 * hsA, tsB = 2 * hsB;
    const unsigned ldsw = (unsigned)wid * 1024u;
    const int aoff = lds_byte(wr * 64 + fr, fq * 8), boff = lds_byte(wc * 32 + fr, fq * 8);
#define PG8_SA(b, h) (((b) * 2 + (h)) * HTB)
#define PG8_SB(b, h) ((4 + (b) * 2 + (h)) * HTB)
#define PG8_STAGE(bufoff, gbase, voff) do { _Pragma("unroll") for (int _i = 0; _i < 2; ++_i) \
        __builtin_amdgcn_global_load_lds((const unsigned*)((const char*)(gbase) + (voff)[_i]), (PG8_LAS unsigned*)(lds + (bufoff) + ldsw + _i * 8192), 16, 0, 0); } while (0)
#define PG8_LDA(dst, b, h) do { _Pragma("unroll") for (int m = 0; m < 4; ++m) _Pragma("unroll") for (int k = 0; k < 2; ++k) dst[m][k] = *(const PG8_LAS bf16x8*)(lds + PG8_SA(b, h) + aoff + m * 2048 + k * 1024); } while (0)
#define PG8_LDB(dst, b, h) do { _Pragma("unroll") for (int n = 0; n < 2; ++n) _Pragma("unroll") for (int k = 0; k < 2; ++k) dst[n][k] = *(const PG8_LAS bf16x8*)(lds + PG8_SB(b, h) + boff + n * 2048 + k * 1024); } while (0)
#define PG8_MMA(ai, bj, At, Bt) do { __builtin_amdgcn_s_setprio(1); _Pragma("unroll") for (int m = 0; m < 4; ++m) _Pragma("unroll") for (int n = 0; n < 2; ++n) _Pragma("unroll") for (int k = 0; k < 2; ++k) \
        acc[ai][bj][m][n] = __builtin_amdgcn_mfma_f32_16x16x32_bf16(Bt[n][k], At[m][k], acc[ai][bj][m][n], 0, 0, 0); __builtin_amdgcn_s_setprio(0); } while (0)
#define PG8_WAIT_V(n) asm volatile("s_waitcnt vmcnt(" #n ")" ::: "memory")
#define PG8_WAIT_L(n) asm volatile("s_waitcnt lgkmcnt(" #n ")" ::: "memory")
#define PG8_BAR __builtin_amdgcn_s_barrier()
#define PG8_SCHED __builtin_amdgcn_sched_barrier(0)
    Unit cur, nxt; int ui = 0;
    if (!S.next(0, cur)) return;
    f32x4 acc[2][2][4][2];
#pragma unroll
    for (int a = 0; a < 2; ++a)
#pragma unroll
        for (int b = 0; b < 2; ++b)
#pragma unroll
            for (int m = 0; m < 4; ++m)
#pragma unroll
                for (int n = 0; n < 2; ++n) acc[a][b][m][n] = (f32x4){0.f, 0.f, 0.f, 0.f};
    bf16x8 At[4][2], B0[2][2], B1[2][2];
    const char* cA = (const char*)g.A + (size_t)cur.pm * tsA; const char* cB = (const char*)g.Bt + (size_t)cur.pn * tsB;
    S.a_ready(cur);
    if constexpr (SP2) {
        PG8_STAGE(PG8_SB(0, 0), cB, voffB); PG8_STAGE(PG8_SB(0, 1), cB + hsB, voffB); PG8_STAGE(PG8_SA(0, 0), cA, voffA); PG8_STAGE(PG8_SA(0, 1), cA + hsA, voffA);
        if (wr == 1) PG8_BAR;
        PG8_WAIT_V(2); PG8_BAR;
        PG8_STAGE(PG8_SB(1, 0), cB + kstep, voffB); PG8_STAGE(PG8_SA(1, 0), cA + kstep, voffA); PG8_STAGE(PG8_SB(1, 1), cB + hsB + kstep, voffB);
        PG8_WAIT_V(6); PG8_BAR;
    } else {
        PG8_STAGE(PG8_SB(0, 0), cB, voffB); PG8_STAGE(PG8_SA(0, 0), cA, voffA); PG8_STAGE(PG8_SB(0, 1), cB + hsB, voffB); PG8_STAGE(PG8_SA(0, 1), cA + hsA, voffA);
        if (wr == 1) PG8_BAR;
        PG8_WAIT_V(4); PG8_BAR;
        PG8_STAGE(PG8_SB(1, 0), cB + kstep, voffB); PG8_STAGE(PG8_SA(1, 0), cA + kstep, voffA); PG8_STAGE(PG8_SB(1, 1), cB + hsB + kstep, voffB);
        PG8_WAIT_V(6); PG8_BAR;
    }
    for (;;) {
        const bool has_next = S.next(ui + 1, nxt);
        const char* nA = has_next ? (const char*)g.A + (size_t)nxt.pm * tsA : cA; const char* nB = has_next ? (const char*)g.Bt + (size_t)nxt.pn * tsB : cB;
        for (int t = 0; t < nt; t += 2) {
            const bool last = (t == nt - 2);
            const char* a1 = cA + (size_t)(t + 1) * kstep;
            const char* a2 = last ? nA : cA + (size_t)(t + 2) * kstep; const char* b2 = last ? nB : cB + (size_t)(t + 2) * kstep;
            const char* a3 = a2 + kstep; const char* b3 = b2 + kstep;
            if (last && has_next) S.a_ready(nxt);
            if constexpr (SP2) {
            PG8_LDB(B0, 0, 0); PG8_LDB(B1, 0, 1); PG8_SCHED; PG8_LDA(At, 0, 0); PG8_STAGE(PG8_SA(1, 1), a1 + hsA, voffA);
            PG8_WAIT_V(8); PG8_WAIT_L(0); PG8_BAR; PG8_MMA(0, 0, At, B0); PG8_MMA(0, 1, At, B1); PG8_BAR; PG8_SCHED;
            PG8_LDA(At, 0, 1); PG8_STAGE(PG8_SB(0, 0), b2, voffB); PG8_STAGE(PG8_SB(0, 1), b2 + hsB, voffB); PG8_STAGE(PG8_SA(0, 0), a2, voffA);
            PG8_WAIT_V(8); PG8_WAIT_L(0); PG8_BAR; PG8_MMA(1, 0, At, B0); PG8_MMA(1, 1, At, B1); PG8_BAR; PG8_SCHED;
            PG8_LDB(B0, 1, 0); PG8_LDB(B1, 1, 1); PG8_SCHED; PG8_LDA(At, 1, 0); PG8_STAGE(PG8_SA(0, 1), a2 + hsA, voffA);
            PG8_WAIT_V(8); PG8_WAIT_L(0); PG8_BAR; PG8_MMA(0, 0, At, B0); PG8_MMA(0, 1, At, B1); PG8_BAR; PG8_SCHED;
            PG8_LDA(At, 1, 1); PG8_STAGE(PG8_SB(1, 0), b3, voffB); PG8_STAGE(PG8_SB(1, 1), b3 + hsB, voffB); PG8_STAGE(PG8_SA(1, 0), a3, voffA);
            PG8_WAIT_V(8); PG8_WAIT_L(0); PG8_BAR; PG8_MMA(1, 0, At, B0); PG8_MMA(1, 1, At, B1); PG8_BAR; PG8_SCHED;
            } else {
            PG8_LDB(B0, 0, 0); PG8_SCHED; PG8_LDA(At, 0, 0); PG8_STAGE(PG8_SA(1, 1), a1 + hsA, voffA);
            PG8_WAIT_L(8); PG8_BAR; PG8_WAIT_L(0); PG8_MMA(0, 0, At, B0); PG8_BAR; PG8_SCHED;
            PG8_LDB(B1, 0, 1); PG8_STAGE(PG8_SB(0, 0), b2, voffB);
            PG8_BAR; PG8_WAIT_L(0); PG8_MMA(0, 1, At, B1); PG8_BAR;
            PG8_LDA(At, 0, 1); PG8_STAGE(PG8_SA(0, 0), a2, voffA);
            PG8_BAR; PG8_WAIT_L(0); PG8_MMA(1, 0, At, B0); PG8_BAR; PG8_SCHED;
            PG8_STAGE(PG8_SB(0, 1), b2 + hsB, voffB);
            PG8_WAIT_V(6); PG8_BAR; PG8_MMA(1, 1, At, B1); PG8_BAR;
            PG8_LDB(B0, 1, 0); PG8_SCHED; PG8_LDA(At, 1, 0); PG8_STAGE(PG8_SA(0, 1), a2 + hsA, voffA);
            PG8_WAIT_L(8); PG8_BAR; PG8_WAIT_L(0); PG8_MMA(0, 0, At, B0); PG8_BAR; PG8_SCHED;
            PG8_LDB(B1, 1, 1); PG8_STAGE(PG8_SB(1, 0), b3, voffB);
            PG8_BAR; PG8_WAIT_L(0); PG8_MMA(0, 1, At, B1); PG8_BAR;
            PG8_LDA(At, 1, 1); PG8_STAGE(PG8_SA(1, 0), a3, voffA);
            PG8_BAR; PG8_WAIT_L(0); PG8_MMA(1, 0, At, B0); PG8_BAR; PG8_SCHED;
            PG8_STAGE(PG8_SB(1, 1), b3 + hsB, voffB);
            PG8_WAIT_V(6); PG8_BAR; PG8_MMA(1, 1, At, B1); PG8_BAR;
            }
        }
        if constexpr (ALIGN_EPI) { if (wr == 0) PG8_BAR; }
        if constexpr (!Epi::AFTER_DRAIN) { E(acc, cur, wr, wc, fr, fq); S.done(cur); }
        if (!has_next) break;
#pragma unroll
        for (int a = 0; a < 2; ++a)
#pragma unroll
            for (int b = 0; b < 2; ++b)
#pragma unroll
                for (int m = 0; m < 4; ++m)
#pragma unroll
                    for (int n = 0; n < 2; ++n) acc[a][b][m][n] = (f32x4){0.f, 0.f, 0.f, 0.f};
        cur = nxt; cA = nA; cB = nB; ++ui;
        if constexpr (ALIGN_EPI) { if (wr == 1) PG8_BAR; }
    }
    PG8_WAIT_V(0);
    if constexpr (!ALIGN_EPI) { if (wr == 0) PG8_BAR; }
    PG8_BAR;
    if constexpr (Epi::AFTER_DRAIN) { E.fused(acc, cur, wr, wc, fr, fq, lds, wid, lane); S.done(cur); }
#undef PG8_SA
#undef PG8_SB
#undef PG8_STAGE
#undef PG8_LDA
#undef PG8_LDB
#undef PG8_MMA
#undef PG8_WAIT_V
#undef PG8_WAIT_L
#undef PG8_BAR
#undef PG8_SCHED
}
}
#define GAS __attribute__((address_space(1)))
#define LAS __attribute__((address_space(3)))
#define XB_TMO      128
#define XB_XCNT(j)  (256  + 64 * (j))
#define XB_XSUB(j)  (1280 + 64 * (j))
#define XB_XGEN(j)  (2304 + 64 * (j))
#define XB_TOP      3328
#define XB_TOPGEN   3392
#define XCD_BAR_WORDS 3456
#define XB_SPIN_CAP (1u << 25)
__device__ __forceinline__ unsigned xb_ld(unsigned* p)              { return __hip_atomic_load(p, __ATOMIC_RELAXED, __HIP_MEMORY_SCOPE_AGENT); }
__device__ __forceinline__ unsigned xb_add(unsigned* p, unsigned v) { return __hip_atomic_fetch_add(p, v, __ATOMIC_RELAXED, __HIP_MEMORY_SCOPE_AGENT); }
__device__ __forceinline__ unsigned xb_xcc_id() { return (unsigned)__builtin_amdgcn_s_getreg((3 << 11) | 20) & 0xFu; }
#define XB_SPIN(cond, bar) do { unsigned _sp = 0; while (cond) { __builtin_amdgcn_s_sleep(1); \
    if ((++_sp & 255u) == 0u) { if (xb_ld(&(bar)[XB_TMO])) break; if (_sp > XB_SPIN_CAP) { atomicAdd(&(bar)[XB_TMO], 1u); break; } } } } while (0)
struct XcdBarrier { unsigned* bar; unsigned x; volatile LAS unsigned* st; };
__device__ __forceinline__ XcdBarrier xcd_barrier_post(unsigned* bar, volatile LAS unsigned* st) {
    XcdBarrier b; b.bar = bar; b.x = xb_xcc_id(); b.st = st;
    if (threadIdx.x == 0) (void)xb_add(&bar[XB_XCNT(b.x)], 1u);
    return b;
}
__device__ __forceinline__ void xcd_barrier_complete(unsigned* bar, unsigned x, unsigned& nloc, unsigned& nx) {
    const unsigned G = gridDim.x * gridDim.y * gridDim.z;
    unsigned sum, cnt, mine, sp = 0u;
    for (;;) {
        sum = 0u; cnt = 0u; mine = 0u;
#pragma unroll
        for (unsigned j = 0; j < 16; ++j) { const unsigned c = xb_ld(&bar[XB_XCNT(j)]); sum += c; cnt += (c > 0u) ? 1u : 0u; mine = (j == x) ? c : mine; }
        if (sum == G) break;
        __builtin_amdgcn_s_sleep(1);
        if ((++sp & 255u) == 0u) { if (xb_ld(&bar[XB_TMO])) break; if (sp > XB_SPIN_CAP) { atomicAdd(&bar[XB_TMO], 1u); break; } }
    }
    nloc = mine > 0u ? mine : 1u; nx = cnt > 0u ? cnt : 1u;
}
__device__ __forceinline__ void xcd_barrier(const XcdBarrier& b) {
    asm volatile("s_waitcnt vmcnt(0)" ::: "memory");
    __syncthreads();
    if (threadIdx.x == 0) {
        unsigned* bar = b.bar;
        __builtin_amdgcn_s_waitcnt(0);
        unsigned nloc = b.st[0], nx = b.st[1];
        if (nloc == 0u) { xcd_barrier_complete(bar, b.x, nloc, nx); b.st[0] = nloc; b.st[1] = nx; }
        const unsigned old = xb_add(&bar[XB_XSUB(b.x)], 1u);
        const unsigned gen = old / nloc;
        if (old + 1u == (gen + 1u) * nloc) {
            __builtin_amdgcn_fence(__ATOMIC_RELEASE, "agent");
            asm volatile("s_waitcnt vmcnt(0)" ::: "memory");
            const unsigned og = xb_add(&bar[XB_TOP], 1u);
            const unsigned tg = og / nx;
            if (og + 1u == (tg + 1u) * nx) xb_add(&bar[XB_TOPGEN], 1u);
            else XB_SPIN(xb_ld(&bar[XB_TOPGEN]) == tg, bar);
            __builtin_amdgcn_fence(__ATOMIC_ACQUIRE, "agent");
            xb_add(&bar[XB_XGEN(b.x)], 1u);
            asm volatile("s_waitcnt vmcnt(0)" ::: "memory");
        } else {
            XB_SPIN(xb_ld(&bar[XB_XGEN(b.x)]) == gen, bar);
            __builtin_amdgcn_fence(__ATOMIC_ACQUIRE, "agent");
            asm volatile("s_waitcnt vmcnt(0)" ::: "memory");
        }
    }
    __syncthreads();
}
namespace s5f {
typedef short bf16x8 __attribute__((ext_vector_type(8)));
typedef float f32x4 __attribute__((ext_vector_type(4)));
typedef unsigned u32x2 __attribute__((ext_vector_type(2)));
constexpr int LC = 32, NCH = SEQ / LC, RS = 272, WBYTES = LC * RS;
__device__ __forceinline__ void build_tables(const float* a_re, const float* a_im, const float* log_dt, const float* b_re, const float* b_im, const float* c_re, const float* c_im,
                                             bf16* S5A, bf16* S5C, float2* S5L, int gt, int ngt) {
    for (int i = gt; i < 16 * 64; i += ngt) {
        const int g = i >> 6;
        const float are = a_re[i], aim = a_im[i], dt = expf(log_dt[g]);
        const float mag = expf(are * dt); float sn, cs; sincos_acc(aim * dt, sn, cs);
        const float lre = mag * cs, lim = mag * sn;
        const float xr = lre - 1.f, xi = lim, den = are * are + aim * aim;
        const float cr = (xr * are + xi * aim) / den, ci = (xi * are - xr * aim) / den;
        S5L[i] = make_float2(lre, lim);
        const int p = i & 63;
        for (int k = 0; k < 16; ++k) { const float br = b_re[i * 16 + k], bi = b_im[i * 16 + k];
            S5A[((size_t)g * 128 + 2 * p) * 16 + k] = f2bf(cr * br - ci * bi); S5A[((size_t)g * 128 + 2 * p + 1) * 16 + k] = f2bf(cr * bi + ci * br);
            S5C[((size_t)g * 16 + k) * 128 + 2 * p] = f2bf(c_re[(g * 16 + k) * 64 + p]); S5C[((size_t)g * 16 + k) * 128 + 2 * p + 1] = f2bf(-c_im[(g * 16 + k) * 64 + p]); }
    }
}
template <bool FULL> __device__ __forceinline__ void chunk(LAS unsigned char* wl, const bf16* Z, const bf16x8 (&afr)[8], const bf16x8 (&cfr)[4], float lre, float lim, float& hre, float& him,
                                                           int b, int ch, int g, int lane, const float* dsk, bf16* YG) {
    const int l15 = lane & 15, q4 = lane >> 4;
    const size_t t0 = (size_t)b * SEQ + (size_t)ch * LC;
#pragma unroll
    for (int nb = 0; nb < 2; ++nb) {
        bf16x8 ufr = bf16x8{};
        if (q4 < 2) ufr = *(const bf16x8*)(Z + (t0 + 16 * nb + l15) * ZW + ZC_U + g * 16 + 8 * q4);
#pragma unroll
        for (int mb = 0; mb < 8; ++mb) {
            f32x4 d = __builtin_amdgcn_mfma_f32_16x16x32_bf16(afr[mb], ufr, f32x4{0.f, 0.f, 0.f, 0.f}, 0, 0, 0);
            *(LAS u32x2*)(wl + (16 * nb + l15) * RS + (16 * mb + 4 * q4) * 2) = u32x2{pk2(d[0], d[1]), pk2(d[2], d[3])};
        }
    }
#pragma unroll 8
    for (int k = 0; k < LC; ++k) {
        LAS unsigned* wp = (LAS unsigned*)(wl + k * RS + 4 * lane);
        const unsigned w = *wp; const float bre = __uint_as_float(w << 16), bim = __uint_as_float(w & 0xffff0000u);
        const float nre = fmaf(lre, hre, fmaf(-lim, him, bre)), nim = fmaf(lre, him, fmaf(lim, hre, bim)); hre = nre; him = nim;
        if (FULL) *wp = pk2(hre, him);
    }
    if (FULL) {
#pragma unroll
        for (int nb = 0; nb < 2; ++nb) {
            f32x4 y = f32x4{0.f, 0.f, 0.f, 0.f};
#pragma unroll
            for (int ks = 0; ks < 4; ++ks) {
                const bf16x8 hfr = *(const LAS bf16x8*)(wl + (16 * nb + l15) * RS + (32 * ks + 8 * q4) * 2);
                y = __builtin_amdgcn_mfma_f32_16x16x32_bf16(cfr[ks], hfr, y, 0, 0, 0);
            }
            const size_t t = t0 + 16 * nb + l15; const int co = 4 * q4;
            const uint2 uw = *(const uint2*)(Z + t * ZW + ZC_U + g * 16 + co);
            const float4 dd = *(const float4*)(dsk + g * 16 + co);
            const float y0 = y[0] + dd.x * __uint_as_float(uw.x << 16), y1 = y[1] + dd.y * __uint_as_float(uw.x & 0xffff0000u),
                        y2 = y[2] + dd.z * __uint_as_float(uw.y << 16), y3 = y[3] + dd.w * __uint_as_float(uw.y & 0xffff0000u);
            *(uint2*)(YG + t * 256 + g * 16 + co) = make_uint2(pk2(gelu_f(y0), gelu_f(y1)), pk2(gelu_f(y2), gelu_f(y3)));
        }
    }
}
template <bool FULL> __device__ __forceinline__ void pass(LAS unsigned char* lds, const bf16* Z, const bf16* S5A, const bf16* S5C, const float2* S5L, const float* dsk,
                                                          float2* SE, const float2* SH, bf16* YG, int gw, int ngw, int wave, int lane) {
    LAS unsigned char* wl = lds + wave * WBYTES;
    const int g = gw & 15, l15 = lane & 15, q4 = lane >> 4;
    bf16x8 afr[8], cfr[4];
#pragma unroll
    for (int mb = 0; mb < 8; ++mb) { afr[mb] = bf16x8{}; if (q4 < 2) afr[mb] = *(const bf16x8*)(S5A + ((size_t)g * 128 + 16 * mb + l15) * 16 + 8 * q4); }
#pragma unroll
    for (int ks = 0; ks < 4; ++ks) { cfr[ks] = bf16x8{}; if (FULL) cfr[ks] = *(const bf16x8*)(S5C + ((size_t)g * 16 + l15) * 128 + 32 * ks + 8 * q4); }
    const float2 lam = S5L[g * 64 + lane];
    for (int it = gw >> 4; it < NB * NCH; it += ngw >> 4) {
        const int b = it / NCH, ch = it % NCH;
        float hre = 0.f, him = 0.f;
        if (FULL) { const float2 h0 = SH[((size_t)it * 16 + g) * 64 + lane]; hre = h0.x; him = h0.y; }
        chunk<FULL>(wl, Z, afr, cfr, lam.x, lam.y, hre, him, b, ch, g, lane, dsk, YG);
        if (!FULL) SE[((size_t)it * 16 + g) * 64 + lane] = make_float2(hre, him);
    }
}
__device__ __forceinline__ void carry_wg(LAS unsigned char* lds, const float2* S5L, const float2* SE, float2* SH, int item, int wave, int lane) {
    typedef float f32x2v __attribute__((ext_vector_type(2)));
    LAS f32x2v* tot = (LAS f32x2v*)lds;
    const int b = item >> 4, g = item & 15;
    float2 L = S5L[g * 64 + lane];
#pragma unroll
    for (int i = 0; i < 5; ++i) { const float re = L.x * L.x - L.y * L.y, im = 2.f * L.x * L.y; L.x = re; L.y = im; }
    float hre = 0.f, him = 0.f;
    const size_t base = (((size_t)b * NCH + 32 * wave) * 16 + g) * 64 + lane;
    float2 e[32];
#pragma unroll
    for (int c = 0; c < 32; ++c) e[c] = SE[base + (size_t)c * 1024];
#pragma unroll
    for (int c = 0; c < 32; ++c) { const float nre = L.x * hre - L.y * him + e[c].x, nim = L.x * him + L.y * hre + e[c].y; e[c] = make_float2(hre, him); hre = nre; him = nim; }
    tot[wave * 64 + lane] = f32x2v{hre, him};
    float2 LS = L;
#pragma unroll
    for (int i = 0; i < 5; ++i) { const float re = LS.x * LS.x - LS.y * LS.y, im = 2.f * LS.x * LS.y; LS.x = re; LS.y = im; }
    __syncthreads();
    float cre = 0.f, cim = 0.f;
    for (int w = 0; w < wave; ++w) { const f32x2v s = tot[w * 64 + lane]; const float nre = LS.x * cre - LS.y * cim + s.x, nim = LS.x * cim + LS.y * cre + s.y; cre = nre; cim = nim; }
#pragma unroll
    for (int c = 0; c < 32; ++c) { SH[base + (size_t)c * 1024] = make_float2(e[c].x + cre, e[c].y + cim); const float nre = L.x * cre - L.y * cim, nim = L.x * cim + L.y * cre; cre = nre; cim = nim; }
    __syncthreads();
}
}
namespace lruf {
typedef float f32x4 __attribute__((ext_vector_type(4)));
constexpr int LC = 32, NCH = SEQ / LC, XS = 68;
__device__ __forceinline__ void pass_a(LAS unsigned char* lds, const bf16* Z, const float* cw, const float* cb, const float* wa, const float* ba, const float* wx, const float* bx, const float* lam,
                                       float* AA, float* BT, float2* LPE, int gw, int ngw, int wave, int lane) {
    LAS float* xt = (LAS float*)lds + wave * (LC * XS);
    for (int item = gw; item < NB * NCH * 4; item += ngw) {
        const int h = item & 3, bc = item >> 2, b = bc / NCH, ch = bc % NCH, c = h * 64 + lane;
        const size_t t0 = (size_t)b * SEQ + (size_t)ch * LC;
        const float w0 = cw[c], w1 = cw[256 + c], w2 = cw[512 + c], w3 = cw[768 + c], bias = cb[c];
        float z0 = 0.f, z1 = 0.f, z2 = 0.f;
        if (ch > 0) { z0 = bf2f(Z[(t0 - 3) * ZW + ZC_X + c]); z1 = bf2f(Z[(t0 - 2) * ZW + ZC_X + c]); z2 = bf2f(Z[(t0 - 1) * ZW + ZC_X + c]); }
        float xc[LC];
#pragma unroll
        for (int k = 0; k < LC; ++k) { const float z3 = bf2f(Z[(t0 + k) * ZW + ZC_X + c]); xc[k] = bias + w0 * z0 + w1 * z1 + w2 * z2 + w3 * z3; z0 = z1; z1 = z2; z2 = z3; xt[k * XS + lane] = xc[k]; }
        float ra[LC], rx[LC];
        { const float b0 = ba[c], b1 = bx[c];
#pragma unroll
          for (int k = 0; k < LC; ++k) { ra[k] = b0; rx[k] = b1; } }
        const float* wap = wa + (size_t)h * 4096 + lane; const float* wxp = wx + (size_t)h * 4096 + lane;
        for (int i = 0; i < 64; i += 4) {
            const float a0 = wap[(i + 0) * 64], a1 = wap[(i + 1) * 64], a2 = wap[(i + 2) * 64], a3 = wap[(i + 3) * 64];
            const float x0 = wxp[(i + 0) * 64], x1 = wxp[(i + 1) * 64], x2 = wxp[(i + 2) * 64], x3 = wxp[(i + 3) * 64];
#pragma unroll
            for (int k = 0; k < LC; ++k) { const f32x4 v = *(const LAS f32x4*)(xt + k * XS + i);
                ra[k] += v.x * a0 + v.y * a1 + v.z * a2 + v.w * a3; rx[k] += v.x * x0 + v.y * x1 + v.z * x2 + v.w * x3; }
        }
        const float lsg8 = -8.f * log1pf(expf(-lam[c]));
        float hloc = 0.f, prod = 1.f;
#pragma unroll
        for (int k = 0; k < LC; ++k) {
            const float r = sigmoid_f(ra[k]), ig = sigmoid_f(rx[k]);
            const float la = r * lsg8, av = expf(la), bt = sqrtf(-expm1f(2.f * la)) * (ig * xc[k]);
            AA[(t0 + k) * 256 + c] = av; BT[(t0 + k) * 256 + c] = bt;
            hloc = av * hloc + bt; prod *= av;
        }
        LPE[(size_t)bc * 256 + c] = make_float2(prod, hloc);
    }
}
__device__ __forceinline__ void carry_wg(LAS unsigned char* lds, const float2* LPE, float* LH, int item, int wave, int lane) {
    typedef float f32x2v __attribute__((ext_vector_type(2)));
    LAS f32x2v* tot = (LAS f32x2v*)lds;
    const int b = item >> 2, ch = (item & 3) * 64 + lane;
    const size_t base = ((size_t)b * NCH + 32 * wave) * 256 + ch;
    float2 pe[32];
#pragma unroll
    for (int c = 0; c < 32; ++c) pe[c] = LPE[base + (size_t)c * 256];
    float h = 0.f, prod = 1.f;
#pragma unroll
    for (int c = 0; c < 32; ++c) { const float p = pe[c].x, e = pe[c].y; pe[c] = make_float2(prod, h); h = p * h + e; prod *= p; }
    tot[wave * 64 + lane] = f32x2v{prod, h};
    __syncthreads();
    float cin = 0.f;
    for (int w = 0; w < wave; ++w) { const f32x2v s = tot[w * 64 + lane]; cin = s.x * cin + s.y; }
#pragma unroll
    for (int c = 0; c < 32; ++c) LH[base + (size_t)c * 256] = pe[c].y + pe[c].x * cin;
    __syncthreads();
}
__device__ __forceinline__ void pass_b(const float* AA, const float* BT, const float* LH, const bf16* Z, bf16* ROUT, int gt, int ngt) {
    for (int i = gt; i < NB * NCH * 256; i += ngt) { const int c = i & 255, bc = i >> 8; const size_t t0 = (size_t)bc * LC;
        float h = LH[i];
#pragma unroll 8
        for (int k = 0; k < LC; ++k) { const size_t t = t0 + k;
            h = AA[t * 256 + c] * h + BT[t * 256 + c];
            ROUT[t * 256 + c] = f2bf(h * gelu_f(bf2f(Z[t * ZW + ZC_G + c]))); } }
}
}
namespace pgf {
typedef float f32x2 __attribute__((ext_vector_type(2)));
typedef unsigned u32x4 __attribute__((ext_vector_type(4)));
constexpr float USCALE = 64.f, VSCALE = 4.f;
__device__ __forceinline__ unsigned pack4_fp8(float a, float b, float c, float d) {
    int w = __builtin_amdgcn_cvt_pk_fp8_f32(a, b, 0, false); w = __builtin_amdgcn_cvt_pk_fp8_f32(c, d, w, true); return (unsigned)w; }
__device__ __forceinline__ void unpack16(const u32x4 w, float* o) {
#pragma unroll
    for (int d = 0; d < 4; ++d) { const f32x2 lo = __builtin_amdgcn_cvt_pk_f32_fp8((int)w[d], false), hi = __builtin_amdgcn_cvt_pk_f32_fp8((int)w[d], true);
        o[4 * d] = lo.x; o[4 * d + 1] = lo.y; o[4 * d + 2] = hi.x; o[4 * d + 3] = hi.y; }
}
__device__ __forceinline__ void convert(const float* in, unsigned char* out8, size_t n, float scale, int gt, int ngt) {
    const size_t n16 = n / 16;
    for (size_t i = gt; i < n16; i += ngt) {
        const float4* p = (const float4*)(in + i * 16);
        const float4 a = p[0], b = p[1], c = p[2], d = p[3];
        u32x4 w; w.x = pack4_fp8(a.x * scale, a.y * scale, a.z * scale, a.w * scale); w.y = pack4_fp8(b.x * scale, b.y * scale, b.z * scale, b.w * scale);
        w.z = pack4_fp8(c.x * scale, c.y * scale, c.z * scale, c.w * scale); w.w = pack4_fp8(d.x * scale, d.y * scale, d.z * scale, d.w * scale);
        *(u32x4*)(out8 + i * 16) = w;
    }
}
template <int EMASK = 0x3fff, bool LOADONLY = false> __device__ __forceinline__ void gather(const bf16* HN, const int* IDX, const float* GATE, const unsigned char* PU8, const unsigned char* PV8, float* X, int gw, int ngw, int lane) {
    for (int t = gw; t < T; t += ngw) {
        float hn[16]; unpack8(*(const uint4*)(HN + (size_t)t * DM + 16 * lane), hn); unpack8(*(const uint4*)(HN + (size_t)t * DM + 16 * lane + 8), hn + 8);
        const int id0 = IDX[(size_t)t * 128 + lane], id1 = IDX[(size_t)t * 128 + 64 + lane];
        const float g0 = GATE[(size_t)t * 128 + lane], g1 = GATE[(size_t)t * 128 + 64 + lane];
        float y[16];
#pragma unroll
        for (int e = 0; e < 16; ++e) y[e] = 0.f;
        for (int kb = 0; kb < 128; kb += 4) {
            int eid[4]; float gt4[4]; u32x4 uw[4], vw[4];
#pragma unroll
            for (int q = 0; q < 4; ++q) { const int k = kb + q;
                eid[q] = __builtin_amdgcn_readlane(k < 64 ? id0 : id1, k & 63) & EMASK; gt4[q] = __builtin_bit_cast(float, __builtin_amdgcn_readlane(__builtin_bit_cast(int, k < 64 ? g0 : g1), k & 63)); }
#pragma unroll
            for (int q = 0; q < 4; ++q) { uw[q] = *(const u32x4*)(PU8 + (size_t)eid[q] * DM + 16 * lane); vw[q] = *(const u32x4*)(PV8 + (size_t)eid[q] * DM + 16 * lane); }
            if (LOADONLY) {
#pragma unroll
                for (int q = 0; q < 4; ++q) { y[0] += __uint_as_float((uw[q][0] ^ vw[q][1]) & 0x3f800000u); y[1] += __uint_as_float((uw[q][2] ^ vw[q][3]) & 0x3f800000u); y[2] += __uint_as_float((uw[q][1] ^ vw[q][0] ^ uw[q][3] ^ vw[q][2]) & 0x3f800000u); }
            } else
#pragma unroll
            for (int q = 0; q < 4; ++q) {
                float u[16]; unpack16(uw[q], u);
                float d0 = 0.f, d1 = 0.f;
#pragma unroll
                for (int e = 0; e < 16; e += 2) { d0 = fmaf(u[e], hn[e], d0); d1 = fmaf(u[e + 1], hn[e + 1], d1); }
                const float d = wave_sum(d0 + d1) * (1.f / USCALE);
                const float w = gt4[q] * gelu_f(d) * (1.f / VSCALE);
                float v[16]; unpack16(vw[q], v);
#pragma unroll
                for (int e = 0; e < 16; ++e) y[e] = fmaf(w, v[e], y[e]);
            }
        }
        float4* xo = (float4*)(X + (size_t)t * DM + 16 * lane);
#pragma unroll
        for (int q = 0; q < 4; ++q) { float4 p = xo[q]; p.x += y[4 * q]; p.y += y[4 * q + 1]; p.z += y[4 * q + 2]; p.w += y[4 * q + 3]; xo[q] = p; }
    }
}
}
namespace tk {
__device__ __forceinline__ float row_rstd(const float* ROWSS, size_t t) { const float4* p = (const float4*)(ROWSS + t * 16); const float4 a = p[0], b = p[1], c = p[2], d = p[3];
    const float s = (((a.x + a.y) + (a.z + a.w)) + ((b.x + b.y) + (b.z + b.w))) + (((c.x + c.y) + (c.z + c.w)) + ((d.x + d.y) + (d.z + d.w))); return rsqrtf(s * (1.f / DM) + EPS); }
typedef short bf16x8 __attribute__((ext_vector_type(8)));
typedef float f32x4 __attribute__((ext_vector_type(4)));
__device__ const unsigned char PAIR_TAB[64] = {
    0x00,0x01,0x02,0x03,0x04,0x05,0x06,0x07,0x08,0x09,0x0a,0x0b,0x0c,0x0d,0x0e,0x0f, 0x10,0x11,0x12,0x13,0x14,0x15,0x16,0x17, 0x20,0x21,0x22,0x23,0x24, 0x30,0x31,0x32,0x33,
    0x40,0x41,0x42, 0x50,0x51, 0x60,0x61, 0x70,0x71, 0x80,0x90,0xa0,0xb0,0xc0,0xd0,0xe0,0xf0, 0,0,0,0,0,0,0,0,0,0,0,0,0,0};
template <int CTRL> __device__ __forceinline__ float dppf(float v) { return __builtin_bit_cast(float, __builtin_amdgcn_update_dpp(0, __builtin_bit_cast(int, v), CTRL, 0xf, 0xf, true)); }
__device__ __forceinline__ float vmax(float a, float b) { float r; asm("v_max_f32_e32 %0, %1, %2" : "=v"(r) : "v"(a), "v"(b)); return r; }
__device__ __forceinline__ float vmin(float a, float b) { float r; asm("v_min_f32_e32 %0, %1, %2" : "=v"(r) : "v"(a), "v"(b)); return r; }
#define TK_ST(ctrl) "v_max_f32_dpp %0, %0, %0 " ctrl " row_mask:0xf bank_mask:0xf\n\tv_max_f32_dpp %1, %1, %1 " ctrl " row_mask:0xf bank_mask:0xf\n\tv_max_f32_dpp %2, %2, %2 " ctrl " row_mask:0xf bank_mask:0xf\n\tv_max_f32_dpp %3, %3, %3 " ctrl " row_mask:0xf bank_mask:0xf\n\t"
__device__ __forceinline__ void rmax16x4(float& a, float& b, float& c, float& d) {
    asm("s_nop 1\n\t" TK_ST("quad_perm:[1,0,3,2]") TK_ST("quad_perm:[2,3,0,1]") TK_ST("row_half_mirror") TK_ST("row_mirror") "s_nop 0" : "+v"(a), "+v"(b), "+v"(c), "+v"(d));
}
#undef TK_ST
__device__ __forceinline__ float rsum16(float v) { v += dppf<0xB1>(v); v += dppf<0x4E>(v); v += dppf<0x141>(v); v += dppf<0x140>(v); return v; }
#define TK_CX(a, b) do { const float hi_ = vmax(a, b), lo_ = vmin(a, b); a = hi_; b = lo_; } while (0)
__device__ __forceinline__ float packkey(float v, unsigned id, unsigned mask) { return __uint_as_float((__float_as_uint(v) & ~mask) | id); }
__device__ __forceinline__ void select16(float (&k)[4][8], float (&top)[4], int l15) {
    const float NEG = -__builtin_inff();
#pragma unroll
    for (int r = 0; r < 4; ++r) {
        TK_CX(k[r][0], k[r][1]); TK_CX(k[r][2], k[r][3]); TK_CX(k[r][4], k[r][5]); TK_CX(k[r][6], k[r][7]);
        TK_CX(k[r][0], k[r][2]); TK_CX(k[r][1], k[r][3]); TK_CX(k[r][4], k[r][6]); TK_CX(k[r][5], k[r][7]);
        TK_CX(k[r][1], k[r][2]); TK_CX(k[r][5], k[r][6]);
        TK_CX(k[r][0], k[r][4]); TK_CX(k[r][1], k[r][5]); TK_CX(k[r][2], k[r][6]); TK_CX(k[r][3], k[r][7]);
        TK_CX(k[r][2], k[r][4]); TK_CX(k[r][3], k[r][5]);
        TK_CX(k[r][1], k[r][2]); TK_CX(k[r][3], k[r][4]); TK_CX(k[r][5], k[r][6]);
        top[r] = NEG;
    }
#pragma unroll
    for (int i = 0; i < 16; ++i) {
        float wr[4] = {k[0][0], k[1][0], k[2][0], k[3][0]};
        rmax16x4(wr[0], wr[1], wr[2], wr[3]);
#pragma unroll
        for (int r = 0; r < 4; ++r) {
            const float w = wr[r];
            if (l15 == i) top[r] = w;
            const bool hit = (k[r][0] == w);
#pragma unroll
            for (int e = 0; e < 7; ++e) k[r][e] = hit ? k[r][e + 1] : k[r][e];
            k[r][7] = hit ? NEG : k[r][7];
        }
    }
}
template <bool FUSE, int EMASK = 0x3fff> __device__ __forceinline__ void topk_phase(const bf16* QP, const bf16* SUBKB, int* IDX, float* GATE, bf16* HN, const unsigned char* PU8, const unsigned char* PV8, float* X, float* Xout, const float* ROWSS, const float* gnext, LAS unsigned char* wl, int gw, int ngw, int lane) {
    const float NEG = -__builtin_inff();
    const int l15 = lane & 15, q4 = lane >> 4, gbase = 16 * q4;
    unsigned pcs[4];
#pragma unroll
    for (int j = 0; j < 4; ++j) pcs[j] = PAIR_TAB[l15 + 16 * j];
    for (int item = gw; item < T * 8 / 16; item += ngw) {
        const size_t R0 = (size_t)item * 16;
        const float rstd_g = row_rstd(ROWSS, (size_t)item * 2 + (q4 >> 1));
        const bf16* qrow = QP + (R0 + l15) * 256 + 8 * q4;
        float topA[4], topB[4];
#pragma unroll
        for (int p = 0; p < 2; ++p) {
            f32x4 acc[8];
#pragma unroll
            for (int nb = 0; nb < 8; ++nb) acc[nb] = f32x4{0.f, 0.f, 0.f, 0.f};
#pragma unroll 1
            for (int ks = 0; ks < 4; ++ks) {
                const bf16x8 afr = *(const bf16x8*)(qrow + p * 128 + 32 * ks);
#pragma unroll
                for (int nb = 0; nb < 8; ++nb) {
                    const bf16x8 bfr = *(const bf16x8*)(SUBKB + ((size_t)(p * 128 + 16 * nb + l15) * 128 + 32 * ks + 8 * q4));
                    acc[nb] = __builtin_amdgcn_mfma_f32_16x16x32_bf16(afr, bfr, acc[nb], 0, 0, 0);
                }
            }
            float k[4][8];
#pragma unroll
            for (int r = 0; r < 4; ++r)
#pragma unroll
                for (int nb = 0; nb < 8; ++nb) k[r][nb] = packkey(acc[nb][r], (unsigned)(16 * nb + l15), 127u);
            if (p == 0) select16(k, topA, l15); else select16(k, topB, l15);
        }
        float c[4][4];
#pragma unroll
        for (int r = 0; r < 4; ++r) {
#pragma unroll
            for (int j = 0; j < 4; ++j) {
                const float s0 = __shfl(topA[r], gbase + (int)(pcs[j] >> 4)), s1 = __shfl(topB[r], gbase + (int)(pcs[j] & 15));
                c[r][j] = (l15 + 16 * j < 50) ? packkey(s0 + s1, (unsigned)(l15 + 16 * j), 63u) : NEG;
            }
            TK_CX(c[r][0], c[r][1]); TK_CX(c[r][2], c[r][3]); TK_CX(c[r][0], c[r][2]); TK_CX(c[r][1], c[r][3]); TK_CX(c[r][1], c[r][2]);
        }
        float win[4], w0[4];
#pragma unroll
        for (int r = 0; r < 4; ++r) { win[r] = NEG; w0[r] = 0.f; }
#pragma unroll
        for (int i = 0; i < 16; ++i) {
            float wr[4] = {c[0][0], c[1][0], c[2][0], c[3][0]};
            rmax16x4(wr[0], wr[1], wr[2], wr[3]);
#pragma unroll
            for (int r = 0; r < 4; ++r) {
                const float w = wr[r];
                if (i == 0) w0[r] = w;
                if (l15 == i) win[r] = w;
                { const bool hit = (c[r][0] == w); c[r][0] = hit ? c[r][1] : c[r][0]; c[r][1] = hit ? c[r][2] : c[r][1]; c[r][2] = hit ? c[r][3] : c[r][2]; c[r][3] = hit ? NEG : c[r][3]; }
            }
        }
        int idr[4]; float gtr[4];
#pragma unroll
        for (int r = 0; r < 4; ++r) {
            const unsigned pcw = PAIR_TAB[__float_as_uint(win[r]) & 63u];
            const int i0 = (int)(__float_as_uint(__shfl(topA[r], gbase + (int)(pcw >> 4))) & 127u), i1 = (int)(__float_as_uint(__shfl(topB[r], gbase + (int)(pcw & 15))) & 127u);
            const float e = __expf((win[r] - w0[r]) * rstd_g); const float sum = rsum16(e);
            idr[r] = (i0 * 128 + i1) & EMASK; gtr[r] = e / sum;
            if (!FUSE) { const size_t row = R0 + 4 * q4 + r; IDX[row * 16 + l15] = idr[r]; GATE[row * 16 + l15] = gtr[r]; }
        }
        if (FUSE) {
            typedef float f32x2 __attribute__((ext_vector_type(2)));
            LAS unsigned char* img = wl;
#pragma unroll 1
            for (int tau = 0; tau < 2; ++tau) {
                const size_t t = (size_t)item * 2 + tau;
                const float rstd_t = row_rstd(ROWSS, t);
                {
                    float hn[16]; unpack8(*(const uint4*)(HN + t * DM + 16 * lane), hn); unpack8(*(const uint4*)(HN + t * DM + 16 * lane + 8), hn + 8);
#pragma unroll
                    for (int bq = 0; bq < 2; ++bq) {
                        float h1[8], h2[8]; unsigned w1[2], w2[2];
#pragma unroll
                        for (int d = 0; d < 2; ++d) { w1[d] = pgf::pack4_fp8(hn[8 * bq + 4 * d] * 8.f, hn[8 * bq + 4 * d + 1] * 8.f, hn[8 * bq + 4 * d + 2] * 8.f, hn[8 * bq + 4 * d + 3] * 8.f);
                            const f32x2 lo = __builtin_amdgcn_cvt_pk_f32_fp8((int)w1[d], false), hi = __builtin_amdgcn_cvt_pk_f32_fp8((int)w1[d], true);
                            h1[4 * d] = lo.x; h1[4 * d + 1] = lo.y; h1[4 * d + 2] = hi.x; h1[4 * d + 3] = hi.y; }
#pragma unroll
                        for (int e = 0; e < 8; ++e) h2[e] = (hn[8 * bq + e] * 8.f - h1[e]) * 16.f;
#pragma unroll
                        for (int d = 0; d < 2; ++d) w2[d] = pgf::pack4_fp8(h2[4 * d], h2[4 * d + 1], h2[4 * d + 2], h2[4 * d + 3]);
                        pgf::u32x4 ww; ww.x = w1[0]; ww.y = w1[1]; ww.z = w2[0]; ww.w = w2[1];
                        *(LAS pgf::u32x4*)(img + (8 * (lane >> 2) + 4 * bq + (lane & 3)) * 16) = ww;
                    }
                }
                f32x2 y2[8];
#pragma unroll
                for (int e = 0; e < 8; ++e) y2[e] = f32x2{0.f, 0.f};
#pragma unroll
                for (int r = 0; r < 4; ++r) {
#pragma unroll 1
                    for (int hh = 0; hh < 2; ++hh) {
                        const int srcb = 32 * tau + 16 * hh;
                        const int my_eid = __shfl(idr[r], srcb + l15);
                        const unsigned char* pa = PU8 + (unsigned)(my_eid * DM + 16 * q4);
                        pgf::u32x4 aw[16], vw[16];
#pragma unroll
                        for (int j = 0; j < 16; ++j) aw[j] = *(const pgf::u32x4*)(pa + 64 * j);
#pragma unroll
                        for (int e = 0; e < 16; ++e) { const int eid = __builtin_amdgcn_readlane(idr[r], srcb + e); vw[e] = *(const pgf::u32x4*)(PV8 + (unsigned)(eid * DM + 16 * lane)); }
                        f32x4 acc = f32x4{0.f, 0.f, 0.f, 0.f};
#pragma unroll
                        for (int j = 0; j < 16; ++j) {
                            const long b0 = *(const LAS long*)(img + ((((2 * j) * 4 + q4) * 2 + (l15 & 1)) << 3)), b1 = *(const LAS long*)(img + ((((2 * j + 1) * 4 + q4) * 2 + (l15 & 1)) << 3));
                            const long a0 = (long)(((unsigned long)aw[j].y << 32) | aw[j].x), a1 = (long)(((unsigned long)aw[j].w << 32) | aw[j].z);
                            acc = __builtin_amdgcn_mfma_f32_16x16x32_fp8_fp8(a0, b0, acc, 0, 0, 0);
                            acc = __builtin_amdgcn_mfma_f32_16x16x32_fp8_fp8(a1, b1, acc, 0, 0, 0);
                        }
                        const float cs = (l15 & 1) ? (1.f / (pgf::USCALE * 128.f)) : (1.f / (pgf::USCALE * 8.f));
                        float dsel = 0.f;
#pragma unroll
                        for (int g4 = 0; g4 < 4; ++g4) { float tt = acc[g4] * cs; tt += dppf<0xB1>(tt); const float got = __shfl(tt, 16 * (l15 >> 2)); dsel = ((l15 & 3) == g4) ? got : dsel; }
                        const float wv = gtr[r] * gelu_f(dsel * rstd_t) * (1.f / pgf::VSCALE);
#pragma unroll
                        for (int e = 0; e < 16; ++e) {
                            const float we = __builtin_bit_cast(float, __builtin_amdgcn_readlane(__builtin_bit_cast(int, wv), srcb + e)); const f32x2 w2v = f32x2{we, we};
#pragma unroll
                            for (int d = 0; d < 4; ++d) { const f32x2 lo = __builtin_amdgcn_cvt_pk_f32_fp8((int)vw[e][d], false), hi = __builtin_amdgcn_cvt_pk_f32_fp8((int)vw[e][d], true);
                                y2[2 * d] = __builtin_elementwise_fma(w2v, lo, y2[2 * d]); y2[2 * d + 1] = __builtin_elementwise_fma(w2v, hi, y2[2 * d + 1]); }
                        }
                    }
                }
                float y[16];
#pragma unroll
                for (int e = 0; e < 8; ++e) { y[2 * e] = y2[e].x; y[2 * e + 1] = y2[e].y; }
                const float4* xi = (const float4*)(X + t * DM + 16 * lane); float4* xo = (float4*)(Xout + t * DM + 16 * lane);
                float ssn = 0.f;
#pragma unroll
                for (int q = 0; q < 4; ++q) { float4 pp = xi[q]; pp.x += y[4 * q]; pp.y += y[4 * q + 1]; pp.z += y[4 * q + 2]; pp.w += y[4 * q + 3]; xo[q] = pp;
                    y[4 * q] = pp.x; y[4 * q + 1] = pp.y; y[4 * q + 2] = pp.z; y[4 * q + 3] = pp.w; ssn += (pp.x * pp.x + pp.y * pp.y) + (pp.z * pp.z + pp.w * pp.w); }
                if (gnext) {
                    const float rn = rsqrtf(wave_sum(ssn) * (1.f / DM) + EPS); const float4* gp = (const float4*)(gnext + 16 * lane);
                    uint4 o0, o1; float4 ga = gp[0], gb = gp[1], gc = gp[2], gd4 = gp[3];
                    o0.x = pk2(y[0] * rn * ga.x, y[1] * rn * ga.y); o0.y = pk2(y[2] * rn * ga.z, y[3] * rn * ga.w); o0.z = pk2(y[4] * rn * gb.x, y[5] * rn * gb.y); o0.w = pk2(y[6] * rn * gb.z, y[7] * rn * gb.w);
                    o1.x = pk2(y[8] * rn * gc.x, y[9] * rn * gc.y); o1.y = pk2(y[10] * rn * gc.z, y[11] * rn * gc.w); o1.z = pk2(y[12] * rn * gd4.x, y[13] * rn * gd4.y); o1.w = pk2(y[14] * rn * gd4.z, y[15] * rn * gd4.w);
                    *(uint4*)(HN + t * DM + 16 * lane) = o0; *(uint4*)(HN + t * DM + 16 * lane + 8) = o1;
                }
            }
        }
    }
}
#undef TK_CX
}
constexpr int NWAVES = 8, NTHR = 512;
constexpr int RING_BYTES = 131072, MISC_OFF = RING_BYTES + 320, LDS_BYTES = 147456;
struct Args { const void* in[34]; float* out; unsigned char* ws; int ph_lo, ph_hi; };
struct Ctx { LAS unsigned char* lds; int tid, lane, wave, G, bid, gw, ngw, gt, ngt; };
#define INF(i) ((const float*)a.in[i])
#define WSP(T_, off) ((T_*)(a.ws + (off)))

__device__ __forceinline__ void ph_rowprep(const Ctx& c, const float* x, const float* gain, bf16* XB);
__device__ __forceinline__ void prep_tile(const float* W, int K, int N, bf16* WT, int Nout, int mapmode, int item, LAS float* tile, int t256) {
    const int nbn = Nout / 32, kb = item / nbn, nb = item % nbn, n0 = nb * 32, k0 = kb * 32, tx = t256 & 31, ty = t256 >> 5;
    for (int i = ty; i < 32; i += 8) {
        const int n = n0 + tx; int src = n;
        if (mapmode == 1) { if (n < 448) src = n; else if (n < 512) src = -1; else src = n - 64; }
        tile[i * 33 + tx] = (src >= 0 && src < N) ? W[(size_t)(k0 + i) * N + src] : 0.f;
    }
    __syncthreads();
    for (int i = ty; i < 32; i += 8) WT[(size_t)(n0 + i) * K + k0 + tx] = f2bf(tile[tx * 33 + i]);
    __syncthreads();
}
template <class ArgsRef> __device__ __forceinline__ void ph_prep(const ArgsRef& a, const Ctx& c) {
    const int sub = c.tid >> 8, t256 = c.tid & 255; LAS float* tile = (LAS float*)c.lds + sub * (32 * 33);
    constexpr int NT0 = 1280, NT1 = 192, NT2 = 128, NT3 = 64, NT4 = 1024, NT5 = 2048, NTL = NT0 + NT1 + NT2 + NT3 + NT4 + NT5, NTOT = NL * NTL;
    const int nsb = c.G * 2;
    for (int it0 = c.bid * 2; it0 < NTOT; it0 += nsb) {
        int it = it0 + sub; if (it >= NTOT) it = NTOT - 1;
        const int l = it / NTL; int r = it % NTL;
        if (r < NT0) prep_tile(INF(3) + (size_t)l * DM * 1216, DM, 1216, WSP(bf16, WS_WINT) + (size_t)l * ZW * DM, ZW, 1, r, tile, t256);
        else if ((r -= NT0) < NT1) prep_tile(INF(5) + (size_t)l * 256 * 768, 256, 768, WSP(bf16, WS_WUQT) + (size_t)l * 768 * 256, 768, 0, r, tile, t256);
        else if ((r -= NT1) < NT2) prep_tile(INF(7) + (size_t)l * 128 * 1024, 128, 1024, WSP(bf16, WS_WUKVT) + (size_t)l * 1024 * 128, 1024, 0, r, tile, t256);
        else if ((r -= NT2) < NT3) prep_tile(INF(18) + (size_t)l * 65536, 256, 256, WSP(bf16, WS_GLUT) + (size_t)l * 65536, 256, 0, r, tile, t256);
        else if ((r -= NT3) < NT4) prep_tile(INF(28) + (size_t)l * DM * DM, DM, DM, WSP(bf16, WS_WOUTT) + (size_t)l * DM * DM, DM, 0, r, tile, t256);
        else { r -= NT4; prep_tile(INF(30) + (size_t)l * DM * 2048, DM, 2048, WSP(bf16, WS_WQT) + (size_t)l * 2048 * DM, 2048, 0, r, tile, t256); }
    }
    for (int i = c.gt; i < NL * 32768; i += c.ngt) WSP(bf16, WS_SUBKT)[i] = f2bf(INF(31)[i]);
    pgf::convert((const float*)a.in[32], WSP(unsigned char, WS_PU), (size_t)NL * 16384 * DM, pgf::USCALE, c.gt, c.ngt);
    pgf::convert((const float*)a.in[33], WSP(unsigned char, WS_PV), (size_t)NL * 16384 * DM, pgf::VSCALE, c.gt, c.ngt);
    for (int i = c.gt; i < T * 32; i += c.ngt) { const int t = i >> 5, j = i & 31;
        const float freq = exp2f(-(float)j * 0.41524101186092033f);
        const float ang = (float)((const int*)a.in[1])[t] * freq; float s, cs; sincos_acc(ang, s, cs);
        WSP(float, WS_COS)[i] = cs; WSP(float, WS_SIN)[i] = s; }
    for (int l = 0; l < NL; ++l)
        s5f::build_tables(INF(10) + l * 1024, INF(11) + l * 1024, INF(12) + l * 16, INF(13) + l * 16384, INF(14) + l * 16384, INF(15) + l * 16384, INF(16) + l * 16384,
                          WSP(bf16, WS_S5A) + (size_t)l * 32768, WSP(bf16, WS_S5C) + (size_t)l * 32768, WSP(float2, WS_S5L) + l * 1024, c.gt, c.ngt);
    ph_rowprep(c, INF(0), INF(2), WSP(bf16, WS_XB));
}

__device__ __forceinline__ void ph_rowprep(const Ctx& c, const float* x, const float* gain, bf16* XB) {
    for (int row = c.gw; row < T; row += c.ngw) {
        const float4* xr = (const float4*)(x + (size_t)row * DM) + c.lane;
        float4 v[4]; float ss = 0.f;
#pragma unroll
        for (int j = 0; j < 4; ++j) { v[j] = xr[64 * j]; ss += v[j].x * v[j].x + v[j].y * v[j].y + v[j].z * v[j].z + v[j].w * v[j].w; }
        const float rstd = rsqrtf(wave_sum(ss) * (1.f / DM) + EPS);
        uint2* o = (uint2*)(XB + (size_t)row * DM) + c.lane;
#pragma unroll
        for (int j = 0; j < 4; ++j) { const float4 g = ((const float4*)gain)[c.lane + 64 * j];
            o[64 * j] = make_uint2(pk2(v[j].x * rstd * g.x, v[j].y * rstd * g.y), pk2(v[j].z * rstd * g.z, v[j].w * rstd * g.w)); }
    }
}

enum { EPI_BF16 = 0, EPI_F32 = 1, EPI_GLU = 2, EPI_RESID = 3 };
template <int EPI> __device__ __forceinline__ void gemm_simple(const Ctx& c, const bf16* A, int lda, const bf16* Bt, int M, int N, int K, void* C, int ldc, const float* aux0, const bf16* aux1) {
    LAS float* As = (LAS float*)c.lds; LAS float* Bs = As + 16 * 132;
    const int tid = c.tid, tx = tid & 15, ty = tid >> 4, nN = N / 64, ntile = (M / 128) * nN;
    for (int tile = c.bid; tile < ntile; tile += c.G) {
        const int m0 = (tile / nN) * 128, n0 = (tile % nN) * 64;
        float acc[4][4];
#pragma unroll
        for (int i = 0; i < 4; ++i)
#pragma unroll
            for (int j = 0; j < 4; ++j) acc[i][j] = 0.f;
        const int lr = tid >> 2, lk = (tid & 3) * 4;
        for (int k0 = 0; k0 < K; k0 += 16) {
            { const uint2 w = *(const uint2*)(A + (size_t)(m0 + lr) * lda + k0 + lk);
              As[lk * 132 + lr] = __uint_as_float(w.x << 16); As[(lk + 1) * 132 + lr] = __uint_as_float(w.x & 0xffff0000u); As[(lk + 2) * 132 + lr] = __uint_as_float(w.y << 16); As[(lk + 3) * 132 + lr] = __uint_as_float(w.y & 0xffff0000u); }
            if (tid < 256) { const uint2 w = *(const uint2*)(Bt + (size_t)(n0 + lr) * K + k0 + lk);
              Bs[lk * 68 + lr] = __uint_as_float(w.x << 16); Bs[(lk + 1) * 68 + lr] = __uint_as_float(w.x & 0xffff0000u); Bs[(lk + 2) * 68 + lr] = __uint_as_float(w.y << 16); Bs[(lk + 3) * 68 + lr] = __uint_as_float(w.y & 0xffff0000u); }
            __syncthreads();
#pragma unroll
            for (int kk = 0; kk < 16; ++kk) {
                float av[4], bv[4];
#pragma unroll
                for (int i = 0; i < 4; ++i) { av[i] = As[kk * 132 + ty * 4 + i]; bv[i] = Bs[kk * 68 + tx * 4 + i]; }
#pragma unroll
                for (int i = 0; i < 4; ++i)
#pragma unroll
                    for (int j = 0; j < 4; ++j) acc[i][j] += av[i] * bv[j];
            }
            __syncthreads();
        }
#pragma unroll
        for (int i = 0; i < 4; ++i)
#pragma unroll
            for (int j = 0; j < 4; ++j) {
                const int row = m0 + ty * 4 + i, col = n0 + tx * 4 + j; const size_t ix = (size_t)row * ldc + col; const float v = acc[i][j];
                if (EPI == EPI_BF16) ((bf16*)C)[ix] = f2bf(v);
                else if (EPI == EPI_F32) ((float*)C)[ix] = v;
                else if (EPI == EPI_GLU) { const float yg = bf2f(aux1[ix]); ((bf16*)C)[ix] = f2bf(yg * sigmoid_f(v + aux0[col])); }
                else { ((float*)C)[ix] = aux0[ix] + v; }
            }
    }
}

__device__ __forceinline__ void ph_zstats(const Ctx& c, const bf16* Z, const float* qan, const float* kvan, bf16* CQN, bf16* CKVN) {
    const int lane = c.lane; const float4 gq = ((const float4*)qan)[lane]; const float2 gk = ((const float2*)kvan)[lane];
    for (int row0 = 4 * c.gw; row0 < T; row0 += 4 * c.ngw) {
        uint2 wq[4]; u32 wk[4];
#pragma unroll
        for (int i = 0; i < 4; ++i) { const bf16* zr = Z + (size_t)(row0 + i) * ZW; wq[i] = *(const uint2*)(zr + ZC_CQ + 4 * lane); wk[i] = *(const u32*)(zr + ZC_CKV + 2 * lane); }
#pragma unroll
        for (int i = 0; i < 4; ++i) { const int row = row0 + i;
            { const float a0 = __uint_as_float(wq[i].x << 16), a1 = __uint_as_float(wq[i].x & 0xffff0000u), a2 = __uint_as_float(wq[i].y << 16), a3 = __uint_as_float(wq[i].y & 0xffff0000u);
              const float rstd = rsqrtf(wave_sum(a0 * a0 + a1 * a1 + a2 * a2 + a3 * a3) * (1.f / 256) + EPS);
              *(uint2*)(CQN + (size_t)row * 256 + 4 * lane) = make_uint2(pk2(a0 * rstd * gq.x, a1 * rstd * gq.y), pk2(a2 * rstd * gq.z, a3 * rstd * gq.w)); }
            { const float a0 = __uint_as_float(wk[i] << 16), a1 = __uint_as_float(wk[i] & 0xffff0000u);
              const float rstd = rsqrtf(wave_sum(a0 * a0 + a1 * a1) * (1.f / 128) + EPS);
              *(u32*)(CKVN + (size_t)row * 128 + 2 * lane) = pk2(a0 * rstd * gk.x, a1 * rstd * gk.y); } }
    }
}

__device__ __forceinline__ float dpp_rsum16(float v) {
    v += __builtin_bit_cast(float, __builtin_amdgcn_update_dpp(0, __builtin_bit_cast(int, v), 0xB1, 0xf, 0xf, true));
    v += __builtin_bit_cast(float, __builtin_amdgcn_update_dpp(0, __builtin_bit_cast(int, v), 0x4E, 0xf, 0xf, true));
    v += __builtin_bit_cast(float, __builtin_amdgcn_update_dpp(0, __builtin_bit_cast(int, v), 0x141, 0xf, 0xf, true));
    v += __builtin_bit_cast(float, __builtin_amdgcn_update_dpp(0, __builtin_bit_cast(int, v), 0x140, 0xf, 0xf, true));
    return v; }
__device__ __forceinline__ void qkfin_token(int t, int lane, const bf16* QRAW, const bf16* KVRAW, const bf16* Z, const float* qn, const float* kn, const float* COS, const float* SIN, bf16* QB, bf16* KB, bf16* VB) {
    const int h = lane >> 4, j = lane & 15, b = t / SEQ, s = t % SEQ; const size_t bh = (size_t)b * NH + h;
    const bf16* qp = QRAW + (size_t)t * 768 + h * DQK; const bf16* kp = KVRAW + (size_t)t * 1024 + h * 256;
    const uint4 qn8 = *(const uint4*)(qp + 8 * j); const u32 qx1 = *(const u32*)(qp + 128 + 2 * j), qx2 = *(const u32*)(qp + 160 + 2 * j);
    const uint4 kn8 = *(const uint4*)(kp + 8 * j); const uint4 v8 = *(const uint4*)(kp + 128 + 8 * j);
    const u32 kx1 = *(const u32*)(Z + (size_t)t * ZW + ZC_KR + 2 * j), kx2 = *(const u32*)(Z + (size_t)t * ZW + ZC_KR + 32 + 2 * j);
    const float2 cs = *(const float2*)(COS + t * 32 + 2 * j), sn = *(const float2*)(SIN + t * 32 + 2 * j);
    const float4 gq0 = *(const float4*)(qn + 8 * j), gq1 = *(const float4*)(qn + 8 * j + 4), gk0 = *(const float4*)(kn + 8 * j), gk1 = *(const float4*)(kn + 8 * j + 4);
    const float2 gqa = *(const float2*)(qn + 128 + 2 * j), gqb = *(const float2*)(qn + 160 + 2 * j), gka = *(const float2*)(kn + 128 + 2 * j), gkb = *(const float2*)(kn + 160 + 2 * j);
    {
        float v[8]; unpack8(qn8, v);
        float a0 = __uint_as_float(qx1 << 16), a1 = __uint_as_float(qx1 & 0xffff0000u), b0 = __uint_as_float(qx2 << 16), b1 = __uint_as_float(qx2 & 0xffff0000u);
        float ss = a0 * a0 + a1 * a1 + b0 * b0 + b1 * b1;
#pragma unroll
        for (int e = 0; e < 8; ++e) ss += v[e] * v[e];
        const float rs = rsqrtf(dpp_rsum16(ss) * (1.f / DQK) + EPS) * QSCALE;
        a0 *= rs * gqa.x; a1 *= rs * gqa.y; b0 *= rs * gqb.x; b1 *= rs * gqb.y;
        bf16* o = QB + (bh * SEQ + s) * DQK;
        *(uint4*)(o + 8 * j) = make_uint4(pk2(v[0] * rs * gq0.x, v[1] * rs * gq0.y), pk2(v[2] * rs * gq0.z, v[3] * rs * gq0.w), pk2(v[4] * rs * gq1.x, v[5] * rs * gq1.y), pk2(v[6] * rs * gq1.z, v[7] * rs * gq1.w));
        *(u32*)(o + 128 + 2 * j) = pk2(a0 * cs.x - b0 * sn.x, a1 * cs.y - b1 * sn.y);
        *(u32*)(o + 160 + 2 * j) = pk2(a0 * sn.x + b0 * cs.x, a1 * sn.y + b1 * cs.y);
    }
    {
        float v[8]; unpack8(kn8, v);
        float a0 = __uint_as_float(kx1 << 16), a1 = __uint_as_float(kx1 & 0xffff0000u), b0 = __uint_as_float(kx2 << 16), b1 = __uint_as_float(kx2 & 0xffff0000u);
        float ss = a0 * a0 + a1 * a1 + b0 * b0 + b1 * b1;
#pragma unroll
        for (int e = 0; e < 8; ++e) ss += v[e] * v[e];
        const float rs = rsqrtf(dpp_rsum16(ss) * (1.f / DQK) + EPS);
        a0 *= rs * gka.x; a1 *= rs * gka.y; b0 *= rs * gkb.x; b1 *= rs * gkb.y;
        bf16* o = KB + (bh * SEQ + s) * DQK;
        *(uint4*)(o + 8 * j) = make_uint4(pk2(v[0] * rs * gk0.x, v[1] * rs * gk0.y), pk2(v[2] * rs * gk0.z, v[3] * rs * gk0.w), pk2(v[4] * rs * gk1.x, v[5] * rs * gk1.y), pk2(v[6] * rs * gk1.z, v[7] * rs * gk1.w));
        *(u32*)(o + 128 + 2 * j) = pk2(a0 * cs.x - b0 * sn.x, a1 * cs.y - b1 * sn.y);
        *(u32*)(o + 160 + 2 * j) = pk2(a0 * sn.x + b0 * cs.x, a1 * sn.y + b1 * cs.y);
        *(uint4*)(VB + (bh * SEQ + s) * DV + 8 * j) = v8;
    }
}
__device__ __forceinline__ void ph_qkfin(const Ctx& c, const bf16* QRAW, const bf16* KVRAW, const bf16* Z, const float* qn, const float* kn, const float* COS, const float* SIN, bf16* QB, bf16* KB, bf16* VB) {
    for (int t = 2 * c.gw; t < T; t += 2 * c.ngw) {
        qkfin_token(t, c.lane, QRAW, KVRAW, Z, qn, kn, COS, SIN, QB, KB, VB);
        qkfin_token(t + 1, c.lane, QRAW, KVRAW, Z, qn, kn, COS, SIN, QB, KB, VB);
    }
}

__device__ __forceinline__ void ph_attn_simple(const Ctx& c, const bf16* QB, const bf16* KB, const bf16* VB, bf16* AO) {
    LAS float* qs = (LAS float*)c.lds + c.wave * DQK; const int lane = c.lane;
    for (int gq = c.gw; gq < NB * NH * SEQ; gq += c.ngw) {
        const int bh = gq / SEQ, q = gq % SEQ;
        const bf16* qp = QB + ((size_t)bh * SEQ + q) * DQK;
        qs[lane] = bf2f(qp[lane]); qs[lane + 64] = bf2f(qp[lane + 64]); qs[lane + 128] = bf2f(qp[lane + 128]);
        asm volatile("s_waitcnt lgkmcnt(0)" ::: "memory");
        float m = -1e30f, l = 0.f, o0 = 0.f, o1 = 0.f;
        const int ntile = q / 64 + 1;
        for (int kt = 0; kt < ntile; ++kt) {
            const int key = kt * 64 + lane;
            const uint4* kp = (const uint4*)(KB + ((size_t)bh * SEQ + key) * DQK);
            float sc = 0.f;
#pragma unroll 4
            for (int cc = 0; cc < 24; ++cc) { float kv[8]; unpack8(kp[cc], kv);
#pragma unroll
                for (int e = 0; e < 8; ++e) sc += kv[e] * qs[cc * 8 + e]; }
            if (key > q) sc = -INFINITY;
            const float mn = fmaxf(m, wave_max(sc));
            const float p = exp2f(sc - mn), al = exp2f(m - mn);
            l = l * al + wave_sum(p); o0 *= al; o1 *= al; m = mn;
            const u32* vp = (const u32*)(VB + ((size_t)bh * SEQ + kt * 64) * DV) + lane;
#pragma unroll 8
            for (int k = 0; k < 64; ++k) { const float pk = __shfl(p, k); const u32 w = vp[(size_t)k * (DV / 2)];
                o0 += pk * __uint_as_float(w << 16); o1 += pk * __uint_as_float(w & 0xffff0000u); }
        }
        const int b = bh / NH, h = bh % NH; const float il = 1.f / l;
        *(u32*)(AO + ((size_t)b * SEQ + q) * 512 + h * DV + 2 * lane) = pk2(o0 * il, o1 * il);
    }
}

__device__ __forceinline__ void ph_s5_simple(const Ctx& c, const bf16* Z, const float* a_re, const float* a_im, const float* log_dt, const float* b_re, const float* b_im,
                                             const float* c_re, const float* c_im, const float* dsk, bf16* YG) {
    for (int item = c.gw; item < NB * 16; item += c.ngw) {
        const int b = item >> 4, g = item & 15, p = c.lane;
        const float are = a_re[g * 64 + p], aim = a_im[g * 64 + p], dt = expf(log_dt[g]);
        const float mag = expf(are * dt); float sn, cs; sincos_acc(aim * dt, sn, cs);
        const float lre = mag * cs, lim = mag * sn;
        const float xr = lre - 1.f, xi = lim, den = are * are + aim * aim;
        const float cr = (xr * are + xi * aim) / den, ci = (xi * are - xr * aim) / den;
        float Bre[16], Bim[16], Cre[16], Cim[16];
#pragma unroll
        for (int k = 0; k < 16; ++k) { const float br = b_re[(g * 64 + p) * 16 + k], bi = b_im[(g * 64 + p) * 16 + k];
            Bre[k] = cr * br - ci * bi; Bim[k] = cr * bi + ci * br; Cre[k] = c_re[(g * 16 + k) * 64 + p]; Cim[k] = c_im[(g * 16 + k) * 64 + p]; }
        const float D = (p < 16) ? dsk[g * 16 + p] : 0.f;
        float hre = 0.f, him = 0.f;
        for (int s = 0; s < SEQ; ++s) {
            const bf16* up = Z + (size_t)(b * SEQ + s) * ZW + ZC_U + g * 16;
            float u[16]; unpack8(*(const uint4*)up, u); unpack8(*(const uint4*)(up + 8), u + 8);
            float bre = 0.f, bim = 0.f;
#pragma unroll
            for (int k = 0; k < 16; ++k) { bre += Bre[k] * u[k]; bim += Bim[k] * u[k]; }
            const float nre = lre * hre - lim * him + bre, nim = lre * him + lim * hre + bim; hre = nre; him = nim;
            float my = 0.f;
#pragma unroll
            for (int k = 0; k < 16; ++k) { const float v = wave_sum(Cre[k] * hre - Cim[k] * him); if (p == k) my = v + D * u[k]; }
            if (p < 16) YG[(size_t)(b * SEQ + s) * 256 + g * 16 + p] = f2bf(gelu_f(my));
        }
    }
}

__device__ __forceinline__ void ph_lru_xc(const Ctx& c, const bf16* Z, const float* cw, const float* cb, float* XC) {
    for (int i = c.gt; i < T * 256; i += c.ngt) { const int t = i >> 8, ch = i & 255, s = t % SEQ;
        float acc = cb[ch];
#pragma unroll
        for (int j = 0; j < 4; ++j) { const int ss = s - 3 + j; if (ss >= 0) acc += cw[j * 256 + ch] * bf2f(Z[(size_t)(t - 3 + j) * ZW + ZC_X + ch]); }
        XC[i] = acc; }
}
__device__ __forceinline__ void ph_lru_gates(const Ctx& c, const float* XC, const float* wa, const float* ba, const float* wx, const float* bx, const float* lam, float* AA, float* BT) {
    for (int i = c.gt; i < T * 256; i += c.ngt) { const int t = i >> 8, ch = i & 255, h = ch >> 6, j = ch & 63;
        const float* xr = XC + (size_t)t * 256 + h * 64;
        float ra = ba[ch], rx = bx[ch];
        for (int k = 0; k < 64; ++k) { const float xv = xr[k]; ra += xv * wa[(h * 64 + k) * 64 + j]; rx += xv * wx[(h * 64 + k) * 64 + j]; }
        const float r = sigmoid_f(ra), ig = sigmoid_f(rx);
        const float lsg = -log1pf(expf(-lam[ch]));
        const float la = 8.f * r * lsg, av = expf(la);
        AA[i] = av; BT[i] = sqrtf(-expm1f(2.f * la)) * (ig * XC[i]); }
}
__device__ __forceinline__ void ph_lru_scan(const Ctx& c, const float* AA, const float* BT, const bf16* Z, bf16* ROUT) {
    for (int item = c.gw; item < NB * 4; item += c.ngw) {
        const int i = item * 64 + c.lane, b = i >> 8, ch = i & 255;
        float h = 0.f;
#pragma unroll 8
        for (int s = 0; s < SEQ; ++s) { const size_t t = (size_t)b * SEQ + s;
            h = AA[t * 256 + ch] * h + BT[t * 256 + ch];
            ROUT[t * 256 + ch] = f2bf(h * gelu_f(bf2f(Z[t * ZW + ZC_G + ch]))); }
    }
}

__device__ __forceinline__ void ph_mixnorm(const Ctx& c, const bf16* AO, const bf16* SOUT, const bf16* ROUT, const float* g, bf16* Y) {
    const int lane = c.lane;
    const float4 ga0 = *(const float4*)(g + 8 * lane), ga1 = *(const float4*)(g + 8 * lane + 4), gs = *(const float4*)(g + 512 + 4 * lane), gr = *(const float4*)(g + 768 + 4 * lane);
    for (int row0 = 4 * c.gw; row0 < T; row0 += 4 * c.ngw) {
        uint4 wa[4]; uint2 ws_[4], wr[4];
#pragma unroll
        for (int i = 0; i < 4; ++i) { const size_t row = row0 + i; wa[i] = *(const uint4*)(AO + row * 512 + 8 * lane); ws_[i] = *(const uint2*)(SOUT + row * 256 + 4 * lane); wr[i] = *(const uint2*)(ROUT + row * 256 + 4 * lane); }
#pragma unroll
        for (int i = 0; i < 4; ++i) { const size_t row = row0 + i;
            {   float v[8]; unpack8(wa[i], v); float ss = 0.f;
#pragma unroll
                for (int e = 0; e < 8; ++e) ss += v[e] * v[e];
                const float rstd = rsqrtf(wave_sum(ss) * (1.f / 512) + EPS);
                *(uint4*)(Y + row * DM + 8 * lane) = make_uint4(pk2(v[0] * rstd * ga0.x, v[1] * rstd * ga0.y), pk2(v[2] * rstd * ga0.z, v[3] * rstd * ga0.w), pk2(v[4] * rstd * ga1.x, v[5] * rstd * ga1.y), pk2(v[6] * rstd * ga1.z, v[7] * rstd * ga1.w)); }
            {   const float a0 = __uint_as_float(ws_[i].x << 16), a1 = __uint_as_float(ws_[i].x & 0xffff0000u), a2 = __uint_as_float(ws_[i].y << 16), a3 = __uint_as_float(ws_[i].y & 0xffff0000u);
                const float rstd = rsqrtf(wave_sum(a0 * a0 + a1 * a1 + a2 * a2 + a3 * a3) * (1.f / 256) + EPS);
                *(uint2*)(Y + row * DM + 512 + 4 * lane) = make_uint2(pk2(a0 * rstd * gs.x, a1 * rstd * gs.y), pk2(a2 * rstd * gs.z, a3 * rstd * gs.w)); }
            {   const float a0 = __uint_as_float(wr[i].x << 16), a1 = __uint_as_float(wr[i].x & 0xffff0000u), a2 = __uint_as_float(wr[i].y << 16), a3 = __uint_as_float(wr[i].y & 0xffff0000u);
                const float rstd = rsqrtf(wave_sum(a0 * a0 + a1 * a1 + a2 * a2 + a3 * a3) * (1.f / 256) + EPS);
                *(uint2*)(Y + row * DM + 768 + 4 * lane) = make_uint2(pk2(a0 * rstd * gr.x, a1 * rstd * gr.y), pk2(a2 * rstd * gr.z, a3 * rstd * gr.w)); } }
    }
}

__device__ __forceinline__ void ph_topk_a(const Ctx& c, const float* SC, float* STOP, int* ITOP) {
    for (int i = c.gt; i < T * 16; i += c.ngt) {
        const float* sc = SC + (size_t)i * 128;
        float pv = INFINITY; int pn = -1;
        for (int it = 0; it < 16; ++it) {
            float bv = -INFINITY; int bn = 1 << 30;
            for (int n = 0; n < 128; ++n) { const float v = sc[n];
                const bool elig = (v < pv) || (v == pv && n > pn);
                if (elig && (v > bv || (v == bv && n < bn))) { bv = v; bn = n; } }
            STOP[(size_t)i * 16 + it] = bv; ITOP[(size_t)i * 16 + it] = bn; pv = bv; pn = bn;
        }
    }
}
__device__ __forceinline__ void ph_topk_b(const Ctx& c, const float* STOP, const int* ITOP, int* IDX, float* GATE) {
    LAS float* my = (LAS float*)c.lds + c.tid * 33;
    for (int i = c.gt; i < T * 8; i += c.ngt) {
        for (int k = 0; k < 32; ++k) my[k] = STOP[(size_t)i * 32 + k];
        float pv = INFINITY; int pn = -1; float best0 = 0.f, den = 0.f;
        float ev[16];
#pragma unroll
        for (int it = 0; it < 16; ++it) {
            float bv = -INFINITY; int bn = 1 << 30;
            for (int f = 0; f < 256; ++f) { const float v = my[f >> 4] + my[16 + (f & 15)];
                const bool elig = (v < pv) || (v == pv && f > pn);
                if (elig && (v > bv || (v == bv && f < bn))) { bv = v; bn = f; } }
            pv = bv; pn = bn;
            if (it == 0) best0 = bv;
            ev[it] = expf(bv - best0); den += ev[it];
            IDX[(size_t)i * 16 + it] = ITOP[(size_t)i * 32 + (bn >> 4)] * 128 + ITOP[(size_t)i * 32 + 16 + (bn & 15)];
        }
#pragma unroll
        for (int it = 0; it < 16; ++it) GATE[(size_t)i * 16 + it] = ev[it] / den;
    }
}

__device__ __forceinline__ void ph_gather(const Ctx& c, const bf16* HN, const int* IDX, const float* GATE, const bf16* PU, const bf16* PV, float* X) {
    const int lane = c.lane;
    for (int t = c.gw; t < T; t += c.ngw) {
        float hn[16]; unpack8(*(const uint4*)(HN + (size_t)t * DM + 8 * lane), hn); unpack8(*(const uint4*)(HN + (size_t)t * DM + 512 + 8 * lane), hn + 8);
        float y[16];
#pragma unroll
        for (int e = 0; e < 16; ++e) y[e] = 0.f;
        for (int k = 0; k < 128; ++k) {
            const int e = IDX[(size_t)t * 128 + k]; const float gt = GATE[(size_t)t * 128 + k];
            const bf16* ur = PU + (size_t)e * DM; const bf16* vr = PV + (size_t)e * DM;
            float u[16]; unpack8(*(const uint4*)(ur + 8 * lane), u); unpack8(*(const uint4*)(ur + 512 + 8 * lane), u + 8);
            float d = 0.f;
#pragma unroll
            for (int q = 0; q < 16; ++q) d += u[q] * hn[q];
            d = wave_sum(d);
            const float w = gt * gelu_f(d);
            float v[16]; unpack8(*(const uint4*)(vr + 8 * lane), v); unpack8(*(const uint4*)(vr + 512 + 8 * lane), v + 8);
#pragma unroll
            for (int q = 0; q < 16; ++q) y[q] += w * v[q];
        }
        float4* xo = (float4*)(X + (size_t)t * DM + 8 * lane);
        float4 p0 = xo[0], p1 = xo[1]; p0.x += y[0]; p0.y += y[1]; p0.z += y[2]; p0.w += y[3]; p1.x += y[4]; p1.y += y[5]; p1.z += y[6]; p1.w += y[7]; xo[0] = p0; xo[1] = p1;
        xo = (float4*)(X + (size_t)t * DM + 512 + 8 * lane);
        p0 = xo[0]; p1 = xo[1]; p0.x += y[8]; p0.y += y[9]; p0.z += y[10]; p0.w += y[11]; p1.x += y[12]; p1.y += y[13]; p1.z += y[14]; p1.w += y[15]; xo[0] = p0; xo[1] = p1;
    }
}
namespace att {
typedef short bf16x8 __attribute__((ext_vector_type(8)));
typedef short s16x4 __attribute__((ext_vector_type(4)));
typedef float f32x16 __attribute__((ext_vector_type(16)));
typedef unsigned u32x4 __attribute__((ext_vector_type(4)));
constexpr int KT = 64, KBYTES = KT * DQK * 2, VBYTES = KT * DV * 2, BUFB = KBYTES + VBYTES;
constexpr int OFF_WS = 2 * BUFB, OFF_MO = 0, OFF_ML = 65536, LDS_NEED = OFF_WS + 8 * 64 * 4;
constexpr float THR = 8.f;
__device__ __forceinline__ int kswz(int row, int c) { return row * 384 + (((c & ~7) | ((c & 7) ^ ((row >> 1) & 7))) << 4); }
__device__ __forceinline__ int v_st(int k, int c) { const int kk = (k & ~0xC) | ((k & 4) << 1) | ((k & 8) >> 1); return ((kk >> 3) * 4 + (c >> 5)) * 512 + ((kk & 7) * 32 + (c & 31)) * 2; }
__device__ __forceinline__ int v_rd_base(int lane) { return ((lane & 3) << 3) | (((lane >> 2) & 3) << 6) | (((lane >> 4) & 1) << 5) | (((lane >> 5) & 1) << 8); }
__device__ __forceinline__ int crow(int r, int hi) { return (r & 3) + 8 * (r >> 2) + 4 * hi; }
__device__ __forceinline__ unsigned cvtpk(float lo, float hi) { unsigned r; asm volatile("v_cvt_pk_bf16_f32 %0, %1, %2" : "=v"(r) : "v"(lo), "v"(hi)); return r; }
#define ATT_SBAR() __builtin_amdgcn_sched_barrier(0)

__device__ __forceinline__ void attn_unit(LAS unsigned char* lds, const bf16* Qg, const bf16* Kg, const bf16* Vg, bf16* AO, int bh, int qb, int tid) {
    const int lane = tid & 63, wid = __builtin_amdgcn_readfirstlane(tid >> 6), qsub = wid & 3, kh = wid >> 2, r32 = lane & 31, hi = lane >> 5;
    const int q0 = qb * 128, NT = 2 * (qb + 1);
    const size_t rowbase = (size_t)bh * SEQ;
    bf16x8 qr[12];
    { const bf16* qp = Qg + (rowbase + q0 + 32 * qsub + r32) * DQK + 8 * hi;
#pragma unroll
      for (int ks = 0; ks < 12; ++ks) qr[ks] = *(const bf16x8*)(qp + 16 * ks); }
    int ksrc[3], vsrc[2];
#pragma unroll
    for (int j = 0; j < 3; ++j) { const int L = (wid + 8 * j) * 64 + lane, row = L / 24, cp = L - row * 24, c = (cp & ~7) | ((cp & 7) ^ ((row >> 1) & 7)); ksrc[j] = row * DQK + c * 8; }
#pragma unroll
    for (int j = 0; j < 2; ++j) { const int X = ((wid + 8 * j) * 64 + lane) * 16, sub = X >> 9, within = (X & 511) >> 1, kk = ((sub >> 2) << 3) | (within >> 5);
        const int k = (kk & ~0xC) | ((kk & 4) << 1) | ((kk & 8) >> 1), c = (sub & 3) * 32 + (within & 31); vsrc[j] = k * DV + c; }
    const bf16* Kt = Kg + rowbase * DQK; const bf16* Vt = Vg + rowbase * DV;
#define ATT_STAGE(t, bo) do { const bf16* kp_ = Kt + (size_t)(t) * (KT * DQK); const bf16* vp_ = Vt + (size_t)(t) * (KT * DV); \
        _Pragma("unroll") for (int j_ = 0; j_ < 3; ++j_) __builtin_amdgcn_global_load_lds((const unsigned*)(kp_ + ksrc[j_]), (LAS unsigned*)(lds + (bo) + (wid + 8 * j_) * 1024), 16, 0, 0); \
        _Pragma("unroll") for (int j_ = 0; j_ < 2; ++j_) __builtin_amdgcn_global_load_lds((const unsigned*)(vp_ + vsrc[j_]), (LAS unsigned*)(lds + (bo) + KBYTES + (wid + 8 * j_) * 1024), 16, 0, 0); } while (0)
    const int krow = 32 * kh + r32, kf = (krow >> 1) & 7;
    int kb[4];
#pragma unroll
    for (int j = 0; j < 4; ++j) kb[j] = krow * 384 + ((((2 * j + hi) & 7) ^ kf) << 4);
    const int vb = KBYTES + v_rd_base(lane) + kh * 8192;
    LAS float* wsf = (LAS float*)(lds + OFF_WS) + wid * 64;
    float m_reg = -1e30f, l_reg = 0.f; f32x16 o[4];
#pragma unroll
    for (int d = 0; d < 4; ++d) o[d] = f32x16{};
    const int rb = 32 * qsub;
    ATT_STAGE(0, 0);
    asm volatile("s_waitcnt vmcnt(0)" ::: "memory");
    __syncthreads();
    for (int t = 0; t < NT; ++t) {
        const int bo = (t & 1) * BUFB;
        if (t + 1 < NT) ATT_STAGE(t + 1, BUFB - bo);
        const int kboff = 64 * t + 32 * kh - q0;
        const bool act = kboff <= rb, diag = kboff == rb;
        if (act) {
            f32x16 p = f32x16{};
#pragma unroll
            for (int ks = 0; ks < 12; ++ks) {
                const bf16x8 kfr = *(const LAS bf16x8*)(lds + bo + kb[ks & 3] + (ks >> 2) * 128);
                p = __builtin_amdgcn_mfma_f32_32x32x16_bf16(kfr, qr[ks], p, 0, 0, 0);
            }
            const int vaddr = (int)(uintptr_t)lds + bo + vb;
            s16x4 vl0[2], vh0[2], vl1[2], vh1[2];
#define ATT_TRRD(dst, off) asm volatile("ds_read_b64_tr_b16 %0, %1 offset:%2" : "=&v"(dst) : "v"(vaddr), "i"(off) : "memory")
#define ATT_VRD(i, d0) do { ATT_TRRD(vl0[i], (d0) * 512); ATT_TRRD(vh0[i], (d0) * 512 + 2048); ATT_TRRD(vl1[i], (d0) * 512 + 4096); ATT_TRRD(vh1[i], (d0) * 512 + 6144); } while (0)
            ATT_VRD(0, 0); ATT_VRD(1, 1);
            if (diag) {
#pragma unroll
                for (int r = 0; r < 16; ++r) if (crow(r, hi) > r32) p[r] = -__builtin_inff();
            }
            float pmax = p[0];
#pragma unroll
            for (int r = 1; r < 16; ++r) pmax = fmaxf(pmax, p[r]);
            { auto rr = __builtin_amdgcn_permlane32_swap(__float_as_uint(pmax), __float_as_uint(pmax), false, false);
              pmax = fmaxf(__uint_as_float(rr[0]), __uint_as_float(rr[1])); }
            float alpha = 1.f;
            if (!__all(pmax - m_reg <= THR)) { const float mn = fmaxf(m_reg, pmax); alpha = __builtin_amdgcn_exp2f(m_reg - mn); m_reg = mn; }
#pragma unroll
            for (int r = 0; r < 16; ++r) p[r] = __builtin_amdgcn_exp2f(p[r] - m_reg);
            float ps = 0.f;
#pragma unroll
            for (int r = 0; r < 16; ++r) ps += p[r];
            { auto rr = __builtin_amdgcn_permlane32_swap(__float_as_uint(ps), __float_as_uint(ps), false, false);
              ps = __uint_as_float(rr[0]) + __uint_as_float(rr[1]); }
            l_reg = l_reg * alpha + ps;
            if (__any(alpha < 1.f)) {
                if (hi == 0) wsf[r32] = alpha;
                asm volatile("s_waitcnt lgkmcnt(0)" ::: "memory");
#pragma unroll
                for (int r = 0; r < 16; ++r) { const float al = wsf[crow(r, hi)];
#pragma unroll
                    for (int d = 0; d < 4; ++d) o[d][r] *= al; }
            }
            bf16x8 pa0, pa1;
#define ATT_PK4(B_, OUT) do { unsigned a0 = cvtpk(p[B_ + 0], p[B_ + 1]), a1 = cvtpk(p[B_ + 2], p[B_ + 3]); unsigned b0 = cvtpk(p[B_ + 4], p[B_ + 5]), b1 = cvtpk(p[B_ + 6], p[B_ + 7]); \
            auto r0 = __builtin_amdgcn_permlane32_swap(a0, b0, false, false); auto r1 = __builtin_amdgcn_permlane32_swap(a1, b1, false, false); \
            u32x4 w_ = {r0[0], r1[0], r0[1], r1[1]}; OUT = __builtin_bit_cast(bf16x8, w_); } while (0)
            ATT_PK4(0, pa0); ATT_PK4(8, pa1);
#undef ATT_PK4
            asm volatile("s_waitcnt lgkmcnt(0)" ::: "memory"); ATT_SBAR();
            __builtin_amdgcn_s_setprio(1);
#define ATT_PV(i, d0) do { \
            o[d0] = __builtin_amdgcn_mfma_f32_32x32x16_bf16(pa0, (bf16x8){vl0[i][0], vl0[i][1], vl0[i][2], vl0[i][3], vh0[i][0], vh0[i][1], vh0[i][2], vh0[i][3]}, o[d0], 0, 0, 0); \
            o[d0] = __builtin_amdgcn_mfma_f32_32x32x16_bf16(pa1, (bf16x8){vl1[i][0], vl1[i][1], vl1[i][2], vl1[i][3], vh1[i][0], vh1[i][1], vh1[i][2], vh1[i][3]}, o[d0], 0, 0, 0); } while (0)
            ATT_PV(0, 0); ATT_SBAR(); ATT_VRD(0, 2); ATT_SBAR(); ATT_PV(1, 1); ATT_SBAR(); ATT_VRD(1, 3);
            asm volatile("s_waitcnt lgkmcnt(0)" ::: "memory"); ATT_SBAR();
            ATT_PV(0, 2); ATT_PV(1, 3);
#undef ATT_PV
#undef ATT_VRD
#undef ATT_TRRD
            __builtin_amdgcn_s_setprio(0);
        }
        asm volatile("s_waitcnt vmcnt(0)" ::: "memory");
        __syncthreads();
    }
    LAS float* MO = (LAS float*)(lds + OFF_MO) + qsub * 4096; LAS float* ML = (LAS float*)(lds + OFF_ML) + qsub * 64;
    if (kh == 1) {
        if (hi == 0) { ML[2 * r32] = m_reg; ML[2 * r32 + 1] = l_reg; }
#pragma unroll
        for (int d = 0; d < 4; ++d)
#pragma unroll
            for (int r = 0; r < 16; ++r) MO[(d * 16 + r) * 64 + lane] = o[d][r];
    }
    __syncthreads();
    if (kh == 0) {
        const float m1 = ML[2 * r32], l1 = ML[2 * r32 + 1];
        const float mm = fmaxf(m_reg, m1), f0 = __builtin_amdgcn_exp2f(m_reg - mm), f1 = __builtin_amdgcn_exp2f(m1 - mm);
        const float il = 1.f / (l_reg * f0 + l1 * f1);
        if (hi == 0) { wsf[r32] = f0 * il; wsf[32 + r32] = f1 * il; }
        asm volatile("s_waitcnt lgkmcnt(0)" ::: "memory");
        const int b = bh / NH, h = bh % NH;
        bf16* Ow = AO + ((size_t)b * SEQ + q0 + rb) * 512 + h * DV;
#pragma unroll
        for (int r = 0; r < 16; ++r) { const int orow = crow(r, hi); const float g0 = wsf[orow], g1 = wsf[32 + orow];
#pragma unroll
            for (int d = 0; d < 4; ++d) { const float v = o[d][r] * g0 + MO[(d * 16 + r) * 64 + lane] * g1; const float vn = __shfl_xor(v, 1);
                if ((r32 & 1) == 0) *(unsigned*)(Ow + (size_t)orow * 512 + d * 32 + r32) = cvtpk(v, vn); } }
    }
    __syncthreads();
#undef ATT_STAGE
}
__device__ __forceinline__ void attn_phase(LAS unsigned char* lds, const bf16* Qg, const bf16* Kg, const bf16* Vg, bf16* AO, int G, int bid, int tid) {
    const int npair = NB * NH * 32;
    for (int v0 = bid; v0 < npair; v0 += G) {
        const int vcu = (G % 8 == 0 && npair % G == 0) ? (v0 % 8) * (npair / 8) + v0 / 8 : v0;
        const int bh = vcu >> 5, s = vcu & 31;
        for (int u = 0; u < 2; ++u) attn_unit(lds, Qg, Kg, Vg, AO, bh, u ? s : 63 - s, tid);
    }
}
#undef ATT_SBAR
}
#ifndef MK_PROBE
#define MK_PROBE 0
#endif
#ifndef PROBE_A_LO
#define PROBE_A_LO 0
#define PROBE_A_HI 1
#define PROBE_B_LO 16
#define PROBE_B_HI 17
#endif
#define TS_OFF 8192
#ifndef MK_DUP
#define MK_DUP 0
#endif
#ifndef MK_DUPK
#define MK_DUPK 0
#endif
#ifndef MK_DUP_LOADONLY
#define MK_DUP_LOADONLY false
#endif
#ifndef MK_DUP_EMASK
#define MK_DUP_EMASK 0x3fff
#endif
#ifndef MK_SIMPLE_TOPK
#define MK_SIMPLE_TOPK 0
#endif
#ifndef MK_SIMPLE_SCAN
#define MK_SIMPLE_SCAN 0
#endif
#ifndef MK_SIMPLE_ATTN
#define MK_SIMPLE_ATTN 0
#endif
#ifndef MK_SIMPLE_GEMM
#define MK_SIMPLE_GEMM 0
#endif
constexpr int NPH_LAYER = 10, NPH = 1 + NL * NPH_LAYER;
struct GD { const bf16* A; const bf16* Bt; void* C; const float* aux0; const bf16* aux1; int lda, M, N, K, ldc, kind; };
template <class Epi> __device__ __forceinline__ void run_gemm(const Ctx& c, const bf16* A, int lda, const bf16* Bt, int M, int N, int K, const Epi& E) {
    pg8::Gemm g{A, Bt, M, N, K, lda}; pg8::StaticOrder S; S.init(M, N, c.G, c.bid);
    pg8::gemm_phase<Epi, pg8::StaticOrder, true, true>(c.lds, g, S, E);
}
#define AS4 __attribute__((address_space(4)))
#define PH_BEGIN \
        const Args AS4* ap = (const Args AS4*)__builtin_amdgcn_kernarg_segment_ptr(); asm volatile("" : "+s"(ap)); \
        int tid_ = threadIdx.x; asm volatile("" : "+v"(tid_)); \
        Ctx c; c.lds = (LAS unsigned char*)lds_raw; c.tid = tid_; c.lane = c.tid & 63; c.wave = __builtin_amdgcn_readfirstlane(c.tid >> 6); \
        { int G_ = gridDim.x, bid_ = blockIdx.x; asm volatile("" : "+s"(G_), "+s"(bid_)); c.G = G_; c.bid = bid_; } \
        c.gw = c.wave * c.G + c.bid; c.ngw = NWAVES * c.G; c.gt = c.bid * NTHR + c.tid; c.ngt = c.G * NTHR; \
        unsigned char* const ws = ap->ws; float* const out = ap->out; (void)out; (void)ws;
#define WSQ(T_, off) ((T_*)(ws + (off)))
#define INQ(i) ((const float*)ap->in[i])
#define PH_BAR(P) if ((P) + 1 < ph_hi) { XcdBarrier b2 = bar; unsigned* bb = (unsigned*)(ap->ws + WS_CTL) + CW_BAR; unsigned bx = bar.x; asm volatile("" : "+s"(bb), "+s"(bx)); b2.bar = bb; b2.x = bx; xcd_barrier(b2); }
#define PHASE(P) if (ph_lo <= (P) && (P) < ph_hi)

template <int L> __device__ __forceinline__ void layer_phases(unsigned char* lds_raw, const XcdBarrier& bar, int ph_lo, int ph_hi) {
    constexpr int P0 = 1 + L * NPH_LAYER;
    PHASE(P0 + 0) { PH_BEGIN
        run_gemm(c, WSQ(bf16, WS_XB), DM, WSQ(bf16, WS_WINT) + (size_t)L * ZW * DM, T, ZW, DM, pg8::EpiBf16<0>{WSQ(bf16, WS_Z), ZW, nullptr, 0, 0, 1.f});
        PH_BAR(P0 + 0) }
    PHASE(P0 + 1) { PH_BEGIN
        ph_zstats(c, WSQ(bf16, WS_Z), INQ(4) + L * 256, INQ(6) + L * 128, WSQ(bf16, WS_CQN), WSQ(bf16, WS_CKVN));
        s5f::pass<false>(c.lds, WSQ(bf16, WS_Z), WSQ(bf16, WS_S5A) + (size_t)L * 32768, WSQ(bf16, WS_S5C) + (size_t)L * 32768, WSQ(float2, WS_S5L) + L * 1024, INQ(17) + L * 256, WSQ(float2, WS_SE), WSQ(float2, WS_SH), WSQ(bf16, WS_YG), c.gw, c.ngw, c.wave, c.lane);
        __syncthreads();
        lruf::pass_a(c.lds, WSQ(bf16, WS_Z), INQ(20) + L * 1024, INQ(21) + L * 256, INQ(22) + L * 16384, INQ(23) + L * 256, INQ(24) + L * 16384, INQ(25) + L * 256, INQ(26) + L * 256, WSQ(float, WS_AA), WSQ(float, WS_BT), WSQ(float2, WS_LPE), c.gw, c.ngw, c.wave, c.lane);
        PH_BAR(P0 + 1) }
    PHASE(P0 + 2) { PH_BEGIN
        for (int it = c.bid; it < 232; it += c.G) {
            if (it >= 224) lruf::carry_wg(c.lds, WSQ(float2, WS_LPE), WSQ(float, WS_LH), it - 224, c.wave, c.lane);
            else if (it >= 192) s5f::carry_wg(c.lds, WSQ(float2, WS_S5L) + L * 1024, WSQ(float2, WS_SE), WSQ(float2, WS_SH), it - 192, c.wave, c.lane);
        }
        run_gemm(c, WSQ(bf16, WS_CQN), 256, WSQ(bf16, WS_WUQT) + (size_t)L * 768 * 256, T, 768, 256, pg8::EpiBf16<0>{WSQ(bf16, WS_QRAW), 768, nullptr, 0, 0, 1.f});
    }
    PHASE(P0 + 2) { PH_BEGIN
        run_gemm(c, WSQ(bf16, WS_CKVN), 128, WSQ(bf16, WS_WUKVT) + (size_t)L * 1024 * 128, T, 1024, 128, pg8::EpiBf16<0>{WSQ(bf16, WS_KVRAW), 1024, nullptr, 0, 0, 1.f});
        PH_BAR(P0 + 2) }
    PHASE(P0 + 3) { PH_BEGIN
        ph_qkfin(c, WSQ(bf16, WS_QRAW), WSQ(bf16, WS_KVRAW), WSQ(bf16, WS_Z), INQ(8) + L * DQK, INQ(9) + L * DQK, WSQ(float, WS_COS), WSQ(float, WS_SIN), WSQ(bf16, WS_QB), WSQ(bf16, WS_KB), WSQ(bf16, WS_VB));
        PH_BAR(P0 + 3) }
    PHASE(P0 + 4) { PH_BEGIN
        s5f::pass<true>(c.lds, WSQ(bf16, WS_Z), WSQ(bf16, WS_S5A) + (size_t)L * 32768, WSQ(bf16, WS_S5C) + (size_t)L * 32768, WSQ(float2, WS_S5L) + L * 1024, INQ(17) + L * 256, WSQ(float2, WS_SE), WSQ(float2, WS_SH), WSQ(bf16, WS_YG), c.gw, c.ngw, c.wave, c.lane);
        lruf::pass_b(WSQ(float, WS_AA), WSQ(float, WS_BT), WSQ(float, WS_LH), WSQ(bf16, WS_Z), WSQ(bf16, WS_ROUT), c.gt, c.ngt);
        __syncthreads();
    }
    PHASE(P0 + 4) { PH_BEGIN
        att::attn_phase(c.lds, WSQ(bf16, WS_QB), WSQ(bf16, WS_KB), WSQ(bf16, WS_VB), WSQ(bf16, WS_AO), c.G, c.bid, c.tid);
        PH_BAR(P0 + 4) }
    PHASE(P0 + 5) { PH_BEGIN
        run_gemm(c, WSQ(bf16, WS_YG), 256, WSQ(bf16, WS_GLUT) + (size_t)L * 65536, T, 256, 256, pg8::EpiGlu{WSQ(bf16, WS_SOUT), 256, INQ(19) + L * 256, WSQ(bf16, WS_YG)});
        PH_BAR(P0 + 5) }
    PHASE(P0 + 6) { PH_BEGIN
        ph_mixnorm(c, WSQ(bf16, WS_AO), WSQ(bf16, WS_SOUT), WSQ(bf16, WS_ROUT), INQ(27) + L * DM, WSQ(bf16, WS_Y));
        PH_BAR(P0 + 6) }
    PHASE(P0 + 7) { PH_BEGIN
        const float* xin = (L == 0) ? INQ(0) : out;
        run_gemm(c, WSQ(bf16, WS_Y), DM, WSQ(bf16, WS_WOUTT) + (size_t)L * DM * DM, T, DM, DM, pg8::EpiOut{out, DM, xin, INQ(29) + L * DM, WSQ(bf16, WS_XB), WSQ(float, WS_ROWSS)});
        PH_BAR(P0 + 7) }
    PHASE(P0 + 8) { PH_BEGIN
        run_gemm(c, WSQ(bf16, WS_XB), DM, WSQ(bf16, WS_WQT) + (size_t)L * 2048 * DM, T, 2048, DM, pg8::EpiBf16<0>{WSQ(bf16, WS_QP), 2048, nullptr, 0, 0, 1.f});
        PH_BAR(P0 + 8) }
    PHASE(P0 + 9) { PH_BEGIN
#if MK_DUP & 8
        tk::topk_phase<true, MK_DUP_EMASK>(WSQ(bf16, WS_QP), WSQ(bf16, WS_SUBKT) + (size_t)L * 32768, nullptr, nullptr, WSQ(bf16, WS_XB), WSQ(unsigned char, WS_PU) + (size_t)L * 16384 * DM, WSQ(unsigned char, WS_PV) + (size_t)L * 16384 * DM,
                                           out, WSQ(float, WS_RA), WSQ(float, WS_ROWSS), nullptr, c.lds + c.wave * 2048, c.gw, c.ngw, c.lane);
#endif
        tk::topk_phase<true>(WSQ(bf16, WS_QP), WSQ(bf16, WS_SUBKT) + (size_t)L * 32768, nullptr, nullptr, WSQ(bf16, WS_XB), WSQ(unsigned char, WS_PU) + (size_t)L * 16384 * DM, WSQ(unsigned char, WS_PV) + (size_t)L * 16384 * DM,
                             out, out, WSQ(float, WS_ROWSS), (L + 1 < NL) ? INQ(2) + (L + 1) * DM : nullptr, c.lds + c.wave * 2048, c.gw, c.ngw, c.lane);
        PH_BAR(P0 + 9) }
}

__global__ void __launch_bounds__(NTHR, 2) mega(Args a_) {
    extern __shared__ __attribute__((aligned(16))) unsigned char lds_raw[];
    {   const int t0 = threadIdx.x;
        for (int u = t0; u < (LDS_BYTES - RING_BYTES) / 4; u += NTHR) ((LAS unsigned*)((LAS unsigned char*)lds_raw + RING_BYTES))[u] = 0u; }
    __syncthreads();
    volatile LAS unsigned* MISC = (volatile LAS unsigned*)((LAS unsigned char*)lds_raw + MISC_OFF);
    XcdBarrier bar; bar.bar = (unsigned*)(a_.ws + WS_CTL) + CW_BAR; bar.x = 0; bar.st = MISC + 8;
    const int ph_lo = a_.ph_lo, ph_hi = a_.ph_hi;
    if (ph_hi - ph_lo > 1) bar = xcd_barrier_post((unsigned*)(a_.ws + WS_CTL) + CW_BAR, MISC + 8);
    PHASE(0) { PH_BEGIN
        ph_prep(*ap, c);
        PH_BAR(0) }
    layer_phases<0>(lds_raw, bar, ph_lo, ph_hi);
    layer_phases<1>(lds_raw, bar, ph_lo, ph_hi);
}

extern "C" void kernel_launch(void* const* d_in, const int* in_sizes, int n_in, void* d_out, int out_size, void* d_ws, size_t ws_size, hipStream_t stream) {
    static int grid = 0;
    if (grid == 0) {
        if (n_in != 34 || out_size != T * DM || ws_size < WS_END) { fprintf(stderr, "kernel_launch: unexpected shapes (n_in %d out %d ws %zu)\n", n_in, out_size, ws_size); grid = -1; return; }
        int dev = 0, cus = 0, per_cu = 0;
        if (hipGetDevice(&dev) != hipSuccess || hipDeviceGetAttribute(&cus, hipDeviceAttributeMultiprocessorCount, dev) != hipSuccess) { grid = -1; return; }
        if (hipFuncSetAttribute((const void*)mega, hipFuncAttributeMaxDynamicSharedMemorySize, LDS_BYTES) != hipSuccess) { fprintf(stderr, "kernel_launch: hipFuncSetAttribute failed\n"); grid = -1; return; }
        if (hipOccupancyMaxActiveBlocksPerMultiprocessor(&per_cu, (const void*)mega, NTHR, LDS_BYTES) != hipSuccess || per_cu < 1) { fprintf(stderr, "kernel_launch: occupancy query says %d blocks per CU\n", per_cu); }
        (void)hipGetLastError();
        grid = cus;
    }
    if (grid < 0) return;
    (void)hipMemsetAsync((char*)d_ws + WS_CTL, 0, CTL_ZERO_BYTES, stream);
    Args a{};
    for (int i = 0; i < 34; ++i) a.in[i] = d_in[i];
    a.out = (float*)d_out; a.ws = (unsigned char*)d_ws;
#if MK_PER_PHASE
    for (int p = 0; p < NPH; ++p) { a.ph_lo = p; a.ph_hi = p + 1; hipLaunchKernelGGL(mega, dim3(grid), dim3(NTHR), LDS_BYTES, stream, a); }
#else
    a.ph_lo = 0; a.ph_hi = NPH;
    hipLaunchKernelGGL(mega, dim3(grid), dim3(NTHR), LDS_BYTES, stream, a);
#endif
}
```

```cpp
#include <hip/hip_runtime.h>
#include <cstdint>
#include <cstdio>

#ifndef MK_PER_PHASE
#define MK_PER_PHASE 0
#endif

typedef unsigned short bf16;
typedef unsigned int u32;

constexpr int NB = 2, SEQ = 8192, T = NB * SEQ, DM = 1024, NL = 2;
constexpr int ZW = 1280;
constexpr int ZC_CQ = 0, ZC_CKV = 256, ZC_KR = 384, ZC_U = 512, ZC_X = 768, ZC_G = 1024;
constexpr int NH = 4, DQK = 192, DV = 128;
constexpr float EPS = 1e-6f;
constexpr float QSCALE = 0.07216878364870322f * 1.4426950408889634f;

constexpr size_t MiB = 1u << 20;
constexpr size_t WS_CTL = 0, CTL_ZERO_BYTES = 1 * MiB, WS_WINT = 1 * MiB, WS_WUQT = 7 * MiB, WS_WUKVT = 8 * MiB, WS_GLUT = 9 * MiB, WS_WOUTT = 10 * MiB,
                 WS_WQT = 14 * MiB, WS_SUBKT = 22 * MiB, WS_COS = 23 * MiB, WS_SIN = 25 * MiB, WS_PU = 28 * MiB, WS_PV = 92 * MiB,
                 WS_XB = 156 * MiB, WS_Z = 188 * MiB, WS_RA = 228 * MiB, WS_RB = 356 * MiB, WS_CKVN = 420 * MiB, WS_AO = 424 * MiB,
                 WS_ROUT = 440 * MiB, WS_Y = 448 * MiB, WS_IDX = 480 * MiB, WS_GATE = 488 * MiB, WS_S5A = 496 * MiB, WS_S5C = WS_S5A + 128 * 1024, WS_S5L = WS_S5A + 256 * 1024, WS_LWT = WS_S5A + 512 * 1024,
                 WS_SE = 497 * MiB, WS_SH = 501 * MiB, WS_LPE = 505 * MiB, WS_LH = 506 * MiB, WS_ROWSS = WS_LH + 512 * 1024, WS_END = 508 * MiB;
constexpr size_t WS_QRAW = WS_RA, WS_KVRAW = WS_RA + 24 * MiB, WS_QB = WS_RA + 56 * MiB, WS_KB = WS_RA + 80 * MiB, WS_VB = WS_RA + 104 * MiB,
                 WS_CQN = WS_RA + 120 * MiB, WS_SC = WS_RA;
constexpr size_t WS_MIXSS = WS_GATE;
constexpr size_t WS_XC = WS_RB, WS_AA = WS_RB + 16 * MiB, WS_BT = WS_RB + 32 * MiB, WS_YG = WS_RB + 48 * MiB, WS_SOUT = WS_RB + 56 * MiB, WS_QP = WS_RB;
constexpr size_t WS_S5W = WS_IDX;
constexpr size_t WS_STOP = WS_Z, WS_ITOP = WS_Z + 16 * MiB;
constexpr int CW_BAR = 4096;

__device__ __forceinline__ float bf2f(bf16 h) { return __uint_as_float((u32)h << 16); }
__device__ __forceinline__ bf16 f2bf(float f) { u32 u = __float_as_uint(f); return (bf16)((u + 0x7fffu + ((u >> 16) & 1u)) >> 16); }
__device__ __forceinline__ u32 pk2(float lo, float hi) { return (u32)f2bf(lo) | ((u32)f2bf(hi) << 16); }
__device__ __forceinline__ float wave_sum(float v) {
#pragma unroll
    for (int o = 32; o > 0; o >>= 1) v += __shfl_xor(v, o);
    return v;
}
__device__ __forceinline__ float wave_max(float v) {
#pragma unroll
    for (int o = 32; o > 0; o >>= 1) v = fmaxf(v, __shfl_xor(v, o));
    return v;
}
__device__ __forceinline__ float gelu_f(float v) {
    const float av = fabsf(v), t = __builtin_amdgcn_rcpf(fmaf(av, 0.2316418882f, 1.0f));
    float q = fmaf(t, 0.5307027145f, -0.7265760135f); q = fmaf(q, t, 0.7107068705f); q = fmaf(q, t, -0.142248368f); q = fmaf(q, t, 0.127414796f); q *= t;
    const float e = __builtin_amdgcn_exp2f(v * v * -0.72134752044f);
    const float m = v * (q * e);
    return v < 0.f ? m : v - m;
}
__device__ __forceinline__ float sigmoid_f(float x) { return 1.f / (1.f + __expf(-x)); }
__device__ __forceinline__ void unpack8(uint4 w, float* o) {
    o[0] = __uint_as_float(w.x << 16); o[1] = __uint_as_float(w.x & 0xffff0000u);
    o[2] = __uint_as_float(w.y << 16); o[3] = __uint_as_float(w.y & 0xffff0000u);
    o[4] = __uint_as_float(w.z << 16); o[5] = __uint_as_float(w.z & 0xffff0000u);
    o[6] = __uint_as_float(w.w << 16); o[7] = __uint_as_float(w.w & 0xffff0000u);
}
__device__ __forceinline__ void sincos_acc(float x, float& s, float& c) {
    const float k = rintf(x * 0.15915494309189535f);
    float r = fmaf(-k, 6.28125f, x);
    r = fmaf(-k, 1.9350051879882812e-3f, r);
    r = fmaf(-k, 3.0199160335e-7f, r);
    const float f = r * 0.15915494309189535f;
    s = __builtin_amdgcn_sinf(f); c = __builtin_amdgcn_cosf(f);
}
namespace pg8 {
#define PG8_LAS __attribute__((address_space(3)))
typedef unsigned short bf16_t;
typedef short bf16x8 __attribute__((ext_vector_type(8)));
typedef float f32x4 __attribute__((ext_vector_type(4)));
typedef unsigned u32x4 __attribute__((ext_vector_type(4)));
constexpr int BM = 256, BK = 64, HALF = 128, HTB = HALF * BK * 2  , STAGE_BYTES = 8 * HTB, NXCD = 8, WGM = 8;

__host__ __device__ __forceinline__ int lds_byte(int r, int c) { const int st = (r >> 4) * 2 + (c >> 5), rr = r & 15, cc = c & 31, ob = rr * 64 + cc * 2; return st * 1024 + (ob ^ (((ob >> 9) & 1) << 5)); }
__host__ __device__ __forceinline__ void stage_rc(int b, int& R, int& C) { const int st = b / 1024, sb = b % 1024, swz = sb ^ (((sb >> 9) & 1) << 5); R = (st >> 1) * 16 + swz / 64; C = (st & 1) * 32 + (swz % 64) / 2; }
__host__ __device__ __forceinline__ int perm32(int rho) { const int n = rho >> 4, i = rho & 15; return 8 * (i >> 2) + 4 * n + (i & 3); }

struct Unit { int pm, pn; };
struct Gemm { const bf16_t* A; const bf16_t* Bt; int M, N, K, lda; };

struct StaticOrder {
    int nM, nN, nwg, G, c;
    __host__ __device__ void init(int M, int N, int G_, int c_) { nM = M / BM; nN = N / BM; nwg = nM * nN; G = G_; c = c_; }
    __host__ __device__ bool next(int i, Unit& u) const {
        const long L = (long)i * G + c; if (L >= nwg) return false;
        int wgid = (int)L; { const int q = nwg / NXCD, r = nwg % NXCD, xcd = wgid % NXCD, off = wgid / NXCD; wgid = (xcd < r ? xcd * (q + 1) : r * (q + 1) + (xcd - r) * q) + off; }
        const int nig = WGM * nN, gid = wgid / nig, fm = gid * WGM, gsz = (nM - fm) < WGM ? (nM - fm) : WGM;
        u.pm = fm + ((wgid % nig) % gsz); u.pn = (wgid % nig) / gsz; return true;
    }
    __device__ __forceinline__ void a_ready(const Unit&) const {}
    __device__ __forceinline__ void done(const Unit&) const {}
};

__device__ __forceinline__ unsigned cvt_pk_bf16(float lo, float hi) { unsigned r; asm volatile("v_cvt_pk_bf16_f32 %0, %1, %2" : "=v"(r) : "v"(lo), "v"(hi)); return r; }
typedef float f32x2 __attribute__((ext_vector_type(2)));
__device__ __forceinline__ f32x2 gelu_pk(f32x2 v) {
    const f32x2 av = __builtin_elementwise_abs(v), d = av * 0.2316418882f + 1.0f;
    f32x2 t; t.x = __builtin_amdgcn_rcpf(d.x); t.y = __builtin_amdgcn_rcpf(d.y);
    f32x2 q = t * 0.5307027145f + (-0.7265760135f); q = q * t + 0.7107068705f; q = q * t + (-0.142248368f); q = q * t + 0.127414796f; q = q * t;
    const f32x2 s = (v * v) * (-0.72134752044f);
    f32x2 e; e.x = __builtin_amdgcn_exp2f(s.x); e.y = __builtin_amdgcn_exp2f(s.y);
    const f32x2 m = v * (q * e), r = v - m;
    f32x2 o; o.x = v.x < 0.f ? m.x : r.x; o.y = v.y < 0.f ? m.y : r.y; return o;
}

template <int ACT  > struct EpiBf16 {
    static constexpr bool PERM = true, AFTER_DRAIN = false, HAS_INIT = false, HAS_KHOOK = false; static_assert(ACT == 0 || ACT == 1, "EpiBf16: ACT is 0 (none) or 1 (gelu_pk)");
    bf16_t* O; int ldc; const float* bias; int split_cols; size_t split_stride; float scale0;
    __device__ __forceinline__ void operator()(const f32x4 (&acc)[2][2][4][2], const Unit& u, int wr, int wc, int fr, int fq) const {
        const int row0 = u.pm * BM + wr * 64 + fr; int colt = u.pn * BM; bf16_t* base = O;
        float sc = 1.f; if (split_cols) { const int t = colt / split_cols; base += (size_t)t * split_stride; colt -= t * split_cols; if (t == 0) sc = scale0; }
        const int col0 = colt + wc * 32 + 8 * fq, bcol0 = u.pn * BM + wc * 32 + 8 * fq;
        f32x4 bv[2][2];
#pragma unroll
        for (int bj = 0; bj < 2; ++bj)
#pragma unroll
            for (int n = 0; n < 2; ++n) bv[bj][n] = bias ? *(const f32x4*)(bias + bcol0 + bj * HALF + 4 * n) : (f32x4){0.f, 0.f, 0.f, 0.f};
#pragma unroll
        for (int ai = 0; ai < 2; ++ai)
#pragma unroll
            for (int m = 0; m < 4; ++m) { bf16_t* rowp = base + (size_t)(row0 + ai * HALF + m * 16) * ldc + col0;
#pragma unroll
                for (int bj = 0; bj < 2; ++bj) { f32x4 v0 = acc[ai][bj][m][0] + bv[bj][0], v1 = acc[ai][bj][m][1] + bv[bj][1];
                    if (ACT == 1) { f32x2 a = gelu_pk((f32x2){v0[0], v0[1]}), b = gelu_pk((f32x2){v0[2], v0[3]}), c = gelu_pk((f32x2){v1[0], v1[1]}), d = gelu_pk((f32x2){v1[2], v1[3]});
                        v0 = (f32x4){a.x, a.y, b.x, b.y}; v1 = (f32x4){c.x, c.y, d.x, d.y}; }
                    v0 = v0 * sc; v1 = v1 * sc; u32x4 w; w.x = cvt_pk_bf16(v0[0], v0[1]); w.y = cvt_pk_bf16(v0[2], v0[3]); w.z = cvt_pk_bf16(v1[0], v1[1]); w.w = cvt_pk_bf16(v1[2], v1[3]);
                    *(u32x4*)(rowp + bj * HALF) = w; } }
    }
};


struct EpiF32 {
    static constexpr bool PERM = false, AFTER_DRAIN = false, HAS_INIT = false, HAS_KHOOK = false;
    float* C; int ldc; const float* resid;
    __device__ __forceinline__ void operator()(const f32x4 (&acc)[2][2][4][2], const Unit& u, int wr, int wc, int fr, int fq) const {
        const int row0 = u.pm * BM + wr * 64 + fr, col0 = u.pn * BM + wc * 32 + 4 * fq;
#pragma unroll
        for (int ai = 0; ai < 2; ++ai)
#pragma unroll
            for (int m = 0; m < 4; ++m) { const size_t rb = (size_t)(row0 + ai * HALF + m * 16) * ldc + col0;
#pragma unroll
                for (int bj = 0; bj < 2; ++bj)
#pragma unroll
                    for (int n = 0; n < 2; ++n) { const size_t ix = rb + bj * HALF + n * 16; f32x4 v = acc[ai][bj][m][n];
                        if (resid) v += *(const f32x4*)(resid + ix);
                        *(f32x4*)(C + ix) = v; } }
    }
};

struct EpiOut {
    static constexpr bool PERM = false, AFTER_DRAIN = false, HAS_INIT = true, HAS_KHOOK = true;
    float* C; int ldc; const float* resid; const float* g; bf16_t* XB; float* rowss; const float* mss; PG8_LAS float* fac;
    __device__ __forceinline__ void init(f32x4 (&acc)[2][2][4][2], const Unit& u, int wr, int wc, int fr, int fq) const {
        const int rl0 = wr * 64 + fr, row0 = u.pm * BM + rl0, col0 = u.pn * BM + wc * 32 + 4 * fq;
#pragma unroll
        for (int ai = 0; ai < 2; ++ai)
#pragma unroll
            for (int m = 0; m < 4; ++m) { const int rl = rl0 + ai * HALF + m * 16, row = row0 + ai * HALF + m * 16; const size_t rb = (size_t)row * ldc + col0;
                const f32x4 a = *(const f32x4*)(mss + (size_t)row * 12), b = *(const f32x4*)(mss + (size_t)row * 12 + 4), c = *(const f32x4*)(mss + (size_t)row * 12 + 8);
                const float ma = ((a[0] + a[1]) + (a[2] + a[3])) * (1.f / 512) + EPS, ms = ((b[0] + b[1]) + (b[2] + b[3])) * (1.f / 256) + EPS, mr = ((c[0] + c[1]) + (c[2] + c[3])) * (1.f / 256) + EPS;
                const float f = __builtin_sqrtf(ma);
                *(PG8_LAS f32x4*)(fac + rl * 4) = f32x4{f, __builtin_sqrtf(ms) * rsqrtf(ma), __builtin_sqrtf(mr) * rsqrtf(ms), rsqrtf(mr)};
#pragma unroll
                for (int bj = 0; bj < 2; ++bj)
#pragma unroll
                    for (int n = 0; n < 2; ++n) acc[ai][bj][m][n] = *(const f32x4*)(resid + rb + bj * HALF + n * 16) * f; }
    }
    __device__ __forceinline__ void khook(f32x4 (&acc)[2][2][4][2], const Unit& u, int t, int wr, int wc, int fr, int fq) const {
        const int rl0 = wr * 64 + fr;
#pragma unroll
        for (int ai = 0; ai < 2; ++ai)
#pragma unroll
            for (int m = 0; m < 4; ++m) { const float f = fac[(rl0 + ai * HALF + m * 16) * 4 + (t == 8 ? 1 : 2)];
#pragma unroll
                for (int bj = 0; bj < 2; ++bj)
#pragma unroll
                    for (int n = 0; n < 2; ++n) acc[ai][bj][m][n] *= f; }
    }
    __device__ __forceinline__ void operator()(const f32x4 (&acc)[2][2][4][2], const Unit& u, int wr, int wc, int fr, int fq) const {
        typedef unsigned u32x2 __attribute__((ext_vector_type(2)));
        const int rl0 = wr * 64 + fr, row0 = u.pm * BM + rl0, col0 = u.pn * BM + wc * 32 + 4 * fq;
#pragma unroll
        for (int ai = 0; ai < 2; ++ai)
#pragma unroll
            for (int m = 0; m < 4; ++m) { const int row = row0 + ai * HALF + m * 16; const size_t rb = (size_t)row * ldc + col0; float ss = 0.f;
                const float f = fac[(rl0 + ai * HALF + m * 16) * 4 + 3];
#pragma unroll
                for (int bj = 0; bj < 2; ++bj)
#pragma unroll
                    for (int n = 0; n < 2; ++n) { const size_t ix = rb + bj * HALF + n * 16; const f32x4 v = acc[ai][bj][m][n] * f;
                        *(f32x4*)(C + ix) = v; ss += (v[0] * v[0] + v[1] * v[1]) + (v[2] * v[2] + v[3] * v[3]);
                        const f32x4 gg = *(const f32x4*)(g + col0 + bj * HALF + n * 16);
                        u32x2 w; w.x = cvt_pk_bf16(v[0] * gg[0], v[1] * gg[1]); w.y = cvt_pk_bf16(v[2] * gg[2], v[3] * gg[3]); *(u32x2*)(XB + ix) = w; }
                ss += __shfl_xor(ss, 16); ss += __shfl_xor(ss, 32);
                if (fq == 0) rowss[(size_t)row * 16 + u.pn * 4 + wc] = ss; }
    }
};
struct EpiGlu {
    static constexpr bool PERM = true, AFTER_DRAIN = false, HAS_INIT = false, HAS_KHOOK = false;
    bf16_t* O; int ldc; const float* bias; const bf16_t* YG; int ldy; float* mss;
    __device__ __forceinline__ void operator()(const f32x4 (&acc)[2][2][4][2], const Unit& u, int wr, int wc, int fr, int fq) const {
        const int row0 = u.pm * BM + wr * 64 + fr, col0 = u.pn * BM + wc * 32 + 8 * fq;
#pragma unroll
        for (int ai = 0; ai < 2; ++ai)
#pragma unroll
            for (int m = 0; m < 4; ++m) { const int row = row0 + ai * HALF + m * 16; float ss = 0.f;
#pragma unroll
                for (int bj = 0; bj < 2; ++bj) { const size_t ix = (size_t)row * ldc + col0 + bj * HALF, iy = (size_t)row * ldy + col0 + bj * HALF;
                    const f32x4 b0 = *(const f32x4*)(bias + col0 + bj * HALF), b1 = *(const f32x4*)(bias + col0 + bj * HALF + 4);
                    const u32x4 yw = *(const u32x4*)(YG + iy);
                    f32x4 v0 = acc[ai][bj][m][0] + b0, v1 = acc[ai][bj][m][1] + b1; float o[8];
#pragma unroll
                    for (int e = 0; e < 4; ++e) { const unsigned w = e == 0 ? yw.x : e == 1 ? yw.y : e == 2 ? yw.z : yw.w;
                        const float y0 = __uint_as_float(w << 16), y1 = __uint_as_float(w & 0xffff0000u);
                        const float a0 = e < 2 ? v0[2 * e] : v1[2 * e - 4], a1 = e < 2 ? v0[2 * e + 1] : v1[2 * e - 3];
                        o[2 * e] = y0 / (1.f + __expf(-a0)); o[2 * e + 1] = y1 / (1.f + __expf(-a1)); }
                    u32x4 w; w.x = cvt_pk_bf16(o[0], o[1]); w.y = cvt_pk_bf16(o[2], o[3]); w.z = cvt_pk_bf16(o[4], o[5]); w.w = cvt_pk_bf16(o[6], o[7]);
                    *(u32x4*)(O + ix) = w;
#pragma unroll
                    for (int e = 0; e < 4; ++e) { const unsigned ww = e == 0 ? w.x : e == 1 ? w.y : e == 2 ? w.z : w.w; const float r0 = __uint_as_float(ww << 16), r1 = __uint_as_float(ww & 0xffff0000u); ss += r0 * r0 + r1 * r1; } }
                ss += __shfl_xor(ss, 16); ss += __shfl_xor(ss, 32);
                if (fq == 0) mss[(size_t)row * 12 + 4 + wc] = ss; }
    }
};
template <class Epi, class Sched, bool ALIGN_EPI = false, bool SP2 = false>
__device__ __forceinline__ void gemm_phase(PG8_LAS unsigned char* lds, const Gemm g, const Sched& S, const Epi& E) {
    int tid_l = threadIdx.x; asm volatile("" : "+v"(tid_l));
    const int tid = tid_l, wid = __builtin_amdgcn_readfirstlane(tid >> 6), lane = tid & 63, wr = wid >> 2, wc = wid & 3, fr = lane & 15, fq = lane >> 4;
    const int K = g.K, nt = K / BK;
    unsigned voffA[2], voffB[2];
#pragma unroll
    for (int i = 0; i < 2; ++i) { int R, C; stage_rc(tid * 16 + i * 8192, R, C); const int Rb = Epi::PERM ? ((R & ~31) + perm32(R & 31)) : R;
        voffA[i] = (unsigned)(R * g.lda + C) * 2u; voffB[i] = (unsigned)(Rb * K + C) * 2u; }
    const size_t kstep = (size_t)(BK * 2);
    const size_t hsA = (size_t)HALF * g.lda * 2, hsB = (size_t)HALF * K * 2;
    const size_t tsA = 2 * hsA, tsB = 2 * hsB;
    const unsigned ldsw = (unsigned)wid * 1024u;
    const int aoff = lds_byte(wr * 64 + fr, fq * 8), boff = lds_byte(wc * 32 + fr, fq * 8);
#define PG8_SA(b, h) (((b) * 2 + (h)) * HTB)
#define PG8_SB(b, h) ((4 + (b) * 2 + (h)) * HTB)
#define PG8_STAGE(bufoff, gbase, voff) do { _Pragma("unroll") for (int _i = 0; _i < 2; ++_i) \
        __builtin_amdgcn_global_load_lds((const unsigned*)((const char*)(gbase) + (voff)[_i]), (PG8_LAS unsigned*)(lds + (bufoff) + ldsw + _i * 8192), 16, 0, 0); } while (0)
#define PG8_LDA(dst, b, h) do { _Pragma("unroll") for (int m = 0; m < 4; ++m) _Pragma("unroll") for (int k = 0; k < 2; ++k) dst[m][k] = *(const PG8_LAS bf16x8*)(lds + PG8_SA(b, h) + aoff + m * 2048 + k * 1024); } while (0)
#define PG8_LDB(dst, b, h) do { _Pragma("unroll") for (int n = 0; n < 2; ++n) _Pragma("unroll") for (int k = 0; k < 2; ++k) dst[n][k] = *(const PG8_LAS bf16x8*)(lds + PG8_SB(b, h) + boff + n * 2048 + k * 1024); } while (0)
#define PG8_MMA(ai, bj, At, Bt) do { __builtin_amdgcn_s_setprio(1); _Pragma("unroll") for (int m = 0; m < 4; ++m) _Pragma("unroll") for (int n = 0; n < 2; ++n) _Pragma("unroll") for (int k = 0; k < 2; ++k) \
        acc[ai][bj][m][n] = __builtin_amdgcn_mfma_f32_16x16x32_bf16(Bt[n][k], At[m][k], acc[ai][bj][m][n], 0, 0, 0); __builtin_amdgcn_s_setprio(0); } while (0)
#define PG8_WAIT_V(n) asm volatile("s_waitcnt vmcnt(" #n ")" ::: "memory")
#define PG8_WAIT_L(n) asm volatile("s_waitcnt lgkmcnt(" #n ")" ::: "memory")
#define PG8_BAR __builtin_amdgcn_s_barrier()
#define PG8_SCHED __builtin_amdgcn_sched_barrier(0)
    Unit cur, nxt; int ui = 0;
    if (!S.next(0, cur)) return;
    f32x4 acc[2][2][4][2];
    if constexpr (Epi::HAS_INIT) E.init(acc, cur, wr, wc, fr, fq);
    else {
#pragma unroll
    for (int a = 0; a < 2; ++a)
#pragma unroll
        for (int b = 0; b < 2; ++b)
#pragma unroll
            for (int m = 0; m < 4; ++m)
#pragma unroll
                for (int n = 0; n < 2; ++n) acc[a][b][m][n] = (f32x4){0.f, 0.f, 0.f, 0.f};
    }
    bf16x8 At[4][2], B0[2][2], B1[2][2];
    const char* cA = (const char*)g.A + (size_t)cur.pm * tsA; const char* cB = (const char*)g.Bt + (size_t)cur.pn * tsB;
    S.a_ready(cur);
    if constexpr (SP2) {
        PG8_STAGE(PG8_SB(0, 0), cB, voffB); PG8_STAGE(PG8_SB(0, 1), cB + hsB, voffB); PG8_STAGE(PG8_SA(0, 0), cA, voffA); PG8_STAGE(PG8_SA(0, 1), cA + hsA, voffA);
        if (wr == 1) PG8_BAR;
        PG8_WAIT_V(2); PG8_BAR;
        PG8_STAGE(PG8_SB(1, 0), cB + kstep, voffB); PG8_STAGE(PG8_SA(1, 0), cA + kstep, voffA); PG8_STAGE(PG8_SB(1, 1), cB + hsB + kstep, voffB);
        PG8_WAIT_V(6); PG8_BAR;
    } else {
        PG8_STAGE(PG8_SB(0, 0), cB, voffB); PG8_STAGE(PG8_SA(0, 0), cA, voffA); PG8_STAGE(PG8_SB(0, 1), cB + hsB, voffB); PG8_STAGE(PG8_SA(0, 1), cA + hsA, voffA);
        if (wr == 1) PG8_BAR;
        PG8_WAIT_V(4); PG8_BAR;
        PG8_STAGE(PG8_SB(1, 0), cB + kstep, voffB); PG8_STAGE(PG8_SA(1, 0), cA + kstep, voffA); PG8_STAGE(PG8_SB(1, 1), cB + hsB + kstep, voffB);
        PG8_WAIT_V(6); PG8_BAR;
    }
    for (;;) {
        const bool has_next = S.next(ui + 1, nxt);
        const char* nA = has_next ? (const char*)g.A + (size_t)nxt.pm * tsA : cA; const char* nB = has_next ? (const char*)g.Bt + (size_t)nxt.pn * tsB : cB;
        for (int t = 0; t < nt; t += 2) {
            if constexpr (Epi::HAS_KHOOK) { if (t == 8 || t == 12) E.khook(acc, cur, t, wr, wc, fr, fq); }
            const bool last = (t == nt - 2);
            const char* a1 = cA + (size_t)(t + 1) * kstep;
            const char* a2 = last ? nA : cA + (size_t)(t + 2) * kstep; const char* b2 = last ? nB : cB + (size_t)(t + 2) * kstep;
            const char* a3 = a2 + kstep; const char* b3 = b2 + kstep;
            if (last && has_next) S.a_ready(nxt);
            if constexpr (SP2) {
            PG8_LDB(B0, 0, 0); PG8_LDB(B1, 0, 1); PG8_SCHED; PG8_LDA(At, 0, 0); PG8_STAGE(PG8_SA(1, 1), a1 + hsA, voffA);
            PG8_WAIT_V(8); PG8_WAIT_L(0); PG8_BAR; PG8_MMA(0, 0, At, B0); PG8_MMA(0, 1, At, B1); PG8_BAR; PG8_SCHED;
            PG8_LDA(At, 0, 1); PG8_STAGE(PG8_SB(0, 0), b2, voffB); PG8_STAGE(PG8_SB(0, 1), b2 + hsB, voffB); PG8_STAGE(PG8_SA(0, 0), a2, voffA);
            PG8_WAIT_V(8); PG8_WAIT_L(0); PG8_BAR; PG8_MMA(1, 0, At, B0); PG8_MMA(1, 1, At, B1); PG8_BAR; PG8_SCHED;
            PG8_LDB(B0, 1, 0); PG8_LDB(B1, 1, 1); PG8_SCHED; PG8_LDA(At, 1, 0); PG8_STAGE(PG8_SA(0, 1), a2 + hsA, voffA);
            PG8_WAIT_V(8); PG8_WAIT_L(0); PG8_BAR; PG8_MMA(0, 0, At, B0); PG8_MMA(0, 1, At, B1); PG8_BAR; PG8_SCHED;
            PG8_LDA(At, 1, 1); PG8_STAGE(PG8_SB(1, 0), b3, voffB); PG8_STAGE(PG8_SB(1, 1), b3 + hsB, voffB); PG8_STAGE(PG8_SA(1, 0), a3, voffA);
            PG8_WAIT_V(8); PG8_WAIT_L(0); PG8_BAR; PG8_MMA(1, 0, At, B0); PG8_MMA(1, 1, At, B1); PG8_BAR; PG8_SCHED;
            } else {
            PG8_LDB(B0, 0, 0); PG8_SCHED; PG8_LDA(At, 0, 0); PG8_STAGE(PG8_SA(1, 1), a1 + hsA, voffA);
            PG8_WAIT_L(8); PG8_BAR; PG8_WAIT_L(0); PG8_MMA(0, 0, At, B0); PG8_BAR; PG8_SCHED;
            PG8_LDB(B1, 0, 1); PG8_STAGE(PG8_SB(0, 0), b2, voffB);
            PG8_BAR; PG8_WAIT_L(0); PG8_MMA(0, 1, At, B1); PG8_BAR;
            PG8_LDA(At, 0, 1); PG8_STAGE(PG8_SA(0, 0), a2, voffA);
            PG8_BAR; PG8_WAIT_L(0); PG8_MMA(1, 0, At, B0); PG8_BAR; PG8_SCHED;
            PG8_STAGE(PG8_SB(0, 1), b2 + hsB, voffB);
            PG8_WAIT_V(6); PG8_BAR; PG8_MMA(1, 1, At, B1); PG8_BAR;
            PG8_LDB(B0, 1, 0); PG8_SCHED; PG8_LDA(At, 1, 0); PG8_STAGE(PG8_SA(0, 1), a2 + hsA, voffA);
            PG8_WAIT_L(8); PG8_BAR; PG8_WAIT_L(0); PG8_MMA(0, 0, At, B0); PG8_BAR; PG8_SCHED;
            PG8_LDB(B1, 1, 1); PG8_STAGE(PG8_SB(1, 0), b3, voffB);
            PG8_BAR; PG8_WAIT_L(0); PG8_MMA(0, 1, At, B1); PG8_BAR;
            PG8_LDA(At, 1, 1); PG8_STAGE(PG8_SA(1, 0), a3, voffA);
            PG8_BAR; PG8_WAIT_L(0); PG8_MMA(1, 0, At, B0); PG8_BAR; PG8_SCHED;
            PG8_STAGE(PG8_SB(1, 1), b3 + hsB, voffB);
            PG8_WAIT_V(6); PG8_BAR; PG8_MMA(1, 1, At, B1); PG8_BAR;
            }
        }
        if constexpr (ALIGN_EPI) { if (wr == 0) PG8_BAR; }
        if constexpr (!Epi::AFTER_DRAIN) { E(acc, cur, wr, wc, fr, fq); S.done(cur); }
        if (!has_next) break;
        if constexpr (Epi::HAS_INIT) E.init(acc, nxt, wr, wc, fr, fq);
        else {
#pragma unroll
        for (int a = 0; a < 2; ++a)
#pragma unroll
            for (int b = 0; b < 2; ++b)
#pragma unroll
                for (int m = 0; m < 4; ++m)
#pragma unroll
                    for (int n = 0; n < 2; ++n) acc[a][b][m][n] = (f32x4){0.f, 0.f, 0.f, 0.f};
        }
        cur = nxt; cA = nA; cB = nB; ++ui;
        if constexpr (ALIGN_EPI) { if (wr == 1) PG8_BAR; }
    }
    PG8_WAIT_V(0);
    if constexpr (!ALIGN_EPI) { if (wr == 0) PG8_BAR; }
    PG8_BAR;
    if constexpr (Epi::AFTER_DRAIN) { E.fused(acc, cur, wr, wc, fr, fq, lds, wid, lane); S.done(cur); }
#undef PG8_SA
#undef PG8_SB
#undef PG8_STAGE
#undef PG8_LDA
#undef PG8_LDB
#undef PG8_MMA
#undef PG8_WAIT_V
#undef PG8_WAIT_L
#undef PG8_BAR
#undef PG8_SCHED
}
}
#define GAS __attribute__((address_space(1)))
#define LAS __attribute__((address_space(3)))
#define XB_TMO      128
#define XB_XCNT(j)  (256  + 64 * (j))
#define XB_XSUB(j)  (1280 + 64 * (j))
#define XB_XGEN(j)  (2304 + 64 * (j))
#define XB_TOP      3328
#define XB_TOPGEN   3392
#define XCD_BAR_WORDS 3456
#define XB_SPIN_CAP (1u << 25)
__device__ __forceinline__ unsigned xb_ld(unsigned* p)              { return __hip_atomic_load(p, __ATOMIC_RELAXED, __HIP_MEMORY_SCOPE_AGENT); }
__device__ __forceinline__ unsigned xb_add(unsigned* p, unsigned v) { return __hip_atomic_fetch_add(p, v, __ATOMIC_RELAXED, __HIP_MEMORY_SCOPE_AGENT); }
__device__ __forceinline__ unsigned xb_xcc_id() { return (unsigned)__builtin_amdgcn_s_getreg((3 << 11) | 20) & 0xFu; }
#define XB_SPIN(cond, bar) do { unsigned _sp = 0; while (cond) { __builtin_amdgcn_s_sleep(1); \
    if ((++_sp & 255u) == 0u) { if (xb_ld(&(bar)[XB_TMO])) break; if (_sp > XB_SPIN_CAP) { atomicAdd(&(bar)[XB_TMO], 1u); break; } } } } while (0)
struct XcdBarrier { unsigned* bar; unsigned x; volatile LAS unsigned* st; };
__device__ __forceinline__ XcdBarrier xcd_barrier_post(unsigned* bar, volatile LAS unsigned* st) {
    XcdBarrier b; b.bar = bar; b.x = xb_xcc_id(); b.st = st;
    if (threadIdx.x == 0) (void)xb_add(&bar[XB_XCNT(b.x)], 1u);
    return b;
}
__device__ __forceinline__ void xcd_barrier_complete(unsigned* bar, unsigned x, unsigned& nloc, unsigned& nx) {
    const unsigned G = gridDim.x * gridDim.y * gridDim.z;
    unsigned sum, cnt, mine, sp = 0u;
    for (;;) {
        sum = 0u; cnt = 0u; mine = 0u;
#pragma unroll
        for (unsigned j = 0; j < 16; ++j) { const unsigned c = xb_ld(&bar[XB_XCNT(j)]); sum += c; cnt += (c > 0u) ? 1u : 0u; mine = (j == x) ? c : mine; }
        if (sum == G) break;
        __builtin_amdgcn_s_sleep(1);
        if ((++sp & 255u) == 0u) { if (xb_ld(&bar[XB_TMO])) break; if (sp > XB_SPIN_CAP) { atomicAdd(&bar[XB_TMO], 1u); break; } }
    }
    nloc = mine > 0u ? mine : 1u; nx = cnt > 0u ? cnt : 1u;
}
__device__ __forceinline__ void xcd_barrier(const XcdBarrier& b) {
    asm volatile("s_waitcnt vmcnt(0)" ::: "memory");
    __syncthreads();
    if (threadIdx.x == 0) {
        unsigned* bar = b.bar;
        __builtin_amdgcn_s_waitcnt(0);
        unsigned nloc = b.st[0], nx = b.st[1];
        if (nloc == 0u) { xcd_barrier_complete(bar, b.x, nloc, nx); b.st[0] = nloc; b.st[1] = nx; }
        const unsigned old = xb_add(&bar[XB_XSUB(b.x)], 1u);
        const unsigned gen = old / nloc;
        if (old + 1u == (gen + 1u) * nloc) {
            __builtin_amdgcn_fence(__ATOMIC_RELEASE, "agent");
            asm volatile("s_waitcnt vmcnt(0)" ::: "memory");
            const unsigned og = xb_add(&bar[XB_TOP], 1u);
            const unsigned tg = og / nx;
            if (og + 1u == (tg + 1u) * nx) xb_add(&bar[XB_TOPGEN], 1u);
            else XB_SPIN(xb_ld(&bar[XB_TOPGEN]) == tg, bar);
            __builtin_amdgcn_fence(__ATOMIC_ACQUIRE, "agent");
            xb_add(&bar[XB_XGEN(b.x)], 1u);
            asm volatile("s_waitcnt vmcnt(0)" ::: "memory");
        } else {
            XB_SPIN(xb_ld(&bar[XB_XGEN(b.x)]) == gen, bar);
            __builtin_amdgcn_fence(__ATOMIC_ACQUIRE, "agent");
            asm volatile("s_waitcnt vmcnt(0)" ::: "memory");
        }
    }
    __syncthreads();
}
namespace s5f {
typedef short bf16x8 __attribute__((ext_vector_type(8)));
typedef float f32x4 __attribute__((ext_vector_type(4)));
typedef unsigned u32x2 __attribute__((ext_vector_type(2)));
constexpr int LC = 32, NCH = SEQ / LC, RS = 272, WBYTES = LC * RS;
__device__ __forceinline__ void build_tables(const float* a_re, const float* a_im, const float* log_dt, const float* b_re, const float* b_im, const float* c_re, const float* c_im,
                                             bf16* S5A, bf16* S5C, float2* S5L, int gt, int ngt) {
    for (int i = gt; i < 16 * 64; i += ngt) {
        const int g = i >> 6;
        const float are = a_re[i], aim = a_im[i], dt = expf(log_dt[g]);
        const float mag = expf(are * dt); float sn, cs; sincos_acc(aim * dt, sn, cs);
        const float lre = mag * cs, lim = mag * sn;
        const float xr = lre - 1.f, xi = lim, den = are * are + aim * aim;
        const float cr = (xr * are + xi * aim) / den, ci = (xi * are - xr * aim) / den;
        S5L[i] = make_float2(lre, lim);
        const int p = i & 63;
        for (int k = 0; k < 16; ++k) { const float br = b_re[i * 16 + k], bi = b_im[i * 16 + k];
            S5A[((size_t)g * 128 + 2 * p) * 16 + k] = f2bf(cr * br - ci * bi); S5A[((size_t)g * 128 + 2 * p + 1) * 16 + k] = f2bf(cr * bi + ci * br);
            S5C[((size_t)g * 16 + k) * 128 + 2 * p] = f2bf(c_re[(g * 16 + k) * 64 + p]); S5C[((size_t)g * 16 + k) * 128 + 2 * p + 1] = f2bf(-c_im[(g * 16 + k) * 64 + p]); }
    }
}
__device__ __forceinline__ void build_wtable(const float* a_re, const float* a_im, const float* log_dt, const float* b_re, const float* b_im, bf16* S5W, int gt, int ngt) {
    for (int i = gt; i < 16 * 64 * 32; i += ngt) {
        const int j = i & 31, gp = i >> 5, g = gp >> 6, p = gp & 63;
        const float are = a_re[gp], aim = a_im[gp], dt = expf(log_dt[g]);
        const float mag = expf(are * dt); float sn, cs; sincos_acc(aim * dt, sn, cs);
        const float lre = mag * cs, lim = mag * sn;
        const float xr = lre - 1.f, xi = lim, den = are * are + aim * aim;
        const float cr = (xr * are + xi * aim) / den, ci = (xi * are - xr * aim) / den;
        float pre = 1.f, pim = 0.f, sre = lre, sim = lim; int e = 31 - j;
#pragma unroll
        for (int bit = 0; bit < 5; ++bit) { if (e & 1) { const float t = pre * sre - pim * sim; pim = pre * sim + pim * sre; pre = t; } e >>= 1; const float t2 = sre * sre - sim * sim; sim = 2.f * sre * sim; sre = t2; }
        const float fr = pre * cr - pim * ci, fi = pre * ci + pim * cr;
        bf16* o_re = S5W + ((size_t)(g * 128 + 2 * p) * 512 + 16 * j); bf16* o_im = o_re + 512;
#pragma unroll
        for (int k = 0; k < 16; k += 2) { const float br0 = b_re[gp * 16 + k], bi0 = b_im[gp * 16 + k], br1 = b_re[gp * 16 + k + 1], bi1 = b_im[gp * 16 + k + 1];
            *(unsigned*)(o_re + k) = pk2(fr * br0 - fi * bi0, fr * br1 - fi * bi1); *(unsigned*)(o_im + k) = pk2(fr * bi0 + fi * br0, fr * bi1 + fi * br1); }
    }
}
__device__ __forceinline__ void pass_a_mfma(const bf16* Z, const bf16* S5W, float2* SE, int gw, int ngw, int lane) {
    const int l15 = lane & 15, q4 = lane >> 4;
    for (int task = gw; task < NB * (NCH / 16) * 16; task += ngw) {
        const int g = task & 15, cb = (task >> 4) & (NCH / 16 - 1), b = task / (16 * (NCH / 16));
        const size_t tok0 = (size_t)b * SEQ + (size_t)(16 * cb + l15) * LC;
        const bf16* zp = Z + (tok0 + (q4 >> 1)) * ZW + ZC_U + 16 * g + 8 * (q4 & 1);
        const bf16* wp = S5W + ((size_t)(g * 128 + l15) * 512 + 8 * q4);
        f32x4 acc[8];
#pragma unroll
        for (int mb = 0; mb < 8; ++mb) acc[mb] = f32x4{0.f, 0.f, 0.f, 0.f};
#pragma unroll 4
        for (int ks = 0; ks < 16; ++ks) {
            const bf16x8 bfr = *(const bf16x8*)(zp + (size_t)(2 * ks) * ZW);
#pragma unroll
            for (int mb = 0; mb < 8; ++mb) { const bf16x8 afr = *(const bf16x8*)(wp + (size_t)(16 * mb) * 512 + 32 * ks); acc[mb] = __builtin_amdgcn_mfma_f32_16x16x32_bf16(afr, bfr, acc[mb], 0, 0, 0); }
        }
        float4* se = (float4*)(SE + (((size_t)b * NCH + 16 * cb + l15) * 16 + g) * 64);
#pragma unroll
        for (int mb = 0; mb < 8; ++mb) se[(8 * mb + 2 * q4) >> 1] = make_float4(acc[mb][0], acc[mb][1], acc[mb][2], acc[mb][3]);
    }
}
template <bool FULL> __device__ __forceinline__ void chunk(LAS unsigned char* wl, const bf16* Z, const bf16x8 (&afr)[8], const bf16x8 (&cfr)[4], float lre, float lim, float& hre, float& him,
                                                           int b, int ch, int g, int lane, const float* dsk, bf16* YG) {
    const int l15 = lane & 15, q4 = lane >> 4;
    const size_t t0 = (size_t)b * SEQ + (size_t)ch * LC;
#pragma unroll
    for (int nb = 0; nb < 2; ++nb) {
        bf16x8 ufr = bf16x8{};
        if (q4 < 2) ufr = *(const bf16x8*)(Z + (t0 + 16 * nb + l15) * ZW + ZC_U + g * 16 + 8 * q4);
#pragma unroll
        for (int mb = 0; mb < 8; ++mb) {
            f32x4 d = __builtin_amdgcn_mfma_f32_16x16x32_bf16(afr[mb], ufr, f32x4{0.f, 0.f, 0.f, 0.f}, 0, 0, 0);
            *(LAS u32x2*)(wl + (16 * nb + l15) * RS + (16 * mb + 4 * q4) * 2) = u32x2{pk2(d[0], d[1]), pk2(d[2], d[3])};
        }
    }
    unsigned wk[LC];
#pragma unroll
    for (int k = 0; k < LC; ++k) wk[k] = *(const LAS unsigned*)(wl + k * RS + 4 * lane);
#pragma unroll
    for (int k = 0; k < LC; ++k) {
        const float bre = __uint_as_float(wk[k] << 16), bim = __uint_as_float(wk[k] & 0xffff0000u);
        const float nre = fmaf(lre, hre, fmaf(-lim, him, bre)), nim = fmaf(lre, him, fmaf(lim, hre, bim)); hre = nre; him = nim;
        if (FULL) wk[k] = pk2(hre, him);
    }
    if (FULL) {
#pragma unroll
        for (int k = 0; k < LC; ++k) *(LAS unsigned*)(wl + k * RS + 4 * lane) = wk[k];
    }
    if (FULL) {
#pragma unroll
        for (int nb = 0; nb < 2; ++nb) {
            f32x4 y = f32x4{0.f, 0.f, 0.f, 0.f};
#pragma unroll
            for (int ks = 0; ks < 4; ++ks) {
                const bf16x8 hfr = *(const LAS bf16x8*)(wl + (16 * nb + l15) * RS + (32 * ks + 8 * q4) * 2);
                y = __builtin_amdgcn_mfma_f32_16x16x32_bf16(cfr[ks], hfr, y, 0, 0, 0);
            }
            const size_t t = t0 + 16 * nb + l15; const int co = 4 * q4;
            const uint2 uw = *(const uint2*)(Z + t * ZW + ZC_U + g * 16 + co);
            const float4 dd = *(const float4*)(dsk + g * 16 + co);
            const float y0 = y[0] + dd.x * __uint_as_float(uw.x << 16), y1 = y[1] + dd.y * __uint_as_float(uw.x & 0xffff0000u),
                        y2 = y[2] + dd.z * __uint_as_float(uw.y << 16), y3 = y[3] + dd.w * __uint_as_float(uw.y & 0xffff0000u);
            *(uint2*)(YG + t * 256 + g * 16 + co) = make_uint2(pk2(gelu_f(y0), gelu_f(y1)), pk2(gelu_f(y2), gelu_f(y3)));
        }
    }
}
template <bool FULL> __device__ __forceinline__ void pass(LAS unsigned char* lds, const bf16* Z, const bf16* S5A, const bf16* S5C, const float2* S5L, const float* dsk,
                                                          float2* SE, const float2* SH, bf16* YG, int gw, int ngw, int wave, int lane) {
    LAS unsigned char* wl = lds + wave * WBYTES;
    const int g = gw & 15, l15 = lane & 15, q4 = lane >> 4;
    bf16x8 afr[8], cfr[4];
#pragma unroll
    for (int mb = 0; mb < 8; ++mb) { afr[mb] = bf16x8{}; if (q4 < 2) afr[mb] = *(const bf16x8*)(S5A + ((size_t)g * 128 + 16 * mb + l15) * 16 + 8 * q4); }
#pragma unroll
    for (int ks = 0; ks < 4; ++ks) { cfr[ks] = bf16x8{}; if (FULL) cfr[ks] = *(const bf16x8*)(S5C + ((size_t)g * 16 + l15) * 128 + 32 * ks + 8 * q4); }
    const float2 lam = S5L[g * 64 + lane];
    for (int it = gw >> 4; it < NB * NCH; it += ngw >> 4) {
        const int b = it / NCH, ch = it % NCH;
        float hre = 0.f, him = 0.f;
        if (FULL) { const float2 h0 = SH[((size_t)it * 16 + g) * 64 + lane]; hre = h0.x; him = h0.y; }
        chunk<FULL>(wl, Z, afr, cfr, lam.x, lam.y, hre, him, b, ch, g, lane, dsk, YG);
        if (!FULL) SE[((size_t)it * 16 + g) * 64 + lane] = make_float2(hre, him);
    }
}
struct ItemLd { bf16x8 ufr[2]; float2 h0; uint2 uw[2]; };
__device__ __forceinline__ void load_item(ItemLd& L, const bf16* Z, const float2* SH, int it, int g, int lane) {
    const int l15 = lane & 15, q4 = lane >> 4; const int b = it / NCH, ch = it % NCH; const size_t t0 = (size_t)b * SEQ + (size_t)ch * LC;
#pragma unroll
    for (int nb = 0; nb < 2; ++nb) { L.ufr[nb] = bf16x8{}; if (q4 < 2) L.ufr[nb] = *(const bf16x8*)(Z + (t0 + 16 * nb + l15) * ZW + ZC_U + g * 16 + 8 * q4);
        L.uw[nb] = *(const uint2*)(Z + (t0 + 16 * nb + l15) * ZW + ZC_U + g * 16 + 4 * q4); }
    L.h0 = SH[((size_t)it * 16 + g) * 64 + lane];
}
__device__ __forceinline__ void pass_b(LAS unsigned char* lds, const bf16* Z, const bf16* S5A, const bf16* S5C, const float2* S5L, const float* dsk, const float2* SH, bf16* YG, int gw, int ngw, int wave, int lane) {
    LAS unsigned char* wl = lds + wave * WBYTES;
    const int g = gw & 15, l15 = lane & 15, q4 = lane >> 4;
    bf16x8 afr[8], cfr[4];
#pragma unroll
    for (int mb = 0; mb < 8; ++mb) { afr[mb] = bf16x8{}; if (q4 < 2) afr[mb] = *(const bf16x8*)(S5A + ((size_t)g * 128 + 16 * mb + l15) * 16 + 8 * q4); }
#pragma unroll
    for (int ks = 0; ks < 4; ++ks) cfr[ks] = *(const bf16x8*)(S5C + ((size_t)g * 16 + l15) * 128 + 32 * ks + 8 * q4);
    const float2 lam = S5L[g * 64 + lane]; const float lre = lam.x, lim = lam.y;
    const float4 dd = *(const float4*)(dsk + g * 16 + 4 * q4);
    const int step = ngw >> 4;
    int it = gw >> 4; if (it >= NB * NCH) return;
    ItemLd cur; load_item(cur, Z, SH, it, g, lane);
    for (; it < NB * NCH; it += step) {
        ItemLd nxt = cur; const bool more = it + step < NB * NCH;
        if (more) load_item(nxt, Z, SH, it + step, g, lane);
        const int b = it / NCH, ch = it % NCH; const size_t t0 = (size_t)b * SEQ + (size_t)ch * LC;
#pragma unroll
        for (int nb = 0; nb < 2; ++nb)
#pragma unroll
            for (int mb = 0; mb < 8; ++mb) { const f32x4 d = __builtin_amdgcn_mfma_f32_16x16x32_bf16(afr[mb], cur.ufr[nb], f32x4{0.f, 0.f, 0.f, 0.f}, 0, 0, 0);
                *(LAS u32x2*)(wl + (16 * nb + l15) * RS + (16 * mb + 4 * q4) * 2) = u32x2{pk2(d[0], d[1]), pk2(d[2], d[3])}; }
        float hre = cur.h0.x, him = cur.h0.y;
        unsigned wk[LC];
#pragma unroll
        for (int k = 0; k < LC; ++k) wk[k] = *(const LAS unsigned*)(wl + k * RS + 4 * lane);
#pragma unroll
        for (int k = 0; k < LC; ++k) { const float bre = __uint_as_float(wk[k] << 16), bim = __uint_as_float(wk[k] & 0xffff0000u);
            const float nre = fmaf(lre, hre, fmaf(-lim, him, bre)), nim = fmaf(lre, him, fmaf(lim, hre, bim)); hre = nre; him = nim; wk[k] = pk2(hre, him); }
#pragma unroll
        for (int k = 0; k < LC; ++k) *(LAS unsigned*)(wl + k * RS + 4 * lane) = wk[k];
#pragma unroll
        for (int nb = 0; nb < 2; ++nb) {
            f32x4 y = f32x4{0.f, 0.f, 0.f, 0.f};
#pragma unroll
            for (int ks = 0; ks < 4; ++ks) { const bf16x8 hfr = *(const LAS bf16x8*)(wl + (16 * nb + l15) * RS + (32 * ks + 8 * q4) * 2); y = __builtin_amdgcn_mfma_f32_16x16x32_bf16(cfr[ks], hfr, y, 0, 0, 0); }
            const size_t t = t0 + 16 * nb + l15; const uint2 uw = cur.uw[nb];
            const float y0 = y[0] + dd.x * __uint_as_float(uw.x << 16), y1 = y[1] + dd.y * __uint_as_float(uw.x & 0xffff0000u),
                        y2 = y[2] + dd.z * __uint_as_float(uw.y << 16), y3 = y[3] + dd.w * __uint_as_float(uw.y & 0xffff0000u);
            *(uint2*)(YG + t * 256 + g * 16 + 4 * q4) = make_uint2(pk2(gelu_f(y0), gelu_f(y1)), pk2(gelu_f(y2), gelu_f(y3)));
        }
        cur = nxt;
    }
}
__device__ __forceinline__ void carry_wg(LAS unsigned char* lds, const float2* S5L, const float2* SE, float2* SH, int item, int wave, int lane) {
    typedef float f32x2v __attribute__((ext_vector_type(2)));
    LAS f32x2v* tot = (LAS f32x2v*)lds;
    const int b = item >> 4, g = item & 15;
    float2 L = S5L[g * 64 + lane];
#pragma unroll
    for (int i = 0; i < 5; ++i) { const float re = L.x * L.x - L.y * L.y, im = 2.f * L.x * L.y; L.x = re; L.y = im; }
    float hre = 0.f, him = 0.f;
    const size_t base = (((size_t)b * NCH + 32 * wave) * 16 + g) * 64 + lane;
    float2 e[32];
#pragma unroll
    for (int c = 0; c < 32; ++c) e[c] = SE[base + (size_t)c * 1024];
#pragma unroll
    for (int c = 0; c < 32; ++c) { const float nre = L.x * hre - L.y * him + e[c].x, nim = L.x * him + L.y * hre + e[c].y; e[c] = make_float2(hre, him); hre = nre; him = nim; }
    tot[wave * 64 + lane] = f32x2v{hre, him};
    float2 LS = L;
#pragma unroll
    for (int i = 0; i < 5; ++i) { const float re = LS.x * LS.x - LS.y * LS.y, im = 2.f * LS.x * LS.y; LS.x = re; LS.y = im; }
    __syncthreads();
    float cre = 0.f, cim = 0.f;
    for (int w = 0; w < wave; ++w) { const f32x2v s = tot[w * 64 + lane]; const float nre = LS.x * cre - LS.y * cim + s.x, nim = LS.x * cim + LS.y * cre + s.y; cre = nre; cim = nim; }
#pragma unroll
    for (int c = 0; c < 32; ++c) { SH[base + (size_t)c * 1024] = make_float2(e[c].x + cre, e[c].y + cim); const float nre = L.x * cre - L.y * cim, nim = L.x * cim + L.y * cre; cre = nre; cim = nim; }
    __syncthreads();
}
}
namespace lruf {
typedef float f32x4 __attribute__((ext_vector_type(4)));
constexpr int LC = 32, NCH = SEQ / LC, XS = 68;
typedef short bf16x8 __attribute__((ext_vector_type(8)));
typedef float f32x4m __attribute__((ext_vector_type(4)));
__device__ __forceinline__ void build_tables(const float* wa, const float* wx, bf16* LWT, int gt, int ngt) {
    for (int i = gt; i < 2 * 4 * 4096; i += ngt) { const int g = i >> 14, h = (i >> 12) & 3, n = (i >> 6) & 63, k = i & 63;
        LWT[i] = f2bf((g ? wx : wa)[(h * 64 + k) * 64 + n]); }
}
__device__ __forceinline__ void pass_a(LAS unsigned char* lds, const bf16* Z, const float* cw, const float* cb, const bf16* LWT, const float* ba, const float* bx, const float* lam,
                                       float* AA, float* BT, float2* LPE, int gw, int ngw, int wave, int lane) {
    LAS float* xt = (LAS float*)lds + wave * (LC * XS);
    const int l15 = lane & 15, q4 = lane >> 4;
    for (int item = gw; item < NB * NCH * 4; item += ngw) {
        const int h = item & 3, bc = item >> 2, b = bc / NCH, ch = bc % NCH;
        const size_t t0 = (size_t)b * SEQ + (size_t)ch * LC;
        bf16x8 afr[2][2];
#pragma unroll
        for (int ks = 0; ks < 2; ++ks) {
            const int c0 = h * 64 + 32 * ks + 8 * q4;
            float w[4][8], bias[8];
#pragma unroll
            for (int j = 0; j < 4; ++j) { const float4 w0 = *(const float4*)(cw + j * 256 + c0), w1 = *(const float4*)(cw + j * 256 + c0 + 4);
                w[j][0] = w0.x; w[j][1] = w0.y; w[j][2] = w0.z; w[j][3] = w0.w; w[j][4] = w1.x; w[j][5] = w1.y; w[j][6] = w1.z; w[j][7] = w1.w; }
            { const float4 b0 = *(const float4*)(cb + c0), b1 = *(const float4*)(cb + c0 + 4); bias[0] = b0.x; bias[1] = b0.y; bias[2] = b0.z; bias[3] = b0.w; bias[4] = b1.x; bias[5] = b1.y; bias[6] = b1.z; bias[7] = b1.w; }
#pragma unroll
            for (int mb = 0; mb < 2; ++mb) {
                const int tk = 16 * mb + l15;
                float xc[8];
#pragma unroll
                for (int e = 0; e < 8; ++e) xc[e] = bias[e];
#pragma unroll
                for (int j = 0; j < 4; ++j) {
                    const int dt = tk - 3 + j;
                    if (ch > 0 || dt >= 0) { float z[8]; unpack8(*(const uint4*)(Z + (size_t)((long)t0 + dt) * ZW + ZC_X + c0), z);
#pragma unroll
                        for (int e = 0; e < 8; ++e) xc[e] = fmaf(w[j][e], z[e], xc[e]); }
                }
                uint4 pk; pk.x = pk2(xc[0], xc[1]); pk.y = pk2(xc[2], xc[3]); pk.z = pk2(xc[4], xc[5]); pk.w = pk2(xc[6], xc[7]);
                afr[mb][ks] = __builtin_bit_cast(bf16x8, pk);
                *(LAS f32x4*)(xt + tk * XS + 32 * ks + 8 * q4) = f32x4{xc[0], xc[1], xc[2], xc[3]};
                *(LAS f32x4*)(xt + tk * XS + 32 * ks + 8 * q4 + 4) = f32x4{xc[4], xc[5], xc[6], xc[7]};
            }
        }
        const bf16* wt = LWT + (size_t)h * 4096;
        float cp[4], ce[4];
#pragma unroll
        for (int nb = 0; nb < 4; ++nb) {
            const int c = h * 64 + 16 * nb + l15;
            const bf16x8 ba0 = *(const bf16x8*)(wt + (size_t)(16 * nb + l15) * 64 + 8 * q4), ba1 = *(const bf16x8*)(wt + (size_t)(16 * nb + l15) * 64 + 32 + 8 * q4);
            const bf16x8 bx0 = *(const bf16x8*)(wt + 16384 + (size_t)(16 * nb + l15) * 64 + 8 * q4), bx1 = *(const bf16x8*)(wt + 16384 + (size_t)(16 * nb + l15) * 64 + 32 + 8 * q4);
            const float bav = ba[c], bxv = bx[c], lsg8 = -8.f * log1pf(__expf(-lam[c]));
            float segp[2], sege[2];
#pragma unroll
            for (int mb = 0; mb < 2; ++mb) {
                f32x4m ra = f32x4m{0.f, 0.f, 0.f, 0.f}, rx = f32x4m{0.f, 0.f, 0.f, 0.f};
                ra = __builtin_amdgcn_mfma_f32_16x16x32_bf16(afr[mb][0], ba0, ra, 0, 0, 0); ra = __builtin_amdgcn_mfma_f32_16x16x32_bf16(afr[mb][1], ba1, ra, 0, 0, 0);
                rx = __builtin_amdgcn_mfma_f32_16x16x32_bf16(afr[mb][0], bx0, rx, 0, 0, 0); rx = __builtin_amdgcn_mfma_f32_16x16x32_bf16(afr[mb][1], bx1, rx, 0, 0, 0);
                float hl = 0.f, pl = 1.f;
#pragma unroll
                for (int r = 0; r < 4; ++r) {
                    const int tk = 16 * mb + 4 * q4 + r;
                    const float xv = xt[tk * XS + 16 * nb + l15];
                    const float rr = __frcp_rn(1.f + __expf(-(ra[r] + bav))), ig = __frcp_rn(1.f + __expf(-(rx[r] + bxv)));
                    const float av = __expf(rr * lsg8), bt = sqrtf(fmaxf(1.f - av * av, 0.f)) * (ig * xv);
                    AA[(t0 + tk) * 256 + c] = av; BT[(t0 + tk) * 256 + c] = bt;
                    hl = av * hl + bt; pl *= av;
                }
                segp[mb] = pl; sege[mb] = hl;
            }
            float P = 1.f, E = 0.f;
#pragma unroll
            for (int mb = 0; mb < 2; ++mb)
#pragma unroll
                for (int j = 0; j < 4; ++j) { const float pj = __shfl(segp[mb], 16 * j + l15), ej = __shfl(sege[mb], 16 * j + l15); E = pj * E + ej; P *= pj; }
            cp[nb] = P; ce[nb] = E;
        }
        if (q4 == 0) {
#pragma unroll
            for (int nb = 0; nb < 4; ++nb) LPE[(size_t)bc * 256 + h * 64 + 16 * nb + l15] = make_float2(cp[nb], ce[nb]);
        }
    }
}
__device__ __forceinline__ void carry_wg(LAS unsigned char* lds, const float2* LPE, float* LH, int item, int wave, int lane) {
    typedef float f32x2v __attribute__((ext_vector_type(2)));
    LAS f32x2v* tot = (LAS f32x2v*)lds;
    const int b = item >> 2, ch = (item & 3) * 64 + lane;
    const size_t base = ((size_t)b * NCH + 32 * wave) * 256 + ch;
    float2 pe[32];
#pragma unroll
    for (int c = 0; c < 32; ++c) pe[c] = LPE[base + (size_t)c * 256];
    float h = 0.f, prod = 1.f;
#pragma unroll
    for (int c = 0; c < 32; ++c) { const float p = pe[c].x, e = pe[c].y; pe[c] = make_float2(prod, h); h = p * h + e; prod *= p; }
    tot[wave * 64 + lane] = f32x2v{prod, h};
    __syncthreads();
    float cin = 0.f;
    for (int w = 0; w < wave; ++w) { const f32x2v s = tot[w * 64 + lane]; cin = s.x * cin + s.y; }
#pragma unroll
    for (int c = 0; c < 32; ++c) LH[base + (size_t)c * 256] = pe[c].y + pe[c].x * cin;
    __syncthreads();
}
__device__ __forceinline__ void pass_b(const float* AA, const float* BT, const float* LH, const bf16* Z, bf16* ROUT, int ldr, float* MSS, int gt, int ngt) {
    for (int i = gt; i < NB * NCH * 256; i += ngt) { const int c = i & 255, bc = i >> 8; const size_t t0 = (size_t)bc * LC;
        float h = LH[i];
        float av[LC], bv[LC]; bf16 gz[LC];
#pragma unroll
        for (int k = 0; k < LC; ++k) { const size_t t = t0 + k; av[k] = AA[t * 256 + c]; bv[k] = BT[t * 256 + c]; gz[k] = Z[t * ZW + ZC_G + c]; }
#pragma unroll
        for (int k = 0; k < LC; ++k) { h = fmaf(av[k], h, bv[k]); const bf16 ob = f2bf(h * gelu_f(bf2f(gz[k]))); ROUT[(t0 + k) * ldr + c] = ob;
            const float of = bf2f(ob); const float ss = wave_sum(of * of);
            if ((c & 63) == 0) MSS[(t0 + k) * 12 + 8 + (c >> 6)] = ss; } }
}
}
namespace pgf {
typedef float f32x2 __attribute__((ext_vector_type(2)));
typedef unsigned u32x4 __attribute__((ext_vector_type(4)));
constexpr float USCALE = 64.f, VSCALE = 5.5f;
__device__ __forceinline__ unsigned pack4_fp8(float a, float b, float c, float d) {
    int w = __builtin_amdgcn_cvt_pk_fp8_f32(a, b, 0, false); w = __builtin_amdgcn_cvt_pk_fp8_f32(c, d, w, true); return (unsigned)w; }
constexpr int ROWB = 1024, VOFF = 512;
__device__ __forceinline__ unsigned enc6(float x) {
    const float a = fminf(fabsf(x), 7.5f);
    const float c = a < 2.f ? __builtin_rintf(a * 8.f) : (a < 4.f ? 16.f + __builtin_rintf((a - 2.f) * 4.f) : 24.f + __builtin_rintf((a - 4.f) * 2.f));
    return (unsigned)(int)c | (x < 0.f ? 32u : 0u);
}
__device__ __forceinline__ unsigned enc4(float x) {
    const float a = fminf(fabsf(x), 6.f);
    const float c = a < 2.f ? __builtin_rintf(a * 2.f) : (a < 4.f ? 4.f + __builtin_rintf(a - 2.f) : 6.f + __builtin_rintf((a - 4.f) * 0.5f));
    return (unsigned)(int)c | (x < 0.f ? 8u : 0u);
}
__device__ __forceinline__ void convert4(const float* in, unsigned char* out, size_t nrows, float scale, int gt, int ngt) {
    typedef float f32x4v __attribute__((ext_vector_type(4)));
    const size_t n4 = nrows * 256; const f32x4v* in4 = (const f32x4v*)in;
    for (size_t i0 = (size_t)gt; i0 < n4; i0 += (size_t)ngt * 8) {
        f32x4v v[8];
#pragma unroll
        for (int k = 0; k < 8; ++k) { const size_t i = i0 + (size_t)k * ngt; v[k] = f32x4v{0.f, 0.f, 0.f, 0.f}; if (i < n4) v[k] = __builtin_nontemporal_load(in4 + i); }
#pragma unroll
        for (int k = 0; k < 8; ++k) { const size_t i = i0 + (size_t)k * ngt;
            unsigned c = 0u;
            c = __builtin_amdgcn_cvt_scalef32_pk_fp4_f32(c, v[k].x * scale, v[k].y * scale, 1.0f, 0); c = __builtin_amdgcn_cvt_scalef32_pk_fp4_f32(c, v[k].z * scale, v[k].w * scale, 1.0f, 1); c &= 0xffffu;
            const unsigned nb = (unsigned)__builtin_amdgcn_mov_dpp((int)c, 0xB1, 0xF, 0xF, true);
            if (!(gt & 1) && i < n4) { const size_t row = i >> 8; *(unsigned*)(out + row * ROWB + 2u * (unsigned)(i & 255)) = c | (nb << 16); }
        }
    }
}
template <bool PERMU> __device__ __forceinline__ void convert6(const float* in, unsigned char* out, size_t nrows, float scale, int gt, int ngt) {
    typedef float f32x4v __attribute__((ext_vector_type(4)));
    const size_t n4 = nrows * 256; const f32x4v* in4 = (const f32x4v*)in; const int j = gt & 3;
    for (size_t i0 = (size_t)gt; i0 < n4; i0 += (size_t)ngt * 4) {
        f32x4v v[4];
#pragma unroll
        for (int k = 0; k < 4; ++k) { const size_t i = i0 + (size_t)k * ngt; v[k] = f32x4v{0.f, 0.f, 0.f, 0.f}; if (i < n4) v[k] = __builtin_nontemporal_load(in4 + i); }
#pragma unroll
        for (int k = 0; k < 4; ++k) { const size_t i = i0 + (size_t)k * ngt;
            const unsigned c = enc6(v[k].x * scale) | (enc6(v[k].y * scale) << 6) | (enc6(v[k].z * scale) << 12) | (enc6(v[k].w * scale) << 18);
            const unsigned nb = (unsigned)__builtin_amdgcn_mov_dpp((int)c, 0xF9, 0xF, 0xF, true);
            const unsigned dw = (c >> (8 * j)) | (nb << (24 - 8 * j));
            if (j < 3 && i < n4) { const size_t row = i >> 8; const unsigned D = 3u * (unsigned)((i & 255) >> 2) + (unsigned)j; unsigned off = 4u * D;
                if (PERMU) {
                    const unsigned m = D / 6u, d = D - 6u * m, c = 24u * (m >> 3) + 4u * d; off = 128u * (c >> 4) + 16u * (4u * ((m >> 2) & 1u) + (m & 3u)) + (c & 15u); }
                *(unsigned*)(out + row * ROWB + off) = dw; }
        }
    }
}
__device__ __forceinline__ void unpack16(const u32x4 w, float* o) {
#pragma unroll
    for (int d = 0; d < 4; ++d) { const f32x2 lo = __builtin_amdgcn_cvt_pk_f32_fp8((int)w[d], false), hi = __builtin_amdgcn_cvt_pk_f32_fp8((int)w[d], true);
        o[4 * d] = lo.x; o[4 * d + 1] = lo.y; o[4 * d + 2] = hi.x; o[4 * d + 3] = hi.y; }
}
__device__ __forceinline__ void convert(const float* in, unsigned char* out8, size_t n, float scale, int gt, int ngt) {
    typedef float f32x4v __attribute__((ext_vector_type(4)));
    const size_t n4 = n / 4; const f32x4v* in4 = (const f32x4v*)in; unsigned* o32 = (unsigned*)out8;
    for (size_t i0 = (size_t)gt; i0 < n4; i0 += (size_t)ngt * 4) {
        f32x4v v[4];
#pragma unroll
        for (int k = 0; k < 4; ++k) { const size_t i = i0 + (size_t)k * ngt; v[k] = f32x4v{0.f, 0.f, 0.f, 0.f}; if (i < n4) v[k] = __builtin_nontemporal_load(in4 + i); }
#pragma unroll
        for (int k = 0; k < 4; ++k) { const size_t i = i0 + (size_t)k * ngt; if (i < n4) o32[(i >> 8) * (ROWB / 4) + (i & 255)] = pack4_fp8(v[k].x * scale, v[k].y * scale, v[k].z * scale, v[k].w * scale); }
    }
}
}
namespace tk {
__device__ __forceinline__ float row_rstd(const float* ROWSS, size_t t) { const float4* p = (const float4*)(ROWSS + t * 16); const float4 a = p[0], b = p[1], c = p[2], d = p[3];
    const float s = (((a.x + a.y) + (a.z + a.w)) + ((b.x + b.y) + (b.z + b.w))) + (((c.x + c.y) + (c.z + c.w)) + ((d.x + d.y) + (d.z + d.w))); return rsqrtf(s * (1.f / DM) + EPS); }
typedef short bf16x8 __attribute__((ext_vector_type(8)));
typedef float f32x4 __attribute__((ext_vector_type(4)));
__device__ const unsigned char PAIR_TAB[64] = {
    0x00,0x01,0x02,0x03,0x04,0x05,0x06,0x07,0x08,0x09,0x0a,0x0b,0x0c,0x0d,0x0e,0x0f, 0x10,0x11,0x12,0x13,0x14,0x15,0x16,0x17, 0x20,0x21,0x22,0x23,0x24, 0x30,0x31,0x32,0x33,
    0x40,0x41,0x42, 0x50,0x51, 0x60,0x61, 0x70,0x71, 0x80,0x90,0xa0,0xb0,0xc0,0xd0,0xe0,0xf0, 0,0,0,0,0,0,0,0,0,0,0,0,0,0};
template <int CTRL> __device__ __forceinline__ float dppf(float v) { return __builtin_bit_cast(float, __builtin_amdgcn_update_dpp(0, __builtin_bit_cast(int, v), CTRL, 0xf, 0xf, true)); }
__device__ __forceinline__ float vmax(float a, float b) { float r; asm("v_max_f32_e32 %0, %1, %2" : "=v"(r) : "v"(a), "v"(b)); return r; }
__device__ __forceinline__ float vmin(float a, float b) { float r; asm("v_min_f32_e32 %0, %1, %2" : "=v"(r) : "v"(a), "v"(b)); return r; }
#define TK_ST(ctrl) "v_max_f32_dpp %0, %0, %0 " ctrl " row_mask:0xf bank_mask:0xf\n\tv_max_f32_dpp %1, %1, %1 " ctrl " row_mask:0xf bank_mask:0xf\n\tv_max_f32_dpp %2, %2, %2 " ctrl " row_mask:0xf bank_mask:0xf\n\tv_max_f32_dpp %3, %3, %3 " ctrl " row_mask:0xf bank_mask:0xf\n\t"
__device__ __forceinline__ void rmax16x4(float& a, float& b, float& c, float& d) {
    asm("s_nop 1\n\t" TK_ST("quad_perm:[1,0,3,2]") TK_ST("quad_perm:[2,3,0,1]") TK_ST("row_half_mirror") TK_ST("row_mirror") "s_nop 0" : "+v"(a), "+v"(b), "+v"(c), "+v"(d));
}
#undef TK_ST
__device__ __forceinline__ float rsum16(float v) { v += dppf<0xB1>(v); v += dppf<0x4E>(v); v += dppf<0x141>(v); v += dppf<0x140>(v); return v; }
#define TK_CX(a, b) do { const float hi_ = vmax(a, b), lo_ = vmin(a, b); a = hi_; b = lo_; } while (0)
__device__ __forceinline__ float packkey(float v, unsigned id, unsigned mask) { return __uint_as_float((__float_as_uint(v) & ~mask) | id); }
__device__ __forceinline__ void select16(float (&k)[4][8], float (&top)[4], int l15) {
    const float NEG = -__builtin_inff();
#pragma unroll
    for (int r = 0; r < 4; ++r) {
        TK_CX(k[r][0], k[r][1]); TK_CX(k[r][2], k[r][3]); TK_CX(k[r][4], k[r][5]); TK_CX(k[r][6], k[r][7]);
        TK_CX(k[r][0], k[r][2]); TK_CX(k[r][1], k[r][3]); TK_CX(k[r][4], k[r][6]); TK_CX(k[r][5], k[r][7]);
        TK_CX(k[r][1], k[r][2]); TK_CX(k[r][5], k[r][6]);
        TK_CX(k[r][0], k[r][4]); TK_CX(k[r][1], k[r][5]); TK_CX(k[r][2], k[r][6]); TK_CX(k[r][3], k[r][7]);
        TK_CX(k[r][2], k[r][4]); TK_CX(k[r][3], k[r][5]);
        TK_CX(k[r][1], k[r][2]); TK_CX(k[r][3], k[r][4]); TK_CX(k[r][5], k[r][6]);
        top[r] = NEG;
    }
#pragma unroll
    for (int i = 0; i < 16; ++i) {
        float wr[4] = {k[0][0], k[1][0], k[2][0], k[3][0]};
        rmax16x4(wr[0], wr[1], wr[2], wr[3]);
#pragma unroll
        for (int r = 0; r < 4; ++r) {
            const float w = wr[r];
            if (l15 == i) top[r] = w;
            const bool hit = (k[r][0] == w);
#pragma unroll
            for (int e = 0; e < 7; ++e) k[r][e] = hit ? k[r][e + 1] : k[r][e];
            k[r][7] = hit ? NEG : k[r][7];
        }
    }
}
constexpr int SK_OFF = 16384, SK_ROWB = 272, PT_OFF = 86016, GN_OFF = 86272;
constexpr int SK_DUMMY = 0;
template <int EMASK> __device__ __forceinline__ void topk_item(int item, const bf16* QP, const LAS unsigned char* skl, const float* ROWSS, int lane_in, int (&idr)[4], float (&gtr)[4]) {
    const float NEG = -__builtin_inff();
    int lane = lane_in; asm volatile("" : "+v"(lane));
    const int l15 = lane & 15, q4 = lane >> 4, gbase = 16 * q4;
    unsigned pcs[4];
#pragma unroll
    for (int j = 0; j < 4; ++j) pcs[j] = ((const LAS unsigned*)(skl + (PT_OFF - SK_OFF)))[l15 + 16 * j];
    {
        const size_t R0 = (size_t)item * 16;
        const float rstd_g = row_rstd(ROWSS, (size_t)item * 2 + (q4 >> 1));
        const bf16* qrow = QP + (R0 + l15) * 256 + 8 * q4;
        float topA[4], topB[4];
#pragma unroll
        for (int p = 0; p < 2; ++p) {
            f32x4 acc[8];
#pragma unroll
            for (int nb = 0; nb < 8; ++nb) acc[nb] = f32x4{0.f, 0.f, 0.f, 0.f};
            bf16x8 afr[4];
#pragma unroll
            for (int ks = 0; ks < 4; ++ks) afr[ks] = *(const bf16x8*)(qrow + p * 128 + 32 * ks);
#pragma unroll 1
            for (int ks = 0; ks < 4; ++ks) {
                const bf16x8 af = ks == 0 ? afr[0] : ks == 1 ? afr[1] : ks == 2 ? afr[2] : afr[3];
#pragma unroll
                for (int nb = 0; nb < 8; ++nb) {
                    const bf16x8 bfr = *(const LAS bf16x8*)(skl + (p * 128 + 16 * nb + l15) * SK_ROWB + 64 * ks + 16 * q4);
                    acc[nb] = __builtin_amdgcn_mfma_f32_16x16x32_bf16(af, bfr, acc[nb], 0, 0, 0);
                }
            }
            float k[4][8];
#pragma unroll
            for (int r = 0; r < 4; ++r)
#pragma unroll
                for (int nb = 0; nb < 8; ++nb) k[r][nb] = packkey(acc[nb][r], (unsigned)(16 * nb + l15), 127u);
            if (p == 0) select16(k, topA, l15); else select16(k, topB, l15);
        }
        float c[4][4];
#pragma unroll
        for (int r = 0; r < 4; ++r) {
#pragma unroll
            for (int j = 0; j < 4; ++j) {
                const float s0 = __shfl(topA[r], gbase + (int)(pcs[j] >> 4)), s1 = __shfl(topB[r], gbase + (int)(pcs[j] & 15));
                c[r][j] = (l15 + 16 * j < 50) ? packkey(s0 + s1, (unsigned)(l15 + 16 * j), 63u) : NEG;
            }
            TK_CX(c[r][0], c[r][1]); TK_CX(c[r][2], c[r][3]); TK_CX(c[r][0], c[r][2]); TK_CX(c[r][1], c[r][3]); TK_CX(c[r][1], c[r][2]);
        }
        float win[4], w0[4];
#pragma unroll
        for (int r = 0; r < 4; ++r) { win[r] = NEG; w0[r] = 0.f; }
#pragma unroll
        for (int i = 0; i < 16; ++i) {
            float wr[4] = {c[0][0], c[1][0], c[2][0], c[3][0]};
            rmax16x4(wr[0], wr[1], wr[2], wr[3]);
#pragma unroll
            for (int r = 0; r < 4; ++r) {
                const float w = wr[r];
                if (i == 0) w0[r] = w;
                if (l15 == i) win[r] = w;
                { const bool hit = (c[r][0] == w); c[r][0] = hit ? c[r][1] : c[r][0]; c[r][1] = hit ? c[r][2] : c[r][1]; c[r][2] = hit ? c[r][3] : c[r][2]; c[r][3] = hit ? NEG : c[r][3]; }
            }
        }
#pragma unroll
        for (int r = 0; r < 4; ++r) {
            const unsigned pcw = ((const LAS unsigned*)(skl + (PT_OFF - SK_OFF)))[__float_as_uint(win[r]) & 63u];
            const int i0 = (int)(__float_as_uint(__shfl(topA[r], gbase + (int)(pcw >> 4))) & 127u), i1 = (int)(__float_as_uint(__shfl(topB[r], gbase + (int)(pcw & 15))) & 127u);
            const float e = __expf((win[r] - w0[r]) * rstd_g); const float sum = rsum16(e);
            idr[r] = (i0 * 128 + i1) & EMASK; gtr[r] = e / sum;
        }
    }
}
template <int SKIP> __device__ __forceinline__ void gather_item(int item, const int (&idr)[4], const float (&gtr)[4], bf16* HN, const unsigned char* PU8, const unsigned char* PV8, float* X, float* Xout,
                                                               const float* ROWSS, const float* gnext, LAS unsigned char* wl, LAS unsigned char* wl_base, int lane_in) {
    int lane = lane_in; asm volatile("" : "+v"(lane));
    const int l15 = lane & 15, q4 = lane >> 4;
    {
        {
            typedef float f32x2 __attribute__((ext_vector_type(2))); typedef unsigned u32x2v __attribute__((ext_vector_type(2))); typedef int i32x6 __attribute__((ext_vector_type(6))); typedef int i32x8 __attribute__((ext_vector_type(8))); typedef float f32x32 __attribute__((ext_vector_type(32)));
            LAS unsigned char* img = wl;
#pragma unroll 1
            for (int tau = 0; tau < 2; ++tau) {
                const size_t t = (size_t)item * 2 + tau;
                const float rstd_t = row_rstd(ROWSS, t);
#define TK_SEL4(arr, ri) ((ri) == 0 ? arr[0] : (ri) == 1 ? arr[1] : (ri) == 2 ? arr[2] : arr[3])
#define TK_LOADA(bi_) do { const int ri_ = (bi_) >> 1, srcb_ = 32 * tau + 16 * ((bi_) & 1); const int idv_ = TK_SEL4(idr, ri_); \
        const int e0_ = __shfl(idv_, srcb_ + (l15 & 7)), e1_ = __shfl(idv_, srcb_ + 8 + (l15 & 7)); \
        const unsigned char* p0_ = PU8 + (unsigned)(e0_ * pgf::ROWB + 64 * (l15 >> 3) + 16 * q4); const unsigned char* p1_ = PU8 + (unsigned)(e1_ * pgf::ROWB + 64 * (l15 >> 3) + 16 * q4); \
        _Pragma("unroll") for (int j = 0; j < 4; ++j) { aw[j] = (SKIP & 8) ? pgf::u32x4{(unsigned)e0_, 1u, 2u, 3u} : *(const pgf::u32x4*)(p0_ + 128 * j); \
                                                       aw[4 + j] = (SKIP & 8) ? pgf::u32x4{(unsigned)e1_, 1u, 2u, 3u} : *(const pgf::u32x4*)(p1_ + 128 * j); } } while (0)
#define TK_LOADV(bi_) do { const int ri_ = (bi_) >> 1, srcb_ = 32 * tau + 16 * ((bi_) & 1); const int idv_ = TK_SEL4(idr, ri_); \
        _Pragma("unroll") for (int e = 0; e < 16; ++e) { const int eid = __builtin_amdgcn_readlane(idv_, srcb_ + e); vw[e] = (SKIP & 16) ? u32x2v{(unsigned)eid, 1u} : *(const u32x2v*)(PV8 + (unsigned)(eid * pgf::ROWB + 8 * lane)); } } while (0)
                const uint4 hraw0 = *(const uint4*)(HN + t * DM + 16 * lane), hraw1 = *(const uint4*)(HN + t * DM + 16 * lane + 8);
                pgf::u32x4 aw[8];
                TK_LOADA(0);
                float4 xv[4];
                { const float4* xi0 = (const float4*)(X + t * DM + 16 * lane);
#pragma unroll
                  for (int q = 0; q < 4; ++q) xv[q] = xi0[q]; }
                {
                    float hn[16]; unpack8(hraw0, hn); unpack8(hraw1, hn + 8);
                    float h1[16]; pgf::u32x4 w1, w2;
#pragma unroll
                    for (int d = 0; d < 4; ++d) { w1[d] = pgf::pack4_fp8(hn[4 * d] * 8.f, hn[4 * d + 1] * 8.f, hn[4 * d + 2] * 8.f, hn[4 * d + 3] * 8.f);
                        const f32x2 lo = __builtin_amdgcn_cvt_pk_f32_fp8((int)w1[d], false), hi = __builtin_amdgcn_cvt_pk_f32_fp8((int)w1[d], true);
                        h1[4 * d] = lo.x; h1[4 * d + 1] = lo.y; h1[4 * d + 2] = hi.x; h1[4 * d + 3] = hi.y; }
#pragma unroll
                    for (int d = 0; d < 4; ++d) w2[d] = pgf::pack4_fp8((hn[4 * d] * 8.f - h1[4 * d]) * 16.f, (hn[4 * d + 1] * 8.f - h1[4 * d + 1]) * 16.f, (hn[4 * d + 2] * 8.f - h1[4 * d + 2]) * 16.f, (hn[4 * d + 3] * 8.f - h1[4 * d + 3]) * 16.f);
                    *(LAS pgf::u32x4*)(img + (lane >> 1) * 64 + (lane & 1) * 16) = w1;
                    *(LAS pgf::u32x4*)(img + (lane >> 1) * 64 + 32 + (lane & 1) * 16) = w2;
                }
                f32x2 y2[8];
#pragma unroll
                for (int e = 0; e < 8; ++e) y2[e] = f32x2{0.f, 0.f};
#pragma unroll 1
                for (int bi = 0; bi < 8; ++bi) {
                    const int ri = bi >> 1, srcb = 32 * tau + 16 * (bi & 1);
                    u32x2v vw[16];
                    TK_LOADV(bi);
                    f32x4 acc0 = f32x4{0.f, 0.f, 0.f, 0.f}, acc1 = f32x4{0.f, 0.f, 0.f, 0.f};
                    int boff = ((l15 >> 1) & 1) * 256 + (q4 >> 1) * 64 + (l15 & 1) * 32 + (q4 & 1) * 16; asm volatile("" : "+v"(boff));
                    if (SKIP & 2) {
#pragma unroll
                        for (int j = 0; j < 8; ++j) acc0[0] += __uint_as_float(((aw[j].x ^ aw[j].y ^ aw[j].z ^ aw[j].w) & 0x007fffffu) | 0x3f800000u);
                    } else
#pragma unroll
                    for (int s4 = 0; s4 < 4; ++s4) {
                        const pgf::u32x4 bl = *(const LAS pgf::u32x4*)(img + boff + s4 * 512), bh = *(const LAS pgf::u32x4*)(img + boff + s4 * 512 + 128);
                        const i32x8 bfrag = i32x8{(int)bl.x, (int)bl.y, (int)bl.z, (int)bl.w, (int)bh.x, (int)bh.y, (int)bh.z, (int)bh.w};
                        const i32x8 a0 = i32x8{(int)aw[s4].x, (int)aw[s4].y, (int)aw[s4].z, (int)aw[s4].w, 0, 0, 0, 0};
                        const i32x8 a1 = i32x8{(int)aw[4 + s4].x, (int)aw[4 + s4].y, (int)aw[4 + s4].z, (int)aw[4 + s4].w, 0, 0, 0, 0};
                        acc0 = __builtin_amdgcn_mfma_scale_f32_16x16x128_f8f6f4(bfrag, a0, acc0, 0, 4, 0, 127, 0, 127);
                        acc1 = __builtin_amdgcn_mfma_scale_f32_16x16x128_f8f6f4(bfrag, a1, acc1, 0, 4, 0, 127, 0, 127);
                    }
                    if (bi + 1 < 8) TK_LOADA(bi + 1);
                    float dsel;
                    {   const bool up = l15 >= 8; const float c0 = 1.f / (pgf::USCALE * 8.f), c1 = 1.f / (pgf::USCALE * 128.f);
                        float p0 = up ? (acc0[2] * c0 + acc0[3] * c1) : (acc0[0] * c0 + acc0[1] * c1), p1 = up ? (acc1[2] * c0 + acc1[3] * c1) : (acc1[0] * c0 + acc1[1] * c1);
                        p0 += dppf<0x128>(p0); p1 += dppf<0x128>(p1);
                        dsel = up ? p1 : p0; }
                    const float gtv = TK_SEL4(gtr, ri);
                    const float wv = gtv * ((SKIP & 4) ? dsel * rstd_t : gelu_f(dsel * rstd_t)) * (1.f / pgf::VSCALE);
                    if (SKIP & 1) {
#pragma unroll
                        for (int e = 0; e < 16; ++e) y2[e & 7].x += __uint_as_float(((vw[e][0] ^ vw[e][1]) & 0x007fffffu) | 0x3f800000u) * wv;
                    } else
#pragma unroll
                    for (int e = 0; e < 16; ++e) {
                        const float we = __builtin_bit_cast(float, __builtin_amdgcn_readlane(__builtin_bit_cast(int, wv), srcb + e)); const f32x2 w2v = f32x2{we, we};
#pragma unroll
                        for (int d = 0; d < 2; ++d) {
                            y2[4 * d] = __builtin_elementwise_fma(w2v, __builtin_amdgcn_cvt_scalef32_pk_f32_fp4(vw[e][d], 1.0f, 0), y2[4 * d]);
                            y2[4 * d + 1] = __builtin_elementwise_fma(w2v, __builtin_amdgcn_cvt_scalef32_pk_f32_fp4(vw[e][d], 1.0f, 1), y2[4 * d + 1]);
                            y2[4 * d + 2] = __builtin_elementwise_fma(w2v, __builtin_amdgcn_cvt_scalef32_pk_f32_fp4(vw[e][d], 1.0f, 2), y2[4 * d + 2]);
                            y2[4 * d + 3] = __builtin_elementwise_fma(w2v, __builtin_amdgcn_cvt_scalef32_pk_f32_fp4(vw[e][d], 1.0f, 3), y2[4 * d + 3]); }
                    }
                }
#undef TK_LOADA
#undef TK_LOADV
#undef TK_SEL4
                float y[16];
#pragma unroll
                for (int e = 0; e < 8; ++e) { y[2 * e] = y2[e].x; y[2 * e + 1] = y2[e].y; }
                float4* xo = (float4*)(Xout + t * DM + 16 * lane);
                float ssn = 0.f;
#pragma unroll
                for (int q = 0; q < 4; ++q) { float4 pp = xv[q]; pp.x += y[4 * q]; pp.y += y[4 * q + 1]; pp.z += y[4 * q + 2]; pp.w += y[4 * q + 3]; xo[q] = pp;
                    y[4 * q] = pp.x; y[4 * q + 1] = pp.y; y[4 * q + 2] = pp.z; y[4 * q + 3] = pp.w; ssn += (pp.x * pp.x + pp.y * pp.y) + (pp.z * pp.z + pp.w * pp.w); }
                if (gnext) {
                    const float rn = rsqrtf(wave_sum(ssn) * (1.f / DM) + EPS); const LAS f32x4* gp = (const LAS f32x4*)(wl_base + GN_OFF) + 4 * lane;
                    uint4 o0, o1; const f32x4 ga = gp[0], gb = gp[1], gc = gp[2], gd4 = gp[3];
                    o0.x = pk2(y[0] * rn * ga.x, y[1] * rn * ga.y); o0.y = pk2(y[2] * rn * ga.z, y[3] * rn * ga.w); o0.z = pk2(y[4] * rn * gb.x, y[5] * rn * gb.y); o0.w = pk2(y[6] * rn * gb.z, y[7] * rn * gb.w);
                    o1.x = pk2(y[8] * rn * gc.x, y[9] * rn * gc.y); o1.y = pk2(y[10] * rn * gc.z, y[11] * rn * gc.w); o1.z = pk2(y[12] * rn * gd4.x, y[13] * rn * gd4.y); o1.w = pk2(y[14] * rn * gd4.z, y[15] * rn * gd4.w);
                    *(uint4*)(HN + t * DM + 16 * lane) = o0; *(uint4*)(HN + t * DM + 16 * lane + 8) = o1;
                }
            }
        }
    }
}

template <int EMASK, int SKIP> __device__ __forceinline__ void peer_phase(LAS unsigned char* lds, const bf16* QP, const bf16* SUBKB, bf16* HN, const unsigned char* PU8, const unsigned char* PV8, float* X, float* Xout,
                                                                          const float* ROWSS, const float* gnext, int G, int bid, int tid) {
    const int lane = tid & 63, wave = __builtin_amdgcn_readfirstlane(tid >> 6);
    LAS unsigned char* img = lds + wave * 2048;
    {
        pgf::u32x4 tmp[8];
#pragma unroll
        for (int j = 0; j < 8; ++j) tmp[j] = *(const pgf::u32x4*)((const unsigned char*)SUBKB + (size_t)(tid + 512 * j) * 16);
#pragma unroll
        for (int j = 0; j < 8; ++j) { const int ch = tid + 512 * j; *(LAS pgf::u32x4*)(lds + SK_OFF + (ch >> 4) * SK_ROWB + (ch & 15) * 16) = tmp[j]; }
        if (tid < 64) ((LAS unsigned*)(lds + PT_OFF))[tid] = PAIR_TAB[tid];
        if (gnext) { const float4 gv = ((const float4*)gnext)[tid & 255]; if (tid < 256) ((LAS f32x4*)(lds + GN_OFF))[tid] = f32x4{gv.x, gv.y, gv.z, gv.w}; }
        __syncthreads();
    }
    const LAS unsigned char* skl = lds + SK_OFF;
    for (int item = wave * G + bid; item < T / 2; item += 8 * G) {
        int idr[4]; float gtr[4];
        topk_item<EMASK>(item, QP, skl, ROWSS, lane, idr, gtr);
        if (SKIP & 32) { if ((idr[0] ^ idr[1] ^ idr[2] ^ idr[3]) == 0x7fffffff) Xout[lane] = gtr[0] + gtr[1] + gtr[2] + gtr[3]; continue; }
        gather_item<SKIP>(item, idr, gtr, HN, PU8, PV8, X, Xout, ROWSS, gnext, img, lds, lane);
    }
}
#undef TK_CX
}
constexpr int NWAVES = 8, NTHR = 512;
constexpr int RING_BYTES = 131072, MISC_OFF = RING_BYTES + 320, LDS_BYTES = 147456;
struct Args { const void* in[34]; float* out; unsigned char* ws; int ph_lo, ph_hi; };
struct Ctx { LAS unsigned char* lds; int tid, lane, wave, G, bid, gw, ngw, gt, ngt; };
#define INF(i) ((const float*)a.in[i])
#define WSP(T_, off) ((T_*)(a.ws + (off)))

__device__ __forceinline__ void ph_rowprep(const Ctx& c, const float* x, const float* gain, bf16* XB);
__device__ __forceinline__ void prep_tile(const float* W, int K, int N, bf16* WT, int Nout, int mapmode, int item, LAS float* tile, int lane, const float* kgain = nullptr) {
    const int nbn = Nout / 32, kb = item / nbn, nb = item % nbn, n0 = nb * 32, k0 = kb * 32, tx = lane & 31, ty = lane >> 5;
    const int n = n0 + tx; int src = n;
    if (mapmode == 1) { if (n < 448) src = n; else if (n < 512) src = -1; else src = n - 64; }
    const bool ok = (src >= 0 && src < N);
    float v[16];
#pragma unroll
    for (int i = 0; i < 16; ++i) v[i] = ok ? W[(size_t)(k0 + ty + 2 * i) * N + src] * (kgain ? kgain[k0 + ty + 2 * i] : 1.f) : 0.f;
#pragma unroll
    for (int i = 0; i < 16; ++i) tile[(ty + 2 * i) * 33 + tx] = v[i];
    asm volatile("s_waitcnt lgkmcnt(0)" ::: "memory");
#pragma unroll
    for (int i = 0; i < 16; ++i) WT[(size_t)(n0 + ty + 2 * i) * K + k0 + tx] = f2bf(tile[tx * 33 + ty + 2 * i]);
    asm volatile("s_waitcnt lgkmcnt(0)" ::: "memory");
}
template <class ArgsRef> __device__ __forceinline__ void ph_prep(const ArgsRef& a, const Ctx& c) {
    LAS float* tile = (LAS float*)c.lds + c.wave * (32 * 33);
    constexpr int NT0 = 1280, NT1 = 192, NT2 = 128, NT3 = 64, NT4 = 1024, NT5 = 2048, NTL = NT0 + NT1 + NT2 + NT3 + NT4 + NT5, NTOT = NL * NTL;
    for (int it = c.gw; it < NTOT; it += c.ngw) {
        const int l = it / NTL; int r = it % NTL;
        if (r < NT0) prep_tile(INF(3) + (size_t)l * DM * 1216, DM, 1216, WSP(bf16, WS_WINT) + (size_t)l * ZW * DM, ZW, 1, r, tile, c.lane);
        else if ((r -= NT0) < NT1) prep_tile(INF(5) + (size_t)l * 256 * 768, 256, 768, WSP(bf16, WS_WUQT) + (size_t)l * 768 * 256, 768, 0, r, tile, c.lane);
        else if ((r -= NT1) < NT2) prep_tile(INF(7) + (size_t)l * 128 * 1024, 128, 1024, WSP(bf16, WS_WUKVT) + (size_t)l * 1024 * 128, 1024, 0, r, tile, c.lane);
        else if ((r -= NT2) < NT3) prep_tile(INF(18) + (size_t)l * 65536, 256, 256, WSP(bf16, WS_GLUT) + (size_t)l * 65536, 256, 0, r, tile, c.lane);
        else if ((r -= NT3) < NT4) prep_tile(INF(28) + (size_t)l * DM * DM, DM, DM, WSP(bf16, WS_WOUTT) + (size_t)l * DM * DM, DM, 0, r, tile, c.lane, INF(27) + (size_t)l * DM);
        else { r -= NT4; prep_tile(INF(30) + (size_t)l * DM * 2048, DM, 2048, WSP(bf16, WS_WQT) + (size_t)l * 2048 * DM, 2048, 0, r, tile, c.lane); }
    }
    for (int i = c.gt; i < NL * 32768; i += c.ngt) WSP(bf16, WS_SUBKT)[i] = f2bf(INF(31)[i]);
    pgf::convert4((const float*)a.in[32], WSP(unsigned char, WS_PU), (size_t)NL * 16384, pgf::USCALE, c.gt, c.ngt);
    pgf::convert4((const float*)a.in[33], WSP(unsigned char, WS_PU) + pgf::VOFF, (size_t)NL * 16384, pgf::VSCALE, c.gt, c.ngt);
    for (int i = c.gt; i < T * 32; i += c.ngt) { const int t = i >> 5, j = i & 31;
        const float freq = exp2f(-(float)j * 0.41524101186092033f);
        const float ang = (float)((const int*)a.in[1])[t] * freq; float s, cs; sincos_acc(ang, s, cs);
        WSP(float, WS_COS)[i] = cs; WSP(float, WS_SIN)[i] = s; }
    for (int l = 0; l < NL; ++l)
        s5f::build_tables(INF(10) + l * 1024, INF(11) + l * 1024, INF(12) + l * 16, INF(13) + l * 16384, INF(14) + l * 16384, INF(15) + l * 16384, INF(16) + l * 16384,
                          WSP(bf16, WS_S5A) + (size_t)l * 32768, WSP(bf16, WS_S5C) + (size_t)l * 32768, WSP(float2, WS_S5L) + l * 1024, c.gt, c.ngt);
    for (int l = 0; l < NL; ++l) s5f::build_wtable(INF(10) + l * 1024, INF(11) + l * 1024, INF(12) + l * 16, INF(13) + l * 16384, INF(14) + l * 16384, WSP(bf16, WS_S5W) + (size_t)l * 1048576, c.gt, c.ngt);
    for (int l = 0; l < NL; ++l) lruf::build_tables(INF(22) + l * 16384, INF(24) + l * 16384, WSP(bf16, WS_LWT) + (size_t)l * 32768, c.gt, c.ngt);
    ph_rowprep(c, INF(0), INF(2), WSP(bf16, WS_XB));
}

__device__ __forceinline__ void ph_rowprep(const Ctx& c, const float* x, const float* gain, bf16* XB) {
    for (int row = c.gw; row < T; row += c.ngw) {
        const float4* xr = (const float4*)(x + (size_t)row * DM) + c.lane;
        float4 v[4]; float ss = 0.f;
#pragma unroll
        for (int j = 0; j < 4; ++j) { v[j] = xr[64 * j]; ss += v[j].x * v[j].x + v[j].y * v[j].y + v[j].z * v[j].z + v[j].w * v[j].w; }
        const float rstd = rsqrtf(wave_sum(ss) * (1.f / DM) + EPS);
        uint2* o = (uint2*)(XB + (size_t)row * DM) + c.lane;
#pragma unroll
        for (int j = 0; j < 4; ++j) { const float4 g = ((const float4*)gain)[c.lane + 64 * j];
            o[64 * j] = make_uint2(pk2(v[j].x * rstd * g.x, v[j].y * rstd * g.y), pk2(v[j].z * rstd * g.z, v[j].w * rstd * g.w)); }
    }
}

enum { EPI_BF16 = 0, EPI_F32 = 1, EPI_GLU = 2, EPI_RESID = 3 };
template <int EPI> __device__ __forceinline__ void gemm_simple(const Ctx& c, const bf16* A, int lda, const bf16* Bt, int M, int N, int K, void* C, int ldc, const float* aux0, const bf16* aux1) {
    LAS float* As = (LAS float*)c.lds; LAS float* Bs = As + 16 * 132;
    const int tid = c.tid, tx = tid & 15, ty = tid >> 4, nN = N / 64, ntile = (M / 128) * nN;
    for (int tile = c.bid; tile < ntile; tile += c.G) {
        const int m0 = (tile / nN) * 128, n0 = (tile % nN) * 64;
        float acc[4][4];
#pragma unroll
        for (int i = 0; i < 4; ++i)
#pragma unroll
            for (int j = 0; j < 4; ++j) acc[i][j] = 0.f;
        const int lr = tid >> 2, lk = (tid & 3) * 4;
        for (int k0 = 0; k0 < K; k0 += 16) {
            { const uint2 w = *(const uint2*)(A + (size_t)(m0 + lr) * lda + k0 + lk);
              As[lk * 132 + lr] = __uint_as_float(w.x << 16); As[(lk + 1) * 132 + lr] = __uint_as_float(w.x & 0xffff0000u); As[(lk + 2) * 132 + lr] = __uint_as_float(w.y << 16); As[(lk + 3) * 132 + lr] = __uint_as_float(w.y & 0xffff0000u); }
            if (tid < 256) { const uint2 w = *(const uint2*)(Bt + (size_t)(n0 + lr) * K + k0 + lk);
              Bs[lk * 68 + lr] = __uint_as_float(w.x << 16); Bs[(lk + 1) * 68 + lr] = __uint_as_float(w.x & 0xffff0000u); Bs[(lk + 2) * 68 + lr] = __uint_as_float(w.y << 16); Bs[(lk + 3) * 68 + lr] = __uint_as_float(w.y & 0xffff0000u); }
            __syncthreads();
#pragma unroll
            for (int kk = 0; kk < 16; ++kk) {
                float av[4], bv[4];
#pragma unroll
                for (int i = 0; i < 4; ++i) { av[i] = As[kk * 132 + ty * 4 + i]; bv[i] = Bs[kk * 68 + tx * 4 + i]; }
#pragma unroll
                for (int i = 0; i < 4; ++i)
#pragma unroll
                    for (int j = 0; j < 4; ++j) acc[i][j] += av[i] * bv[j];
            }
            __syncthreads();
        }
#pragma unroll
        for (int i = 0; i < 4; ++i)
#pragma unroll
            for (int j = 0; j < 4; ++j) {
                const int row = m0 + ty * 4 + i, col = n0 + tx * 4 + j; const size_t ix = (size_t)row * ldc + col; const float v = acc[i][j];
                if (EPI == EPI_BF16) ((bf16*)C)[ix] = f2bf(v);
                else if (EPI == EPI_F32) ((float*)C)[ix] = v;
                else if (EPI == EPI_GLU) { const float yg = bf2f(aux1[ix]); ((bf16*)C)[ix] = f2bf(yg * sigmoid_f(v + aux0[col])); }
                else { ((float*)C)[ix] = aux0[ix] + v; }
            }
    }
}

__device__ __forceinline__ void ph_zstats(const Ctx& c, const bf16* Z, const float* qan, const float* kvan, bf16* CQN, bf16* CKVN) {
    const int lane = c.lane; const float4 gq = ((const float4*)qan)[lane]; const float2 gk = ((const float2*)kvan)[lane];
    for (int row0 = 4 * c.gw; row0 < T; row0 += 4 * c.ngw) {
        uint2 wq[4]; u32 wk[4];
#pragma unroll
        for (int i = 0; i < 4; ++i) { const bf16* zr = Z + (size_t)(row0 + i) * ZW; wq[i] = *(const uint2*)(zr + ZC_CQ + 4 * lane); wk[i] = *(const u32*)(zr + ZC_CKV + 2 * lane); }
#pragma unroll
        for (int i = 0; i < 4; ++i) { const int row = row0 + i;
            { const float a0 = __uint_as_float(wq[i].x << 16), a1 = __uint_as_float(wq[i].x & 0xffff0000u), a2 = __uint_as_float(wq[i].y << 16), a3 = __uint_as_float(wq[i].y & 0xffff0000u);
              const float rstd = rsqrtf(wave_sum(a0 * a0 + a1 * a1 + a2 * a2 + a3 * a3) * (1.f / 256) + EPS);
              *(uint2*)(CQN + (size_t)row * 256 + 4 * lane) = make_uint2(pk2(a0 * rstd * gq.x, a1 * rstd * gq.y), pk2(a2 * rstd * gq.z, a3 * rstd * gq.w)); }
            { const float a0 = __uint_as_float(wk[i] << 16), a1 = __uint_as_float(wk[i] & 0xffff0000u);
              const float rstd = rsqrtf(wave_sum(a0 * a0 + a1 * a1) * (1.f / 128) + EPS);
              *(u32*)(CKVN + (size_t)row * 128 + 2 * lane) = pk2(a0 * rstd * gk.x, a1 * rstd * gk.y); } }
    }
}

__device__ __forceinline__ float dpp_rsum16(float v) {
    v += __builtin_bit_cast(float, __builtin_amdgcn_update_dpp(0, __builtin_bit_cast(int, v), 0xB1, 0xf, 0xf, true));
    v += __builtin_bit_cast(float, __builtin_amdgcn_update_dpp(0, __builtin_bit_cast(int, v), 0x4E, 0xf, 0xf, true));
    v += __builtin_bit_cast(float, __builtin_amdgcn_update_dpp(0, __builtin_bit_cast(int, v), 0x141, 0xf, 0xf, true));
    v += __builtin_bit_cast(float, __builtin_amdgcn_update_dpp(0, __builtin_bit_cast(int, v), 0x140, 0xf, 0xf, true));
    return v; }
struct QkLd { uint4 kn8; u32 kx1, kx2; float2 cs, sn; };
__device__ __forceinline__ void qkfin_load(QkLd& L, int t, int lane, const bf16* KVRAW, const bf16* Z, const float* COS, const float* SIN) {
    const int h = lane >> 4, j = lane & 15;
    const bf16* kp = KVRAW + (size_t)t * 1024 + h * 256;
    L.kn8 = *(const uint4*)(kp + 8 * j);
    L.kx1 = *(const u32*)(Z + (size_t)t * ZW + ZC_KR + 2 * j); L.kx2 = *(const u32*)(Z + (size_t)t * ZW + ZC_KR + 32 + 2 * j);
    L.cs = *(const float2*)(COS + t * 32 + 2 * j); L.sn = *(const float2*)(SIN + t * 32 + 2 * j);
}
__device__ __forceinline__ void qkfin_store(const QkLd& L, int t, int lane, const float4 (&gk)[2], const float2 (&gkr)[2], bf16* KB) {
    const int h = lane >> 4, j = lane & 15, b = t / SEQ, s = t % SEQ; const size_t bh = (size_t)b * NH + h;
    const float2 cs = L.cs, sn = L.sn;
    {
        float v[8]; unpack8(L.kn8, v);
        float a0 = __uint_as_float(L.kx1 << 16), a1 = __uint_as_float(L.kx1 & 0xffff0000u), b0 = __uint_as_float(L.kx2 << 16), b1 = __uint_as_float(L.kx2 & 0xffff0000u);
        float ss = a0 * a0 + a1 * a1 + b0 * b0 + b1 * b1;
#pragma unroll
        for (int e = 0; e < 8; ++e) ss += v[e] * v[e];
        const float rs = rsqrtf(dpp_rsum16(ss) * (1.f / DQK) + EPS);
        a0 *= rs * gkr[0].x; a1 *= rs * gkr[0].y; b0 *= rs * gkr[1].x; b1 *= rs * gkr[1].y;
        bf16* o = KB + (bh * SEQ + s) * DQK;
        *(uint4*)(o + 8 * j) = make_uint4(pk2(v[0] * rs * gk[0].x, v[1] * rs * gk[0].y), pk2(v[2] * rs * gk[0].z, v[3] * rs * gk[0].w), pk2(v[4] * rs * gk[1].x, v[5] * rs * gk[1].y), pk2(v[6] * rs * gk[1].z, v[7] * rs * gk[1].w));
        *(u32*)(o + 128 + 2 * j) = pk2(a0 * cs.x - b0 * sn.x, a1 * cs.y - b1 * sn.y);
        *(u32*)(o + 160 + 2 * j) = pk2(a0 * sn.x + b0 * cs.x, a1 * sn.y + b1 * cs.y);
    }
}
__device__ __forceinline__ void ph_qkfin(const Ctx& c, const bf16* KVRAW, const bf16* Z, const float* kn, const float* COS, const float* SIN, bf16* KB) {
    const int j = c.lane & 15;
    const float4 gk[2] = {*(const float4*)(kn + 8 * j), *(const float4*)(kn + 8 * j + 4)};
    const float2 gkr[2] = {*(const float2*)(kn + 128 + 2 * j), *(const float2*)(kn + 160 + 2 * j)};
    for (int t = 8 * c.gw; t < T; t += 8 * c.ngw) {
        QkLd L[8];
#pragma unroll
        for (int i = 0; i < 8; ++i) qkfin_load(L[i], t + i, c.lane, KVRAW, Z, COS, SIN);
#pragma unroll
        for (int i = 0; i < 8; ++i) qkfin_store(L[i], t + i, c.lane, gk, gkr, KB);
    }
}

__device__ __forceinline__ void ph_attn_simple(const Ctx& c, const bf16* QB, const bf16* KB, const bf16* VB, bf16* AO) {
    LAS float* qs = (LAS float*)c.lds + c.wave * DQK; const int lane = c.lane;
    for (int gq = c.gw; gq < NB * NH * SEQ; gq += c.ngw) {
        const int bh = gq / SEQ, q = gq % SEQ;
        const bf16* qp = QB + ((size_t)bh * SEQ + q) * DQK;
        qs[lane] = bf2f(qp[lane]); qs[lane + 64] = bf2f(qp[lane + 64]); qs[lane + 128] = bf2f(qp[lane + 128]);
        asm volatile("s_waitcnt lgkmcnt(0)" ::: "memory");
        float m = -1e30f, l = 0.f, o0 = 0.f, o1 = 0.f;
        const int ntile = q / 64 + 1;
        for (int kt = 0; kt < ntile; ++kt) {
            const int key = kt * 64 + lane;
            const uint4* kp = (const uint4*)(KB + ((size_t)bh * SEQ + key) * DQK);
            float sc = 0.f;
#pragma unroll 4
            for (int cc = 0; cc < 24; ++cc) { float kv[8]; unpack8(kp[cc], kv);
#pragma unroll
                for (int e = 0; e < 8; ++e) sc += kv[e] * qs[cc * 8 + e]; }
            if (key > q) sc = -INFINITY;
            const float mn = fmaxf(m, wave_max(sc));
            const float p = exp2f(sc - mn), al = exp2f(m - mn);
            l = l * al + wave_sum(p); o0 *= al; o1 *= al; m = mn;
            const u32* vp = (const u32*)(VB + ((size_t)bh * SEQ + kt * 64) * DV) + lane;
#pragma unroll 8
            for (int k = 0; k < 64; ++k) { const float pk = __shfl(p, k); const u32 w = vp[(size_t)k * (DV / 2)];
                o0 += pk * __uint_as_float(w << 16); o1 += pk * __uint_as_float(w & 0xffff0000u); }
        }
        const int b = bh / NH, h = bh % NH; const float il = 1.f / l;
        *(u32*)(AO + ((size_t)b * SEQ + q) * 512 + h * DV + 2 * lane) = pk2(o0 * il, o1 * il);
    }
}

__device__ __forceinline__ void ph_s5_simple(const Ctx& c, const bf16* Z, const float* a_re, const float* a_im, const float* log_dt, const float* b_re, const float* b_im,
                                             const float* c_re, const float* c_im, const float* dsk, bf16* YG) {
    for (int item = c.gw; item < NB * 16; item += c.ngw) {
        const int b = item >> 4, g = item & 15, p = c.lane;
        const float are = a_re[g * 64 + p], aim = a_im[g * 64 + p], dt = expf(log_dt[g]);
        const float mag = expf(are * dt); float sn, cs; sincos_acc(aim * dt, sn, cs);
        const float lre = mag * cs, lim = mag * sn;
        const float xr = lre - 1.f, xi = lim, den = are * are + aim * aim;
        const float cr = (xr * are + xi * aim) / den, ci = (xi * are - xr * aim) / den;
        float Bre[16], Bim[16], Cre[16], Cim[16];
#pragma unroll
        for (int k = 0; k < 16; ++k) { const float br = b_re[(g * 64 + p) * 16 + k], bi = b_im[(g * 64 + p) * 16 + k];
            Bre[k] = cr * br - ci * bi; Bim[k] = cr * bi + ci * br; Cre[k] = c_re[(g * 16 + k) * 64 + p]; Cim[k] = c_im[(g * 16 + k) * 64 + p]; }
        const float D = (p < 16) ? dsk[g * 16 + p] : 0.f;
        float hre = 0.f, him = 0.f;
        for (int s = 0; s < SEQ; ++s) {
            const bf16* up = Z + (size_t)(b * SEQ + s) * ZW + ZC_U + g * 16;
            float u[16]; unpack8(*(const uint4*)up, u); unpack8(*(const uint4*)(up + 8), u + 8);
            float bre = 0.f, bim = 0.f;
#pragma unroll
            for (int k = 0; k < 16; ++k) { bre += Bre[k] * u[k]; bim += Bim[k] * u[k]; }
            const float nre = lre * hre - lim * him + bre, nim = lre * him + lim * hre + bim; hre = nre; him = nim;
            float my = 0.f;
#pragma unroll
            for (int k = 0; k < 16; ++k) { const float v = wave_sum(Cre[k] * hre - Cim[k] * him); if (p == k) my = v + D * u[k]; }
            if (p < 16) YG[(size_t)(b * SEQ + s) * 256 + g * 16 + p] = f2bf(gelu_f(my));
        }
    }
}

__device__ __forceinline__ void ph_lru_xc(const Ctx& c, const bf16* Z, const float* cw, const float* cb, float* XC) {
    for (int i = c.gt; i < T * 256; i += c.ngt) { const int t = i >> 8, ch = i & 255, s = t % SEQ;
        float acc = cb[ch];
#pragma unroll
        for (int j = 0; j < 4; ++j) { const int ss = s - 3 + j; if (ss >= 0) acc += cw[j * 256 + ch] * bf2f(Z[(size_t)(t - 3 + j) * ZW + ZC_X + ch]); }
        XC[i] = acc; }
}
__device__ __forceinline__ void ph_lru_gates(const Ctx& c, const float* XC, const float* wa, const float* ba, const float* wx, const float* bx, const float* lam, float* AA, float* BT) {
    for (int i = c.gt; i < T * 256; i += c.ngt) { const int t = i >> 8, ch = i & 255, h = ch >> 6, j = ch & 63;
        const float* xr = XC + (size_t)t * 256 + h * 64;
        float ra = ba[ch], rx = bx[ch];
        for (int k = 0; k < 64; ++k) { const float xv = xr[k]; ra += xv * wa[(h * 64 + k) * 64 + j]; rx += xv * wx[(h * 64 + k) * 64 + j]; }
        const float r = sigmoid_f(ra), ig = sigmoid_f(rx);
        const float lsg = -log1pf(expf(-lam[ch]));
        const float la = 8.f * r * lsg, av = expf(la);
        AA[i] = av; BT[i] = sqrtf(-expm1f(2.f * la)) * (ig * XC[i]); }
}
__device__ __forceinline__ void ph_lru_scan(const Ctx& c, const float* AA, const float* BT, const bf16* Z, bf16* ROUT) {
    for (int item = c.gw; item < NB * 4; item += c.ngw) {
        const int i = item * 64 + c.lane, b = i >> 8, ch = i & 255;
        float h = 0.f;
#pragma unroll 8
        for (int s = 0; s < SEQ; ++s) { const size_t t = (size_t)b * SEQ + s;
            h = AA[t * 256 + ch] * h + BT[t * 256 + ch];
            ROUT[t * 256 + ch] = f2bf(h * gelu_f(bf2f(Z[t * ZW + ZC_G + ch]))); }
    }
}

__device__ __forceinline__ void ph_mixnorm(const Ctx& c, const bf16* AO, const bf16* SOUT, const bf16* ROUT, const float* g, bf16* Y) {
    const int lane = c.lane;
    const float4 ga0 = *(const float4*)(g + 8 * lane), ga1 = *(const float4*)(g + 8 * lane + 4), gs = *(const float4*)(g + 512 + 4 * lane), gr = *(const float4*)(g + 768 + 4 * lane);
    for (int row0 = 4 * c.gw; row0 < T; row0 += 4 * c.ngw) {
        uint4 wa[4]; uint2 ws_[4], wr[4];
#pragma unroll
        for (int i = 0; i < 4; ++i) { const size_t row = row0 + i; wa[i] = *(const uint4*)(AO + row * 512 + 8 * lane); ws_[i] = *(const uint2*)(SOUT + row * 256 + 4 * lane); wr[i] = *(const uint2*)(ROUT + row * 256 + 4 * lane); }
#pragma unroll
        for (int i = 0; i < 4; ++i) { const size_t row = row0 + i;
            {   float v[8]; unpack8(wa[i], v); float ss = 0.f;
#pragma unroll
                for (int e = 0; e < 8; ++e) ss += v[e] * v[e];
                const float rstd = rsqrtf(wave_sum(ss) * (1.f / 512) + EPS);
                *(uint4*)(Y + row * DM + 8 * lane) = make_uint4(pk2(v[0] * rstd * ga0.x, v[1] * rstd * ga0.y), pk2(v[2] * rstd * ga0.z, v[3] * rstd * ga0.w), pk2(v[4] * rstd * ga1.x, v[5] * rstd * ga1.y), pk2(v[6] * rstd * ga1.z, v[7] * rstd * ga1.w)); }
            {   const float a0 = __uint_as_float(ws_[i].x << 16), a1 = __uint_as_float(ws_[i].x & 0xffff0000u), a2 = __uint_as_float(ws_[i].y << 16), a3 = __uint_as_float(ws_[i].y & 0xffff0000u);
                const float rstd = rsqrtf(wave_sum(a0 * a0 + a1 * a1 + a2 * a2 + a3 * a3) * (1.f / 256) + EPS);
                *(uint2*)(Y + row * DM + 512 + 4 * lane) = make_uint2(pk2(a0 * rstd * gs.x, a1 * rstd * gs.y), pk2(a2 * rstd * gs.z, a3 * rstd * gs.w)); }
            {   const float a0 = __uint_as_float(wr[i].x << 16), a1 = __uint_as_float(wr[i].x & 0xffff0000u), a2 = __uint_as_float(wr[i].y << 16), a3 = __uint_as_float(wr[i].y & 0xffff0000u);
                const float rstd = rsqrtf(wave_sum(a0 * a0 + a1 * a1 + a2 * a2 + a3 * a3) * (1.f / 256) + EPS);
                *(uint2*)(Y + row * DM + 768 + 4 * lane) = make_uint2(pk2(a0 * rstd * gr.x, a1 * rstd * gr.y), pk2(a2 * rstd * gr.z, a3 * rstd * gr.w)); } }
    }
}

__device__ __forceinline__ void ph_topk_a(const Ctx& c, const float* SC, float* STOP, int* ITOP) {
    for (int i = c.gt; i < T * 16; i += c.ngt) {
        const float* sc = SC + (size_t)i * 128;
        float pv = INFINITY; int pn = -1;
        for (int it = 0; it < 16; ++it) {
            float bv = -INFINITY; int bn = 1 << 30;
            for (int n = 0; n < 128; ++n) { const float v = sc[n];
                const bool elig = (v < pv) || (v == pv && n > pn);
                if (elig && (v > bv || (v == bv && n < bn))) { bv = v; bn = n; } }
            STOP[(size_t)i * 16 + it] = bv; ITOP[(size_t)i * 16 + it] = bn; pv = bv; pn = bn;
        }
    }
}
__device__ __forceinline__ void ph_topk_b(const Ctx& c, const float* STOP, const int* ITOP, int* IDX, float* GATE) {
    LAS float* my = (LAS float*)c.lds + c.tid * 33;
    for (int i = c.gt; i < T * 8; i += c.ngt) {
        for (int k = 0; k < 32; ++k) my[k] = STOP[(size_t)i * 32 + k];
        float pv = INFINITY; int pn = -1; float best0 = 0.f, den = 0.f;
        float ev[16];
#pragma unroll
        for (int it = 0; it < 16; ++it) {
            float bv = -INFINITY; int bn = 1 << 30;
            for (int f = 0; f < 256; ++f) { const float v = my[f >> 4] + my[16 + (f & 15)];
                const bool elig = (v < pv) || (v == pv && f > pn);
                if (elig && (v > bv || (v == bv && f < bn))) { bv = v; bn = f; } }
            pv = bv; pn = bn;
            if (it == 0) best0 = bv;
            ev[it] = expf(bv - best0); den += ev[it];
            IDX[(size_t)i * 16 + it] = ITOP[(size_t)i * 32 + (bn >> 4)] * 128 + ITOP[(size_t)i * 32 + 16 + (bn & 15)];
        }
#pragma unroll
        for (int it = 0; it < 16; ++it) GATE[(size_t)i * 16 + it] = ev[it] / den;
    }
}

__device__ __forceinline__ void ph_gather(const Ctx& c, const bf16* HN, const int* IDX, const float* GATE, const bf16* PU, const bf16* PV, float* X) {
    const int lane = c.lane;
    for (int t = c.gw; t < T; t += c.ngw) {
        float hn[16]; unpack8(*(const uint4*)(HN + (size_t)t * DM + 8 * lane), hn); unpack8(*(const uint4*)(HN + (size_t)t * DM + 512 + 8 * lane), hn + 8);
        float y[16];
#pragma unroll
        for (int e = 0; e < 16; ++e) y[e] = 0.f;
        for (int k = 0; k < 128; ++k) {
            const int e = IDX[(size_t)t * 128 + k]; const float gt = GATE[(size_t)t * 128 + k];
            const bf16* ur = PU + (size_t)e * DM; const bf16* vr = PV + (size_t)e * DM;
            float u[16]; unpack8(*(const uint4*)(ur + 8 * lane), u); unpack8(*(const uint4*)(ur + 512 + 8 * lane), u + 8);
            float d = 0.f;
#pragma unroll
            for (int q = 0; q < 16; ++q) d += u[q] * hn[q];
            d = wave_sum(d);
            const float w = gt * gelu_f(d);
            float v[16]; unpack8(*(const uint4*)(vr + 8 * lane), v); unpack8(*(const uint4*)(vr + 512 + 8 * lane), v + 8);
#pragma unroll
            for (int q = 0; q < 16; ++q) y[q] += w * v[q];
        }
        float4* xo = (float4*)(X + (size_t)t * DM + 8 * lane);
        float4 p0 = xo[0], p1 = xo[1]; p0.x += y[0]; p0.y += y[1]; p0.z += y[2]; p0.w += y[3]; p1.x += y[4]; p1.y += y[5]; p1.z += y[6]; p1.w += y[7]; xo[0] = p0; xo[1] = p1;
        xo = (float4*)(X + (size_t)t * DM + 512 + 8 * lane);
        p0 = xo[0]; p1 = xo[1]; p0.x += y[8]; p0.y += y[9]; p0.z += y[10]; p0.w += y[11]; p1.x += y[12]; p1.y += y[13]; p1.z += y[14]; p1.w += y[15]; xo[0] = p0; xo[1] = p1;
    }
}
namespace att {
typedef short bf16x8 __attribute__((ext_vector_type(8)));
typedef short s16x4 __attribute__((ext_vector_type(4)));
typedef float f32x16 __attribute__((ext_vector_type(16)));
typedef unsigned u32x4 __attribute__((ext_vector_type(4)));
constexpr int KT = 64, KBYTES = KT * DQK * 2, VBYTES = KT * DV * 2, BUFB = KBYTES + VBYTES;
constexpr int OFF_WS = 2 * BUFB, OFF_MO = 0, OFF_ML = 65536, LDS_NEED = OFF_WS + 8 * 64 * 4;
constexpr float THR = 8.f;
__device__ __forceinline__ int kswz(int row, int c) { return row * 384 + (((c & ~7) | ((c & 7) ^ ((row >> 1) & 7))) << 4); }
__device__ __forceinline__ int v_st(int k, int c) { const int kk = (k & ~0xC) | ((k & 4) << 1) | ((k & 8) >> 1); return ((kk >> 3) * 4 + (c >> 5)) * 512 + ((kk & 7) * 32 + (c & 31)) * 2; }
__device__ __forceinline__ int v_rd_base(int lane) { return ((lane & 3) << 3) | (((lane >> 2) & 3) << 6) | (((lane >> 4) & 1) << 5) | (((lane >> 5) & 1) << 8); }
__device__ __forceinline__ int crow(int r, int hi) { return (r & 3) + 8 * (r >> 2) + 4 * hi; }
__device__ __forceinline__ unsigned cvtpk(float lo, float hi) { unsigned r; asm volatile("v_cvt_pk_bf16_f32 %0, %1, %2" : "=v"(r) : "v"(lo), "v"(hi)); return r; }
#define ATT_SBAR() __builtin_amdgcn_sched_barrier(0)

template <int SKIP> __device__ __forceinline__ void attn_unit(LAS unsigned char* lds, const bf16* QRAW, const float* qn, const float* COS, const float* SIN, const bf16* Kg, const bf16* KVRAW, bf16* AO, float* MSS, int bh, int qb, int tid) {
    const int lane = tid & 63, wid = __builtin_amdgcn_readfirstlane(tid >> 6), qsub = wid & 3, kh = wid >> 2, r32 = lane & 31, hi = lane >> 5;
    const int q0 = qb * 128, NT = 2 * (qb + 1);
    const size_t rowbase = (size_t)bh * SEQ;
    bf16x8 qr[12];
    { const int b_ = bh / NH, h_ = bh % NH; const size_t trow = (size_t)b_ * SEQ + q0 + 32 * qsub + r32;
      const bf16* qp = QRAW + trow * 768 + h_ * DQK + 8 * hi;
      uint4 raw[12];
#pragma unroll
      for (int ks = 0; ks < 12; ++ks) raw[ks] = *(const uint4*)(qp + 16 * ks);
      float ss = 0.f;
#pragma unroll
      for (int ks = 0; ks < 12; ++ks) { float v[8]; unpack8(raw[ks], v);
#pragma unroll
          for (int e = 0; e < 8; ++e) ss += v[e] * v[e]; }
      { auto rr = __builtin_amdgcn_permlane32_swap(__float_as_uint(ss), __float_as_uint(ss), false, false); ss = __uint_as_float(rr[0]) + __uint_as_float(rr[1]); }
      const float rs = rsqrtf(ss * (1.f / DQK) + EPS) * QSCALE;
#pragma unroll
      for (int ks = 0; ks < 8; ++ks) { float v[8]; unpack8(raw[ks], v); const float4 g0 = *(const float4*)(qn + 16 * ks + 8 * hi), g1 = *(const float4*)(qn + 16 * ks + 8 * hi + 4);
          u32x4 w = {pk2(v[0] * rs * g0.x, v[1] * rs * g0.y), pk2(v[2] * rs * g0.z, v[3] * rs * g0.w), pk2(v[4] * rs * g1.x, v[5] * rs * g1.y), pk2(v[6] * rs * g1.z, v[7] * rs * g1.w)};
          qr[ks] = __builtin_bit_cast(bf16x8, w); }
#pragma unroll
      for (int kp = 0; kp < 2; ++kp) { float a[8], bq[8]; unpack8(raw[8 + kp], a); unpack8(raw[10 + kp], bq); const int i0 = 16 * kp + 8 * hi;
          const float4 ga0 = *(const float4*)(qn + 128 + i0), ga1 = *(const float4*)(qn + 128 + i0 + 4), gb0 = *(const float4*)(qn + 160 + i0), gb1 = *(const float4*)(qn + 160 + i0 + 4);
          const float4 c0 = *(const float4*)(COS + trow * 32 + i0), c1 = *(const float4*)(COS + trow * 32 + i0 + 4), s0 = *(const float4*)(SIN + trow * 32 + i0), s1 = *(const float4*)(SIN + trow * 32 + i0 + 4);
          const float ga[8] = {ga0.x, ga0.y, ga0.z, ga0.w, ga1.x, ga1.y, ga1.z, ga1.w}, gb[8] = {gb0.x, gb0.y, gb0.z, gb0.w, gb1.x, gb1.y, gb1.z, gb1.w};
          const float cs[8] = {c0.x, c0.y, c0.z, c0.w, c1.x, c1.y, c1.z, c1.w}, sn[8] = {s0.x, s0.y, s0.z, s0.w, s1.x, s1.y, s1.z, s1.w};
          float oa[8], ob[8];
#pragma unroll
          for (int e = 0; e < 8; ++e) { const float x = a[e] * rs * ga[e], y = bq[e] * rs * gb[e]; oa[e] = x * cs[e] - y * sn[e]; ob[e] = x * sn[e] + y * cs[e]; }
          u32x4 wa = {pk2(oa[0], oa[1]), pk2(oa[2], oa[3]), pk2(oa[4], oa[5]), pk2(oa[6], oa[7])}, wb = {pk2(ob[0], ob[1]), pk2(ob[2], ob[3]), pk2(ob[4], ob[5]), pk2(ob[6], ob[7])};
          qr[8 + kp] = __builtin_bit_cast(bf16x8, wa); qr[10 + kp] = __builtin_bit_cast(bf16x8, wb); }
    }
    int ksrc[3], vsrc[2];
#pragma unroll
    for (int j = 0; j < 3; ++j) { const int L = (wid + 8 * j) * 64 + lane, row = L / 24, cp = L - row * 24, c = (cp & ~7) | ((cp & 7) ^ ((row >> 1) & 7)); ksrc[j] = row * DQK + c * 8; }
#pragma unroll
    for (int j = 0; j < 2; ++j) { const int X = ((wid + 8 * j) * 64 + lane) * 16, sub = X >> 9, within = (X & 511) >> 1, kk = ((sub >> 2) << 3) | (within >> 5);
        const int k = (kk & ~0xC) | ((kk & 4) << 1) | ((kk & 8) >> 1), c = (sub & 3) * 32 + (within & 31); vsrc[j] = k * 1024 + c; }
    const bf16* Kt = Kg + rowbase * DQK; const bf16* Vt = KVRAW + ((size_t)(bh / NH) * SEQ) * 1024 + (bh % NH) * 256 + 128;
#define ATT_STAGE(t, bo) do { const bf16* kp_ = Kt + (size_t)(t) * (KT * DQK); const bf16* vp_ = Vt + (size_t)(t) * (KT * 1024); \
        _Pragma("unroll") for (int j_ = 0; j_ < 3; ++j_) __builtin_amdgcn_global_load_lds((const unsigned*)(kp_ + ksrc[j_]), (LAS unsigned*)(lds + (bo) + (wid + 8 * j_) * 1024), 16, 0, 0); \
        _Pragma("unroll") for (int j_ = 0; j_ < 2; ++j_) __builtin_amdgcn_global_load_lds((const unsigned*)(vp_ + vsrc[j_]), (LAS unsigned*)(lds + (bo) + KBYTES + (wid + 8 * j_) * 1024), 16, 0, 0); } while (0)
    const int krow = 32 * kh + r32, kf = (krow >> 1) & 7;
    int kb[4];
#pragma unroll
    for (int j = 0; j < 4; ++j) kb[j] = krow * 384 + ((((2 * j + hi) & 7) ^ kf) << 4);
    const int vb = KBYTES + v_rd_base(lane) + kh * 8192;
    LAS float* wsf = (LAS float*)(lds + OFF_WS) + wid * 64;
    float m_reg = -1e30f, l_reg = 0.f; f32x16 o[4];
#pragma unroll
    for (int d = 0; d < 4; ++d) o[d] = f32x16{};
    const int rb = 32 * qsub;
    ATT_STAGE(0, 0);
    asm volatile("s_waitcnt vmcnt(0)" ::: "memory");
    __syncthreads();
    for (int t = 0; t < NT; ++t) {
        const int bo = (t & 1) * BUFB;
        if (!(SKIP & 8) && t + 1 < NT) ATT_STAGE(t + 1, BUFB - bo);
        const int kboff = 64 * t + 32 * kh - q0;
        const bool act = kboff <= rb, diag = kboff == rb;
        if (act) {
            f32x16 p = f32x16{};
            bf16x8 kfr[12];
#pragma unroll
            for (int ks = 0; ks < 12; ++ks) kfr[ks] = *(const LAS bf16x8*)(lds + bo + kb[ks & 3] + (ks >> 2) * 128);
            ATT_SBAR();
#pragma unroll
            for (int ks = 0; ks < 12; ++ks) {
                if (!(SKIP & 2)) p = __builtin_amdgcn_mfma_f32_32x32x16_bf16(kfr[ks], qr[ks], p, 0, 0, 0); else p[ks] += __uint_as_float((unsigned)kfr[ks][0] << 16);
            }
            const int vaddr = (int)(uintptr_t)lds + bo + vb;
            s16x4 vl0[2], vh0[2], vl1[2], vh1[2];
#define ATT_TRRD(dst, off) asm volatile("ds_read_b64_tr_b16 %0, %1 offset:%2" : "=&v"(dst) : "v"(vaddr), "i"(off) : "memory")
#define ATT_VRD(i, d0) do { ATT_TRRD(vl0[i], (d0) * 512); ATT_TRRD(vh0[i], (d0) * 512 + 2048); ATT_TRRD(vl1[i], (d0) * 512 + 4096); ATT_TRRD(vh1[i], (d0) * 512 + 6144); } while (0)
            ATT_VRD(0, 0); ATT_VRD(1, 1);
            if (diag) {
#pragma unroll
                for (int r = 0; r < 16; ++r) if (crow(r, hi) > r32) p[r] = -__builtin_inff();
            }
            if (!(SKIP & 1)) {
            float pmax = p[0];
#pragma unroll
            for (int r = 1; r < 16; ++r) pmax = fmaxf(pmax, p[r]);
            { auto rr = __builtin_amdgcn_permlane32_swap(__float_as_uint(pmax), __float_as_uint(pmax), false, false);
              pmax = fmaxf(__uint_as_float(rr[0]), __uint_as_float(rr[1])); }
            float alpha = 1.f;
            if (!__all(pmax - m_reg <= THR)) { const float mn = fmaxf(m_reg, pmax); alpha = __builtin_amdgcn_exp2f(m_reg - mn); m_reg = mn; }
#pragma unroll
            for (int r = 0; r < 16; ++r) p[r] = __builtin_amdgcn_exp2f(p[r] - m_reg);
            float ps = 0.f;
#pragma unroll
            for (int r = 0; r < 16; ++r) ps += p[r];
            { auto rr = __builtin_amdgcn_permlane32_swap(__float_as_uint(ps), __float_as_uint(ps), false, false);
              ps = __uint_as_float(rr[0]) + __uint_as_float(rr[1]); }
            l_reg = l_reg * alpha + ps;
            if (__any(alpha < 1.f)) {
                if (hi == 0) wsf[r32] = alpha;
                asm volatile("s_waitcnt lgkmcnt(0)" ::: "memory");
#pragma unroll
                for (int r = 0; r < 16; ++r) { const float al = wsf[crow(r, hi)];
#pragma unroll
                    for (int d = 0; d < 4; ++d) o[d][r] *= al; }
            }
            }
            bf16x8 pa0, pa1;
#define ATT_PK4(B_, OUT) do { unsigned a0 = cvtpk(p[B_ + 0], p[B_ + 1]), a1 = cvtpk(p[B_ + 2], p[B_ + 3]); unsigned b0 = cvtpk(p[B_ + 4], p[B_ + 5]), b1 = cvtpk(p[B_ + 6], p[B_ + 7]); \
            auto r0 = __builtin_amdgcn_permlane32_swap(a0, b0, false, false); auto r1 = __builtin_amdgcn_permlane32_swap(a1, b1, false, false); \
            u32x4 w_ = {r0[0], r1[0], r0[1], r1[1]}; OUT = __builtin_bit_cast(bf16x8, w_); } while (0)
            ATT_PK4(0, pa0); ATT_PK4(8, pa1);
#undef ATT_PK4
            asm volatile("s_waitcnt lgkmcnt(0)" ::: "memory"); ATT_SBAR();
            __builtin_amdgcn_s_setprio(1);
#define ATT_PV(i, d0) do { \
            o[d0] = __builtin_amdgcn_mfma_f32_32x32x16_bf16(pa0, (bf16x8){vl0[i][0], vl0[i][1], vl0[i][2], vl0[i][3], vh0[i][0], vh0[i][1], vh0[i][2], vh0[i][3]}, o[d0], 0, 0, 0); \
            o[d0] = __builtin_amdgcn_mfma_f32_32x32x16_bf16(pa1, (bf16x8){vl1[i][0], vl1[i][1], vl1[i][2], vl1[i][3], vh1[i][0], vh1[i][1], vh1[i][2], vh1[i][3]}, o[d0], 0, 0, 0); } while (0)
            ATT_PV(0, 0); ATT_SBAR(); ATT_VRD(0, 2); ATT_SBAR(); ATT_PV(1, 1); ATT_SBAR(); ATT_VRD(1, 3);
            asm volatile("s_waitcnt lgkmcnt(0)" ::: "memory"); ATT_SBAR();
            ATT_PV(0, 2); ATT_PV(1, 3);
#undef ATT_PV
#undef ATT_VRD
#undef ATT_TRRD
            __builtin_amdgcn_s_setprio(0);
        }
        asm volatile("s_waitcnt vmcnt(0)" ::: "memory");
        __syncthreads();
    }
    int lane_m = lane; asm volatile("" : "+v"(lane_m));
    const int r32m = lane_m & 31, him = lane_m >> 5;
    LAS float* MO = (LAS float*)(lds + OFF_MO) + qsub * 4096; LAS float* ML = (LAS float*)(lds + OFF_ML) + qsub * 64;
    if (kh == 1) {
        if (him == 0) { ML[2 * r32m] = m_reg; ML[2 * r32m + 1] = l_reg; }
#pragma unroll
        for (int d = 0; d < 4; ++d)
#pragma unroll
            for (int r = 0; r < 16; ++r) MO[(d * 16 + r) * 64 + lane_m] = o[d][r];
    }
    __syncthreads();
    if (kh == 0) {
        const float m1 = ML[2 * r32m], l1 = ML[2 * r32m + 1];
        const float mm = fmaxf(m_reg, m1), f0 = __builtin_amdgcn_exp2f(m_reg - mm), f1 = __builtin_amdgcn_exp2f(m1 - mm);
        const float il = 1.f / (l_reg * f0 + l1 * f1);
        if (him == 0) { wsf[r32m] = f0 * il; wsf[32 + r32m] = f1 * il; }
        asm volatile("s_waitcnt lgkmcnt(0)" ::: "memory");
        const int b = bh / NH, h = bh % NH;
        bf16* Ow = AO + ((size_t)b * SEQ + q0 + rb) * DM + h * DV;
        float* Mw = MSS + ((size_t)b * SEQ + q0 + rb) * 12 + h;
#pragma unroll
        for (int r = 0; r < 16; ++r) { const int orow = crow(r, him); const float g0 = wsf[orow], g1 = wsf[32 + orow]; float ss = 0.f;
#pragma unroll
            for (int d = 0; d < 4; ++d) { const float v = o[d][r] * g0 + MO[(d * 16 + r) * 64 + lane_m] * g1; const float vn = __shfl_xor(v, 1); ss += v * v;
                if ((r32m & 1) == 0) *(unsigned*)(Ow + (size_t)orow * DM + d * 32 + r32m) = cvtpk(v, vn); }
            ss += tk::dppf<0xB1>(ss); ss += tk::dppf<0x4E>(ss); ss += tk::dppf<0x141>(ss); ss += tk::dppf<0x140>(ss); ss += __shfl_xor(ss, 16);
            if (r32m == 0) Mw[(size_t)orow * 12] = ss; }
    }
    __syncthreads();
#undef ATT_STAGE
}
template <int SKIP = 0> __device__ __forceinline__ void attn_phase(LAS unsigned char* lds, const bf16* QRAW, const float* qn, const float* COS, const float* SIN, const bf16* Kg, const bf16* KVRAW, bf16* AO, float* MSS, int G, int bid, int tid) {
    const int npair = NB * NH * 32;
    for (int v0 = bid; v0 < npair; v0 += G) {
        const int vcu = (G % 8 == 0 && npair % G == 0) ? (v0 % 8) * (npair / 8) + v0 / 8 : v0;
        const int bh = vcu >> 5, s = vcu & 31;
        for (int u = 0; u < 2; ++u) attn_unit<SKIP>(lds, QRAW, qn, COS, SIN, Kg, KVRAW, AO, MSS, bh, u ? s : 63 - s, tid);
    }
}
#undef ATT_SBAR
}
#ifndef MK_PROBE
#define MK_PROBE 0
#endif
#ifndef MK_UTEST
#define MK_UTEST 0
#endif
#ifndef PROBE_A_LO
#define PROBE_A_LO 0
#define PROBE_A_HI 1
#define PROBE_B_LO 16
#define PROBE_B_HI 17
#endif
#ifndef PROBE_Q
#define PROBE_Q 4.f
#endif
#define TS_OFF 8192
#ifndef MK_DUP
#define MK_DUP 0
#endif
#ifndef MK_DUP_SKIP
#define MK_DUP_SKIP 0
#endif
#ifndef MK_DUPK
#define MK_DUPK 0
#endif
#ifndef MK_DUP_LOADONLY
#define MK_DUP_LOADONLY false
#endif
#ifndef MK_DUP_EMASK
#define MK_DUP_EMASK 0x3fff
#endif
#ifndef MK_SIMPLE_TOPK
#define MK_SIMPLE_TOPK 0
#endif
#ifndef MK_SIMPLE_SCAN
#define MK_SIMPLE_SCAN 0
#endif
#ifndef MK_SIMPLE_ATTN
#define MK_SIMPLE_ATTN 0
#endif
#ifndef MK_SIMPLE_GEMM
#define MK_SIMPLE_GEMM 0
#endif
constexpr int NPH_LAYER = 9, NPH = 1 + NL * NPH_LAYER;
struct GD { const bf16* A; const bf16* Bt; void* C; const float* aux0; const bf16* aux1; int lda, M, N, K, ldc, kind; };
template <class Epi> __device__ __forceinline__ void run_gemm(const Ctx& c, const bf16* A, int lda, const bf16* Bt, int M, int N, int K, const Epi& E) {
    pg8::Gemm g{A, Bt, M, N, K, lda}; pg8::StaticOrder S; S.init(M, N, c.G, c.bid);
    pg8::gemm_phase<Epi, pg8::StaticOrder, true, true>(c.lds, g, S, E);
}
#define AS4 __attribute__((address_space(4)))
#define PH_BEGIN \
        const Args AS4* ap = (const Args AS4*)__builtin_amdgcn_kernarg_segment_ptr(); asm volatile("" : "+s"(ap)); \
        int tid_ = threadIdx.x; asm volatile("" : "+v"(tid_)); \
        Ctx c; c.lds = (LAS unsigned char*)lds_raw; c.tid = tid_; c.lane = c.tid & 63; c.wave = __builtin_amdgcn_readfirstlane(c.tid >> 6); \
        { int G_ = gridDim.x, bid_ = blockIdx.x; asm volatile("" : "+s"(G_), "+s"(bid_)); c.G = G_; c.bid = bid_; } \
        c.gw = c.wave * c.G + c.bid; c.ngw = NWAVES * c.G; c.gt = c.bid * NTHR + c.tid; c.ngt = c.G * NTHR; \
        unsigned char* const ws = ap->ws; float* const out = ap->out; (void)out; (void)ws;
#define WSQ(T_, off) ((T_*)(ws + (off)))
#define INQ(i) ((const float*)ap->in[i])
#define PH_BAR(P) if ((P) + 1 < ph_hi) { XcdBarrier b2 = bar; unsigned* bb = (unsigned*)(ap->ws + WS_CTL) + CW_BAR; unsigned bx = bar.x; asm volatile("" : "+s"(bb), "+s"(bx)); b2.bar = bb; b2.x = bx; xcd_barrier(b2); } PH_STAMP(P)
#if MK_PROBE
#define PH_STAMP(P) if (blockIdx.x == 0 && threadIdx.x == 0) ((unsigned long long*)(ap->ws + WS_CTL + TS_OFF))[(P) + 1] = __builtin_amdgcn_s_memrealtime();
#else
#define PH_STAMP(P)
#endif
#define PHASE(P) if (ph_lo <= (P) && (P) < ph_hi)

template <int L> __device__ __forceinline__ void layer_phases(unsigned char* lds_raw, const XcdBarrier& bar, int ph_lo, int ph_hi) {
    constexpr int P0 = 1 + L * NPH_LAYER;
    PHASE(P0 + 0) { PH_BEGIN
        run_gemm(c, WSQ(bf16, WS_XB), DM, WSQ(bf16, WS_WINT) + (size_t)L * ZW * DM, T, (c.G > 128) ? 1024 : ZW, DM, pg8::EpiBf16<0>{WSQ(bf16, WS_Z), ZW, nullptr, 0, 0, 1.f});
        PH_BAR(P0 + 0) }
    PHASE(P0 + 1) { PH_BEGIN
        if (c.G > 128) run_gemm(c, WSQ(bf16, WS_XB), DM, WSQ(bf16, WS_WINT) + (size_t)L * ZW * DM + (size_t)1024 * DM, T, 256, DM, pg8::EpiBf16<0>{WSQ(bf16, WS_Z) + 1024, ZW, nullptr, 0, 0, 1.f});
    }
    PHASE(P0 + 1) { PH_BEGIN
        if (c.G > 128) { if (c.bid < 64) { c.gw = 0x04000000; c.gt = 0x04000000; } else { c.gw = c.wave * (c.G - 64) + (c.bid - 64); c.gt = (c.bid - 64) * NTHR + c.tid; } c.ngw = NWAVES * (c.G - 64); c.ngt = (c.G - 64) * NTHR; }
        ph_zstats(c, WSQ(bf16, WS_Z), INQ(4) + L * 256, INQ(6) + L * 128, WSQ(bf16, WS_CQN), WSQ(bf16, WS_CKVN));
        s5f::pass_a_mfma(WSQ(bf16, WS_Z), WSQ(bf16, WS_S5W) + (size_t)L * 1048576, WSQ(float2, WS_SE), c.gw, c.ngw, c.lane);
        lruf::pass_a(c.lds, WSQ(bf16, WS_Z), INQ(20) + L * 1024, INQ(21) + L * 256, WSQ(bf16, WS_LWT) + (size_t)L * 32768, INQ(23) + L * 256, INQ(25) + L * 256, INQ(26) + L * 256, WSQ(float, WS_AA), WSQ(float, WS_BT), WSQ(float2, WS_LPE), c.gw, c.ngw, c.wave, c.lane);
#if MK_DUP & 4096
        ph_zstats(c, WSQ(bf16, WS_Z), INQ(4) + L * 256, INQ(6) + L * 128, WSQ(bf16, WS_CQN), WSQ(bf16, WS_CKVN));
#endif
#if MK_DUP & 8192
        __syncthreads(); s5f::pass<false>(c.lds, WSQ(bf16, WS_Z), WSQ(bf16, WS_S5A) + (size_t)L * 32768, WSQ(bf16, WS_S5C) + (size_t)L * 32768, WSQ(float2, WS_S5L) + L * 1024, INQ(17) + L * 256, WSQ(float2, WS_SE), WSQ(float2, WS_SH), WSQ(bf16, WS_YG), c.gw, c.ngw, c.wave, c.lane);
#endif
#if MK_DUP & 16384
        __syncthreads(); lruf::pass_a(c.lds, WSQ(bf16, WS_Z), INQ(20) + L * 1024, INQ(21) + L * 256, WSQ(bf16, WS_LWT) + (size_t)L * 32768, INQ(23) + L * 256, INQ(25) + L * 256, INQ(26) + L * 256, WSQ(float, WS_AA), WSQ(float, WS_BT), WSQ(float2, WS_LPE), c.gw, c.ngw, c.wave, c.lane);
#endif
        PH_BAR(P0 + 1) }
    PHASE(P0 + 2) { PH_BEGIN
        for (int it = c.bid; it < 232; it += c.G) {
            if (it >= 224) lruf::carry_wg(c.lds, WSQ(float2, WS_LPE), WSQ(float, WS_LH), it - 224, c.wave, c.lane);
            else if (it >= 192) s5f::carry_wg(c.lds, WSQ(float2, WS_S5L) + L * 1024, WSQ(float2, WS_SE), WSQ(float2, WS_SH), it - 192, c.wave, c.lane);
        }
        run_gemm(c, WSQ(bf16, WS_CQN), 256, WSQ(bf16, WS_WUQT) + (size_t)L * 768 * 256, T, 768, 256, pg8::EpiBf16<0>{WSQ(bf16, WS_QRAW), 768, nullptr, 0, 0, 1.f});
    }
    PHASE(P0 + 2) { PH_BEGIN
        run_gemm(c, WSQ(bf16, WS_CKVN), 128, WSQ(bf16, WS_WUKVT) + (size_t)L * 1024 * 128, T, 1024, 128, pg8::EpiBf16<0>{WSQ(bf16, WS_KVRAW), 1024, nullptr, 0, 0, 1.f});
        PH_BAR(P0 + 2) }
    PHASE(P0 + 3) { PH_BEGIN
        ph_qkfin(c, WSQ(bf16, WS_KVRAW), WSQ(bf16, WS_Z), INQ(9) + L * DQK, WSQ(float, WS_COS), WSQ(float, WS_SIN), WSQ(bf16, WS_KB));
#if MK_DUP & 64
        ph_qkfin(c, WSQ(bf16, WS_KVRAW), WSQ(bf16, WS_Z), INQ(9) + L * DQK, WSQ(float, WS_COS), WSQ(float, WS_SIN), WSQ(bf16, WS_KB));
#endif
    }
    PHASE(P0 + 3) { PH_BEGIN
        s5f::pass_b(c.lds, WSQ(bf16, WS_Z), WSQ(bf16, WS_S5A) + (size_t)L * 32768, WSQ(bf16, WS_S5C) + (size_t)L * 32768, WSQ(float2, WS_S5L) + L * 1024, INQ(17) + L * 256, WSQ(float2, WS_SH), WSQ(bf16, WS_YG), c.gw, c.ngw, c.wave, c.lane);
        lruf::pass_b(WSQ(float, WS_AA), WSQ(float, WS_BT), WSQ(float, WS_LH), WSQ(bf16, WS_Z), WSQ(bf16, WS_Y) + 768, DM, WSQ(float, WS_MIXSS), c.gt, c.ngt);
#if MK_DUP & 1024
        s5f::pass<true>(c.lds, WSQ(bf16, WS_Z), WSQ(bf16, WS_S5A) + (size_t)L * 32768, WSQ(bf16, WS_S5C) + (size_t)L * 32768, WSQ(float2, WS_S5L) + L * 1024, INQ(17) + L * 256, WSQ(float2, WS_SE), WSQ(float2, WS_SH), WSQ(bf16, WS_YG), c.gw, c.ngw, c.wave, c.lane);
#endif
#if MK_DUP & 2048
        lruf::pass_b(WSQ(float, WS_AA), WSQ(float, WS_BT), WSQ(float, WS_LH), WSQ(bf16, WS_Z), WSQ(bf16, WS_Y) + 768, DM, WSQ(float, WS_MIXSS), c.gt, c.ngt);
#endif
        PH_BAR(P0 + 3) }
    PHASE(P0 + 4) { PH_BEGIN
        run_gemm(c, WSQ(bf16, WS_YG), 256, WSQ(bf16, WS_GLUT) + (size_t)L * 65536, T, 256, 256, pg8::EpiGlu{WSQ(bf16, WS_Y) + 512, DM, INQ(19) + L * 256, WSQ(bf16, WS_YG), 256, WSQ(float, WS_MIXSS)});
    }
    PHASE(P0 + 4) { PH_BEGIN
#if MK_DUP & 512
        att::attn_phase<MK_DUP_SKIP>(c.lds, WSQ(bf16, WS_QRAW), INQ(8) + L * DQK, WSQ(float, WS_COS), WSQ(float, WS_SIN), WSQ(bf16, WS_KB), WSQ(bf16, WS_KVRAW), WSQ(bf16, WS_QB), WSQ(float, WS_IDX), c.G, c.bid, c.tid);
#endif
        att::attn_phase(c.lds, WSQ(bf16, WS_QRAW), INQ(8) + L * DQK, WSQ(float, WS_COS), WSQ(float, WS_SIN), WSQ(bf16, WS_KB), WSQ(bf16, WS_KVRAW), WSQ(bf16, WS_Y), WSQ(float, WS_MIXSS), c.G, c.bid, c.tid);
        PH_BAR(P0 + 4) }
    PHASE(P0 + 6) { PH_BEGIN
        const float* xin = (L == 0) ? INQ(0) : out;
        run_gemm(c, WSQ(bf16, WS_Y), DM, WSQ(bf16, WS_WOUTT) + (size_t)L * DM * DM, T, DM, DM, pg8::EpiOut{out, DM, xin, INQ(29) + L * DM, WSQ(bf16, WS_XB), WSQ(float, WS_ROWSS), WSQ(float, WS_MIXSS), (LAS float*)(c.lds + RING_BYTES + 4096)});
        PH_BAR(P0 + 6) }
    PHASE(P0 + 7) { PH_BEGIN
        run_gemm(c, WSQ(bf16, WS_XB), DM, WSQ(bf16, WS_WQT) + (size_t)L * 2048 * DM, T, 2048, DM, pg8::EpiBf16<0>{WSQ(bf16, WS_QP), 2048, nullptr, 0, 0, 1.f});
        PH_BAR(P0 + 7) }
    PHASE(P0 + 8) { PH_BEGIN
#if MK_DUP & 8
        tk::peer_phase<MK_DUP_EMASK, MK_DUP_SKIP>(c.lds, WSQ(bf16, WS_QP), WSQ(bf16, WS_SUBKT) + (size_t)L * 32768, WSQ(bf16, WS_XB), WSQ(unsigned char, WS_PU) + (size_t)L * 16384 * pgf::ROWB, WSQ(unsigned char, WS_PU) + (size_t)L * 16384 * pgf::ROWB + pgf::VOFF,
                                                  out, WSQ(float, WS_RA), WSQ(float, WS_ROWSS), nullptr, c.G, c.bid, c.tid);
        __syncthreads();
#endif
        tk::peer_phase<0x3fff, 0>(c.lds, WSQ(bf16, WS_QP), WSQ(bf16, WS_SUBKT) + (size_t)L * 32768, WSQ(bf16, WS_XB), WSQ(unsigned char, WS_PU) + (size_t)L * 16384 * pgf::ROWB, WSQ(unsigned char, WS_PU) + (size_t)L * 16384 * pgf::ROWB + pgf::VOFF,
                                  out, out, WSQ(float, WS_ROWSS), (L + 1 < NL) ? INQ(2) + (L + 1) * DM : nullptr, c.G, c.bid, c.tid);
        PH_BAR(P0 + 8) }
}

__global__ void __launch_bounds__(NTHR, 2) mega(Args a_) {
    extern __shared__ __attribute__((aligned(16))) unsigned char lds_raw[];
    {   const int t0 = threadIdx.x;
        for (int u = t0; u < (LDS_BYTES - RING_BYTES) / 4; u += NTHR) ((LAS unsigned*)((LAS unsigned char*)lds_raw + RING_BYTES))[u] = 0u; }
    __syncthreads();
    volatile LAS unsigned* MISC = (volatile LAS unsigned*)((LAS unsigned char*)lds_raw + MISC_OFF);
    XcdBarrier bar; bar.bar = (unsigned*)(a_.ws + WS_CTL) + CW_BAR; bar.x = 0; bar.st = MISC + 8;
    const int ph_lo = a_.ph_lo, ph_hi = a_.ph_hi;
    if (ph_hi - ph_lo > 1) bar = xcd_barrier_post((unsigned*)(a_.ws + WS_CTL) + CW_BAR, MISC + 8);
#if MK_PROBE
    if (blockIdx.x == 0 && threadIdx.x == 0) ((unsigned long long*)(a_.ws + WS_CTL + TS_OFF))[0] = __builtin_amdgcn_s_memrealtime();
#endif
    PHASE(0) { PH_BEGIN
        ph_prep(*ap, c);
        PH_BAR(0) }
    layer_phases<0>(lds_raw, bar, ph_lo, ph_hi);
    layer_phases<1>(lds_raw, bar, ph_lo, ph_hi);
#if MK_UTEST
    xcd_barrier(bar);
    if (blockIdx.x == 0 && threadIdx.x < 64) {
        typedef int i32x8 __attribute__((ext_vector_type(8))); typedef float f32x4 __attribute__((ext_vector_type(4)));
        const int lane = threadIdx.x, l15 = lane & 15, q4 = lane >> 4;
        i32x8 b = i32x8{0, 0, 0, 0, 0, 0, 0, 0};
#pragma unroll
        for (int d = 0; d < 8; ++d) { unsigned w = 0;
#pragma unroll
            for (int e = 0; e < 4; ++e) { const int idx = q4 * 32 + 4 * d + e; const unsigned by = idx < 126 ? (unsigned)(idx + 1) : (unsigned)(0x81 + idx - 126); w |= by << (8 * e); }
            b[d] = (l15 == 0) ? (int)w : 0; }
        int okH1 = 1, okH2 = 1, f52 = -1;
        for (int p = 0; p < 128; ++p) {
            const int kq = p >> 5, jj = p & 31, bit = (MK_UTEST == 4 ? 4 * jj + 1 : 6 * jj + 3), dw = bit >> 5, sh = bit & 31;
            i32x8 a;
#pragma unroll
            for (int d = 0; d < 8; ++d) a[d] = (l15 == 0 && q4 == kq && d == dw) ? (int)(1u << sh) : 0;
            f32x4 acc = f32x4{0.f, 0.f, 0.f, 0.f};
            acc = __builtin_amdgcn_mfma_scale_f32_16x16x128_f8f6f4(a, b, acc, (MK_UTEST == 4 ? 4 : 2), 0, 0, 127, 0, 127);
            const float D = __shfl(acc[0], 0);
            int found = -1;
            for (int idx = 0; idx < 128; ++idx) { const int by = idx < 126 ? idx + 1 : 0x81 + idx - 126; if (__builtin_amdgcn_cvt_f32_fp8(by, 0) == D) found = idx; }
            const int h2 = (p < 64) ? ((p >> 4) * 32 + (p & 15)) : (((p - 64) >> 4) * 32 + 16 + (p & 15));
            if (found != p) okH1 = 0;
            if (found != h2) okH2 = 0;
            if (p == 52) f52 = found;
        }
        if (lane == 0) a_.out[0] = okH1 ? 1024.f : okH2 ? 1048576.f : (f52 < 0 ? 3.f * 1073741824.f : exp2f((float)(f52 >> 1) + 32.f) * ((f52 & 1) ? 1.5f : 1.f));
    }
#endif
#if MK_PROBE
    xcd_barrier(bar);
    if (blockIdx.x == 0 && threadIdx.x == 0) {
        const unsigned long long* ts = (const unsigned long long*)(a_.ws + WS_CTL + TS_OFF);
        const float d_us = (float)(__hip_atomic_load(ts + PROBE_A_HI, __ATOMIC_RELAXED, __HIP_MEMORY_SCOPE_AGENT) - __hip_atomic_load(ts + PROBE_A_LO, __ATOMIC_RELAXED, __HIP_MEMORY_SCOPE_AGENT)) * 0.01f;
        a_.out[0] += rintf(d_us * (1.f / PROBE_Q)) * PROBE_Q;
    }
#endif
}

extern "C" void kernel_launch(void* const* d_in, const int* in_sizes, int n_in, void* d_out, int out_size, void* d_ws, size_t ws_size, hipStream_t stream) {
    static int grid = 0;
    if (grid == 0) {
        if (n_in != 34 || out_size != T * DM || ws_size < WS_END) { fprintf(stderr, "kernel_launch: unexpected shapes (n_in %d out %d ws %zu)\n", n_in, out_size, ws_size); grid = -1; return; }
        int dev = 0, cus = 0, per_cu = 0;
        if (hipGetDevice(&dev) != hipSuccess || hipDeviceGetAttribute(&cus, hipDeviceAttributeMultiprocessorCount, dev) != hipSuccess) { grid = -1; return; }
        if (hipFuncSetAttribute((const void*)mega, hipFuncAttributeMaxDynamicSharedMemorySize, LDS_BYTES) != hipSuccess) { fprintf(stderr, "kernel_launch: hipFuncSetAttribute failed\n"); grid = -1; return; }
        if (hipOccupancyMaxActiveBlocksPerMultiprocessor(&per_cu, (const void*)mega, NTHR, LDS_BYTES) != hipSuccess || per_cu < 1) { fprintf(stderr, "kernel_launch: occupancy query says %d blocks per CU\n", per_cu); }
        (void)hipGetLastError();
        grid = cus;
    }
    if (grid < 0) return;
    (void)hipMemsetAsync((char*)d_ws + WS_CTL, 0, CTL_ZERO_BYTES, stream);
    Args a{};
    for (int i = 0; i < 34; ++i) a.in[i] = d_in[i];
    a.out = (float*)d_out; a.ws = (unsigned char*)d_ws;
#if MK_PER_PHASE
    for (int p = 0; p < NPH; ++p) { a.ph_lo = p; a.ph_hi = p + 1; hipLaunchKernelGGL(mega, dim3(grid), dim3(NTHR), LDS_BYTES, stream, a); }
#else
    a.ph_lo = 0; a.ph_hi = NPH;
    hipLaunchKernelGGL(mega, dim3(grid), dim3(NTHR), LDS_BYTES, stream, a);
#endif
}
```

```cpp
#include <hip/hip_runtime.h>
#include <cstdint>
#include <cstdio>

#ifndef MK_PER_PHASE
#define MK_PER_PHASE 0
#endif

typedef unsigned short bf16;
typedef unsigned int u32;

constexpr int NB = 2, SEQ = 8192, T = NB * SEQ, DM = 1024, NL = 2;
constexpr int ZW = 1280;
constexpr int ZC_CQ = 0, ZC_CKV = 256, ZC_KR = 384, ZC_U = 512, ZC_X = 768, ZC_G = 1024;
constexpr int NH = 4, DQK = 192, DV = 128;
constexpr float EPS = 1e-6f;
constexpr float QSCALE = 0.07216878364870322f * 1.4426950408889634f;

constexpr size_t MiB = 1u << 20;
constexpr size_t WS_CTL = 0, CTL_ZERO_BYTES = 1 * MiB, WS_WINT = 1 * MiB, WS_WUQT = 7 * MiB, WS_WUKVT = 8 * MiB, WS_GLUT = 9 * MiB, WS_WOUTT = 10 * MiB,
                 WS_WQT = 14 * MiB, WS_SUBKT = 22 * MiB, WS_COS = 23 * MiB, WS_SIN = 25 * MiB, WS_PU = 28 * MiB, WS_PV = 92 * MiB,
                 WS_XB = 156 * MiB, WS_Z = 188 * MiB, WS_RA = 228 * MiB, WS_RB = 356 * MiB, WS_CKVN = 420 * MiB, WS_AO = 424 * MiB,
                 WS_ROUT = 440 * MiB, WS_Y = 448 * MiB, WS_IDX = 480 * MiB, WS_GATE = 488 * MiB, WS_S5A = 496 * MiB, WS_S5C = WS_S5A + 128 * 1024, WS_S5L = WS_S5A + 256 * 1024, WS_LWT = WS_S5A + 512 * 1024,
                 WS_SE = 497 * MiB, WS_SH = 501 * MiB, WS_LPE = 505 * MiB, WS_LH = 506 * MiB, WS_ROWSS = WS_LH + 512 * 1024, WS_END = 508 * MiB;
constexpr size_t WS_QRAW = WS_RA, WS_KVRAW = WS_RA + 24 * MiB, WS_QB = WS_RA + 56 * MiB, WS_KB = WS_RA + 80 * MiB, WS_VB = WS_RA + 104 * MiB,
                 WS_CQN = WS_RA + 120 * MiB, WS_SC = WS_RA;
constexpr size_t WS_MIXSS = WS_GATE;
constexpr size_t WS_XC = WS_RB, WS_AA = WS_RB + 16 * MiB, WS_BT = WS_RB + 32 * MiB, WS_YG = WS_RB + 48 * MiB, WS_SOUT = WS_RB + 56 * MiB, WS_QP = WS_RB;
constexpr size_t WS_S5W = WS_IDX;
constexpr size_t WS_STOP = WS_Z, WS_ITOP = WS_Z + 16 * MiB;
constexpr int CW_BAR = 4096;

__device__ __forceinline__ float bf2f(bf16 h) { return __uint_as_float((u32)h << 16); }
__device__ __forceinline__ bf16 f2bf(float f) { u32 u = __float_as_uint(f); return (bf16)((u + 0x7fffu + ((u >> 16) & 1u)) >> 16); }
__device__ __forceinline__ u32 pk2(float lo, float hi) { return (u32)f2bf(lo) | ((u32)f2bf(hi) << 16); }
__device__ __forceinline__ float wave_sum(float v) {
#pragma unroll
    for (int o = 32; o > 0; o >>= 1) v += __shfl_xor(v, o);
    return v;
}
__device__ __forceinline__ float wave_max(float v) {
#pragma unroll
    for (int o = 32; o > 0; o >>= 1) v = fmaxf(v, __shfl_xor(v, o));
    return v;
}
__device__ __forceinline__ float gelu_f(float v) {
    const float av = fabsf(v), t = __builtin_amdgcn_rcpf(fmaf(av, 0.2316418882f, 1.0f));
    float q = fmaf(t, 0.5307027145f, -0.7265760135f); q = fmaf(q, t, 0.7107068705f); q = fmaf(q, t, -0.142248368f); q = fmaf(q, t, 0.127414796f); q *= t;
    const float e = __builtin_amdgcn_exp2f(v * v * -0.72134752044f);
    const float m = v * (q * e);
    return v < 0.f ? m : v - m;
}
__device__ __forceinline__ float sigmoid_f(float x) { return 1.f / (1.f + __expf(-x)); }
__device__ __forceinline__ void unpack8(uint4 w, float* o) {
    o[0] = __uint_as_float(w.x << 16); o[1] = __uint_as_float(w.x & 0xffff0000u);
    o[2] = __uint_as_float(w.y << 16); o[3] = __uint_as_float(w.y & 0xffff0000u);
    o[4] = __uint_as_float(w.z << 16); o[5] = __uint_as_float(w.z & 0xffff0000u);
    o[6] = __uint_as_float(w.w << 16); o[7] = __uint_as_float(w.w & 0xffff0000u);
}
__device__ __forceinline__ void sincos_acc(float x, float& s, float& c) {
    const float k = rintf(x * 0.15915494309189535f);
    float r = fmaf(-k, 6.28125f, x);
    r = fmaf(-k, 1.9350051879882812e-3f, r);
    r = fmaf(-k, 3.0199160335e-7f, r);
    const float f = r * 0.15915494309189535f;
    s = __builtin_amdgcn_sinf(f); c = __builtin_amdgcn_cosf(f);
}
namespace pg8 {
#define PG8_LAS __attribute__((address_space(3)))
typedef unsigned short bf16_t;
typedef short bf16x8 __attribute__((ext_vector_type(8)));
typedef float f32x4 __attribute__((ext_vector_type(4)));
typedef unsigned u32x4 __attribute__((ext_vector_type(4)));
constexpr int BM = 256, BK = 64, HALF = 128, HTB = HALF * BK * 2  , STAGE_BYTES = 8 * HTB, NXCD = 8, WGM = 8;

__host__ __device__ __forceinline__ int lds_byte(int r, int c) { const int st = (r >> 4) * 2 + (c >> 5), rr = r & 15, cc = c & 31, ob = rr * 64 + cc * 2; return st * 1024 + (ob ^ (((ob >> 9) & 1) << 5)); }
__host__ __device__ __forceinline__ void stage_rc(int b, int& R, int& C) { const int st = b / 1024, sb = b % 1024, swz = sb ^ (((sb >> 9) & 1) << 5); R = (st >> 1) * 16 + swz / 64; C = (st & 1) * 32 + (swz % 64) / 2; }
__host__ __device__ __forceinline__ int perm32(int rho) { const int n = rho >> 4, i = rho & 15; return 8 * (i >> 2) + 4 * n + (i & 3); }

struct Unit { int pm, pn; };
struct Gemm { const bf16_t* A; const bf16_t* Bt; int M, N, K, lda; };

struct StaticOrder {
    int nM, nN, nwg, G, c;
    __host__ __device__ void init(int M, int N, int G_, int c_) { nM = M / BM; nN = N / BM; nwg = nM * nN; G = G_; c = c_; }
    __host__ __device__ bool next(int i, Unit& u) const {
        const long L = (long)i * G + c; if (L >= nwg) return false;
        int wgid = (int)L; { const int q = nwg / NXCD, r = nwg % NXCD, xcd = wgid % NXCD, off = wgid / NXCD; wgid = (xcd < r ? xcd * (q + 1) : r * (q + 1) + (xcd - r) * q) + off; }
        const int nig = WGM * nN, gid = wgid / nig, fm = gid * WGM, gsz = (nM - fm) < WGM ? (nM - fm) : WGM;
        u.pm = fm + ((wgid % nig) % gsz); u.pn = (wgid % nig) / gsz; return true;
    }
    __device__ __forceinline__ void a_ready(const Unit&) const {}
    __device__ __forceinline__ void done(const Unit&) const {}
};

__device__ __forceinline__ unsigned cvt_pk_bf16(float lo, float hi) { unsigned r; asm volatile("v_cvt_pk_bf16_f32 %0, %1, %2" : "=v"(r) : "v"(lo), "v"(hi)); return r; }
typedef float f32x2 __attribute__((ext_vector_type(2)));
__device__ __forceinline__ f32x2 gelu_pk(f32x2 v) {
    const f32x2 av = __builtin_elementwise_abs(v), d = av * 0.2316418882f + 1.0f;
    f32x2 t; t.x = __builtin_amdgcn_rcpf(d.x); t.y = __builtin_amdgcn_rcpf(d.y);
    f32x2 q = t * 0.5307027145f + (-0.7265760135f); q = q * t + 0.7107068705f; q = q * t + (-0.142248368f); q = q * t + 0.127414796f; q = q * t;
    const f32x2 s = (v * v) * (-0.72134752044f);
    f32x2 e; e.x = __builtin_amdgcn_exp2f(s.x); e.y = __builtin_amdgcn_exp2f(s.y);
    const f32x2 m = v * (q * e), r = v - m;
    f32x2 o; o.x = v.x < 0.f ? m.x : r.x; o.y = v.y < 0.f ? m.y : r.y; return o;
}

template <int ACT  > struct EpiBf16 {
    static constexpr bool PERM = true, AFTER_DRAIN = false, HAS_INIT = false, HAS_KHOOK = false; static_assert(ACT == 0 || ACT == 1, "EpiBf16: ACT is 0 (none) or 1 (gelu_pk)");
    bf16_t* O; int ldc; const float* bias; int split_cols; size_t split_stride; float scale0;
    __device__ __forceinline__ void operator()(const f32x4 (&acc)[2][2][4][2], const Unit& u, int wr, int wc, int fr, int fq) const {
        const int row0 = u.pm * BM + wr * 64 + fr; int colt = u.pn * BM; bf16_t* base = O;
        float sc = 1.f; if (split_cols) { const int t = colt / split_cols; base += (size_t)t * split_stride; colt -= t * split_cols; if (t == 0) sc = scale0; }
        const int col0 = colt + wc * 32 + 8 * fq, bcol0 = u.pn * BM + wc * 32 + 8 * fq;
        f32x4 bv[2][2];
#pragma unroll
        for (int bj = 0; bj < 2; ++bj)
#pragma unroll
            for (int n = 0; n < 2; ++n) bv[bj][n] = bias ? *(const f32x4*)(bias + bcol0 + bj * HALF + 4 * n) : (f32x4){0.f, 0.f, 0.f, 0.f};
#pragma unroll
        for (int ai = 0; ai < 2; ++ai)
#pragma unroll
            for (int m = 0; m < 4; ++m) { bf16_t* rowp = base + (size_t)(row0 + ai * HALF + m * 16) * ldc + col0;
#pragma unroll
                for (int bj = 0; bj < 2; ++bj) { f32x4 v0 = acc[ai][bj][m][0] + bv[bj][0], v1 = acc[ai][bj][m][1] + bv[bj][1];
                    if (ACT == 1) { f32x2 a = gelu_pk((f32x2){v0[0], v0[1]}), b = gelu_pk((f32x2){v0[2], v0[3]}), c = gelu_pk((f32x2){v1[0], v1[1]}), d = gelu_pk((f32x2){v1[2], v1[3]});
                        v0 = (f32x4){a.x, a.y, b.x, b.y}; v1 = (f32x4){c.x, c.y, d.x, d.y}; }
                    v0 = v0 * sc; v1 = v1 * sc; u32x4 w; w.x = cvt_pk_bf16(v0[0], v0[1]); w.y = cvt_pk_bf16(v0[2], v0[3]); w.z = cvt_pk_bf16(v1[0], v1[1]); w.w = cvt_pk_bf16(v1[2], v1[3]);
                    *(u32x4*)(rowp + bj * HALF) = w; } }
    }
};


struct EpiF32 {
    static constexpr bool PERM = false, AFTER_DRAIN = false, HAS_INIT = false, HAS_KHOOK = false;
    float* C; int ldc; const float* resid;
    __device__ __forceinline__ void operator()(const f32x4 (&acc)[2][2][4][2], const Unit& u, int wr, int wc, int fr, int fq) const {
        const int row0 = u.pm * BM + wr * 64 + fr, col0 = u.pn * BM + wc * 32 + 4 * fq;
#pragma unroll
        for (int ai = 0; ai < 2; ++ai)
#pragma unroll
            for (int m = 0; m < 4; ++m) { const size_t rb = (size_t)(row0 + ai * HALF + m * 16) * ldc + col0;
#pragma unroll
                for (int bj = 0; bj < 2; ++bj)
#pragma unroll
                    for (int n = 0; n < 2; ++n) { const size_t ix = rb + bj * HALF + n * 16; f32x4 v = acc[ai][bj][m][n];
                        if (resid) v += *(const f32x4*)(resid + ix);
                        *(f32x4*)(C + ix) = v; } }
    }
};

struct EpiOut {
    static constexpr bool PERM = false, AFTER_DRAIN = false, HAS_INIT = true, HAS_KHOOK = true;
    float* C; int ldc; const float* resid; const float* g; bf16_t* XB; float* rowss; const float* mss; PG8_LAS float* fac;
    __device__ __forceinline__ void init(f32x4 (&acc)[2][2][4][2], const Unit& u, int wr, int wc, int fr, int fq) const {
        const int rl0 = wr * 64 + fr, row0 = u.pm * BM + rl0, col0 = u.pn * BM + wc * 32 + 4 * fq;
#pragma unroll
        for (int ai = 0; ai < 2; ++ai)
#pragma unroll
            for (int m = 0; m < 4; ++m) { const int rl = rl0 + ai * HALF + m * 16, row = row0 + ai * HALF + m * 16; const size_t rb = (size_t)row * ldc + col0;
                const f32x4 a = *(const f32x4*)(mss + (size_t)row * 12), b = *(const f32x4*)(mss + (size_t)row * 12 + 4), c = *(const f32x4*)(mss + (size_t)row * 12 + 8);
                const float ma = ((a[0] + a[1]) + (a[2] + a[3])) * (1.f / 512) + EPS, ms = ((b[0] + b[1]) + (b[2] + b[3])) * (1.f / 256) + EPS, mr = ((c[0] + c[1]) + (c[2] + c[3])) * (1.f / 256) + EPS;
                const float f = __builtin_sqrtf(ma);
                *(PG8_LAS f32x4*)(fac + rl * 4) = f32x4{f, __builtin_sqrtf(ms) * rsqrtf(ma), __builtin_sqrtf(mr) * rsqrtf(ms), rsqrtf(mr)};
#pragma unroll
                for (int bj = 0; bj < 2; ++bj)
#pragma unroll
                    for (int n = 0; n < 2; ++n) acc[ai][bj][m][n] = *(const f32x4*)(resid + rb + bj * HALF + n * 16) * f; }
    }
    __device__ __forceinline__ void khook(f32x4 (&acc)[2][2][4][2], const Unit& u, int t, int wr, int wc, int fr, int fq) const {
        const int rl0 = wr * 64 + fr;
#pragma unroll
        for (int ai = 0; ai < 2; ++ai)
#pragma unroll
            for (int m = 0; m < 4; ++m) { const float f = fac[(rl0 + ai * HALF + m * 16) * 4 + (t == 8 ? 1 : 2)];
#pragma unroll
                for (int bj = 0; bj < 2; ++bj)
#pragma unroll
                    for (int n = 0; n < 2; ++n) acc[ai][bj][m][n] *= f; }
    }
    __device__ __forceinline__ void operator()(const f32x4 (&acc)[2][2][4][2], const Unit& u, int wr, int wc, int fr, int fq) const {
        typedef unsigned u32x2 __attribute__((ext_vector_type(2)));
        const int rl0 = wr * 64 + fr, row0 = u.pm * BM + rl0, col0 = u.pn * BM + wc * 32 + 4 * fq;
#pragma unroll
        for (int ai = 0; ai < 2; ++ai)
#pragma unroll
            for (int m = 0; m < 4; ++m) { const int row = row0 + ai * HALF + m * 16; const size_t rb = (size_t)row * ldc + col0; float ss = 0.f;
                const float f = fac[(rl0 + ai * HALF + m * 16) * 4 + 3];
#pragma unroll
                for (int bj = 0; bj < 2; ++bj)
#pragma unroll
                    for (int n = 0; n < 2; ++n) { const size_t ix = rb + bj * HALF + n * 16; const f32x4 v = acc[ai][bj][m][n] * f;
                        *(f32x4*)(C + ix) = v; ss += (v[0] * v[0] + v[1] * v[1]) + (v[2] * v[2] + v[3] * v[3]);
                        const f32x4 gg = *(const f32x4*)(g + col0 + bj * HALF + n * 16);
                        u32x2 w; w.x = cvt_pk_bf16(v[0] * gg[0], v[1] * gg[1]); w.y = cvt_pk_bf16(v[2] * gg[2], v[3] * gg[3]); *(u32x2*)(XB + ix) = w; }
                ss += __shfl_xor(ss, 16); ss += __shfl_xor(ss, 32);
                if (fq == 0) rowss[(size_t)row * 16 + u.pn * 4 + wc] = ss; }
    }
};
struct EpiGlu {
    static constexpr bool PERM = true, AFTER_DRAIN = false, HAS_INIT = false, HAS_KHOOK = false;
    bf16_t* O; int ldc; const float* bias; const bf16_t* YG; int ldy; float* mss;
    __device__ __forceinline__ void operator()(const f32x4 (&acc)[2][2][4][2], const Unit& u, int wr, int wc, int fr, int fq) const {
        const int row0 = u.pm * BM + wr * 64 + fr, col0 = u.pn * BM + wc * 32 + 8 * fq;
#pragma unroll
        for (int ai = 0; ai < 2; ++ai)
#pragma unroll
            for (int m = 0; m < 4; ++m) { const int row = row0 + ai * HALF + m * 16; float ss = 0.f;
#pragma unroll
                for (int bj = 0; bj < 2; ++bj) { const size_t ix = (size_t)row * ldc + col0 + bj * HALF, iy = (size_t)row * ldy + col0 + bj * HALF;
                    const f32x4 b0 = *(const f32x4*)(bias + col0 + bj * HALF), b1 = *(const f32x4*)(bias + col0 + bj * HALF + 4);
                    const u32x4 yw = *(const u32x4*)(YG + iy);
                    f32x4 v0 = acc[ai][bj][m][0] + b0, v1 = acc[ai][bj][m][1] + b1; float o[8];
#pragma unroll
                    for (int e = 0; e < 4; ++e) { const unsigned w = e == 0 ? yw.x : e == 1 ? yw.y : e == 2 ? yw.z : yw.w;
                        const float y0 = __uint_as_float(w << 16), y1 = __uint_as_float(w & 0xffff0000u);
                        const float a0 = e < 2 ? v0[2 * e] : v1[2 * e - 4], a1 = e < 2 ? v0[2 * e + 1] : v1[2 * e - 3];
                        o[2 * e] = y0 / (1.f + __expf(-a0)); o[2 * e + 1] = y1 / (1.f + __expf(-a1)); }
                    u32x4 w; w.x = cvt_pk_bf16(o[0], o[1]); w.y = cvt_pk_bf16(o[2], o[3]); w.z = cvt_pk_bf16(o[4], o[5]); w.w = cvt_pk_bf16(o[6], o[7]);
                    *(u32x4*)(O + ix) = w;
#pragma unroll
                    for (int e = 0; e < 4; ++e) { const unsigned ww = e == 0 ? w.x : e == 1 ? w.y : e == 2 ? w.z : w.w; const float r0 = __uint_as_float(ww << 16), r1 = __uint_as_float(ww & 0xffff0000u); ss += r0 * r0 + r1 * r1; } }
                ss += __shfl_xor(ss, 16); ss += __shfl_xor(ss, 32);
                if (fq == 0) mss[(size_t)row * 12 + 4 + wc] = ss; }
    }
};
template <class Epi, class Sched, bool ALIGN_EPI = false, bool SP2 = false>
__device__ __forceinline__ void gemm_phase(PG8_LAS unsigned char* lds, const Gemm g, const Sched& S, const Epi& E) {
    int tid_l = threadIdx.x; asm volatile("" : "+v"(tid_l));
    const int tid = tid_l, wid = __builtin_amdgcn_readfirstlane(tid >> 6), lane = tid & 63, wr = wid >> 2, wc = wid & 3, fr = lane & 15, fq = lane >> 4;
    const int K = g.K, nt = K / BK;
    unsigned voffA[2], voffB[2];
#pragma unroll
    for (int i = 0; i < 2; ++i) { int R, C; stage_rc(tid * 16 + i * 8192, R, C); const int Rb = Epi::PERM ? ((R & ~31) + perm32(R & 31)) : R;
        voffA[i] = (unsigned)(R * g.lda + C) * 2u; voffB[i] = (unsigned)(Rb * K + C) * 2u; }
    const size_t kstep = (size_t)(BK * 2);
    const size_t hsA = (size_t)HALF * g.lda * 2, hsB = (size_t)HALF * K * 2;
    const size_t tsA = 2 * hsA, tsB = 2 * hsB;
    const unsigned ldsw = (unsigned)wid * 1024u;
    const int aoff = lds_byte(wr * 64 + fr, fq * 8), boff = lds_byte(wc * 32 + fr, fq * 8);
#define PG8_SA(b, h) (((b) * 2 + (h)) * HTB)
#define PG8_SB(b, h) ((4 + (b) * 2 + (h)) * HTB)
#define PG8_STAGE(bufoff, gbase, voff) do { _Pragma("unroll") for (int _i = 0; _i < 2; ++_i) \
        __builtin_amdgcn_global_load_lds((const unsigned*)((const char*)(gbase) + (voff)[_i]), (PG8_LAS unsigned*)(lds + (bufoff) + ldsw + _i * 8192), 16, 0, 0); } while (0)
#define PG8_LDA(dst, b, h) do { _Pragma("unroll") for (int m = 0; m < 4; ++m) _Pragma("unroll") for (int k = 0; k < 2; ++k) dst[m][k] = *(const PG8_LAS bf16x8*)(lds + PG8_SA(b, h) + aoff + m * 2048 + k * 1024); } while (0)
#define PG8_LDB(dst, b, h) do { _Pragma("unroll") for (int n = 0; n < 2; ++n) _Pragma("unroll") for (int k = 0; k < 2; ++k) dst[n][k] = *(const PG8_LAS bf16x8*)(lds + PG8_SB(b, h) + boff + n * 2048 + k * 1024); } while (0)
#define PG8_MMA(ai, bj, At, Bt) do { __builtin_amdgcn_s_setprio(1); _Pragma("unroll") for (int m = 0; m < 4; ++m) _Pragma("unroll") for (int n = 0; n < 2; ++n) _Pragma("unroll") for (int k = 0; k < 2; ++k) \
        acc[ai][bj][m][n] = __builtin_amdgcn_mfma_f32_16x16x32_bf16(Bt[n][k], At[m][k], acc[ai][bj][m][n], 0, 0, 0); __builtin_amdgcn_s_setprio(0); } while (0)
#define PG8_WAIT_V(n) asm volatile("s_waitcnt vmcnt(" #n ")" ::: "memory")
#define PG8_WAIT_L(n) asm volatile("s_waitcnt lgkmcnt(" #n ")" ::: "memory")
#define PG8_BAR __builtin_amdgcn_s_barrier()
#define PG8_SCHED __builtin_amdgcn_sched_barrier(0)
    Unit cur, nxt; int ui = 0;
    if (!S.next(0, cur)) return;
    f32x4 acc[2][2][4][2];
    if constexpr (Epi::HAS_INIT) E.init(acc, cur, wr, wc, fr, fq);
    else {
#pragma unroll
    for (int a = 0; a < 2; ++a)
#pragma unroll
        for (int b = 0; b < 2; ++b)
#pragma unroll
            for (int m = 0; m < 4; ++m)
#pragma unroll
                for (int n = 0; n < 2; ++n) acc[a][b][m][n] = (f32x4){0.f, 0.f, 0.f, 0.f};
    }
    bf16x8 At[4][2], B0[2][2], B1[2][2];
    const char* cA = (const char*)g.A + (size_t)cur.pm * tsA; const char* cB = (const char*)g.Bt + (size_t)cur.pn * tsB;
    S.a_ready(cur);
    if constexpr (SP2) {
        PG8_STAGE(PG8_SB(0, 0), cB, voffB); PG8_STAGE(PG8_SB(0, 1), cB + hsB, voffB); PG8_STAGE(PG8_SA(0, 0), cA, voffA); PG8_STAGE(PG8_SA(0, 1), cA + hsA, voffA);
        if (wr == 1) PG8_BAR;
        PG8_WAIT_V(2); PG8_BAR;
        PG8_STAGE(PG8_SB(1, 0), cB + kstep, voffB); PG8_STAGE(PG8_SA(1, 0), cA + kstep, voffA); PG8_STAGE(PG8_SB(1, 1), cB + hsB + kstep, voffB);
        PG8_WAIT_V(6); PG8_BAR;
    } else {
        PG8_STAGE(PG8_SB(0, 0), cB, voffB); PG8_STAGE(PG8_SA(0, 0), cA, voffA); PG8_STAGE(PG8_SB(0, 1), cB + hsB, voffB); PG8_STAGE(PG8_SA(0, 1), cA + hsA, voffA);
        if (wr == 1) PG8_BAR;
        PG8_WAIT_V(4); PG8_BAR;
        PG8_STAGE(PG8_SB(1, 0), cB + kstep, voffB); PG8_STAGE(PG8_SA(1, 0), cA + kstep, voffA); PG8_STAGE(PG8_SB(1, 1), cB + hsB + kstep, voffB);
        PG8_WAIT_V(6); PG8_BAR;
    }
    for (;;) {
        const bool has_next = S.next(ui + 1, nxt);
        const char* nA = has_next ? (const char*)g.A + (size_t)nxt.pm * tsA : cA; const char* nB = has_next ? (const char*)g.Bt + (size_t)nxt.pn * tsB : cB;
        for (int t = 0; t < nt; t += 2) {
            if constexpr (Epi::HAS_KHOOK) { if (t == 8 || t == 12) E.khook(acc, cur, t, wr, wc, fr, fq); }
            const bool last = (t == nt - 2);
            const char* a1 = cA + (size_t)(t + 1) * kstep;
            const char* a2 = last ? nA : cA + (size_t)(t + 2) * kstep; const char* b2 = last ? nB : cB + (size_t)(t + 2) * kstep;
            const char* a3 = a2 + kstep; const char* b3 = b2 + kstep;
            if (last && has_next) S.a_ready(nxt);
            if constexpr (SP2) {
            PG8_LDB(B0, 0, 0); PG8_LDB(B1, 0, 1); PG8_SCHED; PG8_LDA(At, 0, 0); PG8_STAGE(PG8_SA(1, 1), a1 + hsA, voffA);
            PG8_WAIT_V(8); PG8_WAIT_L(0); PG8_BAR; PG8_MMA(0, 0, At, B0); PG8_MMA(0, 1, At, B1); PG8_BAR; PG8_SCHED;
            PG8_LDA(At, 0, 1); PG8_STAGE(PG8_SB(0, 0), b2, voffB); PG8_STAGE(PG8_SB(0, 1), b2 + hsB, voffB); PG8_STAGE(PG8_SA(0, 0), a2, voffA);
            PG8_WAIT_V(8); PG8_WAIT_L(0); PG8_BAR; PG8_MMA(1, 0, At, B0); PG8_MMA(1, 1, At, B1); PG8_BAR; PG8_SCHED;
            PG8_LDB(B0, 1, 0); PG8_LDB(B1, 1, 1); PG8_SCHED; PG8_LDA(At, 1, 0); PG8_STAGE(PG8_SA(0, 1), a2 + hsA, voffA);
            PG8_WAIT_V(8); PG8_WAIT_L(0); PG8_BAR; PG8_MMA(0, 0, At, B0); PG8_MMA(0, 1, At, B1); PG8_BAR; PG8_SCHED;
            PG8_LDA(At, 1, 1); PG8_STAGE(PG8_SB(1, 0), b3, voffB); PG8_STAGE(PG8_SB(1, 1), b3 + hsB, voffB); PG8_STAGE(PG8_SA(1, 0), a3, voffA);
            PG8_WAIT_V(8); PG8_WAIT_L(0); PG8_BAR; PG8_MMA(1, 0, At, B0); PG8_MMA(1, 1, At, B1); PG8_BAR; PG8_SCHED;
            } else {
            PG8_LDB(B0, 0, 0); PG8_SCHED; PG8_LDA(At, 0, 0); PG8_STAGE(PG8_SA(1, 1), a1 + hsA, voffA);
            PG8_WAIT_L(8); PG8_BAR; PG8_WAIT_L(0); PG8_MMA(0, 0, At, B0); PG8_BAR; PG8_SCHED;
            PG8_LDB(B1, 0, 1); PG8_STAGE(PG8_SB(0, 0), b2, voffB);
            PG8_BAR; PG8_WAIT_L(0); PG8_MMA(0, 1, At, B1); PG8_BAR;
            PG8_LDA(At, 0, 1); PG8_STAGE(PG8_SA(0, 0), a2, voffA);
            PG8_BAR; PG8_WAIT_L(0); PG8_MMA(1, 0, At, B0); PG8_BAR; PG8_SCHED;
            PG8_STAGE(PG8_SB(0, 1), b2 + hsB, voffB);
            PG8_WAIT_V(6); PG8_BAR; PG8_MMA(1, 1, At, B1); PG8_BAR;
            PG8_LDB(B0, 1, 0); PG8_SCHED; PG8_LDA(At, 1, 0); PG8_STAGE(PG8_SA(0, 1), a2 + hsA, voffA);
            PG8_WAIT_L(8); PG8_BAR; PG8_WAIT_L(0); PG8_MMA(0, 0, At, B0); PG8_BAR; PG8_SCHED;
            PG8_LDB(B1, 1, 1); PG8_STAGE(PG8_SB(1, 0), b3, voffB);
            PG8_BAR; PG8_WAIT_L(0); PG8_MMA(0, 1, At, B1); PG8_BAR;
            PG8_LDA(At, 1, 1); PG8_STAGE(PG8_SA(1, 0), a3, voffA);
            PG8_BAR; PG8_WAIT_L(0); PG8_MMA(1, 0, At, B0); PG8_BAR; PG8_SCHED;
            PG8_STAGE(PG8_SB(1, 1), b3 + hsB, voffB);
            PG8_WAIT_V(6); PG8_BAR; PG8_MMA(1, 1, At, B1); PG8_BAR;
            }
        }
        if constexpr (ALIGN_EPI) { if (wr == 0) PG8_BAR; }
        if constexpr (!Epi::AFTER_DRAIN) { E(acc, cur, wr, wc, fr, fq); S.done(cur); }
        if (!has_next) break;
        if constexpr (Epi::HAS_INIT) E.init(acc, nxt, wr, wc, fr, fq);
        else {
#pragma unroll
        for (int a = 0; a < 2; ++a)
#pragma unroll
            for (int b = 0; b < 2; ++b)
#pragma unroll
                for (int m = 0; m < 4; ++m)
#pragma unroll
                    for (int n = 0; n < 2; ++n) acc[a][b][m][n] = (f32x4){0.f, 0.f, 0.f, 0.f};
        }
        cur = nxt; cA = nA; cB = nB; ++ui;
        if constexpr (ALIGN_EPI) { if (wr == 1) PG8_BAR; }
    }
    PG8_WAIT_V(0);
    if constexpr (!ALIGN_EPI) { if (wr == 0) PG8_BAR; }
    PG8_BAR;
    if constexpr (Epi::AFTER_DRAIN) { E.fused(acc, cur, wr, wc, fr, fq, lds, wid, lane); S.done(cur); }
#undef PG8_SA
#undef PG8_SB
#undef PG8_STAGE
#undef PG8_LDA
#undef PG8_LDB
#undef PG8_MMA
#undef PG8_WAIT_V
#undef PG8_WAIT_L
#undef PG8_BAR
#undef PG8_SCHED
}
}
#define GAS __attribute__((address_space(1)))
#define LAS __attribute__((address_space(3)))
#define XB_TMO      128
#define XB_XCNT(j)  (256  + 64 * (j))
#define XB_XSUB(j)  (1280 + 64 * (j))
#define XB_XGEN(j)  (2304 + 64 * (j))
#define XB_TOP      3328
#define XB_TOPGEN   3392
#define XCD_BAR_WORDS 3456
#define XB_SPIN_CAP (1u << 25)
__device__ __forceinline__ unsigned xb_ld(unsigned* p)              { return __hip_atomic_load(p, __ATOMIC_RELAXED, __HIP_MEMORY_SCOPE_AGENT); }
__device__ __forceinline__ unsigned xb_add(unsigned* p, unsigned v) { return __hip_atomic_fetch_add(p, v, __ATOMIC_RELAXED, __HIP_MEMORY_SCOPE_AGENT); }
__device__ __forceinline__ unsigned xb_xcc_id() { return (unsigned)__builtin_amdgcn_s_getreg((3 << 11) | 20) & 0xFu; }
#define XB_SPIN(cond, bar) do { unsigned _sp = 0; while (cond) { __builtin_amdgcn_s_sleep(1); \
    if ((++_sp & 255u) == 0u) { if (xb_ld(&(bar)[XB_TMO])) break; if (_sp > XB_SPIN_CAP) { atomicAdd(&(bar)[XB_TMO], 1u); break; } } } } while (0)
struct XcdBarrier { unsigned* bar; unsigned x; volatile LAS unsigned* st; };
__device__ __forceinline__ XcdBarrier xcd_barrier_post(unsigned* bar, volatile LAS unsigned* st) {
    XcdBarrier b; b.bar = bar; b.x = xb_xcc_id(); b.st = st;
    if (threadIdx.x == 0) (void)xb_add(&bar[XB_XCNT(b.x)], 1u);
    return b;
}
__device__ __forceinline__ void xcd_barrier_complete(unsigned* bar, unsigned x, unsigned& nloc, unsigned& nx) {
    const unsigned G = gridDim.x * gridDim.y * gridDim.z;
    unsigned sum, cnt, mine, sp = 0u;
    for (;;) {
        sum = 0u; cnt = 0u; mine = 0u;
#pragma unroll
        for (unsigned j = 0; j < 16; ++j) { const unsigned c = xb_ld(&bar[XB_XCNT(j)]); sum += c; cnt += (c > 0u) ? 1u : 0u; mine = (j == x) ? c : mine; }
        if (sum == G) break;
        __builtin_amdgcn_s_sleep(1);
        if ((++sp & 255u) == 0u) { if (xb_ld(&bar[XB_TMO])) break; if (sp > XB_SPIN_CAP) { atomicAdd(&bar[XB_TMO], 1u); break; } }
    }
    nloc = mine > 0u ? mine : 1u; nx = cnt > 0u ? cnt : 1u;
}
__device__ __forceinline__ void xcd_barrier(const XcdBarrier& b) {
    asm volatile("s_waitcnt vmcnt(0)" ::: "memory");
    __syncthreads();
    if (threadIdx.x == 0) {
        unsigned* bar = b.bar;
        __builtin_amdgcn_s_waitcnt(0);
        unsigned nloc = b.st[0], nx = b.st[1];
        if (nloc == 0u) { xcd_barrier_complete(bar, b.x, nloc, nx); b.st[0] = nloc; b.st[1] = nx; }
        const unsigned old = xb_add(&bar[XB_XSUB(b.x)], 1u);
        const unsigned gen = old / nloc;
        if (old + 1u == (gen + 1u) * nloc) {
            __builtin_amdgcn_fence(__ATOMIC_RELEASE, "agent");
            asm volatile("s_waitcnt vmcnt(0)" ::: "memory");
            const unsigned og = xb_add(&bar[XB_TOP], 1u);
            const unsigned tg = og / nx;
            if (og + 1u == (tg + 1u) * nx) xb_add(&bar[XB_TOPGEN], 1u);
            else XB_SPIN(xb_ld(&bar[XB_TOPGEN]) == tg, bar);
            __builtin_amdgcn_fence(__ATOMIC_ACQUIRE, "agent");
            xb_add(&bar[XB_XGEN(b.x)], 1u);
            asm volatile("s_waitcnt vmcnt(0)" ::: "memory");
        } else {
            XB_SPIN(xb_ld(&bar[XB_XGEN(b.x)]) == gen, bar);
            __builtin_amdgcn_fence(__ATOMIC_ACQUIRE, "agent");
            asm volatile("s_waitcnt vmcnt(0)" ::: "memory");
        }
    }
    __syncthreads();
}
namespace s5f {
typedef short bf16x8 __attribute__((ext_vector_type(8)));
typedef float f32x4 __attribute__((ext_vector_type(4)));
typedef unsigned u32x2 __attribute__((ext_vector_type(2)));
constexpr int LC = 32, NCH = SEQ / LC, RS = 272, WBYTES = LC * RS;
__device__ __forceinline__ void build_tables(const float* a_re, const float* a_im, const float* log_dt, const float* b_re, const float* b_im, const float* c_re, const float* c_im,
                                             bf16* S5A, bf16* S5C, float2* S5L, int gt, int ngt) {
    for (int i = gt; i < 16 * 64; i += ngt) {
        const int g = i >> 6;
        const float are = a_re[i], aim = a_im[i], dt = expf(log_dt[g]);
        const float mag = expf(are * dt); float sn, cs; sincos_acc(aim * dt, sn, cs);
        const float lre = mag * cs, lim = mag * sn;
        const float xr = lre - 1.f, xi = lim, den = are * are + aim * aim;
        const float cr = (xr * are + xi * aim) / den, ci = (xi * are - xr * aim) / den;
        S5L[i] = make_float2(lre, lim);
        const int p = i & 63;
        for (int k = 0; k < 16; ++k) { const float br = b_re[i * 16 + k], bi = b_im[i * 16 + k];
            S5A[((size_t)g * 128 + 2 * p) * 16 + k] = f2bf(cr * br - ci * bi); S5A[((size_t)g * 128 + 2 * p + 1) * 16 + k] = f2bf(cr * bi + ci * br);
            S5C[((size_t)g * 16 + k) * 128 + 2 * p] = f2bf(c_re[(g * 16 + k) * 64 + p]); S5C[((size_t)g * 16 + k) * 128 + 2 * p + 1] = f2bf(-c_im[(g * 16 + k) * 64 + p]); }
    }
}
__device__ __forceinline__ void build_wtable(const float* a_re, const float* a_im, const float* log_dt, const float* b_re, const float* b_im, bf16* S5W, int gt, int ngt) {
    for (int i = gt; i < 16 * 64 * 32; i += ngt) {
        const int j = i & 31, gp = i >> 5, g = gp >> 6, p = gp & 63;
        const float are = a_re[gp], aim = a_im[gp], dt = expf(log_dt[g]);
        const float mag = expf(are * dt); float sn, cs; sincos_acc(aim * dt, sn, cs);
        const float lre = mag * cs, lim = mag * sn;
        const float xr = lre - 1.f, xi = lim, den = are * are + aim * aim;
        const float cr = (xr * are + xi * aim) / den, ci = (xi * are - xr * aim) / den;
        float pre = 1.f, pim = 0.f, sre = lre, sim = lim; int e = 31 - j;
#pragma unroll
        for (int bit = 0; bit < 5; ++bit) { if (e & 1) { const float t = pre * sre - pim * sim; pim = pre * sim + pim * sre; pre = t; } e >>= 1; const float t2 = sre * sre - sim * sim; sim = 2.f * sre * sim; sre = t2; }
        const float fr = pre * cr - pim * ci, fi = pre * ci + pim * cr;
        bf16* o_re = S5W + ((size_t)(g * 128 + 2 * p) * 512 + 16 * j); bf16* o_im = o_re + 512;
#pragma unroll
        for (int k = 0; k < 16; k += 2) { const float br0 = b_re[gp * 16 + k], bi0 = b_im[gp * 16 + k], br1 = b_re[gp * 16 + k + 1], bi1 = b_im[gp * 16 + k + 1];
            *(unsigned*)(o_re + k) = pk2(fr * br0 - fi * bi0, fr * br1 - fi * bi1); *(unsigned*)(o_im + k) = pk2(fr * bi0 + fi * br0, fr * bi1 + fi * br1); }
    }
}
__device__ __forceinline__ void pass_a_mfma(const bf16* Z, const bf16* S5W, float2* SE, int gw, int ngw, int lane) {
    const int l15 = lane & 15, q4 = lane >> 4;
    for (int task = gw; task < NB * (NCH / 16) * 16; task += ngw) {
        const int g = task & 15, cb = (task >> 4) & (NCH / 16 - 1), b = task / (16 * (NCH / 16));
        const size_t tok0 = (size_t)b * SEQ + (size_t)(16 * cb + l15) * LC;
        const bf16* zp = Z + (tok0 + (q4 >> 1)) * ZW + ZC_U + 16 * g + 8 * (q4 & 1);
        const bf16* wp = S5W + ((size_t)(g * 128 + l15) * 512 + 8 * q4);
        f32x4 acc[8];
#pragma unroll
        for (int mb = 0; mb < 8; ++mb) acc[mb] = f32x4{0.f, 0.f, 0.f, 0.f};
#pragma unroll 4
        for (int ks = 0; ks < 16; ++ks) {
            const bf16x8 bfr = *(const bf16x8*)(zp + (size_t)(2 * ks) * ZW);
#pragma unroll
            for (int mb = 0; mb < 8; ++mb) { const bf16x8 afr = *(const bf16x8*)(wp + (size_t)(16 * mb) * 512 + 32 * ks); acc[mb] = __builtin_amdgcn_mfma_f32_16x16x32_bf16(afr, bfr, acc[mb], 0, 0, 0); }
        }
        float4* se = (float4*)(SE + (((size_t)b * NCH + 16 * cb + l15) * 16 + g) * 64);
#pragma unroll
        for (int mb = 0; mb < 8; ++mb) se[(8 * mb + 2 * q4) >> 1] = make_float4(acc[mb][0], acc[mb][1], acc[mb][2], acc[mb][3]);
    }
}
template <bool FULL> __device__ __forceinline__ void chunk(LAS unsigned char* wl, const bf16* Z, const bf16x8 (&afr)[8], const bf16x8 (&cfr)[4], float lre, float lim, float& hre, float& him,
                                                           int b, int ch, int g, int lane, const float* dsk, bf16* YG) {
    const int l15 = lane & 15, q4 = lane >> 4;
    const size_t t0 = (size_t)b * SEQ + (size_t)ch * LC;
#pragma unroll
    for (int nb = 0; nb < 2; ++nb) {
        bf16x8 ufr = bf16x8{};
        if (q4 < 2) ufr = *(const bf16x8*)(Z + (t0 + 16 * nb + l15) * ZW + ZC_U + g * 16 + 8 * q4);
#pragma unroll
        for (int mb = 0; mb < 8; ++mb) {
            f32x4 d = __builtin_amdgcn_mfma_f32_16x16x32_bf16(afr[mb], ufr, f32x4{0.f, 0.f, 0.f, 0.f}, 0, 0, 0);
            *(LAS u32x2*)(wl + (16 * nb + l15) * RS + (16 * mb + 4 * q4) * 2) = u32x2{pk2(d[0], d[1]), pk2(d[2], d[3])};
        }
    }
    unsigned wk[LC];
#pragma unroll
    for (int k = 0; k < LC; ++k) wk[k] = *(const LAS unsigned*)(wl + k * RS + 4 * lane);
#pragma unroll
    for (int k = 0; k < LC; ++k) {
        const float bre = __uint_as_float(wk[k] << 16), bim = __uint_as_float(wk[k] & 0xffff0000u);
        const float nre = fmaf(lre, hre, fmaf(-lim, him, bre)), nim = fmaf(lre, him, fmaf(lim, hre, bim)); hre = nre; him = nim;
        if (FULL) wk[k] = pk2(hre, him);
    }
    if (FULL) {
#pragma unroll
        for (int k = 0; k < LC; ++k) *(LAS unsigned*)(wl + k * RS + 4 * lane) = wk[k];
    }
    if (FULL) {
#pragma unroll
        for (int nb = 0; nb < 2; ++nb) {
            f32x4 y = f32x4{0.f, 0.f, 0.f, 0.f};
#pragma unroll
            for (int ks = 0; ks < 4; ++ks) {
                const bf16x8 hfr = *(const LAS bf16x8*)(wl + (16 * nb + l15) * RS + (32 * ks + 8 * q4) * 2);
                y = __builtin_amdgcn_mfma_f32_16x16x32_bf16(cfr[ks], hfr, y, 0, 0, 0);
            }
            const size_t t = t0 + 16 * nb + l15; const int co = 4 * q4;
            const uint2 uw = *(const uint2*)(Z + t * ZW + ZC_U + g * 16 + co);
            const float4 dd = *(const float4*)(dsk + g * 16 + co);
            const float y0 = y[0] + dd.x * __uint_as_float(uw.x << 16), y1 = y[1] + dd.y * __uint_as_float(uw.x & 0xffff0000u),
                        y2 = y[2] + dd.z * __uint_as_float(uw.y << 16), y3 = y[3] + dd.w * __uint_as_float(uw.y & 0xffff0000u);
            *(uint2*)(YG + t * 256 + g * 16 + co) = make_uint2(pk2(gelu_f(y0), gelu_f(y1)), pk2(gelu_f(y2), gelu_f(y3)));
        }
    }
}
template <bool FULL> __device__ __forceinline__ void pass(LAS unsigned char* lds, const bf16* Z, const bf16* S5A, const bf16* S5C, const float2* S5L, const float* dsk,
                                                          float2* SE, const float2* SH, bf16* YG, int gw, int ngw, int wave, int lane) {
    LAS unsigned char* wl = lds + wave * WBYTES;
    const int g = gw & 15, l15 = lane & 15, q4 = lane >> 4;
    bf16x8 afr[8], cfr[4];
#pragma unroll
    for (int mb = 0; mb < 8; ++mb) { afr[mb] = bf16x8{}; if (q4 < 2) afr[mb] = *(const bf16x8*)(S5A + ((size_t)g * 128 + 16 * mb + l15) * 16 + 8 * q4); }
#pragma unroll
    for (int ks = 0; ks < 4; ++ks) { cfr[ks] = bf16x8{}; if (FULL) cfr[ks] = *(const bf16x8*)(S5C + ((size_t)g * 16 + l15) * 128 + 32 * ks + 8 * q4); }
    const float2 lam = S5L[g * 64 + lane];
    for (int it = gw >> 4; it < NB * NCH; it += ngw >> 4) {
        const int b = it / NCH, ch = it % NCH;
        float hre = 0.f, him = 0.f;
        if (FULL) { const float2 h0 = SH[((size_t)it * 16 + g) * 64 + lane]; hre = h0.x; him = h0.y; }
        chunk<FULL>(wl, Z, afr, cfr, lam.x, lam.y, hre, him, b, ch, g, lane, dsk, YG);
        if (!FULL) SE[((size_t)it * 16 + g) * 64 + lane] = make_float2(hre, him);
    }
}
struct ItemLd { bf16x8 ufr[2]; float2 h0; uint2 uw[2]; };
__device__ __forceinline__ void load_item(ItemLd& L, const bf16* Z, const float2* SH, int it, int g, int lane) {
    const int l15 = lane & 15, q4 = lane >> 4; const int b = it / NCH, ch = it % NCH; const size_t t0 = (size_t)b * SEQ + (size_t)ch * LC;
#pragma unroll
    for (int nb = 0; nb < 2; ++nb) { L.ufr[nb] = bf16x8{}; if (q4 < 2) L.ufr[nb] = *(const bf16x8*)(Z + (t0 + 16 * nb + l15) * ZW + ZC_U + g * 16 + 8 * q4);
        L.uw[nb] = *(const uint2*)(Z + (t0 + 16 * nb + l15) * ZW + ZC_U + g * 16 + 4 * q4); }
    L.h0 = SH[((size_t)it * 16 + g) * 64 + lane];
}
__device__ __forceinline__ void pass_b(LAS unsigned char* lds, const bf16* Z, const bf16* S5A, const bf16* S5C, const float2* S5L, const float* dsk, const float2* SH, bf16* YG, int gw, int ngw, int wave, int lane) {
    LAS unsigned char* wl = lds + wave * WBYTES;
    const int g = gw & 15, l15 = lane & 15, q4 = lane >> 4;
    bf16x8 afr[8], cfr[4];
#pragma unroll
    for (int mb = 0; mb < 8; ++mb) { afr[mb] = bf16x8{}; if (q4 < 2) afr[mb] = *(const bf16x8*)(S5A + ((size_t)g * 128 + 16 * mb + l15) * 16 + 8 * q4); }
#pragma unroll
    for (int ks = 0; ks < 4; ++ks) cfr[ks] = *(const bf16x8*)(S5C + ((size_t)g * 16 + l15) * 128 + 32 * ks + 8 * q4);
    const float2 lam = S5L[g * 64 + lane]; const float lre = lam.x, lim = lam.y;
    const float4 dd = *(const float4*)(dsk + g * 16 + 4 * q4);
    const int step = ngw >> 4;
    int it = gw >> 4; if (it >= NB * NCH) return;
    ItemLd cur; load_item(cur, Z, SH, it, g, lane);
    for (; it < NB * NCH; it += step) {
        ItemLd nxt = cur; const bool more = it + step < NB * NCH;
        if (more) load_item(nxt, Z, SH, it + step, g, lane);
        const int b = it / NCH, ch = it % NCH; const size_t t0 = (size_t)b * SEQ + (size_t)ch * LC;
#pragma unroll
        for (int nb = 0; nb < 2; ++nb)
#pragma unroll
            for (int mb = 0; mb < 8; ++mb) { const f32x4 d = __builtin_amdgcn_mfma_f32_16x16x32_bf16(afr[mb], cur.ufr[nb], f32x4{0.f, 0.f, 0.f, 0.f}, 0, 0, 0);
                *(LAS u32x2*)(wl + (16 * nb + l15) * RS + (16 * mb + 4 * q4) * 2) = u32x2{pk2(d[0], d[1]), pk2(d[2], d[3])}; }
        float hre = cur.h0.x, him = cur.h0.y;
        unsigned wk[LC];
#pragma unroll
        for (int k = 0; k < LC; ++k) wk[k] = *(const LAS unsigned*)(wl + k * RS + 4 * lane);
#pragma unroll
        for (int k = 0; k < LC; ++k) { const float bre = __uint_as_float(wk[k] << 16), bim = __uint_as_float(wk[k] & 0xffff0000u);
            const float nre = fmaf(lre, hre, fmaf(-lim, him, bre)), nim = fmaf(lre, him, fmaf(lim, hre, bim)); hre = nre; him = nim; wk[k] = pk2(hre, him); }
#pragma unroll
        for (int k = 0; k < LC; ++k) *(LAS unsigned*)(wl + k * RS + 4 * lane) = wk[k];
#pragma unroll
        for (int nb = 0; nb < 2; ++nb) {
            f32x4 y = f32x4{0.f, 0.f, 0.f, 0.f};
#pragma unroll
            for (int ks = 0; ks < 4; ++ks) { const bf16x8 hfr = *(const LAS bf16x8*)(wl + (16 * nb + l15) * RS + (32 * ks + 8 * q4) * 2); y = __builtin_amdgcn_mfma_f32_16x16x32_bf16(cfr[ks], hfr, y, 0, 0, 0); }
            const size_t t = t0 + 16 * nb + l15; const uint2 uw = cur.uw[nb];
            const float y0 = y[0] + dd.x * __uint_as_float(uw.x << 16), y1 = y[1] + dd.y * __uint_as_float(uw.x & 0xffff0000u),
                        y2 = y[2] + dd.z * __uint_as_float(uw.y << 16), y3 = y[3] + dd.w * __uint_as_float(uw.y & 0xffff0000u);
            *(uint2*)(YG + t * 256 + g * 16 + 4 * q4) = make_uint2(pk2(gelu_f(y0), gelu_f(y1)), pk2(gelu_f(y2), gelu_f(y3)));
        }
        cur = nxt;
    }
}
__device__ __forceinline__ void carry_wg(LAS unsigned char* lds, const float2* S5L, const float2* SE, float2* SH, int item, int wave, int lane) {
    typedef float f32x2v __attribute__((ext_vector_type(2)));
    LAS f32x2v* tot = (LAS f32x2v*)lds;
    const int b = item >> 4, g = item & 15;
    float2 L = S5L[g * 64 + lane];
#pragma unroll
    for (int i = 0; i < 5; ++i) { const float re = L.x * L.x - L.y * L.y, im = 2.f * L.x * L.y; L.x = re; L.y = im; }
    float hre = 0.f, him = 0.f;
    const size_t base = (((size_t)b * NCH + 32 * wave) * 16 + g) * 64 + lane;
    float2 e[32];
#pragma unroll
    for (int c = 0; c < 32; ++c) e[c] = SE[base + (size_t)c * 1024];
#pragma unroll
    for (int c = 0; c < 32; ++c) { const float nre = L.x * hre - L.y * him + e[c].x, nim = L.x * him + L.y * hre + e[c].y; e[c] = make_float2(hre, him); hre = nre; him = nim; }
    tot[wave * 64 + lane] = f32x2v{hre, him};
    float2 LS = L;
#pragma unroll
    for (int i = 0; i < 5; ++i) { const float re = LS.x * LS.x - LS.y * LS.y, im = 2.f * LS.x * LS.y; LS.x = re; LS.y = im; }
    __syncthreads();
    float cre = 0.f, cim = 0.f;
    for (int w = 0; w < wave; ++w) { const f32x2v s = tot[w * 64 + lane]; const float nre = LS.x * cre - LS.y * cim + s.x, nim = LS.x * cim + LS.y * cre + s.y; cre = nre; cim = nim; }
#pragma unroll
    for (int c = 0; c < 32; ++c) { SH[base + (size_t)c * 1024] = make_float2(e[c].x + cre, e[c].y + cim); const float nre = L.x * cre - L.y * cim, nim = L.x * cim + L.y * cre; cre = nre; cim = nim; }
    __syncthreads();
}
}
namespace lruf {
typedef float f32x4 __attribute__((ext_vector_type(4)));
constexpr int LC = 32, NCH = SEQ / LC, XS = 68;
typedef short bf16x8 __attribute__((ext_vector_type(8)));
typedef float f32x4m __attribute__((ext_vector_type(4)));
__device__ __forceinline__ void build_tables(const float* wa, const float* wx, bf16* LWT, int gt, int ngt) {
    for (int i = gt; i < 2 * 4 * 4096; i += ngt) { const int g = i >> 14, h = (i >> 12) & 3, n = (i >> 6) & 63, k = i & 63;
        LWT[i] = f2bf((g ? wx : wa)[(h * 64 + k) * 64 + n]); }
}
__device__ __forceinline__ void pass_a(LAS unsigned char* lds, const bf16* Z, const float* cw, const float* cb, const bf16* LWT, const float* ba, const float* bx, const float* lam,
                                       float* AA, float* BT, float2* LPE, int gw, int ngw, int wave, int lane) {
    LAS float* xt = (LAS float*)lds + wave * (LC * XS);
    const int l15 = lane & 15, q4 = lane >> 4;
    for (int item = gw; item < NB * NCH * 4; item += ngw) {
        const int h = item & 3, bc = item >> 2, b = bc / NCH, ch = bc % NCH;
        const size_t t0 = (size_t)b * SEQ + (size_t)ch * LC;
        bf16x8 afr[2][2];
#pragma unroll
        for (int ks = 0; ks < 2; ++ks) {
            const int c0 = h * 64 + 32 * ks + 8 * q4;
            float w[4][8], bias[8];
#pragma unroll
            for (int j = 0; j < 4; ++j) { const float4 w0 = *(const float4*)(cw + j * 256 + c0), w1 = *(const float4*)(cw + j * 256 + c0 + 4);
                w[j][0] = w0.x; w[j][1] = w0.y; w[j][2] = w0.z; w[j][3] = w0.w; w[j][4] = w1.x; w[j][5] = w1.y; w[j][6] = w1.z; w[j][7] = w1.w; }
            { const float4 b0 = *(const float4*)(cb + c0), b1 = *(const float4*)(cb + c0 + 4); bias[0] = b0.x; bias[1] = b0.y; bias[2] = b0.z; bias[3] = b0.w; bias[4] = b1.x; bias[5] = b1.y; bias[6] = b1.z; bias[7] = b1.w; }
#pragma unroll
            for (int mb = 0; mb < 2; ++mb) {
                const int tk = 16 * mb + l15;
                float xc[8];
#pragma unroll
                for (int e = 0; e < 8; ++e) xc[e] = bias[e];
#pragma unroll
                for (int j = 0; j < 4; ++j) {
                    const int dt = tk - 3 + j;
                    if (ch > 0 || dt >= 0) { float z[8]; unpack8(*(const uint4*)(Z + (size_t)((long)t0 + dt) * ZW + ZC_X + c0), z);
#pragma unroll
                        for (int e = 0; e < 8; ++e) xc[e] = fmaf(w[j][e], z[e], xc[e]); }
                }
                uint4 pk; pk.x = pk2(xc[0], xc[1]); pk.y = pk2(xc[2], xc[3]); pk.z = pk2(xc[4], xc[5]); pk.w = pk2(xc[6], xc[7]);
                afr[mb][ks] = __builtin_bit_cast(bf16x8, pk);
                *(LAS f32x4*)(xt + tk * XS + 32 * ks + 8 * q4) = f32x4{xc[0], xc[1], xc[2], xc[3]};
                *(LAS f32x4*)(xt + tk * XS + 32 * ks + 8 * q4 + 4) = f32x4{xc[4], xc[5], xc[6], xc[7]};
            }
        }
        const bf16* wt = LWT + (size_t)h * 4096;
        float cp[4], ce[4];
#pragma unroll
        for (int nb = 0; nb < 4; ++nb) {
            const int c = h * 64 + 16 * nb + l15;
            const bf16x8 ba0 = *(const bf16x8*)(wt + (size_t)(16 * nb + l15) * 64 + 8 * q4), ba1 = *(const bf16x8*)(wt + (size_t)(16 * nb + l15) * 64 + 32 + 8 * q4);
            const bf16x8 bx0 = *(const bf16x8*)(wt + 16384 + (size_t)(16 * nb + l15) * 64 + 8 * q4), bx1 = *(const bf16x8*)(wt + 16384 + (size_t)(16 * nb + l15) * 64 + 32 + 8 * q4);
            const float bav = ba[c], bxv = bx[c], lsg8 = -8.f * log1pf(__expf(-lam[c]));
            float segp[2], sege[2];
#pragma unroll
            for (int mb = 0; mb < 2; ++mb) {
                f32x4m ra = f32x4m{0.f, 0.f, 0.f, 0.f}, rx = f32x4m{0.f, 0.f, 0.f, 0.f};
                ra = __builtin_amdgcn_mfma_f32_16x16x32_bf16(afr[mb][0], ba0, ra, 0, 0, 0); ra = __builtin_amdgcn_mfma_f32_16x16x32_bf16(afr[mb][1], ba1, ra, 0, 0, 0);
                rx = __builtin_amdgcn_mfma_f32_16x16x32_bf16(afr[mb][0], bx0, rx, 0, 0, 0); rx = __builtin_amdgcn_mfma_f32_16x16x32_bf16(afr[mb][1], bx1, rx, 0, 0, 0);
                float hl = 0.f, pl = 1.f;
#pragma unroll
                for (int r = 0; r < 4; ++r) {
                    const int tk = 16 * mb + 4 * q4 + r;
                    const float xv = xt[tk * XS + 16 * nb + l15];
                    const float rr = __frcp_rn(1.f + __expf(-(ra[r] + bav))), ig = __frcp_rn(1.f + __expf(-(rx[r] + bxv)));
                    const float av = __expf(rr * lsg8), bt = sqrtf(fmaxf(1.f - av * av, 0.f)) * (ig * xv);
                    AA[(t0 + tk) * 256 + c] = av; BT[(t0 + tk) * 256 + c] = bt;
                    hl = av * hl + bt; pl *= av;
                }
                segp[mb] = pl; sege[mb] = hl;
            }
            float P = 1.f, E = 0.f;
#pragma unroll
            for (int mb = 0; mb < 2; ++mb)
#pragma unroll
                for (int j = 0; j < 4; ++j) { const float pj = __shfl(segp[mb], 16 * j + l15), ej = __shfl(sege[mb], 16 * j + l15); E = pj * E + ej; P *= pj; }
            cp[nb] = P; ce[nb] = E;
        }
        if (q4 == 0) {
#pragma unroll
            for (int nb = 0; nb < 4; ++nb) LPE[(size_t)bc * 256 + h * 64 + 16 * nb + l15] = make_float2(cp[nb], ce[nb]);
        }
    }
}
__device__ __forceinline__ void carry_wg(LAS unsigned char* lds, const float2* LPE, float* LH, int item, int wave, int lane) {
    typedef float f32x2v __attribute__((ext_vector_type(2)));
    LAS f32x2v* tot = (LAS f32x2v*)lds;
    const int b = item >> 2, ch = (item & 3) * 64 + lane;
    const size_t base = ((size_t)b * NCH + 32 * wave) * 256 + ch;
    float2 pe[32];
#pragma unroll
    for (int c = 0; c < 32; ++c) pe[c] = LPE[base + (size_t)c * 256];
    float h = 0.f, prod = 1.f;
#pragma unroll
    for (int c = 0; c < 32; ++c) { const float p = pe[c].x, e = pe[c].y; pe[c] = make_float2(prod, h); h = p * h + e; prod *= p; }
    tot[wave * 64 + lane] = f32x2v{prod, h};
    __syncthreads();
    float cin = 0.f;
    for (int w = 0; w < wave; ++w) { const f32x2v s = tot[w * 64 + lane]; cin = s.x * cin + s.y; }
#pragma unroll
    for (int c = 0; c < 32; ++c) LH[base + (size_t)c * 256] = pe[c].y + pe[c].x * cin;
    __syncthreads();
}
__device__ __forceinline__ void pass_b(const float* AA, const float* BT, const float* LH, const bf16* Z, bf16* ROUT, int ldr, float* MSS, int gt, int ngt) {
    for (int i = gt; i < NB * NCH * 256; i += ngt) { const int c = i & 255, bc = i >> 8; const size_t t0 = (size_t)bc * LC;
        float h = LH[i];
        float av[LC], bv[LC]; bf16 gz[LC];
#pragma unroll
        for (int k = 0; k < LC; ++k) { const size_t t = t0 + k; av[k] = AA[t * 256 + c]; bv[k] = BT[t * 256 + c]; gz[k] = Z[t * ZW + ZC_G + c]; }
#pragma unroll
        for (int k = 0; k < LC; ++k) { h = fmaf(av[k], h, bv[k]); const bf16 ob = f2bf(h * gelu_f(bf2f(gz[k]))); ROUT[(t0 + k) * ldr + c] = ob;
            const float of = bf2f(ob); const float ss = wave_sum(of * of);
            if ((c & 63) == 0) MSS[(t0 + k) * 12 + 8 + (c >> 6)] = ss; } }
}
}
namespace pgf {
typedef float f32x2 __attribute__((ext_vector_type(2)));
typedef unsigned u32x4 __attribute__((ext_vector_type(4)));
constexpr float USCALE = 64.f, VSCALE = 5.5f;
__device__ __forceinline__ unsigned pack4_fp8(float a, float b, float c, float d) {
    int w = __builtin_amdgcn_cvt_pk_fp8_f32(a, b, 0, false); w = __builtin_amdgcn_cvt_pk_fp8_f32(c, d, w, true); return (unsigned)w; }
constexpr int ROWB = 1024, VOFF = 512;
__device__ __forceinline__ unsigned enc6(float x) {
    const float a = fminf(fabsf(x), 7.5f);
    const float c = a < 2.f ? __builtin_rintf(a * 8.f) : (a < 4.f ? 16.f + __builtin_rintf((a - 2.f) * 4.f) : 24.f + __builtin_rintf((a - 4.f) * 2.f));
    return (unsigned)(int)c | (x < 0.f ? 32u : 0u);
}
__device__ __forceinline__ unsigned enc4(float x) {
    const float a = fminf(fabsf(x), 6.f);
    const float c = a < 2.f ? __builtin_rintf(a * 2.f) : (a < 4.f ? 4.f + __builtin_rintf(a - 2.f) : 6.f + __builtin_rintf((a - 4.f) * 0.5f));
    return (unsigned)(int)c | (x < 0.f ? 8u : 0u);
}
__device__ __forceinline__ void convert4(const float* in, unsigned char* out, size_t nrows, float scale, int gt, int ngt) {
    typedef float f32x4v __attribute__((ext_vector_type(4)));
    const size_t n4 = nrows * 256; const f32x4v* in4 = (const f32x4v*)in;
    for (size_t i0 = (size_t)gt; i0 < n4; i0 += (size_t)ngt * 8) {
        f32x4v v[8];
#pragma unroll
        for (int k = 0; k < 8; ++k) { const size_t i = i0 + (size_t)k * ngt; v[k] = f32x4v{0.f, 0.f, 0.f, 0.f}; if (i < n4) v[k] = __builtin_nontemporal_load(in4 + i); }
#pragma unroll
        for (int k = 0; k < 8; ++k) { const size_t i = i0 + (size_t)k * ngt;
            unsigned c = 0u;
            c = __builtin_amdgcn_cvt_scalef32_pk_fp4_f32(c, v[k].x * scale, v[k].y * scale, 1.0f, 0); c = __builtin_amdgcn_cvt_scalef32_pk_fp4_f32(c, v[k].z * scale, v[k].w * scale, 1.0f, 1); c &= 0xffffu;
            const unsigned nb = (unsigned)__builtin_amdgcn_mov_dpp((int)c, 0xB1, 0xF, 0xF, true);
            if (!(gt & 1) && i < n4) { const size_t row = i >> 8; *(unsigned*)(out + row * ROWB + 2u * (unsigned)(i & 255)) = c | (nb << 16); }
        }
    }
}
template <bool PERMU> __device__ __forceinline__ void convert6(const float* in, unsigned char* out, size_t nrows, float scale, int gt, int ngt) {
    typedef float f32x4v __attribute__((ext_vector_type(4)));
    const size_t n4 = nrows * 256; const f32x4v* in4 = (const f32x4v*)in; const int j = gt & 3;
    for (size_t i0 = (size_t)gt; i0 < n4; i0 += (size_t)ngt * 4) {
        f32x4v v[4];
#pragma unroll
        for (int k = 0; k < 4; ++k) { const size_t i = i0 + (size_t)k * ngt; v[k] = f32x4v{0.f, 0.f, 0.f, 0.f}; if (i < n4) v[k] = __builtin_nontemporal_load(in4 + i); }
#pragma unroll
        for (int k = 0; k < 4; ++k) { const size_t i = i0 + (size_t)k * ngt;
            const unsigned c = enc6(v[k].x * scale) | (enc6(v[k].y * scale) << 6) | (enc6(v[k].z * scale) << 12) | (enc6(v[k].w * scale) << 18);
            const unsigned nb = (unsigned)__builtin_amdgcn_mov_dpp((int)c, 0xF9, 0xF, 0xF, true);
            const unsigned dw = (c >> (8 * j)) | (nb << (24 - 8 * j));
            if (j < 3 && i < n4) { const size_t row = i >> 8; const unsigned D = 3u * (unsigned)((i & 255) >> 2) + (unsigned)j; unsigned off = 4u * D;
                if (PERMU) {
                    const unsigned m = D / 6u, d = D - 6u * m, c = 24u * (m >> 3) + 4u * d; off = 128u * (c >> 4) + 16u * (4u * ((m >> 2) & 1u) + (m & 3u)) + (c & 15u); }
                *(unsigned*)(out + row * ROWB + off) = dw; }
        }
    }
}
__device__ __forceinline__ void unpack16(const u32x4 w, float* o) {
#pragma unroll
    for (int d = 0; d < 4; ++d) { const f32x2 lo = __builtin_amdgcn_cvt_pk_f32_fp8((int)w[d], false), hi = __builtin_amdgcn_cvt_pk_f32_fp8((int)w[d], true);
        o[4 * d] = lo.x; o[4 * d + 1] = lo.y; o[4 * d + 2] = hi.x; o[4 * d + 3] = hi.y; }
}
__device__ __forceinline__ void convert(const float* in, unsigned char* out8, size_t n, float scale, int gt, int ngt) {
    typedef float f32x4v __attribute__((ext_vector_type(4)));
    const size_t n4 = n / 4; const f32x4v* in4 = (const f32x4v*)in; unsigned* o32 = (unsigned*)out8;
    for (size_t i0 = (size_t)gt; i0 < n4; i0 += (size_t)ngt * 4) {
        f32x4v v[4];
#pragma unroll
        for (int k = 0; k < 4; ++k) { const size_t i = i0 + (size_t)k * ngt; v[k] = f32x4v{0.f, 0.f, 0.f, 0.f}; if (i < n4) v[k] = __builtin_nontemporal_load(in4 + i); }
#pragma unroll
        for (int k = 0; k < 4; ++k) { const size_t i = i0 + (size_t)k * ngt; if (i < n4) o32[(i >> 8) * (ROWB / 4) + (i & 255)] = pack4_fp8(v[k].x * scale, v[k].y * scale, v[k].z * scale, v[k].w * scale); }
    }
}
}
namespace tk {
__device__ __forceinline__ float row_rstd(const float* ROWSS, size_t t) { const float4* p = (const float4*)(ROWSS + t * 16); const float4 a = p[0], b = p[1], c = p[2], d = p[3];
    const float s = (((a.x + a.y) + (a.z + a.w)) + ((b.x + b.y) + (b.z + b.w))) + (((c.x + c.y) + (c.z + c.w)) + ((d.x + d.y) + (d.z + d.w))); return rsqrtf(s * (1.f / DM) + EPS); }
typedef short bf16x8 __attribute__((ext_vector_type(8)));
typedef float f32x4 __attribute__((ext_vector_type(4)));
__device__ const unsigned char PAIR_TAB[64] = {
    0x00,0x01,0x02,0x03,0x04,0x05,0x06,0x07,0x08,0x09,0x0a,0x0b,0x0c,0x0d,0x0e,0x0f, 0x10,0x11,0x12,0x13,0x14,0x15,0x16,0x17, 0x20,0x21,0x22,0x23,0x24, 0x30,0x31,0x32,0x33,
    0x40,0x41,0x42, 0x50,0x51, 0x60,0x61, 0x70,0x71, 0x80,0x90,0xa0,0xb0,0xc0,0xd0,0xe0,0xf0, 0,0,0,0,0,0,0,0,0,0,0,0,0,0};
template <int CTRL> __device__ __forceinline__ float dppf(float v) { return __builtin_bit_cast(float, __builtin_amdgcn_update_dpp(0, __builtin_bit_cast(int, v), CTRL, 0xf, 0xf, true)); }
__device__ __forceinline__ float vmax(float a, float b) { float r; asm("v_max_f32_e32 %0, %1, %2" : "=v"(r) : "v"(a), "v"(b)); return r; }
__device__ __forceinline__ float vmin(float a, float b) { float r; asm("v_min_f32_e32 %0, %1, %2" : "=v"(r) : "v"(a), "v"(b)); return r; }
#define TK_ST(ctrl) "v_max_f32_dpp %0, %0, %0 " ctrl " row_mask:0xf bank_mask:0xf\n\tv_max_f32_dpp %1, %1, %1 " ctrl " row_mask:0xf bank_mask:0xf\n\tv_max_f32_dpp %2, %2, %2 " ctrl " row_mask:0xf bank_mask:0xf\n\tv_max_f32_dpp %3, %3, %3 " ctrl " row_mask:0xf bank_mask:0xf\n\t"
__device__ __forceinline__ void rmax16x4(float& a, float& b, float& c, float& d) {
    asm("s_nop 1\n\t" TK_ST("quad_perm:[1,0,3,2]") TK_ST("quad_perm:[2,3,0,1]") TK_ST("row_half_mirror") TK_ST("row_mirror") "s_nop 0" : "+v"(a), "+v"(b), "+v"(c), "+v"(d));
}
#undef TK_ST
__device__ __forceinline__ float rsum16(float v) { v += dppf<0xB1>(v); v += dppf<0x4E>(v); v += dppf<0x141>(v); v += dppf<0x140>(v); return v; }
#define TK_CX(a, b) do { const float hi_ = vmax(a, b), lo_ = vmin(a, b); a = hi_; b = lo_; } while (0)
__device__ __forceinline__ float packkey(float v, unsigned id, unsigned mask) { return __uint_as_float((__float_as_uint(v) & ~mask) | id); }
__device__ __forceinline__ void select16(float (&k)[4][8], float (&top)[4], int l15) {
    const float NEG = -__builtin_inff();
#pragma unroll
    for (int r = 0; r < 4; ++r) {
        TK_CX(k[r][0], k[r][1]); TK_CX(k[r][2], k[r][3]); TK_CX(k[r][4], k[r][5]); TK_CX(k[r][6], k[r][7]);
        TK_CX(k[r][0], k[r][2]); TK_CX(k[r][1], k[r][3]); TK_CX(k[r][4], k[r][6]); TK_CX(k[r][5], k[r][7]);
        TK_CX(k[r][1], k[r][2]); TK_CX(k[r][5], k[r][6]);
        TK_CX(k[r][0], k[r][4]); TK_CX(k[r][1], k[r][5]); TK_CX(k[r][2], k[r][6]); TK_CX(k[r][3], k[r][7]);
        TK_CX(k[r][2], k[r][4]); TK_CX(k[r][3], k[r][5]);
        TK_CX(k[r][1], k[r][2]); TK_CX(k[r][3], k[r][4]); TK_CX(k[r][5], k[r][6]);
        top[r] = NEG;
    }
#pragma unroll
    for (int i = 0; i < 16; ++i) {
        float wr[4] = {k[0][0], k[1][0], k[2][0], k[3][0]};
        rmax16x4(wr[0], wr[1], wr[2], wr[3]);
#pragma unroll
        for (int r = 0; r < 4; ++r) {
            const float w = wr[r];
            if (l15 == i) top[r] = w;
            const bool hit = (k[r][0] == w);
#pragma unroll
            for (int e = 0; e < 7; ++e) k[r][e] = hit ? k[r][e + 1] : k[r][e];
            k[r][7] = hit ? NEG : k[r][7];
        }
    }
}
constexpr int SK_OFF = 16384, SK_ROWB = 272, PT_OFF = 86016, GN_OFF = 86272;
constexpr int SK_DUMMY = 0;
template <int EMASK> __device__ __forceinline__ void topk_item(int item, const bf16* QP, const LAS unsigned char* skl, const float* ROWSS, int lane_in, int (&idr)[4], float (&gtr)[4]) {
    const float NEG = -__builtin_inff();
    int lane = lane_in; asm volatile("" : "+v"(lane));
    const int l15 = lane & 15, q4 = lane >> 4, gbase = 16 * q4;
    unsigned pcs[4];
#pragma unroll
    for (int j = 0; j < 4; ++j) pcs[j] = ((const LAS unsigned*)(skl + (PT_OFF - SK_OFF)))[l15 + 16 * j];
    {
        const size_t R0 = (size_t)item * 16;
        const float rstd_g = row_rstd(ROWSS, (size_t)item * 2 + (q4 >> 1));
        const bf16* qrow = QP + (R0 + l15) * 256 + 8 * q4;
        float topA[4], topB[4];
#pragma unroll
        for (int p = 0; p < 2; ++p) {
            f32x4 acc[8];
#pragma unroll
            for (int nb = 0; nb < 8; ++nb) acc[nb] = f32x4{0.f, 0.f, 0.f, 0.f};
            bf16x8 afr[4];
#pragma unroll
            for (int ks = 0; ks < 4; ++ks) afr[ks] = *(const bf16x8*)(qrow + p * 128 + 32 * ks);
#pragma unroll 1
            for (int ks = 0; ks < 4; ++ks) {
                const bf16x8 af = ks == 0 ? afr[0] : ks == 1 ? afr[1] : ks == 2 ? afr[2] : afr[3];
#pragma unroll
                for (int nb = 0; nb < 8; ++nb) {
                    const bf16x8 bfr = *(const LAS bf16x8*)(skl + (p * 128 + 16 * nb + l15) * SK_ROWB + 64 * ks + 16 * q4);
                    acc[nb] = __builtin_amdgcn_mfma_f32_16x16x32_bf16(af, bfr, acc[nb], 0, 0, 0);
                }
            }
            float k[4][8];
#pragma unroll
            for (int r = 0; r < 4; ++r)
#pragma unroll
                for (int nb = 0; nb < 8; ++nb) k[r][nb] = packkey(acc[nb][r], (unsigned)(16 * nb + l15), 127u);
            if (p == 0) select16(k, topA, l15); else select16(k, topB, l15);
        }
        float c[4][4];
#pragma unroll
        for (int r = 0; r < 4; ++r) {
#pragma unroll
            for (int j = 0; j < 4; ++j) {
                const float s0 = __shfl(topA[r], gbase + (int)(pcs[j] >> 4)), s1 = __shfl(topB[r], gbase + (int)(pcs[j] & 15));
                c[r][j] = (l15 + 16 * j < 50) ? packkey(s0 + s1, (unsigned)(l15 + 16 * j), 63u) : NEG;
            }
            TK_CX(c[r][0], c[r][1]); TK_CX(c[r][2], c[r][3]); TK_CX(c[r][0], c[r][2]); TK_CX(c[r][1], c[r][3]); TK_CX(c[r][1], c[r][2]);
        }
        float win[4], w0[4];
#pragma unroll
        for (int r = 0; r < 4; ++r) { win[r] = NEG; w0[r] = 0.f; }
#pragma unroll
        for (int i = 0; i < 16; ++i) {
            float wr[4] = {c[0][0], c[1][0], c[2][0], c[3][0]};
            rmax16x4(wr[0], wr[1], wr[2], wr[3]);
#pragma unroll
            for (int r = 0; r < 4; ++r) {
                const float w = wr[r];
                if (i == 0) w0[r] = w;
                if (l15 == i) win[r] = w;
                { const bool hit = (c[r][0] == w); c[r][0] = hit ? c[r][1] : c[r][0]; c[r][1] = hit ? c[r][2] : c[r][1]; c[r][2] = hit ? c[r][3] : c[r][2]; c[r][3] = hit ? NEG : c[r][3]; }
            }
        }
#pragma unroll
        for (int r = 0; r < 4; ++r) {
            const unsigned pcw = ((const LAS unsigned*)(skl + (PT_OFF - SK_OFF)))[__float_as_uint(win[r]) & 63u];
            const int i0 = (int)(__float_as_uint(__shfl(topA[r], gbase + (int)(pcw >> 4))) & 127u), i1 = (int)(__float_as_uint(__shfl(topB[r], gbase + (int)(pcw & 15))) & 127u);
            const float e = __expf((win[r] - w0[r]) * rstd_g); const float sum = rsum16(e);
            idr[r] = (i0 * 128 + i1) & EMASK; gtr[r] = e / sum;
        }
    }
}
template <int SKIP> __device__ __forceinline__ void gather_item(int item, const int (&idr)[4], const float (&gtr)[4], bf16* HN, const unsigned char* PU8, const unsigned char* PV8, float* X, float* Xout,
                                                               const float* ROWSS, const float* gnext, LAS unsigned char* wl, LAS unsigned char* wl_base, int lane_in) {
    int lane = lane_in; asm volatile("" : "+v"(lane));
    const int l15 = lane & 15, q4 = lane >> 4; const bool hi2 = lane >= 32; const int colb = 32 * (lane & 31) + 16 * (lane >> 5);
    {
        {
            typedef float f32x2 __attribute__((ext_vector_type(2))); typedef unsigned u32x2v __attribute__((ext_vector_type(2))); typedef int i32x6 __attribute__((ext_vector_type(6))); typedef int i32x8 __attribute__((ext_vector_type(8))); typedef float f32x32 __attribute__((ext_vector_type(32)));
            LAS unsigned char* img = wl;
#pragma unroll 1
            for (int tau = 0; tau < 2; ++tau) {
                const size_t t = (size_t)item * 2 + tau;
                const float rstd_t = row_rstd(ROWSS, t);
#define TK_SEL4(arr, ri) ((ri) == 0 ? arr[0] : (ri) == 1 ? arr[1] : (ri) == 2 ? arr[2] : arr[3])
#define TK_LOADA(bi_) do { const int ri_ = (bi_) >> 1, srcb_ = 32 * tau + 16 * ((bi_) & 1); const int idv_ = TK_SEL4(idr, ri_); \
        const int e0_ = __shfl(idv_, srcb_ + (l15 & 7)), e1_ = __shfl(idv_, srcb_ + 8 + (l15 & 7)); \
        const unsigned char* p0_ = PU8 + (unsigned)(e0_ * pgf::ROWB + 64 * (l15 >> 3) + 16 * q4); const unsigned char* p1_ = PU8 + (unsigned)(e1_ * pgf::ROWB + 64 * (l15 >> 3) + 16 * q4); \
        _Pragma("unroll") for (int j = 0; j < 4; ++j) { aw[j] = (SKIP & 8) ? pgf::u32x4{(unsigned)e0_, 1u, 2u, 3u} : *(const pgf::u32x4*)(p0_ + 128 * j); \
                                                       aw[4 + j] = (SKIP & 8) ? pgf::u32x4{(unsigned)e1_, 1u, 2u, 3u} : *(const pgf::u32x4*)(p1_ + 128 * j); } } while (0)
#define TK_LOADV(bi_) do { const int ri_ = (bi_) >> 1, srcb_ = 32 * tau + 16 * ((bi_) & 1); const int idv_ = TK_SEL4(idr, ri_); \
        _Pragma("unroll") for (int p_ = 0; p_ < 8; ++p_) { const int e0_ = __builtin_amdgcn_readlane(idv_, srcb_ + 2 * p_), e1_ = __builtin_amdgcn_readlane(idv_, srcb_ + 2 * p_ + 1); const int eid = hi2 ? e1_ : e0_; \
            vw[p_] = (SKIP & 16) ? pgf::u32x4{(unsigned)eid, 1u, 2u, 3u} : *(const pgf::u32x4*)(PV8 + (unsigned)(eid * pgf::ROWB + 16 * (lane & 31))); } } while (0)
                const uint4 hraw0 = *(const uint4*)(HN + t * DM + 16 * lane), hraw1 = *(const uint4*)(HN + t * DM + 16 * lane + 8);
                pgf::u32x4 aw[8];
                TK_LOADA(0);
                float4 xv[4];
                { const float4* xi0 = (const float4*)(X + t * DM + colb);
#pragma unroll
                  for (int q = 0; q < 4; ++q) xv[q] = xi0[q]; }
                {
                    float hn[16]; unpack8(hraw0, hn); unpack8(hraw1, hn + 8);
                    float h1[16]; pgf::u32x4 w1, w2;
#pragma unroll
                    for (int d = 0; d < 4; ++d) { w1[d] = pgf::pack4_fp8(hn[4 * d] * 8.f, hn[4 * d + 1] * 8.f, hn[4 * d + 2] * 8.f, hn[4 * d + 3] * 8.f);
                        const f32x2 lo = __builtin_amdgcn_cvt_pk_f32_fp8((int)w1[d], false), hi = __builtin_amdgcn_cvt_pk_f32_fp8((int)w1[d], true);
                        h1[4 * d] = lo.x; h1[4 * d + 1] = lo.y; h1[4 * d + 2] = hi.x; h1[4 * d + 3] = hi.y; }
#pragma unroll
                    for (int d = 0; d < 4; ++d) w2[d] = pgf::pack4_fp8((hn[4 * d] * 8.f - h1[4 * d]) * 16.f, (hn[4 * d + 1] * 8.f - h1[4 * d + 1]) * 16.f, (hn[4 * d + 2] * 8.f - h1[4 * d + 2]) * 16.f, (hn[4 * d + 3] * 8.f - h1[4 * d + 3]) * 16.f);
                    *(LAS pgf::u32x4*)(img + (lane >> 1) * 64 + (lane & 1) * 16) = w1;
                    *(LAS pgf::u32x4*)(img + (lane >> 1) * 64 + 32 + (lane & 1) * 16) = w2;
                }
                f32x2 y2[16];
#pragma unroll
                for (int e = 0; e < 16; ++e) y2[e] = f32x2{0.f, 0.f};
#pragma unroll 1
                for (int bi = 0; bi < 8; ++bi) {
                    const int ri = bi >> 1, srcb = 32 * tau + 16 * (bi & 1);
                    pgf::u32x4 vw[8];
                    TK_LOADV(bi);
                    f32x4 acc0 = f32x4{0.f, 0.f, 0.f, 0.f}, acc1 = f32x4{0.f, 0.f, 0.f, 0.f};
                    int boff = ((l15 >> 1) & 1) * 256 + (q4 >> 1) * 64 + (l15 & 1) * 32 + (q4 & 1) * 16; asm volatile("" : "+v"(boff));
                    if (SKIP & 2) {
#pragma unroll
                        for (int j = 0; j < 8; ++j) acc0[0] += __uint_as_float(((aw[j].x ^ aw[j].y ^ aw[j].z ^ aw[j].w) & 0x007fffffu) | 0x3f800000u);
                    } else
#pragma unroll
                    for (int s4 = 0; s4 < 4; ++s4) {
                        const pgf::u32x4 bl = *(const LAS pgf::u32x4*)(img + boff + s4 * 512), bh = *(const LAS pgf::u32x4*)(img + boff + s4 * 512 + 128);
                        const i32x8 bfrag = i32x8{(int)bl.x, (int)bl.y, (int)bl.z, (int)bl.w, (int)bh.x, (int)bh.y, (int)bh.z, (int)bh.w};
                        const i32x8 a0 = i32x8{(int)aw[s4].x, (int)aw[s4].y, (int)aw[s4].z, (int)aw[s4].w, 0, 0, 0, 0};
                        const i32x8 a1 = i32x8{(int)aw[4 + s4].x, (int)aw[4 + s4].y, (int)aw[4 + s4].z, (int)aw[4 + s4].w, 0, 0, 0, 0};
                        acc0 = __builtin_amdgcn_mfma_scale_f32_16x16x128_f8f6f4(bfrag, a0, acc0, 0, 4, 0, 127, 0, 127);
                        acc1 = __builtin_amdgcn_mfma_scale_f32_16x16x128_f8f6f4(bfrag, a1, acc1, 0, 4, 0, 127, 0, 127);
                    }
                    if (bi + 1 < 8) TK_LOADA(bi + 1);
                    float dsel;
                    {   const bool up = l15 >= 8; const float c0 = 1.f / (pgf::USCALE * 8.f), c1 = 1.f / (pgf::USCALE * 128.f);
                        float p0 = up ? (acc0[2] * c0 + acc0[3] * c1) : (acc0[0] * c0 + acc0[1] * c1), p1 = up ? (acc1[2] * c0 + acc1[3] * c1) : (acc1[0] * c0 + acc1[1] * c1);
                        p0 += dppf<0x128>(p0); p1 += dppf<0x128>(p1);
                        dsel = up ? p1 : p0; }
                    const float gtv = TK_SEL4(gtr, ri);
                    const float wv = gtv * ((SKIP & 4) ? dsel * rstd_t : gelu_f(dsel * rstd_t)) * (1.f / pgf::VSCALE);
                    if (SKIP & 1) {
#pragma unroll
                        for (int e = 0; e < 8; ++e) y2[e].x += __uint_as_float(((vw[e][0] ^ vw[e][1] ^ vw[e][2] ^ vw[e][3]) & 0x007fffffu) | 0x3f800000u) * wv;
                    } else
#pragma unroll
                    for (int p = 0; p < 8; ++p) {
                        const float w0 = __builtin_bit_cast(float, __builtin_amdgcn_readlane(__builtin_bit_cast(int, wv), srcb + 2 * p)), w1 = __builtin_bit_cast(float, __builtin_amdgcn_readlane(__builtin_bit_cast(int, wv), srcb + 2 * p + 1));
                        const float we = hi2 ? w1 : w0; const f32x2 w2v = f32x2{we, we};
#pragma unroll
                        for (int d = 0; d < 4; ++d) {
                            y2[4 * d] = __builtin_elementwise_fma(w2v, __builtin_amdgcn_cvt_scalef32_pk_f32_fp4(vw[p][d], 1.0f, 0), y2[4 * d]);
                            y2[4 * d + 1] = __builtin_elementwise_fma(w2v, __builtin_amdgcn_cvt_scalef32_pk_f32_fp4(vw[p][d], 1.0f, 1), y2[4 * d + 1]);
                            y2[4 * d + 2] = __builtin_elementwise_fma(w2v, __builtin_amdgcn_cvt_scalef32_pk_f32_fp4(vw[p][d], 1.0f, 2), y2[4 * d + 2]);
                            y2[4 * d + 3] = __builtin_elementwise_fma(w2v, __builtin_amdgcn_cvt_scalef32_pk_f32_fp4(vw[p][d], 1.0f, 3), y2[4 * d + 3]); }
                    }
                }
#undef TK_LOADA
#undef TK_LOADV
#undef TK_SEL4
                float y[16];
#pragma unroll
                for (int e = 0; e < 8; ++e) {
                    const float a0 = hi2 ? y2[e].x : y2[8 + e].x, a1 = hi2 ? y2[e].y : y2[8 + e].y;
                    const float b0 = hi2 ? y2[8 + e].x : y2[e].x, b1 = hi2 ? y2[8 + e].y : y2[e].y;
                    const auto r0 = __builtin_amdgcn_permlane32_swap(__float_as_uint(a0), __float_as_uint(a0), false, false); const auto r1 = __builtin_amdgcn_permlane32_swap(__float_as_uint(a1), __float_as_uint(a1), false, false);
                    y[2 * e] = b0 + __uint_as_float(hi2 ? r0[0] : r0[1]); y[2 * e + 1] = b1 + __uint_as_float(hi2 ? r1[0] : r1[1]); }
                float4* xo = (float4*)(Xout + t * DM + colb);
                float ssn = 0.f;
#pragma unroll
                for (int q = 0; q < 4; ++q) { float4 pp = xv[q]; pp.x += y[4 * q]; pp.y += y[4 * q + 1]; pp.z += y[4 * q + 2]; pp.w += y[4 * q + 3]; xo[q] = pp;
                    y[4 * q] = pp.x; y[4 * q + 1] = pp.y; y[4 * q + 2] = pp.z; y[4 * q + 3] = pp.w; ssn += (pp.x * pp.x + pp.y * pp.y) + (pp.z * pp.z + pp.w * pp.w); }
                if (gnext) {
                    const float rn = rsqrtf(wave_sum(ssn) * (1.f / DM) + EPS); const LAS f32x4* gp = (const LAS f32x4*)(wl_base + GN_OFF + 4 * colb);
                    uint4 o0, o1; const f32x4 ga = gp[0], gb = gp[1], gc = gp[2], gd4 = gp[3];
                    o0.x = pk2(y[0] * rn * ga.x, y[1] * rn * ga.y); o0.y = pk2(y[2] * rn * ga.z, y[3] * rn * ga.w); o0.z = pk2(y[4] * rn * gb.x, y[5] * rn * gb.y); o0.w = pk2(y[6] * rn * gb.z, y[7] * rn * gb.w);
                    o1.x = pk2(y[8] * rn * gc.x, y[9] * rn * gc.y); o1.y = pk2(y[10] * rn * gc.z, y[11] * rn * gc.w); o1.z = pk2(y[12] * rn * gd4.x, y[13] * rn * gd4.y); o1.w = pk2(y[14] * rn * gd4.z, y[15] * rn * gd4.w);
                    *(uint4*)(HN + t * DM + colb) = o0; *(uint4*)(HN + t * DM + colb + 8) = o1;
                }
            }
        }
    }
}

template <int EMASK, int SKIP> __device__ __forceinline__ void peer_phase(LAS unsigned char* lds, const bf16* QP, const bf16* SUBKB, bf16* HN, const unsigned char* PU8, const unsigned char* PV8, float* X, float* Xout,
                                                                          const float* ROWSS, const float* gnext, int G, int bid, int tid) {
    const int lane = tid & 63, wave = __builtin_amdgcn_readfirstlane(tid >> 6);
    LAS unsigned char* img = lds + wave * 2048;
    {
        pgf::u32x4 tmp[8];
#pragma unroll
        for (int j = 0; j < 8; ++j) tmp[j] = *(const pgf::u32x4*)((const unsigned char*)SUBKB + (size_t)(tid + 512 * j) * 16);
#pragma unroll
        for (int j = 0; j < 8; ++j) { const int ch = tid + 512 * j; *(LAS pgf::u32x4*)(lds + SK_OFF + (ch >> 4) * SK_ROWB + (ch & 15) * 16) = tmp[j]; }
        if (tid < 64) ((LAS unsigned*)(lds + PT_OFF))[tid] = PAIR_TAB[tid];
        if (gnext) { const float4 gv = ((const float4*)gnext)[tid & 255]; if (tid < 256) ((LAS f32x4*)(lds + GN_OFF))[tid] = f32x4{gv.x, gv.y, gv.z, gv.w}; }
        __syncthreads();
    }
    const LAS unsigned char* skl = lds + SK_OFF;
    for (int item = wave * G + bid; item < T / 2; item += 8 * G) {
        int idr[4]; float gtr[4];
        topk_item<EMASK>(item, QP, skl, ROWSS, lane, idr, gtr);
        if (SKIP & 32) { if ((idr[0] ^ idr[1] ^ idr[2] ^ idr[3]) == 0x7fffffff) Xout[lane] = gtr[0] + gtr[1] + gtr[2] + gtr[3]; continue; }
        gather_item<SKIP>(item, idr, gtr, HN, PU8, PV8, X, Xout, ROWSS, gnext, img, lds, lane);
    }
}
#undef TK_CX
}
constexpr int NWAVES = 8, NTHR = 512;
constexpr int RING_BYTES = 131072, MISC_OFF = RING_BYTES + 320, LDS_BYTES = 147456;
struct Args { const void* in[34]; float* out; unsigned char* ws; int ph_lo, ph_hi; };
struct Ctx { LAS unsigned char* lds; int tid, lane, wave, G, bid, gw, ngw, gt, ngt; };
#define INF(i) ((const float*)a.in[i])
#define WSP(T_, off) ((T_*)(a.ws + (off)))

__device__ __forceinline__ void ph_rowprep(const Ctx& c, const float* x, const float* gain, bf16* XB);
__device__ __forceinline__ void prep_tile(const float* W, int K, int N, bf16* WT, int Nout, int mapmode, int item, LAS float* tile, int lane, const float* kgain = nullptr) {
    const int nbn = Nout / 32, kb = item / nbn, nb = item % nbn, n0 = nb * 32, k0 = kb * 32, tx = lane & 31, ty = lane >> 5;
    const int n = n0 + tx; int src = n;
    if (mapmode == 1) { if (n < 448) src = n; else if (n < 512) src = -1; else src = n - 64; }
    const bool ok = (src >= 0 && src < N);
    float v[16];
#pragma unroll
    for (int i = 0; i < 16; ++i) v[i] = ok ? W[(size_t)(k0 + ty + 2 * i) * N + src] * (kgain ? kgain[k0 + ty + 2 * i] : 1.f) : 0.f;
#pragma unroll
    for (int i = 0; i < 16; ++i) tile[(ty + 2 * i) * 33 + tx] = v[i];
    asm volatile("s_waitcnt lgkmcnt(0)" ::: "memory");
#pragma unroll
    for (int i = 0; i < 16; ++i) WT[(size_t)(n0 + ty + 2 * i) * K + k0 + tx] = f2bf(tile[tx * 33 + ty + 2 * i]);
    asm volatile("s_waitcnt lgkmcnt(0)" ::: "memory");
}
template <class ArgsRef> __device__ __forceinline__ void ph_prep(const ArgsRef& a, const Ctx& c) {
    LAS float* tile = (LAS float*)c.lds + c.wave * (32 * 33);
    constexpr int NT0 = 1280, NT1 = 192, NT2 = 128, NT3 = 64, NT4 = 1024, NT5 = 2048, NTL = NT0 + NT1 + NT2 + NT3 + NT4 + NT5, NTOT = NL * NTL;
    for (int it = c.gw; it < NTOT; it += c.ngw) {
        const int l = it / NTL; int r = it % NTL;
        if (r < NT0) prep_tile(INF(3) + (size_t)l * DM * 1216, DM, 1216, WSP(bf16, WS_WINT) + (size_t)l * ZW * DM, ZW, 1, r, tile, c.lane);
        else if ((r -= NT0) < NT1) prep_tile(INF(5) + (size_t)l * 256 * 768, 256, 768, WSP(bf16, WS_WUQT) + (size_t)l * 768 * 256, 768, 0, r, tile, c.lane);
        else if ((r -= NT1) < NT2) prep_tile(INF(7) + (size_t)l * 128 * 1024, 128, 1024, WSP(bf16, WS_WUKVT) + (size_t)l * 1024 * 128, 1024, 0, r, tile, c.lane);
        else if ((r -= NT2) < NT3) prep_tile(INF(18) + (size_t)l * 65536, 256, 256, WSP(bf16, WS_GLUT) + (size_t)l * 65536, 256, 0, r, tile, c.lane);
        else if ((r -= NT3) < NT4) prep_tile(INF(28) + (size_t)l * DM * DM, DM, DM, WSP(bf16, WS_WOUTT) + (size_t)l * DM * DM, DM, 0, r, tile, c.lane, INF(27) + (size_t)l * DM);
        else { r -= NT4; prep_tile(INF(30) + (size_t)l * DM * 2048, DM, 2048, WSP(bf16, WS_WQT) + (size_t)l * 2048 * DM, 2048, 0, r, tile, c.lane); }
    }
    for (int i = c.gt; i < NL * 32768; i += c.ngt) WSP(bf16, WS_SUBKT)[i] = f2bf(INF(31)[i]);
    pgf::convert4((const float*)a.in[32], WSP(unsigned char, WS_PU), (size_t)NL * 16384, pgf::USCALE, c.gt, c.ngt);
    pgf::convert4((const float*)a.in[33], WSP(unsigned char, WS_PU) + pgf::VOFF, (size_t)NL * 16384, pgf::VSCALE, c.gt, c.ngt);
    for (int i = c.gt; i < T * 32; i += c.ngt) { const int t = i >> 5, j = i & 31;
        const float freq = exp2f(-(float)j * 0.41524101186092033f);
        const float ang = (float)((const int*)a.in[1])[t] * freq; float s, cs; sincos_acc(ang, s, cs);
        WSP(float, WS_COS)[i] = cs; WSP(float, WS_SIN)[i] = s; }
    for (int l = 0; l < NL; ++l)
        s5f::build_tables(INF(10) + l * 1024, INF(11) + l * 1024, INF(12) + l * 16, INF(13) + l * 16384, INF(14) + l * 16384, INF(15) + l * 16384, INF(16) + l * 16384,
                          WSP(bf16, WS_S5A) + (size_t)l * 32768, WSP(bf16, WS_S5C) + (size_t)l * 32768, WSP(float2, WS_S5L) + l * 1024, c.gt, c.ngt);
    for (int l = 0; l < NL; ++l) s5f::build_wtable(INF(10) + l * 1024, INF(11) + l * 1024, INF(12) + l * 16, INF(13) + l * 16384, INF(14) + l * 16384, WSP(bf16, WS_S5W) + (size_t)l * 1048576, c.gt, c.ngt);
    for (int l = 0; l < NL; ++l) lruf::build_tables(INF(22) + l * 16384, INF(24) + l * 16384, WSP(bf16, WS_LWT) + (size_t)l * 32768, c.gt, c.ngt);
    ph_rowprep(c, INF(0), INF(2), WSP(bf16, WS_XB));
}

__device__ __forceinline__ void ph_rowprep(const Ctx& c, const float* x, const float* gain, bf16* XB) {
    for (int row = c.gw; row < T; row += c.ngw) {
        const float4* xr = (const float4*)(x + (size_t)row * DM) + c.lane;
        float4 v[4]; float ss = 0.f;
#pragma unroll
        for (int j = 0; j < 4; ++j) { v[j] = xr[64 * j]; ss += v[j].x * v[j].x + v[j].y * v[j].y + v[j].z * v[j].z + v[j].w * v[j].w; }
        const float rstd = rsqrtf(wave_sum(ss) * (1.f / DM) + EPS);
        uint2* o = (uint2*)(XB + (size_t)row * DM) + c.lane;
#pragma unroll
        for (int j = 0; j < 4; ++j) { const float4 g = ((const float4*)gain)[c.lane + 64 * j];
            o[64 * j] = make_uint2(pk2(v[j].x * rstd * g.x, v[j].y * rstd * g.y), pk2(v[j].z * rstd * g.z, v[j].w * rstd * g.w)); }
    }
}

enum { EPI_BF16 = 0, EPI_F32 = 1, EPI_GLU = 2, EPI_RESID = 3 };
template <int EPI> __device__ __forceinline__ void gemm_simple(const Ctx& c, const bf16* A, int lda, const bf16* Bt, int M, int N, int K, void* C, int ldc, const float* aux0, const bf16* aux1) {
    LAS float* As = (LAS float*)c.lds; LAS float* Bs = As + 16 * 132;
    const int tid = c.tid, tx = tid & 15, ty = tid >> 4, nN = N / 64, ntile = (M / 128) * nN;
    for (int tile = c.bid; tile < ntile; tile += c.G) {
        const int m0 = (tile / nN) * 128, n0 = (tile % nN) * 64;
        float acc[4][4];
#pragma unroll
        for (int i = 0; i < 4; ++i)
#pragma unroll
            for (int j = 0; j < 4; ++j) acc[i][j] = 0.f;
        const int lr = tid >> 2, lk = (tid & 3) * 4;
        for (int k0 = 0; k0 < K; k0 += 16) {
            { const uint2 w = *(const uint2*)(A + (size_t)(m0 + lr) * lda + k0 + lk);
              As[lk * 132 + lr] = __uint_as_float(w.x << 16); As[(lk + 1) * 132 + lr] = __uint_as_float(w.x & 0xffff0000u); As[(lk + 2) * 132 + lr] = __uint_as_float(w.y << 16); As[(lk + 3) * 132 + lr] = __uint_as_float(w.y & 0xffff0000u); }
            if (tid < 256) { const uint2 w = *(const uint2*)(Bt + (size_t)(n0 + lr) * K + k0 + lk);
              Bs[lk * 68 + lr] = __uint_as_float(w.x << 16); Bs[(lk + 1) * 68 + lr] = __uint_as_float(w.x & 0xffff0000u); Bs[(lk + 2) * 68 + lr] = __uint_as_float(w.y << 16); Bs[(lk + 3) * 68 + lr] = __uint_as_float(w.y & 0xffff0000u); }
            __syncthreads();
#pragma unroll
            for (int kk = 0; kk < 16; ++kk) {
                float av[4], bv[4];
#pragma unroll
                for (int i = 0; i < 4; ++i) { av[i] = As[kk * 132 + ty * 4 + i]; bv[i] = Bs[kk * 68 + tx * 4 + i]; }
#pragma unroll
                for (int i = 0; i < 4; ++i)
#pragma unroll
                    for (int j = 0; j < 4; ++j) acc[i][j] += av[i] * bv[j];
            }
            __syncthreads();
        }
#pragma unroll
        for (int i = 0; i < 4; ++i)
#pragma unroll
            for (int j = 0; j < 4; ++j) {
                const int row = m0 + ty * 4 + i, col = n0 + tx * 4 + j; const size_t ix = (size_t)row * ldc + col; const float v = acc[i][j];
                if (EPI == EPI_BF16) ((bf16*)C)[ix] = f2bf(v);
                else if (EPI == EPI_F32) ((float*)C)[ix] = v;
                else if (EPI == EPI_GLU) { const float yg = bf2f(aux1[ix]); ((bf16*)C)[ix] = f2bf(yg * sigmoid_f(v + aux0[col])); }
                else { ((float*)C)[ix] = aux0[ix] + v; }
            }
    }
}

__device__ __forceinline__ void ph_zstats(const Ctx& c, const bf16* Z, const float* qan, const float* kvan, bf16* CQN, bf16* CKVN) {
    const int lane = c.lane; const float4 gq = ((const float4*)qan)[lane]; const float2 gk = ((const float2*)kvan)[lane];
    for (int row0 = 4 * c.gw; row0 < T; row0 += 4 * c.ngw) {
        uint2 wq[4]; u32 wk[4];
#pragma unroll
        for (int i = 0; i < 4; ++i) { const bf16* zr = Z + (size_t)(row0 + i) * ZW; wq[i] = *(const uint2*)(zr + ZC_CQ + 4 * lane); wk[i] = *(const u32*)(zr + ZC_CKV + 2 * lane); }
#pragma unroll
        for (int i = 0; i < 4; ++i) { const int row = row0 + i;
            { const float a0 = __uint_as_float(wq[i].x << 16), a1 = __uint_as_float(wq[i].x & 0xffff0000u), a2 = __uint_as_float(wq[i].y << 16), a3 = __uint_as_float(wq[i].y & 0xffff0000u);
              const float rstd = rsqrtf(wave_sum(a0 * a0 + a1 * a1 + a2 * a2 + a3 * a3) * (1.f / 256) + EPS);
              *(uint2*)(CQN + (size_t)row * 256 + 4 * lane) = make_uint2(pk2(a0 * rstd * gq.x, a1 * rstd * gq.y), pk2(a2 * rstd * gq.z, a3 * rstd * gq.w)); }
            { const float a0 = __uint_as_float(wk[i] << 16), a1 = __uint_as_float(wk[i] & 0xffff0000u);
              const float rstd = rsqrtf(wave_sum(a0 * a0 + a1 * a1) * (1.f / 128) + EPS);
              *(u32*)(CKVN + (size_t)row * 128 + 2 * lane) = pk2(a0 * rstd * gk.x, a1 * rstd * gk.y); } }
    }
}

__device__ __forceinline__ float dpp_rsum16(float v) {
    v += __builtin_bit_cast(float, __builtin_amdgcn_update_dpp(0, __builtin_bit_cast(int, v), 0xB1, 0xf, 0xf, true));
    v += __builtin_bit_cast(float, __builtin_amdgcn_update_dpp(0, __builtin_bit_cast(int, v), 0x4E, 0xf, 0xf, true));
    v += __builtin_bit_cast(float, __builtin_amdgcn_update_dpp(0, __builtin_bit_cast(int, v), 0x141, 0xf, 0xf, true));
    v += __builtin_bit_cast(float, __builtin_amdgcn_update_dpp(0, __builtin_bit_cast(int, v), 0x140, 0xf, 0xf, true));
    return v; }
struct QkLd { uint4 qn8, kn8, v8; u32 qx1, qx2, kx1, kx2; float2 cs, sn; };
__device__ __forceinline__ void qkfin_load(QkLd& L, int t, int lane, const bf16* QRAW, const bf16* KVRAW, const bf16* Z, const float* COS, const float* SIN) {
    const int h = lane >> 4, j = lane & 15;
    const bf16* qp = QRAW + (size_t)t * 768 + h * DQK; const bf16* kp = KVRAW + (size_t)t * 1024 + h * 256;
    L.qn8 = *(const uint4*)(qp + 8 * j); L.qx1 = *(const u32*)(qp + 128 + 2 * j); L.qx2 = *(const u32*)(qp + 160 + 2 * j);
    L.kn8 = *(const uint4*)(kp + 8 * j); L.v8 = *(const uint4*)(kp + 128 + 8 * j);
    L.kx1 = *(const u32*)(Z + (size_t)t * ZW + ZC_KR + 2 * j); L.kx2 = *(const u32*)(Z + (size_t)t * ZW + ZC_KR + 32 + 2 * j);
    L.cs = *(const float2*)(COS + t * 32 + 2 * j); L.sn = *(const float2*)(SIN + t * 32 + 2 * j);
}
__device__ __forceinline__ void qkfin_store(const QkLd& L, int t, int lane, const float4 (&gq)[2], const float4 (&gk)[2], const float2 (&gqr)[2], const float2 (&gkr)[2], bf16* QB, bf16* KB, bf16* VB) {
    const int h = lane >> 4, j = lane & 15, b = t / SEQ, s = t % SEQ; const size_t bh = (size_t)b * NH + h;
    const float2 cs = L.cs, sn = L.sn;
    {
        float v[8]; unpack8(L.qn8, v);
        float a0 = __uint_as_float(L.qx1 << 16), a1 = __uint_as_float(L.qx1 & 0xffff0000u), b0 = __uint_as_float(L.qx2 << 16), b1 = __uint_as_float(L.qx2 & 0xffff0000u);
        float ss = a0 * a0 + a1 * a1 + b0 * b0 + b1 * b1;
#pragma unroll
        for (int e = 0; e < 8; ++e) ss += v[e] * v[e];
        const float rs = rsqrtf(dpp_rsum16(ss) * (1.f / DQK) + EPS) * QSCALE;
        a0 *= rs * gqr[0].x; a1 *= rs * gqr[0].y; b0 *= rs * gqr[1].x; b1 *= rs * gqr[1].y;
        bf16* o = QB + (bh * SEQ + s) * DQK;
        *(uint4*)(o + 8 * j) = make_uint4(pk2(v[0] * rs * gq[0].x, v[1] * rs * gq[0].y), pk2(v[2] * rs * gq[0].z, v[3] * rs * gq[0].w), pk2(v[4] * rs * gq[1].x, v[5] * rs * gq[1].y), pk2(v[6] * rs * gq[1].z, v[7] * rs * gq[1].w));
        *(u32*)(o + 128 + 2 * j) = pk2(a0 * cs.x - b0 * sn.x, a1 * cs.y - b1 * sn.y);
        *(u32*)(o + 160 + 2 * j) = pk2(a0 * sn.x + b0 * cs.x, a1 * sn.y + b1 * cs.y);
    }
    {
        float v[8]; unpack8(L.kn8, v);
        float a0 = __uint_as_float(L.kx1 << 16), a1 = __uint_as_float(L.kx1 & 0xffff0000u), b0 = __uint_as_float(L.kx2 << 16), b1 = __uint_as_float(L.kx2 & 0xffff0000u);
        float ss = a0 * a0 + a1 * a1 + b0 * b0 + b1 * b1;
#pragma unroll
        for (int e = 0; e < 8; ++e) ss += v[e] * v[e];
        const float rs = rsqrtf(dpp_rsum16(ss) * (1.f / DQK) + EPS);
        a0 *= rs * gkr[0].x; a1 *= rs * gkr[0].y; b0 *= rs * gkr[1].x; b1 *= rs * gkr[1].y;
        bf16* o = KB + (bh * SEQ + s) * DQK;
        *(uint4*)(o + 8 * j) = make_uint4(pk2(v[0] * rs * gk[0].x, v[1] * rs * gk[0].y), pk2(v[2] * rs * gk[0].z, v[3] * rs * gk[0].w), pk2(v[4] * rs * gk[1].x, v[5] * rs * gk[1].y), pk2(v[6] * rs * gk[1].z, v[7] * rs * gk[1].w));
        *(u32*)(o + 128 + 2 * j) = pk2(a0 * cs.x - b0 * sn.x, a1 * cs.y - b1 * sn.y);
        *(u32*)(o + 160 + 2 * j) = pk2(a0 * sn.x + b0 * cs.x, a1 * sn.y + b1 * cs.y);
        *(uint4*)(VB + (bh * SEQ + s) * DV + 8 * j) = L.v8;
    }
}
__device__ __forceinline__ void ph_qkfin(const Ctx& c, const bf16* QRAW, const bf16* KVRAW, const bf16* Z, const float* qn, const float* kn, const float* COS, const float* SIN, bf16* QB, bf16* KB, bf16* VB) {
    const int j = c.lane & 15;
    const float4 gq[2] = {*(const float4*)(qn + 8 * j), *(const float4*)(qn + 8 * j + 4)}, gk[2] = {*(const float4*)(kn + 8 * j), *(const float4*)(kn + 8 * j + 4)};
    const float2 gqr[2] = {*(const float2*)(qn + 128 + 2 * j), *(const float2*)(qn + 160 + 2 * j)}, gkr[2] = {*(const float2*)(kn + 128 + 2 * j), *(const float2*)(kn + 160 + 2 * j)};
    for (int t = 4 * c.gw; t < T; t += 4 * c.ngw) {
        QkLd L[4];
#pragma unroll
        for (int i = 0; i < 4; ++i) qkfin_load(L[i], t + i, c.lane, QRAW, KVRAW, Z, COS, SIN);
#pragma unroll
        for (int i = 0; i < 4; ++i) qkfin_store(L[i], t + i, c.lane, gq, gk, gqr, gkr, QB, KB, VB);
    }
}

__device__ __forceinline__ void ph_attn_simple(const Ctx& c, const bf16* QB, const bf16* KB, const bf16* VB, bf16* AO) {
    LAS float* qs = (LAS float*)c.lds + c.wave * DQK; const int lane = c.lane;
    for (int gq = c.gw; gq < NB * NH * SEQ; gq += c.ngw) {
        const int bh = gq / SEQ, q = gq % SEQ;
        const bf16* qp = QB + ((size_t)bh * SEQ + q) * DQK;
        qs[lane] = bf2f(qp[lane]); qs[lane + 64] = bf2f(qp[lane + 64]); qs[lane + 128] = bf2f(qp[lane + 128]);
        asm volatile("s_waitcnt lgkmcnt(0)" ::: "memory");
        float m = -1e30f, l = 0.f, o0 = 0.f, o1 = 0.f;
        const int ntile = q / 64 + 1;
        for (int kt = 0; kt < ntile; ++kt) {
            const int key = kt * 64 + lane;
            const uint4* kp = (const uint4*)(KB + ((size_t)bh * SEQ + key) * DQK);
            float sc = 0.f;
#pragma unroll 4
            for (int cc = 0; cc < 24; ++cc) { float kv[8]; unpack8(kp[cc], kv);
#pragma unroll
                for (int e = 0; e < 8; ++e) sc += kv[e] * qs[cc * 8 + e]; }
            if (key > q) sc = -INFINITY;
            const float mn = fmaxf(m, wave_max(sc));
            const float p = exp2f(sc - mn), al = exp2f(m - mn);
            l = l * al + wave_sum(p); o0 *= al; o1 *= al; m = mn;
            const u32* vp = (const u32*)(VB + ((size_t)bh * SEQ + kt * 64) * DV) + lane;
#pragma unroll 8
            for (int k = 0; k < 64; ++k) { const float pk = __shfl(p, k); const u32 w = vp[(size_t)k * (DV / 2)];
                o0 += pk * __uint_as_float(w << 16); o1 += pk * __uint_as_float(w & 0xffff0000u); }
        }
        const int b = bh / NH, h = bh % NH; const float il = 1.f / l;
        *(u32*)(AO + ((size_t)b * SEQ + q) * 512 + h * DV + 2 * lane) = pk2(o0 * il, o1 * il);
    }
}

__device__ __forceinline__ void ph_s5_simple(const Ctx& c, const bf16* Z, const float* a_re, const float* a_im, const float* log_dt, const float* b_re, const float* b_im,
                                             const float* c_re, const float* c_im, const float* dsk, bf16* YG) {
    for (int item = c.gw; item < NB * 16; item += c.ngw) {
        const int b = item >> 4, g = item & 15, p = c.lane;
        const float are = a_re[g * 64 + p], aim = a_im[g * 64 + p], dt = expf(log_dt[g]);
        const float mag = expf(are * dt); float sn, cs; sincos_acc(aim * dt, sn, cs);
        const float lre = mag * cs, lim = mag * sn;
        const float xr = lre - 1.f, xi = lim, den = are * are + aim * aim;
        const float cr = (xr * are + xi * aim) / den, ci = (xi * are - xr * aim) / den;
        float Bre[16], Bim[16], Cre[16], Cim[16];
#pragma unroll
        for (int k = 0; k < 16; ++k) { const float br = b_re[(g * 64 + p) * 16 + k], bi = b_im[(g * 64 + p) * 16 + k];
            Bre[k] = cr * br - ci * bi; Bim[k] = cr * bi + ci * br; Cre[k] = c_re[(g * 16 + k) * 64 + p]; Cim[k] = c_im[(g * 16 + k) * 64 + p]; }
        const float D = (p < 16) ? dsk[g * 16 + p] : 0.f;
        float hre = 0.f, him = 0.f;
        for (int s = 0; s < SEQ; ++s) {
            const bf16* up = Z + (size_t)(b * SEQ + s) * ZW + ZC_U + g * 16;
            float u[16]; unpack8(*(const uint4*)up, u); unpack8(*(const uint4*)(up + 8), u + 8);
            float bre = 0.f, bim = 0.f;
#pragma unroll
            for (int k = 0; k < 16; ++k) { bre += Bre[k] * u[k]; bim += Bim[k] * u[k]; }
            const float nre = lre * hre - lim * him + bre, nim = lre * him + lim * hre + bim; hre = nre; him = nim;
            float my = 0.f;
#pragma unroll
            for (int k = 0; k < 16; ++k) { const float v = wave_sum(Cre[k] * hre - Cim[k] * him); if (p == k) my = v + D * u[k]; }
            if (p < 16) YG[(size_t)(b * SEQ + s) * 256 + g * 16 + p] = f2bf(gelu_f(my));
        }
    }
}

__device__ __forceinline__ void ph_lru_xc(const Ctx& c, const bf16* Z, const float* cw, const float* cb, float* XC) {
    for (int i = c.gt; i < T * 256; i += c.ngt) { const int t = i >> 8, ch = i & 255, s = t % SEQ;
        float acc = cb[ch];
#pragma unroll
        for (int j = 0; j < 4; ++j) { const int ss = s - 3 + j; if (ss >= 0) acc += cw[j * 256 + ch] * bf2f(Z[(size_t)(t - 3 + j) * ZW + ZC_X + ch]); }
        XC[i] = acc; }
}
__device__ __forceinline__ void ph_lru_gates(const Ctx& c, const float* XC, const float* wa, const float* ba, const float* wx, const float* bx, const float* lam, float* AA, float* BT) {
    for (int i = c.gt; i < T * 256; i += c.ngt) { const int t = i >> 8, ch = i & 255, h = ch >> 6, j = ch & 63;
        const float* xr = XC + (size_t)t * 256 + h * 64;
        float ra = ba[ch], rx = bx[ch];
        for (int k = 0; k < 64; ++k) { const float xv = xr[k]; ra += xv * wa[(h * 64 + k) * 64 + j]; rx += xv * wx[(h * 64 + k) * 64 + j]; }
        const float r = sigmoid_f(ra), ig = sigmoid_f(rx);
        const float lsg = -log1pf(expf(-lam[ch]));
        const float la = 8.f * r * lsg, av = expf(la);
        AA[i] = av; BT[i] = sqrtf(-expm1f(2.f * la)) * (ig * XC[i]); }
}
__device__ __forceinline__ void ph_lru_scan(const Ctx& c, const float* AA, const float* BT, const bf16* Z, bf16* ROUT) {
    for (int item = c.gw; item < NB * 4; item += c.ngw) {
        const int i = item * 64 + c.lane, b = i >> 8, ch = i & 255;
        float h = 0.f;
#pragma unroll 8
        for (int s = 0; s < SEQ; ++s) { const size_t t = (size_t)b * SEQ + s;
            h = AA[t * 256 + ch] * h + BT[t * 256 + ch];
            ROUT[t * 256 + ch] = f2bf(h * gelu_f(bf2f(Z[t * ZW + ZC_G + ch]))); }
    }
}

__device__ __forceinline__ void ph_mixnorm(const Ctx& c, const bf16* AO, const bf16* SOUT, const bf16* ROUT, const float* g, bf16* Y) {
    const int lane = c.lane;
    const float4 ga0 = *(const float4*)(g + 8 * lane), ga1 = *(const float4*)(g + 8 * lane + 4), gs = *(const float4*)(g + 512 + 4 * lane), gr = *(const float4*)(g + 768 + 4 * lane);
    for (int row0 = 4 * c.gw; row0 < T; row0 += 4 * c.ngw) {
        uint4 wa[4]; uint2 ws_[4], wr[4];
#pragma unroll
        for (int i = 0; i < 4; ++i) { const size_t row = row0 + i; wa[i] = *(const uint4*)(AO + row * 512 + 8 * lane); ws_[i] = *(const uint2*)(SOUT + row * 256 + 4 * lane); wr[i] = *(const uint2*)(ROUT + row * 256 + 4 * lane); }
#pragma unroll
        for (int i = 0; i < 4; ++i) { const size_t row = row0 + i;
            {   float v[8]; unpack8(wa[i], v); float ss = 0.f;
#pragma unroll
                for (int e = 0; e < 8; ++e) ss += v[e] * v[e];
                const float rstd = rsqrtf(wave_sum(ss) * (1.f / 512) + EPS);
                *(uint4*)(Y + row * DM + 8 * lane) = make_uint4(pk2(v[0] * rstd * ga0.x, v[1] * rstd * ga0.y), pk2(v[2] * rstd * ga0.z, v[3] * rstd * ga0.w), pk2(v[4] * rstd * ga1.x, v[5] * rstd * ga1.y), pk2(v[6] * rstd * ga1.z, v[7] * rstd * ga1.w)); }
            {   const float a0 = __uint_as_float(ws_[i].x << 16), a1 = __uint_as_float(ws_[i].x & 0xffff0000u), a2 = __uint_as_float(ws_[i].y << 16), a3 = __uint_as_float(ws_[i].y & 0xffff0000u);
                const float rstd = rsqrtf(wave_sum(a0 * a0 + a1 * a1 + a2 * a2 + a3 * a3) * (1.f / 256) + EPS);
                *(uint2*)(Y + row * DM + 512 + 4 * lane) = make_uint2(pk2(a0 * rstd * gs.x, a1 * rstd * gs.y), pk2(a2 * rstd * gs.z, a3 * rstd * gs.w)); }
            {   const float a0 = __uint_as_float(wr[i].x << 16), a1 = __uint_as_float(wr[i].x & 0xffff0000u), a2 = __uint_as_float(wr[i].y << 16), a3 = __uint_as_float(wr[i].y & 0xffff0000u);
                const float rstd = rsqrtf(wave_sum(a0 * a0 + a1 * a1 + a2 * a2 + a3 * a3) * (1.f / 256) + EPS);
                *(uint2*)(Y + row * DM + 768 + 4 * lane) = make_uint2(pk2(a0 * rstd * gr.x, a1 * rstd * gr.y), pk2(a2 * rstd * gr.z, a3 * rstd * gr.w)); } }
    }
}

__device__ __forceinline__ void ph_topk_a(const Ctx& c, const float* SC, float* STOP, int* ITOP) {
    for (int i = c.gt; i < T * 16; i += c.ngt) {
        const float* sc = SC + (size_t)i * 128;
        float pv = INFINITY; int pn = -1;
        for (int it = 0; it < 16; ++it) {
            float bv = -INFINITY; int bn = 1 << 30;
            for (int n = 0; n < 128; ++n) { const float v = sc[n];
                const bool elig = (v < pv) || (v == pv && n > pn);
                if (elig && (v > bv || (v == bv && n < bn))) { bv = v; bn = n; } }
            STOP[(size_t)i * 16 + it] = bv; ITOP[(size_t)i * 16 + it] = bn; pv = bv; pn = bn;
        }
    }
}
__device__ __forceinline__ void ph_topk_b(const Ctx& c, const float* STOP, const int* ITOP, int* IDX, float* GATE) {
    LAS float* my = (LAS float*)c.lds + c.tid * 33;
    for (int i = c.gt; i < T * 8; i += c.ngt) {
        for (int k = 0; k < 32; ++k) my[k] = STOP[(size_t)i * 32 + k];
        float pv = INFINITY; int pn = -1; float best0 = 0.f, den = 0.f;
        float ev[16];
#pragma unroll
        for (int it = 0; it < 16; ++it) {
            float bv = -INFINITY; int bn = 1 << 30;
            for (int f = 0; f < 256; ++f) { const float v = my[f >> 4] + my[16 + (f & 15)];
                const bool elig = (v < pv) || (v == pv && f > pn);
                if (elig && (v > bv || (v == bv && f < bn))) { bv = v; bn = f; } }
            pv = bv; pn = bn;
            if (it == 0) best0 = bv;
            ev[it] = expf(bv - best0); den += ev[it];
            IDX[(size_t)i * 16 + it] = ITOP[(size_t)i * 32 + (bn >> 4)] * 128 + ITOP[(size_t)i * 32 + 16 + (bn & 15)];
        }
#pragma unroll
        for (int it = 0; it < 16; ++it) GATE[(size_t)i * 16 + it] = ev[it] / den;
    }
}

__device__ __forceinline__ void ph_gather(const Ctx& c, const bf16* HN, const int* IDX, const float* GATE, const bf16* PU, const bf16* PV, float* X) {
    const int lane = c.lane;
    for (int t = c.gw; t < T; t += c.ngw) {
        float hn[16]; unpack8(*(const uint4*)(HN + (size_t)t * DM + 8 * lane), hn); unpack8(*(const uint4*)(HN + (size_t)t * DM + 512 + 8 * lane), hn + 8);
        float y[16];
#pragma unroll
        for (int e = 0; e < 16; ++e) y[e] = 0.f;
        for (int k = 0; k < 128; ++k) {
            const int e = IDX[(size_t)t * 128 + k]; const float gt = GATE[(size_t)t * 128 + k];
            const bf16* ur = PU + (size_t)e * DM; const bf16* vr = PV + (size_t)e * DM;
            float u[16]; unpack8(*(const uint4*)(ur + 8 * lane), u); unpack8(*(const uint4*)(ur + 512 + 8 * lane), u + 8);
            float d = 0.f;
#pragma unroll
            for (int q = 0; q < 16; ++q) d += u[q] * hn[q];
            d = wave_sum(d);
            const float w = gt * gelu_f(d);
            float v[16]; unpack8(*(const uint4*)(vr + 8 * lane), v); unpack8(*(const uint4*)(vr + 512 + 8 * lane), v + 8);
#pragma unroll
            for (int q = 0; q < 16; ++q) y[q] += w * v[q];
        }
        float4* xo = (float4*)(X + (size_t)t * DM + 8 * lane);
        float4 p0 = xo[0], p1 = xo[1]; p0.x += y[0]; p0.y += y[1]; p0.z += y[2]; p0.w += y[3]; p1.x += y[4]; p1.y += y[5]; p1.z += y[6]; p1.w += y[7]; xo[0] = p0; xo[1] = p1;
        xo = (float4*)(X + (size_t)t * DM + 512 + 8 * lane);
        p0 = xo[0]; p1 = xo[1]; p0.x += y[8]; p0.y += y[9]; p0.z += y[10]; p0.w += y[11]; p1.x += y[12]; p1.y += y[13]; p1.z += y[14]; p1.w += y[15]; xo[0] = p0; xo[1] = p1;
    }
}
namespace att {
typedef short bf16x8 __attribute__((ext_vector_type(8)));
typedef short s16x4 __attribute__((ext_vector_type(4)));
typedef float f32x16 __attribute__((ext_vector_type(16)));
typedef unsigned u32x4 __attribute__((ext_vector_type(4)));
constexpr int KT = 64, KBYTES = KT * DQK * 2, VBYTES = KT * DV * 2, BUFB = KBYTES + VBYTES;
constexpr int OFF_WS = 2 * BUFB, OFF_MO = 0, OFF_ML = 65536, LDS_NEED = OFF_WS + 8 * 64 * 4;
constexpr float THR = 8.f;
__device__ __forceinline__ int kswz(int row, int c) { return row * 384 + (((c & ~7) | ((c & 7) ^ ((row >> 1) & 7))) << 4); }
__device__ __forceinline__ int v_st(int k, int c) { const int kk = (k & ~0xC) | ((k & 4) << 1) | ((k & 8) >> 1); return ((kk >> 3) * 4 + (c >> 5)) * 512 + ((kk & 7) * 32 + (c & 31)) * 2; }
__device__ __forceinline__ int v_rd_base(int lane) { return ((lane & 3) << 3) | (((lane >> 2) & 3) << 6) | (((lane >> 4) & 1) << 5) | (((lane >> 5) & 1) << 8); }
__device__ __forceinline__ int crow(int r, int hi) { return (r & 3) + 8 * (r >> 2) + 4 * hi; }
__device__ __forceinline__ unsigned cvtpk(float lo, float hi) { unsigned r; asm volatile("v_cvt_pk_bf16_f32 %0, %1, %2" : "=v"(r) : "v"(lo), "v"(hi)); return r; }
#define ATT_SBAR() __builtin_amdgcn_sched_barrier(0)

template <int SKIP> __device__ __forceinline__ void attn_unit(LAS unsigned char* lds, const bf16* Qg, const bf16* Kg, const bf16* Vg, bf16* AO, float* MSS, int bh, int qb, int tid) {
    const int lane = tid & 63, wid = __builtin_amdgcn_readfirstlane(tid >> 6), qsub = wid & 3, kh = wid >> 2, r32 = lane & 31, hi = lane >> 5;
    const int q0 = qb * 128, NT = 2 * (qb + 1);
    const size_t rowbase = (size_t)bh * SEQ;
    bf16x8 qr[12];
    { const bf16* qp = Qg + (rowbase + q0 + 32 * qsub + r32) * DQK + 8 * hi;
#pragma unroll
      for (int ks = 0; ks < 12; ++ks) qr[ks] = *(const bf16x8*)(qp + 16 * ks); }
    int ksrc[3], vsrc[2];
#pragma unroll
    for (int j = 0; j < 3; ++j) { const int L = (wid + 8 * j) * 64 + lane, row = L / 24, cp = L - row * 24, c = (cp & ~7) | ((cp & 7) ^ ((row >> 1) & 7)); ksrc[j] = row * DQK + c * 8; }
#pragma unroll
    for (int j = 0; j < 2; ++j) { const int X = ((wid + 8 * j) * 64 + lane) * 16, sub = X >> 9, within = (X & 511) >> 1, kk = ((sub >> 2) << 3) | (within >> 5);
        const int k = (kk & ~0xC) | ((kk & 4) << 1) | ((kk & 8) >> 1), c = (sub & 3) * 32 + (within & 31); vsrc[j] = k * DV + c; }
    const bf16* Kt = Kg + rowbase * DQK; const bf16* Vt = Vg + rowbase * DV;
#define ATT_STAGE(t, bo) do { const bf16* kp_ = Kt + (size_t)(t) * (KT * DQK); const bf16* vp_ = Vt + (size_t)(t) * (KT * DV); \
        _Pragma("unroll") for (int j_ = 0; j_ < 3; ++j_) __builtin_amdgcn_global_load_lds((const unsigned*)(kp_ + ksrc[j_]), (LAS unsigned*)(lds + (bo) + (wid + 8 * j_) * 1024), 16, 0, 0); \
        _Pragma("unroll") for (int j_ = 0; j_ < 2; ++j_) __builtin_amdgcn_global_load_lds((const unsigned*)(vp_ + vsrc[j_]), (LAS unsigned*)(lds + (bo) + KBYTES + (wid + 8 * j_) * 1024), 16, 0, 0); } while (0)
    const int krow = 32 * kh + r32, kf = (krow >> 1) & 7;
    int kb[4];
#pragma unroll
    for (int j = 0; j < 4; ++j) kb[j] = krow * 384 + ((((2 * j + hi) & 7) ^ kf) << 4);
    const int vb = KBYTES + v_rd_base(lane) + kh * 8192;
    LAS float* wsf = (LAS float*)(lds + OFF_WS) + wid * 64;
    float m_reg = -1e30f, l_reg = 0.f; f32x16 o[4];
#pragma unroll
    for (int d = 0; d < 4; ++d) o[d] = f32x16{};
    const int rb = 32 * qsub;
    ATT_STAGE(0, 0);
    asm volatile("s_waitcnt vmcnt(0)" ::: "memory");
    __syncthreads();
    for (int t = 0; t < NT; ++t) {
        const int bo = (t & 1) * BUFB;
        if (!(SKIP & 8) && t + 1 < NT) ATT_STAGE(t + 1, BUFB - bo);
        const int kboff = 64 * t + 32 * kh - q0;
        const bool act = kboff <= rb, diag = kboff == rb;
        if (act) {
            f32x16 p = f32x16{};
            bf16x8 kfr[12];
#pragma unroll
            for (int ks = 0; ks < 12; ++ks) kfr[ks] = *(const LAS bf16x8*)(lds + bo + kb[ks & 3] + (ks >> 2) * 128);
            ATT_SBAR();
#pragma unroll
            for (int ks = 0; ks < 12; ++ks) {
                if (!(SKIP & 2)) p = __builtin_amdgcn_mfma_f32_32x32x16_bf16(kfr[ks], qr[ks], p, 0, 0, 0); else p[ks] += __uint_as_float((unsigned)kfr[ks][0] << 16);
            }
            const int vaddr = (int)(uintptr_t)lds + bo + vb;
            s16x4 vl0[2], vh0[2], vl1[2], vh1[2];
#define ATT_TRRD(dst, off) asm volatile("ds_read_b64_tr_b16 %0, %1 offset:%2" : "=&v"(dst) : "v"(vaddr), "i"(off) : "memory")
#define ATT_VRD(i, d0) do { ATT_TRRD(vl0[i], (d0) * 512); ATT_TRRD(vh0[i], (d0) * 512 + 2048); ATT_TRRD(vl1[i], (d0) * 512 + 4096); ATT_TRRD(vh1[i], (d0) * 512 + 6144); } while (0)
            ATT_VRD(0, 0); ATT_VRD(1, 1);
            if (diag) {
#pragma unroll
                for (int r = 0; r < 16; ++r) if (crow(r, hi) > r32) p[r] = -__builtin_inff();
            }
            if (!(SKIP & 1)) {
            float pmax = p[0];
#pragma unroll
            for (int r = 1; r < 16; ++r) pmax = fmaxf(pmax, p[r]);
            { auto rr = __builtin_amdgcn_permlane32_swap(__float_as_uint(pmax), __float_as_uint(pmax), false, false);
              pmax = fmaxf(__uint_as_float(rr[0]), __uint_as_float(rr[1])); }
            float alpha = 1.f;
            if (!__all(pmax - m_reg <= THR)) { const float mn = fmaxf(m_reg, pmax); alpha = __builtin_amdgcn_exp2f(m_reg - mn); m_reg = mn; }
#pragma unroll
            for (int r = 0; r < 16; ++r) p[r] = __builtin_amdgcn_exp2f(p[r] - m_reg);
            float ps = 0.f;
#pragma unroll
            for (int r = 0; r < 16; ++r) ps += p[r];
            { auto rr = __builtin_amdgcn_permlane32_swap(__float_as_uint(ps), __float_as_uint(ps), false, false);
              ps = __uint_as_float(rr[0]) + __uint_as_float(rr[1]); }
            l_reg = l_reg * alpha + ps;
            if (__any(alpha < 1.f)) {
                if (hi == 0) wsf[r32] = alpha;
                asm volatile("s_waitcnt lgkmcnt(0)" ::: "memory");
#pragma unroll
                for (int r = 0; r < 16; ++r) { const float al = wsf[crow(r, hi)];
#pragma unroll
                    for (int d = 0; d < 4; ++d) o[d][r] *= al; }
            }
            }
            bf16x8 pa0, pa1;
#define ATT_PK4(B_, OUT) do { unsigned a0 = cvtpk(p[B_ + 0], p[B_ + 1]), a1 = cvtpk(p[B_ + 2], p[B_ + 3]); unsigned b0 = cvtpk(p[B_ + 4], p[B_ + 5]), b1 = cvtpk(p[B_ + 6], p[B_ + 7]); \
            auto r0 = __builtin_amdgcn_permlane32_swap(a0, b0, false, false); auto r1 = __builtin_amdgcn_permlane32_swap(a1, b1, false, false); \
            u32x4 w_ = {r0[0], r1[0], r0[1], r1[1]}; OUT = __builtin_bit_cast(bf16x8, w_); } while (0)
            ATT_PK4(0, pa0); ATT_PK4(8, pa1);
#undef ATT_PK4
            asm volatile("s_waitcnt lgkmcnt(0)" ::: "memory"); ATT_SBAR();
            __builtin_amdgcn_s_setprio(1);
#define ATT_PV(i, d0) do { \
            o[d0] = __builtin_amdgcn_mfma_f32_32x32x16_bf16(pa0, (bf16x8){vl0[i][0], vl0[i][1], vl0[i][2], vl0[i][3], vh0[i][0], vh0[i][1], vh0[i][2], vh0[i][3]}, o[d0], 0, 0, 0); \
            o[d0] = __builtin_amdgcn_mfma_f32_32x32x16_bf16(pa1, (bf16x8){vl1[i][0], vl1[i][1], vl1[i][2], vl1[i][3], vh1[i][0], vh1[i][1], vh1[i][2], vh1[i][3]}, o[d0], 0, 0, 0); } while (0)
            ATT_PV(0, 0); ATT_SBAR(); ATT_VRD(0, 2); ATT_SBAR(); ATT_PV(1, 1); ATT_SBAR(); ATT_VRD(1, 3);
            asm volatile("s_waitcnt lgkmcnt(0)" ::: "memory"); ATT_SBAR();
            ATT_PV(0, 2); ATT_PV(1, 3);
#undef ATT_PV
#undef ATT_VRD
#undef ATT_TRRD
            __builtin_amdgcn_s_setprio(0);
        }
        asm volatile("s_waitcnt vmcnt(0)" ::: "memory");
        __syncthreads();
    }
    int lane_m = lane; asm volatile("" : "+v"(lane_m));
    const int r32m = lane_m & 31, him = lane_m >> 5;
    LAS float* MO = (LAS float*)(lds + OFF_MO) + qsub * 4096; LAS float* ML = (LAS float*)(lds + OFF_ML) + qsub * 64;
    if (kh == 1) {
        if (him == 0) { ML[2 * r32m] = m_reg; ML[2 * r32m + 1] = l_reg; }
#pragma unroll
        for (int d = 0; d < 4; ++d)
#pragma unroll
            for (int r = 0; r < 16; ++r) MO[(d * 16 + r) * 64 + lane_m] = o[d][r];
    }
    __syncthreads();
    if (kh == 0) {
        const float m1 = ML[2 * r32m], l1 = ML[2 * r32m + 1];
        const float mm = fmaxf(m_reg, m1), f0 = __builtin_amdgcn_exp2f(m_reg - mm), f1 = __builtin_amdgcn_exp2f(m1 - mm);
        const float il = 1.f / (l_reg * f0 + l1 * f1);
        if (him == 0) { wsf[r32m] = f0 * il; wsf[32 + r32m] = f1 * il; }
        asm volatile("s_waitcnt lgkmcnt(0)" ::: "memory");
        const int b = bh / NH, h = bh % NH;
        bf16* Ow = AO + ((size_t)b * SEQ + q0 + rb) * DM + h * DV;
        float* Mw = MSS + ((size_t)b * SEQ + q0 + rb) * 12 + h;
#pragma unroll
        for (int r = 0; r < 16; ++r) { const int orow = crow(r, him); const float g0 = wsf[orow], g1 = wsf[32 + orow]; float ss = 0.f;
#pragma unroll
            for (int d = 0; d < 4; ++d) { const float v = o[d][r] * g0 + MO[(d * 16 + r) * 64 + lane_m] * g1; const float vn = __shfl_xor(v, 1); ss += v * v;
                if ((r32m & 1) == 0) *(unsigned*)(Ow + (size_t)orow * DM + d * 32 + r32m) = cvtpk(v, vn); }
            ss += tk::dppf<0xB1>(ss); ss += tk::dppf<0x4E>(ss); ss += tk::dppf<0x141>(ss); ss += tk::dppf<0x140>(ss); ss += __shfl_xor(ss, 16);
            if (r32m == 0) Mw[(size_t)orow * 12] = ss; }
    }
    __syncthreads();
#undef ATT_STAGE
}
template <int SKIP = 0> __device__ __forceinline__ void attn_phase(LAS unsigned char* lds, const bf16* Qg, const bf16* Kg, const bf16* Vg, bf16* AO, float* MSS, int G, int bid, int tid) {
    const int npair = NB * NH * 32;
    for (int v0 = bid; v0 < npair; v0 += G) {
        const int vcu = (G % 8 == 0 && npair % G == 0) ? (v0 % 8) * (npair / 8) + v0 / 8 : v0;
        const int bh = vcu >> 5, s = vcu & 31;
        for (int u = 0; u < 2; ++u) attn_unit<SKIP>(lds, Qg, Kg, Vg, AO, MSS, bh, u ? s : 63 - s, tid);
    }
}
#undef ATT_SBAR
}
#ifndef MK_PROBE
#define MK_PROBE 0
#endif
#ifndef MK_UTEST
#define MK_UTEST 0
#endif
#ifndef PROBE_A_LO
#define PROBE_A_LO 0
#define PROBE_A_HI 1
#define PROBE_B_LO 16
#define PROBE_B_HI 17
#endif
#ifndef PROBE_Q
#define PROBE_Q 4.f
#endif
#define TS_OFF 8192
#ifndef MK_DUP
#define MK_DUP 0
#endif
#ifndef MK_DUP_SKIP
#define MK_DUP_SKIP 0
#endif
#ifndef MK_DUPK
#define MK_DUPK 0
#endif
#ifndef MK_DUP_LOADONLY
#define MK_DUP_LOADONLY false
#endif
#ifndef MK_DUP_EMASK
#define MK_DUP_EMASK 0x3fff
#endif
#ifndef MK_SIMPLE_TOPK
#define MK_SIMPLE_TOPK 0
#endif
#ifndef MK_SIMPLE_SCAN
#define MK_SIMPLE_SCAN 0
#endif
#ifndef MK_SIMPLE_ATTN
#define MK_SIMPLE_ATTN 0
#endif
#ifndef MK_SIMPLE_GEMM
#define MK_SIMPLE_GEMM 0
#endif
constexpr int NPH_LAYER = 9, NPH = 1 + NL * NPH_LAYER;
struct GD { const bf16* A; const bf16* Bt; void* C; const float* aux0; const bf16* aux1; int lda, M, N, K, ldc, kind; };
template <class Epi> __device__ __forceinline__ void run_gemm(const Ctx& c, const bf16* A, int lda, const bf16* Bt, int M, int N, int K, const Epi& E) {
    pg8::Gemm g{A, Bt, M, N, K, lda}; pg8::StaticOrder S; S.init(M, N, c.G, c.bid);
    pg8::gemm_phase<Epi, pg8::StaticOrder, true, true>(c.lds, g, S, E);
}
#define AS4 __attribute__((address_space(4)))
#define PH_BEGIN \
        const Args AS4* ap = (const Args AS4*)__builtin_amdgcn_kernarg_segment_ptr(); asm volatile("" : "+s"(ap)); \
        int tid_ = threadIdx.x; asm volatile("" : "+v"(tid_)); \
        Ctx c; c.lds = (LAS unsigned char*)lds_raw; c.tid = tid_; c.lane = c.tid & 63; c.wave = __builtin_amdgcn_readfirstlane(c.tid >> 6); \
        { int G_ = gridDim.x, bid_ = blockIdx.x; asm volatile("" : "+s"(G_), "+s"(bid_)); c.G = G_; c.bid = bid_; } \
        c.gw = c.wave * c.G + c.bid; c.ngw = NWAVES * c.G; c.gt = c.bid * NTHR + c.tid; c.ngt = c.G * NTHR; \
        unsigned char* const ws = ap->ws; float* const out = ap->out; (void)out; (void)ws;
#define WSQ(T_, off) ((T_*)(ws + (off)))
#define INQ(i) ((const float*)ap->in[i])
#define PH_BAR(P) if ((P) + 1 < ph_hi) { XcdBarrier b2 = bar; unsigned* bb = (unsigned*)(ap->ws + WS_CTL) + CW_BAR; unsigned bx = bar.x; asm volatile("" : "+s"(bb), "+s"(bx)); b2.bar = bb; b2.x = bx; xcd_barrier(b2); } PH_STAMP(P)
#if MK_PROBE
#define PH_STAMP(P) if (blockIdx.x == 0 && threadIdx.x == 0) ((unsigned long long*)(ap->ws + WS_CTL + TS_OFF))[(P) + 1] = __builtin_amdgcn_s_memrealtime();
#else
#define PH_STAMP(P)
#endif
#define PHASE(P) if (ph_lo <= (P) && (P) < ph_hi)

template <int L> __device__ __forceinline__ void layer_phases(unsigned char* lds_raw, const XcdBarrier& bar, int ph_lo, int ph_hi) {
    constexpr int P0 = 1 + L * NPH_LAYER;
    PHASE(P0 + 0) { PH_BEGIN
        run_gemm(c, WSQ(bf16, WS_XB), DM, WSQ(bf16, WS_WINT) + (size_t)L * ZW * DM, T, (c.G > 128) ? 1024 : ZW, DM, pg8::EpiBf16<0>{WSQ(bf16, WS_Z), ZW, nullptr, 0, 0, 1.f});
        PH_BAR(P0 + 0) }
    PHASE(P0 + 1) { PH_BEGIN
        if (c.G > 128) run_gemm(c, WSQ(bf16, WS_XB), DM, WSQ(bf16, WS_WINT) + (size_t)L * ZW * DM + (size_t)1024 * DM, T, 256, DM, pg8::EpiBf16<0>{WSQ(bf16, WS_Z) + 1024, ZW, nullptr, 0, 0, 1.f});
    }
    PHASE(P0 + 1) { PH_BEGIN
        if (c.G > 128) { if (c.bid < 64) { c.gw = 0x04000000; c.gt = 0x04000000; } else { c.gw = c.wave * (c.G - 64) + (c.bid - 64); c.gt = (c.bid - 64) * NTHR + c.tid; } c.ngw = NWAVES * (c.G - 64); c.ngt = (c.G - 64) * NTHR; }
        ph_zstats(c, WSQ(bf16, WS_Z), INQ(4) + L * 256, INQ(6) + L * 128, WSQ(bf16, WS_CQN), WSQ(bf16, WS_CKVN));
        s5f::pass_a_mfma(WSQ(bf16, WS_Z), WSQ(bf16, WS_S5W) + (size_t)L * 1048576, WSQ(float2, WS_SE), c.gw, c.ngw, c.lane);
        lruf::pass_a(c.lds, WSQ(bf16, WS_Z), INQ(20) + L * 1024, INQ(21) + L * 256, WSQ(bf16, WS_LWT) + (size_t)L * 32768, INQ(23) + L * 256, INQ(25) + L * 256, INQ(26) + L * 256, WSQ(float, WS_AA), WSQ(float, WS_BT), WSQ(float2, WS_LPE), c.gw, c.ngw, c.wave, c.lane);
#if MK_DUP & 4096
        ph_zstats(c, WSQ(bf16, WS_Z), INQ(4) + L * 256, INQ(6) + L * 128, WSQ(bf16, WS_CQN), WSQ(bf16, WS_CKVN));
#endif
#if MK_DUP & 8192
        __syncthreads(); s5f::pass<false>(c.lds, WSQ(bf16, WS_Z), WSQ(bf16, WS_S5A) + (size_t)L * 32768, WSQ(bf16, WS_S5C) + (size_t)L * 32768, WSQ(float2, WS_S5L) + L * 1024, INQ(17) + L * 256, WSQ(float2, WS_SE), WSQ(float2, WS_SH), WSQ(bf16, WS_YG), c.gw, c.ngw, c.wave, c.lane);
#endif
#if MK_DUP & 16384
        __syncthreads(); lruf::pass_a(c.lds, WSQ(bf16, WS_Z), INQ(20) + L * 1024, INQ(21) + L * 256, WSQ(bf16, WS_LWT) + (size_t)L * 32768, INQ(23) + L * 256, INQ(25) + L * 256, INQ(26) + L * 256, WSQ(float, WS_AA), WSQ(float, WS_BT), WSQ(float2, WS_LPE), c.gw, c.ngw, c.wave, c.lane);
#endif
        PH_BAR(P0 + 1) }
    PHASE(P0 + 2) { PH_BEGIN
        for (int it = c.bid; it < 232; it += c.G) {
            if (it >= 224) lruf::carry_wg(c.lds, WSQ(float2, WS_LPE), WSQ(float, WS_LH), it - 224, c.wave, c.lane);
            else if (it >= 192) s5f::carry_wg(c.lds, WSQ(float2, WS_S5L) + L * 1024, WSQ(float2, WS_SE), WSQ(float2, WS_SH), it - 192, c.wave, c.lane);
        }
        run_gemm(c, WSQ(bf16, WS_CQN), 256, WSQ(bf16, WS_WUQT) + (size_t)L * 768 * 256, T, 768, 256, pg8::EpiBf16<0>{WSQ(bf16, WS_QRAW), 768, nullptr, 0, 0, 1.f});
    }
    PHASE(P0 + 2) { PH_BEGIN
        run_gemm(c, WSQ(bf16, WS_CKVN), 128, WSQ(bf16, WS_WUKVT) + (size_t)L * 1024 * 128, T, 1024, 128, pg8::EpiBf16<0>{WSQ(bf16, WS_KVRAW), 1024, nullptr, 0, 0, 1.f});
        PH_BAR(P0 + 2) }
    PHASE(P0 + 3) { PH_BEGIN
        ph_qkfin(c, WSQ(bf16, WS_QRAW), WSQ(bf16, WS_KVRAW), WSQ(bf16, WS_Z), INQ(8) + L * DQK, INQ(9) + L * DQK, WSQ(float, WS_COS), WSQ(float, WS_SIN), WSQ(bf16, WS_QB), WSQ(bf16, WS_KB), WSQ(bf16, WS_VB));
#if MK_DUP & 64
        ph_qkfin(c, WSQ(bf16, WS_QRAW), WSQ(bf16, WS_KVRAW), WSQ(bf16, WS_Z), INQ(8) + L * DQK, INQ(9) + L * DQK, WSQ(float, WS_COS), WSQ(float, WS_SIN), WSQ(bf16, WS_QB), WSQ(bf16, WS_KB), WSQ(bf16, WS_VB));
#endif
    }
    PHASE(P0 + 3) { PH_BEGIN
        s5f::pass_b(c.lds, WSQ(bf16, WS_Z), WSQ(bf16, WS_S5A) + (size_t)L * 32768, WSQ(bf16, WS_S5C) + (size_t)L * 32768, WSQ(float2, WS_S5L) + L * 1024, INQ(17) + L * 256, WSQ(float2, WS_SH), WSQ(bf16, WS_YG), c.gw, c.ngw, c.wave, c.lane);
        lruf::pass_b(WSQ(float, WS_AA), WSQ(float, WS_BT), WSQ(float, WS_LH), WSQ(bf16, WS_Z), WSQ(bf16, WS_Y) + 768, DM, WSQ(float, WS_MIXSS), c.gt, c.ngt);
#if MK_DUP & 1024
        s5f::pass<true>(c.lds, WSQ(bf16, WS_Z), WSQ(bf16, WS_S5A) + (size_t)L * 32768, WSQ(bf16, WS_S5C) + (size_t)L * 32768, WSQ(float2, WS_S5L) + L * 1024, INQ(17) + L * 256, WSQ(float2, WS_SE), WSQ(float2, WS_SH), WSQ(bf16, WS_YG), c.gw, c.ngw, c.wave, c.lane);
#endif
#if MK_DUP & 2048
        lruf::pass_b(WSQ(float, WS_AA), WSQ(float, WS_BT), WSQ(float, WS_LH), WSQ(bf16, WS_Z), WSQ(bf16, WS_Y) + 768, DM, WSQ(float, WS_MIXSS), c.gt, c.ngt);
#endif
        PH_BAR(P0 + 3) }
    PHASE(P0 + 4) { PH_BEGIN
        run_gemm(c, WSQ(bf16, WS_YG), 256, WSQ(bf16, WS_GLUT) + (size_t)L * 65536, T, 256, 256, pg8::EpiGlu{WSQ(bf16, WS_Y) + 512, DM, INQ(19) + L * 256, WSQ(bf16, WS_YG), 256, WSQ(float, WS_MIXSS)});
    }
    PHASE(P0 + 4) { PH_BEGIN
#if MK_DUP & 512
        att::attn_phase<MK_DUP_SKIP>(c.lds, WSQ(bf16, WS_QB), WSQ(bf16, WS_KB), WSQ(bf16, WS_VB), WSQ(bf16, WS_RA), WSQ(float, WS_IDX), c.G, c.bid, c.tid);
#endif
        att::attn_phase(c.lds, WSQ(bf16, WS_QB), WSQ(bf16, WS_KB), WSQ(bf16, WS_VB), WSQ(bf16, WS_Y), WSQ(float, WS_MIXSS), c.G, c.bid, c.tid);
        PH_BAR(P0 + 4) }
    PHASE(P0 + 6) { PH_BEGIN
        const float* xin = (L == 0) ? INQ(0) : out;
        run_gemm(c, WSQ(bf16, WS_Y), DM, WSQ(bf16, WS_WOUTT) + (size_t)L * DM * DM, T, DM, DM, pg8::EpiOut{out, DM, xin, INQ(29) + L * DM, WSQ(bf16, WS_XB), WSQ(float, WS_ROWSS), WSQ(float, WS_MIXSS), (LAS float*)(c.lds + RING_BYTES + 4096)});
        PH_BAR(P0 + 6) }
    PHASE(P0 + 7) { PH_BEGIN
        run_gemm(c, WSQ(bf16, WS_XB), DM, WSQ(bf16, WS_WQT) + (size_t)L * 2048 * DM, T, 2048, DM, pg8::EpiBf16<0>{WSQ(bf16, WS_QP), 2048, nullptr, 0, 0, 1.f});
        PH_BAR(P0 + 7) }
    PHASE(P0 + 8) { PH_BEGIN
#if MK_DUP & 8
        tk::peer_phase<MK_DUP_EMASK, MK_DUP_SKIP>(c.lds, WSQ(bf16, WS_QP), WSQ(bf16, WS_SUBKT) + (size_t)L * 32768, WSQ(bf16, WS_XB), WSQ(unsigned char, WS_PU) + (size_t)L * 16384 * pgf::ROWB, WSQ(unsigned char, WS_PU) + (size_t)L * 16384 * pgf::ROWB + pgf::VOFF,
                                                  out, WSQ(float, WS_RA), WSQ(float, WS_ROWSS), nullptr, c.G, c.bid, c.tid);
        __syncthreads();
#endif
        tk::peer_phase<0x3fff, 0>(c.lds, WSQ(bf16, WS_QP), WSQ(bf16, WS_SUBKT) + (size_t)L * 32768, WSQ(bf16, WS_XB), WSQ(unsigned char, WS_PU) + (size_t)L * 16384 * pgf::ROWB, WSQ(unsigned char, WS_PU) + (size_t)L * 16384 * pgf::ROWB + pgf::VOFF,
                                  out, out, WSQ(float, WS_ROWSS), (L + 1 < NL) ? INQ(2) + (L + 1) * DM : nullptr, c.G, c.bid, c.tid);
        PH_BAR(P0 + 8) }
}

__global__ void __launch_bounds__(NTHR, 2) mega(Args a_) {
    extern __shared__ __attribute__((aligned(16))) unsigned char lds_raw[];
    {   const int t0 = threadIdx.x;
        for (int u = t0; u < (LDS_BYTES - RING_BYTES) / 4; u += NTHR) ((LAS unsigned*)((LAS unsigned char*)lds_raw + RING_BYTES))[u] = 0u; }
    __syncthreads();
    volatile LAS unsigned* MISC = (volatile LAS unsigned*)((LAS unsigned char*)lds_raw + MISC_OFF);
    XcdBarrier bar; bar.bar = (unsigned*)(a_.ws + WS_CTL) + CW_BAR; bar.x = 0; bar.st = MISC + 8;
    const int ph_lo = a_.ph_lo, ph_hi = a_.ph_hi;
    if (ph_hi - ph_lo > 1) bar = xcd_barrier_post((unsigned*)(a_.ws + WS_CTL) + CW_BAR, MISC + 8);
#if MK_PROBE
    if (blockIdx.x == 0 && threadIdx.x == 0) ((unsigned long long*)(a_.ws + WS_CTL + TS_OFF))[0] = __builtin_amdgcn_s_memrealtime();
#endif
    PHASE(0) { PH_BEGIN
        ph_prep(*ap, c);
        PH_BAR(0) }
    layer_phases<0>(lds_raw, bar, ph_lo, ph_hi);
    layer_phases<1>(lds_raw, bar, ph_lo, ph_hi);
#if MK_UTEST
    xcd_barrier(bar);
    if (blockIdx.x == 0 && threadIdx.x < 64) {
        typedef int i32x8 __attribute__((ext_vector_type(8))); typedef float f32x4 __attribute__((ext_vector_type(4)));
        const int lane = threadIdx.x, l15 = lane & 15, q4 = lane >> 4;
        i32x8 b = i32x8{0, 0, 0, 0, 0, 0, 0, 0};
#pragma unroll
        for (int d = 0; d < 8; ++d) { unsigned w = 0;
#pragma unroll
            for (int e = 0; e < 4; ++e) { const int idx = q4 * 32 + 4 * d + e; const unsigned by = idx < 126 ? (unsigned)(idx + 1) : (unsigned)(0x81 + idx - 126); w |= by << (8 * e); }
            b[d] = (l15 == 0) ? (int)w : 0; }
        int okH1 = 1, okH2 = 1, f52 = -1;
        for (int p = 0; p < 128; ++p) {
            const int kq = p >> 5, jj = p & 31, bit = (MK_UTEST == 4 ? 4 * jj + 1 : 6 * jj + 3), dw = bit >> 5, sh = bit & 31;
            i32x8 a;
#pragma unroll
            for (int d = 0; d < 8; ++d) a[d] = (l15 == 0 && q4 == kq && d == dw) ? (int)(1u << sh) : 0;
            f32x4 acc = f32x4{0.f, 0.f, 0.f, 0.f};
            acc = __builtin_amdgcn_mfma_scale_f32_16x16x128_f8f6f4(a, b, acc, (MK_UTEST == 4 ? 4 : 2), 0, 0, 127, 0, 127);
            const float D = __shfl(acc[0], 0);
            int found = -1;
            for (int idx = 0; idx < 128; ++idx) { const int by = idx < 126 ? idx + 1 : 0x81 + idx - 126; if (__builtin_amdgcn_cvt_f32_fp8(by, 0) == D) found = idx; }
            const int h2 = (p < 64) ? ((p >> 4) * 32 + (p & 15)) : (((p - 64) >> 4) * 32 + 16 + (p & 15));
            if (found != p) okH1 = 0;
            if (found != h2) okH2 = 0;
            if (p == 52) f52 = found;
        }
        if (lane == 0) a_.out[0] = okH1 ? 1024.f : okH2 ? 1048576.f : (f52 < 0 ? 3.f * 1073741824.f : exp2f((float)(f52 >> 1) + 32.f) * ((f52 & 1) ? 1.5f : 1.f));
    }
#endif
#if MK_PROBE
    xcd_barrier(bar);
    if (blockIdx.x == 0 && threadIdx.x == 0) {
        const unsigned long long* ts = (const unsigned long long*)(a_.ws + WS_CTL + TS_OFF);
        const float d_us = (float)(__hip_atomic_load(ts + PROBE_A_HI, __ATOMIC_RELAXED, __HIP_MEMORY_SCOPE_AGENT) - __hip_atomic_load(ts + PROBE_A_LO, __ATOMIC_RELAXED, __HIP_MEMORY_SCOPE_AGENT)) * 0.01f;
        a_.out[0] += rintf(d_us * (1.f / PROBE_Q)) * PROBE_Q;
    }
#endif
}

extern "C" void kernel_launch(void* const* d_in, const int* in_sizes, int n_in, void* d_out, int out_size, void* d_ws, size_t ws_size, hipStream_t stream) {
    static int grid = 0;
    if (grid == 0) {
        if (n_in != 34 || out_size != T * DM || ws_size < WS_END) { fprintf(stderr, "kernel_launch: unexpected shapes (n_in %d out %d ws %zu)\n", n_in, out_size, ws_size); grid = -1; return; }
        int dev = 0, cus = 0, per_cu = 0;
        if (hipGetDevice(&dev) != hipSuccess || hipDeviceGetAttribute(&cus, hipDeviceAttributeMultiprocessorCount, dev) != hipSuccess) { grid = -1; return; }
        if (hipFuncSetAttribute((const void*)mega, hipFuncAttributeMaxDynamicSharedMemorySize, LDS_BYTES) != hipSuccess) { fprintf(stderr, "kernel_launch: hipFuncSetAttribute failed\n"); grid = -1; return; }
        if (hipOccupancyMaxActiveBlocksPerMultiprocessor(&per_cu, (const void*)mega, NTHR, LDS_BYTES) != hipSuccess || per_cu < 1) { fprintf(stderr, "kernel_launch: occupancy query says %d blocks per CU\n", per_cu); }
        (void)hipGetLastError();
        grid = cus;
    }
    if (grid < 0) return;
    (void)hipMemsetAsync((char*)d_ws + WS_CTL, 0, CTL_ZERO_BYTES, stream);
    Args a{};
    for (int i = 0; i < 34; ++i) a.in[i] = d_in[i];
    a.out = (float*)d_out; a.ws = (unsigned char*)d_ws;
#if MK_PER_PHASE
    for (int p = 0; p < NPH; ++p) { a.ph_lo = p; a.ph_hi = p + 1; hipLaunchKernelGGL(mega, dim3(grid), dim3(NTHR), LDS_BYTES, stream, a); }
#else
    a.ph_lo = 0; a.ph_hi = NPH;
    hipLaunchKernelGGL(mega, dim3(grid), dim3(NTHR), LDS_BYTES, stream, a);
#endif
}
```
